# Optimizing an MI355X kernel written in HIP

```python
import math
import jax, jax.numpy as jnp
from jax import lax
import numpy as np

D_MODEL = 1024
BATCH = 1
SEQ = 16384
DEPTH = 4

HEAD_DIM = 64
CONV_HEADS = 4
CONV_WIDTH = CONV_HEADS * HEAD_DIM
SGU_HEADS = 4
SGU_WIDTH = SGU_HEADS * HEAD_DIM
SB_HEADS = 8
SB_WIDTH = SB_HEADS * HEAD_DIM
D_MIX = CONV_WIDTH + SGU_WIDTH + SB_WIDTH
CHUNK = 128
SB_BLOCK = 128
CONV_K = 3
D_FF = 2816
EPS = 1e-6
IN_SIZES = (CONV_WIDTH, CONV_WIDTH, CONV_WIDTH,
            SGU_WIDTH, SGU_WIDTH,
            SB_WIDTH, SB_WIDTH, SB_WIDTH)
IN_COLS = sum(IN_SIZES)
IN_SPLITS = tuple(int(s) for s in np.cumsum(IN_SIZES)[:-1])
OUT_SPLITS = (CONV_WIDTH, CONV_WIDTH + SGU_WIDTH)

kernel_name = "hybrid_conv_sgu_stickbreak_trunk"


def rmsnorm(x, g):
    xf = x.astype(jnp.float32)
    y = xf * lax.rsqrt(jnp.mean(xf * xf, axis=-1, keepdims=True) + EPS)
    return (y * g.astype(jnp.float32)).astype(x.dtype)


def causal_dwconv(x, w):
    S = x.shape[1]
    xp = jnp.pad(x, ((0, 0), (CONV_K - 1, 0), (0, 0)))
    y = w[0] * xp[:, 0:S]
    for i in range(1, CONV_K):
        y = y + w[i] * xp[:, i:i + S]
    return y


def spatial_gating(u, v, g_norm, w_s, b_s):
    Bsz, S, _ = v.shape
    v = rmsnorm(v, g_norm)
    vc = v.reshape(Bsz, S // CHUNK, CHUNK, SGU_HEADS, HEAD_DIM)
    mask = jnp.tril(jnp.ones((CHUNK, CHUNK), dtype=w_s.dtype))
    mixed = jnp.einsum('hts,bcshd->bcthd', w_s * mask, vc)
    mixed = mixed + b_s.T[None, None, :, :, None]
    return u * mixed.reshape(Bsz, S, SGU_WIDTH)


def stick_breaking_attention(q, k, v):
    Bsz, S, H, Dh = q.shape
    f32 = jnp.float32
    q = (q.astype(f32) * (1.0 / math.sqrt(Dh))).transpose(0, 2, 1, 3)
    k = k.astype(f32).transpose(0, 2, 1, 3)
    v = v.astype(f32).transpose(0, 2, 1, 3)
    n_blocks = S // SB_BLOCK
    t_idx = jnp.arange(SB_BLOCK)[:, None]
    s_idx = jnp.arange(SB_BLOCK)[None, :]

    def query_block(i):
        q_blk = lax.dynamic_slice_in_dim(q, i * SB_BLOCK, SB_BLOCK, axis=2)

        def key_step(n, carry):
            acc, log_surv = carry
            j = i - n
            k_blk = lax.dynamic_slice_in_dim(k, j * SB_BLOCK, SB_BLOCK, axis=2)
            v_blk = lax.dynamic_slice_in_dim(v, j * SB_BLOCK, SB_BLOCK, axis=2)
            z = jnp.einsum('bhtd,bhsd->bhts', q_blk, k_blk)
            valid = (j < i) | (s_idx < t_idx)
            log_1mb = jnp.where(valid, jax.nn.log_sigmoid(-z), 0.0)
            suffix = lax.cumsum(log_1mb, axis=3, reverse=True) - log_1mb
            log_w = jax.nn.log_sigmoid(z) + suffix + log_surv[..., None]
            w = jnp.where(valid, jnp.exp(log_w), 0.0)
            acc = acc + jnp.einsum('bhts,bhsd->bhtd', w, v_blk)
            return acc, log_surv + jnp.sum(log_1mb, axis=-1)

        init = (jnp.zeros((Bsz, H, SB_BLOCK, Dh), f32),
                jnp.zeros((Bsz, H, SB_BLOCK), f32))
        acc, _ = lax.fori_loop(0, i + 1, key_step, init)
        return acc

    out = lax.map(query_block, jnp.arange(n_blocks))
    return out.transpose(1, 0, 3, 2, 4).reshape(Bsz, S, H * Dh)


def setup_inputs(seed: int = 0) -> dict:
    key = jax.random.key(seed)
    ks = jax.random.split(key, 16)
    n = jax.random.normal
    f32 = jnp.float32
    return {
        "x": n(ks[0], (BATCH, SEQ, D_MODEL), f32),
        "norm_mix": 1.0 + 0.05 * n(ks[1], (DEPTH, D_MODEL), f32),
        "w_in": n(ks[2], (DEPTH, D_MODEL, IN_COLS), f32) * D_MODEL ** -0.5,
        "conv_w": n(ks[3], (DEPTH, CONV_K, CONV_WIDTH), f32) * CONV_K ** -0.5,
        "sgu_norm": 1.0 + 0.05 * n(ks[4], (DEPTH, SGU_WIDTH), f32),
        "sgu_w": n(ks[5], (DEPTH, SGU_HEADS, CHUNK, CHUNK), f32) * CHUNK ** -0.5,
        "sgu_b": 1.0 + 0.1 * n(ks[6], (DEPTH, SGU_HEADS, CHUNK), f32),
        "out_norm": 1.0 + 0.05 * n(ks[7], (DEPTH, D_MIX), f32),
        "w_out": n(ks[8], (DEPTH, D_MIX, D_MODEL), f32) * D_MIX ** -0.5,
        "norm_ffn": 1.0 + 0.05 * n(ks[9], (DEPTH, D_MODEL), f32),
        "w_up": n(ks[10], (DEPTH, D_MODEL, 2 * D_FF), f32) * D_MODEL ** -0.5,
        "ffn_conv": n(ks[11], (DEPTH, CONV_K, 2 * D_FF), f32) * CONV_K ** -0.5,
        "w_down": n(ks[12], (DEPTH, D_FF, D_MODEL), f32) * D_FF ** -0.5,
        "norm_final": 1.0 + 0.05 * n(ks[13], (D_MODEL,), f32),
    }


def reference(x, norm_mix, w_in, conv_w, sgu_norm, sgu_w, sgu_b, out_norm, w_out,
              norm_ffn, w_up, ffn_conv, w_down, norm_final):
    Bsz, S, _ = x.shape
    for l in range(DEPTH):
        h = rmsnorm(x, norm_mix[l])
        p = h @ w_in[l]
        gb, gc, hc, u, vs, q, k, v = jnp.split(p, IN_SPLITS, axis=-1)
        y_conv = gb * causal_dwconv(gc * hc, conv_w[l])
        y_sgu = spatial_gating(u, vs, sgu_norm[l], sgu_w[l], sgu_b[l])
        y_sb = stick_breaking_attention(
            q.reshape(Bsz, S, SB_HEADS, HEAD_DIM),
            k.reshape(Bsz, S, SB_HEADS, HEAD_DIM),
            v.reshape(Bsz, S, SB_HEADS, HEAD_DIM)).astype(x.dtype)
        g_a, g_b, g_c = jnp.split(out_norm[l], OUT_SPLITS)
        y = jnp.concatenate([rmsnorm(y_conv, g_a), rmsnorm(y_sgu, g_b),
                             rmsnorm(y_sb, g_c)], axis=-1)
        x = x + y @ w_out[l]
        h2 = rmsnorm(x, norm_ffn[l])
        gu = causal_dwconv(h2 @ w_up[l], ffn_conv[l])
        g, up = jnp.split(gu, 2, axis=-1)
        x = x + (jax.nn.silu(g) * up) @ w_down[l]
    return rmsnorm(x, norm_final)
```

```cpp
#include <hip/hip_runtime.h>
#include <hip/hip_cooperative_groups.h>
#include <cstdio>
#include <cstdint>
namespace cg = cooperative_groups;
namespace pg8 {
#define PG8_LAS __attribute__((address_space(3)))
typedef unsigned short bf16_t;
typedef short bf16x8 __attribute__((ext_vector_type(8)));
typedef float f32x4 __attribute__((ext_vector_type(4)));
typedef unsigned u32x4 __attribute__((ext_vector_type(4)));
constexpr int BM = 256, BK = 64, HALF = 128, HTB = HALF * BK * 2  , STAGE_BYTES = 8 * HTB, NXCD = 8, WGM = 8;

__host__ __device__ __forceinline__ int lds_byte(int r, int c) { const int st = (r >> 4) * 2 + (c >> 5), rr = r & 15, cc = c & 31, ob = rr * 64 + cc * 2; return st * 1024 + (ob ^ (((ob >> 9) & 1) << 5)); }
__host__ __device__ __forceinline__ void stage_rc(int b, int& R, int& C) { const int st = b / 1024, sb = b % 1024, swz = sb ^ (((sb >> 9) & 1) << 5); R = (st >> 1) * 16 + swz / 64; C = (st & 1) * 32 + (swz % 64) / 2; }
__host__ __device__ __forceinline__ int perm32(int rho) { const int n = rho >> 4, i = rho & 15; return 8 * (i >> 2) + 4 * n + (i & 3); }

struct Unit { int pm, pn; };
struct Gemm { const bf16_t* A; const bf16_t* Bt; int M, N, K; };

struct StaticOrder {
    int nM, nN, nwg, G, c;
    __host__ __device__ void init(int M, int N, int G_, int c_) { nM = M / BM; nN = N / BM; nwg = nM * nN; G = G_; c = c_; }
    __host__ __device__ bool next(int i, Unit& u) const {
        const long L = (long)i * G + c; if (L >= nwg) return false;
        int wgid = (int)L; { const int q = nwg / NXCD, r = nwg % NXCD, xcd = wgid % NXCD, off = wgid / NXCD; wgid = (xcd < r ? xcd * (q + 1) : r * (q + 1) + (xcd - r) * q) + off; }
        const int nig = WGM * nN, gid = wgid / nig, fm = gid * WGM, gsz = (nM - fm) < WGM ? (nM - fm) : WGM;
        u.pm = fm + ((wgid % nig) % gsz); u.pn = (wgid % nig) / gsz; return true;
    }
    __device__ __forceinline__ void a_ready(const Unit&) const {}
    __device__ __forceinline__ void done(const Unit&) const {}
};

__device__ __forceinline__ unsigned cvt_pk_bf16(float lo, float hi) { unsigned r; asm volatile("v_cvt_pk_bf16_f32 %0, %1, %2" : "=v"(r) : "v"(lo), "v"(hi)); return r; }
struct EpiScaleBf16 {
    static constexpr bool PERM = true, AFTER_DRAIN = false;
    bf16_t* O; int ldc; const float* part;
    __device__ __forceinline__ void operator()(const f32x4 (&acc)[2][2][4][2], const Unit& u, int wr, int wc, int fr, int fq) const {
        const int row0 = u.pm * BM + wr * 64 + fr; const int col0 = u.pn * BM + wc * 32 + 8 * fq;
#pragma unroll
        for (int ai = 0; ai < 2; ++ai)
#pragma unroll
            for (int m = 0; m < 4; ++m) { const int row = row0 + ai * HALF + m * 16;
                const f32x4* pp = (const f32x4*)(part + (size_t)row * 16); const f32x4 a = pp[0], b = pp[1], c = pp[2], d = pp[3];
                const f32x4 s4 = (a + b) + (c + d); const float ss = (s4[0] + s4[1]) + (s4[2] + s4[3]);
                const float rs = __builtin_amdgcn_rsqf(ss * (1.0f / 1024.0f) + 1e-6f);
                bf16_t* rowp = O + (size_t)row * ldc + col0;
#pragma unroll
                for (int bj = 0; bj < 2; ++bj) { const f32x4 v0 = acc[ai][bj][m][0] * rs, v1 = acc[ai][bj][m][1] * rs;
                    u32x4 w; w.x = cvt_pk_bf16(v0[0], v0[1]); w.y = cvt_pk_bf16(v0[2], v0[3]); w.z = cvt_pk_bf16(v1[0], v1[1]); w.w = cvt_pk_bf16(v1[2], v1[3]);
                    *(u32x4*)(rowp + bj * HALF) = w; }
                if (m & 1) asm volatile("" ::: "memory"); }
    }
};
struct EpiResid {
    static constexpr bool PERM = true, AFTER_DRAIN = false;
    const float* base; float* out; bf16_t* xb; float* part;
    __device__ __forceinline__ void operator()(const f32x4 (&acc)[2][2][4][2], const Unit& u, int wr, int wc, int fr, int fq) const {
        const int row0 = u.pm * BM + wr * 64 + fr; const int col0 = u.pn * BM + wc * 32 + 8 * fq;
#pragma unroll
        for (int ai = 0; ai < 2; ++ai)
#pragma unroll
            for (int m = 0; m < 4; ++m) { const int row = row0 + ai * HALF + m * 16; const size_t off = (size_t)row * 1024 + col0; float ss = 0.f;
#pragma unroll
                for (int bj = 0; bj < 2; ++bj) { const f32x4 b0 = *(const f32x4*)(base + off + bj * HALF), b1 = *(const f32x4*)(base + off + bj * HALF + 4);
                    const f32x4 v0 = acc[ai][bj][m][0] + b0, v1 = acc[ai][bj][m][1] + b1;
                    *(f32x4*)(out + off + bj * HALF) = v0; *(f32x4*)(out + off + bj * HALF + 4) = v1;
                    ss += (v0[0] * v0[0] + v0[1] * v0[1]) + (v0[2] * v0[2] + v0[3] * v0[3]) + (v1[0] * v1[0] + v1[1] * v1[1]) + (v1[2] * v1[2] + v1[3] * v1[3]);
                    u32x4 w; w.x = cvt_pk_bf16(v0[0], v0[1]); w.y = cvt_pk_bf16(v0[2], v0[3]); w.z = cvt_pk_bf16(v1[0], v1[1]); w.w = cvt_pk_bf16(v1[2], v1[3]);
                    *(u32x4*)(xb + off + bj * HALF) = w; }
                ss += __shfl_xor(ss, 16); ss += __shfl_xor(ss, 32);
                if (fq == 0) part[(size_t)row * 16 + u.pn * 4 + wc] = ss;
                asm volatile("" ::: "memory"); }
    }
};
template <class Epi, class Sched, bool ALIGN_EPI = false, bool SP2 = false>
__device__ __forceinline__ void gemm_phase(PG8_LAS unsigned char* lds, const Gemm g, const Sched& S, const Epi& E) {
    int tid = threadIdx.x; asm volatile("" : "+v"(tid));
    const int wid = __builtin_amdgcn_readfirstlane(tid >> 6), lane = tid & 63, wr = wid >> 2, wc = wid & 3, fr = lane & 15, fq = lane >> 4;
    const int K = g.K, nt = K / BK;
    unsigned voffA[2], voffB[2];
#pragma unroll
    for (int i = 0; i < 2; ++i) { int R, C; stage_rc(tid * 16 + i * 8192, R, C); const int Rb = Epi::PERM ? ((R & ~31) + perm32(R & 31)) : R;
        voffA[i] = (unsigned)(R * K + C) * 2u; voffB[i] = (unsigned)(Rb * K + C) * 2u; }
    const size_t kstep = (size_t)(BK * 2);
    const size_t hstep = (size_t)HALF * K * 2;
    const size_t tstep = 2 * hstep;
    const unsigned ldsw = (unsigned)wid * 1024u;
    const int aoff = lds_byte(wr * 64 + fr, fq * 8), boff = lds_byte(wc * 32 + fr, fq * 8);
#define PG8_SA(b, h) (((b) * 2 + (h)) * HTB)
#define PG8_SB(b, h) ((4 + (b) * 2 + (h)) * HTB)
#define PG8_STAGE(bufoff, gbase, voff) do { _Pragma("unroll") for (int _i = 0; _i < 2; ++_i) \
        __builtin_amdgcn_global_load_lds((const unsigned*)((const char*)(gbase) + (voff)[_i]), (PG8_LAS unsigned*)(lds + (bufoff) + ldsw + _i * 8192), 16, 0, 0); } while (0)
#define PG8_LDA(dst, b, h) do { _Pragma("unroll") for (int m = 0; m < 4; ++m) _Pragma("unroll") for (int k = 0; k < 2; ++k) dst[m][k] = *(const PG8_LAS bf16x8*)(lds + PG8_SA(b, h) + aoff + m * 2048 + k * 1024); } while (0)
#define PG8_LDB(dst, b, h) do { _Pragma("unroll") for (int n = 0; n < 2; ++n) _Pragma("unroll") for (int k = 0; k < 2; ++k) dst[n][k] = *(const PG8_LAS bf16x8*)(lds + PG8_SB(b, h) + boff + n * 2048 + k * 1024); } while (0)
#define PG8_MMA(ai, bj, At, Bt) do { __builtin_amdgcn_s_setprio(1); _Pragma("unroll") for (int m = 0; m < 4; ++m) _Pragma("unroll") for (int n = 0; n < 2; ++n) _Pragma("unroll") for (int k = 0; k < 2; ++k) \
        acc[ai][bj][m][n] = __builtin_amdgcn_mfma_f32_16x16x32_bf16(Bt[n][k], At[m][k], acc[ai][bj][m][n], 0, 0, 0); __builtin_amdgcn_s_setprio(0); } while (0)
#define PG8_WAIT_V(n) asm volatile("s_waitcnt vmcnt(" #n ")" ::: "memory")
#define PG8_WAIT_L(n) asm volatile("s_waitcnt lgkmcnt(" #n ")" ::: "memory")
#define PG8_BAR __builtin_amdgcn_s_barrier()
#define PG8_SCHED __builtin_amdgcn_sched_barrier(0)
    Unit cur, nxt; int ui = 0;
    if (!S.next(0, cur)) return;
    f32x4 acc[2][2][4][2];
#pragma unroll
    for (int a = 0; a < 2; ++a)
#pragma unroll
        for (int b = 0; b < 2; ++b)
#pragma unroll
            for (int m = 0; m < 4; ++m)
#pragma unroll
                for (int n = 0; n < 2; ++n) acc[a][b][m][n] = (f32x4){0.f, 0.f, 0.f, 0.f};
    bf16x8 At[4][2], B0[2][2], B1[2][2];
    const char* cA = (const char*)g.A + (size_t)cur.pm * tstep; const char* cB = (const char*)g.Bt + (size_t)cur.pn * tstep;
    S.a_ready(cur);
    if constexpr (SP2) {
        PG8_STAGE(PG8_SB(0, 0), cB, voffB); PG8_STAGE(PG8_SB(0, 1), cB + hstep, voffB); PG8_STAGE(PG8_SA(0, 0), cA, voffA); PG8_STAGE(PG8_SA(0, 1), cA + hstep, voffA);
        if (wr == 1) PG8_BAR;
        PG8_WAIT_V(2); PG8_BAR;
        PG8_STAGE(PG8_SB(1, 0), cB + kstep, voffB); PG8_STAGE(PG8_SA(1, 0), cA + kstep, voffA); PG8_STAGE(PG8_SB(1, 1), cB + hstep + kstep, voffB);
        PG8_WAIT_V(6); PG8_BAR;
    } else {
        PG8_STAGE(PG8_SB(0, 0), cB, voffB); PG8_STAGE(PG8_SA(0, 0), cA, voffA); PG8_STAGE(PG8_SB(0, 1), cB + hstep, voffB); PG8_STAGE(PG8_SA(0, 1), cA + hstep, voffA);
        if (wr == 1) PG8_BAR;
        PG8_WAIT_V(4); PG8_BAR;
        PG8_STAGE(PG8_SB(1, 0), cB + kstep, voffB); PG8_STAGE(PG8_SA(1, 0), cA + kstep, voffA); PG8_STAGE(PG8_SB(1, 1), cB + hstep + kstep, voffB);
        PG8_WAIT_V(6); PG8_BAR;
    }
    for (;;) {
        const bool has_next = S.next(ui + 1, nxt);
        const char* nA = has_next ? (const char*)g.A + (size_t)nxt.pm * tstep : cA; const char* nB = has_next ? (const char*)g.Bt + (size_t)nxt.pn * tstep : cB;
        for (int t = 0; t < nt; t += 2) {
            const bool last = (t == nt - 2);
            const char* a1 = cA + (size_t)(t + 1) * kstep;
            const char* a2 = last ? nA : cA + (size_t)(t + 2) * kstep; const char* b2 = last ? nB : cB + (size_t)(t + 2) * kstep;
            const char* a3 = a2 + kstep; const char* b3 = b2 + kstep;
            if (last && has_next) S.a_ready(nxt);
            if constexpr (SP2) {
            PG8_LDB(B0, 0, 0); PG8_LDB(B1, 0, 1); PG8_SCHED; PG8_LDA(At, 0, 0); PG8_STAGE(PG8_SA(1, 1), a1 + hstep, voffA);
            PG8_WAIT_V(8); PG8_WAIT_L(0); PG8_BAR; PG8_MMA(0, 0, At, B0); PG8_MMA(0, 1, At, B1); PG8_BAR; PG8_SCHED;
            PG8_LDA(At, 0, 1); PG8_STAGE(PG8_SB(0, 0), b2, voffB); PG8_STAGE(PG8_SB(0, 1), b2 + hstep, voffB); PG8_STAGE(PG8_SA(0, 0), a2, voffA);
            PG8_WAIT_V(8); PG8_WAIT_L(0); PG8_BAR; PG8_MMA(1, 0, At, B0); PG8_MMA(1, 1, At, B1); PG8_BAR; PG8_SCHED;
            PG8_LDB(B0, 1, 0); PG8_LDB(B1, 1, 1); PG8_SCHED; PG8_LDA(At, 1, 0); PG8_STAGE(PG8_SA(0, 1), a2 + hstep, voffA);
            PG8_WAIT_V(8); PG8_WAIT_L(0); PG8_BAR; PG8_MMA(0, 0, At, B0); PG8_MMA(0, 1, At, B1); PG8_BAR; PG8_SCHED;
            PG8_LDA(At, 1, 1); PG8_STAGE(PG8_SB(1, 0), b3, voffB); PG8_STAGE(PG8_SB(1, 1), b3 + hstep, voffB); PG8_STAGE(PG8_SA(1, 0), a3, voffA);
            PG8_WAIT_V(8); PG8_WAIT_L(0); PG8_BAR; PG8_MMA(1, 0, At, B0); PG8_MMA(1, 1, At, B1); PG8_BAR; PG8_SCHED;
            } else {
            PG8_LDB(B0, 0, 0); PG8_SCHED; PG8_LDA(At, 0, 0); PG8_STAGE(PG8_SA(1, 1), a1 + hstep, voffA);
            PG8_WAIT_L(8); PG8_BAR; PG8_WAIT_L(0); PG8_MMA(0, 0, At, B0); PG8_BAR; PG8_SCHED;
            PG8_LDB(B1, 0, 1); PG8_STAGE(PG8_SB(0, 0), b2, voffB);
            PG8_BAR; PG8_WAIT_L(0); PG8_MMA(0, 1, At, B1); PG8_BAR;
            PG8_LDA(At, 0, 1); PG8_STAGE(PG8_SA(0, 0), a2, voffA);
            PG8_BAR; PG8_WAIT_L(0); PG8_MMA(1, 0, At, B0); PG8_BAR; PG8_SCHED;
            PG8_STAGE(PG8_SB(0, 1), b2 + hstep, voffB);
            PG8_WAIT_V(6); PG8_BAR; PG8_MMA(1, 1, At, B1); PG8_BAR;
            PG8_LDB(B0, 1, 0); PG8_SCHED; PG8_LDA(At, 1, 0); PG8_STAGE(PG8_SA(0, 1), a2 + hstep, voffA);
            PG8_WAIT_L(8); PG8_BAR; PG8_WAIT_L(0); PG8_MMA(0, 0, At, B0); PG8_BAR; PG8_SCHED;
            PG8_LDB(B1, 1, 1); PG8_STAGE(PG8_SB(1, 0), b3, voffB);
            PG8_BAR; PG8_WAIT_L(0); PG8_MMA(0, 1, At, B1); PG8_BAR;
            PG8_LDA(At, 1, 1); PG8_STAGE(PG8_SA(1, 0), a3, voffA);
            PG8_BAR; PG8_WAIT_L(0); PG8_MMA(1, 0, At, B0); PG8_BAR; PG8_SCHED;
            PG8_STAGE(PG8_SB(1, 1), b3 + hstep, voffB);
            PG8_WAIT_V(6); PG8_BAR; PG8_MMA(1, 1, At, B1); PG8_BAR;
            }
        }
        if constexpr (ALIGN_EPI) { if (wr == 0) PG8_BAR; }
        if constexpr (!Epi::AFTER_DRAIN) { E(acc, cur, wr, wc, fr, fq); S.done(cur); }
        if (!has_next) break;
#pragma unroll
        for (int a = 0; a < 2; ++a)
#pragma unroll
            for (int b = 0; b < 2; ++b)
#pragma unroll
                for (int m = 0; m < 4; ++m)
#pragma unroll
                    for (int n = 0; n < 2; ++n) acc[a][b][m][n] = (f32x4){0.f, 0.f, 0.f, 0.f};
        cur = nxt; cA = nA; cB = nB; ++ui;
        if constexpr (ALIGN_EPI) { if (wr == 1) PG8_BAR; }
    }
    PG8_WAIT_V(0);
    if constexpr (!ALIGN_EPI) { if (wr == 0) PG8_BAR; }
    PG8_BAR;
    if constexpr (Epi::AFTER_DRAIN) { E.fused(acc, cur, wr, wc, fr, fq, lds, wid, lane); S.done(cur); }
#undef PG8_SA
#undef PG8_SB
#undef PG8_STAGE
#undef PG8_LDA
#undef PG8_LDB
#undef PG8_MMA
#undef PG8_WAIT_V
#undef PG8_WAIT_L
#undef PG8_BAR
#undef PG8_SCHED
}
}
constexpr int S = 16384, DM = 1024, DEPTH = 4, NIN = 2816, DFF = 2816, NUP = 5632;
constexpr float EPS = 1e-6f;
constexpr int NWAVES = 8, NTHR = 512;
constexpr size_t MiB = 1u << 20;
constexpr size_t WS_WIN = 1 * MiB, WS_WOUT = 23 * MiB, WS_WUP = 31 * MiB, WS_WDN = 75 * MiB;
constexpr size_t WS_PART = 97 * MiB;
constexpr size_t WS_XB = 98 * MiB + 4096;
constexpr size_t WS_P = 131 * MiB;
constexpr size_t WS_Y = 219 * MiB;
constexpr size_t WS_GU = 131 * MiB;
constexpr size_t WS_A = 219 * MiB;
constexpr size_t WS_END = 307 * MiB;
constexpr int LDS_BYTES = 147456;
#define LAS __attribute__((address_space(3)))
typedef unsigned short bf16;
typedef unsigned v4u __attribute__((ext_vector_type(4)));
typedef unsigned v2u __attribute__((ext_vector_type(2)));
typedef float f32x4 __attribute__((ext_vector_type(4)));
typedef float f32x16 __attribute__((ext_vector_type(16)));
typedef short bf16x8 __attribute__((ext_vector_type(8)));
#define LDS_WAIT() asm volatile("s_waitcnt lgkmcnt(0)" ::: "memory")
__device__ __forceinline__ unsigned pk2(float lo, float hi) { return pg8::cvt_pk_bf16(lo, hi); }
__device__ __forceinline__ float bflo(unsigned u) { return __uint_as_float(u << 16); }
__device__ __forceinline__ float bfhi(unsigned u) { return __uint_as_float(u & 0xffff0000u); }
__device__ __forceinline__ float bf1(bf16 v) { return __uint_as_float((unsigned)v << 16); }
__device__ __forceinline__ float wave_sum(float v) {
#pragma unroll
    for (int o = 1; o < 64; o <<= 1) v += __shfl_xor(v, o);
    return v;
}

__device__ __forceinline__ void cvt_item(const float* W, int K, int N, bf16* WT, const float* gain, int mode, LAS float* scr, int item, int lane) {
    const int nblk = N / 32, kb = item / nblk, nb = item % nblk, k0 = 64 * kb, n0 = 32 * nb;
#pragma unroll 8
    for (int i = 0; i < 32; ++i) { const int kk = 2 * i + (lane >> 5); const float g = gain ? gain[k0 + kk] : 1.0f; scr[kk * 33 + (lane & 31)] = W[(size_t)(k0 + kk) * N + n0 + (lane & 31)] * g; }
    LDS_WAIT(); asm volatile("" ::: "memory");
    const float cs = (mode == 1 && n0 >= 1280 && n0 < 1792) ? 0.125f : 1.0f;
    int rb = n0;
    if (mode == 2) { rb = (n0 < DFF) ? 256 * (n0 / 128) + (n0 % 128) : 256 * ((n0 - DFF) / 128) + 128 + ((n0 - DFF) % 128); }
    const int c = lane & 7;
#pragma unroll
    for (int j = 0; j < 4; ++j) { const int n = (lane >> 3) + 8 * j; const LAS float* s = scr + (8 * c) * 33 + n;
        v4u o; o.x = pk2(s[0 * 33] * cs, s[1 * 33] * cs); o.y = pk2(s[2 * 33] * cs, s[3 * 33] * cs); o.z = pk2(s[4 * 33] * cs, s[5 * 33] * cs); o.w = pk2(s[6 * 33] * cs, s[7 * 33] * cs);
        *(v4u*)(WT + (size_t)(rb + n) * K + k0 + 8 * c) = o; }
    LDS_WAIT(); asm volatile("" ::: "memory");
}

struct Args { const float* in[14]; float* out; unsigned char* ws; };

__device__ __forceinline__ void norm_store_rows(const LAS float* tile, bf16* Y, int t0, int coff, int wave, int lane) {
#pragma unroll 2
    for (int i = 0; i < 8; ++i) { const int r = wave * 8 + i; const f32x4 v = *(const LAS f32x4*)(tile + r * 260 + lane * 4);
        const float ss = wave_sum((v[0] * v[0] + v[1] * v[1]) + (v[2] * v[2] + v[3] * v[3]));
        const float rs = __builtin_amdgcn_rsqf(ss * (1.0f / 256.0f) + EPS);
        v2u o; o.x = pk2(v[0] * rs, v[1] * rs); o.y = pk2(v[2] * rs, v[3] * rs);
        *(v2u*)(Y + (size_t)(t0 + r) * DM + coff + lane * 4) = o; }
}

__device__ __forceinline__ void mixer_unit(LAS unsigned char* lds, int unit, const bf16* P, bf16* Y, const float* conv_w, const float* sgu_norm, const float* sgu_w, const float* sgu_b, int tid, int wave, int lane) {
    const int t0 = unit * 64;
    asm volatile("" : "+v"(tid), "+v"(lane));
    LAS bf16* vnT = (LAS bf16*)lds;
    LAS float* tile = (LAS float*)(lds + 69632);
    LAS float* sm_ss = (LAS float*)(lds + 69632 + 66560);
    {
        const int h = wave, t = t0 + lane;
        float q[64], acc[64];
        { const v4u* qp = (const v4u*)(P + (size_t)t * NIN + 1280 + h * 64);
#pragma unroll
          for (int i = 0; i < 8; ++i) { const v4u u = qp[i]; q[8 * i + 0] = bflo(u.x); q[8 * i + 1] = bfhi(u.x); q[8 * i + 2] = bflo(u.y); q[8 * i + 3] = bfhi(u.y); q[8 * i + 4] = bflo(u.z); q[8 * i + 5] = bfhi(u.z); q[8 * i + 6] = bflo(u.w); q[8 * i + 7] = bfhi(u.w); } }
#pragma unroll
        for (int i = 0; i < 64; ++i) acc[i] = 0.f;
        float ls = 0.f;
        for (int j = 1;; ++j) {
            const int s = t - j; const bool act = (s >= 0) && (ls > -104.0f);
            if (__builtin_amdgcn_ballot_w64(act) == 0ull) break;
            const int sc = s < 0 ? 0 : s;
            const v4u* kp = (const v4u*)(P + (size_t)sc * NIN + 1792 + h * 64);
            float z0 = 0.f, z1 = 0.f;
#pragma unroll
            for (int i = 0; i < 8; ++i) { const v4u u = kp[i];
                z0 += q[8 * i + 0] * bflo(u.x); z1 += q[8 * i + 1] * bfhi(u.x); z0 += q[8 * i + 2] * bflo(u.y); z1 += q[8 * i + 3] * bfhi(u.y);
                z0 += q[8 * i + 4] * bflo(u.z); z1 += q[8 * i + 5] * bfhi(u.z); z0 += q[8 * i + 6] * bflo(u.w); z1 += q[8 * i + 7] * bfhi(u.w); }
            const float z = z0 + z1;
            const float e = __expf(-fabsf(z)); const float lsig = fminf(z, 0.f) - __logf(1.0f + e);
            const float w = act ? __expf(lsig + ls) : 0.f;
            ls += act ? (lsig - z) : 0.f;
            const v4u* vp = (const v4u*)(P + (size_t)sc * NIN + 2304 + h * 64);
#pragma unroll
            for (int i = 0; i < 8; ++i) { const v4u u = vp[i];
                acc[8 * i + 0] += w * bflo(u.x); acc[8 * i + 1] += w * bfhi(u.x); acc[8 * i + 2] += w * bflo(u.y); acc[8 * i + 3] += w * bfhi(u.y);
                acc[8 * i + 4] += w * bflo(u.z); acc[8 * i + 5] += w * bfhi(u.z); acc[8 * i + 6] += w * bflo(u.w); acc[8 * i + 7] += w * bfhi(u.w); }
        }
        float ss = 0.f;
#pragma unroll
        for (int i = 0; i < 64; ++i) ss += acc[i] * acc[i];
        sm_ss[lane * 8 + h] = ss;
        LDS_WAIT(); __syncthreads();
        float tot = 0.f;
#pragma unroll
        for (int i = 0; i < 8; ++i) tot += sm_ss[lane * 8 + i];
        const float rs = __builtin_amdgcn_rsqf(tot * (1.0f / 512.0f) + EPS);
        v4u* yp = (v4u*)(Y + (size_t)t * DM + 512 + h * 64);
#pragma unroll
        for (int i = 0; i < 8; ++i) { v4u o; o.x = pk2(acc[8 * i + 0] * rs, acc[8 * i + 1] * rs); o.y = pk2(acc[8 * i + 2] * rs, acc[8 * i + 3] * rs); o.z = pk2(acc[8 * i + 4] * rs, acc[8 * i + 5] * rs); o.w = pk2(acc[8 * i + 6] * rs, acc[8 * i + 7] * rs); yp[i] = o; }
    }
    {
        const int c = tid & 255, rh = tid >> 8, tb = t0 + 32 * rh;
        const float w0 = conv_w[c], w1 = conv_w[256 + c], w2 = conv_w[512 + c];
        float p2 = 0.f, p1 = 0.f;
        if (tb >= 2) { const bf16* r2 = P + (size_t)(tb - 2) * NIN; const bf16* r1 = P + (size_t)(tb - 1) * NIN; p2 = bf1(r2[256 + c]) * bf1(r2[512 + c]); p1 = bf1(r1[256 + c]) * bf1(r1[512 + c]); }
#pragma unroll 4
        for (int r = 0; r < 32; ++r) { const bf16* rp = P + (size_t)(tb + r) * NIN; const float p0 = bf1(rp[256 + c]) * bf1(rp[512 + c]);
            tile[(32 * rh + r) * 260 + c] = bf1(rp[c]) * (w0 * p2 + w1 * p1 + w2 * p0); p2 = p1; p1 = p0; }
    }
    LDS_WAIT(); __syncthreads();
    norm_store_rows(tile, Y, t0, 0, wave, lane);
    const int tc = t0 & ~127, dt = t0 - tc, ns = dt + 64;
    for (int s = wave; s < ns; s += 8) { const v2u u = *(const v2u*)(P + (size_t)(tc + s) * NIN + 1024 + lane * 4);
        const float v0 = bflo(u.x), v1 = bfhi(u.x), v2 = bflo(u.y), v3 = bfhi(u.y);
        const float ss = wave_sum((v0 * v0 + v1 * v1) + (v2 * v2 + v3 * v3)); const float rs = __builtin_amdgcn_rsqf(ss * (1.0f / 256.0f) + EPS);
        const f32x4 g = *(const f32x4*)(sgu_norm + lane * 4);
        const unsigned a = pk2(v0 * rs * g[0], v1 * rs * g[1]), b = pk2(v2 * rs * g[2], v3 * rs * g[3]);
        vnT[(lane * 4 + 0) * 136 + s] = (bf16)(a & 0xffffu); vnT[(lane * 4 + 1) * 136 + s] = (bf16)(a >> 16); vnT[(lane * 4 + 2) * 136 + s] = (bf16)(b & 0xffffu); vnT[(lane * 4 + 3) * 136 + s] = (bf16)(b >> 16); }
    LDS_WAIT(); __syncthreads();
    {
        const int h = wave >> 1, rh = wave & 1, r32 = lane & 31, hi = lane >> 5;
        const int tcl = dt + 32 * rh + r32;
        const float* wrow = sgu_w + ((size_t)h * 128 + tcl) * 128;
        f32x16 o0 = {}, o1 = {};
        const int nk = (dt + 32 * rh + 32) >> 4;
        for (int ks = 0; ks < nk; ++ks) { const int s0 = ks * 16 + 8 * hi;
            const f32x4 wa = *(const f32x4*)(wrow + s0), wb = *(const f32x4*)(wrow + s0 + 4);
            float wv[8] = {wa[0], wa[1], wa[2], wa[3], wb[0], wb[1], wb[2], wb[3]};
#pragma unroll
            for (int i = 0; i < 8; ++i) wv[i] = (s0 + i <= tcl) ? wv[i] : 0.f;
            v4u ap; ap.x = pk2(wv[0], wv[1]); ap.y = pk2(wv[2], wv[3]); ap.z = pk2(wv[4], wv[5]); ap.w = pk2(wv[6], wv[7]);
            const bf16x8 af = __builtin_bit_cast(bf16x8, ap);
            const bf16x8 b0 = *(const LAS bf16x8*)(vnT + (h * 64 + r32) * 136 + s0), b1 = *(const LAS bf16x8*)(vnT + (h * 64 + 32 + r32) * 136 + s0);
            o0 = __builtin_amdgcn_mfma_f32_32x32x16_bf16(af, b0, o0, 0, 0, 0);
            o1 = __builtin_amdgcn_mfma_f32_32x32x16_bf16(af, b1, o1, 0, 0, 0); }
#pragma unroll
        for (int j = 0; j < 16; ++j) { const int rl = 32 * rh + (j & 3) + 8 * (j >> 2) + 4 * hi;
            const float bb = sgu_b[h * 128 + dt + rl]; const bf16* up = P + (size_t)(t0 + rl) * NIN + 768 + h * 64;
            tile[rl * 260 + h * 64 + r32] = bf1(up[r32]) * (o0[j] + bb);
            tile[rl * 260 + h * 64 + 32 + r32] = bf1(up[32 + r32]) * (o1[j] + bb); }
    }
    LDS_WAIT(); __syncthreads();
    norm_store_rows(tile, Y, t0, 256, wave, lane);
    LDS_WAIT(); __syncthreads();
}

__device__ __forceinline__ void ffn_gate_phase(const bf16* GU, bf16* A, const float* fconv, int hf, int gtid, int gthreads) {
    for (int it = gtid; it < 256 * 176; it += gthreads) { const int rb = it / 176, cgp = it % 176, pnl = cgp >> 4, cc = (cgp & 15) * 8, ch = 1408 * hf + 128 * pnl + cc;
        float wg[3][8], wu[3][8];
#pragma unroll
        for (int i = 0; i < 3; ++i) { const f32x4 a0 = *(const f32x4*)(fconv + (size_t)i * NUP + ch), a1 = *(const f32x4*)(fconv + (size_t)i * NUP + ch + 4), b0 = *(const f32x4*)(fconv + (size_t)i * NUP + DFF + ch), b1 = *(const f32x4*)(fconv + (size_t)i * NUP + DFF + ch + 4);
#pragma unroll
            for (int e = 0; e < 4; ++e) { wg[i][e] = a0[e]; wg[i][4 + e] = a1[e]; wu[i][e] = b0[e]; wu[i][4 + e] = b1[e]; } }
        float g2[8], g1[8], u2[8], u1[8];
#pragma unroll
        for (int e = 0; e < 8; ++e) { g2[e] = g1[e] = u2[e] = u1[e] = 0.f; }
        for (int r = -2; r < 64; ++r) { const int t = 64 * rb + r; float g0[8], u0[8];
            if (t >= 0) { const v4u gv = *(const v4u*)(GU + (size_t)t * NIN + 256 * pnl + cc), uv = *(const v4u*)(GU + (size_t)t * NIN + 256 * pnl + 128 + cc);
                g0[0] = bflo(gv.x); g0[1] = bfhi(gv.x); g0[2] = bflo(gv.y); g0[3] = bfhi(gv.y); g0[4] = bflo(gv.z); g0[5] = bfhi(gv.z); g0[6] = bflo(gv.w); g0[7] = bfhi(gv.w);
                u0[0] = bflo(uv.x); u0[1] = bfhi(uv.x); u0[2] = bflo(uv.y); u0[3] = bfhi(uv.y); u0[4] = bflo(uv.z); u0[5] = bfhi(uv.z); u0[6] = bflo(uv.w); u0[7] = bfhi(uv.w); }
            else {
#pragma unroll
                for (int e = 0; e < 8; ++e) { g0[e] = 0.f; u0[e] = 0.f; } }
            if (r >= 0) { float o[8];
#pragma unroll
                for (int e = 0; e < 8; ++e) { const float G = wg[0][e] * g2[e] + wg[1][e] * g1[e] + wg[2][e] * g0[e], U = wu[0][e] * u2[e] + wu[1][e] * u1[e] + wu[2][e] * u0[e];
                    o[e] = G * __builtin_amdgcn_rcpf(1.0f + __expf(-G)) * U; }
                v4u ov; ov.x = pk2(o[0], o[1]); ov.y = pk2(o[2], o[3]); ov.z = pk2(o[4], o[5]); ov.w = pk2(o[6], o[7]);
                *(v4u*)(A + (size_t)t * DFF + ch) = ov; }
#pragma unroll
            for (int e = 0; e < 8; ++e) { g2[e] = g1[e]; g1[e] = g0[e]; u2[e] = u1[e]; u1[e] = u0[e]; } }
    }
}
__global__ void __launch_bounds__(NTHR, 2) hybrid_fwd(Args args) {
    extern __shared__ __attribute__((aligned(16))) unsigned char lds_raw[];
    LAS unsigned char* lds = (LAS unsigned char*)lds_raw;
    cg::grid_group grid = cg::this_grid();
    const int tid = threadIdx.x, lane = tid & 63, wave = __builtin_amdgcn_readfirstlane(tid >> 6);
    const int G = gridDim.x, bx = blockIdx.x;
    const int gw = bx * NWAVES + wave, NGW = G * NWAVES;
    unsigned char* ws = args.ws;
    const float* x_in = args.in[0]; const float* norm_mix = args.in[1]; const float* w_in = args.in[2]; const float* conv_w = args.in[3];
    const float* sgu_norm = args.in[4]; const float* sgu_w = args.in[5]; const float* sgu_b = args.in[6]; const float* out_norm = args.in[7];
    const float* w_out = args.in[8]; const float* norm_ffn = args.in[9]; const float* w_up = args.in[10]; const float* ffn_conv = args.in[11];
    const float* w_down = args.in[12]; const float* norm_final = args.in[13];
    float* xcur = args.out;
    bf16* Win_t = (bf16*)(ws + WS_WIN); bf16* Wout_t = (bf16*)(ws + WS_WOUT); bf16* Wup_t = (bf16*)(ws + WS_WUP); bf16* Wdn_t = (bf16*)(ws + WS_WDN);
    float* part = (float*)(ws + WS_PART); bf16* XB = (bf16*)(ws + WS_XB); bf16* P = (bf16*)(ws + WS_P); bf16* Y = (bf16*)(ws + WS_Y);
    bf16* GU = (bf16*)(ws + WS_GU); bf16* A = (bf16*)(ws + WS_A);

    {
        LAS float* scr = (LAS float*)(lds + wave * 16384);
        constexpr int I_IN = 16 * 88, I_OUT = 16 * 32, I_UP = 16 * 176, I_DN = 44 * 32, I_L = I_IN + I_OUT + I_UP + I_DN;
        for (int it = gw; it < DEPTH * I_L; it += NGW) { const int l = it / I_L; int r = it % I_L;
            if (r < I_IN) { cvt_item(w_in + (size_t)l * DM * NIN, DM, NIN, Win_t + (size_t)l * NIN * DM, norm_mix + l * DM, 1, scr, r, lane); continue; } r -= I_IN;
            if (r < I_OUT) { cvt_item(w_out + (size_t)l * DM * DM, DM, DM, Wout_t + (size_t)l * DM * DM, out_norm + l * DM, 0, scr, r, lane); continue; } r -= I_OUT;
            if (r < I_UP) { cvt_item(w_up + (size_t)l * DM * NUP, DM, NUP, Wup_t + (size_t)l * NUP * DM, norm_ffn + l * DM, 2, scr, r, lane); continue; } r -= I_UP;
            cvt_item(w_down + (size_t)l * DFF * DM, DFF, DM, Wdn_t + (size_t)l * DM * DFF, nullptr, 0, scr, r, lane); }
        for (int m = gw; m < S; m += NGW) { const f32x4* xr = (const f32x4*)(x_in + (size_t)m * DM) + lane; f32x4 v[4]; float ss = 0.f;
#pragma unroll
            for (int j = 0; j < 4; ++j) { v[j] = xr[64 * j]; ss += (v[j][0] * v[j][0] + v[j][1] * v[j][1]) + (v[j][2] * v[j][2] + v[j][3] * v[j][3]); }
            ss = wave_sum(ss);
            v2u* o8 = (v2u*)(XB + (size_t)m * DM) + lane;
#pragma unroll
            for (int j = 0; j < 4; ++j) { v2u o; o.x = pk2(v[j][0], v[j][1]); o.y = pk2(v[j][2], v[j][3]); o8[64 * j] = o; }
            if (lane < 16) part[(size_t)m * 16 + lane] = lane == 0 ? ss : 0.f; }
    }
    grid.sync();

    for (int l = 0; l < DEPTH; ++l) {
        { pg8::Gemm g{XB, Win_t + (size_t)l * NIN * DM, S, NIN, DM}; pg8::StaticOrder So; So.init(S, NIN, G, bx);
          pg8::EpiScaleBf16 E{P, NIN, part};
          pg8::gemm_phase<pg8::EpiScaleBf16, pg8::StaticOrder, true, true>(lds, g, So, E); }
        grid.sync();
        for (int u = bx; u < S / 64; u += G)
            mixer_unit(lds, u, P, Y, conv_w + l * 3 * 256, sgu_norm + l * 256, sgu_w + (size_t)l * 4 * 128 * 128, sgu_b + l * 4 * 128, tid, wave, lane);
        grid.sync();
        { pg8::Gemm g{Y, Wout_t + (size_t)l * DM * DM, S, DM, DM}; pg8::StaticOrder So; So.init(S, DM, G, bx);
          pg8::EpiResid E{l == 0 ? x_in : xcur, xcur, XB, part};
          pg8::gemm_phase<pg8::EpiResid, pg8::StaticOrder, true, true>(lds, g, So, E); }
        grid.sync();
        for (int hf = 0; hf < 2; ++hf) {
            { pg8::Gemm g{XB, Wup_t + (size_t)l * NUP * DM + (size_t)hf * NIN * DM, S, NIN, DM}; pg8::StaticOrder So; So.init(S, NIN, G, bx);
              pg8::EpiScaleBf16 E{GU, NIN, part};
              pg8::gemm_phase<pg8::EpiScaleBf16, pg8::StaticOrder, true, true>(lds, g, So, E); }
            grid.sync();
            ffn_gate_phase(GU, A, ffn_conv + (size_t)l * 3 * NUP, hf, bx * NTHR + tid, G * NTHR);
            grid.sync();
        }
        { pg8::Gemm g{A, Wdn_t + (size_t)l * DM * DFF, S, DM, DFF}; pg8::StaticOrder So; So.init(S, DM, G, bx);
          pg8::EpiResid E{xcur, xcur, XB, part};
          pg8::gemm_phase<pg8::EpiResid, pg8::StaticOrder, true, true>(lds, g, So, E); }
        grid.sync();
    }
    for (int m = gw; m < S; m += NGW) { f32x4* xr = (f32x4*)(xcur + (size_t)m * DM) + lane; f32x4 v[4]; float ss = 0.f;
#pragma unroll
        for (int j = 0; j < 4; ++j) { v[j] = xr[64 * j]; ss += (v[j][0] * v[j][0] + v[j][1] * v[j][1]) + (v[j][2] * v[j][2] + v[j][3] * v[j][3]); }
        const float rs = __builtin_amdgcn_rsqf(wave_sum(ss) * (1.0f / 1024.0f) + EPS);
#pragma unroll
        for (int j = 0; j < 4; ++j) { const f32x4 g = *((const f32x4*)norm_final + lane + 64 * j); xr[64 * j] = v[j] * rs * g; } }
}

extern "C" void kernel_launch(void* const* d_in, const int* in_sizes, int n_in, void* d_out, int out_size, void* d_ws, size_t ws_size, hipStream_t stream) {
    static int grid = 0;
    if (grid == 0) {
        if (n_in != 14 || out_size != S * DM || ws_size < WS_END) { fprintf(stderr, "kernel_launch: unexpected shapes / workspace (%d inputs, out %d, ws %zu)\n", n_in, out_size, ws_size); grid = -1; return; }
        int dev = 0, cus = 0, per_cu = 0;
        hipGetDevice(&dev); hipDeviceGetAttribute(&cus, hipDeviceAttributeMultiprocessorCount, dev);
        hipFuncSetAttribute((const void*)hybrid_fwd, hipFuncAttributeMaxDynamicSharedMemorySize, LDS_BYTES);
        hipOccupancyMaxActiveBlocksPerMultiprocessor(&per_cu, (const void*)hybrid_fwd, NTHR, LDS_BYTES);
        (void)hipGetLastError();
        if (per_cu < 1) per_cu = 1;
        grid = cus * 1;
    }
    if (grid < 0) return;
    hipMemsetAsync((unsigned char*)d_ws + WS_XB - 4096, 0, 4096, stream);
    Args a{};
    for (int i = 0; i < 14; ++i) a.in[i] = (const float*)d_in[i];
    a.out = (float*)d_out; a.ws = (unsigned char*)d_ws;
    void* kargs[] = {&a};
    hipError_t e = hipLaunchCooperativeKernel((const void*)hybrid_fwd, dim3(grid), dim3(NTHR), kargs, LDS_BYTES, stream);
    if (e != hipSuccess) fprintf(stderr, "cooperative launch failed: %s (grid %d)\n", hipGetErrorString(e), grid);
}
```

```cpp
#include <hip/hip_runtime.h>
#include <hip/hip_cooperative_groups.h>
#include <cstdio>
#include <cstdint>
namespace cg = cooperative_groups;
namespace pg8 {
#define PG8_LAS __attribute__((address_space(3)))
typedef unsigned short bf16_t;
typedef short bf16x8 __attribute__((ext_vector_type(8)));
typedef float f32x4 __attribute__((ext_vector_type(4)));
typedef unsigned u32x4 __attribute__((ext_vector_type(4)));
typedef unsigned u32x2 __attribute__((ext_vector_type(2)));
constexpr int BM = 256, BK = 64, HALF = 128, HTB = HALF * BK * 2  , STAGE_BYTES = 8 * HTB, NXCD = 8, WGM = 8;

__host__ __device__ __forceinline__ int lds_byte(int r, int c) { const int st = (r >> 4) * 2 + (c >> 5), rr = r & 15, cc = c & 31, ob = rr * 64 + cc * 2; return st * 1024 + (ob ^ (((ob >> 9) & 1) << 5)); }
__host__ __device__ __forceinline__ void stage_rc(int b, int& R, int& C) { const int st = b / 1024, sb = b % 1024, swz = sb ^ (((sb >> 9) & 1) << 5); R = (st >> 1) * 16 + swz / 64; C = (st & 1) * 32 + (swz % 64) / 2; }
__host__ __device__ __forceinline__ int perm32(int rho) { const int n = rho >> 4, i = rho & 15; return 8 * (i >> 2) + 4 * n + (i & 3); }

struct Unit { int pm, pn; };
struct Gemm { const bf16_t* A; const bf16_t* Bt; int M, N, K; int arows; };

struct StaticOrder {
    int nM, nN, nwg, G, c;
    __host__ __device__ void init(int M, int N, int G_, int c_) { nM = M / BM; nN = N / BM; nwg = nM * nN; G = G_; c = c_; }
    __host__ __device__ bool next(int i, Unit& u) const {
        const long L = (long)i * G + c; if (L >= nwg) return false;
        int wgid = (int)L; { const int q = nwg / NXCD, r = nwg % NXCD, xcd = wgid % NXCD, off = wgid / NXCD; wgid = (xcd < r ? xcd * (q + 1) : r * (q + 1) + (xcd - r) * q) + off; }
        const int nig = WGM * nN, gid = wgid / nig, fm = gid * WGM, gsz = (nM - fm) < WGM ? (nM - fm) : WGM;
        u.pm = fm + ((wgid % nig) % gsz); u.pn = (wgid % nig) / gsz; return true;
    }
    __device__ __forceinline__ void a_ready(const Unit&) const {}
    __device__ __forceinline__ void done(const Unit&) const {}
};

__device__ __forceinline__ unsigned cvt_pk_bf16(float lo, float hi) { unsigned r; asm volatile("v_cvt_pk_bf16_f32 %0, %1, %2" : "=v"(r) : "v"(lo), "v"(hi)); return r; }
struct EpiScaleBf16 {
    static constexpr bool PERM = true, AFTER_DRAIN = false;
    bf16_t* O; int ldc; const float* part;
    __device__ __forceinline__ void operator()(const f32x4 (&acc)[2][2][4][2], const Unit& u, int wr, int wc, int fr, int fq) const {
        const int row0 = u.pm * BM + wr * 64 + fr; const int col0 = u.pn * BM + wc * 32 + 8 * fq;
#pragma unroll
        for (int ai = 0; ai < 2; ++ai)
#pragma unroll
            for (int m = 0; m < 4; ++m) { const int row = row0 + ai * HALF + m * 16;
                const f32x4* pp = (const f32x4*)(part + (size_t)row * 16); const f32x4 a = pp[0], b = pp[1], c = pp[2], d = pp[3];
                const f32x4 s4 = (a + b) + (c + d); const float ss = (s4[0] + s4[1]) + (s4[2] + s4[3]);
                const float rs = __builtin_amdgcn_rsqf(ss * (1.0f / 1024.0f) + 1e-6f);
                bf16_t* rowp = O + (size_t)row * ldc + col0;
#pragma unroll
                for (int bj = 0; bj < 2; ++bj) { const f32x4 v0 = acc[ai][bj][m][0] * rs, v1 = acc[ai][bj][m][1] * rs;
                    u32x4 w; w.x = cvt_pk_bf16(v0[0], v0[1]); w.y = cvt_pk_bf16(v0[2], v0[3]); w.z = cvt_pk_bf16(v1[0], v1[1]); w.w = cvt_pk_bf16(v1[2], v1[3]);
                    *(u32x4*)(rowp + bj * HALF) = w; }
                if (m & 1) asm volatile("" ::: "memory"); }
    }
};
struct EpiResid {
    static constexpr bool PERM = true, AFTER_DRAIN = false;
    const float* base; float* out; bf16_t* xb; float* part;
    __device__ __forceinline__ void operator()(const f32x4 (&acc)[2][2][4][2], const Unit& u, int wr, int wc, int fr, int fq) const {
        const int row0 = u.pm * BM + wr * 64 + fr; const int col0 = u.pn * BM + wc * 32 + 8 * fq;
#pragma unroll
        for (int ai = 0; ai < 2; ++ai)
#pragma unroll
            for (int m = 0; m < 4; ++m) { const int row = row0 + ai * HALF + m * 16; const size_t off = (size_t)row * 1024 + col0; float ss = 0.f;
#pragma unroll
                for (int bj = 0; bj < 2; ++bj) { const f32x4 b0 = *(const f32x4*)(base + off + bj * HALF), b1 = *(const f32x4*)(base + off + bj * HALF + 4);
                    const f32x4 v0 = acc[ai][bj][m][0] + b0, v1 = acc[ai][bj][m][1] + b1;
                    *(f32x4*)(out + off + bj * HALF) = v0; *(f32x4*)(out + off + bj * HALF + 4) = v1;
                    ss += (v0[0] * v0[0] + v0[1] * v0[1]) + (v0[2] * v0[2] + v0[3] * v0[3]) + (v1[0] * v1[0] + v1[1] * v1[1]) + (v1[2] * v1[2] + v1[3] * v1[3]);
                    u32x4 w; w.x = cvt_pk_bf16(v0[0], v0[1]); w.y = cvt_pk_bf16(v0[2], v0[3]); w.z = cvt_pk_bf16(v1[0], v1[1]); w.w = cvt_pk_bf16(v1[2], v1[3]);
                    *(u32x4*)(xb + off + bj * HALF) = w; }
                ss += __shfl_xor(ss, 16); ss += __shfl_xor(ss, 32);
                if (fq == 0) part[(size_t)row * 16 + u.pn * 4 + wc] = ss;
                asm volatile("" ::: "memory"); }
    }
};
#define PG8_DPP(oldv, srcv, ctrl) __builtin_bit_cast(float, __builtin_amdgcn_update_dpp(__builtin_bit_cast(int, (float)(oldv)), __builtin_bit_cast(int, (float)(srcv)), (ctrl), 0xf, 0xf, false))
struct EpiGate {
    static constexpr bool PERM = true, AFTER_DRAIN = false;
    bf16_t* Aout; const float* part; const float* fconv; PG8_LAS float* xch;
    __device__ __forceinline__ void operator()(f32x4 (&acc)[2][2][4][2], const Unit& u, int wr, int wc, int fr, int fq) const {
        const int rbase = u.pm * 254 - 2 + wr * 64 + fr;
        const int ccol = wc * 32 + 8 * fq;
#pragma unroll
        for (int ai = 0; ai < 2; ++ai)
#pragma unroll
            for (int m = 0; m < 4; ++m) { const int row = rbase + ai * HALF + m * 16; const bool ok = row >= 0 && row < 16384; const int rc = ok ? row : 0;
                const f32x4* pp = (const f32x4*)(part + (size_t)rc * 16); const f32x4 a = pp[0], b = pp[1], c = pp[2], d = pp[3];
                const f32x4 s4 = (a + b) + (c + d); const float ss = (s4[0] + s4[1]) + (s4[2] + s4[3]);
                const float rs = ok ? __builtin_amdgcn_rsqf(ss * (1.0f / 1024.0f) + 1e-6f) : 0.f;
#pragma unroll
                for (int bj = 0; bj < 2; ++bj) { acc[ai][bj][m][0] *= rs; acc[ai][bj][m][1] *= rs; }
                asm volatile("" : "+v"(acc[ai][0][m][0]), "+v"(acc[ai][0][m][1]), "+v"(acc[ai][1][m][0]), "+v"(acc[ai][1][m][1]) :: "memory"); }
        if (fr >= 14) {
#pragma unroll
            for (int ai = 0; ai < 2; ++ai)
#pragma unroll
                for (int bj = 0; bj < 2; ++bj)
#pragma unroll
                    for (int n = 0; n < 2; ++n) *(PG8_LAS f32x4*)(xch + ((2 * ai + wr) * 2 + (fr & 1)) * 256 + bj * HALF + ccol + 4 * n) = acc[ai][bj][3][n];
        }
        asm volatile("s_waitcnt lgkmcnt(0)" ::: "memory"); __builtin_amdgcn_s_barrier(); asm volatile("" ::: "memory");
        const int ch0 = u.pn * HALF + ccol;
#pragma unroll
        for (int ai = 0; ai < 2; ++ai) {
            const int grp = 2 * ai + wr;
#pragma unroll
            for (int n = 0; n < 2; ++n) {
                asm volatile("" ::: "memory");
                const float* fw = fconv + ch0 + 4 * n;
                const f32x4 wg0 = *(const f32x4*)(fw), wg1 = *(const f32x4*)(fw + 5632), wg2 = *(const f32x4*)(fw + 2 * 5632);
                const f32x4 wu0 = *(const f32x4*)(fw + 2816), wu1 = *(const f32x4*)(fw + 5632 + 2816), wu2 = *(const f32x4*)(fw + 2 * 5632 + 2816);
                f32x4 xpg = {0.f, 0.f, 0.f, 0.f}, xpu = {0.f, 0.f, 0.f, 0.f};
                if (grp > 0) { xpg = *(const PG8_LAS f32x4*)(xch + ((grp - 1) * 2 + (fr & 1)) * 256 + ccol + 4 * n); xpu = *(const PG8_LAS f32x4*)(xch + ((grp - 1) * 2 + (fr & 1)) * 256 + HALF + ccol + 4 * n); }
#pragma unroll
                for (int m = 0; m < 4; ++m) {
                    float o[4];
#pragma unroll
                    for (int j = 0; j < 4; ++j) {
                        const float xg = acc[ai][0][m][n][j], xu = acc[ai][1][m][n][j];
                        const float pg = m > 0 ? acc[ai][0][m > 0 ? m - 1 : 0][n][j] : xpg[j], pu = m > 0 ? acc[ai][1][m > 0 ? m - 1 : 0][n][j] : xpu[j];
                        const float g1 = PG8_DPP(PG8_DPP(0.f, pg, 0x121), xg, 0x111), g2 = PG8_DPP(PG8_DPP(0.f, pg, 0x122), xg, 0x112);
                        const float u1 = PG8_DPP(PG8_DPP(0.f, pu, 0x121), xu, 0x111), u2 = PG8_DPP(PG8_DPP(0.f, pu, 0x122), xu, 0x112);
                        const float Gv = wg0[j] * g2 + wg1[j] * g1 + wg2[j] * xg, Uv = wu0[j] * u2 + wu1[j] * u1 + wu2[j] * xu;
                        o[j] = Gv * __builtin_amdgcn_rcpf(1.0f + __expf(-Gv)) * Uv; }
                    const int r = ai * HALF + wr * 64 + m * 16 + fr, row = u.pm * 254 - 2 + r;
                    u32x2 w; w.x = cvt_pk_bf16(o[0], o[1]); w.y = cvt_pk_bf16(o[2], o[3]);
                    if (r >= 2 && row < 16384) *(u32x2*)(Aout + (size_t)row * 2816 + ch0 + 4 * n) = w; }
            }
        }
    }
};
template <class Epi, class Sched, bool ALIGN_EPI = false, bool SP2 = false>
__device__ __forceinline__ void gemm_phase(PG8_LAS unsigned char* lds, const Gemm g, const Sched& S, const Epi& E) {
    int tid = threadIdx.x; asm volatile("" : "+v"(tid));
    const int wid = __builtin_amdgcn_readfirstlane(tid >> 6), lane = tid & 63, wr = wid >> 2, wc = wid & 3, fr = lane & 15, fq = lane >> 4;
    const int K = g.K, nt = K / BK;
    unsigned voffA[2], voffB[2];
#pragma unroll
    for (int i = 0; i < 2; ++i) { int R, C; stage_rc(tid * 16 + i * 8192, R, C); const int Rb = Epi::PERM ? ((R & ~31) + perm32(R & 31)) : R;
        voffA[i] = (unsigned)(R * K + C) * 2u; voffB[i] = (unsigned)(Rb * K + C) * 2u; }
    const size_t kstep = (size_t)(BK * 2);
    const size_t hstep = (size_t)HALF * K * 2;
    const size_t tstep = 2 * hstep;
    const size_t tstepA = (size_t)g.arows * K * 2;
    const unsigned ldsw = (unsigned)wid * 1024u;
    const int aoff = lds_byte(wr * 64 + fr, fq * 8), boff = lds_byte(wc * 32 + fr, fq * 8);
#define PG8_SA(b, h) (((b) * 2 + (h)) * HTB)
#define PG8_SB(b, h) ((4 + (b) * 2 + (h)) * HTB)
#define PG8_STAGE(bufoff, gbase, voff) do { _Pragma("unroll") for (int _i = 0; _i < 2; ++_i) \
        __builtin_amdgcn_global_load_lds((const unsigned*)((const char*)(gbase) + (voff)[_i]), (PG8_LAS unsigned*)(lds + (bufoff) + ldsw + _i * 8192), 16, 0, 0); } while (0)
#define PG8_LDA(dst, b, h) do { _Pragma("unroll") for (int m = 0; m < 4; ++m) _Pragma("unroll") for (int k = 0; k < 2; ++k) dst[m][k] = *(const PG8_LAS bf16x8*)(lds + PG8_SA(b, h) + aoff + m * 2048 + k * 1024); } while (0)
#define PG8_LDB(dst, b, h) do { _Pragma("unroll") for (int n = 0; n < 2; ++n) _Pragma("unroll") for (int k = 0; k < 2; ++k) dst[n][k] = *(const PG8_LAS bf16x8*)(lds + PG8_SB(b, h) + boff + n * 2048 + k * 1024); } while (0)
#define PG8_MMA(ai, bj, At, Bt) do { __builtin_amdgcn_s_setprio(1); _Pragma("unroll") for (int m = 0; m < 4; ++m) _Pragma("unroll") for (int n = 0; n < 2; ++n) _Pragma("unroll") for (int k = 0; k < 2; ++k) \
        acc[ai][bj][m][n] = __builtin_amdgcn_mfma_f32_16x16x32_bf16(Bt[n][k], At[m][k], acc[ai][bj][m][n], 0, 0, 0); __builtin_amdgcn_s_setprio(0); } while (0)
#define PG8_WAIT_V(n) asm volatile("s_waitcnt vmcnt(" #n ")" ::: "memory")
#define PG8_WAIT_L(n) asm volatile("s_waitcnt lgkmcnt(" #n ")" ::: "memory")
#define PG8_BAR __builtin_amdgcn_s_barrier()
#define PG8_SCHED __builtin_amdgcn_sched_barrier(0)
    Unit cur, nxt; int ui = 0;
    if (!S.next(0, cur)) return;
    f32x4 acc[2][2][4][2];
#pragma unroll
    for (int a = 0; a < 2; ++a)
#pragma unroll
        for (int b = 0; b < 2; ++b)
#pragma unroll
            for (int m = 0; m < 4; ++m)
#pragma unroll
                for (int n = 0; n < 2; ++n) acc[a][b][m][n] = (f32x4){0.f, 0.f, 0.f, 0.f};
    bf16x8 At[4][2], B0[2][2], B1[2][2];
    const char* cA = (const char*)g.A + (size_t)cur.pm * tstepA; const char* cB = (const char*)g.Bt + (size_t)cur.pn * tstep;
    S.a_ready(cur);
    if constexpr (SP2) {
        PG8_STAGE(PG8_SB(0, 0), cB, voffB); PG8_STAGE(PG8_SB(0, 1), cB + hstep, voffB); PG8_STAGE(PG8_SA(0, 0), cA, voffA); PG8_STAGE(PG8_SA(0, 1), cA + hstep, voffA);
        if (wr == 1) PG8_BAR;
        PG8_WAIT_V(2); PG8_BAR;
        PG8_STAGE(PG8_SB(1, 0), cB + kstep, voffB); PG8_STAGE(PG8_SA(1, 0), cA + kstep, voffA); PG8_STAGE(PG8_SB(1, 1), cB + hstep + kstep, voffB);
        PG8_WAIT_V(6); PG8_BAR;
    } else {
        PG8_STAGE(PG8_SB(0, 0), cB, voffB); PG8_STAGE(PG8_SA(0, 0), cA, voffA); PG8_STAGE(PG8_SB(0, 1), cB + hstep, voffB); PG8_STAGE(PG8_SA(0, 1), cA + hstep, voffA);
        if (wr == 1) PG8_BAR;
        PG8_WAIT_V(4); PG8_BAR;
        PG8_STAGE(PG8_SB(1, 0), cB + kstep, voffB); PG8_STAGE(PG8_SA(1, 0), cA + kstep, voffA); PG8_STAGE(PG8_SB(1, 1), cB + hstep + kstep, voffB);
        PG8_WAIT_V(6); PG8_BAR;
    }
    for (;;) {
        const bool has_next = S.next(ui + 1, nxt);
        const char* nA = has_next ? (const char*)g.A + (size_t)nxt.pm * tstepA : cA; const char* nB = has_next ? (const char*)g.Bt + (size_t)nxt.pn * tstep : cB;
        for (int t = 0; t < nt; t += 2) {
            const bool last = (t == nt - 2);
            const char* a1 = cA + (size_t)(t + 1) * kstep;
            const char* a2 = last ? nA : cA + (size_t)(t + 2) * kstep; const char* b2 = last ? nB : cB + (size_t)(t + 2) * kstep;
            const char* a3 = a2 + kstep; const char* b3 = b2 + kstep;
            if (last && has_next) S.a_ready(nxt);
            if constexpr (SP2) {
            PG8_LDB(B0, 0, 0); PG8_LDB(B1, 0, 1); PG8_SCHED; PG8_LDA(At, 0, 0); PG8_STAGE(PG8_SA(1, 1), a1 + hstep, voffA);
            PG8_WAIT_V(8); PG8_WAIT_L(0); PG8_BAR; PG8_MMA(0, 0, At, B0); PG8_MMA(0, 1, At, B1); PG8_BAR; PG8_SCHED;
            PG8_LDA(At, 0, 1); PG8_STAGE(PG8_SB(0, 0), b2, voffB); PG8_STAGE(PG8_SB(0, 1), b2 + hstep, voffB); PG8_STAGE(PG8_SA(0, 0), a2, voffA);
            PG8_WAIT_V(8); PG8_WAIT_L(0); PG8_BAR; PG8_MMA(1, 0, At, B0); PG8_MMA(1, 1, At, B1); PG8_BAR; PG8_SCHED;
            PG8_LDB(B0, 1, 0); PG8_LDB(B1, 1, 1); PG8_SCHED; PG8_LDA(At, 1, 0); PG8_STAGE(PG8_SA(0, 1), a2 + hstep, voffA);
            PG8_WAIT_V(8); PG8_WAIT_L(0); PG8_BAR; PG8_MMA(0, 0, At, B0); PG8_MMA(0, 1, At, B1); PG8_BAR; PG8_SCHED;
            PG8_LDA(At, 1, 1); PG8_STAGE(PG8_SB(1, 0), b3, voffB); PG8_STAGE(PG8_SB(1, 1), b3 + hstep, voffB); PG8_STAGE(PG8_SA(1, 0), a3, voffA);
            PG8_WAIT_V(8); PG8_WAIT_L(0); PG8_BAR; PG8_MMA(1, 0, At, B0); PG8_MMA(1, 1, At, B1); PG8_BAR; PG8_SCHED;
            } else {
            PG8_LDB(B0, 0, 0); PG8_SCHED; PG8_LDA(At, 0, 0); PG8_STAGE(PG8_SA(1, 1), a1 + hstep, voffA);
            PG8_WAIT_L(8); PG8_BAR; PG8_WAIT_L(0); PG8_MMA(0, 0, At, B0); PG8_BAR; PG8_SCHED;
            PG8_LDB(B1, 0, 1); PG8_STAGE(PG8_SB(0, 0), b2, voffB);
            PG8_BAR; PG8_WAIT_L(0); PG8_MMA(0, 1, At, B1); PG8_BAR;
            PG8_LDA(At, 0, 1); PG8_STAGE(PG8_SA(0, 0), a2, voffA);
            PG8_BAR; PG8_WAIT_L(0); PG8_MMA(1, 0, At, B0); PG8_BAR; PG8_SCHED;
            PG8_STAGE(PG8_SB(0, 1), b2 + hstep, voffB);
            PG8_WAIT_V(6); PG8_BAR; PG8_MMA(1, 1, At, B1); PG8_BAR;
            PG8_LDB(B0, 1, 0); PG8_SCHED; PG8_LDA(At, 1, 0); PG8_STAGE(PG8_SA(0, 1), a2 + hstep, voffA);
            PG8_WAIT_L(8); PG8_BAR; PG8_WAIT_L(0); PG8_MMA(0, 0, At, B0); PG8_BAR; PG8_SCHED;
            PG8_LDB(B1, 1, 1); PG8_STAGE(PG8_SB(1, 0), b3, voffB);
            PG8_BAR; PG8_WAIT_L(0); PG8_MMA(0, 1, At, B1); PG8_BAR;
            PG8_LDA(At, 1, 1); PG8_STAGE(PG8_SA(1, 0), a3, voffA);
            PG8_BAR; PG8_WAIT_L(0); PG8_MMA(1, 0, At, B0); PG8_BAR; PG8_SCHED;
            PG8_STAGE(PG8_SB(1, 1), b3 + hstep, voffB);
            PG8_WAIT_V(6); PG8_BAR; PG8_MMA(1, 1, At, B1); PG8_BAR;
            }
        }
        if constexpr (ALIGN_EPI) { if (wr == 0) PG8_BAR; }
        if constexpr (!Epi::AFTER_DRAIN) { E(acc, cur, wr, wc, fr, fq); S.done(cur); }
        if (!has_next) break;
#pragma unroll
        for (int a = 0; a < 2; ++a)
#pragma unroll
            for (int b = 0; b < 2; ++b)
#pragma unroll
                for (int m = 0; m < 4; ++m)
#pragma unroll
                    for (int n = 0; n < 2; ++n) acc[a][b][m][n] = (f32x4){0.f, 0.f, 0.f, 0.f};
        cur = nxt; cA = nA; cB = nB; ++ui;
        if constexpr (ALIGN_EPI) { if (wr == 1) PG8_BAR; }
    }
    PG8_WAIT_V(0);
    if constexpr (!ALIGN_EPI) { if (wr == 0) PG8_BAR; }
    PG8_BAR;
    if constexpr (Epi::AFTER_DRAIN) { E.fused(acc, cur, wr, wc, fr, fq, lds, wid, lane); S.done(cur); }
#undef PG8_SA
#undef PG8_SB
#undef PG8_STAGE
#undef PG8_LDA
#undef PG8_LDB
#undef PG8_MMA
#undef PG8_WAIT_V
#undef PG8_WAIT_L
#undef PG8_BAR
#undef PG8_SCHED
}
}
constexpr int S = 16384, DM = 1024, DEPTH = 4, NIN = 2816, DFF = 2816, NUP = 5632;
constexpr float EPS = 1e-6f;
constexpr int NWAVES = 8, NTHR = 512;
constexpr size_t MiB = 1u << 20;
constexpr size_t WS_WIN = 1 * MiB, WS_WOUT = 23 * MiB, WS_WUP = 31 * MiB, WS_WDN = 75 * MiB;
constexpr size_t WS_PART = 97 * MiB;
constexpr size_t WS_XB = 98 * MiB + 4096;
constexpr size_t WS_P = 131 * MiB;
constexpr size_t WS_Y = 219 * MiB;
constexpr size_t WS_GU = 131 * MiB;
constexpr size_t WS_A = 219 * MiB;
constexpr size_t WS_END = 307 * MiB;
constexpr int LDS_BYTES = 147456;
#define LAS __attribute__((address_space(3)))
typedef unsigned short bf16;
typedef unsigned v4u __attribute__((ext_vector_type(4)));
typedef unsigned v2u __attribute__((ext_vector_type(2)));
typedef float f32x4 __attribute__((ext_vector_type(4)));
typedef float f32x16 __attribute__((ext_vector_type(16)));
typedef short bf16x8 __attribute__((ext_vector_type(8)));
#define LDS_WAIT() asm volatile("s_waitcnt lgkmcnt(0)" ::: "memory")
__device__ __forceinline__ unsigned pk2(float lo, float hi) { return pg8::cvt_pk_bf16(lo, hi); }
__device__ __forceinline__ float bflo(unsigned u) { return __uint_as_float(u << 16); }
__device__ __forceinline__ float bfhi(unsigned u) { return __uint_as_float(u & 0xffff0000u); }
__device__ __forceinline__ float bf1(bf16 v) { return __uint_as_float((unsigned)v << 16); }
__device__ __forceinline__ float wave_sum(float v) {
#pragma unroll
    for (int o = 1; o < 64; o <<= 1) v += __shfl_xor(v, o);
    return v;
}

__device__ __forceinline__ void cvt_item(const float* W, int K, int N, bf16* WT, const float* gain, int mode, LAS float* scr, int item, int lane) {
    const int nblk = N / 32, kb = item / nblk, nb = item % nblk, k0 = 64 * kb, n0 = 32 * nb;
#pragma unroll 8
    for (int i = 0; i < 32; ++i) { const int kk = 2 * i + (lane >> 5); const float g = gain ? gain[k0 + kk] : 1.0f; scr[kk * 33 + (lane & 31)] = W[(size_t)(k0 + kk) * N + n0 + (lane & 31)] * g; }
    LDS_WAIT(); asm volatile("" ::: "memory");
    const float cs = (mode == 1 && n0 >= 1280 && n0 < 1792) ? 0.125f : 1.0f;
    int rb = n0;
    if (mode == 2) { rb = (n0 < DFF) ? 256 * (n0 / 128) + (n0 % 128) : 256 * ((n0 - DFF) / 128) + 128 + ((n0 - DFF) % 128); }
    const int c = lane & 7;
#pragma unroll
    for (int j = 0; j < 4; ++j) { const int n = (lane >> 3) + 8 * j; const LAS float* s = scr + (8 * c) * 33 + n;
        v4u o; o.x = pk2(s[0 * 33] * cs, s[1 * 33] * cs); o.y = pk2(s[2 * 33] * cs, s[3 * 33] * cs); o.z = pk2(s[4 * 33] * cs, s[5 * 33] * cs); o.w = pk2(s[6 * 33] * cs, s[7 * 33] * cs);
        *(v4u*)(WT + (size_t)(rb + n) * K + k0 + 8 * c) = o; }
    LDS_WAIT(); asm volatile("" ::: "memory");
}

struct Args { const float* in[14]; float* out; unsigned char* ws; };

__device__ __forceinline__ void norm_store_rows(const LAS float* tile, bf16* Y, int t0, int coff, int wave, int lane) {
#pragma unroll 2
    for (int i = 0; i < 8; ++i) { const int r = wave * 8 + i; const f32x4 v = *(const LAS f32x4*)(tile + r * 260 + lane * 4);
        const float ss = wave_sum((v[0] * v[0] + v[1] * v[1]) + (v[2] * v[2] + v[3] * v[3]));
        const float rs = __builtin_amdgcn_rsqf(ss * (1.0f / 256.0f) + EPS);
        v2u o; o.x = pk2(v[0] * rs, v[1] * rs); o.y = pk2(v[2] * rs, v[3] * rs);
        *(v2u*)(Y + (size_t)(t0 + r) * DM + coff + lane * 4) = o; }
}

__device__ __forceinline__ void mixer_unit(LAS unsigned char* lds, int unit, const bf16* P, bf16* Y, const float* conv_w, const float* sgu_norm, const float* sgu_w, const float* sgu_b, int tid, int wave, int lane) {
    const int t0 = unit * 64;
    asm volatile("" : "+v"(tid), "+v"(lane));
    LAS bf16* vnT = (LAS bf16*)lds;
    LAS float* tile = (LAS float*)(lds + 69632);
    LAS float* sm_ss = (LAS float*)(lds + 69632 + 66560);
    {
        const int h = wave, t = t0 + lane;
        float q[64], acc[64];
        { const v4u* qp = (const v4u*)(P + (size_t)t * NIN + 1280 + h * 64);
#pragma unroll
          for (int i = 0; i < 8; ++i) { const v4u u = qp[i]; q[8 * i + 0] = bflo(u.x); q[8 * i + 1] = bfhi(u.x); q[8 * i + 2] = bflo(u.y); q[8 * i + 3] = bfhi(u.y); q[8 * i + 4] = bflo(u.z); q[8 * i + 5] = bfhi(u.z); q[8 * i + 6] = bflo(u.w); q[8 * i + 7] = bfhi(u.w); } }
#pragma unroll
        for (int i = 0; i < 64; ++i) acc[i] = 0.f;
        float ls = 0.f;
        for (int j = 1;; ++j) {
            const int s = t - j; const bool act = (s >= 0) && (ls > -104.0f);
            if (__builtin_amdgcn_ballot_w64(act) == 0ull) break;
            const int sc = s < 0 ? 0 : s;
            const v4u* kp = (const v4u*)(P + (size_t)sc * NIN + 1792 + h * 64);
            float z0 = 0.f, z1 = 0.f;
#pragma unroll
            for (int i = 0; i < 8; ++i) { const v4u u = kp[i];
                z0 += q[8 * i + 0] * bflo(u.x); z1 += q[8 * i + 1] * bfhi(u.x); z0 += q[8 * i + 2] * bflo(u.y); z1 += q[8 * i + 3] * bfhi(u.y);
                z0 += q[8 * i + 4] * bflo(u.z); z1 += q[8 * i + 5] * bfhi(u.z); z0 += q[8 * i + 6] * bflo(u.w); z1 += q[8 * i + 7] * bfhi(u.w); }
            const float z = z0 + z1;
            const float e = __expf(-fabsf(z)); const float lsig = fminf(z, 0.f) - __logf(1.0f + e);
            const float w = act ? __expf(lsig + ls) : 0.f;
            ls += act ? (lsig - z) : 0.f;
            const v4u* vp = (const v4u*)(P + (size_t)sc * NIN + 2304 + h * 64);
#pragma unroll
            for (int i = 0; i < 8; ++i) { const v4u u = vp[i];
                acc[8 * i + 0] += w * bflo(u.x); acc[8 * i + 1] += w * bfhi(u.x); acc[8 * i + 2] += w * bflo(u.y); acc[8 * i + 3] += w * bfhi(u.y);
                acc[8 * i + 4] += w * bflo(u.z); acc[8 * i + 5] += w * bfhi(u.z); acc[8 * i + 6] += w * bflo(u.w); acc[8 * i + 7] += w * bfhi(u.w); }
        }
        float ss = 0.f;
#pragma unroll
        for (int i = 0; i < 64; ++i) ss += acc[i] * acc[i];
        sm_ss[lane * 8 + h] = ss;
        LDS_WAIT(); __syncthreads();
        float tot = 0.f;
#pragma unroll
        for (int i = 0; i < 8; ++i) tot += sm_ss[lane * 8 + i];
        const float rs = __builtin_amdgcn_rsqf(tot * (1.0f / 512.0f) + EPS);
        v4u* yp = (v4u*)(Y + (size_t)t * DM + 512 + h * 64);
#pragma unroll
        for (int i = 0; i < 8; ++i) { v4u o; o.x = pk2(acc[8 * i + 0] * rs, acc[8 * i + 1] * rs); o.y = pk2(acc[8 * i + 2] * rs, acc[8 * i + 3] * rs); o.z = pk2(acc[8 * i + 4] * rs, acc[8 * i + 5] * rs); o.w = pk2(acc[8 * i + 6] * rs, acc[8 * i + 7] * rs); yp[i] = o; }
    }
    {
        const int c = tid & 255, rh = tid >> 8, tb = t0 + 32 * rh;
        const float w0 = conv_w[c], w1 = conv_w[256 + c], w2 = conv_w[512 + c];
        float p2 = 0.f, p1 = 0.f;
        if (tb >= 2) { const bf16* r2 = P + (size_t)(tb - 2) * NIN; const bf16* r1 = P + (size_t)(tb - 1) * NIN; p2 = bf1(r2[256 + c]) * bf1(r2[512 + c]); p1 = bf1(r1[256 + c]) * bf1(r1[512 + c]); }
#pragma unroll 4
        for (int r = 0; r < 32; ++r) { const bf16* rp = P + (size_t)(tb + r) * NIN; const float p0 = bf1(rp[256 + c]) * bf1(rp[512 + c]);
            tile[(32 * rh + r) * 260 + c] = bf1(rp[c]) * (w0 * p2 + w1 * p1 + w2 * p0); p2 = p1; p1 = p0; }
    }
    LDS_WAIT(); __syncthreads();
    norm_store_rows(tile, Y, t0, 0, wave, lane);
    const int tc = t0 & ~127, dt = t0 - tc, ns = dt + 64;
    for (int s = wave; s < ns; s += 8) { const v2u u = *(const v2u*)(P + (size_t)(tc + s) * NIN + 1024 + lane * 4);
        const float v0 = bflo(u.x), v1 = bfhi(u.x), v2 = bflo(u.y), v3 = bfhi(u.y);
        const float ss = wave_sum((v0 * v0 + v1 * v1) + (v2 * v2 + v3 * v3)); const float rs = __builtin_amdgcn_rsqf(ss * (1.0f / 256.0f) + EPS);
        const f32x4 g = *(const f32x4*)(sgu_norm + lane * 4);
        const unsigned a = pk2(v0 * rs * g[0], v1 * rs * g[1]), b = pk2(v2 * rs * g[2], v3 * rs * g[3]);
        vnT[(lane * 4 + 0) * 136 + s] = (bf16)(a & 0xffffu); vnT[(lane * 4 + 1) * 136 + s] = (bf16)(a >> 16); vnT[(lane * 4 + 2) * 136 + s] = (bf16)(b & 0xffffu); vnT[(lane * 4 + 3) * 136 + s] = (bf16)(b >> 16); }
    LDS_WAIT(); __syncthreads();
    {
        const int h = wave >> 1, rh = wave & 1, r32 = lane & 31, hi = lane >> 5;
        const int tcl = dt + 32 * rh + r32;
        const float* wrow = sgu_w + ((size_t)h * 128 + tcl) * 128;
        f32x16 o0 = {}, o1 = {};
        const int nk = (dt + 32 * rh + 32) >> 4;
        for (int ks = 0; ks < nk; ++ks) { const int s0 = ks * 16 + 8 * hi;
            const f32x4 wa = *(const f32x4*)(wrow + s0), wb = *(const f32x4*)(wrow + s0 + 4);
            float wv[8] = {wa[0], wa[1], wa[2], wa[3], wb[0], wb[1], wb[2], wb[3]};
#pragma unroll
            for (int i = 0; i < 8; ++i) wv[i] = (s0 + i <= tcl) ? wv[i] : 0.f;
            v4u ap; ap.x = pk2(wv[0], wv[1]); ap.y = pk2(wv[2], wv[3]); ap.z = pk2(wv[4], wv[5]); ap.w = pk2(wv[6], wv[7]);
            const bf16x8 af = __builtin_bit_cast(bf16x8, ap);
            const bf16x8 b0 = *(const LAS bf16x8*)(vnT + (h * 64 + r32) * 136 + s0), b1 = *(const LAS bf16x8*)(vnT + (h * 64 + 32 + r32) * 136 + s0);
            o0 = __builtin_amdgcn_mfma_f32_32x32x16_bf16(af, b0, o0, 0, 0, 0);
            o1 = __builtin_amdgcn_mfma_f32_32x32x16_bf16(af, b1, o1, 0, 0, 0); }
#pragma unroll
        for (int j = 0; j < 16; ++j) { const int rl = 32 * rh + (j & 3) + 8 * (j >> 2) + 4 * hi;
            const float bb = sgu_b[h * 128 + dt + rl]; const bf16* up = P + (size_t)(t0 + rl) * NIN + 768 + h * 64;
            tile[rl * 260 + h * 64 + r32] = bf1(up[r32]) * (o0[j] + bb);
            tile[rl * 260 + h * 64 + 32 + r32] = bf1(up[32 + r32]) * (o1[j] + bb); }
    }
    LDS_WAIT(); __syncthreads();
    norm_store_rows(tile, Y, t0, 256, wave, lane);
    LDS_WAIT(); __syncthreads();
}

__device__ __forceinline__ void ffn_gate_phase(const bf16* GU, bf16* A, const float* fconv, int hf, int gtid, int gthreads) {
    for (int it = gtid; it < 256 * 176; it += gthreads) { const int rb = it / 176, cgp = it % 176, pnl = cgp >> 4, cc = (cgp & 15) * 8, ch = 1408 * hf + 128 * pnl + cc;
        float wg[3][8], wu[3][8];
#pragma unroll
        for (int i = 0; i < 3; ++i) { const f32x4 a0 = *(const f32x4*)(fconv + (size_t)i * NUP + ch), a1 = *(const f32x4*)(fconv + (size_t)i * NUP + ch + 4), b0 = *(const f32x4*)(fconv + (size_t)i * NUP + DFF + ch), b1 = *(const f32x4*)(fconv + (size_t)i * NUP + DFF + ch + 4);
#pragma unroll
            for (int e = 0; e < 4; ++e) { wg[i][e] = a0[e]; wg[i][4 + e] = a1[e]; wu[i][e] = b0[e]; wu[i][4 + e] = b1[e]; } }
        float g2[8], g1[8], u2[8], u1[8];
#pragma unroll
        for (int e = 0; e < 8; ++e) { g2[e] = g1[e] = u2[e] = u1[e] = 0.f; }
        for (int r = -2; r < 64; ++r) { const int t = 64 * rb + r; float g0[8], u0[8];
            if (t >= 0) { const v4u gv = *(const v4u*)(GU + (size_t)t * NIN + 256 * pnl + cc), uv = *(const v4u*)(GU + (size_t)t * NIN + 256 * pnl + 128 + cc);
                g0[0] = bflo(gv.x); g0[1] = bfhi(gv.x); g0[2] = bflo(gv.y); g0[3] = bfhi(gv.y); g0[4] = bflo(gv.z); g0[5] = bfhi(gv.z); g0[6] = bflo(gv.w); g0[7] = bfhi(gv.w);
                u0[0] = bflo(uv.x); u0[1] = bfhi(uv.x); u0[2] = bflo(uv.y); u0[3] = bfhi(uv.y); u0[4] = bflo(uv.z); u0[5] = bfhi(uv.z); u0[6] = bflo(uv.w); u0[7] = bfhi(uv.w); }
            else {
#pragma unroll
                for (int e = 0; e < 8; ++e) { g0[e] = 0.f; u0[e] = 0.f; } }
            if (r >= 0) { float o[8];
#pragma unroll
                for (int e = 0; e < 8; ++e) { const float G = wg[0][e] * g2[e] + wg[1][e] * g1[e] + wg[2][e] * g0[e], U = wu[0][e] * u2[e] + wu[1][e] * u1[e] + wu[2][e] * u0[e];
                    o[e] = G * __builtin_amdgcn_rcpf(1.0f + __expf(-G)) * U; }
                v4u ov; ov.x = pk2(o[0], o[1]); ov.y = pk2(o[2], o[3]); ov.z = pk2(o[4], o[5]); ov.w = pk2(o[6], o[7]);
                *(v4u*)(A + (size_t)t * DFF + ch) = ov; }
#pragma unroll
            for (int e = 0; e < 8; ++e) { g2[e] = g1[e]; g1[e] = g0[e]; u2[e] = u1[e]; u1[e] = u0[e]; } }
    }
}
__global__ void __launch_bounds__(NTHR, 2) hybrid_fwd(Args args) {
    extern __shared__ __attribute__((aligned(16))) unsigned char lds_raw[];
    LAS unsigned char* lds = (LAS unsigned char*)lds_raw;
    cg::grid_group grid = cg::this_grid();
    const int tid = threadIdx.x, lane = tid & 63, wave = __builtin_amdgcn_readfirstlane(tid >> 6);
    const int G = gridDim.x, bx = blockIdx.x;
    const int gw = bx * NWAVES + wave, NGW = G * NWAVES;
    unsigned char* ws = args.ws;
    const float* x_in = args.in[0]; const float* norm_mix = args.in[1]; const float* w_in = args.in[2]; const float* conv_w = args.in[3];
    const float* sgu_norm = args.in[4]; const float* sgu_w = args.in[5]; const float* sgu_b = args.in[6]; const float* out_norm = args.in[7];
    const float* w_out = args.in[8]; const float* norm_ffn = args.in[9]; const float* w_up = args.in[10]; const float* ffn_conv = args.in[11];
    const float* w_down = args.in[12]; const float* norm_final = args.in[13];
    float* xcur = args.out;
    bf16* Win_t = (bf16*)(ws + WS_WIN); bf16* Wout_t = (bf16*)(ws + WS_WOUT); bf16* Wup_t = (bf16*)(ws + WS_WUP); bf16* Wdn_t = (bf16*)(ws + WS_WDN);
    float* part = (float*)(ws + WS_PART); bf16* XB = (bf16*)(ws + WS_XB); bf16* P = (bf16*)(ws + WS_P); bf16* Y = (bf16*)(ws + WS_Y);
    bf16* GU = (bf16*)(ws + WS_GU); bf16* A = (bf16*)(ws + WS_A);

    {
        LAS float* scr = (LAS float*)(lds + wave * 16384);
        constexpr int I_IN = 16 * 88, I_OUT = 16 * 32, I_UP = 16 * 176, I_DN = 44 * 32, I_L = I_IN + I_OUT + I_UP + I_DN;
        for (int it = gw; it < DEPTH * I_L; it += NGW) { const int l = it / I_L; int r = it % I_L;
            if (r < I_IN) { cvt_item(w_in + (size_t)l * DM * NIN, DM, NIN, Win_t + (size_t)l * NIN * DM, norm_mix + l * DM, 1, scr, r, lane); continue; } r -= I_IN;
            if (r < I_OUT) { cvt_item(w_out + (size_t)l * DM * DM, DM, DM, Wout_t + (size_t)l * DM * DM, out_norm + l * DM, 0, scr, r, lane); continue; } r -= I_OUT;
            if (r < I_UP) { cvt_item(w_up + (size_t)l * DM * NUP, DM, NUP, Wup_t + (size_t)l * NUP * DM, norm_ffn + l * DM, 2, scr, r, lane); continue; } r -= I_UP;
            cvt_item(w_down + (size_t)l * DFF * DM, DFF, DM, Wdn_t + (size_t)l * DM * DFF, nullptr, 0, scr, r, lane); }
        for (int m = gw; m < S; m += NGW) { const f32x4* xr = (const f32x4*)(x_in + (size_t)m * DM) + lane; f32x4 v[4]; float ss = 0.f;
#pragma unroll
            for (int j = 0; j < 4; ++j) { v[j] = xr[64 * j]; ss += (v[j][0] * v[j][0] + v[j][1] * v[j][1]) + (v[j][2] * v[j][2] + v[j][3] * v[j][3]); }
            ss = wave_sum(ss);
            v2u* o8 = (v2u*)(XB + (size_t)m * DM) + lane;
#pragma unroll
            for (int j = 0; j < 4; ++j) { v2u o; o.x = pk2(v[j][0], v[j][1]); o.y = pk2(v[j][2], v[j][3]); o8[64 * j] = o; }
            if (lane < 16) part[(size_t)m * 16 + lane] = lane == 0 ? ss : 0.f; }
    }
    grid.sync();

    for (int l = 0; l < DEPTH; ++l) {
        { pg8::Gemm g{XB, Win_t + (size_t)l * NIN * DM, S, NIN, DM, 256}; pg8::StaticOrder So; So.init(S, NIN, G, bx);
          pg8::EpiScaleBf16 E{P, NIN, part};
          pg8::gemm_phase<pg8::EpiScaleBf16, pg8::StaticOrder, true, true>(lds, g, So, E); }
        grid.sync();
        for (int u = bx; u < S / 64; u += G)
            mixer_unit(lds, u, P, Y, conv_w + l * 3 * 256, sgu_norm + l * 256, sgu_w + (size_t)l * 4 * 128 * 128, sgu_b + l * 4 * 128, tid, wave, lane);
        grid.sync();
        { pg8::Gemm g{Y, Wout_t + (size_t)l * DM * DM, S, DM, DM, 256}; pg8::StaticOrder So; So.init(S, DM, G, bx);
          pg8::EpiResid E{l == 0 ? x_in : xcur, xcur, XB, part};
          pg8::gemm_phase<pg8::EpiResid, pg8::StaticOrder, true, true>(lds, g, So, E); }
        grid.sync();
        { pg8::Gemm g{XB - 2 * DM, Wup_t + (size_t)l * NUP * DM, 65 * 256, NUP, DM, 254}; pg8::StaticOrder So; So.init(65 * 256, NUP, G, bx);
          pg8::EpiGate E{A, part, ffn_conv + (size_t)l * 3 * NUP, (LAS float*)(lds + 131072)};
          pg8::gemm_phase<pg8::EpiGate, pg8::StaticOrder, true, true>(lds, g, So, E); }
        grid.sync();
        { pg8::Gemm g{A, Wdn_t + (size_t)l * DM * DFF, S, DM, DFF, 256}; pg8::StaticOrder So; So.init(S, DM, G, bx);
          pg8::EpiResid E{xcur, xcur, XB, part};
          pg8::gemm_phase<pg8::EpiResid, pg8::StaticOrder, true, true>(lds, g, So, E); }
        grid.sync();
    }
    for (int m = gw; m < S; m += NGW) { f32x4* xr = (f32x4*)(xcur + (size_t)m * DM) + lane; f32x4 v[4]; float ss = 0.f;
#pragma unroll
        for (int j = 0; j < 4; ++j) { v[j] = xr[64 * j]; ss += (v[j][0] * v[j][0] + v[j][1] * v[j][1]) + (v[j][2] * v[j][2] + v[j][3] * v[j][3]); }
        const float rs = __builtin_amdgcn_rsqf(wave_sum(ss) * (1.0f / 1024.0f) + EPS);
#pragma unroll
        for (int j = 0; j < 4; ++j) { const f32x4 g = *((const f32x4*)norm_final + lane + 64 * j); xr[64 * j] = v[j] * rs * g; } }
}

extern "C" void kernel_launch(void* const* d_in, const int* in_sizes, int n_in, void* d_out, int out_size, void* d_ws, size_t ws_size, hipStream_t stream) {
    static int grid = 0;
    if (grid == 0) {
        if (n_in != 14 || out_size != S * DM || ws_size < WS_END) { fprintf(stderr, "kernel_launch: unexpected shapes / workspace (%d inputs, out %d, ws %zu)\n", n_in, out_size, ws_size); grid = -1; return; }
        int dev = 0, cus = 0, per_cu = 0;
        hipGetDevice(&dev); hipDeviceGetAttribute(&cus, hipDeviceAttributeMultiprocessorCount, dev);
        hipFuncSetAttribute((const void*)hybrid_fwd, hipFuncAttributeMaxDynamicSharedMemorySize, LDS_BYTES);
        hipOccupancyMaxActiveBlocksPerMultiprocessor(&per_cu, (const void*)hybrid_fwd, NTHR, LDS_BYTES);
        (void)hipGetLastError();
        if (per_cu < 1) per_cu = 1;
        grid = cus * 1;
    }
    if (grid < 0) return;
    hipMemsetAsync((unsigned char*)d_ws + WS_XB - 4096, 0, 4096, stream);
    Args a{};
    for (int i = 0; i < 14; ++i) a.in[i] = (const float*)d_in[i];
    a.out = (float*)d_out; a.ws = (unsigned char*)d_ws;
    void* kargs[] = {&a};
    hipError_t e = hipLaunchCooperativeKernel((const void*)hybrid_fwd, dim3(grid), dim3(NTHR), kargs, LDS_BYTES, stream);
    if (e != hipSuccess) fprintf(stderr, "cooperative launch failed: %s (grid %d)\n", hipGetErrorString(e), grid);
}
```

```cpp
#include <hip/hip_runtime.h>
#include <hip/hip_cooperative_groups.h>
#include <cstdio>
#include <cstdint>
namespace cg = cooperative_groups;
namespace pg8 {
#define PG8_LAS __attribute__((address_space(3)))
typedef unsigned short bf16_t;
typedef short bf16x8 __attribute__((ext_vector_type(8)));
typedef float f32x4 __attribute__((ext_vector_type(4)));
typedef unsigned u32x4 __attribute__((ext_vector_type(4)));
typedef unsigned u32x2 __attribute__((ext_vector_type(2)));
constexpr int BM = 256, BK = 64, HALF = 128, HTB = HALF * BK * 2  , STAGE_BYTES = 8 * HTB, NXCD = 8, WGM = 8;

__host__ __device__ __forceinline__ int lds_byte(int r, int c) { const int st = (r >> 4) * 2 + (c >> 5), rr = r & 15, cc = c & 31, ob = rr * 64 + cc * 2; return st * 1024 + (ob ^ (((ob >> 9) & 1) << 5)); }
__host__ __device__ __forceinline__ void stage_rc(int b, int& R, int& C) { const int st = b / 1024, sb = b % 1024, swz = sb ^ (((sb >> 9) & 1) << 5); R = (st >> 1) * 16 + swz / 64; C = (st & 1) * 32 + (swz % 64) / 2; }
__host__ __device__ __forceinline__ int perm32(int rho) { const int n = rho >> 4, i = rho & 15; return 8 * (i >> 2) + 4 * n + (i & 3); }

struct Unit { int pm, pn; };
struct Gemm { const bf16_t* A; const bf16_t* Bt; int M, N, K; int arows; };

struct StaticOrder {
    int nM, nN, nwg, G, c;
    __host__ __device__ void init(int M, int N, int G_, int c_) { nM = M / BM; nN = N / BM; nwg = nM * nN; G = G_; c = c_; }
    __host__ __device__ bool next(int i, Unit& u) const {
        const long L = (long)i * G + c; if (L >= nwg) return false;
        int wgid = (int)L; { const int q = nwg / NXCD, r = nwg % NXCD, xcd = wgid % NXCD, off = wgid / NXCD; wgid = (xcd < r ? xcd * (q + 1) : r * (q + 1) + (xcd - r) * q) + off; }
        const int nig = WGM * nN, gid = wgid / nig, fm = gid * WGM, gsz = (nM - fm) < WGM ? (nM - fm) : WGM;
        u.pm = fm + ((wgid % nig) % gsz); u.pn = (wgid % nig) / gsz; return true;
    }
    __device__ __forceinline__ void a_ready(const Unit&) const {}
    __device__ __forceinline__ void done(const Unit&) const {}
};

__device__ __forceinline__ unsigned cvt_pk_bf16(float lo, float hi) { unsigned r; asm volatile("v_cvt_pk_bf16_f32 %0, %1, %2" : "=v"(r) : "v"(lo), "v"(hi)); return r; }
struct EpiScaleBf16 {
    static constexpr bool PERM = true, AFTER_DRAIN = false;
    bf16_t* O; int ldc; const float* part;
    __device__ __forceinline__ void operator()(const f32x4 (&acc)[2][2][4][2], const Unit& u, int wr, int wc, int fr, int fq) const {
        const int row0 = u.pm * BM + wr * 64 + fr; const int col0 = u.pn * BM + wc * 32 + 8 * fq;
#pragma unroll
        for (int ai = 0; ai < 2; ++ai)
#pragma unroll
            for (int m = 0; m < 4; ++m) { const int row = row0 + ai * HALF + m * 16;
                const f32x4* pp = (const f32x4*)(part + (size_t)row * 16); const f32x4 a = pp[0], b = pp[1], c = pp[2], d = pp[3];
                const f32x4 s4 = (a + b) + (c + d); const float ss = (s4[0] + s4[1]) + (s4[2] + s4[3]);
                const float rs = __builtin_amdgcn_rsqf(ss * (1.0f / 1024.0f) + 1e-6f);
                bf16_t* rowp = O + (size_t)row * ldc + col0;
#pragma unroll
                for (int bj = 0; bj < 2; ++bj) { const f32x4 v0 = acc[ai][bj][m][0] * rs, v1 = acc[ai][bj][m][1] * rs;
                    u32x4 w; w.x = cvt_pk_bf16(v0[0], v0[1]); w.y = cvt_pk_bf16(v0[2], v0[3]); w.z = cvt_pk_bf16(v1[0], v1[1]); w.w = cvt_pk_bf16(v1[2], v1[3]);
                    *(u32x4*)(rowp + bj * HALF) = w; }
                if (m & 1) asm volatile("" ::: "memory"); }
    }
};
struct EpiResid {
    static constexpr bool PERM = true, AFTER_DRAIN = false;
    const float* base; float* out; bf16_t* xb; float* part;
    __device__ __forceinline__ void operator()(const f32x4 (&acc)[2][2][4][2], const Unit& u, int wr, int wc, int fr, int fq) const {
        const int row0 = u.pm * BM + wr * 64 + fr; const int col0 = u.pn * BM + wc * 32 + 8 * fq;
#pragma unroll
        for (int ai = 0; ai < 2; ++ai)
#pragma unroll
            for (int m = 0; m < 4; ++m) { const int row = row0 + ai * HALF + m * 16; const size_t off = (size_t)row * 1024 + col0; float ss = 0.f;
#pragma unroll
                for (int bj = 0; bj < 2; ++bj) { const f32x4 b0 = *(const f32x4*)(base + off + bj * HALF), b1 = *(const f32x4*)(base + off + bj * HALF + 4);
                    const f32x4 v0 = acc[ai][bj][m][0] + b0, v1 = acc[ai][bj][m][1] + b1;
                    *(f32x4*)(out + off + bj * HALF) = v0; *(f32x4*)(out + off + bj * HALF + 4) = v1;
                    ss += (v0[0] * v0[0] + v0[1] * v0[1]) + (v0[2] * v0[2] + v0[3] * v0[3]) + (v1[0] * v1[0] + v1[1] * v1[1]) + (v1[2] * v1[2] + v1[3] * v1[3]);
                    u32x4 w; w.x = cvt_pk_bf16(v0[0], v0[1]); w.y = cvt_pk_bf16(v0[2], v0[3]); w.z = cvt_pk_bf16(v1[0], v1[1]); w.w = cvt_pk_bf16(v1[2], v1[3]);
                    *(u32x4*)(xb + off + bj * HALF) = w; }
                ss += __shfl_xor(ss, 16); ss += __shfl_xor(ss, 32);
                if (fq == 0) part[(size_t)row * 16 + u.pn * 4 + wc] = ss;
                asm volatile("" ::: "memory"); }
    }
};
#define PG8_DPP(oldv, srcv, ctrl) __builtin_bit_cast(float, __builtin_amdgcn_update_dpp(__builtin_bit_cast(int, (float)(oldv)), __builtin_bit_cast(int, (float)(srcv)), (ctrl), 0xf, 0xf, false))
struct EpiGate {
    static constexpr bool PERM = true, AFTER_DRAIN = false;
    bf16_t* Aout; const float* part; const float* fconv; PG8_LAS float* xch;
    __device__ __forceinline__ void operator()(f32x4 (&acc)[2][2][4][2], const Unit& u, int wr, int wc, int fr, int fq) const {
        const int rbase = u.pm * 254 - 2 + wr * 64 + fr;
        const int ccol = wc * 32 + 8 * fq;
#pragma unroll
        for (int ai = 0; ai < 2; ++ai)
#pragma unroll
            for (int m = 0; m < 4; ++m) { const int row = rbase + ai * HALF + m * 16; const bool ok = row >= 0 && row < 16384; const int rc = ok ? row : 0;
                const f32x4* pp = (const f32x4*)(part + (size_t)rc * 16); const f32x4 a = pp[0], b = pp[1], c = pp[2], d = pp[3];
                const f32x4 s4 = (a + b) + (c + d); const float ss = (s4[0] + s4[1]) + (s4[2] + s4[3]);
                const float rs = ok ? __builtin_amdgcn_rsqf(ss * (1.0f / 1024.0f) + 1e-6f) : 0.f;
#pragma unroll
                for (int bj = 0; bj < 2; ++bj) { acc[ai][bj][m][0] *= rs; acc[ai][bj][m][1] *= rs; }
                asm volatile("" : "+v"(acc[ai][0][m][0]), "+v"(acc[ai][0][m][1]), "+v"(acc[ai][1][m][0]), "+v"(acc[ai][1][m][1]) :: "memory"); }
        if (fr >= 14) {
#pragma unroll
            for (int ai = 0; ai < 2; ++ai)
#pragma unroll
                for (int bj = 0; bj < 2; ++bj)
#pragma unroll
                    for (int n = 0; n < 2; ++n) *(PG8_LAS f32x4*)(xch + ((2 * ai + wr) * 2 + (fr & 1)) * 256 + bj * HALF + ccol + 4 * n) = acc[ai][bj][3][n];
        }
        asm volatile("s_waitcnt lgkmcnt(0)" ::: "memory"); __builtin_amdgcn_s_barrier(); asm volatile("" ::: "memory");
        const int ch0 = u.pn * HALF + ccol;
#pragma unroll
        for (int ai = 0; ai < 2; ++ai) {
            const int grp = 2 * ai + wr;
#pragma unroll
            for (int n = 0; n < 2; ++n) {
                asm volatile("" ::: "memory");
                const float* fw = fconv + ch0 + 4 * n;
                const f32x4 wg0 = *(const f32x4*)(fw), wg1 = *(const f32x4*)(fw + 5632), wg2 = *(const f32x4*)(fw + 2 * 5632);
                const f32x4 wu0 = *(const f32x4*)(fw + 2816), wu1 = *(const f32x4*)(fw + 5632 + 2816), wu2 = *(const f32x4*)(fw + 2 * 5632 + 2816);
                f32x4 xpg = {0.f, 0.f, 0.f, 0.f}, xpu = {0.f, 0.f, 0.f, 0.f};
                if (grp > 0) { xpg = *(const PG8_LAS f32x4*)(xch + ((grp - 1) * 2 + (fr & 1)) * 256 + ccol + 4 * n); xpu = *(const PG8_LAS f32x4*)(xch + ((grp - 1) * 2 + (fr & 1)) * 256 + HALF + ccol + 4 * n); }
#pragma unroll
                for (int m = 0; m < 4; ++m) {
                    float o[4];
#pragma unroll
                    for (int j = 0; j < 4; ++j) {
                        const float xg = acc[ai][0][m][n][j], xu = acc[ai][1][m][n][j];
                        const float pg = m > 0 ? acc[ai][0][m > 0 ? m - 1 : 0][n][j] : xpg[j], pu = m > 0 ? acc[ai][1][m > 0 ? m - 1 : 0][n][j] : xpu[j];
                        const float g1 = PG8_DPP(PG8_DPP(0.f, pg, 0x121), xg, 0x111), g2 = PG8_DPP(PG8_DPP(0.f, pg, 0x122), xg, 0x112);
                        const float u1 = PG8_DPP(PG8_DPP(0.f, pu, 0x121), xu, 0x111), u2 = PG8_DPP(PG8_DPP(0.f, pu, 0x122), xu, 0x112);
                        const float Gv = wg0[j] * g2 + wg1[j] * g1 + wg2[j] * xg, Uv = wu0[j] * u2 + wu1[j] * u1 + wu2[j] * xu;
                        o[j] = Gv * __builtin_amdgcn_rcpf(1.0f + __expf(-Gv)) * Uv; }
                    const int r = ai * HALF + wr * 64 + m * 16 + fr, row = u.pm * 254 - 2 + r;
                    u32x2 w; w.x = cvt_pk_bf16(o[0], o[1]); w.y = cvt_pk_bf16(o[2], o[3]);
                    if (r >= 2 && row < 16384) *(u32x2*)(Aout + (size_t)row * 2816 + ch0 + 4 * n) = w; }
            }
        }
    }
};
template <class Epi, class Sched, bool ALIGN_EPI = false, bool SP2 = false>
__device__ __forceinline__ void gemm_phase(PG8_LAS unsigned char* lds, const Gemm g, const Sched& S, const Epi& E) {
    int tid = threadIdx.x; asm volatile("" : "+v"(tid));
    const int wid = __builtin_amdgcn_readfirstlane(tid >> 6), lane = tid & 63, wr = wid >> 2, wc = wid & 3, fr = lane & 15, fq = lane >> 4;
    const int K = g.K, nt = K / BK;
    unsigned voffA[2], voffB[2];
#pragma unroll
    for (int i = 0; i < 2; ++i) { int R, C; stage_rc(tid * 16 + i * 8192, R, C); const int Rb = Epi::PERM ? ((R & ~31) + perm32(R & 31)) : R;
        voffA[i] = (unsigned)(R * K + C) * 2u; voffB[i] = (unsigned)(Rb * K + C) * 2u; }
    const size_t kstep = (size_t)(BK * 2);
    const size_t hstep = (size_t)HALF * K * 2;
    const size_t tstep = 2 * hstep;
    const size_t tstepA = (size_t)g.arows * K * 2;
    const unsigned ldsw = (unsigned)wid * 1024u;
    const int aoff = lds_byte(wr * 64 + fr, fq * 8), boff = lds_byte(wc * 32 + fr, fq * 8);
#define PG8_SA(b, h) (((b) * 2 + (h)) * HTB)
#define PG8_SB(b, h) ((4 + (b) * 2 + (h)) * HTB)
#define PG8_STAGE(bufoff, gbase, voff) do { _Pragma("unroll") for (int _i = 0; _i < 2; ++_i) \
        __builtin_amdgcn_global_load_lds((const unsigned*)((const char*)(gbase) + (voff)[_i]), (PG8_LAS unsigned*)(lds + (bufoff) + ldsw + _i * 8192), 16, 0, 0); } while (0)
#define PG8_LDA(dst, b, h) do { _Pragma("unroll") for (int m = 0; m < 4; ++m) _Pragma("unroll") for (int k = 0; k < 2; ++k) dst[m][k] = *(const PG8_LAS bf16x8*)(lds + PG8_SA(b, h) + aoff + m * 2048 + k * 1024); } while (0)
#define PG8_LDB(dst, b, h) do { _Pragma("unroll") for (int n = 0; n < 2; ++n) _Pragma("unroll") for (int k = 0; k < 2; ++k) dst[n][k] = *(const PG8_LAS bf16x8*)(lds + PG8_SB(b, h) + boff + n * 2048 + k * 1024); } while (0)
#define PG8_MMA(ai, bj, At, Bt) do { __builtin_amdgcn_s_setprio(1); _Pragma("unroll") for (int m = 0; m < 4; ++m) _Pragma("unroll") for (int n = 0; n < 2; ++n) _Pragma("unroll") for (int k = 0; k < 2; ++k) \
        acc[ai][bj][m][n] = __builtin_amdgcn_mfma_f32_16x16x32_bf16(Bt[n][k], At[m][k], acc[ai][bj][m][n], 0, 0, 0); __builtin_amdgcn_s_setprio(0); } while (0)
#define PG8_WAIT_V(n) asm volatile("s_waitcnt vmcnt(" #n ")" ::: "memory")
#define PG8_WAIT_L(n) asm volatile("s_waitcnt lgkmcnt(" #n ")" ::: "memory")
#define PG8_BAR __builtin_amdgcn_s_barrier()
#define PG8_SCHED __builtin_amdgcn_sched_barrier(0)
    Unit cur, nxt; int ui = 0;
    if (!S.next(0, cur)) return;
    f32x4 acc[2][2][4][2];
#pragma unroll
    for (int a = 0; a < 2; ++a)
#pragma unroll
        for (int b = 0; b < 2; ++b)
#pragma unroll
            for (int m = 0; m < 4; ++m)
#pragma unroll
                for (int n = 0; n < 2; ++n) acc[a][b][m][n] = (f32x4){0.f, 0.f, 0.f, 0.f};
    bf16x8 At[4][2], B0[2][2], B1[2][2];
    const char* cA = (const char*)g.A + (size_t)cur.pm * tstepA; const char* cB = (const char*)g.Bt + (size_t)cur.pn * tstep;
    S.a_ready(cur);
    if constexpr (SP2) {
        PG8_STAGE(PG8_SB(0, 0), cB, voffB); PG8_STAGE(PG8_SB(0, 1), cB + hstep, voffB); PG8_STAGE(PG8_SA(0, 0), cA, voffA); PG8_STAGE(PG8_SA(0, 1), cA + hstep, voffA);
        if (wr == 1) PG8_BAR;
        PG8_WAIT_V(2); PG8_BAR;
        PG8_STAGE(PG8_SB(1, 0), cB + kstep, voffB); PG8_STAGE(PG8_SA(1, 0), cA + kstep, voffA); PG8_STAGE(PG8_SB(1, 1), cB + hstep + kstep, voffB);
        PG8_WAIT_V(6); PG8_BAR;
    } else {
        PG8_STAGE(PG8_SB(0, 0), cB, voffB); PG8_STAGE(PG8_SA(0, 0), cA, voffA); PG8_STAGE(PG8_SB(0, 1), cB + hstep, voffB); PG8_STAGE(PG8_SA(0, 1), cA + hstep, voffA);
        if (wr == 1) PG8_BAR;
        PG8_WAIT_V(4); PG8_BAR;
        PG8_STAGE(PG8_SB(1, 0), cB + kstep, voffB); PG8_STAGE(PG8_SA(1, 0), cA + kstep, voffA); PG8_STAGE(PG8_SB(1, 1), cB + hstep + kstep, voffB);
        PG8_WAIT_V(6); PG8_BAR;
    }
    for (;;) {
        const bool has_next = S.next(ui + 1, nxt);
        const char* nA = has_next ? (const char*)g.A + (size_t)nxt.pm * tstepA : cA; const char* nB = has_next ? (const char*)g.Bt + (size_t)nxt.pn * tstep : cB;
        for (int t = 0; t < nt; t += 2) {
            const bool last = (t == nt - 2);
            const char* a1 = cA + (size_t)(t + 1) * kstep;
            const char* a2 = last ? nA : cA + (size_t)(t + 2) * kstep; const char* b2 = last ? nB : cB + (size_t)(t + 2) * kstep;
            const char* a3 = a2 + kstep; const char* b3 = b2 + kstep;
            if (last && has_next) S.a_ready(nxt);
            if constexpr (SP2) {
            PG8_LDB(B0, 0, 0); PG8_LDB(B1, 0, 1); PG8_SCHED; PG8_LDA(At, 0, 0); PG8_STAGE(PG8_SA(1, 1), a1 + hstep, voffA);
            PG8_WAIT_V(8); PG8_WAIT_L(0); PG8_BAR; PG8_MMA(0, 0, At, B0); PG8_MMA(0, 1, At, B1); PG8_BAR; PG8_SCHED;
            PG8_LDA(At, 0, 1); PG8_STAGE(PG8_SB(0, 0), b2, voffB); PG8_STAGE(PG8_SB(0, 1), b2 + hstep, voffB); PG8_STAGE(PG8_SA(0, 0), a2, voffA);
            PG8_WAIT_V(8); PG8_WAIT_L(0); PG8_BAR; PG8_MMA(1, 0, At, B0); PG8_MMA(1, 1, At, B1); PG8_BAR; PG8_SCHED;
            PG8_LDB(B0, 1, 0); PG8_LDB(B1, 1, 1); PG8_SCHED; PG8_LDA(At, 1, 0); PG8_STAGE(PG8_SA(0, 1), a2 + hstep, voffA);
            PG8_WAIT_V(8); PG8_WAIT_L(0); PG8_BAR; PG8_MMA(0, 0, At, B0); PG8_MMA(0, 1, At, B1); PG8_BAR; PG8_SCHED;
            PG8_LDA(At, 1, 1); PG8_STAGE(PG8_SB(1, 0), b3, voffB); PG8_STAGE(PG8_SB(1, 1), b3 + hstep, voffB); PG8_STAGE(PG8_SA(1, 0), a3, voffA);
            PG8_WAIT_V(8); PG8_WAIT_L(0); PG8_BAR; PG8_MMA(1, 0, At, B0); PG8_MMA(1, 1, At, B1); PG8_BAR; PG8_SCHED;
            } else {
            PG8_LDB(B0, 0, 0); PG8_SCHED; PG8_LDA(At, 0, 0); PG8_STAGE(PG8_SA(1, 1), a1 + hstep, voffA);
            PG8_WAIT_L(8); PG8_BAR; PG8_WAIT_L(0); PG8_MMA(0, 0, At, B0); PG8_BAR; PG8_SCHED;
            PG8_LDB(B1, 0, 1); PG8_STAGE(PG8_SB(0, 0), b2, voffB);
            PG8_BAR; PG8_WAIT_L(0); PG8_MMA(0, 1, At, B1); PG8_BAR;
            PG8_LDA(At, 0, 1); PG8_STAGE(PG8_SA(0, 0), a2, voffA);
            PG8_BAR; PG8_WAIT_L(0); PG8_MMA(1, 0, At, B0); PG8_BAR; PG8_SCHED;
            PG8_STAGE(PG8_SB(0, 1), b2 + hstep, voffB);
            PG8_WAIT_V(6); PG8_BAR; PG8_MMA(1, 1, At, B1); PG8_BAR;
            PG8_LDB(B0, 1, 0); PG8_SCHED; PG8_LDA(At, 1, 0); PG8_STAGE(PG8_SA(0, 1), a2 + hstep, voffA);
            PG8_WAIT_L(8); PG8_BAR; PG8_WAIT_L(0); PG8_MMA(0, 0, At, B0); PG8_BAR; PG8_SCHED;
            PG8_LDB(B1, 1, 1); PG8_STAGE(PG8_SB(1, 0), b3, voffB);
            PG8_BAR; PG8_WAIT_L(0); PG8_MMA(0, 1, At, B1); PG8_BAR;
            PG8_LDA(At, 1, 1); PG8_STAGE(PG8_SA(1, 0), a3, voffA);
            PG8_BAR; PG8_WAIT_L(0); PG8_MMA(1, 0, At, B0); PG8_BAR; PG8_SCHED;
            PG8_STAGE(PG8_SB(1, 1), b3 + hstep, voffB);
            PG8_WAIT_V(6); PG8_BAR; PG8_MMA(1, 1, At, B1); PG8_BAR;
            }
        }
        if constexpr (ALIGN_EPI) { if (wr == 0) PG8_BAR; }
        if constexpr (!Epi::AFTER_DRAIN) { E(acc, cur, wr, wc, fr, fq); S.done(cur); }
        if (!has_next) break;
#pragma unroll
        for (int a = 0; a < 2; ++a)
#pragma unroll
            for (int b = 0; b < 2; ++b)
#pragma unroll
                for (int m = 0; m < 4; ++m)
#pragma unroll
                    for (int n = 0; n < 2; ++n) acc[a][b][m][n] = (f32x4){0.f, 0.f, 0.f, 0.f};
        cur = nxt; cA = nA; cB = nB; ++ui;
        if constexpr (ALIGN_EPI) { if (wr == 1) PG8_BAR; }
    }
    PG8_WAIT_V(0);
    if constexpr (!ALIGN_EPI) { if (wr == 0) PG8_BAR; }
    PG8_BAR;
    if constexpr (Epi::AFTER_DRAIN) { E.fused(acc, cur, wr, wc, fr, fq, lds, wid, lane); S.done(cur); }
#undef PG8_SA
#undef PG8_SB
#undef PG8_STAGE
#undef PG8_LDA
#undef PG8_LDB
#undef PG8_MMA
#undef PG8_WAIT_V
#undef PG8_WAIT_L
#undef PG8_BAR
#undef PG8_SCHED
}
}
constexpr int S = 16384, DM = 1024, DEPTH = 4, NIN = 2816, DFF = 2816, NUP = 5632;
constexpr float EPS = 1e-6f;
constexpr int NWAVES = 8, NTHR = 512;
constexpr size_t MiB = 1u << 20;
constexpr size_t WS_WIN = 1 * MiB, WS_WOUT = 23 * MiB, WS_WUP = 31 * MiB, WS_WDN = 75 * MiB;
constexpr size_t WS_PART = 97 * MiB;
constexpr size_t WS_XB = 98 * MiB + 4096;
constexpr size_t WS_P = 131 * MiB;
constexpr size_t WS_Y = 219 * MiB;
constexpr size_t WS_GU = 131 * MiB;
constexpr size_t WS_A = 219 * MiB;
constexpr size_t WS_END = 307 * MiB;
constexpr int LDS_BYTES = 147456;
#define LAS __attribute__((address_space(3)))
typedef unsigned short bf16;
typedef unsigned v4u __attribute__((ext_vector_type(4)));
typedef unsigned v2u __attribute__((ext_vector_type(2)));
typedef float f32x4 __attribute__((ext_vector_type(4)));
typedef float f32x16 __attribute__((ext_vector_type(16)));
typedef short bf16x8 __attribute__((ext_vector_type(8)));
#define LDS_WAIT() asm volatile("s_waitcnt lgkmcnt(0)" ::: "memory")
__device__ __forceinline__ unsigned pk2(float lo, float hi) { return pg8::cvt_pk_bf16(lo, hi); }
__device__ __forceinline__ float bflo(unsigned u) { return __uint_as_float(u << 16); }
__device__ __forceinline__ float bfhi(unsigned u) { return __uint_as_float(u & 0xffff0000u); }
__device__ __forceinline__ float bf1(bf16 v) { return __uint_as_float((unsigned)v << 16); }
__device__ __forceinline__ float wave_sum(float v) {
#pragma unroll
    for (int o = 1; o < 64; o <<= 1) v += __shfl_xor(v, o);
    return v;
}

__device__ __forceinline__ void cvt_item(const float* W, int K, int N, bf16* WT, const float* gain, int mode, LAS float* scr, int item, int lane) {
    const int nblk = N / 32, kb = item / nblk, nb = item % nblk, k0 = 64 * kb, n0 = 32 * nb;
#pragma unroll 8
    for (int i = 0; i < 32; ++i) { const int kk = 2 * i + (lane >> 5); const float g = gain ? gain[k0 + kk] : 1.0f; scr[kk * 33 + (lane & 31)] = W[(size_t)(k0 + kk) * N + n0 + (lane & 31)] * g; }
    LDS_WAIT(); asm volatile("" ::: "memory");
    const float cs = (mode == 1 && n0 >= 1280 && n0 < 1792) ? 0.125f : 1.0f;
    int rb = n0;
    if (mode == 2) { rb = (n0 < DFF) ? 256 * (n0 / 128) + (n0 % 128) : 256 * ((n0 - DFF) / 128) + 128 + ((n0 - DFF) % 128); }
    const int c = lane & 7;
#pragma unroll
    for (int j = 0; j < 4; ++j) { const int n = (lane >> 3) + 8 * j; const LAS float* s = scr + (8 * c) * 33 + n;
        v4u o; o.x = pk2(s[0 * 33] * cs, s[1 * 33] * cs); o.y = pk2(s[2 * 33] * cs, s[3 * 33] * cs); o.z = pk2(s[4 * 33] * cs, s[5 * 33] * cs); o.w = pk2(s[6 * 33] * cs, s[7 * 33] * cs);
        *(v4u*)(WT + (size_t)(rb + n) * K + k0 + 8 * c) = o; }
    LDS_WAIT(); asm volatile("" ::: "memory");
}

struct Args { const float* in[14]; float* out; unsigned char* ws; };

__device__ __forceinline__ void norm_store_rows(const LAS float* tile, bf16* Y, int t0, int coff, int wave, int lane) {
#pragma unroll 2
    for (int i = 0; i < 8; ++i) { const int r = wave * 8 + i; const f32x4 v = *(const LAS f32x4*)(tile + r * 260 + lane * 4);
        const float ss = wave_sum((v[0] * v[0] + v[1] * v[1]) + (v[2] * v[2] + v[3] * v[3]));
        const float rs = __builtin_amdgcn_rsqf(ss * (1.0f / 256.0f) + EPS);
        v2u o; o.x = pk2(v[0] * rs, v[1] * rs); o.y = pk2(v[2] * rs, v[3] * rs);
        *(v2u*)(Y + (size_t)(t0 + r) * DM + coff + lane * 4) = o; }
}

__device__ __forceinline__ void mixer_unit(LAS unsigned char* lds, int unit, const bf16* P, bf16* Y, const float* conv_w, const float* sgu_norm, const float* sgu_w, const float* sgu_b, int tid, int wave, int lane) {
    const int t0 = unit * 64;
    asm volatile("" : "+v"(tid), "+v"(lane));
    LAS bf16* vnT = (LAS bf16*)lds;
    LAS float* tile = (LAS float*)(lds + 69632);
    LAS float* sm_ss = (LAS float*)(lds + 69632 + 66560);
    {
        const int hd = wave, r = lane & 31, h = lane >> 5;
        const int pr = (r & 0x13) | ((r & 4) << 1) | ((r & 8) >> 1);
        LAS bf16* Vt = (LAS bf16*)(lds + wave * 5120);
        bf16x8 atri[2];
#pragma unroll
        for (int sI = 0; sI < 2; ++sI) { v4u t;
            t.x = ((16 * sI + 8 * h + 0 > pr) ? 0x3F80u : 0u) | ((16 * sI + 8 * h + 1 > pr) ? 0x3F800000u : 0u); t.y = ((16 * sI + 8 * h + 2 > pr) ? 0x3F80u : 0u) | ((16 * sI + 8 * h + 3 > pr) ? 0x3F800000u : 0u);
            t.z = ((16 * sI + 8 * h + 4 > pr) ? 0x3F80u : 0u) | ((16 * sI + 8 * h + 5 > pr) ? 0x3F800000u : 0u); t.w = ((16 * sI + 8 * h + 6 > pr) ? 0x3F80u : 0u) | ((16 * sI + 8 * h + 7 > pr) ? 0x3F800000u : 0u);
            atri[sI] = __builtin_bit_cast(bf16x8, t); }
        f32x16 oacc[2][2]; float ssq[2];
#pragma unroll
        for (int qh = 0; qh < 2; ++qh) {
            const int tq = t0 + 32 * qh;
            bf16x8 qf[4];
#pragma unroll
            for (int ks = 0; ks < 4; ++ks) qf[ks] = *(const bf16x8*)(P + (size_t)(tq + r) * NIN + 1280 + hd * 64 + 16 * ks + 8 * h);
            f32x16 o0 = {}, o1 = {};
            float ls = 0.f;
            for (int k0 = tq; k0 >= 0; k0 -= 32) {
                const bool diag = (k0 == tq);
                const bf16* kp = P + (size_t)(k0 + pr) * NIN + 1792 + hd * 64 + 8 * h;
                f32x16 z = {};
#pragma unroll
                for (int ks = 0; ks < 4; ++ks) z = __builtin_amdgcn_mfma_f32_32x32x16_bf16(*(const bf16x8*)(kp + 16 * ks), qf[ks], z, 0, 0, 0);
#pragma unroll
                for (int i = 0; i < 4; ++i) { const int key = (lane >> 3) + 8 * i, c = lane & 7; const v4u vv = *(const v4u*)(P + (size_t)(k0 + key) * NIN + 2304 + hd * 64 + 8 * c);
                    LAS bf16* vd = Vt + (8 * c) * 40 + key;
                    vd[0] = (bf16)(vv.x & 0xffffu); vd[40] = (bf16)(vv.x >> 16); vd[80] = (bf16)(vv.y & 0xffffu); vd[120] = (bf16)(vv.y >> 16);
                    vd[160] = (bf16)(vv.z & 0xffffu); vd[200] = (bf16)(vv.z >> 16); vd[240] = (bf16)(vv.w & 0xffffu); vd[280] = (bf16)(vv.w >> 16); }
                f32x16 cin; float rowsum = 0.f; unsigned lh[8], ll[8];
#pragma unroll
                for (int j = 0; j < 16; j += 2) { float Lv[2];
#pragma unroll
                    for (int e2 = 0; e2 < 2; ++e2) { const int jj = j + e2; const int keyl = 16 * (jj >> 3) + 8 * h + (jj & 7); const bool valid = !diag || (keyl < r);
                        const float zz = z[jj]; const float ex = __expf(-fabsf(zz)); const float lsig = fminf(zz, 0.f) - __logf(1.0f + ex);
                        Lv[e2] = valid ? (lsig - zz) : 0.f; cin[jj] = lsig + ls; rowsum += Lv[e2]; }
                    const unsigned hp = pk2(Lv[0], Lv[1]); lh[j >> 1] = hp; ll[j >> 1] = pk2(Lv[0] - bflo(hp), Lv[1] - bfhi(hp)); }
                bf16x8 bh0 = __builtin_bit_cast(bf16x8, (v4u){lh[0], lh[1], lh[2], lh[3]}), bh1 = __builtin_bit_cast(bf16x8, (v4u){lh[4], lh[5], lh[6], lh[7]});
                bf16x8 bl0 = __builtin_bit_cast(bf16x8, (v4u){ll[0], ll[1], ll[2], ll[3]}), bl1 = __builtin_bit_cast(bf16x8, (v4u){ll[4], ll[5], ll[6], ll[7]});
                f32x16 lw = __builtin_amdgcn_mfma_f32_32x32x16_bf16(atri[0], bh0, cin, 0, 0, 0);
                lw = __builtin_amdgcn_mfma_f32_32x32x16_bf16(atri[1], bh1, lw, 0, 0, 0);
                lw = __builtin_amdgcn_mfma_f32_32x32x16_bf16(atri[0], bl0, lw, 0, 0, 0);
                lw = __builtin_amdgcn_mfma_f32_32x32x16_bf16(atri[1], bl1, lw, 0, 0, 0);
                unsigned wp[8];
#pragma unroll
                for (int j = 0; j < 16; j += 2) { float wv[2];
#pragma unroll
                    for (int e2 = 0; e2 < 2; ++e2) { const int jj = j + e2; const int keyl = 16 * (jj >> 3) + 8 * h + (jj & 7); const bool valid = !diag || (keyl < r);
                        wv[e2] = valid ? __expf(lw[jj]) : 0.f; }
                    wp[j >> 1] = pk2(wv[0], wv[1]); }
                const bf16x8 w0 = __builtin_bit_cast(bf16x8, (v4u){wp[0], wp[1], wp[2], wp[3]}), w1 = __builtin_bit_cast(bf16x8, (v4u){wp[4], wp[5], wp[6], wp[7]});
                const LAS bf16* vr = Vt + r * 40 + 8 * h;
                o0 = __builtin_amdgcn_mfma_f32_32x32x16_bf16(*(const LAS bf16x8*)(vr), w0, o0, 0, 0, 0);
                o0 = __builtin_amdgcn_mfma_f32_32x32x16_bf16(*(const LAS bf16x8*)(vr + 16), w1, o0, 0, 0, 0);
                o1 = __builtin_amdgcn_mfma_f32_32x32x16_bf16(*(const LAS bf16x8*)(vr + 32 * 40), w0, o1, 0, 0, 0);
                o1 = __builtin_amdgcn_mfma_f32_32x32x16_bf16(*(const LAS bf16x8*)(vr + 32 * 40 + 16), w1, o1, 0, 0, 0);
                ls += rowsum + __shfl_xor(rowsum, 32);
                if (__builtin_amdgcn_ballot_w64(ls > -104.0f) == 0ull) break;
            }
            float ss = 0.f;
#pragma unroll
            for (int j = 0; j < 16; ++j) ss += o0[j] * o0[j] + o1[j] * o1[j];
            ss += __shfl_xor(ss, 32);
            if (h == 0) sm_ss[(32 * qh + r) * 8 + hd] = ss;
            oacc[qh][0] = o0; oacc[qh][1] = o1; ssq[qh] = ss;
        }
        LDS_WAIT(); __syncthreads();
#pragma unroll
        for (int qh = 0; qh < 2; ++qh) {
            const f32x4 sa = *(const LAS f32x4*)(sm_ss + (32 * qh + r) * 8), sb = *(const LAS f32x4*)(sm_ss + (32 * qh + r) * 8 + 4);
            const float tot = ((sa[0] + sa[1]) + (sa[2] + sa[3])) + ((sb[0] + sb[1]) + (sb[2] + sb[3]));
            const float rs = __builtin_amdgcn_rsqf(tot * (1.0f / 512.0f) + EPS);
            bf16* yp = Y + (size_t)(t0 + 32 * qh + r) * DM + 512 + hd * 64 + 4 * h;
#pragma unroll
            for (int db = 0; db < 2; ++db)
#pragma unroll
                for (int g4 = 0; g4 < 4; ++g4) { const f32x16& o = oacc[qh][db]; v2u w; w.x = pk2(o[4 * g4 + 0] * rs, o[4 * g4 + 1] * rs); w.y = pk2(o[4 * g4 + 2] * rs, o[4 * g4 + 3] * rs);
                    *(v2u*)(yp + 32 * db + 8 * g4) = w; }
        }
    }
    {
        const int c = tid & 255, rh = tid >> 8, tb = t0 + 32 * rh;
        const float w0 = conv_w[c], w1 = conv_w[256 + c], w2 = conv_w[512 + c];
        float p2 = 0.f, p1 = 0.f;
        if (tb >= 2) { const bf16* r2 = P + (size_t)(tb - 2) * NIN; const bf16* r1 = P + (size_t)(tb - 1) * NIN; p2 = bf1(r2[256 + c]) * bf1(r2[512 + c]); p1 = bf1(r1[256 + c]) * bf1(r1[512 + c]); }
#pragma unroll 4
        for (int r = 0; r < 32; ++r) { const bf16* rp = P + (size_t)(tb + r) * NIN; const float p0 = bf1(rp[256 + c]) * bf1(rp[512 + c]);
            tile[(32 * rh + r) * 260 + c] = bf1(rp[c]) * (w0 * p2 + w1 * p1 + w2 * p0); p2 = p1; p1 = p0; }
    }
    LDS_WAIT(); __syncthreads();
    norm_store_rows(tile, Y, t0, 0, wave, lane);
    const int tc = t0 & ~127, dt = t0 - tc, ns = dt + 64;
    for (int s = wave; s < ns; s += 8) { const v2u u = *(const v2u*)(P + (size_t)(tc + s) * NIN + 1024 + lane * 4);
        const float v0 = bflo(u.x), v1 = bfhi(u.x), v2 = bflo(u.y), v3 = bfhi(u.y);
        const float ss = wave_sum((v0 * v0 + v1 * v1) + (v2 * v2 + v3 * v3)); const float rs = __builtin_amdgcn_rsqf(ss * (1.0f / 256.0f) + EPS);
        const f32x4 g = *(const f32x4*)(sgu_norm + lane * 4);
        const unsigned a = pk2(v0 * rs * g[0], v1 * rs * g[1]), b = pk2(v2 * rs * g[2], v3 * rs * g[3]);
        vnT[(lane * 4 + 0) * 136 + s] = (bf16)(a & 0xffffu); vnT[(lane * 4 + 1) * 136 + s] = (bf16)(a >> 16); vnT[(lane * 4 + 2) * 136 + s] = (bf16)(b & 0xffffu); vnT[(lane * 4 + 3) * 136 + s] = (bf16)(b >> 16); }
    LDS_WAIT(); __syncthreads();
    {
        const int h = wave >> 1, rh = wave & 1, r32 = lane & 31, hi = lane >> 5;
        const int tcl = dt + 32 * rh + r32;
        const float* wrow = sgu_w + ((size_t)h * 128 + tcl) * 128;
        f32x16 o0 = {}, o1 = {};
        const int nk = (dt + 32 * rh + 32) >> 4;
        for (int ks = 0; ks < nk; ++ks) { const int s0 = ks * 16 + 8 * hi;
            const f32x4 wa = *(const f32x4*)(wrow + s0), wb = *(const f32x4*)(wrow + s0 + 4);
            float wv[8] = {wa[0], wa[1], wa[2], wa[3], wb[0], wb[1], wb[2], wb[3]};
#pragma unroll
            for (int i = 0; i < 8; ++i) wv[i] = (s0 + i <= tcl) ? wv[i] : 0.f;
            v4u ap; ap.x = pk2(wv[0], wv[1]); ap.y = pk2(wv[2], wv[3]); ap.z = pk2(wv[4], wv[5]); ap.w = pk2(wv[6], wv[7]);
            const bf16x8 af = __builtin_bit_cast(bf16x8, ap);
            const bf16x8 b0 = *(const LAS bf16x8*)(vnT + (h * 64 + r32) * 136 + s0), b1 = *(const LAS bf16x8*)(vnT + (h * 64 + 32 + r32) * 136 + s0);
            o0 = __builtin_amdgcn_mfma_f32_32x32x16_bf16(af, b0, o0, 0, 0, 0);
            o1 = __builtin_amdgcn_mfma_f32_32x32x16_bf16(af, b1, o1, 0, 0, 0); }
#pragma unroll
        for (int j = 0; j < 16; ++j) { const int rl = 32 * rh + (j & 3) + 8 * (j >> 2) + 4 * hi;
            const float bb = sgu_b[h * 128 + dt + rl]; const bf16* up = P + (size_t)(t0 + rl) * NIN + 768 + h * 64;
            tile[rl * 260 + h * 64 + r32] = bf1(up[r32]) * (o0[j] + bb);
            tile[rl * 260 + h * 64 + 32 + r32] = bf1(up[32 + r32]) * (o1[j] + bb); }
    }
    LDS_WAIT(); __syncthreads();
    norm_store_rows(tile, Y, t0, 256, wave, lane);
    LDS_WAIT(); __syncthreads();
}

__device__ __forceinline__ void ffn_gate_phase(const bf16* GU, bf16* A, const float* fconv, int hf, int gtid, int gthreads) {
    for (int it = gtid; it < 256 * 176; it += gthreads) { const int rb = it / 176, cgp = it % 176, pnl = cgp >> 4, cc = (cgp & 15) * 8, ch = 1408 * hf + 128 * pnl + cc;
        float wg[3][8], wu[3][8];
#pragma unroll
        for (int i = 0; i < 3; ++i) { const f32x4 a0 = *(const f32x4*)(fconv + (size_t)i * NUP + ch), a1 = *(const f32x4*)(fconv + (size_t)i * NUP + ch + 4), b0 = *(const f32x4*)(fconv + (size_t)i * NUP + DFF + ch), b1 = *(const f32x4*)(fconv + (size_t)i * NUP + DFF + ch + 4);
#pragma unroll
            for (int e = 0; e < 4; ++e) { wg[i][e] = a0[e]; wg[i][4 + e] = a1[e]; wu[i][e] = b0[e]; wu[i][4 + e] = b1[e]; } }
        float g2[8], g1[8], u2[8], u1[8];
#pragma unroll
        for (int e = 0; e < 8; ++e) { g2[e] = g1[e] = u2[e] = u1[e] = 0.f; }
        for (int r = -2; r < 64; ++r) { const int t = 64 * rb + r; float g0[8], u0[8];
            if (t >= 0) { const v4u gv = *(const v4u*)(GU + (size_t)t * NIN + 256 * pnl + cc), uv = *(const v4u*)(GU + (size_t)t * NIN + 256 * pnl + 128 + cc);
                g0[0] = bflo(gv.x); g0[1] = bfhi(gv.x); g0[2] = bflo(gv.y); g0[3] = bfhi(gv.y); g0[4] = bflo(gv.z); g0[5] = bfhi(gv.z); g0[6] = bflo(gv.w); g0[7] = bfhi(gv.w);
                u0[0] = bflo(uv.x); u0[1] = bfhi(uv.x); u0[2] = bflo(uv.y); u0[3] = bfhi(uv.y); u0[4] = bflo(uv.z); u0[5] = bfhi(uv.z); u0[6] = bflo(uv.w); u0[7] = bfhi(uv.w); }
            else {
#pragma unroll
                for (int e = 0; e < 8; ++e) { g0[e] = 0.f; u0[e] = 0.f; } }
            if (r >= 0) { float o[8];
#pragma unroll
                for (int e = 0; e < 8; ++e) { const float G = wg[0][e] * g2[e] + wg[1][e] * g1[e] + wg[2][e] * g0[e], U = wu[0][e] * u2[e] + wu[1][e] * u1[e] + wu[2][e] * u0[e];
                    o[e] = G * __builtin_amdgcn_rcpf(1.0f + __expf(-G)) * U; }
                v4u ov; ov.x = pk2(o[0], o[1]); ov.y = pk2(o[2], o[3]); ov.z = pk2(o[4], o[5]); ov.w = pk2(o[6], o[7]);
                *(v4u*)(A + (size_t)t * DFF + ch) = ov; }
#pragma unroll
            for (int e = 0; e < 8; ++e) { g2[e] = g1[e]; g1[e] = g0[e]; u2[e] = u1[e]; u1[e] = u0[e]; } }
    }
}
__global__ void __launch_bounds__(NTHR, 2) hybrid_fwd(Args args) {
    extern __shared__ __attribute__((aligned(16))) unsigned char lds_raw[];
    LAS unsigned char* lds = (LAS unsigned char*)lds_raw;
    cg::grid_group grid = cg::this_grid();
    const int tid = threadIdx.x, lane = tid & 63, wave = __builtin_amdgcn_readfirstlane(tid >> 6);
    const int G = gridDim.x, bx = blockIdx.x;
    const int gw = bx * NWAVES + wave, NGW = G * NWAVES;
    unsigned char* ws = args.ws;
    const float* x_in = args.in[0]; const float* norm_mix = args.in[1]; const float* w_in = args.in[2]; const float* conv_w = args.in[3];
    const float* sgu_norm = args.in[4]; const float* sgu_w = args.in[5]; const float* sgu_b = args.in[6]; const float* out_norm = args.in[7];
    const float* w_out = args.in[8]; const float* norm_ffn = args.in[9]; const float* w_up = args.in[10]; const float* ffn_conv = args.in[11];
    const float* w_down = args.in[12]; const float* norm_final = args.in[13];
    float* xcur = args.out;
    bf16* Win_t = (bf16*)(ws + WS_WIN); bf16* Wout_t = (bf16*)(ws + WS_WOUT); bf16* Wup_t = (bf16*)(ws + WS_WUP); bf16* Wdn_t = (bf16*)(ws + WS_WDN);
    float* part = (float*)(ws + WS_PART); bf16* XB = (bf16*)(ws + WS_XB); bf16* P = (bf16*)(ws + WS_P); bf16* Y = (bf16*)(ws + WS_Y);
    bf16* GU = (bf16*)(ws + WS_GU); bf16* A = (bf16*)(ws + WS_A);

    {
        LAS float* scr = (LAS float*)(lds + wave * 16384);
        constexpr int I_IN = 16 * 88, I_OUT = 16 * 32, I_UP = 16 * 176, I_DN = 44 * 32, I_L = I_IN + I_OUT + I_UP + I_DN;
        for (int it = gw; it < DEPTH * I_L; it += NGW) { const int l = it / I_L; int r = it % I_L;
            if (r < I_IN) { cvt_item(w_in + (size_t)l * DM * NIN, DM, NIN, Win_t + (size_t)l * NIN * DM, norm_mix + l * DM, 1, scr, r, lane); continue; } r -= I_IN;
            if (r < I_OUT) { cvt_item(w_out + (size_t)l * DM * DM, DM, DM, Wout_t + (size_t)l * DM * DM, out_norm + l * DM, 0, scr, r, lane); continue; } r -= I_OUT;
            if (r < I_UP) { cvt_item(w_up + (size_t)l * DM * NUP, DM, NUP, Wup_t + (size_t)l * NUP * DM, norm_ffn + l * DM, 2, scr, r, lane); continue; } r -= I_UP;
            cvt_item(w_down + (size_t)l * DFF * DM, DFF, DM, Wdn_t + (size_t)l * DM * DFF, nullptr, 0, scr, r, lane); }
        for (int m = gw; m < S; m += NGW) { const f32x4* xr = (const f32x4*)(x_in + (size_t)m * DM) + lane; f32x4 v[4]; float ss = 0.f;
#pragma unroll
            for (int j = 0; j < 4; ++j) { v[j] = xr[64 * j]; ss += (v[j][0] * v[j][0] + v[j][1] * v[j][1]) + (v[j][2] * v[j][2] + v[j][3] * v[j][3]); }
            ss = wave_sum(ss);
            v2u* o8 = (v2u*)(XB + (size_t)m * DM) + lane;
#pragma unroll
            for (int j = 0; j < 4; ++j) { v2u o; o.x = pk2(v[j][0], v[j][1]); o.y = pk2(v[j][2], v[j][3]); o8[64 * j] = o; }
            if (lane < 16) part[(size_t)m * 16 + lane] = lane == 0 ? ss : 0.f; }
    }
    grid.sync();

    for (int l = 0; l < DEPTH; ++l) {
        { pg8::Gemm g{XB, Win_t + (size_t)l * NIN * DM, S, NIN, DM, 256}; pg8::StaticOrder So; So.init(S, NIN, G, bx);
          pg8::EpiScaleBf16 E{P, NIN, part};
          pg8::gemm_phase<pg8::EpiScaleBf16, pg8::StaticOrder, true, true>(lds, g, So, E); }
        grid.sync();
        for (int u = bx; u < S / 64; u += G)
            mixer_unit(lds, u, P, Y, conv_w + l * 3 * 256, sgu_norm + l * 256, sgu_w + (size_t)l * 4 * 128 * 128, sgu_b + l * 4 * 128, tid, wave, lane);
        grid.sync();
        { pg8::Gemm g{Y, Wout_t + (size_t)l * DM * DM, S, DM, DM, 256}; pg8::StaticOrder So; So.init(S, DM, G, bx);
          pg8::EpiResid E{l == 0 ? x_in : xcur, xcur, XB, part};
          pg8::gemm_phase<pg8::EpiResid, pg8::StaticOrder, true, true>(lds, g, So, E); }
        grid.sync();
        { pg8::Gemm g{XB - 2 * DM, Wup_t + (size_t)l * NUP * DM, 65 * 256, NUP, DM, 254}; pg8::StaticOrder So; So.init(65 * 256, NUP, G, bx);
          pg8::EpiGate E{A, part, ffn_conv + (size_t)l * 3 * NUP, (LAS float*)(lds + 131072)};
          pg8::gemm_phase<pg8::EpiGate, pg8::StaticOrder, true, true>(lds, g, So, E); }
        grid.sync();
        { pg8::Gemm g{A, Wdn_t + (size_t)l * DM * DFF, S, DM, DFF, 256}; pg8::StaticOrder So; So.init(S, DM, G, bx);
          pg8::EpiResid E{xcur, xcur, XB, part};
          pg8::gemm_phase<pg8::EpiResid, pg8::StaticOrder, true, true>(lds, g, So, E); }
        grid.sync();
    }
    for (int m = gw; m < S; m += NGW) { f32x4* xr = (f32x4*)(xcur + (size_t)m * DM) + lane; f32x4 v[4]; float ss = 0.f;
#pragma unroll
        for (int j = 0; j < 4; ++j) { v[j] = xr[64 * j]; ss += (v[j][0] * v[j][0] + v[j][1] * v[j][1]) + (v[j][2] * v[j][2] + v[j][3] * v[j][3]); }
        const float rs = __builtin_amdgcn_rsqf(wave_sum(ss) * (1.0f / 1024.0f) + EPS);
#pragma unroll
        for (int j = 0; j < 4; ++j) { const f32x4 g = *((const f32x4*)norm_final + lane + 64 * j); xr[64 * j] = v[j] * rs * g; } }
}

extern "C" void kernel_launch(void* const* d_in, const int* in_sizes, int n_in, void* d_out, int out_size, void* d_ws, size_t ws_size, hipStream_t stream) {
    static int grid = 0;
    if (grid == 0) {
        if (n_in != 14 || out_size != S * DM || ws_size < WS_END) { fprintf(stderr, "kernel_launch: unexpected shapes / workspace (%d inputs, out %d, ws %zu)\n", n_in, out_size, ws_size); grid = -1; return; }
        int dev = 0, cus = 0, per_cu = 0;
        hipGetDevice(&dev); hipDeviceGetAttribute(&cus, hipDeviceAttributeMultiprocessorCount, dev);
        hipFuncSetAttribute((const void*)hybrid_fwd, hipFuncAttributeMaxDynamicSharedMemorySize, LDS_BYTES);
        hipOccupancyMaxActiveBlocksPerMultiprocessor(&per_cu, (const void*)hybrid_fwd, NTHR, LDS_BYTES);
        (void)hipGetLastError();
        if (per_cu < 1) per_cu = 1;
        grid = cus * 1;
    }
    if (grid < 0) return;
    hipMemsetAsync((unsigned char*)d_ws + WS_XB - 4096, 0, 4096, stream);
    Args a{};
    for (int i = 0; i < 14; ++i) a.in[i] = (const float*)d_in[i];
    a.out = (float*)d_out; a.ws = (unsigned char*)d_ws;
    void* kargs[] = {&a};
    hipError_t e = hipLaunchCooperativeKernel((const void*)hybrid_fwd, dim3(grid), dim3(NTHR), kargs, LDS_BYTES, stream);
    if (e != hipSuccess) fprintf(stderr, "cooperative launch failed: %s (grid %d)\n", hipGetErrorString(e), grid);
}
```

```cpp
#include <hip/hip_runtime.h>
#include <hip/hip_cooperative_groups.h>
#include <cstdio>
#include <cstdint>
namespace cg = cooperative_groups;
namespace pg8 {
#define PG8_LAS __attribute__((address_space(3)))
typedef unsigned short bf16_t;
typedef short bf16x8 __attribute__((ext_vector_type(8)));
typedef float f32x4 __attribute__((ext_vector_type(4)));
typedef unsigned u32x4 __attribute__((ext_vector_type(4)));
typedef unsigned u32x2 __attribute__((ext_vector_type(2)));
constexpr int BM = 256, BK = 64, HALF = 128, HTB = HALF * BK * 2  , STAGE_BYTES = 8 * HTB, NXCD = 8, WGM = 8;

__host__ __device__ __forceinline__ int lds_byte(int r, int c) { const int st = (r >> 4) * 2 + (c >> 5), rr = r & 15, cc = c & 31, ob = rr * 64 + cc * 2; return st * 1024 + (ob ^ (((ob >> 9) & 1) << 5)); }
__host__ __device__ __forceinline__ void stage_rc(int b, int& R, int& C) { const int st = b / 1024, sb = b % 1024, swz = sb ^ (((sb >> 9) & 1) << 5); R = (st >> 1) * 16 + swz / 64; C = (st & 1) * 32 + (swz % 64) / 2; }
__host__ __device__ __forceinline__ int perm32(int rho) { const int n = rho >> 4, i = rho & 15; return 8 * (i >> 2) + 4 * n + (i & 3); }

struct Unit { int pm, pn; };
struct Gemm { const bf16_t* A; const bf16_t* Bt; int M, N, K; int arows; };

struct StaticOrder {
    int nM, nN, nwg, G, c;
    __host__ __device__ void init(int M, int N, int G_, int c_) { nM = M / BM; nN = N / BM; nwg = nM * nN; G = G_; c = c_; }
    __host__ __device__ bool next(int i, Unit& u) const {
        const long L = (long)i * G + c; if (L >= nwg) return false;
        int wgid = (int)L; { const int q = nwg / NXCD, r = nwg % NXCD, xcd = wgid % NXCD, off = wgid / NXCD; wgid = (xcd < r ? xcd * (q + 1) : r * (q + 1) + (xcd - r) * q) + off; }
        const int nig = WGM * nN, gid = wgid / nig, fm = gid * WGM, gsz = (nM - fm) < WGM ? (nM - fm) : WGM;
        u.pm = fm + ((wgid % nig) % gsz); u.pn = (wgid % nig) / gsz; return true;
    }
    __device__ __forceinline__ void a_ready(const Unit&) const {}
    __device__ __forceinline__ void done(const Unit&) const {}
};

__device__ __forceinline__ unsigned cvt_pk_bf16(float lo, float hi) { unsigned r; asm volatile("v_cvt_pk_bf16_f32 %0, %1, %2" : "=v"(r) : "v"(lo), "v"(hi)); return r; }
struct EpiScaleBf16 {
    static constexpr bool PERM = true, AFTER_DRAIN = false;
    bf16_t* O; int ldc; const float* part;
    __device__ __forceinline__ void operator()(const f32x4 (&acc)[2][2][4][2], const Unit& u, int wr, int wc, int fr, int fq) const {
        const int row0 = u.pm * BM + wr * 64 + fr; const int col0 = u.pn * BM + wc * 32 + 8 * fq;
#pragma unroll
        for (int ai = 0; ai < 2; ++ai)
#pragma unroll
            for (int m = 0; m < 4; ++m) { const int row = row0 + ai * HALF + m * 16;
                const f32x4* pp = (const f32x4*)(part + (size_t)row * 16); const f32x4 a = pp[0], b = pp[1], c = pp[2], d = pp[3];
                const f32x4 s4 = (a + b) + (c + d); const float ss = (s4[0] + s4[1]) + (s4[2] + s4[3]);
                const float rs = __builtin_amdgcn_rsqf(ss * (1.0f / 1024.0f) + 1e-6f);
                bf16_t* rowp = O + (size_t)row * ldc + col0;
#pragma unroll
                for (int bj = 0; bj < 2; ++bj) { const f32x4 v0 = acc[ai][bj][m][0] * rs, v1 = acc[ai][bj][m][1] * rs;
                    u32x4 w; w.x = cvt_pk_bf16(v0[0], v0[1]); w.y = cvt_pk_bf16(v0[2], v0[3]); w.z = cvt_pk_bf16(v1[0], v1[1]); w.w = cvt_pk_bf16(v1[2], v1[3]);
                    *(u32x4*)(rowp + bj * HALF) = w; }
                if (m & 1) asm volatile("" ::: "memory"); }
    }
};
struct EpiResid {
    static constexpr bool PERM = true, AFTER_DRAIN = false;
    const float* base; float* out; bf16_t* xb; float* part;
    __device__ __forceinline__ void operator()(const f32x4 (&acc)[2][2][4][2], const Unit& u, int wr, int wc, int fr, int fq) const {
        const int row0 = u.pm * BM + wr * 64 + fr; const int col0 = u.pn * BM + wc * 32 + 8 * fq;
#pragma unroll
        for (int ai = 0; ai < 2; ++ai)
#pragma unroll
            for (int m = 0; m < 4; ++m) { const int row = row0 + ai * HALF + m * 16; const size_t off = (size_t)row * 1024 + col0; float ss = 0.f;
#pragma unroll
                for (int bj = 0; bj < 2; ++bj) { const f32x4 b0 = *(const f32x4*)(base + off + bj * HALF), b1 = *(const f32x4*)(base + off + bj * HALF + 4);
                    const f32x4 v0 = acc[ai][bj][m][0] + b0, v1 = acc[ai][bj][m][1] + b1;
                    *(f32x4*)(out + off + bj * HALF) = v0; *(f32x4*)(out + off + bj * HALF + 4) = v1;
                    ss += (v0[0] * v0[0] + v0[1] * v0[1]) + (v0[2] * v0[2] + v0[3] * v0[3]) + (v1[0] * v1[0] + v1[1] * v1[1]) + (v1[2] * v1[2] + v1[3] * v1[3]);
                    u32x4 w; w.x = cvt_pk_bf16(v0[0], v0[1]); w.y = cvt_pk_bf16(v0[2], v0[3]); w.z = cvt_pk_bf16(v1[0], v1[1]); w.w = cvt_pk_bf16(v1[2], v1[3]);
                    *(u32x4*)(xb + off + bj * HALF) = w; }
                ss += __shfl_xor(ss, 16); ss += __shfl_xor(ss, 32);
                if (fq == 0) part[(size_t)row * 16 + u.pn * 4 + wc] = ss;
                asm volatile("" ::: "memory"); }
    }
};
#define PG8_DPP(oldv, srcv, ctrl) __builtin_bit_cast(float, __builtin_amdgcn_update_dpp(__builtin_bit_cast(int, (float)(oldv)), __builtin_bit_cast(int, (float)(srcv)), (ctrl), 0xf, 0xf, false))
struct EpiGate {
    static constexpr bool PERM = true, AFTER_DRAIN = false;
    bf16_t* Aout; const float* part; const float* fconv; PG8_LAS float* xch;
    __device__ __forceinline__ void operator()(f32x4 (&acc)[2][2][4][2], const Unit& u, int wr, int wc, int fr, int fq) const {
        const int rbase = u.pm * 254 - 2 + wr * 64 + fr;
        const int ccol = wc * 32 + 8 * fq;
#pragma unroll
        for (int ai = 0; ai < 2; ++ai)
#pragma unroll
            for (int m = 0; m < 4; ++m) { const int row = rbase + ai * HALF + m * 16; const bool ok = row >= 0 && row < 16384; const int rc = ok ? row : 0;
                const f32x4* pp = (const f32x4*)(part + (size_t)rc * 16); const f32x4 a = pp[0], b = pp[1], c = pp[2], d = pp[3];
                const f32x4 s4 = (a + b) + (c + d); const float ss = (s4[0] + s4[1]) + (s4[2] + s4[3]);
                const float rs = ok ? __builtin_amdgcn_rsqf(ss * (1.0f / 1024.0f) + 1e-6f) : 0.f;
#pragma unroll
                for (int bj = 0; bj < 2; ++bj) { acc[ai][bj][m][0] *= rs; acc[ai][bj][m][1] *= rs; }
                asm volatile("" : "+v"(acc[ai][0][m][0]), "+v"(acc[ai][0][m][1]), "+v"(acc[ai][1][m][0]), "+v"(acc[ai][1][m][1]) :: "memory"); }
        if (fr >= 14) {
#pragma unroll
            for (int ai = 0; ai < 2; ++ai)
#pragma unroll
                for (int bj = 0; bj < 2; ++bj)
#pragma unroll
                    for (int n = 0; n < 2; ++n) *(PG8_LAS f32x4*)(xch + ((2 * ai + wr) * 2 + (fr & 1)) * 256 + bj * HALF + ccol + 4 * n) = acc[ai][bj][3][n];
        }
        asm volatile("s_waitcnt lgkmcnt(0)" ::: "memory"); __builtin_amdgcn_s_barrier(); asm volatile("" ::: "memory");
        const int ch0 = u.pn * HALF + ccol;
#pragma unroll
        for (int ai = 0; ai < 2; ++ai) {
            const int grp = 2 * ai + wr;
#pragma unroll
            for (int n = 0; n < 2; ++n) {
                asm volatile("" ::: "memory");
                const float* fw = fconv + ch0 + 4 * n;
                const f32x4 wg0 = *(const f32x4*)(fw), wg1 = *(const f32x4*)(fw + 5632), wg2 = *(const f32x4*)(fw + 2 * 5632);
                const f32x4 wu0 = *(const f32x4*)(fw + 2816), wu1 = *(const f32x4*)(fw + 5632 + 2816), wu2 = *(const f32x4*)(fw + 2 * 5632 + 2816);
                f32x4 xpg = {0.f, 0.f, 0.f, 0.f}, xpu = {0.f, 0.f, 0.f, 0.f};
                if (grp > 0) { xpg = *(const PG8_LAS f32x4*)(xch + ((grp - 1) * 2 + (fr & 1)) * 256 + ccol + 4 * n); xpu = *(const PG8_LAS f32x4*)(xch + ((grp - 1) * 2 + (fr & 1)) * 256 + HALF + ccol + 4 * n); }
#pragma unroll
                for (int m = 0; m < 4; ++m) {
                    float o[4];
#pragma unroll
                    for (int j = 0; j < 4; ++j) {
                        const float xg = acc[ai][0][m][n][j], xu = acc[ai][1][m][n][j];
                        const float pg = m > 0 ? acc[ai][0][m > 0 ? m - 1 : 0][n][j] : xpg[j], pu = m > 0 ? acc[ai][1][m > 0 ? m - 1 : 0][n][j] : xpu[j];
                        const float g1 = PG8_DPP(PG8_DPP(0.f, pg, 0x121), xg, 0x111), g2 = PG8_DPP(PG8_DPP(0.f, pg, 0x122), xg, 0x112);
                        const float u1 = PG8_DPP(PG8_DPP(0.f, pu, 0x121), xu, 0x111), u2 = PG8_DPP(PG8_DPP(0.f, pu, 0x122), xu, 0x112);
                        const float Gv = wg0[j] * g2 + wg1[j] * g1 + wg2[j] * xg, Uv = wu0[j] * u2 + wu1[j] * u1 + wu2[j] * xu;
                        o[j] = Gv * __builtin_amdgcn_rcpf(1.0f + __expf(-Gv)) * Uv; }
                    const int r = ai * HALF + wr * 64 + m * 16 + fr, row = u.pm * 254 - 2 + r;
                    u32x2 w; w.x = cvt_pk_bf16(o[0], o[1]); w.y = cvt_pk_bf16(o[2], o[3]);
                    if (r >= 2 && row < 16384) *(u32x2*)(Aout + (size_t)row * 2816 + ch0 + 4 * n) = w; }
            }
        }
    }
};
template <class Epi, class Sched, bool ALIGN_EPI = false, bool SP2 = false>
__device__ __forceinline__ void gemm_phase(PG8_LAS unsigned char* lds, const Gemm g, const Sched& S, const Epi& E) {
    int tid = threadIdx.x; asm volatile("" : "+v"(tid));
    const int wid = __builtin_amdgcn_readfirstlane(tid >> 6), lane = tid & 63, wr = wid >> 2, wc = wid & 3, fr = lane & 15, fq = lane >> 4;
    const int K = g.K, nt = K / BK;
    unsigned voffA[2], voffB[2];
#pragma unroll
    for (int i = 0; i < 2; ++i) { int R, C; stage_rc(tid * 16 + i * 8192, R, C); const int Rb = Epi::PERM ? ((R & ~31) + perm32(R & 31)) : R;
        voffA[i] = (unsigned)(R * K + C) * 2u; voffB[i] = (unsigned)(Rb * K + C) * 2u; }
    const size_t kstep = (size_t)(BK * 2);
    const size_t hstep = (size_t)HALF * K * 2;
    const size_t tstep = 2 * hstep;
    const size_t tstepA = (size_t)g.arows * K * 2;
    const unsigned ldsw = (unsigned)wid * 1024u;
    const int aoff = lds_byte(wr * 64 + fr, fq * 8), boff = lds_byte(wc * 32 + fr, fq * 8);
#define PG8_SA(b, h) (((b) * 2 + (h)) * HTB)
#define PG8_SB(b, h) ((4 + (b) * 2 + (h)) * HTB)
#define PG8_STAGE(bufoff, gbase, voff) do { _Pragma("unroll") for (int _i = 0; _i < 2; ++_i) \
        __builtin_amdgcn_global_load_lds((const unsigned*)((const char*)(gbase) + (voff)[_i]), (PG8_LAS unsigned*)(lds + (bufoff) + ldsw + _i * 8192), 16, 0, 0); } while (0)
#define PG8_LDA(dst, b, h) do { _Pragma("unroll") for (int m = 0; m < 4; ++m) _Pragma("unroll") for (int k = 0; k < 2; ++k) dst[m][k] = *(const PG8_LAS bf16x8*)(lds + PG8_SA(b, h) + aoff + m * 2048 + k * 1024); } while (0)
#define PG8_LDB(dst, b, h) do { _Pragma("unroll") for (int n = 0; n < 2; ++n) _Pragma("unroll") for (int k = 0; k < 2; ++k) dst[n][k] = *(const PG8_LAS bf16x8*)(lds + PG8_SB(b, h) + boff + n * 2048 + k * 1024); } while (0)
#define PG8_MMA(ai, bj, At, Bt) do { __builtin_amdgcn_s_setprio(1); _Pragma("unroll") for (int m = 0; m < 4; ++m) _Pragma("unroll") for (int n = 0; n < 2; ++n) _Pragma("unroll") for (int k = 0; k < 2; ++k) \
        acc[ai][bj][m][n] = __builtin_amdgcn_mfma_f32_16x16x32_bf16(Bt[n][k], At[m][k], acc[ai][bj][m][n], 0, 0, 0); __builtin_amdgcn_s_setprio(0); } while (0)
#define PG8_WAIT_V(n) asm volatile("s_waitcnt vmcnt(" #n ")" ::: "memory")
#define PG8_WAIT_L(n) asm volatile("s_waitcnt lgkmcnt(" #n ")" ::: "memory")
#define PG8_BAR __builtin_amdgcn_s_barrier()
#define PG8_SCHED __builtin_amdgcn_sched_barrier(0)
    Unit cur, nxt; int ui = 0;
    if (!S.next(0, cur)) return;
    f32x4 acc[2][2][4][2];
#pragma unroll
    for (int a = 0; a < 2; ++a)
#pragma unroll
        for (int b = 0; b < 2; ++b)
#pragma unroll
            for (int m = 0; m < 4; ++m)
#pragma unroll
                for (int n = 0; n < 2; ++n) acc[a][b][m][n] = (f32x4){0.f, 0.f, 0.f, 0.f};
    bf16x8 At[4][2], B0[2][2], B1[2][2];
    const char* cA = (const char*)g.A + (size_t)cur.pm * tstepA; const char* cB = (const char*)g.Bt + (size_t)cur.pn * tstep;
    S.a_ready(cur);
    if constexpr (SP2) {
        PG8_STAGE(PG8_SB(0, 0), cB, voffB); PG8_STAGE(PG8_SB(0, 1), cB + hstep, voffB); PG8_STAGE(PG8_SA(0, 0), cA, voffA); PG8_STAGE(PG8_SA(0, 1), cA + hstep, voffA);
        if (wr == 1) PG8_BAR;
        PG8_WAIT_V(2); PG8_BAR;
        PG8_STAGE(PG8_SB(1, 0), cB + kstep, voffB); PG8_STAGE(PG8_SA(1, 0), cA + kstep, voffA); PG8_STAGE(PG8_SB(1, 1), cB + hstep + kstep, voffB);
        PG8_WAIT_V(6); PG8_BAR;
    } else {
        PG8_STAGE(PG8_SB(0, 0), cB, voffB); PG8_STAGE(PG8_SA(0, 0), cA, voffA); PG8_STAGE(PG8_SB(0, 1), cB + hstep, voffB); PG8_STAGE(PG8_SA(0, 1), cA + hstep, voffA);
        if (wr == 1) PG8_BAR;
        PG8_WAIT_V(4); PG8_BAR;
        PG8_STAGE(PG8_SB(1, 0), cB + kstep, voffB); PG8_STAGE(PG8_SA(1, 0), cA + kstep, voffA); PG8_STAGE(PG8_SB(1, 1), cB + hstep + kstep, voffB);
        PG8_WAIT_V(6); PG8_BAR;
    }
    for (;;) {
        const bool has_next = S.next(ui + 1, nxt);
        const char* nA = has_next ? (const char*)g.A + (size_t)nxt.pm * tstepA : cA; const char* nB = has_next ? (const char*)g.Bt + (size_t)nxt.pn * tstep : cB;
        for (int t = 0; t < nt; t += 2) {
            const bool last = (t == nt - 2);
            const char* a1 = cA + (size_t)(t + 1) * kstep;
            const char* a2 = last ? nA : cA + (size_t)(t + 2) * kstep; const char* b2 = last ? nB : cB + (size_t)(t + 2) * kstep;
            const char* a3 = a2 + kstep; const char* b3 = b2 + kstep;
            if (last && has_next) S.a_ready(nxt);
            if constexpr (SP2) {
            PG8_LDB(B0, 0, 0); PG8_LDB(B1, 0, 1); PG8_SCHED; PG8_LDA(At, 0, 0); PG8_STAGE(PG8_SA(1, 1), a1 + hstep, voffA);
            PG8_WAIT_V(8); PG8_WAIT_L(0); PG8_BAR; PG8_MMA(0, 0, At, B0); PG8_MMA(0, 1, At, B1); PG8_BAR; PG8_SCHED;
            PG8_LDA(At, 0, 1); PG8_STAGE(PG8_SB(0, 0), b2, voffB); PG8_STAGE(PG8_SB(0, 1), b2 + hstep, voffB); PG8_STAGE(PG8_SA(0, 0), a2, voffA);
            PG8_WAIT_V(8); PG8_WAIT_L(0); PG8_BAR; PG8_MMA(1, 0, At, B0); PG8_MMA(1, 1, At, B1); PG8_BAR; PG8_SCHED;
            PG8_LDB(B0, 1, 0); PG8_LDB(B1, 1, 1); PG8_SCHED; PG8_LDA(At, 1, 0); PG8_STAGE(PG8_SA(0, 1), a2 + hstep, voffA);
            PG8_WAIT_V(8); PG8_WAIT_L(0); PG8_BAR; PG8_MMA(0, 0, At, B0); PG8_MMA(0, 1, At, B1); PG8_BAR; PG8_SCHED;
            PG8_LDA(At, 1, 1); PG8_STAGE(PG8_SB(1, 0), b3, voffB); PG8_STAGE(PG8_SB(1, 1), b3 + hstep, voffB); PG8_STAGE(PG8_SA(1, 0), a3, voffA);
            PG8_WAIT_V(8); PG8_WAIT_L(0); PG8_BAR; PG8_MMA(1, 0, At, B0); PG8_MMA(1, 1, At, B1); PG8_BAR; PG8_SCHED;
            } else {
            PG8_LDB(B0, 0, 0); PG8_SCHED; PG8_LDA(At, 0, 0); PG8_STAGE(PG8_SA(1, 1), a1 + hstep, voffA);
            PG8_WAIT_L(8); PG8_BAR; PG8_WAIT_L(0); PG8_MMA(0, 0, At, B0); PG8_BAR; PG8_SCHED;
            PG8_LDB(B1, 0, 1); PG8_STAGE(PG8_SB(0, 0), b2, voffB);
            PG8_BAR; PG8_WAIT_L(0); PG8_MMA(0, 1, At, B1); PG8_BAR;
            PG8_LDA(At, 0, 1); PG8_STAGE(PG8_SA(0, 0), a2, voffA);
            PG8_BAR; PG8_WAIT_L(0); PG8_MMA(1, 0, At, B0); PG8_BAR; PG8_SCHED;
            PG8_STAGE(PG8_SB(0, 1), b2 + hstep, voffB);
            PG8_WAIT_V(6); PG8_BAR; PG8_MMA(1, 1, At, B1); PG8_BAR;
            PG8_LDB(B0, 1, 0); PG8_SCHED; PG8_LDA(At, 1, 0); PG8_STAGE(PG8_SA(0, 1), a2 + hstep, voffA);
            PG8_WAIT_L(8); PG8_BAR; PG8_WAIT_L(0); PG8_MMA(0, 0, At, B0); PG8_BAR; PG8_SCHED;
            PG8_LDB(B1, 1, 1); PG8_STAGE(PG8_SB(1, 0), b3, voffB);
            PG8_BAR; PG8_WAIT_L(0); PG8_MMA(0, 1, At, B1); PG8_BAR;
            PG8_LDA(At, 1, 1); PG8_STAGE(PG8_SA(1, 0), a3, voffA);
            PG8_BAR; PG8_WAIT_L(0); PG8_MMA(1, 0, At, B0); PG8_BAR; PG8_SCHED;
            PG8_STAGE(PG8_SB(1, 1), b3 + hstep, voffB);
            PG8_WAIT_V(6); PG8_BAR; PG8_MMA(1, 1, At, B1); PG8_BAR;
            }
        }
        if constexpr (ALIGN_EPI) { if (wr == 0) PG8_BAR; }
        if constexpr (!Epi::AFTER_DRAIN) { E(acc, cur, wr, wc, fr, fq); S.done(cur); }
        if (!has_next) break;
#pragma unroll
        for (int a = 0; a < 2; ++a)
#pragma unroll
            for (int b = 0; b < 2; ++b)
#pragma unroll
                for (int m = 0; m < 4; ++m)
#pragma unroll
                    for (int n = 0; n < 2; ++n) acc[a][b][m][n] = (f32x4){0.f, 0.f, 0.f, 0.f};
        cur = nxt; cA = nA; cB = nB; ++ui;
        if constexpr (ALIGN_EPI) { if (wr == 1) PG8_BAR; }
    }
    PG8_WAIT_V(0);
    if constexpr (!ALIGN_EPI) { if (wr == 0) PG8_BAR; }
    PG8_BAR;
    if constexpr (Epi::AFTER_DRAIN) { E.fused(acc, cur, wr, wc, fr, fq, lds, wid, lane); S.done(cur); }
#undef PG8_SA
#undef PG8_SB
#undef PG8_STAGE
#undef PG8_LDA
#undef PG8_LDB
#undef PG8_MMA
#undef PG8_WAIT_V
#undef PG8_WAIT_L
#undef PG8_BAR
#undef PG8_SCHED
}
}
constexpr int S = 16384, DM = 1024, DEPTH = 4, NIN = 2816, DFF = 2816, NUP = 5632;
constexpr float EPS = 1e-6f;
constexpr int NWAVES = 8, NTHR = 512;
constexpr size_t MiB = 1u << 20;
constexpr size_t WS_WIN = 1 * MiB, WS_WOUT = 23 * MiB, WS_WUP = 31 * MiB, WS_WDN = 75 * MiB;
constexpr size_t WS_PART = 97 * MiB;
constexpr size_t WS_XB = 98 * MiB + 4096;
constexpr size_t WS_P = 131 * MiB;
constexpr size_t WS_Y = 219 * MiB;
constexpr size_t WS_GU = 131 * MiB;
constexpr size_t WS_A = 219 * MiB;
constexpr size_t WS_END = 307 * MiB;
constexpr int LDS_BYTES = 147456;
#define LAS __attribute__((address_space(3)))
typedef unsigned short bf16;
typedef unsigned v4u __attribute__((ext_vector_type(4)));
typedef unsigned v2u __attribute__((ext_vector_type(2)));
typedef float f32x4 __attribute__((ext_vector_type(4)));
typedef float f32x16 __attribute__((ext_vector_type(16)));
typedef short bf16x8 __attribute__((ext_vector_type(8)));
#define LDS_WAIT() asm volatile("s_waitcnt lgkmcnt(0)" ::: "memory")
__device__ __forceinline__ unsigned pk2(float lo, float hi) { return pg8::cvt_pk_bf16(lo, hi); }
__device__ __forceinline__ float bflo(unsigned u) { return __uint_as_float(u << 16); }
__device__ __forceinline__ float bfhi(unsigned u) { return __uint_as_float(u & 0xffff0000u); }
__device__ __forceinline__ float bf1(bf16 v) { return __uint_as_float((unsigned)v << 16); }
__device__ __forceinline__ float wave_sum(float v) {
#pragma unroll
    for (int o = 1; o < 64; o <<= 1) v += __shfl_xor(v, o);
    return v;
}

__device__ __forceinline__ void cvt_item(const float* W, int K, int N, bf16* WT, const float* gain, int mode, LAS float* scr, int item, int lane) {
    const int nblk = N / 32, kb = item / nblk, nb = item % nblk, k0 = 64 * kb, n0 = 32 * nb;
#pragma unroll 8
    for (int i = 0; i < 32; ++i) { const int kk = 2 * i + (lane >> 5); const float g = gain ? gain[k0 + kk] : 1.0f; scr[kk * 33 + (lane & 31)] = W[(size_t)(k0 + kk) * N + n0 + (lane & 31)] * g; }
    LDS_WAIT(); asm volatile("" ::: "memory");
    const float cs = (mode == 1 && n0 >= 1280 && n0 < 1792) ? 0.125f : 1.0f;
    int rb = n0;
    if (mode == 2) { rb = (n0 < DFF) ? 256 * (n0 / 128) + (n0 % 128) : 256 * ((n0 - DFF) / 128) + 128 + ((n0 - DFF) % 128); }
    const int c = lane & 7;
#pragma unroll
    for (int j = 0; j < 4; ++j) { const int n = (lane >> 3) + 8 * j; const LAS float* s = scr + (8 * c) * 33 + n;
        v4u o; o.x = pk2(s[0 * 33] * cs, s[1 * 33] * cs); o.y = pk2(s[2 * 33] * cs, s[3 * 33] * cs); o.z = pk2(s[4 * 33] * cs, s[5 * 33] * cs); o.w = pk2(s[6 * 33] * cs, s[7 * 33] * cs);
        *(v4u*)(WT + (size_t)(rb + n) * K + k0 + 8 * c) = o; }
    LDS_WAIT(); asm volatile("" ::: "memory");
}

typedef __attribute__((address_space(1))) unsigned gu32;
#define XB_TMO      128
#define XB_XCNT(j)  (256  + 64 * (j))
#define XB_XSUB(j)  (1280 + 64 * (j))
#define XB_XGEN(j)  (2304 + 64 * (j))
#define XB_TOP      3328
#define XB_TOPGEN   3392
#define XCD_BAR_WORDS 3456
#define XB_SPIN_CAP (1u << 18)

__device__ __forceinline__ unsigned xb_ld(unsigned* p)              { return __hip_atomic_load(p, __ATOMIC_RELAXED, __HIP_MEMORY_SCOPE_AGENT); }
__device__ __forceinline__ unsigned xb_add(unsigned* p, unsigned v) { return __hip_atomic_fetch_add(p, v, __ATOMIC_RELAXED, __HIP_MEMORY_SCOPE_AGENT); }
__device__ __forceinline__ unsigned xb_xcc_id() { return (unsigned)__builtin_amdgcn_s_getreg((3 << 11) | 20) & 0xFu; }
#define XB_SPIN(cond, bar) do { unsigned _sp = 0; while (cond) { __builtin_amdgcn_s_sleep(1); \
    if ((++_sp & 255u) == 0u) { if (xb_ld(&(bar)[XB_TMO])) break; if (_sp > XB_SPIN_CAP) { atomicAdd(&(bar)[XB_TMO], 1u); break; } } } } while (0)

struct XcdBarrier {
    unsigned* bar; unsigned x;
    volatile LAS unsigned* st;
};

__device__ __forceinline__ XcdBarrier xcd_barrier_post(unsigned* bar, volatile LAS unsigned* st) {
    XcdBarrier b; b.bar = bar; b.x = xb_xcc_id(); b.st = st;
    if (threadIdx.x == 0) (void)xb_add(&bar[XB_XCNT(b.x)], 1u);
    return b;
}
__device__ __forceinline__ void xcd_barrier_complete(unsigned* bar, unsigned x, unsigned& nloc, unsigned& nx) {
    const unsigned G = gridDim.x * gridDim.y * gridDim.z;
    unsigned sum, cnt, mine, sp = 0u;
    for (;;) {
        sum = 0u; cnt = 0u; mine = 0u;
#pragma unroll
        for (unsigned j = 0; j < 16; ++j) { const unsigned c = xb_ld(&bar[XB_XCNT(j)]); sum += c; cnt += (c > 0u) ? 1u : 0u; mine = (j == x) ? c : mine; }
        if (sum == G) break;
        __builtin_amdgcn_s_sleep(1);
        if ((++sp & 255u) == 0u) { if (xb_ld(&bar[XB_TMO])) break; if (sp > XB_SPIN_CAP) { atomicAdd(&bar[XB_TMO], 1u); break; } }
    }
    nloc = mine > 0u ? mine : 1u; nx = cnt > 0u ? cnt : 1u;
}

__device__ __forceinline__ void xcd_barrier(const XcdBarrier& b) {
    asm volatile("s_waitcnt vmcnt(0)" ::: "memory");
    __syncthreads();
    if (threadIdx.x == 0) {
        unsigned* bar = b.bar;
        __builtin_amdgcn_s_waitcnt(0);
        unsigned nloc = b.st[0], nx = b.st[1];
        if (nloc == 0u) { xcd_barrier_complete(bar, b.x, nloc, nx); b.st[0] = nloc; b.st[1] = nx; }
        const unsigned old = xb_add(&bar[XB_XSUB(b.x)], 1u);
        const unsigned gen = old / nloc;
        if (old + 1u == (gen + 1u) * nloc) {
            __builtin_amdgcn_fence(__ATOMIC_RELEASE, "agent");
            asm volatile("s_waitcnt vmcnt(0)" ::: "memory");
            const unsigned og = xb_add(&bar[XB_TOP], 1u);
            const unsigned tg = og / nx;
            if (og + 1u == (tg + 1u) * nx) xb_add(&bar[XB_TOPGEN], 1u);
            else XB_SPIN(xb_ld(&bar[XB_TOPGEN]) == tg, bar);
            __builtin_amdgcn_fence(__ATOMIC_ACQUIRE, "agent");
            xb_add(&bar[XB_XGEN(b.x)], 1u);
            asm volatile("s_waitcnt vmcnt(0)" ::: "memory");
        } else {
            XB_SPIN(xb_ld(&bar[XB_XGEN(b.x)]) == gen, bar);
            __builtin_amdgcn_fence(__ATOMIC_ACQUIRE, "agent");
            asm volatile("s_waitcnt vmcnt(0)" ::: "memory");
        }
    }
    __syncthreads();
}

struct Args { const float* in[14]; float* out; unsigned char* ws; };

__device__ __forceinline__ void norm_store_rows(const LAS float* tile, bf16* Y, int t0, int coff, int wave, int lane) {
#pragma unroll 2
    for (int i = 0; i < 8; ++i) { const int r = wave * 8 + i; const f32x4 v = *(const LAS f32x4*)(tile + r * 260 + lane * 4);
        const float ss = wave_sum((v[0] * v[0] + v[1] * v[1]) + (v[2] * v[2] + v[3] * v[3]));
        const float rs = __builtin_amdgcn_rsqf(ss * (1.0f / 256.0f) + EPS);
        v2u o; o.x = pk2(v[0] * rs, v[1] * rs); o.y = pk2(v[2] * rs, v[3] * rs);
        *(v2u*)(Y + (size_t)(t0 + r) * DM + coff + lane * 4) = o; }
}

__device__ __forceinline__ void mixer_unit(LAS unsigned char* lds, int unit, const bf16* P, bf16* Y, const float* conv_w, const float* sgu_norm, const float* sgu_w, const float* sgu_b, int tid, int wave, int lane) {
    const int t0 = unit * 64;
    asm volatile("" : "+v"(tid), "+v"(lane));
    LAS bf16* vnT = (LAS bf16*)lds;
    LAS float* tile = (LAS float*)(lds + 69632);
    LAS float* sm_ss = (LAS float*)(lds + 69632 + 66560);
    {
        const int hd = wave, r = lane & 31, h = lane >> 5;
        const int pr = (r & 0x13) | ((r & 4) << 1) | ((r & 8) >> 1);
        LAS bf16* Vt = (LAS bf16*)(lds + wave * 5120);
        bf16x8 atri[2];
#pragma unroll
        for (int sI = 0; sI < 2; ++sI) { v4u t;
            t.x = ((16 * sI + 8 * h + 0 > pr) ? 0x3F80u : 0u) | ((16 * sI + 8 * h + 1 > pr) ? 0x3F800000u : 0u); t.y = ((16 * sI + 8 * h + 2 > pr) ? 0x3F80u : 0u) | ((16 * sI + 8 * h + 3 > pr) ? 0x3F800000u : 0u);
            t.z = ((16 * sI + 8 * h + 4 > pr) ? 0x3F80u : 0u) | ((16 * sI + 8 * h + 5 > pr) ? 0x3F800000u : 0u); t.w = ((16 * sI + 8 * h + 6 > pr) ? 0x3F80u : 0u) | ((16 * sI + 8 * h + 7 > pr) ? 0x3F800000u : 0u);
            atri[sI] = __builtin_bit_cast(bf16x8, t); }
        f32x16 oacc[2][2]; float ssq[2];
#pragma unroll
        for (int qh = 0; qh < 2; ++qh) {
            const int tq = t0 + 32 * qh;
            bf16x8 qf[4];
#pragma unroll
            for (int ks = 0; ks < 4; ++ks) qf[ks] = *(const bf16x8*)(P + (size_t)(tq + r) * NIN + 1280 + hd * 64 + 16 * ks + 8 * h);
            f32x16 o0 = {}, o1 = {};
            float ls = 0.f;
            for (int k0 = tq; k0 >= 0; k0 -= 32) {
                const bool diag = (k0 == tq);
                const bf16* kp = P + (size_t)(k0 + pr) * NIN + 1792 + hd * 64 + 8 * h;
                f32x16 z = {};
#pragma unroll
                for (int ks = 0; ks < 4; ++ks) z = __builtin_amdgcn_mfma_f32_32x32x16_bf16(*(const bf16x8*)(kp + 16 * ks), qf[ks], z, 0, 0, 0);
#pragma unroll
                for (int i = 0; i < 4; ++i) { const int key = (lane >> 3) + 8 * i, c = lane & 7; const v4u vv = *(const v4u*)(P + (size_t)(k0 + key) * NIN + 2304 + hd * 64 + 8 * c);
                    LAS bf16* vd = Vt + (8 * c) * 40 + key;
                    vd[0] = (bf16)(vv.x & 0xffffu); vd[40] = (bf16)(vv.x >> 16); vd[80] = (bf16)(vv.y & 0xffffu); vd[120] = (bf16)(vv.y >> 16);
                    vd[160] = (bf16)(vv.z & 0xffffu); vd[200] = (bf16)(vv.z >> 16); vd[240] = (bf16)(vv.w & 0xffffu); vd[280] = (bf16)(vv.w >> 16); }
                f32x16 cin; float rowsum = 0.f; unsigned lh[8], ll[8];
#pragma unroll
                for (int j = 0; j < 16; j += 2) { float Lv[2];
#pragma unroll
                    for (int e2 = 0; e2 < 2; ++e2) { const int jj = j + e2; const int keyl = 16 * (jj >> 3) + 8 * h + (jj & 7); const bool valid = !diag || (keyl < r);
                        const float zz = z[jj]; const float ex = __expf(-fabsf(zz)); const float lsig = fminf(zz, 0.f) - __logf(1.0f + ex);
                        Lv[e2] = valid ? (lsig - zz) : 0.f; cin[jj] = lsig + ls; rowsum += Lv[e2]; }
                    const unsigned hp = pk2(Lv[0], Lv[1]); lh[j >> 1] = hp; ll[j >> 1] = pk2(Lv[0] - bflo(hp), Lv[1] - bfhi(hp)); }
                bf16x8 bh0 = __builtin_bit_cast(bf16x8, (v4u){lh[0], lh[1], lh[2], lh[3]}), bh1 = __builtin_bit_cast(bf16x8, (v4u){lh[4], lh[5], lh[6], lh[7]});
                bf16x8 bl0 = __builtin_bit_cast(bf16x8, (v4u){ll[0], ll[1], ll[2], ll[3]}), bl1 = __builtin_bit_cast(bf16x8, (v4u){ll[4], ll[5], ll[6], ll[7]});
                f32x16 lw = __builtin_amdgcn_mfma_f32_32x32x16_bf16(atri[0], bh0, cin, 0, 0, 0);
                lw = __builtin_amdgcn_mfma_f32_32x32x16_bf16(atri[1], bh1, lw, 0, 0, 0);
                lw = __builtin_amdgcn_mfma_f32_32x32x16_bf16(atri[0], bl0, lw, 0, 0, 0);
                lw = __builtin_amdgcn_mfma_f32_32x32x16_bf16(atri[1], bl1, lw, 0, 0, 0);
                unsigned wp[8];
#pragma unroll
                for (int j = 0; j < 16; j += 2) { float wv[2];
#pragma unroll
                    for (int e2 = 0; e2 < 2; ++e2) { const int jj = j + e2; const int keyl = 16 * (jj >> 3) + 8 * h + (jj & 7); const bool valid = !diag || (keyl < r);
                        wv[e2] = valid ? __expf(lw[jj]) : 0.f; }
                    wp[j >> 1] = pk2(wv[0], wv[1]); }
                const bf16x8 w0 = __builtin_bit_cast(bf16x8, (v4u){wp[0], wp[1], wp[2], wp[3]}), w1 = __builtin_bit_cast(bf16x8, (v4u){wp[4], wp[5], wp[6], wp[7]});
                const LAS bf16* vr = Vt + r * 40 + 8 * h;
                o0 = __builtin_amdgcn_mfma_f32_32x32x16_bf16(*(const LAS bf16x8*)(vr), w0, o0, 0, 0, 0);
                o0 = __builtin_amdgcn_mfma_f32_32x32x16_bf16(*(const LAS bf16x8*)(vr + 16), w1, o0, 0, 0, 0);
                o1 = __builtin_amdgcn_mfma_f32_32x32x16_bf16(*(const LAS bf16x8*)(vr + 32 * 40), w0, o1, 0, 0, 0);
                o1 = __builtin_amdgcn_mfma_f32_32x32x16_bf16(*(const LAS bf16x8*)(vr + 32 * 40 + 16), w1, o1, 0, 0, 0);
                ls += rowsum + __shfl_xor(rowsum, 32);
                if (__builtin_amdgcn_ballot_w64(ls > -104.0f) == 0ull) break;
            }
            float ss = 0.f;
#pragma unroll
            for (int j = 0; j < 16; ++j) ss += o0[j] * o0[j] + o1[j] * o1[j];
            ss += __shfl_xor(ss, 32);
            if (h == 0) sm_ss[(32 * qh + r) * 8 + hd] = ss;
            oacc[qh][0] = o0; oacc[qh][1] = o1; ssq[qh] = ss;
        }
        LDS_WAIT(); __syncthreads();
#pragma unroll
        for (int qh = 0; qh < 2; ++qh) {
            const f32x4 sa = *(const LAS f32x4*)(sm_ss + (32 * qh + r) * 8), sb = *(const LAS f32x4*)(sm_ss + (32 * qh + r) * 8 + 4);
            const float tot = ((sa[0] + sa[1]) + (sa[2] + sa[3])) + ((sb[0] + sb[1]) + (sb[2] + sb[3]));
            const float rs = __builtin_amdgcn_rsqf(tot * (1.0f / 512.0f) + EPS);
            bf16* yp = Y + (size_t)(t0 + 32 * qh + r) * DM + 512 + hd * 64 + 4 * h;
#pragma unroll
            for (int db = 0; db < 2; ++db)
#pragma unroll
                for (int g4 = 0; g4 < 4; ++g4) { const f32x16& o = oacc[qh][db]; v2u w; w.x = pk2(o[4 * g4 + 0] * rs, o[4 * g4 + 1] * rs); w.y = pk2(o[4 * g4 + 2] * rs, o[4 * g4 + 3] * rs);
                    *(v2u*)(yp + 32 * db + 8 * g4) = w; }
        }
    }
    {
        const int c = tid & 255, rh = tid >> 8, tb = t0 + 32 * rh;
        const float w0 = conv_w[c], w1 = conv_w[256 + c], w2 = conv_w[512 + c];
        float p2 = 0.f, p1 = 0.f;
        if (tb >= 2) { const bf16* r2 = P + (size_t)(tb - 2) * NIN; const bf16* r1 = P + (size_t)(tb - 1) * NIN; p2 = bf1(r2[256 + c]) * bf1(r2[512 + c]); p1 = bf1(r1[256 + c]) * bf1(r1[512 + c]); }
#pragma unroll 4
        for (int r = 0; r < 32; ++r) { const bf16* rp = P + (size_t)(tb + r) * NIN; const float p0 = bf1(rp[256 + c]) * bf1(rp[512 + c]);
            tile[(32 * rh + r) * 260 + c] = bf1(rp[c]) * (w0 * p2 + w1 * p1 + w2 * p0); p2 = p1; p1 = p0; }
    }
    LDS_WAIT(); __syncthreads();
    norm_store_rows(tile, Y, t0, 0, wave, lane);
    const int tc = t0 & ~127, dt = t0 - tc, ns = dt + 64;
    for (int s = wave; s < ns; s += 8) { const v2u u = *(const v2u*)(P + (size_t)(tc + s) * NIN + 1024 + lane * 4);
        const float v0 = bflo(u.x), v1 = bfhi(u.x), v2 = bflo(u.y), v3 = bfhi(u.y);
        const float ss = wave_sum((v0 * v0 + v1 * v1) + (v2 * v2 + v3 * v3)); const float rs = __builtin_amdgcn_rsqf(ss * (1.0f / 256.0f) + EPS);
        const f32x4 g = *(const f32x4*)(sgu_norm + lane * 4);
        const unsigned a = pk2(v0 * rs * g[0], v1 * rs * g[1]), b = pk2(v2 * rs * g[2], v3 * rs * g[3]);
        vnT[(lane * 4 + 0) * 136 + s] = (bf16)(a & 0xffffu); vnT[(lane * 4 + 1) * 136 + s] = (bf16)(a >> 16); vnT[(lane * 4 + 2) * 136 + s] = (bf16)(b & 0xffffu); vnT[(lane * 4 + 3) * 136 + s] = (bf16)(b >> 16); }
    LDS_WAIT(); __syncthreads();
    {
        const int h = wave >> 1, rh = wave & 1, r32 = lane & 31, hi = lane >> 5;
        const int tcl = dt + 32 * rh + r32;
        const float* wrow = sgu_w + ((size_t)h * 128 + tcl) * 128;
        f32x16 o0 = {}, o1 = {};
        const int nk = (dt + 32 * rh + 32) >> 4;
        for (int ks = 0; ks < nk; ++ks) { const int s0 = ks * 16 + 8 * hi;
            const f32x4 wa = *(const f32x4*)(wrow + s0), wb = *(const f32x4*)(wrow + s0 + 4);
            float wv[8] = {wa[0], wa[1], wa[2], wa[3], wb[0], wb[1], wb[2], wb[3]};
#pragma unroll
            for (int i = 0; i < 8; ++i) wv[i] = (s0 + i <= tcl) ? wv[i] : 0.f;
            v4u ap; ap.x = pk2(wv[0], wv[1]); ap.y = pk2(wv[2], wv[3]); ap.z = pk2(wv[4], wv[5]); ap.w = pk2(wv[6], wv[7]);
            const bf16x8 af = __builtin_bit_cast(bf16x8, ap);
            const bf16x8 b0 = *(const LAS bf16x8*)(vnT + (h * 64 + r32) * 136 + s0), b1 = *(const LAS bf16x8*)(vnT + (h * 64 + 32 + r32) * 136 + s0);
            o0 = __builtin_amdgcn_mfma_f32_32x32x16_bf16(af, b0, o0, 0, 0, 0);
            o1 = __builtin_amdgcn_mfma_f32_32x32x16_bf16(af, b1, o1, 0, 0, 0); }
#pragma unroll
        for (int j = 0; j < 16; ++j) { const int rl = 32 * rh + (j & 3) + 8 * (j >> 2) + 4 * hi;
            const float bb = sgu_b[h * 128 + dt + rl]; const bf16* up = P + (size_t)(t0 + rl) * NIN + 768 + h * 64;
            tile[rl * 260 + h * 64 + r32] = bf1(up[r32]) * (o0[j] + bb);
            tile[rl * 260 + h * 64 + 32 + r32] = bf1(up[32 + r32]) * (o1[j] + bb); }
    }
    LDS_WAIT(); __syncthreads();
    norm_store_rows(tile, Y, t0, 256, wave, lane);
    LDS_WAIT(); __syncthreads();
}

__device__ __forceinline__ void ffn_gate_phase(const bf16* GU, bf16* A, const float* fconv, int hf, int gtid, int gthreads) {
    for (int it = gtid; it < 256 * 176; it += gthreads) { const int rb = it / 176, cgp = it % 176, pnl = cgp >> 4, cc = (cgp & 15) * 8, ch = 1408 * hf + 128 * pnl + cc;
        float wg[3][8], wu[3][8];
#pragma unroll
        for (int i = 0; i < 3; ++i) { const f32x4 a0 = *(const f32x4*)(fconv + (size_t)i * NUP + ch), a1 = *(const f32x4*)(fconv + (size_t)i * NUP + ch + 4), b0 = *(const f32x4*)(fconv + (size_t)i * NUP + DFF + ch), b1 = *(const f32x4*)(fconv + (size_t)i * NUP + DFF + ch + 4);
#pragma unroll
            for (int e = 0; e < 4; ++e) { wg[i][e] = a0[e]; wg[i][4 + e] = a1[e]; wu[i][e] = b0[e]; wu[i][4 + e] = b1[e]; } }
        float g2[8], g1[8], u2[8], u1[8];
#pragma unroll
        for (int e = 0; e < 8; ++e) { g2[e] = g1[e] = u2[e] = u1[e] = 0.f; }
        for (int r = -2; r < 64; ++r) { const int t = 64 * rb + r; float g0[8], u0[8];
            if (t >= 0) { const v4u gv = *(const v4u*)(GU + (size_t)t * NIN + 256 * pnl + cc), uv = *(const v4u*)(GU + (size_t)t * NIN + 256 * pnl + 128 + cc);
                g0[0] = bflo(gv.x); g0[1] = bfhi(gv.x); g0[2] = bflo(gv.y); g0[3] = bfhi(gv.y); g0[4] = bflo(gv.z); g0[5] = bfhi(gv.z); g0[6] = bflo(gv.w); g0[7] = bfhi(gv.w);
                u0[0] = bflo(uv.x); u0[1] = bfhi(uv.x); u0[2] = bflo(uv.y); u0[3] = bfhi(uv.y); u0[4] = bflo(uv.z); u0[5] = bfhi(uv.z); u0[6] = bflo(uv.w); u0[7] = bfhi(uv.w); }
            else {
#pragma unroll
                for (int e = 0; e < 8; ++e) { g0[e] = 0.f; u0[e] = 0.f; } }
            if (r >= 0) { float o[8];
#pragma unroll
                for (int e = 0; e < 8; ++e) { const float G = wg[0][e] * g2[e] + wg[1][e] * g1[e] + wg[2][e] * g0[e], U = wu[0][e] * u2[e] + wu[1][e] * u1[e] + wu[2][e] * u0[e];
                    o[e] = G * __builtin_amdgcn_rcpf(1.0f + __expf(-G)) * U; }
                v4u ov; ov.x = pk2(o[0], o[1]); ov.y = pk2(o[2], o[3]); ov.z = pk2(o[4], o[5]); ov.w = pk2(o[6], o[7]);
                *(v4u*)(A + (size_t)t * DFF + ch) = ov; }
#pragma unroll
            for (int e = 0; e < 8; ++e) { g2[e] = g1[e]; g1[e] = g0[e]; u2[e] = u1[e]; u1[e] = u0[e]; } }
    }
}
__global__ void __launch_bounds__(NTHR, 2) hybrid_fwd(Args args) {
    extern __shared__ __attribute__((aligned(16))) unsigned char lds_raw[];
    LAS unsigned char* lds = (LAS unsigned char*)lds_raw;
    cg::grid_group grid = cg::this_grid();
    volatile LAS unsigned* MISC = (volatile LAS unsigned*)(lds + LDS_BYTES - 64);
    if (threadIdx.x < 16) MISC[threadIdx.x] = 0u;
    __syncthreads();
    XcdBarrier xbar = xcd_barrier_post((unsigned*)args.ws, MISC);
    const int tid = threadIdx.x, lane = tid & 63, wave = __builtin_amdgcn_readfirstlane(tid >> 6);
    const int G = gridDim.x, bx = blockIdx.x;
    const int gw = bx * NWAVES + wave, NGW = G * NWAVES;
    unsigned char* ws = args.ws;
    const float* x_in = args.in[0]; const float* norm_mix = args.in[1]; const float* w_in = args.in[2]; const float* conv_w = args.in[3];
    const float* sgu_norm = args.in[4]; const float* sgu_w = args.in[5]; const float* sgu_b = args.in[6]; const float* out_norm = args.in[7];
    const float* w_out = args.in[8]; const float* norm_ffn = args.in[9]; const float* w_up = args.in[10]; const float* ffn_conv = args.in[11];
    const float* w_down = args.in[12]; const float* norm_final = args.in[13];
    float* xcur = args.out;
    bf16* Win_t = (bf16*)(ws + WS_WIN); bf16* Wout_t = (bf16*)(ws + WS_WOUT); bf16* Wup_t = (bf16*)(ws + WS_WUP); bf16* Wdn_t = (bf16*)(ws + WS_WDN);
    float* part = (float*)(ws + WS_PART); bf16* XB = (bf16*)(ws + WS_XB); bf16* P = (bf16*)(ws + WS_P); bf16* Y = (bf16*)(ws + WS_Y);
    bf16* GU = (bf16*)(ws + WS_GU); bf16* A = (bf16*)(ws + WS_A);

    {
        LAS float* scr = (LAS float*)(lds + wave * 16384);
        constexpr int I_IN = 16 * 88, I_OUT = 16 * 32, I_UP = 16 * 176, I_DN = 44 * 32, I_L = I_IN + I_OUT + I_UP + I_DN;
        for (int it = gw; it < DEPTH * I_L; it += NGW) { const int l = it / I_L; int r = it % I_L;
            if (r < I_IN) { cvt_item(w_in + (size_t)l * DM * NIN, DM, NIN, Win_t + (size_t)l * NIN * DM, norm_mix + l * DM, 1, scr, r, lane); continue; } r -= I_IN;
            if (r < I_OUT) { cvt_item(w_out + (size_t)l * DM * DM, DM, DM, Wout_t + (size_t)l * DM * DM, out_norm + l * DM, 0, scr, r, lane); continue; } r -= I_OUT;
            if (r < I_UP) { cvt_item(w_up + (size_t)l * DM * NUP, DM, NUP, Wup_t + (size_t)l * NUP * DM, norm_ffn + l * DM, 2, scr, r, lane); continue; } r -= I_UP;
            cvt_item(w_down + (size_t)l * DFF * DM, DFF, DM, Wdn_t + (size_t)l * DM * DFF, nullptr, 0, scr, r, lane); }
        for (int m = gw; m < S; m += NGW) { const f32x4* xr = (const f32x4*)(x_in + (size_t)m * DM) + lane; f32x4 v[4]; float ss = 0.f;
#pragma unroll
            for (int j = 0; j < 4; ++j) { v[j] = xr[64 * j]; ss += (v[j][0] * v[j][0] + v[j][1] * v[j][1]) + (v[j][2] * v[j][2] + v[j][3] * v[j][3]); }
            ss = wave_sum(ss);
            v2u* o8 = (v2u*)(XB + (size_t)m * DM) + lane;
#pragma unroll
            for (int j = 0; j < 4; ++j) { v2u o; o.x = pk2(v[j][0], v[j][1]); o.y = pk2(v[j][2], v[j][3]); o8[64 * j] = o; }
            if (lane < 16) part[(size_t)m * 16 + lane] = lane == 0 ? ss : 0.f; }
    }
    grid.sync();

    for (int l = 0; l < DEPTH; ++l) {
        { pg8::Gemm g{XB, Win_t + (size_t)l * NIN * DM, S, NIN, DM, 256}; pg8::StaticOrder So; So.init(S, NIN, G, bx);
          pg8::EpiScaleBf16 E{P, NIN, part};
          pg8::gemm_phase<pg8::EpiScaleBf16, pg8::StaticOrder, true, true>(lds, g, So, E); }
        xcd_barrier(xbar);
        for (int u = bx; u < S / 64; u += G)
            mixer_unit(lds, u, P, Y, conv_w + l * 3 * 256, sgu_norm + l * 256, sgu_w + (size_t)l * 4 * 128 * 128, sgu_b + l * 4 * 128, tid, wave, lane);
        xcd_barrier(xbar);
        { pg8::Gemm g{Y, Wout_t + (size_t)l * DM * DM, S, DM, DM, 256}; pg8::StaticOrder So; So.init(S, DM, G, bx);
          pg8::EpiResid E{l == 0 ? x_in : xcur, xcur, XB, part};
          pg8::gemm_phase<pg8::EpiResid, pg8::StaticOrder, true, true>(lds, g, So, E); }
        xcd_barrier(xbar);
        { pg8::Gemm g{XB - 2 * DM, Wup_t + (size_t)l * NUP * DM, 65 * 256, NUP, DM, 254}; pg8::StaticOrder So; So.init(65 * 256, NUP, G, bx);
          pg8::EpiGate E{A, part, ffn_conv + (size_t)l * 3 * NUP, (LAS float*)(lds + 131072)};
          pg8::gemm_phase<pg8::EpiGate, pg8::StaticOrder, true, true>(lds, g, So, E); }
        xcd_barrier(xbar);
        { pg8::Gemm g{A, Wdn_t + (size_t)l * DM * DFF, S, DM, DFF, 256}; pg8::StaticOrder So; So.init(S, DM, G, bx);
          pg8::EpiResid E{xcur, xcur, XB, part};
          pg8::gemm_phase<pg8::EpiResid, pg8::StaticOrder, true, true>(lds, g, So, E); }
        xcd_barrier(xbar);
    }
    for (int m = gw; m < S; m += NGW) { f32x4* xr = (f32x4*)(xcur + (size_t)m * DM) + lane; f32x4 v[4]; float ss = 0.f;
#pragma unroll
        for (int j = 0; j < 4; ++j) { v[j] = xr[64 * j]; ss += (v[j][0] * v[j][0] + v[j][1] * v[j][1]) + (v[j][2] * v[j][2] + v[j][3] * v[j][3]); }
        const float rs = __builtin_amdgcn_rsqf(wave_sum(ss) * (1.0f / 1024.0f) + EPS);
#pragma unroll
        for (int j = 0; j < 4; ++j) { const f32x4 g = *((const f32x4*)norm_final + lane + 64 * j); xr[64 * j] = v[j] * rs * g; } }
}

extern "C" void kernel_launch(void* const* d_in, const int* in_sizes, int n_in, void* d_out, int out_size, void* d_ws, size_t ws_size, hipStream_t stream) {
    static int grid = 0;
    if (grid == 0) {
        if (n_in != 14 || out_size != S * DM || ws_size < WS_END) { fprintf(stderr, "kernel_launch: unexpected shapes / workspace (%d inputs, out %d, ws %zu)\n", n_in, out_size, ws_size); grid = -1; return; }
        int dev = 0, cus = 0, per_cu = 0;
        hipGetDevice(&dev); hipDeviceGetAttribute(&cus, hipDeviceAttributeMultiprocessorCount, dev);
        hipFuncSetAttribute((const void*)hybrid_fwd, hipFuncAttributeMaxDynamicSharedMemorySize, LDS_BYTES);
        hipOccupancyMaxActiveBlocksPerMultiprocessor(&per_cu, (const void*)hybrid_fwd, NTHR, LDS_BYTES);
        (void)hipGetLastError();
        if (per_cu < 1) per_cu = 1;
        grid = cus * 1;
    }
    if (grid < 0) return;
    hipMemsetAsync((unsigned char*)d_ws, 0, 16384, stream);
    hipMemsetAsync((unsigned char*)d_ws + WS_XB - 4096, 0, 4096, stream);
    Args a{};
    for (int i = 0; i < 14; ++i) a.in[i] = (const float*)d_in[i];
    a.out = (float*)d_out; a.ws = (unsigned char*)d_ws;
    void* kargs[] = {&a};
    hipError_t e = hipLaunchCooperativeKernel((const void*)hybrid_fwd, dim3(grid), dim3(NTHR), kargs, LDS_BYTES, stream);
    if (e != hipSuccess) fprintf(stderr, "cooperative launch failed: %s (grid %d)\n", hipGetErrorString(e), grid);
}
```

```cpp
#include <hip/hip_runtime.h>
#include <hip/hip_cooperative_groups.h>
#include <cstdio>
#include <cstdint>
namespace cg = cooperative_groups;
namespace pg8 {
#define PG8_LAS __attribute__((address_space(3)))
typedef unsigned short bf16_t;
typedef short bf16x8 __attribute__((ext_vector_type(8)));
typedef float f32x4 __attribute__((ext_vector_type(4)));
typedef unsigned u32x4 __attribute__((ext_vector_type(4)));
typedef unsigned u32x2 __attribute__((ext_vector_type(2)));
constexpr int BM = 256, BK = 64, HALF = 128, HTB = HALF * BK * 2  , STAGE_BYTES = 8 * HTB, NXCD = 8, WGM = 8;

__host__ __device__ __forceinline__ int lds_byte(int r, int c) { const int st = (r >> 4) * 2 + (c >> 5), rr = r & 15, cc = c & 31, ob = rr * 64 + cc * 2; return st * 1024 + (ob ^ (((ob >> 9) & 1) << 5)); }
__host__ __device__ __forceinline__ void stage_rc(int b, int& R, int& C) { const int st = b / 1024, sb = b % 1024, swz = sb ^ (((sb >> 9) & 1) << 5); R = (st >> 1) * 16 + swz / 64; C = (st & 1) * 32 + (swz % 64) / 2; }
__host__ __device__ __forceinline__ int perm32(int rho) { const int n = rho >> 4, i = rho & 15; return 8 * (i >> 2) + 4 * n + (i & 3); }

struct Unit { int pm, pn; };
struct Gemm { const bf16_t* A; const bf16_t* Bt; int M, N, K; int arows; };

struct StaticOrder {
    int nM, nN, nwg, G, c;
    __host__ __device__ void init(int M, int N, int G_, int c_) { nM = M / BM; nN = N / BM; nwg = nM * nN; G = G_; c = c_; }
    __host__ __device__ bool next(int i, Unit& u) const {
        const long L = (long)i * G + c; if (L >= nwg) return false;
        int wgid = (int)L; { const int q = nwg / NXCD, r = nwg % NXCD, xcd = wgid % NXCD, off = wgid / NXCD; wgid = (xcd < r ? xcd * (q + 1) : r * (q + 1) + (xcd - r) * q) + off; }
        const int nig = WGM * nN, gid = wgid / nig, fm = gid * WGM, gsz = (nM - fm) < WGM ? (nM - fm) : WGM;
        u.pm = fm + ((wgid % nig) % gsz); u.pn = (wgid % nig) / gsz; return true;
    }
    __device__ __forceinline__ void a_ready(const Unit&) const {}
    __device__ __forceinline__ void done(const Unit&) const {}
};

__device__ __forceinline__ unsigned cvt_pk_bf16(float lo, float hi) { unsigned r; asm volatile("v_cvt_pk_bf16_f32 %0, %1, %2" : "=v"(r) : "v"(lo), "v"(hi)); return r; }
struct EpiScaleBf16 {
    static constexpr bool PERM = true, AFTER_DRAIN = false;
    bf16_t* O; int ldc; const float* part; PG8_LAS float* rsl;
    __device__ __forceinline__ void operator()(const f32x4 (&acc)[2][2][4][2], const Unit& u, int wr, int wc, int fr, int fq) const {
        { const int t = (wr * 4 + wc) * 64 + fq * 16 + fr;
          if (t < 256) { const f32x4* pp = (const f32x4*)(part + (size_t)(u.pm * BM + t) * 16); const f32x4 a = pp[0], b = pp[1], c = pp[2], d = pp[3];
              const f32x4 s4 = (a + b) + (c + d); const float ss = (s4[0] + s4[1]) + (s4[2] + s4[3]); rsl[t] = __builtin_amdgcn_rsqf(ss * (1.0f / 1024.0f) + 1e-6f); } }
        asm volatile("s_waitcnt lgkmcnt(0)" ::: "memory"); __builtin_amdgcn_s_barrier(); asm volatile("" ::: "memory");
        const int row0 = u.pm * BM + wr * 64 + fr; const int col0 = u.pn * BM + wc * 32 + 8 * fq;
#pragma unroll
        for (int ai = 0; ai < 2; ++ai)
#pragma unroll
            for (int m = 0; m < 4; ++m) { const int row = row0 + ai * HALF + m * 16;
                const float rs = rsl[ai * HALF + wr * 64 + m * 16 + fr];
                bf16_t* rowp = O + (size_t)row * ldc + col0;
#pragma unroll
                for (int bj = 0; bj < 2; ++bj) { const f32x4 v0 = acc[ai][bj][m][0] * rs, v1 = acc[ai][bj][m][1] * rs;
                    u32x4 w; w.x = cvt_pk_bf16(v0[0], v0[1]); w.y = cvt_pk_bf16(v0[2], v0[3]); w.z = cvt_pk_bf16(v1[0], v1[1]); w.w = cvt_pk_bf16(v1[2], v1[3]);
                    *(u32x4*)(rowp + bj * HALF) = w; } }
    }
};
struct EpiResid {
    static constexpr bool PERM = true, AFTER_DRAIN = false;
    const float* base; float* out; bf16_t* xb; float* part;
    __device__ __forceinline__ void operator()(const f32x4 (&acc)[2][2][4][2], const Unit& u, int wr, int wc, int fr, int fq) const {
        const int row0 = u.pm * BM + wr * 64 + fr; const int col0 = u.pn * BM + wc * 32 + 8 * fq;
        f32x4 pre[3][4];
#define PG8_RLOAD(g_) do { const size_t o_ = (size_t)(row0 + ((g_) >> 2) * HALF + ((g_) & 3) * 16) * 1024 + col0; \
            pre[(g_) % 3][0] = *(const f32x4*)(base + o_); pre[(g_) % 3][1] = *(const f32x4*)(base + o_ + 4); pre[(g_) % 3][2] = *(const f32x4*)(base + o_ + HALF); pre[(g_) % 3][3] = *(const f32x4*)(base + o_ + HALF + 4); } while (0)
        PG8_RLOAD(0); PG8_RLOAD(1);
#pragma unroll
        for (int g = 0; g < 8; ++g) { const int ai = g >> 2, m = g & 3;
            if (g + 2 < 8) PG8_RLOAD(g + 2);
            asm volatile("" ::: "memory");
            const int row = row0 + ai * HALF + m * 16; const size_t off = (size_t)row * 1024 + col0; float ss = 0.f;
#pragma unroll
            for (int bj = 0; bj < 2; ++bj) { const f32x4 v0 = acc[ai][bj][m][0] + pre[g % 3][2 * bj], v1 = acc[ai][bj][m][1] + pre[g % 3][2 * bj + 1];
                *(f32x4*)(out + off + bj * HALF) = v0; *(f32x4*)(out + off + bj * HALF + 4) = v1;
                ss += (v0[0] * v0[0] + v0[1] * v0[1]) + (v0[2] * v0[2] + v0[3] * v0[3]) + (v1[0] * v1[0] + v1[1] * v1[1]) + (v1[2] * v1[2] + v1[3] * v1[3]);
                u32x4 w; w.x = cvt_pk_bf16(v0[0], v0[1]); w.y = cvt_pk_bf16(v0[2], v0[3]); w.z = cvt_pk_bf16(v1[0], v1[1]); w.w = cvt_pk_bf16(v1[2], v1[3]);
                *(u32x4*)(xb + off + bj * HALF) = w; }
            ss += __shfl_xor(ss, 16); ss += __shfl_xor(ss, 32);
            if (fq == 0) part[(size_t)row * 16 + u.pn * 4 + wc] = ss;
            asm volatile("" ::: "memory"); }
#undef PG8_RLOAD
    }
};
#define PG8_DPP(oldv, srcv, ctrl) __builtin_bit_cast(float, __builtin_amdgcn_update_dpp(__builtin_bit_cast(int, (float)(oldv)), __builtin_bit_cast(int, (float)(srcv)), (ctrl), 0xf, 0xf, false))
struct EpiGate {
    static constexpr bool PERM = true, AFTER_DRAIN = false;
    bf16_t* Aout; const float* part; const float* fconv; PG8_LAS float* xch;
    __device__ __forceinline__ void operator()(f32x4 (&acc)[2][2][4][2], const Unit& u, int wr, int wc, int fr, int fq) const {
        PG8_LAS float* rsl = xch + 2048;
        { const int t = (wr * 4 + wc) * 64 + fq * 16 + fr;
          if (t < 256) { const int row = u.pm * 254 - 2 + t; const bool ok = row >= 0 && row < 16384; const int rc = ok ? row : 0;
              const f32x4* pp = (const f32x4*)(part + (size_t)rc * 16); const f32x4 a = pp[0], b = pp[1], c = pp[2], d = pp[3];
              const f32x4 s4 = (a + b) + (c + d); const float ss = (s4[0] + s4[1]) + (s4[2] + s4[3]);
              rsl[t] = ok ? __builtin_amdgcn_rsqf(ss * (1.0f / 1024.0f) + 1e-6f) : 0.f; } }
        asm volatile("s_waitcnt lgkmcnt(0)" ::: "memory"); __builtin_amdgcn_s_barrier(); asm volatile("" ::: "memory");
        const int ccol = wc * 32 + 8 * fq;
#pragma unroll
        for (int ai = 0; ai < 2; ++ai)
#pragma unroll
            for (int m = 0; m < 4; ++m) { const float rs = rsl[ai * HALF + wr * 64 + m * 16 + fr];
#pragma unroll
                for (int bj = 0; bj < 2; ++bj) { acc[ai][bj][m][0] *= rs; acc[ai][bj][m][1] *= rs; } }
        if (fr >= 14) {
#pragma unroll
            for (int ai = 0; ai < 2; ++ai)
#pragma unroll
                for (int bj = 0; bj < 2; ++bj)
#pragma unroll
                    for (int n = 0; n < 2; ++n) *(PG8_LAS f32x4*)(xch + ((2 * ai + wr) * 2 + (fr & 1)) * 256 + bj * HALF + ccol + 4 * n) = acc[ai][bj][3][n];
        }
        asm volatile("s_waitcnt lgkmcnt(0)" ::: "memory"); __builtin_amdgcn_s_barrier(); asm volatile("" ::: "memory");
        const int ch0 = u.pn * HALF + ccol;
#pragma unroll
        for (int ai = 0; ai < 2; ++ai) {
            const int grp = 2 * ai + wr;
#pragma unroll
            for (int n = 0; n < 2; ++n) {
                asm volatile("" ::: "memory");
                const float* fw = fconv + ch0 + 4 * n;
                const f32x4 wg0 = *(const f32x4*)(fw), wg1 = *(const f32x4*)(fw + 5632), wg2 = *(const f32x4*)(fw + 2 * 5632);
                const f32x4 wu0 = *(const f32x4*)(fw + 2816), wu1 = *(const f32x4*)(fw + 5632 + 2816), wu2 = *(const f32x4*)(fw + 2 * 5632 + 2816);
                f32x4 xpg = {0.f, 0.f, 0.f, 0.f}, xpu = {0.f, 0.f, 0.f, 0.f};
                if (grp > 0) { xpg = *(const PG8_LAS f32x4*)(xch + ((grp - 1) * 2 + (fr & 1)) * 256 + ccol + 4 * n); xpu = *(const PG8_LAS f32x4*)(xch + ((grp - 1) * 2 + (fr & 1)) * 256 + HALF + ccol + 4 * n); }
#pragma unroll
                for (int m = 0; m < 4; ++m) {
                    float o[4];
#pragma unroll
                    for (int j = 0; j < 4; ++j) {
                        const float xg = acc[ai][0][m][n][j], xu = acc[ai][1][m][n][j];
                        const float pg = m > 0 ? acc[ai][0][m > 0 ? m - 1 : 0][n][j] : xpg[j], pu = m > 0 ? acc[ai][1][m > 0 ? m - 1 : 0][n][j] : xpu[j];
                        const float g1 = PG8_DPP(PG8_DPP(0.f, pg, 0x121), xg, 0x111), g2 = PG8_DPP(PG8_DPP(0.f, pg, 0x122), xg, 0x112);
                        const float u1 = PG8_DPP(PG8_DPP(0.f, pu, 0x121), xu, 0x111), u2 = PG8_DPP(PG8_DPP(0.f, pu, 0x122), xu, 0x112);
                        const float Gv = wg0[j] * g2 + wg1[j] * g1 + wg2[j] * xg, Uv = wu0[j] * u2 + wu1[j] * u1 + wu2[j] * xu;
                        o[j] = Gv * __builtin_amdgcn_rcpf(1.0f + __expf(-Gv)) * Uv; }
                    const int r = ai * HALF + wr * 64 + m * 16 + fr, row = u.pm * 254 - 2 + r;
                    u32x2 w; w.x = cvt_pk_bf16(o[0], o[1]); w.y = cvt_pk_bf16(o[2], o[3]);
                    if (r >= 2 && row < 16384) *(u32x2*)(Aout + (size_t)row * 2816 + ch0 + 4 * n) = w; }
            }
        }
    }
};
template <class Epi, class Sched, bool ALIGN_EPI = false, bool SP2 = false>
__device__ __forceinline__ void gemm_phase(PG8_LAS unsigned char* lds, const Gemm g, const Sched& S, const Epi& E) {
    int tid = threadIdx.x; asm volatile("" : "+v"(tid));
    const int wid = __builtin_amdgcn_readfirstlane(tid >> 6), lane = tid & 63, wr = wid >> 2, wc = wid & 3, fr = lane & 15, fq = lane >> 4;
    const int K = g.K, nt = K / BK;
    unsigned voffA[2], voffB[2];
#pragma unroll
    for (int i = 0; i < 2; ++i) { int R, C; stage_rc(tid * 16 + i * 8192, R, C); const int Rb = Epi::PERM ? ((R & ~31) + perm32(R & 31)) : R;
        voffA[i] = (unsigned)(R * K + C) * 2u; voffB[i] = (unsigned)(Rb * K + C) * 2u; }
    const size_t kstep = (size_t)(BK * 2);
    const size_t hstep = (size_t)HALF * K * 2;
    const size_t tstep = 2 * hstep;
    const size_t tstepA = (size_t)g.arows * K * 2;
    const unsigned ldsw = (unsigned)wid * 1024u;
    const int aoff = lds_byte(wr * 64 + fr, fq * 8), boff = lds_byte(wc * 32 + fr, fq * 8);
#define PG8_SA(b, h) (((b) * 2 + (h)) * HTB)
#define PG8_SB(b, h) ((4 + (b) * 2 + (h)) * HTB)
#define PG8_STAGE(bufoff, gbase, voff) do { _Pragma("unroll") for (int _i = 0; _i < 2; ++_i) \
        __builtin_amdgcn_global_load_lds((const unsigned*)((const char*)(gbase) + (voff)[_i]), (PG8_LAS unsigned*)(lds + (bufoff) + ldsw + _i * 8192), 16, 0, 0); } while (0)
#define PG8_LDA(dst, b, h) do { _Pragma("unroll") for (int m = 0; m < 4; ++m) _Pragma("unroll") for (int k = 0; k < 2; ++k) dst[m][k] = *(const PG8_LAS bf16x8*)(lds + PG8_SA(b, h) + aoff + m * 2048 + k * 1024); } while (0)
#define PG8_LDB(dst, b, h) do { _Pragma("unroll") for (int n = 0; n < 2; ++n) _Pragma("unroll") for (int k = 0; k < 2; ++k) dst[n][k] = *(const PG8_LAS bf16x8*)(lds + PG8_SB(b, h) + boff + n * 2048 + k * 1024); } while (0)
#define PG8_MMA(ai, bj, At, Bt) do { __builtin_amdgcn_s_setprio(1); _Pragma("unroll") for (int m = 0; m < 4; ++m) _Pragma("unroll") for (int n = 0; n < 2; ++n) _Pragma("unroll") for (int k = 0; k < 2; ++k) \
        acc[ai][bj][m][n] = __builtin_amdgcn_mfma_f32_16x16x32_bf16(Bt[n][k], At[m][k], acc[ai][bj][m][n], 0, 0, 0); __builtin_amdgcn_s_setprio(0); } while (0)
#define PG8_WAIT_V(n) asm volatile("s_waitcnt vmcnt(" #n ")" ::: "memory")
#define PG8_WAIT_L(n) asm volatile("s_waitcnt lgkmcnt(" #n ")" ::: "memory")
#define PG8_BAR __builtin_amdgcn_s_barrier()
#define PG8_SCHED __builtin_amdgcn_sched_barrier(0)
    Unit cur, nxt; int ui = 0;
    if (!S.next(0, cur)) return;
    f32x4 acc[2][2][4][2];
#pragma unroll
    for (int a = 0; a < 2; ++a)
#pragma unroll
        for (int b = 0; b < 2; ++b)
#pragma unroll
            for (int m = 0; m < 4; ++m)
#pragma unroll
                for (int n = 0; n < 2; ++n) acc[a][b][m][n] = (f32x4){0.f, 0.f, 0.f, 0.f};
    bf16x8 At[4][2], B0[2][2], B1[2][2];
    const char* cA = (const char*)g.A + (size_t)cur.pm * tstepA; const char* cB = (const char*)g.Bt + (size_t)cur.pn * tstep;
    S.a_ready(cur);
    if constexpr (SP2) {
        PG8_STAGE(PG8_SB(0, 0), cB, voffB); PG8_STAGE(PG8_SB(0, 1), cB + hstep, voffB); PG8_STAGE(PG8_SA(0, 0), cA, voffA); PG8_STAGE(PG8_SA(0, 1), cA + hstep, voffA);
        if (wr == 1) PG8_BAR;
        PG8_WAIT_V(2); PG8_BAR;
        PG8_STAGE(PG8_SB(1, 0), cB + kstep, voffB); PG8_STAGE(PG8_SA(1, 0), cA + kstep, voffA); PG8_STAGE(PG8_SB(1, 1), cB + hstep + kstep, voffB);
        PG8_WAIT_V(6); PG8_BAR;
    } else {
        PG8_STAGE(PG8_SB(0, 0), cB, voffB); PG8_STAGE(PG8_SA(0, 0), cA, voffA); PG8_STAGE(PG8_SB(0, 1), cB + hstep, voffB); PG8_STAGE(PG8_SA(0, 1), cA + hstep, voffA);
        if (wr == 1) PG8_BAR;
        PG8_WAIT_V(4); PG8_BAR;
        PG8_STAGE(PG8_SB(1, 0), cB + kstep, voffB); PG8_STAGE(PG8_SA(1, 0), cA + kstep, voffA); PG8_STAGE(PG8_SB(1, 1), cB + hstep + kstep, voffB);
        PG8_WAIT_V(6); PG8_BAR;
    }
    for (;;) {
        const bool has_next = S.next(ui + 1, nxt);
        const char* nA = has_next ? (const char*)g.A + (size_t)nxt.pm * tstepA : cA; const char* nB = has_next ? (const char*)g.Bt + (size_t)nxt.pn * tstep : cB;
        for (int t = 0; t < nt; t += 2) {
            const bool last = (t == nt - 2);
            const char* a1 = cA + (size_t)(t + 1) * kstep;
            const char* a2 = last ? nA : cA + (size_t)(t + 2) * kstep; const char* b2 = last ? nB : cB + (size_t)(t + 2) * kstep;
            const char* a3 = a2 + kstep; const char* b3 = b2 + kstep;
            if (last && has_next) S.a_ready(nxt);
            if constexpr (SP2) {
            PG8_LDB(B0, 0, 0); PG8_LDB(B1, 0, 1); PG8_SCHED; PG8_LDA(At, 0, 0); PG8_STAGE(PG8_SA(1, 1), a1 + hstep, voffA);
            PG8_WAIT_V(8); PG8_WAIT_L(0); PG8_BAR; PG8_MMA(0, 0, At, B0); PG8_MMA(0, 1, At, B1); PG8_BAR; PG8_SCHED;
            PG8_LDA(At, 0, 1); PG8_STAGE(PG8_SB(0, 0), b2, voffB); PG8_STAGE(PG8_SB(0, 1), b2 + hstep, voffB); PG8_STAGE(PG8_SA(0, 0), a2, voffA);
            PG8_WAIT_V(8); PG8_WAIT_L(0); PG8_BAR; PG8_MMA(1, 0, At, B0); PG8_MMA(1, 1, At, B1); PG8_BAR; PG8_SCHED;
            PG8_LDB(B0, 1, 0); PG8_LDB(B1, 1, 1); PG8_SCHED; PG8_LDA(At, 1, 0); PG8_STAGE(PG8_SA(0, 1), a2 + hstep, voffA);
            PG8_WAIT_V(8); PG8_WAIT_L(0); PG8_BAR; PG8_MMA(0, 0, At, B0); PG8_MMA(0, 1, At, B1); PG8_BAR; PG8_SCHED;
            PG8_LDA(At, 1, 1); PG8_STAGE(PG8_SB(1, 0), b3, voffB); PG8_STAGE(PG8_SB(1, 1), b3 + hstep, voffB); PG8_STAGE(PG8_SA(1, 0), a3, voffA);
            PG8_WAIT_V(8); PG8_WAIT_L(0); PG8_BAR; PG8_MMA(1, 0, At, B0); PG8_MMA(1, 1, At, B1); PG8_BAR; PG8_SCHED;
            } else {
            PG8_LDB(B0, 0, 0); PG8_SCHED; PG8_LDA(At, 0, 0); PG8_STAGE(PG8_SA(1, 1), a1 + hstep, voffA);
            PG8_WAIT_L(8); PG8_BAR; PG8_WAIT_L(0); PG8_MMA(0, 0, At, B0); PG8_BAR; PG8_SCHED;
            PG8_LDB(B1, 0, 1); PG8_STAGE(PG8_SB(0, 0), b2, voffB);
            PG8_BAR; PG8_WAIT_L(0); PG8_MMA(0, 1, At, B1); PG8_BAR;
            PG8_LDA(At, 0, 1); PG8_STAGE(PG8_SA(0, 0), a2, voffA);
            PG8_BAR; PG8_WAIT_L(0); PG8_MMA(1, 0, At, B0); PG8_BAR; PG8_SCHED;
            PG8_STAGE(PG8_SB(0, 1), b2 + hstep, voffB);
            PG8_WAIT_V(6); PG8_BAR; PG8_MMA(1, 1, At, B1); PG8_BAR;
            PG8_LDB(B0, 1, 0); PG8_SCHED; PG8_LDA(At, 1, 0); PG8_STAGE(PG8_SA(0, 1), a2 + hstep, voffA);
            PG8_WAIT_L(8); PG8_BAR; PG8_WAIT_L(0); PG8_MMA(0, 0, At, B0); PG8_BAR; PG8_SCHED;
            PG8_LDB(B1, 1, 1); PG8_STAGE(PG8_SB(1, 0), b3, voffB);
            PG8_BAR; PG8_WAIT_L(0); PG8_MMA(0, 1, At, B1); PG8_BAR;
            PG8_LDA(At, 1, 1); PG8_STAGE(PG8_SA(1, 0), a3, voffA);
            PG8_BAR; PG8_WAIT_L(0); PG8_MMA(1, 0, At, B0); PG8_BAR; PG8_SCHED;
            PG8_STAGE(PG8_SB(1, 1), b3 + hstep, voffB);
            PG8_WAIT_V(6); PG8_BAR; PG8_MMA(1, 1, At, B1); PG8_BAR;
            }
        }
        if constexpr (ALIGN_EPI) { if (wr == 0) PG8_BAR; }
        if constexpr (!Epi::AFTER_DRAIN) { E(acc, cur, wr, wc, fr, fq); S.done(cur); }
        if (!has_next) break;
#pragma unroll
        for (int a = 0; a < 2; ++a)
#pragma unroll
            for (int b = 0; b < 2; ++b)
#pragma unroll
                for (int m = 0; m < 4; ++m)
#pragma unroll
                    for (int n = 0; n < 2; ++n) acc[a][b][m][n] = (f32x4){0.f, 0.f, 0.f, 0.f};
        cur = nxt; cA = nA; cB = nB; ++ui;
        if constexpr (ALIGN_EPI) { if (wr == 1) PG8_BAR; }
    }
    PG8_WAIT_V(0);
    if constexpr (!ALIGN_EPI) { if (wr == 0) PG8_BAR; }
    PG8_BAR;
    if constexpr (Epi::AFTER_DRAIN) { E.fused(acc, cur, wr, wc, fr, fq, lds, wid, lane); S.done(cur); }
#undef PG8_SA
#undef PG8_SB
#undef PG8_STAGE
#undef PG8_LDA
#undef PG8_LDB
#undef PG8_MMA
#undef PG8_WAIT_V
#undef PG8_WAIT_L
#undef PG8_BAR
#undef PG8_SCHED
}
}
constexpr int S = 16384, DM = 1024, DEPTH = 4, NIN = 2816, DFF = 2816, NUP = 5632;
constexpr float EPS = 1e-6f;
constexpr int NWAVES = 8, NTHR = 512;
constexpr size_t MiB = 1u << 20;
constexpr size_t WS_WIN = 1 * MiB, WS_WOUT = 23 * MiB, WS_WUP = 31 * MiB, WS_WDN = 75 * MiB;
constexpr size_t WS_PART = 97 * MiB;
constexpr size_t WS_XB = 98 * MiB + 4096;
constexpr size_t WS_P = 131 * MiB;
constexpr size_t WS_Y = 219 * MiB;
constexpr size_t WS_GU = 131 * MiB;
constexpr size_t WS_A = 219 * MiB;
constexpr size_t WS_END = 307 * MiB;
constexpr int LDS_BYTES = 147456;
#define LAS __attribute__((address_space(3)))
typedef unsigned short bf16;
typedef unsigned v4u __attribute__((ext_vector_type(4)));
typedef unsigned v2u __attribute__((ext_vector_type(2)));
typedef float f32x4 __attribute__((ext_vector_type(4)));
typedef float f32x16 __attribute__((ext_vector_type(16)));
typedef short bf16x8 __attribute__((ext_vector_type(8)));
#define LDS_WAIT() asm volatile("s_waitcnt lgkmcnt(0)" ::: "memory")
__device__ __forceinline__ unsigned pk2(float lo, float hi) { return pg8::cvt_pk_bf16(lo, hi); }
__device__ __forceinline__ float bflo(unsigned u) { return __uint_as_float(u << 16); }
__device__ __forceinline__ float bfhi(unsigned u) { return __uint_as_float(u & 0xffff0000u); }
__device__ __forceinline__ float bf1(bf16 v) { return __uint_as_float((unsigned)v << 16); }
__device__ __forceinline__ float wave_sum(float v) {
#pragma unroll
    for (int o = 1; o < 64; o <<= 1) v += __shfl_xor(v, o);
    return v;
}

__device__ __forceinline__ void cvt_item(const float* W, int K, int N, bf16* WT, const float* gain, int mode, LAS float* scr, int item, int lane) {
    const int nblk = N / 32, kb = item / nblk, nb = item % nblk, k0 = 64 * kb, n0 = 32 * nb;
#pragma unroll 8
    for (int i = 0; i < 32; ++i) { const int kk = 2 * i + (lane >> 5); const float g = gain ? gain[k0 + kk] : 1.0f; scr[kk * 33 + (lane & 31)] = W[(size_t)(k0 + kk) * N + n0 + (lane & 31)] * g; }
    LDS_WAIT(); asm volatile("" ::: "memory");
    const float cs = (mode == 1 && n0 >= 1280 && n0 < 1792) ? 0.125f : 1.0f;
    int rb = n0;
    if (mode == 2) { rb = (n0 < DFF) ? 256 * (n0 / 128) + (n0 % 128) : 256 * ((n0 - DFF) / 128) + 128 + ((n0 - DFF) % 128); }
    const int c = lane & 7;
#pragma unroll
    for (int j = 0; j < 4; ++j) { const int n = (lane >> 3) + 8 * j; const LAS float* s = scr + (8 * c) * 33 + n;
        v4u o; o.x = pk2(s[0 * 33] * cs, s[1 * 33] * cs); o.y = pk2(s[2 * 33] * cs, s[3 * 33] * cs); o.z = pk2(s[4 * 33] * cs, s[5 * 33] * cs); o.w = pk2(s[6 * 33] * cs, s[7 * 33] * cs);
        *(v4u*)(WT + (size_t)(rb + n) * K + k0 + 8 * c) = o; }
    LDS_WAIT(); asm volatile("" ::: "memory");
}

typedef __attribute__((address_space(1))) unsigned gu32;
#define XB_TMO      128
#define XB_XCNT(j)  (256  + 64 * (j))
#define XB_XSUB(j)  (1280 + 64 * (j))
#define XB_XGEN(j)  (2304 + 64 * (j))
#define XB_TOP      3328
#define XB_TOPGEN   3392
#define XCD_BAR_WORDS 3456
#define XB_SPIN_CAP (1u << 18)

__device__ __forceinline__ unsigned xb_ld(unsigned* p)              { return __hip_atomic_load(p, __ATOMIC_RELAXED, __HIP_MEMORY_SCOPE_AGENT); }
__device__ __forceinline__ unsigned xb_add(unsigned* p, unsigned v) { return __hip_atomic_fetch_add(p, v, __ATOMIC_RELAXED, __HIP_MEMORY_SCOPE_AGENT); }
__device__ __forceinline__ unsigned xb_xcc_id() { return (unsigned)__builtin_amdgcn_s_getreg((3 << 11) | 20) & 0xFu; }
#define XB_SPIN(cond, bar) do { unsigned _sp = 0; while (cond) { __builtin_amdgcn_s_sleep(1); \
    if ((++_sp & 255u) == 0u) { if (xb_ld(&(bar)[XB_TMO])) break; if (_sp > XB_SPIN_CAP) { atomicAdd(&(bar)[XB_TMO], 1u); break; } } } } while (0)

struct XcdBarrier {
    unsigned* bar; unsigned x;
    volatile LAS unsigned* st;
};

__device__ __forceinline__ XcdBarrier xcd_barrier_post(unsigned* bar, volatile LAS unsigned* st) {
    XcdBarrier b; b.bar = bar; b.x = xb_xcc_id(); b.st = st;
    if (threadIdx.x == 0) (void)xb_add(&bar[XB_XCNT(b.x)], 1u);
    return b;
}
__device__ __forceinline__ void xcd_barrier_complete(unsigned* bar, unsigned x, unsigned& nloc, unsigned& nx) {
    const unsigned G = gridDim.x * gridDim.y * gridDim.z;
    unsigned sum, cnt, mine, sp = 0u;
    for (;;) {
        sum = 0u; cnt = 0u; mine = 0u;
#pragma unroll
        for (unsigned j = 0; j < 16; ++j) { const unsigned c = xb_ld(&bar[XB_XCNT(j)]); sum += c; cnt += (c > 0u) ? 1u : 0u; mine = (j == x) ? c : mine; }
        if (sum == G) break;
        __builtin_amdgcn_s_sleep(1);
        if ((++sp & 255u) == 0u) { if (xb_ld(&bar[XB_TMO])) break; if (sp > XB_SPIN_CAP) { atomicAdd(&bar[XB_TMO], 1u); break; } }
    }
    nloc = mine > 0u ? mine : 1u; nx = cnt > 0u ? cnt : 1u;
}

__device__ __forceinline__ void xcd_barrier(const XcdBarrier& b) {
    asm volatile("s_waitcnt vmcnt(0)" ::: "memory");
    __syncthreads();
    if (threadIdx.x == 0) {
        unsigned* bar = b.bar;
        __builtin_amdgcn_s_waitcnt(0);
        unsigned nloc = b.st[0], nx = b.st[1];
        if (nloc == 0u) { xcd_barrier_complete(bar, b.x, nloc, nx); b.st[0] = nloc; b.st[1] = nx; }
        const unsigned old = xb_add(&bar[XB_XSUB(b.x)], 1u);
        const unsigned gen = old / nloc;
        if (old + 1u == (gen + 1u) * nloc) {
            __builtin_amdgcn_fence(__ATOMIC_RELEASE, "agent");
            asm volatile("s_waitcnt vmcnt(0)" ::: "memory");
            const unsigned og = xb_add(&bar[XB_TOP], 1u);
            const unsigned tg = og / nx;
            if (og + 1u == (tg + 1u) * nx) xb_add(&bar[XB_TOPGEN], 1u);
            else XB_SPIN(xb_ld(&bar[XB_TOPGEN]) == tg, bar);
            __builtin_amdgcn_fence(__ATOMIC_ACQUIRE, "agent");
            xb_add(&bar[XB_XGEN(b.x)], 1u);
            asm volatile("s_waitcnt vmcnt(0)" ::: "memory");
        } else {
            XB_SPIN(xb_ld(&bar[XB_XGEN(b.x)]) == gen, bar);
            __builtin_amdgcn_fence(__ATOMIC_ACQUIRE, "agent");
            asm volatile("s_waitcnt vmcnt(0)" ::: "memory");
        }
    }
    __syncthreads();
}

struct Args { const float* in[14]; float* out; unsigned char* ws; };

__device__ __forceinline__ void norm_store_rows(const LAS float* tile, bf16* Y, int t0, int coff, int wave, int lane) {
#pragma unroll 2
    for (int i = 0; i < 8; ++i) { const int r = wave * 8 + i; const f32x4 v = *(const LAS f32x4*)(tile + r * 260 + lane * 4);
        const float ss = wave_sum((v[0] * v[0] + v[1] * v[1]) + (v[2] * v[2] + v[3] * v[3]));
        const float rs = __builtin_amdgcn_rsqf(ss * (1.0f / 256.0f) + EPS);
        v2u o; o.x = pk2(v[0] * rs, v[1] * rs); o.y = pk2(v[2] * rs, v[3] * rs);
        *(v2u*)(Y + (size_t)(t0 + r) * DM + coff + lane * 4) = o; }
}

__device__ __forceinline__ void mixer_unit(LAS unsigned char* lds, int unit, const bf16* P, bf16* Y, const float* conv_w, const float* sgu_norm, const float* sgu_w, const float* sgu_b, int tid, int wave, int lane) {
    const int t0 = unit * 64;
    asm volatile("" : "+v"(tid), "+v"(lane));
    LAS bf16* vnT = (LAS bf16*)lds;
    LAS float* tile = (LAS float*)(lds + 69632);
    LAS float* sm_ss = (LAS float*)(lds + 69632 + 66560);
    {
        const int hd = wave, r = lane & 31, h = lane >> 5;
        const int pr = (r & 0x13) | ((r & 4) << 1) | ((r & 8) >> 1);
        LAS bf16* Vt = (LAS bf16*)(lds + wave * 5120);
        bf16x8 atri[2];
#pragma unroll
        for (int sI = 0; sI < 2; ++sI) { v4u t;
            t.x = ((16 * sI + 8 * h + 0 > pr) ? 0x3F80u : 0u) | ((16 * sI + 8 * h + 1 > pr) ? 0x3F800000u : 0u); t.y = ((16 * sI + 8 * h + 2 > pr) ? 0x3F80u : 0u) | ((16 * sI + 8 * h + 3 > pr) ? 0x3F800000u : 0u);
            t.z = ((16 * sI + 8 * h + 4 > pr) ? 0x3F80u : 0u) | ((16 * sI + 8 * h + 5 > pr) ? 0x3F800000u : 0u); t.w = ((16 * sI + 8 * h + 6 > pr) ? 0x3F80u : 0u) | ((16 * sI + 8 * h + 7 > pr) ? 0x3F800000u : 0u);
            atri[sI] = __builtin_bit_cast(bf16x8, t); }
        f32x16 oacc[2][2]; float ssq[2];
#pragma unroll
        for (int qh = 0; qh < 2; ++qh) {
            const int tq = t0 + 32 * qh;
            bf16x8 qf[4];
#pragma unroll
            for (int ks = 0; ks < 4; ++ks) qf[ks] = *(const bf16x8*)(P + (size_t)(tq + r) * NIN + 1280 + hd * 64 + 16 * ks + 8 * h);
            f32x16 o0 = {}, o1 = {};
            float ls = 0.f;
            for (int k0 = tq; k0 >= 0; k0 -= 32) {
                const bool diag = (k0 == tq);
                const bf16* kp = P + (size_t)(k0 + pr) * NIN + 1792 + hd * 64 + 8 * h;
                f32x16 z = {};
#pragma unroll
                for (int ks = 0; ks < 4; ++ks) z = __builtin_amdgcn_mfma_f32_32x32x16_bf16(*(const bf16x8*)(kp + 16 * ks), qf[ks], z, 0, 0, 0);
#pragma unroll
                for (int i = 0; i < 4; ++i) { const int key = (lane >> 3) + 8 * i, c = lane & 7; const v4u vv = *(const v4u*)(P + (size_t)(k0 + key) * NIN + 2304 + hd * 64 + 8 * c);
                    LAS bf16* vd = Vt + (8 * c) * 40 + key;
                    vd[0] = (bf16)(vv.x & 0xffffu); vd[40] = (bf16)(vv.x >> 16); vd[80] = (bf16)(vv.y & 0xffffu); vd[120] = (bf16)(vv.y >> 16);
                    vd[160] = (bf16)(vv.z & 0xffffu); vd[200] = (bf16)(vv.z >> 16); vd[240] = (bf16)(vv.w & 0xffffu); vd[280] = (bf16)(vv.w >> 16); }
                f32x16 cin; float rowsum = 0.f; unsigned lh[8], ll[8];
#pragma unroll
                for (int j = 0; j < 16; j += 2) { float Lv[2];
#pragma unroll
                    for (int e2 = 0; e2 < 2; ++e2) { const int jj = j + e2; const int keyl = 16 * (jj >> 3) + 8 * h + (jj & 7); const bool valid = !diag || (keyl < r);
                        const float zz = z[jj]; const float ex = __expf(-fabsf(zz)); const float lsig = fminf(zz, 0.f) - __logf(1.0f + ex);
                        Lv[e2] = valid ? (lsig - zz) : 0.f; cin[jj] = lsig + ls; rowsum += Lv[e2]; }
                    const unsigned hp = pk2(Lv[0], Lv[1]); lh[j >> 1] = hp; ll[j >> 1] = pk2(Lv[0] - bflo(hp), Lv[1] - bfhi(hp)); }
                bf16x8 bh0 = __builtin_bit_cast(bf16x8, (v4u){lh[0], lh[1], lh[2], lh[3]}), bh1 = __builtin_bit_cast(bf16x8, (v4u){lh[4], lh[5], lh[6], lh[7]});
                bf16x8 bl0 = __builtin_bit_cast(bf16x8, (v4u){ll[0], ll[1], ll[2], ll[3]}), bl1 = __builtin_bit_cast(bf16x8, (v4u){ll[4], ll[5], ll[6], ll[7]});
                f32x16 lw = __builtin_amdgcn_mfma_f32_32x32x16_bf16(atri[0], bh0, cin, 0, 0, 0);
                lw = __builtin_amdgcn_mfma_f32_32x32x16_bf16(atri[1], bh1, lw, 0, 0, 0);
                lw = __builtin_amdgcn_mfma_f32_32x32x16_bf16(atri[0], bl0, lw, 0, 0, 0);
                lw = __builtin_amdgcn_mfma_f32_32x32x16_bf16(atri[1], bl1, lw, 0, 0, 0);
                unsigned wp[8];
#pragma unroll
                for (int j = 0; j < 16; j += 2) { float wv[2];
#pragma unroll
                    for (int e2 = 0; e2 < 2; ++e2) { const int jj = j + e2; const int keyl = 16 * (jj >> 3) + 8 * h + (jj & 7); const bool valid = !diag || (keyl < r);
                        wv[e2] = valid ? __expf(lw[jj]) : 0.f; }
                    wp[j >> 1] = pk2(wv[0], wv[1]); }
                const bf16x8 w0 = __builtin_bit_cast(bf16x8, (v4u){wp[0], wp[1], wp[2], wp[3]}), w1 = __builtin_bit_cast(bf16x8, (v4u){wp[4], wp[5], wp[6], wp[7]});
                const LAS bf16* vr = Vt + r * 40 + 8 * h;
                o0 = __builtin_amdgcn_mfma_f32_32x32x16_bf16(*(const LAS bf16x8*)(vr), w0, o0, 0, 0, 0);
                o0 = __builtin_amdgcn_mfma_f32_32x32x16_bf16(*(const LAS bf16x8*)(vr + 16), w1, o0, 0, 0, 0);
                o1 = __builtin_amdgcn_mfma_f32_32x32x16_bf16(*(const LAS bf16x8*)(vr + 32 * 40), w0, o1, 0, 0, 0);
                o1 = __builtin_amdgcn_mfma_f32_32x32x16_bf16(*(const LAS bf16x8*)(vr + 32 * 40 + 16), w1, o1, 0, 0, 0);
                ls += rowsum + __shfl_xor(rowsum, 32);
                if (__builtin_amdgcn_ballot_w64(ls > -104.0f) == 0ull) break;
            }
            float ss = 0.f;
#pragma unroll
            for (int j = 0; j < 16; ++j) ss += o0[j] * o0[j] + o1[j] * o1[j];
            ss += __shfl_xor(ss, 32);
            if (h == 0) sm_ss[(32 * qh + r) * 8 + hd] = ss;
            oacc[qh][0] = o0; oacc[qh][1] = o1; ssq[qh] = ss;
        }
        LDS_WAIT(); __syncthreads();
#pragma unroll
        for (int qh = 0; qh < 2; ++qh) {
            const f32x4 sa = *(const LAS f32x4*)(sm_ss + (32 * qh + r) * 8), sb = *(const LAS f32x4*)(sm_ss + (32 * qh + r) * 8 + 4);
            const float tot = ((sa[0] + sa[1]) + (sa[2] + sa[3])) + ((sb[0] + sb[1]) + (sb[2] + sb[3]));
            const float rs = __builtin_amdgcn_rsqf(tot * (1.0f / 512.0f) + EPS);
            bf16* yp = Y + (size_t)(t0 + 32 * qh + r) * DM + 512 + hd * 64 + 4 * h;
#pragma unroll
            for (int db = 0; db < 2; ++db)
#pragma unroll
                for (int g4 = 0; g4 < 4; ++g4) { const f32x16& o = oacc[qh][db]; v2u w; w.x = pk2(o[4 * g4 + 0] * rs, o[4 * g4 + 1] * rs); w.y = pk2(o[4 * g4 + 2] * rs, o[4 * g4 + 3] * rs);
                    *(v2u*)(yp + 32 * db + 8 * g4) = w; }
        }
    }
    {
        const int c = tid & 255, rh = tid >> 8, tb = t0 + 32 * rh;
        const float w0 = conv_w[c], w1 = conv_w[256 + c], w2 = conv_w[512 + c];
        float p2 = 0.f, p1 = 0.f;
        if (tb >= 2) { const bf16* r2 = P + (size_t)(tb - 2) * NIN; const bf16* r1 = P + (size_t)(tb - 1) * NIN; p2 = bf1(r2[256 + c]) * bf1(r2[512 + c]); p1 = bf1(r1[256 + c]) * bf1(r1[512 + c]); }
#pragma unroll 4
        for (int r = 0; r < 32; ++r) { const bf16* rp = P + (size_t)(tb + r) * NIN; const float p0 = bf1(rp[256 + c]) * bf1(rp[512 + c]);
            tile[(32 * rh + r) * 260 + c] = bf1(rp[c]) * (w0 * p2 + w1 * p1 + w2 * p0); p2 = p1; p1 = p0; }
    }
    LDS_WAIT(); __syncthreads();
    norm_store_rows(tile, Y, t0, 0, wave, lane);
    const int tc = t0 & ~127, dt = t0 - tc, ns = dt + 64;
    for (int s = wave; s < ns; s += 8) { const v2u u = *(const v2u*)(P + (size_t)(tc + s) * NIN + 1024 + lane * 4);
        const float v0 = bflo(u.x), v1 = bfhi(u.x), v2 = bflo(u.y), v3 = bfhi(u.y);
        const float ss = wave_sum((v0 * v0 + v1 * v1) + (v2 * v2 + v3 * v3)); const float rs = __builtin_amdgcn_rsqf(ss * (1.0f / 256.0f) + EPS);
        const f32x4 g = *(const f32x4*)(sgu_norm + lane * 4);
        const unsigned a = pk2(v0 * rs * g[0], v1 * rs * g[1]), b = pk2(v2 * rs * g[2], v3 * rs * g[3]);
        vnT[(lane * 4 + 0) * 136 + s] = (bf16)(a & 0xffffu); vnT[(lane * 4 + 1) * 136 + s] = (bf16)(a >> 16); vnT[(lane * 4 + 2) * 136 + s] = (bf16)(b & 0xffffu); vnT[(lane * 4 + 3) * 136 + s] = (bf16)(b >> 16); }
    LDS_WAIT(); __syncthreads();
    {
        const int h = wave >> 1, rh = wave & 1, r32 = lane & 31, hi = lane >> 5;
        const int tcl = dt + 32 * rh + r32;
        const float* wrow = sgu_w + ((size_t)h * 128 + tcl) * 128;
        f32x16 o0 = {}, o1 = {};
        const int nk = (dt + 32 * rh + 32) >> 4;
        for (int ks = 0; ks < nk; ++ks) { const int s0 = ks * 16 + 8 * hi;
            const f32x4 wa = *(const f32x4*)(wrow + s0), wb = *(const f32x4*)(wrow + s0 + 4);
            float wv[8] = {wa[0], wa[1], wa[2], wa[3], wb[0], wb[1], wb[2], wb[3]};
#pragma unroll
            for (int i = 0; i < 8; ++i) wv[i] = (s0 + i <= tcl) ? wv[i] : 0.f;
            v4u ap; ap.x = pk2(wv[0], wv[1]); ap.y = pk2(wv[2], wv[3]); ap.z = pk2(wv[4], wv[5]); ap.w = pk2(wv[6], wv[7]);
            const bf16x8 af = __builtin_bit_cast(bf16x8, ap);
            const bf16x8 b0 = *(const LAS bf16x8*)(vnT + (h * 64 + r32) * 136 + s0), b1 = *(const LAS bf16x8*)(vnT + (h * 64 + 32 + r32) * 136 + s0);
            o0 = __builtin_amdgcn_mfma_f32_32x32x16_bf16(af, b0, o0, 0, 0, 0);
            o1 = __builtin_amdgcn_mfma_f32_32x32x16_bf16(af, b1, o1, 0, 0, 0); }
#pragma unroll
        for (int j = 0; j < 16; ++j) { const int rl = 32 * rh + (j & 3) + 8 * (j >> 2) + 4 * hi;
            const float bb = sgu_b[h * 128 + dt + rl]; const bf16* up = P + (size_t)(t0 + rl) * NIN + 768 + h * 64;
            tile[rl * 260 + h * 64 + r32] = bf1(up[r32]) * (o0[j] + bb);
            tile[rl * 260 + h * 64 + 32 + r32] = bf1(up[32 + r32]) * (o1[j] + bb); }
    }
    LDS_WAIT(); __syncthreads();
    norm_store_rows(tile, Y, t0, 256, wave, lane);
    LDS_WAIT(); __syncthreads();
}

__device__ __forceinline__ void ffn_gate_phase(const bf16* GU, bf16* A, const float* fconv, int hf, int gtid, int gthreads) {
    for (int it = gtid; it < 256 * 176; it += gthreads) { const int rb = it / 176, cgp = it % 176, pnl = cgp >> 4, cc = (cgp & 15) * 8, ch = 1408 * hf + 128 * pnl + cc;
        float wg[3][8], wu[3][8];
#pragma unroll
        for (int i = 0; i < 3; ++i) { const f32x4 a0 = *(const f32x4*)(fconv + (size_t)i * NUP + ch), a1 = *(const f32x4*)(fconv + (size_t)i * NUP + ch + 4), b0 = *(const f32x4*)(fconv + (size_t)i * NUP + DFF + ch), b1 = *(const f32x4*)(fconv + (size_t)i * NUP + DFF + ch + 4);
#pragma unroll
            for (int e = 0; e < 4; ++e) { wg[i][e] = a0[e]; wg[i][4 + e] = a1[e]; wu[i][e] = b0[e]; wu[i][4 + e] = b1[e]; } }
        float g2[8], g1[8], u2[8], u1[8];
#pragma unroll
        for (int e = 0; e < 8; ++e) { g2[e] = g1[e] = u2[e] = u1[e] = 0.f; }
        for (int r = -2; r < 64; ++r) { const int t = 64 * rb + r; float g0[8], u0[8];
            if (t >= 0) { const v4u gv = *(const v4u*)(GU + (size_t)t * NIN + 256 * pnl + cc), uv = *(const v4u*)(GU + (size_t)t * NIN + 256 * pnl + 128 + cc);
                g0[0] = bflo(gv.x); g0[1] = bfhi(gv.x); g0[2] = bflo(gv.y); g0[3] = bfhi(gv.y); g0[4] = bflo(gv.z); g0[5] = bfhi(gv.z); g0[6] = bflo(gv.w); g0[7] = bfhi(gv.w);
                u0[0] = bflo(uv.x); u0[1] = bfhi(uv.x); u0[2] = bflo(uv.y); u0[3] = bfhi(uv.y); u0[4] = bflo(uv.z); u0[5] = bfhi(uv.z); u0[6] = bflo(uv.w); u0[7] = bfhi(uv.w); }
            else {
#pragma unroll
                for (int e = 0; e < 8; ++e) { g0[e] = 0.f; u0[e] = 0.f; } }
            if (r >= 0) { float o[8];
#pragma unroll
                for (int e = 0; e < 8; ++e) { const float G = wg[0][e] * g2[e] + wg[1][e] * g1[e] + wg[2][e] * g0[e], U = wu[0][e] * u2[e] + wu[1][e] * u1[e] + wu[2][e] * u0[e];
                    o[e] = G * __builtin_amdgcn_rcpf(1.0f + __expf(-G)) * U; }
                v4u ov; ov.x = pk2(o[0], o[1]); ov.y = pk2(o[2], o[3]); ov.z = pk2(o[4], o[5]); ov.w = pk2(o[6], o[7]);
                *(v4u*)(A + (size_t)t * DFF + ch) = ov; }
#pragma unroll
            for (int e = 0; e < 8; ++e) { g2[e] = g1[e]; g1[e] = g0[e]; u2[e] = u1[e]; u1[e] = u0[e]; } }
    }
}
__global__ void __launch_bounds__(NTHR, 2) hybrid_fwd(Args args) {
    extern __shared__ __attribute__((aligned(16))) unsigned char lds_raw[];
    LAS unsigned char* lds = (LAS unsigned char*)lds_raw;
    cg::grid_group grid = cg::this_grid();
    volatile LAS unsigned* MISC = (volatile LAS unsigned*)(lds + LDS_BYTES - 64);
    if (threadIdx.x < 16) MISC[threadIdx.x] = 0u;
    __syncthreads();
    XcdBarrier xbar = xcd_barrier_post((unsigned*)args.ws, MISC);
    const int tid = threadIdx.x, lane = tid & 63, wave = __builtin_amdgcn_readfirstlane(tid >> 6);
    const int G = gridDim.x, bx = blockIdx.x;
    const int gw = bx * NWAVES + wave, NGW = G * NWAVES;
    unsigned char* ws = args.ws;
    const float* x_in = args.in[0]; const float* norm_mix = args.in[1]; const float* w_in = args.in[2]; const float* conv_w = args.in[3];
    const float* sgu_norm = args.in[4]; const float* sgu_w = args.in[5]; const float* sgu_b = args.in[6]; const float* out_norm = args.in[7];
    const float* w_out = args.in[8]; const float* norm_ffn = args.in[9]; const float* w_up = args.in[10]; const float* ffn_conv = args.in[11];
    const float* w_down = args.in[12]; const float* norm_final = args.in[13];
    float* xcur = args.out;
    bf16* Win_t = (bf16*)(ws + WS_WIN); bf16* Wout_t = (bf16*)(ws + WS_WOUT); bf16* Wup_t = (bf16*)(ws + WS_WUP); bf16* Wdn_t = (bf16*)(ws + WS_WDN);
    float* part = (float*)(ws + WS_PART); bf16* XB = (bf16*)(ws + WS_XB); bf16* P = (bf16*)(ws + WS_P); bf16* Y = (bf16*)(ws + WS_Y);
    bf16* GU = (bf16*)(ws + WS_GU); bf16* A = (bf16*)(ws + WS_A);

    {
        LAS float* scr = (LAS float*)(lds + wave * 16384);
        constexpr int I_IN = 16 * 88, I_OUT = 16 * 32, I_UP = 16 * 176, I_DN = 44 * 32, I_L = I_IN + I_OUT + I_UP + I_DN;
        for (int it = gw; it < DEPTH * I_L; it += NGW) { const int l = it / I_L; int r = it % I_L;
            if (r < I_IN) { cvt_item(w_in + (size_t)l * DM * NIN, DM, NIN, Win_t + (size_t)l * NIN * DM, norm_mix + l * DM, 1, scr, r, lane); continue; } r -= I_IN;
            if (r < I_OUT) { cvt_item(w_out + (size_t)l * DM * DM, DM, DM, Wout_t + (size_t)l * DM * DM, out_norm + l * DM, 0, scr, r, lane); continue; } r -= I_OUT;
            if (r < I_UP) { cvt_item(w_up + (size_t)l * DM * NUP, DM, NUP, Wup_t + (size_t)l * NUP * DM, norm_ffn + l * DM, 2, scr, r, lane); continue; } r -= I_UP;
            cvt_item(w_down + (size_t)l * DFF * DM, DFF, DM, Wdn_t + (size_t)l * DM * DFF, nullptr, 0, scr, r, lane); }
        for (int m = gw; m < S; m += NGW) { const f32x4* xr = (const f32x4*)(x_in + (size_t)m * DM) + lane; f32x4 v[4]; float ss = 0.f;
#pragma unroll
            for (int j = 0; j < 4; ++j) { v[j] = xr[64 * j]; ss += (v[j][0] * v[j][0] + v[j][1] * v[j][1]) + (v[j][2] * v[j][2] + v[j][3] * v[j][3]); }
            ss = wave_sum(ss);
            v2u* o8 = (v2u*)(XB + (size_t)m * DM) + lane;
#pragma unroll
            for (int j = 0; j < 4; ++j) { v2u o; o.x = pk2(v[j][0], v[j][1]); o.y = pk2(v[j][2], v[j][3]); o8[64 * j] = o; }
            if (lane < 16) part[(size_t)m * 16 + lane] = lane == 0 ? ss : 0.f; }
    }
    grid.sync();

    for (int l = 0; l < DEPTH; ++l) {
        { pg8::Gemm g{XB, Win_t + (size_t)l * NIN * DM, S, NIN, DM, 256}; pg8::StaticOrder So; So.init(S, NIN, G, bx);
          pg8::EpiScaleBf16 E{P, NIN, part, (LAS float*)(lds + 131072 + 8192)};
          pg8::gemm_phase<pg8::EpiScaleBf16, pg8::StaticOrder, true, true>(lds, g, So, E); }
        xcd_barrier(xbar);
        for (int u = bx; u < S / 64; u += G)
            mixer_unit(lds, u, P, Y, conv_w + l * 3 * 256, sgu_norm + l * 256, sgu_w + (size_t)l * 4 * 128 * 128, sgu_b + l * 4 * 128, tid, wave, lane);
        xcd_barrier(xbar);
        { pg8::Gemm g{Y, Wout_t + (size_t)l * DM * DM, S, DM, DM, 256}; pg8::StaticOrder So; So.init(S, DM, G, bx);
          pg8::EpiResid E{l == 0 ? x_in : xcur, xcur, XB, part};
          pg8::gemm_phase<pg8::EpiResid, pg8::StaticOrder, true, true>(lds, g, So, E); }
        xcd_barrier(xbar);
        { pg8::Gemm g{XB - 2 * DM, Wup_t + (size_t)l * NUP * DM, 65 * 256, NUP, DM, 254}; pg8::StaticOrder So; So.init(65 * 256, NUP, G, bx);
          pg8::EpiGate E{A, part, ffn_conv + (size_t)l * 3 * NUP, (LAS float*)(lds + 131072)};
          pg8::gemm_phase<pg8::EpiGate, pg8::StaticOrder, true, true>(lds, g, So, E); }
        xcd_barrier(xbar);
        { pg8::Gemm g{A, Wdn_t + (size_t)l * DM * DFF, S, DM, DFF, 256}; pg8::StaticOrder So; So.init(S, DM, G, bx);
          pg8::EpiResid E{xcur, xcur, XB, part};
          pg8::gemm_phase<pg8::EpiResid, pg8::StaticOrder, true, true>(lds, g, So, E); }
        xcd_barrier(xbar);
    }
    for (int m = gw; m < S; m += NGW) { f32x4* xr = (f32x4*)(xcur + (size_t)m * DM) + lane; f32x4 v[4]; float ss = 0.f;
#pragma unroll
        for (int j = 0; j < 4; ++j) { v[j] = xr[64 * j]; ss += (v[j][0] * v[j][0] + v[j][1] * v[j][1]) + (v[j][2] * v[j][2] + v[j][3] * v[j][3]); }
        const float rs = __builtin_amdgcn_rsqf(wave_sum(ss) * (1.0f / 1024.0f) + EPS);
#pragma unroll
        for (int j = 0; j < 4; ++j) { const f32x4 g = *((const f32x4*)norm_final + lane + 64 * j); xr[64 * j] = v[j] * rs * g; } }
}

extern "C" void kernel_launch(void* const* d_in, const int* in_sizes, int n_in, void* d_out, int out_size, void* d_ws, size_t ws_size, hipStream_t stream) {
    static int grid = 0;
    if (grid == 0) {
        if (n_in != 14 || out_size != S * DM || ws_size < WS_END) { fprintf(stderr, "kernel_launch: unexpected shapes / workspace (%d inputs, out %d, ws %zu)\n", n_in, out_size, ws_size); grid = -1; return; }
        int dev = 0, cus = 0, per_cu = 0;
        hipGetDevice(&dev); hipDeviceGetAttribute(&cus, hipDeviceAttributeMultiprocessorCount, dev);
        hipFuncSetAttribute((const void*)hybrid_fwd, hipFuncAttributeMaxDynamicSharedMemorySize, LDS_BYTES);
        hipOccupancyMaxActiveBlocksPerMultiprocessor(&per_cu, (const void*)hybrid_fwd, NTHR, LDS_BYTES);
        (void)hipGetLastError();
        if (per_cu < 1) per_cu = 1;
        grid = cus * 1;
    }
    if (grid < 0) return;
    hipMemsetAsync((unsigned char*)d_ws, 0, 16384, stream);
    hipMemsetAsync((unsigned char*)d_ws + WS_XB - 4096, 0, 4096, stream);
    Args a{};
    for (int i = 0; i < 14; ++i) a.in[i] = (const float*)d_in[i];
    a.out = (float*)d_out; a.ws = (unsigned char*)d_ws;
    void* kargs[] = {&a};
    hipError_t e = hipLaunchCooperativeKernel((const void*)hybrid_fwd, dim3(grid), dim3(NTHR), kargs, LDS_BYTES, stream);
    if (e != hipSuccess) fprintf(stderr, "cooperative launch failed: %s (grid %d)\n", hipGetErrorString(e), grid);
}
```

```cpp
#include <hip/hip_runtime.h>
#include <hip/hip_cooperative_groups.h>
#include <cstdio>
#include <cstdint>
namespace cg = cooperative_groups;
namespace pg8 {
#define PG8_LAS __attribute__((address_space(3)))
typedef unsigned short bf16_t;
typedef short bf16x8 __attribute__((ext_vector_type(8)));
typedef float f32x4 __attribute__((ext_vector_type(4)));
typedef unsigned u32x4 __attribute__((ext_vector_type(4)));
typedef unsigned u32x2 __attribute__((ext_vector_type(2)));
constexpr int BM = 256, BK = 64, HALF = 128, HTB = HALF * BK * 2  , STAGE_BYTES = 8 * HTB, NXCD = 8, WGM = 8;

__host__ __device__ __forceinline__ int lds_byte(int r, int c) { const int st = (r >> 4) * 2 + (c >> 5), rr = r & 15, cc = c & 31, ob = rr * 64 + cc * 2; return st * 1024 + (ob ^ (((ob >> 9) & 1) << 5)); }
__host__ __device__ __forceinline__ void stage_rc(int b, int& R, int& C) { const int st = b / 1024, sb = b % 1024, swz = sb ^ (((sb >> 9) & 1) << 5); R = (st >> 1) * 16 + swz / 64; C = (st & 1) * 32 + (swz % 64) / 2; }
__host__ __device__ __forceinline__ int perm32(int rho) { const int n = rho >> 4, i = rho & 15; return 8 * (i >> 2) + 4 * n + (i & 3); }

struct Unit { int pm, pn; };
struct Gemm { const bf16_t* A; const bf16_t* Bt; int M, N, K; int arows; };

struct StaticOrder {
    int nM, nN, nwg, G, c;
    __host__ __device__ void init(int M, int N, int G_, int c_) { nM = M / BM; nN = N / BM; nwg = nM * nN; G = G_; c = c_; }
    __host__ __device__ bool next(int i, Unit& u) const {
        const long L = (long)i * G + c; if (L >= nwg) return false;
        int wgid = (int)L; { const int q = nwg / NXCD, r = nwg % NXCD, xcd = wgid % NXCD, off = wgid / NXCD; wgid = (xcd < r ? xcd * (q + 1) : r * (q + 1) + (xcd - r) * q) + off; }
        const int nig = WGM * nN, gid = wgid / nig, fm = gid * WGM, gsz = (nM - fm) < WGM ? (nM - fm) : WGM;
        u.pm = fm + ((wgid % nig) % gsz); u.pn = (wgid % nig) / gsz; return true;
    }
    __device__ __forceinline__ void a_ready(const Unit&) const {}
    __device__ __forceinline__ void done(const Unit&) const {}
};

__device__ __forceinline__ unsigned cvt_pk_bf16(float lo, float hi) { unsigned r; asm volatile("v_cvt_pk_bf16_f32 %0, %1, %2" : "=v"(r) : "v"(lo), "v"(hi)); return r; }
struct EpiScaleBf16 {
    static constexpr bool PERM = true, AFTER_DRAIN = false;
    bf16_t* O; int ldc; const float* part; PG8_LAS float* rsl;
    __device__ __forceinline__ void operator()(const f32x4 (&acc)[2][2][4][2], const Unit& u, int wr, int wc, int fr, int fq) const {
        { const int t = (wr * 4 + wc) * 64 + fq * 16 + fr;
          if (t < 256) { const f32x4* pp = (const f32x4*)(part + (size_t)(u.pm * BM + t) * 16); const f32x4 a = pp[0], b = pp[1], c = pp[2], d = pp[3];
              const f32x4 s4 = (a + b) + (c + d); const float ss = (s4[0] + s4[1]) + (s4[2] + s4[3]); rsl[t] = __builtin_amdgcn_rsqf(ss * (1.0f / 1024.0f) + 1e-6f); } }
        asm volatile("s_waitcnt lgkmcnt(0)" ::: "memory"); __builtin_amdgcn_s_barrier(); asm volatile("" ::: "memory");
        const int row0 = u.pm * BM + wr * 64 + fr; const int col0 = u.pn * BM + wc * 32 + 8 * fq;
#pragma unroll
        for (int ai = 0; ai < 2; ++ai)
#pragma unroll
            for (int m = 0; m < 4; ++m) { const int row = row0 + ai * HALF + m * 16;
                const float rs = rsl[ai * HALF + wr * 64 + m * 16 + fr];
                bf16_t* rowp = O + (size_t)row * ldc + col0;
#pragma unroll
                for (int bj = 0; bj < 2; ++bj) { const f32x4 v0 = acc[ai][bj][m][0] * rs, v1 = acc[ai][bj][m][1] * rs;
                    u32x4 w; w.x = cvt_pk_bf16(v0[0], v0[1]); w.y = cvt_pk_bf16(v0[2], v0[3]); w.z = cvt_pk_bf16(v1[0], v1[1]); w.w = cvt_pk_bf16(v1[2], v1[3]);
                    *(u32x4*)(rowp + bj * HALF) = w; } }
    }
};
struct EpiResid {
    static constexpr bool PERM = true, AFTER_DRAIN = false;
    const float* base; float* out; bf16_t* xb; float* part;
    __device__ __forceinline__ void operator()(const f32x4 (&acc)[2][2][4][2], const Unit& u, int wr, int wc, int fr, int fq) const {
        const int row0 = u.pm * BM + wr * 64 + fr; const int col0 = u.pn * BM + wc * 32 + 8 * fq;
        f32x4 pre[3][4];
#define PG8_RLOAD(g_) do { const size_t o_ = (size_t)(row0 + ((g_) >> 2) * HALF + ((g_) & 3) * 16) * 1024 + col0; \
            pre[(g_) % 3][0] = *(const f32x4*)(base + o_); pre[(g_) % 3][1] = *(const f32x4*)(base + o_ + 4); pre[(g_) % 3][2] = *(const f32x4*)(base + o_ + HALF); pre[(g_) % 3][3] = *(const f32x4*)(base + o_ + HALF + 4); } while (0)
        PG8_RLOAD(0); PG8_RLOAD(1);
#pragma unroll
        for (int g = 0; g < 8; ++g) { const int ai = g >> 2, m = g & 3;
            if (g + 2 < 8) PG8_RLOAD(g + 2);
            asm volatile("" ::: "memory");
            const int row = row0 + ai * HALF + m * 16; const size_t off = (size_t)row * 1024 + col0; float ss = 0.f;
#pragma unroll
            for (int bj = 0; bj < 2; ++bj) { const f32x4 v0 = acc[ai][bj][m][0] + pre[g % 3][2 * bj], v1 = acc[ai][bj][m][1] + pre[g % 3][2 * bj + 1];
                *(f32x4*)(out + off + bj * HALF) = v0; *(f32x4*)(out + off + bj * HALF + 4) = v1;
                ss += (v0[0] * v0[0] + v0[1] * v0[1]) + (v0[2] * v0[2] + v0[3] * v0[3]) + (v1[0] * v1[0] + v1[1] * v1[1]) + (v1[2] * v1[2] + v1[3] * v1[3]);
                u32x4 w; w.x = cvt_pk_bf16(v0[0], v0[1]); w.y = cvt_pk_bf16(v0[2], v0[3]); w.z = cvt_pk_bf16(v1[0], v1[1]); w.w = cvt_pk_bf16(v1[2], v1[3]);
                *(u32x4*)(xb + off + bj * HALF) = w; }
            ss += __shfl_xor(ss, 16); ss += __shfl_xor(ss, 32);
            if (fq == 0) part[(size_t)row * 16 + u.pn * 4 + wc] = ss;
            asm volatile("" ::: "memory"); }
#undef PG8_RLOAD
    }
};
#define PG8_DPP(oldv, srcv, ctrl) __builtin_bit_cast(float, __builtin_amdgcn_update_dpp(__builtin_bit_cast(int, (float)(oldv)), __builtin_bit_cast(int, (float)(srcv)), (ctrl), 0xf, 0xf, false))
struct EpiGate {
    static constexpr bool PERM = true, AFTER_DRAIN = false;
    bf16_t* Aout; const float* part; const float* fconv; PG8_LAS float* xch;
    __device__ __forceinline__ void operator()(f32x4 (&acc)[2][2][4][2], const Unit& u, int wr, int wc, int fr, int fq) const {
        PG8_LAS float* rsl = xch + 2048;
        { const int t = (wr * 4 + wc) * 64 + fq * 16 + fr;
          if (t < 256) { const int row = u.pm * 254 - 2 + t; const bool ok = row >= 0 && row < 16384; const int rc = ok ? row : 0;
              const f32x4* pp = (const f32x4*)(part + (size_t)rc * 16); const f32x4 a = pp[0], b = pp[1], c = pp[2], d = pp[3];
              const f32x4 s4 = (a + b) + (c + d); const float ss = (s4[0] + s4[1]) + (s4[2] + s4[3]);
              rsl[t] = ok ? __builtin_amdgcn_rsqf(ss * (1.0f / 1024.0f) + 1e-6f) : 0.f; } }
        asm volatile("s_waitcnt lgkmcnt(0)" ::: "memory"); __builtin_amdgcn_s_barrier(); asm volatile("" ::: "memory");
        const int ccol = wc * 32 + 8 * fq;
#pragma unroll
        for (int ai = 0; ai < 2; ++ai)
#pragma unroll
            for (int m = 0; m < 4; ++m) { const float rs = rsl[ai * HALF + wr * 64 + m * 16 + fr];
#pragma unroll
                for (int bj = 0; bj < 2; ++bj) { acc[ai][bj][m][0] *= rs; acc[ai][bj][m][1] *= rs; } }
        if (fr >= 14) {
#pragma unroll
            for (int ai = 0; ai < 2; ++ai)
#pragma unroll
                for (int bj = 0; bj < 2; ++bj)
#pragma unroll
                    for (int n = 0; n < 2; ++n) *(PG8_LAS f32x4*)(xch + ((2 * ai + wr) * 2 + (fr & 1)) * 256 + bj * HALF + ccol + 4 * n) = acc[ai][bj][3][n];
        }
        asm volatile("s_waitcnt lgkmcnt(0)" ::: "memory"); __builtin_amdgcn_s_barrier(); asm volatile("" ::: "memory");
        const int ch0 = u.pn * HALF + ccol;
#pragma unroll
        for (int ai = 0; ai < 2; ++ai) {
            const int grp = 2 * ai + wr;
#pragma unroll
            for (int n = 0; n < 2; ++n) {
                asm volatile("" ::: "memory");
                const float* fw = fconv + ch0 + 4 * n;
                const f32x4 wg0 = *(const f32x4*)(fw), wg1 = *(const f32x4*)(fw + 5632), wg2 = *(const f32x4*)(fw + 2 * 5632);
                const f32x4 wu0 = *(const f32x4*)(fw + 2816), wu1 = *(const f32x4*)(fw + 5632 + 2816), wu2 = *(const f32x4*)(fw + 2 * 5632 + 2816);
                f32x4 xpg = {0.f, 0.f, 0.f, 0.f}, xpu = {0.f, 0.f, 0.f, 0.f};
                if (grp > 0) { xpg = *(const PG8_LAS f32x4*)(xch + ((grp - 1) * 2 + (fr & 1)) * 256 + ccol + 4 * n); xpu = *(const PG8_LAS f32x4*)(xch + ((grp - 1) * 2 + (fr & 1)) * 256 + HALF + ccol + 4 * n); }
#pragma unroll
                for (int m = 0; m < 4; ++m) {
                    float o[4];
#pragma unroll
                    for (int j = 0; j < 4; ++j) {
                        const float xg = acc[ai][0][m][n][j], xu = acc[ai][1][m][n][j];
                        const float pg = m > 0 ? acc[ai][0][m > 0 ? m - 1 : 0][n][j] : xpg[j], pu = m > 0 ? acc[ai][1][m > 0 ? m - 1 : 0][n][j] : xpu[j];
                        const float g1 = PG8_DPP(PG8_DPP(0.f, pg, 0x121), xg, 0x111), g2 = PG8_DPP(PG8_DPP(0.f, pg, 0x122), xg, 0x112);
                        const float u1 = PG8_DPP(PG8_DPP(0.f, pu, 0x121), xu, 0x111), u2 = PG8_DPP(PG8_DPP(0.f, pu, 0x122), xu, 0x112);
                        const float Gv = wg0[j] * g2 + wg1[j] * g1 + wg2[j] * xg, Uv = wu0[j] * u2 + wu1[j] * u1 + wu2[j] * xu;
                        o[j] = Gv * __builtin_amdgcn_rcpf(1.0f + __expf(-Gv)) * Uv; }
                    const int r = ai * HALF + wr * 64 + m * 16 + fr, row = u.pm * 254 - 2 + r;
                    u32x2 w; w.x = cvt_pk_bf16(o[0], o[1]); w.y = cvt_pk_bf16(o[2], o[3]);
                    if (r >= 2 && row < 16384) *(u32x2*)(Aout + (size_t)row * 2816 + ch0 + 4 * n) = w; }
            }
        }
    }
};
template <class Epi, class Sched, bool ALIGN_EPI = false, bool SP2 = false>
__device__ __forceinline__ void gemm_phase(PG8_LAS unsigned char* lds, const Gemm g, const Sched& S, const Epi& E) {
    int tid = threadIdx.x; asm volatile("" : "+v"(tid));
    const int wid = __builtin_amdgcn_readfirstlane(tid >> 6), lane = tid & 63, wr = wid >> 2, wc = wid & 3, fr = lane & 15, fq = lane >> 4;
    const int K = g.K, nt = K / BK;
    unsigned voffA[2], voffB[2];
#pragma unroll
    for (int i = 0; i < 2; ++i) { int R, C; stage_rc(tid * 16 + i * 8192, R, C); const int Rb = Epi::PERM ? ((R & ~31) + perm32(R & 31)) : R;
        voffA[i] = (unsigned)(R * K + C) * 2u; voffB[i] = (unsigned)(Rb * K + C) * 2u; }
    const size_t kstep = (size_t)(BK * 2);
    const size_t hstep = (size_t)HALF * K * 2;
    const size_t tstep = 2 * hstep;
    const size_t tstepA = (size_t)g.arows * K * 2;
    const unsigned ldsw = (unsigned)wid * 1024u;
    const int aoff = lds_byte(wr * 64 + fr, fq * 8), boff = lds_byte(wc * 32 + fr, fq * 8);
#define PG8_SA(b, h) (((b) * 2 + (h)) * HTB)
#define PG8_SB(b, h) ((4 + (b) * 2 + (h)) * HTB)
#define PG8_STAGE(bufoff, gbase, voff) do { _Pragma("unroll") for (int _i = 0; _i < 2; ++_i) \
        __builtin_amdgcn_global_load_lds((const unsigned*)((const char*)(gbase) + (voff)[_i]), (PG8_LAS unsigned*)(lds + (bufoff) + ldsw + _i * 8192), 16, 0, 0); } while (0)
#define PG8_LDA(dst, b, h) do { _Pragma("unroll") for (int m = 0; m < 4; ++m) _Pragma("unroll") for (int k = 0; k < 2; ++k) dst[m][k] = *(const PG8_LAS bf16x8*)(lds + PG8_SA(b, h) + aoff + m * 2048 + k * 1024); } while (0)
#define PG8_LDB(dst, b, h) do { _Pragma("unroll") for (int n = 0; n < 2; ++n) _Pragma("unroll") for (int k = 0; k < 2; ++k) dst[n][k] = *(const PG8_LAS bf16x8*)(lds + PG8_SB(b, h) + boff + n * 2048 + k * 1024); } while (0)
#define PG8_MMA(ai, bj, At, Bt) do { __builtin_amdgcn_s_setprio(1); _Pragma("unroll") for (int m = 0; m < 4; ++m) _Pragma("unroll") for (int n = 0; n < 2; ++n) _Pragma("unroll") for (int k = 0; k < 2; ++k) \
        acc[ai][bj][m][n] = __builtin_amdgcn_mfma_f32_16x16x32_bf16(Bt[n][k], At[m][k], acc[ai][bj][m][n], 0, 0, 0); __builtin_amdgcn_s_setprio(0); } while (0)
#define PG8_WAIT_V(n) asm volatile("s_waitcnt vmcnt(" #n ")" ::: "memory")
#define PG8_WAIT_L(n) asm volatile("s_waitcnt lgkmcnt(" #n ")" ::: "memory")
#define PG8_BAR __builtin_amdgcn_s_barrier()
#define PG8_SCHED __builtin_amdgcn_sched_barrier(0)
    Unit cur, nxt; int ui = 0;
    if (!S.next(0, cur)) return;
    f32x4 acc[2][2][4][2];
#pragma unroll
    for (int a = 0; a < 2; ++a)
#pragma unroll
        for (int b = 0; b < 2; ++b)
#pragma unroll
            for (int m = 0; m < 4; ++m)
#pragma unroll
                for (int n = 0; n < 2; ++n) acc[a][b][m][n] = (f32x4){0.f, 0.f, 0.f, 0.f};
    bf16x8 At[4][2], B0[2][2], B1[2][2];
    const char* cA = (const char*)g.A + (size_t)cur.pm * tstepA; const char* cB = (const char*)g.Bt + (size_t)cur.pn * tstep;
    S.a_ready(cur);
    if constexpr (SP2) {
        PG8_STAGE(PG8_SB(0, 0), cB, voffB); PG8_STAGE(PG8_SB(0, 1), cB + hstep, voffB); PG8_STAGE(PG8_SA(0, 0), cA, voffA); PG8_STAGE(PG8_SA(0, 1), cA + hstep, voffA);
        if (wr == 1) PG8_BAR;
        PG8_WAIT_V(2); PG8_BAR;
        PG8_STAGE(PG8_SB(1, 0), cB + kstep, voffB); PG8_STAGE(PG8_SA(1, 0), cA + kstep, voffA); PG8_STAGE(PG8_SB(1, 1), cB + hstep + kstep, voffB);
        PG8_WAIT_V(6); PG8_BAR;
    } else {
        PG8_STAGE(PG8_SB(0, 0), cB, voffB); PG8_STAGE(PG8_SA(0, 0), cA, voffA); PG8_STAGE(PG8_SB(0, 1), cB + hstep, voffB); PG8_STAGE(PG8_SA(0, 1), cA + hstep, voffA);
        if (wr == 1) PG8_BAR;
        PG8_WAIT_V(4); PG8_BAR;
        PG8_STAGE(PG8_SB(1, 0), cB + kstep, voffB); PG8_STAGE(PG8_SA(1, 0), cA + kstep, voffA); PG8_STAGE(PG8_SB(1, 1), cB + hstep + kstep, voffB);
        PG8_WAIT_V(6); PG8_BAR;
    }
    for (;;) {
        const bool has_next = S.next(ui + 1, nxt);
        const char* nA = has_next ? (const char*)g.A + (size_t)nxt.pm * tstepA : cA; const char* nB = has_next ? (const char*)g.Bt + (size_t)nxt.pn * tstep : cB;
        for (int t = 0; t < nt; t += 2) {
            const bool last = (t == nt - 2);
            const char* a1 = cA + (size_t)(t + 1) * kstep;
            const char* a2 = last ? nA : cA + (size_t)(t + 2) * kstep; const char* b2 = last ? nB : cB + (size_t)(t + 2) * kstep;
            const char* a3 = a2 + kstep; const char* b3 = b2 + kstep;
            if (last && has_next) S.a_ready(nxt);
            if constexpr (SP2) {
            PG8_LDB(B0, 0, 0); PG8_LDB(B1, 0, 1); PG8_SCHED; PG8_LDA(At, 0, 0); PG8_STAGE(PG8_SA(1, 1), a1 + hstep, voffA);
            PG8_WAIT_V(8); PG8_WAIT_L(0); PG8_BAR; PG8_MMA(0, 0, At, B0); PG8_MMA(0, 1, At, B1); PG8_BAR; PG8_SCHED;
            PG8_LDA(At, 0, 1); PG8_STAGE(PG8_SB(0, 0), b2, voffB); PG8_STAGE(PG8_SB(0, 1), b2 + hstep, voffB); PG8_STAGE(PG8_SA(0, 0), a2, voffA);
            PG8_WAIT_V(8); PG8_WAIT_L(0); PG8_BAR; PG8_MMA(1, 0, At, B0); PG8_MMA(1, 1, At, B1); PG8_BAR; PG8_SCHED;
            PG8_LDB(B0, 1, 0); PG8_LDB(B1, 1, 1); PG8_SCHED; PG8_LDA(At, 1, 0); PG8_STAGE(PG8_SA(0, 1), a2 + hstep, voffA);
            PG8_WAIT_V(8); PG8_WAIT_L(0); PG8_BAR; PG8_MMA(0, 0, At, B0); PG8_MMA(0, 1, At, B1); PG8_BAR; PG8_SCHED;
            PG8_LDA(At, 1, 1); PG8_STAGE(PG8_SB(1, 0), b3, voffB); PG8_STAGE(PG8_SB(1, 1), b3 + hstep, voffB); PG8_STAGE(PG8_SA(1, 0), a3, voffA);
            PG8_WAIT_V(8); PG8_WAIT_L(0); PG8_BAR; PG8_MMA(1, 0, At, B0); PG8_MMA(1, 1, At, B1); PG8_BAR; PG8_SCHED;
            } else {
            PG8_LDB(B0, 0, 0); PG8_SCHED; PG8_LDA(At, 0, 0); PG8_STAGE(PG8_SA(1, 1), a1 + hstep, voffA);
            PG8_WAIT_L(8); PG8_BAR; PG8_WAIT_L(0); PG8_MMA(0, 0, At, B0); PG8_BAR; PG8_SCHED;
            PG8_LDB(B1, 0, 1); PG8_STAGE(PG8_SB(0, 0), b2, voffB);
            PG8_BAR; PG8_WAIT_L(0); PG8_MMA(0, 1, At, B1); PG8_BAR;
            PG8_LDA(At, 0, 1); PG8_STAGE(PG8_SA(0, 0), a2, voffA);
            PG8_BAR; PG8_WAIT_L(0); PG8_MMA(1, 0, At, B0); PG8_BAR; PG8_SCHED;
            PG8_STAGE(PG8_SB(0, 1), b2 + hstep, voffB);
            PG8_WAIT_V(6); PG8_BAR; PG8_MMA(1, 1, At, B1); PG8_BAR;
            PG8_LDB(B0, 1, 0); PG8_SCHED; PG8_LDA(At, 1, 0); PG8_STAGE(PG8_SA(0, 1), a2 + hstep, voffA);
            PG8_WAIT_L(8); PG8_BAR; PG8_WAIT_L(0); PG8_MMA(0, 0, At, B0); PG8_BAR; PG8_SCHED;
            PG8_LDB(B1, 1, 1); PG8_STAGE(PG8_SB(1, 0), b3, voffB);
            PG8_BAR; PG8_WAIT_L(0); PG8_MMA(0, 1, At, B1); PG8_BAR;
            PG8_LDA(At, 1, 1); PG8_STAGE(PG8_SA(1, 0), a3, voffA);
            PG8_BAR; PG8_WAIT_L(0); PG8_MMA(1, 0, At, B0); PG8_BAR; PG8_SCHED;
            PG8_STAGE(PG8_SB(1, 1), b3 + hstep, voffB);
            PG8_WAIT_V(6); PG8_BAR; PG8_MMA(1, 1, At, B1); PG8_BAR;
            }
        }
        if constexpr (ALIGN_EPI) { if (wr == 0) PG8_BAR; }
        if constexpr (!Epi::AFTER_DRAIN) { E(acc, cur, wr, wc, fr, fq); S.done(cur); }
        if (!has_next) break;
#pragma unroll
        for (int a = 0; a < 2; ++a)
#pragma unroll
            for (int b = 0; b < 2; ++b)
#pragma unroll
                for (int m = 0; m < 4; ++m)
#pragma unroll
                    for (int n = 0; n < 2; ++n) acc[a][b][m][n] = (f32x4){0.f, 0.f, 0.f, 0.f};
        cur = nxt; cA = nA; cB = nB; ++ui;
        if constexpr (ALIGN_EPI) { if (wr == 1) PG8_BAR; }
    }
    PG8_WAIT_V(0);
    if constexpr (!ALIGN_EPI) { if (wr == 0) PG8_BAR; }
    PG8_BAR;
    if constexpr (Epi::AFTER_DRAIN) { E.fused(acc, cur, wr, wc, fr, fq, lds, wid, lane); S.done(cur); }
#undef PG8_SA
#undef PG8_SB
#undef PG8_STAGE
#undef PG8_LDA
#undef PG8_LDB
#undef PG8_MMA
#undef PG8_WAIT_V
#undef PG8_WAIT_L
#undef PG8_BAR
#undef PG8_SCHED
}
}
constexpr int S = 16384, DM = 1024, DEPTH = 4, NIN = 2816, DFF = 2816, NUP = 5632;
constexpr float EPS = 1e-6f;
constexpr int NWAVES = 8, NTHR = 512;
constexpr size_t MiB = 1u << 20;
constexpr size_t WS_WIN = 1 * MiB, WS_WOUT = 23 * MiB, WS_WUP = 31 * MiB, WS_WDN = 75 * MiB;
constexpr size_t WS_PART = 97 * MiB;
constexpr size_t WS_XB = 98 * MiB + 4096;
constexpr size_t WS_P = 131 * MiB;
constexpr size_t WS_Y = 219 * MiB;
constexpr size_t WS_GU = 131 * MiB;
constexpr size_t WS_A = 219 * MiB;
constexpr size_t WS_END = 307 * MiB;
constexpr int LDS_BYTES = 147456;
#define LAS __attribute__((address_space(3)))
typedef unsigned short bf16;
typedef unsigned v4u __attribute__((ext_vector_type(4)));
typedef unsigned v2u __attribute__((ext_vector_type(2)));
typedef float f32x4 __attribute__((ext_vector_type(4)));
typedef float f32x16 __attribute__((ext_vector_type(16)));
typedef short bf16x8 __attribute__((ext_vector_type(8)));
#define LDS_WAIT() asm volatile("s_waitcnt lgkmcnt(0)" ::: "memory")
__device__ __forceinline__ unsigned pk2(float lo, float hi) { return pg8::cvt_pk_bf16(lo, hi); }
__device__ __forceinline__ float bflo(unsigned u) { return __uint_as_float(u << 16); }
__device__ __forceinline__ float bfhi(unsigned u) { return __uint_as_float(u & 0xffff0000u); }
__device__ __forceinline__ float bf1(bf16 v) { return __uint_as_float((unsigned)v << 16); }
__device__ __forceinline__ float wave_sum(float v) {
#pragma unroll
    for (int o = 1; o < 64; o <<= 1) v += __shfl_xor(v, o);
    return v;
}

__device__ __forceinline__ void cvt_item(const float* W, int K, int N, bf16* WT, const float* gain, int mode, LAS float* scr, int item, int lane) {
    const int nblk = N / 32, kb = item / nblk, nb = item % nblk, k0 = 64 * kb, n0 = 32 * nb;
#pragma unroll 8
    for (int i = 0; i < 32; ++i) { const int kk = 2 * i + (lane >> 5); const float g = gain ? gain[k0 + kk] : 1.0f; scr[kk * 33 + (lane & 31)] = W[(size_t)(k0 + kk) * N + n0 + (lane & 31)] * g; }
    LDS_WAIT(); asm volatile("" ::: "memory");
    const float cs = (mode == 1 && n0 >= 1280 && n0 < 1792) ? 0.125f : 1.0f;
    int rb = n0;
    if (mode == 2) { rb = (n0 < DFF) ? 256 * (n0 / 128) + (n0 % 128) : 256 * ((n0 - DFF) / 128) + 128 + ((n0 - DFF) % 128); }
    const int c = lane & 7;
#pragma unroll
    for (int j = 0; j < 4; ++j) { const int n = (lane >> 3) + 8 * j; const LAS float* s = scr + (8 * c) * 33 + n;
        v4u o; o.x = pk2(s[0 * 33] * cs, s[1 * 33] * cs); o.y = pk2(s[2 * 33] * cs, s[3 * 33] * cs); o.z = pk2(s[4 * 33] * cs, s[5 * 33] * cs); o.w = pk2(s[6 * 33] * cs, s[7 * 33] * cs);
        *(v4u*)(WT + (size_t)(rb + n) * K + k0 + 8 * c) = o; }
    LDS_WAIT(); asm volatile("" ::: "memory");
}

typedef __attribute__((address_space(1))) unsigned gu32;
#define XB_TMO      128
#define XB_XCNT(j)  (256  + 64 * (j))
#define XB_XSUB(j)  (1280 + 64 * (j))
#define XB_XGEN(j)  (2304 + 64 * (j))
#define XB_TOP      3328
#define XB_TOPGEN   3392
#define XCD_BAR_WORDS 3456
#define XB_SPIN_CAP (1u << 18)

__device__ __forceinline__ unsigned xb_ld(unsigned* p)              { return __hip_atomic_load(p, __ATOMIC_RELAXED, __HIP_MEMORY_SCOPE_AGENT); }
__device__ __forceinline__ unsigned xb_add(unsigned* p, unsigned v) { return __hip_atomic_fetch_add(p, v, __ATOMIC_RELAXED, __HIP_MEMORY_SCOPE_AGENT); }
__device__ __forceinline__ unsigned xb_xcc_id() { return (unsigned)__builtin_amdgcn_s_getreg((3 << 11) | 20) & 0xFu; }
#define XB_SPIN(cond, bar) do { unsigned _sp = 0; while (cond) { __builtin_amdgcn_s_sleep(1); \
    if ((++_sp & 255u) == 0u) { if (xb_ld(&(bar)[XB_TMO])) break; if (_sp > XB_SPIN_CAP) { atomicAdd(&(bar)[XB_TMO], 1u); break; } } } } while (0)

struct XcdBarrier {
    unsigned* bar; unsigned x;
    volatile LAS unsigned* st;
};

__device__ __forceinline__ XcdBarrier xcd_barrier_post(unsigned* bar, volatile LAS unsigned* st) {
    XcdBarrier b; b.bar = bar; b.x = xb_xcc_id(); b.st = st;
    if (threadIdx.x == 0) (void)xb_add(&bar[XB_XCNT(b.x)], 1u);
    return b;
}
__device__ __forceinline__ void xcd_barrier_complete(unsigned* bar, unsigned x, unsigned& nloc, unsigned& nx) {
    const unsigned G = gridDim.x * gridDim.y * gridDim.z;
    unsigned sum, cnt, mine, sp = 0u;
    for (;;) {
        sum = 0u; cnt = 0u; mine = 0u;
#pragma unroll
        for (unsigned j = 0; j < 16; ++j) { const unsigned c = xb_ld(&bar[XB_XCNT(j)]); sum += c; cnt += (c > 0u) ? 1u : 0u; mine = (j == x) ? c : mine; }
        if (sum == G) break;
        __builtin_amdgcn_s_sleep(1);
        if ((++sp & 255u) == 0u) { if (xb_ld(&bar[XB_TMO])) break; if (sp > XB_SPIN_CAP) { atomicAdd(&bar[XB_TMO], 1u); break; } }
    }
    nloc = mine > 0u ? mine : 1u; nx = cnt > 0u ? cnt : 1u;
}

__device__ __forceinline__ void xcd_barrier(const XcdBarrier& b) {
    asm volatile("s_waitcnt vmcnt(0)" ::: "memory");
    __syncthreads();
    if (threadIdx.x == 0) {
        unsigned* bar = b.bar;
        __builtin_amdgcn_s_waitcnt(0);
        unsigned nloc = b.st[0], nx = b.st[1];
        if (nloc == 0u) { xcd_barrier_complete(bar, b.x, nloc, nx); b.st[0] = nloc; b.st[1] = nx; }
        const unsigned old = xb_add(&bar[XB_XSUB(b.x)], 1u);
        const unsigned gen = old / nloc;
        if (old + 1u == (gen + 1u) * nloc) {
            __builtin_amdgcn_fence(__ATOMIC_RELEASE, "agent");
            asm volatile("s_waitcnt vmcnt(0)" ::: "memory");
            const unsigned og = xb_add(&bar[XB_TOP], 1u);
            const unsigned tg = og / nx;
            if (og + 1u == (tg + 1u) * nx) xb_add(&bar[XB_TOPGEN], 1u);
            else XB_SPIN(xb_ld(&bar[XB_TOPGEN]) == tg, bar);
            __builtin_amdgcn_fence(__ATOMIC_ACQUIRE, "agent");
            xb_add(&bar[XB_XGEN(b.x)], 1u);
            asm volatile("s_waitcnt vmcnt(0)" ::: "memory");
        } else {
            XB_SPIN(xb_ld(&bar[XB_XGEN(b.x)]) == gen, bar);
            __builtin_amdgcn_fence(__ATOMIC_ACQUIRE, "agent");
            asm volatile("s_waitcnt vmcnt(0)" ::: "memory");
        }
    }
    __syncthreads();
}

struct Args { const float* in[14]; float* out; unsigned char* ws; };

__device__ __forceinline__ void norm_store_rows(const LAS float* tile, bf16* Y, int t0, int coff, int wave, int lane) {
#pragma unroll 2
    for (int i = 0; i < 8; ++i) { const int r = wave * 8 + i; const f32x4 v = *(const LAS f32x4*)(tile + r * 260 + lane * 4);
        const float ss = wave_sum((v[0] * v[0] + v[1] * v[1]) + (v[2] * v[2] + v[3] * v[3]));
        const float rs = __builtin_amdgcn_rsqf(ss * (1.0f / 256.0f) + EPS);
        v2u o; o.x = pk2(v[0] * rs, v[1] * rs); o.y = pk2(v[2] * rs, v[3] * rs);
        *(v2u*)(Y + (size_t)(t0 + r) * DM + coff + lane * 4) = o; }
}

__device__ __forceinline__ void mixer_unit(LAS unsigned char* lds, int unit, const bf16* P, bf16* Y, const float* conv_w, const float* sgu_norm, const float* sgu_w, const float* sgu_b, int tid, int wave, int lane) {
    const int t0 = unit * 64;
    asm volatile("" : "+v"(tid), "+v"(lane));
    LAS bf16* vnT = (LAS bf16*)lds;
    LAS float* tile = (LAS float*)(lds + 69632);
    LAS float* sm_ss = (LAS float*)(lds + 69632 + 66560);
    {
        const int hd = wave, r = lane & 31, h = lane >> 5;
        const int pr = (r & 0x13) | ((r & 4) << 1) | ((r & 8) >> 1);
        LAS bf16* Vt = (LAS bf16*)(lds + wave * 5120);
        bf16x8 atri[2];
#pragma unroll
        for (int sI = 0; sI < 2; ++sI) { v4u t;
            t.x = ((16 * sI + 8 * h + 0 > pr) ? 0x3F80u : 0u) | ((16 * sI + 8 * h + 1 > pr) ? 0x3F800000u : 0u); t.y = ((16 * sI + 8 * h + 2 > pr) ? 0x3F80u : 0u) | ((16 * sI + 8 * h + 3 > pr) ? 0x3F800000u : 0u);
            t.z = ((16 * sI + 8 * h + 4 > pr) ? 0x3F80u : 0u) | ((16 * sI + 8 * h + 5 > pr) ? 0x3F800000u : 0u); t.w = ((16 * sI + 8 * h + 6 > pr) ? 0x3F80u : 0u) | ((16 * sI + 8 * h + 7 > pr) ? 0x3F800000u : 0u);
            atri[sI] = __builtin_bit_cast(bf16x8, t); }
        f32x16 oacc[2][2]; float ssq[2];
#pragma unroll
        for (int qh = 0; qh < 2; ++qh) {
            const int tq = t0 + 32 * qh;
            bf16x8 qf[4];
#pragma unroll
            for (int ks = 0; ks < 4; ++ks) qf[ks] = *(const bf16x8*)(P + (size_t)(tq + r) * NIN + 1280 + hd * 64 + 16 * ks + 8 * h);
            f32x16 o0 = {}, o1 = {};
            float ls = 0.f;
            bf16x8 kfn[4]; v4u vvn[4];
            { const bf16* kp = P + (size_t)(tq + pr) * NIN + 1792 + hd * 64 + 8 * h;
#pragma unroll
              for (int ks = 0; ks < 4; ++ks) kfn[ks] = *(const bf16x8*)(kp + 16 * ks);
#pragma unroll
              for (int i = 0; i < 4; ++i) vvn[i] = *(const v4u*)(P + (size_t)(tq + (lane >> 3) + 8 * i) * NIN + 2304 + hd * 64 + 8 * (lane & 7)); }
            for (int k0 = tq;; k0 -= 32) {
                const bool diag = (k0 == tq);
                f32x16 z = {};
#pragma unroll
                for (int ks = 0; ks < 4; ++ks) z = __builtin_amdgcn_mfma_f32_32x32x16_bf16(kfn[ks], qf[ks], z, 0, 0, 0);
#pragma unroll
                for (int i = 0; i < 4; ++i) { const int key = (lane >> 3) + 8 * i, c = lane & 7; const v4u vv = vvn[i];
                    LAS bf16* vd = Vt + (8 * c) * 40 + key;
                    vd[0] = (bf16)(vv.x & 0xffffu); vd[40] = (bf16)(vv.x >> 16); vd[80] = (bf16)(vv.y & 0xffffu); vd[120] = (bf16)(vv.y >> 16);
                    vd[160] = (bf16)(vv.z & 0xffffu); vd[200] = (bf16)(vv.z >> 16); vd[240] = (bf16)(vv.w & 0xffffu); vd[280] = (bf16)(vv.w >> 16); }
                if (k0 >= 32) { const bf16* kp = P + (size_t)(k0 - 32 + pr) * NIN + 1792 + hd * 64 + 8 * h;
#pragma unroll
                    for (int ks = 0; ks < 4; ++ks) kfn[ks] = *(const bf16x8*)(kp + 16 * ks);
#pragma unroll
                    for (int i = 0; i < 4; ++i) vvn[i] = *(const v4u*)(P + (size_t)(k0 - 32 + (lane >> 3) + 8 * i) * NIN + 2304 + hd * 64 + 8 * (lane & 7)); }
                f32x16 cin; float rowsum = 0.f; unsigned lh[8], ll[8];
#pragma unroll
                for (int j = 0; j < 16; j += 2) { float Lv[2];
#pragma unroll
                    for (int e2 = 0; e2 < 2; ++e2) { const int jj = j + e2; const int keyl = 16 * (jj >> 3) + 8 * h + (jj & 7); const bool valid = !diag || (keyl < r);
                        const float zz = z[jj]; const float ex = __expf(-fabsf(zz)); const float lsig = fminf(zz, 0.f) - __logf(1.0f + ex);
                        Lv[e2] = valid ? (lsig - zz) : 0.f; cin[jj] = lsig + ls; rowsum += Lv[e2]; }
                    const unsigned hp = pk2(Lv[0], Lv[1]); lh[j >> 1] = hp; ll[j >> 1] = pk2(Lv[0] - bflo(hp), Lv[1] - bfhi(hp)); }
                bf16x8 bh0 = __builtin_bit_cast(bf16x8, (v4u){lh[0], lh[1], lh[2], lh[3]}), bh1 = __builtin_bit_cast(bf16x8, (v4u){lh[4], lh[5], lh[6], lh[7]});
                bf16x8 bl0 = __builtin_bit_cast(bf16x8, (v4u){ll[0], ll[1], ll[2], ll[3]}), bl1 = __builtin_bit_cast(bf16x8, (v4u){ll[4], ll[5], ll[6], ll[7]});
                f32x16 lw = __builtin_amdgcn_mfma_f32_32x32x16_bf16(atri[0], bh0, cin, 0, 0, 0);
                lw = __builtin_amdgcn_mfma_f32_32x32x16_bf16(atri[1], bh1, lw, 0, 0, 0);
                lw = __builtin_amdgcn_mfma_f32_32x32x16_bf16(atri[0], bl0, lw, 0, 0, 0);
                lw = __builtin_amdgcn_mfma_f32_32x32x16_bf16(atri[1], bl1, lw, 0, 0, 0);
                unsigned wp[8];
#pragma unroll
                for (int j = 0; j < 16; j += 2) { float wv[2];
#pragma unroll
                    for (int e2 = 0; e2 < 2; ++e2) { const int jj = j + e2; const int keyl = 16 * (jj >> 3) + 8 * h + (jj & 7); const bool valid = !diag || (keyl < r);
                        wv[e2] = valid ? __expf(lw[jj]) : 0.f; }
                    wp[j >> 1] = pk2(wv[0], wv[1]); }
                const bf16x8 w0 = __builtin_bit_cast(bf16x8, (v4u){wp[0], wp[1], wp[2], wp[3]}), w1 = __builtin_bit_cast(bf16x8, (v4u){wp[4], wp[5], wp[6], wp[7]});
                const LAS bf16* vr = Vt + r * 40 + 8 * h;
                o0 = __builtin_amdgcn_mfma_f32_32x32x16_bf16(*(const LAS bf16x8*)(vr), w0, o0, 0, 0, 0);
                o0 = __builtin_amdgcn_mfma_f32_32x32x16_bf16(*(const LAS bf16x8*)(vr + 16), w1, o0, 0, 0, 0);
                o1 = __builtin_amdgcn_mfma_f32_32x32x16_bf16(*(const LAS bf16x8*)(vr + 32 * 40), w0, o1, 0, 0, 0);
                o1 = __builtin_amdgcn_mfma_f32_32x32x16_bf16(*(const LAS bf16x8*)(vr + 32 * 40 + 16), w1, o1, 0, 0, 0);
                ls += rowsum + __shfl_xor(rowsum, 32);
                if (k0 < 32 || __builtin_amdgcn_ballot_w64(ls > -104.0f) == 0ull) break;
            }
            float ss = 0.f;
#pragma unroll
            for (int j = 0; j < 16; ++j) ss += o0[j] * o0[j] + o1[j] * o1[j];
            ss += __shfl_xor(ss, 32);
            if (h == 0) sm_ss[(32 * qh + r) * 8 + hd] = ss;
            oacc[qh][0] = o0; oacc[qh][1] = o1; ssq[qh] = ss;
        }
        LDS_WAIT(); __syncthreads();
#pragma unroll
        for (int qh = 0; qh < 2; ++qh) {
            const f32x4 sa = *(const LAS f32x4*)(sm_ss + (32 * qh + r) * 8), sb = *(const LAS f32x4*)(sm_ss + (32 * qh + r) * 8 + 4);
            const float tot = ((sa[0] + sa[1]) + (sa[2] + sa[3])) + ((sb[0] + sb[1]) + (sb[2] + sb[3]));
            const float rs = __builtin_amdgcn_rsqf(tot * (1.0f / 512.0f) + EPS);
            bf16* yp = Y + (size_t)(t0 + 32 * qh + r) * DM + 512 + hd * 64 + 4 * h;
#pragma unroll
            for (int db = 0; db < 2; ++db)
#pragma unroll
                for (int g4 = 0; g4 < 4; ++g4) { const f32x16& o = oacc[qh][db]; v2u w; w.x = pk2(o[4 * g4 + 0] * rs, o[4 * g4 + 1] * rs); w.y = pk2(o[4 * g4 + 2] * rs, o[4 * g4 + 3] * rs);
                    *(v2u*)(yp + 32 * db + 8 * g4) = w; }
        }
    }
    {
        const int c = tid & 255, rh = tid >> 8, tb = t0 + 32 * rh;
        const float w0 = conv_w[c], w1 = conv_w[256 + c], w2 = conv_w[512 + c];
        float p2 = 0.f, p1 = 0.f;
        if (tb >= 2) { const bf16* r2 = P + (size_t)(tb - 2) * NIN; const bf16* r1 = P + (size_t)(tb - 1) * NIN; p2 = bf1(r2[256 + c]) * bf1(r2[512 + c]); p1 = bf1(r1[256 + c]) * bf1(r1[512 + c]); }
#pragma unroll 16
        for (int r = 0; r < 32; ++r) { const bf16* rp = P + (size_t)(tb + r) * NIN; const float p0 = bf1(rp[256 + c]) * bf1(rp[512 + c]);
            tile[(32 * rh + r) * 260 + c] = bf1(rp[c]) * (w0 * p2 + w1 * p1 + w2 * p0); p2 = p1; p1 = p0; }
    }
    LDS_WAIT(); __syncthreads();
    norm_store_rows(tile, Y, t0, 0, wave, lane);
    const int tc = t0 & ~127, dt = t0 - tc, ns = dt + 64;
    { v2u uu[16];
#pragma unroll
      for (int i = 0; i < 16; ++i) { const int s = wave + 8 * i; uu[i] = (s < ns) ? *(const v2u*)(P + (size_t)(tc + s) * NIN + 1024 + lane * 4) : (v2u){0u, 0u}; }
      const f32x4 g = *(const f32x4*)(sgu_norm + lane * 4);
#pragma unroll
      for (int i = 0; i < 16; ++i) { const int s = wave + 8 * i;
        if (s < ns) { const v2u u = uu[i];
        const float v0 = bflo(u.x), v1 = bfhi(u.x), v2 = bflo(u.y), v3 = bfhi(u.y);
        const float ss = wave_sum((v0 * v0 + v1 * v1) + (v2 * v2 + v3 * v3)); const float rs = __builtin_amdgcn_rsqf(ss * (1.0f / 256.0f) + EPS);
        const unsigned a = pk2(v0 * rs * g[0], v1 * rs * g[1]), b = pk2(v2 * rs * g[2], v3 * rs * g[3]);
        vnT[(lane * 4 + 0) * 136 + s] = (bf16)(a & 0xffffu); vnT[(lane * 4 + 1) * 136 + s] = (bf16)(a >> 16); vnT[(lane * 4 + 2) * 136 + s] = (bf16)(b & 0xffffu); vnT[(lane * 4 + 3) * 136 + s] = (bf16)(b >> 16); } } }
    LDS_WAIT(); __syncthreads();
    {
        const int h = wave >> 1, rh = wave & 1, r32 = lane & 31, hi = lane >> 5;
        const int tcl = dt + 32 * rh + r32;
        const float* wrow = sgu_w + ((size_t)h * 128 + tcl) * 128;
        f32x16 o0 = {}, o1 = {};
        const int nk = (dt + 32 * rh + 32) >> 4;
        f32x4 wa[8], wb[8];
#pragma unroll
        for (int ks = 0; ks < 8; ++ks) { const int s0 = ks * 16 + 8 * hi; if (ks < nk) { wa[ks] = *(const f32x4*)(wrow + s0); wb[ks] = *(const f32x4*)(wrow + s0 + 4); } else { wa[ks] = (f32x4){0.f, 0.f, 0.f, 0.f}; wb[ks] = wa[ks]; } }
#pragma unroll
        for (int ks = 0; ks < 8; ++ks) if (ks < nk) { const int s0 = ks * 16 + 8 * hi;
            float wv[8] = {wa[ks][0], wa[ks][1], wa[ks][2], wa[ks][3], wb[ks][0], wb[ks][1], wb[ks][2], wb[ks][3]};
#pragma unroll
            for (int i = 0; i < 8; ++i) wv[i] = (s0 + i <= tcl) ? wv[i] : 0.f;
            v4u ap; ap.x = pk2(wv[0], wv[1]); ap.y = pk2(wv[2], wv[3]); ap.z = pk2(wv[4], wv[5]); ap.w = pk2(wv[6], wv[7]);
            const bf16x8 af = __builtin_bit_cast(bf16x8, ap);
            const bf16x8 b0 = *(const LAS bf16x8*)(vnT + (h * 64 + r32) * 136 + s0), b1 = *(const LAS bf16x8*)(vnT + (h * 64 + 32 + r32) * 136 + s0);
            o0 = __builtin_amdgcn_mfma_f32_32x32x16_bf16(af, b0, o0, 0, 0, 0);
            o1 = __builtin_amdgcn_mfma_f32_32x32x16_bf16(af, b1, o1, 0, 0, 0); }
#pragma unroll
        for (int j = 0; j < 16; ++j) { const int rl = 32 * rh + (j & 3) + 8 * (j >> 2) + 4 * hi;
            const float bb = sgu_b[h * 128 + dt + rl]; const bf16* up = P + (size_t)(t0 + rl) * NIN + 768 + h * 64;
            tile[rl * 260 + h * 64 + r32] = bf1(up[r32]) * (o0[j] + bb);
            tile[rl * 260 + h * 64 + 32 + r32] = bf1(up[32 + r32]) * (o1[j] + bb); }
    }
    LDS_WAIT(); __syncthreads();
    norm_store_rows(tile, Y, t0, 256, wave, lane);
    LDS_WAIT(); __syncthreads();
}

__device__ __forceinline__ void ffn_gate_phase(const bf16* GU, bf16* A, const float* fconv, int hf, int gtid, int gthreads) {
    for (int it = gtid; it < 256 * 176; it += gthreads) { const int rb = it / 176, cgp = it % 176, pnl = cgp >> 4, cc = (cgp & 15) * 8, ch = 1408 * hf + 128 * pnl + cc;
        float wg[3][8], wu[3][8];
#pragma unroll
        for (int i = 0; i < 3; ++i) { const f32x4 a0 = *(const f32x4*)(fconv + (size_t)i * NUP + ch), a1 = *(const f32x4*)(fconv + (size_t)i * NUP + ch + 4), b0 = *(const f32x4*)(fconv + (size_t)i * NUP + DFF + ch), b1 = *(const f32x4*)(fconv + (size_t)i * NUP + DFF + ch + 4);
#pragma unroll
            for (int e = 0; e < 4; ++e) { wg[i][e] = a0[e]; wg[i][4 + e] = a1[e]; wu[i][e] = b0[e]; wu[i][4 + e] = b1[e]; } }
        float g2[8], g1[8], u2[8], u1[8];
#pragma unroll
        for (int e = 0; e < 8; ++e) { g2[e] = g1[e] = u2[e] = u1[e] = 0.f; }
        for (int r = -2; r < 64; ++r) { const int t = 64 * rb + r; float g0[8], u0[8];
            if (t >= 0) { const v4u gv = *(const v4u*)(GU + (size_t)t * NIN + 256 * pnl + cc), uv = *(const v4u*)(GU + (size_t)t * NIN + 256 * pnl + 128 + cc);
                g0[0] = bflo(gv.x); g0[1] = bfhi(gv.x); g0[2] = bflo(gv.y); g0[3] = bfhi(gv.y); g0[4] = bflo(gv.z); g0[5] = bfhi(gv.z); g0[6] = bflo(gv.w); g0[7] = bfhi(gv.w);
                u0[0] = bflo(uv.x); u0[1] = bfhi(uv.x); u0[2] = bflo(uv.y); u0[3] = bfhi(uv.y); u0[4] = bflo(uv.z); u0[5] = bfhi(uv.z); u0[6] = bflo(uv.w); u0[7] = bfhi(uv.w); }
            else {
#pragma unroll
                for (int e = 0; e < 8; ++e) { g0[e] = 0.f; u0[e] = 0.f; } }
            if (r >= 0) { float o[8];
#pragma unroll
                for (int e = 0; e < 8; ++e) { const float G = wg[0][e] * g2[e] + wg[1][e] * g1[e] + wg[2][e] * g0[e], U = wu[0][e] * u2[e] + wu[1][e] * u1[e] + wu[2][e] * u0[e];
                    o[e] = G * __builtin_amdgcn_rcpf(1.0f + __expf(-G)) * U; }
                v4u ov; ov.x = pk2(o[0], o[1]); ov.y = pk2(o[2], o[3]); ov.z = pk2(o[4], o[5]); ov.w = pk2(o[6], o[7]);
                *(v4u*)(A + (size_t)t * DFF + ch) = ov; }
#pragma unroll
            for (int e = 0; e < 8; ++e) { g2[e] = g1[e]; g1[e] = g0[e]; u2[e] = u1[e]; u1[e] = u0[e]; } }
    }
}
__global__ void __launch_bounds__(NTHR, 2) hybrid_fwd(Args args) {
    extern __shared__ __attribute__((aligned(16))) unsigned char lds_raw[];
    LAS unsigned char* lds = (LAS unsigned char*)lds_raw;
    cg::grid_group grid = cg::this_grid();
    volatile LAS unsigned* MISC = (volatile LAS unsigned*)(lds + LDS_BYTES - 64);
    if (threadIdx.x < 16) MISC[threadIdx.x] = 0u;
    __syncthreads();
    XcdBarrier xbar = xcd_barrier_post((unsigned*)args.ws, MISC);
    const int tid = threadIdx.x, lane = tid & 63, wave = __builtin_amdgcn_readfirstlane(tid >> 6);
    const int G = gridDim.x, bx = blockIdx.x;
    const int gw = bx * NWAVES + wave, NGW = G * NWAVES;
    unsigned char* ws = args.ws;
    const float* x_in = args.in[0]; const float* norm_mix = args.in[1]; const float* w_in = args.in[2]; const float* conv_w = args.in[3];
    const float* sgu_norm = args.in[4]; const float* sgu_w = args.in[5]; const float* sgu_b = args.in[6]; const float* out_norm = args.in[7];
    const float* w_out = args.in[8]; const float* norm_ffn = args.in[9]; const float* w_up = args.in[10]; const float* ffn_conv = args.in[11];
    const float* w_down = args.in[12]; const float* norm_final = args.in[13];
    float* xcur = args.out;
    bf16* Win_t = (bf16*)(ws + WS_WIN); bf16* Wout_t = (bf16*)(ws + WS_WOUT); bf16* Wup_t = (bf16*)(ws + WS_WUP); bf16* Wdn_t = (bf16*)(ws + WS_WDN);
    float* part = (float*)(ws + WS_PART); bf16* XB = (bf16*)(ws + WS_XB); bf16* P = (bf16*)(ws + WS_P); bf16* Y = (bf16*)(ws + WS_Y);
    bf16* GU = (bf16*)(ws + WS_GU); bf16* A = (bf16*)(ws + WS_A);

    {
        LAS float* scr = (LAS float*)(lds + wave * 16384);
        constexpr int I_IN = 16 * 88, I_OUT = 16 * 32, I_UP = 16 * 176, I_DN = 44 * 32, I_L = I_IN + I_OUT + I_UP + I_DN;
        for (int it = gw; it < DEPTH * I_L; it += NGW) { const int l = it / I_L; int r = it % I_L;
            if (r < I_IN) { cvt_item(w_in + (size_t)l * DM * NIN, DM, NIN, Win_t + (size_t)l * NIN * DM, norm_mix + l * DM, 1, scr, r, lane); continue; } r -= I_IN;
            if (r < I_OUT) { cvt_item(w_out + (size_t)l * DM * DM, DM, DM, Wout_t + (size_t)l * DM * DM, out_norm + l * DM, 0, scr, r, lane); continue; } r -= I_OUT;
            if (r < I_UP) { cvt_item(w_up + (size_t)l * DM * NUP, DM, NUP, Wup_t + (size_t)l * NUP * DM, norm_ffn + l * DM, 2, scr, r, lane); continue; } r -= I_UP;
            cvt_item(w_down + (size_t)l * DFF * DM, DFF, DM, Wdn_t + (size_t)l * DM * DFF, nullptr, 0, scr, r, lane); }
        for (int m = gw; m < S; m += NGW) { const f32x4* xr = (const f32x4*)(x_in + (size_t)m * DM) + lane; f32x4 v[4]; float ss = 0.f;
#pragma unroll
            for (int j = 0; j < 4; ++j) { v[j] = xr[64 * j]; ss += (v[j][0] * v[j][0] + v[j][1] * v[j][1]) + (v[j][2] * v[j][2] + v[j][3] * v[j][3]); }
            ss = wave_sum(ss);
            v2u* o8 = (v2u*)(XB + (size_t)m * DM) + lane;
#pragma unroll
            for (int j = 0; j < 4; ++j) { v2u o; o.x = pk2(v[j][0], v[j][1]); o.y = pk2(v[j][2], v[j][3]); o8[64 * j] = o; }
            if (lane < 16) part[(size_t)m * 16 + lane] = lane == 0 ? ss : 0.f; }
    }
    grid.sync();

    for (int l = 0; l < DEPTH; ++l) {
        { pg8::Gemm g{XB, Win_t + (size_t)l * NIN * DM, S, NIN, DM, 256}; pg8::StaticOrder So; So.init(S, NIN, G, bx);
          pg8::EpiScaleBf16 E{P, NIN, part, (LAS float*)(lds + 131072 + 8192)};
          pg8::gemm_phase<pg8::EpiScaleBf16, pg8::StaticOrder, true, true>(lds, g, So, E); }
        xcd_barrier(xbar);
        for (int u = bx; u < S / 64; u += G)
            mixer_unit(lds, u, P, Y, conv_w + l * 3 * 256, sgu_norm + l * 256, sgu_w + (size_t)l * 4 * 128 * 128, sgu_b + l * 4 * 128, tid, wave, lane);
        xcd_barrier(xbar);
        { pg8::Gemm g{Y, Wout_t + (size_t)l * DM * DM, S, DM, DM, 256}; pg8::StaticOrder So; So.init(S, DM, G, bx);
          pg8::EpiResid E{l == 0 ? x_in : xcur, xcur, XB, part};
          pg8::gemm_phase<pg8::EpiResid, pg8::StaticOrder, true, true>(lds, g, So, E); }
        xcd_barrier(xbar);
        { pg8::Gemm g{XB - 2 * DM, Wup_t + (size_t)l * NUP * DM, 65 * 256, NUP, DM, 254}; pg8::StaticOrder So; So.init(65 * 256, NUP, G, bx);
          pg8::EpiGate E{A, part, ffn_conv + (size_t)l * 3 * NUP, (LAS float*)(lds + 131072)};
          pg8::gemm_phase<pg8::EpiGate, pg8::StaticOrder, true, true>(lds, g, So, E); }
        xcd_barrier(xbar);
        { pg8::Gemm g{A, Wdn_t + (size_t)l * DM * DFF, S, DM, DFF, 256}; pg8::StaticOrder So; So.init(S, DM, G, bx);
          pg8::EpiResid E{xcur, xcur, XB, part};
          pg8::gemm_phase<pg8::EpiResid, pg8::StaticOrder, true, true>(lds, g, So, E); }
        xcd_barrier(xbar);
    }
    for (int m = gw; m < S; m += NGW) { f32x4* xr = (f32x4*)(xcur + (size_t)m * DM) + lane; f32x4 v[4]; float ss = 0.f;
#pragma unroll
        for (int j = 0; j < 4; ++j) { v[j] = xr[64 * j]; ss += (v[j][0] * v[j][0] + v[j][1] * v[j][1]) + (v[j][2] * v[j][2] + v[j][3] * v[j][3]); }
        const float rs = __builtin_amdgcn_rsqf(wave_sum(ss) * (1.0f / 1024.0f) + EPS);
#pragma unroll
        for (int j = 0; j < 4; ++j) { const f32x4 g = *((const f32x4*)norm_final + lane + 64 * j); xr[64 * j] = v[j] * rs * g; } }
}

extern "C" void kernel_launch(void* const* d_in, const int* in_sizes, int n_in, void* d_out, int out_size, void* d_ws, size_t ws_size, hipStream_t stream) {
    static int grid = 0;
    if (grid == 0) {
        if (n_in != 14 || out_size != S * DM || ws_size < WS_END) { fprintf(stderr, "kernel_launch: unexpected shapes / workspace (%d inputs, out %d, ws %zu)\n", n_in, out_size, ws_size); grid = -1; return; }
        int dev = 0, cus = 0, per_cu = 0;
        hipGetDevice(&dev); hipDeviceGetAttribute(&cus, hipDeviceAttributeMultiprocessorCount, dev);
        hipFuncSetAttribute((const void*)hybrid_fwd, hipFuncAttributeMaxDynamicSharedMemorySize, LDS_BYTES);
        hipOccupancyMaxActiveBlocksPerMultiprocessor(&per_cu, (const void*)hybrid_fwd, NTHR, LDS_BYTES);
        (void)hipGetLastError();
        if (per_cu < 1) per_cu = 1;
        grid = cus * 1;
    }
    if (grid < 0) return;
    hipMemsetAsync((unsigned char*)d_ws, 0, 16384, stream);
    hipMemsetAsync((unsigned char*)d_ws + WS_XB - 4096, 0, 4096, stream);
    Args a{};
    for (int i = 0; i < 14; ++i) a.in[i] = (const float*)d_in[i];
    a.out = (float*)d_out; a.ws = (unsigned char*)d_ws;
    void* kargs[] = {&a};
    hipError_t e = hipLaunchCooperativeKernel((const void*)hybrid_fwd, dim3(grid), dim3(NTHR), kargs, LDS_BYTES, stream);
    if (e != hipSuccess) fprintf(stderr, "cooperative launch failed: %s (grid %d)\n", hipGetErrorString(e), grid);
}
```

```cpp
#include <hip/hip_runtime.h>
#include <hip/hip_cooperative_groups.h>
#include <cstdio>
#include <cstdint>
namespace cg = cooperative_groups;
namespace pg8 {
#define PG8_LAS __attribute__((address_space(3)))
typedef unsigned short bf16_t;
typedef short bf16x8 __attribute__((ext_vector_type(8)));
typedef float f32x4 __attribute__((ext_vector_type(4)));
typedef unsigned u32x4 __attribute__((ext_vector_type(4)));
typedef unsigned u32x2 __attribute__((ext_vector_type(2)));
constexpr int BM = 256, BK = 64, HALF = 128, HTB = HALF * BK * 2  , STAGE_BYTES = 8 * HTB, NXCD = 8, WGM = 8;

__host__ __device__ __forceinline__ int lds_byte(int r, int c) { const int st = (r >> 4) * 2 + (c >> 5), rr = r & 15, cc = c & 31, ob = rr * 64 + cc * 2; return st * 1024 + (ob ^ (((ob >> 9) & 1) << 5)); }
__host__ __device__ __forceinline__ void stage_rc(int b, int& R, int& C) { const int st = b / 1024, sb = b % 1024, swz = sb ^ (((sb >> 9) & 1) << 5); R = (st >> 1) * 16 + swz / 64; C = (st & 1) * 32 + (swz % 64) / 2; }
__host__ __device__ __forceinline__ int perm32(int rho) { const int n = rho >> 4, i = rho & 15; return 8 * (i >> 2) + 4 * n + (i & 3); }

struct Unit { int pm, pn; };
struct Gemm { const bf16_t* A; const bf16_t* Bt; int M, N, K; int arows; };

struct StaticOrder {
    int nM, nN, nwg, G, c;
    __host__ __device__ void init(int M, int N, int G_, int c_) { nM = M / BM; nN = N / BM; nwg = nM * nN; G = G_; c = c_; }
    __host__ __device__ bool next(int i, Unit& u) const {
        const long L = (long)i * G + c; if (L >= nwg) return false;
        int wgid = (int)L; { const int q = nwg / NXCD, r = nwg % NXCD, xcd = wgid % NXCD, off = wgid / NXCD; wgid = (xcd < r ? xcd * (q + 1) : r * (q + 1) + (xcd - r) * q) + off; }
        const int nig = WGM * nN, gid = wgid / nig, fm = gid * WGM, gsz = (nM - fm) < WGM ? (nM - fm) : WGM;
        u.pm = fm + ((wgid % nig) % gsz); u.pn = (wgid % nig) / gsz; return true;
    }
    __device__ __forceinline__ void a_ready(const Unit&) const {}
    __device__ __forceinline__ void done(const Unit&) const {}
};

__device__ __forceinline__ unsigned cvt_pk_bf16(float lo, float hi) { unsigned r; asm volatile("v_cvt_pk_bf16_f32 %0, %1, %2" : "=v"(r) : "v"(lo), "v"(hi)); return r; }
struct EpiScaleBf16 {
    static constexpr bool PERM = true, AFTER_DRAIN = false;
    bf16_t* O; int ldc; const float* part; PG8_LAS float* rsl;
    __device__ __forceinline__ void operator()(const f32x4 (&acc)[2][2][4][2], const Unit& u, int wr, int wc, int fr, int fq) const {
        { const int t = (wr * 4 + wc) * 64 + fq * 16 + fr;
          if (t < 256) { const f32x4* pp = (const f32x4*)(part + (size_t)(u.pm * BM + t) * 16); const f32x4 a = pp[0], b = pp[1], c = pp[2], d = pp[3];
              const f32x4 s4 = (a + b) + (c + d); const float ss = (s4[0] + s4[1]) + (s4[2] + s4[3]); rsl[t] = __builtin_amdgcn_rsqf(ss * (1.0f / 1024.0f) + 1e-6f); } }
        asm volatile("s_waitcnt lgkmcnt(0)" ::: "memory"); __builtin_amdgcn_s_barrier(); asm volatile("" ::: "memory");
        const int row0 = u.pm * BM + wr * 64 + fr; const int col0 = u.pn * BM + wc * 32 + 8 * fq;
#pragma unroll
        for (int ai = 0; ai < 2; ++ai)
#pragma unroll
            for (int m = 0; m < 4; ++m) { const int row = row0 + ai * HALF + m * 16;
                const float rs = rsl[ai * HALF + wr * 64 + m * 16 + fr];
                bf16_t* rowp = O + (size_t)row * ldc + col0;
#pragma unroll
                for (int bj = 0; bj < 2; ++bj) { const f32x4 v0 = acc[ai][bj][m][0] * rs, v1 = acc[ai][bj][m][1] * rs;
                    u32x4 w; w.x = cvt_pk_bf16(v0[0], v0[1]); w.y = cvt_pk_bf16(v0[2], v0[3]); w.z = cvt_pk_bf16(v1[0], v1[1]); w.w = cvt_pk_bf16(v1[2], v1[3]);
                    *(u32x4*)(rowp + bj * HALF) = w; } }
    }
};
struct EpiResid {
    static constexpr bool PERM = true, AFTER_DRAIN = false;
    const float* base; float* out; bf16_t* xb; float* part;
    __device__ __forceinline__ void operator()(const f32x4 (&acc)[2][2][4][2], const Unit& u, int wr, int wc, int fr, int fq) const {
        const int row0 = u.pm * BM + wr * 64 + fr; const int col0 = u.pn * BM + wc * 32 + 8 * fq;
        f32x4 pre[3][4];
#define PG8_RLOAD(g_) do { const size_t o_ = (size_t)(row0 + ((g_) >> 2) * HALF + ((g_) & 3) * 16) * 1024 + col0; \
            pre[(g_) % 3][0] = *(const f32x4*)(base + o_); pre[(g_) % 3][1] = *(const f32x4*)(base + o_ + 4); pre[(g_) % 3][2] = *(const f32x4*)(base + o_ + HALF); pre[(g_) % 3][3] = *(const f32x4*)(base + o_ + HALF + 4); } while (0)
        PG8_RLOAD(0); PG8_RLOAD(1);
#pragma unroll
        for (int g = 0; g < 8; ++g) { const int ai = g >> 2, m = g & 3;
            if (g + 2 < 8) PG8_RLOAD(g + 2);
            asm volatile("" ::: "memory");
            const int row = row0 + ai * HALF + m * 16; const size_t off = (size_t)row * 1024 + col0; float ss = 0.f;
#pragma unroll
            for (int bj = 0; bj < 2; ++bj) { const f32x4 v0 = acc[ai][bj][m][0] + pre[g % 3][2 * bj], v1 = acc[ai][bj][m][1] + pre[g % 3][2 * bj + 1];
                *(f32x4*)(out + off + bj * HALF) = v0; *(f32x4*)(out + off + bj * HALF + 4) = v1;
                ss += (v0[0] * v0[0] + v0[1] * v0[1]) + (v0[2] * v0[2] + v0[3] * v0[3]) + (v1[0] * v1[0] + v1[1] * v1[1]) + (v1[2] * v1[2] + v1[3] * v1[3]);
                u32x4 w; w.x = cvt_pk_bf16(v0[0], v0[1]); w.y = cvt_pk_bf16(v0[2], v0[3]); w.z = cvt_pk_bf16(v1[0], v1[1]); w.w = cvt_pk_bf16(v1[2], v1[3]);
                *(u32x4*)(xb + off + bj * HALF) = w; }
            ss += __shfl_xor(ss, 16); ss += __shfl_xor(ss, 32);
            if (fq == 0) part[(size_t)row * 16 + u.pn * 4 + wc] = ss;
            asm volatile("" ::: "memory"); }
#undef PG8_RLOAD
    }
};
#define PG8_DPP(oldv, srcv, ctrl) __builtin_bit_cast(float, __builtin_amdgcn_update_dpp(__builtin_bit_cast(int, (float)(oldv)), __builtin_bit_cast(int, (float)(srcv)), (ctrl), 0xf, 0xf, false))
struct EpiGate {
    static constexpr bool PERM = true, AFTER_DRAIN = false;
    bf16_t* Aout; const float* part; const float* fconv; PG8_LAS float* xch;
    __device__ __forceinline__ void operator()(f32x4 (&acc)[2][2][4][2], const Unit& u, int wr, int wc, int fr, int fq) const {
        PG8_LAS float* rsl = xch + 2048;
        { const int t = (wr * 4 + wc) * 64 + fq * 16 + fr;
          if (t < 256) { const int row = u.pm * 254 - 2 + t; const bool ok = row >= 0 && row < 16384; const int rc = ok ? row : 0;
              const f32x4* pp = (const f32x4*)(part + (size_t)rc * 16); const f32x4 a = pp[0], b = pp[1], c = pp[2], d = pp[3];
              const f32x4 s4 = (a + b) + (c + d); const float ss = (s4[0] + s4[1]) + (s4[2] + s4[3]);
              rsl[t] = ok ? __builtin_amdgcn_rsqf(ss * (1.0f / 1024.0f) + 1e-6f) : 0.f; } }
        asm volatile("s_waitcnt lgkmcnt(0)" ::: "memory"); __builtin_amdgcn_s_barrier(); asm volatile("" ::: "memory");
        const int ccol = wc * 32 + 8 * fq;
#pragma unroll
        for (int ai = 0; ai < 2; ++ai)
#pragma unroll
            for (int m = 0; m < 4; ++m) { const float rs = rsl[ai * HALF + wr * 64 + m * 16 + fr];
#pragma unroll
                for (int bj = 0; bj < 2; ++bj) { acc[ai][bj][m][0] *= rs; acc[ai][bj][m][1] *= rs; } }
        if (fr >= 14) {
#pragma unroll
            for (int ai = 0; ai < 2; ++ai)
#pragma unroll
                for (int bj = 0; bj < 2; ++bj)
#pragma unroll
                    for (int n = 0; n < 2; ++n) *(PG8_LAS f32x4*)(xch + ((2 * ai + wr) * 2 + (fr & 1)) * 256 + bj * HALF + ccol + 4 * n) = acc[ai][bj][3][n];
        }
        asm volatile("s_waitcnt lgkmcnt(0)" ::: "memory"); __builtin_amdgcn_s_barrier(); asm volatile("" ::: "memory");
        const int ch0 = u.pn * HALF + ccol;
#pragma unroll
        for (int ai = 0; ai < 2; ++ai) {
            const int grp = 2 * ai + wr;
#pragma unroll
            for (int n = 0; n < 2; ++n) {
                asm volatile("" ::: "memory");
                const float* fw = fconv + ch0 + 4 * n;
                const f32x4 wg0 = *(const f32x4*)(fw), wg1 = *(const f32x4*)(fw + 5632), wg2 = *(const f32x4*)(fw + 2 * 5632);
                const f32x4 wu0 = *(const f32x4*)(fw + 2816), wu1 = *(const f32x4*)(fw + 5632 + 2816), wu2 = *(const f32x4*)(fw + 2 * 5632 + 2816);
                f32x4 xpg = {0.f, 0.f, 0.f, 0.f}, xpu = {0.f, 0.f, 0.f, 0.f};
                if (grp > 0) { xpg = *(const PG8_LAS f32x4*)(xch + ((grp - 1) * 2 + (fr & 1)) * 256 + ccol + 4 * n); xpu = *(const PG8_LAS f32x4*)(xch + ((grp - 1) * 2 + (fr & 1)) * 256 + HALF + ccol + 4 * n); }
#pragma unroll
                for (int m = 0; m < 4; ++m) {
                    float o[4];
#pragma unroll
                    for (int j = 0; j < 4; ++j) {
                        const float xg = acc[ai][0][m][n][j], xu = acc[ai][1][m][n][j];
                        const float pg = m > 0 ? acc[ai][0][m > 0 ? m - 1 : 0][n][j] : xpg[j], pu = m > 0 ? acc[ai][1][m > 0 ? m - 1 : 0][n][j] : xpu[j];
                        const float g1 = PG8_DPP(PG8_DPP(0.f, pg, 0x121), xg, 0x111), g2 = PG8_DPP(PG8_DPP(0.f, pg, 0x122), xg, 0x112);
                        const float u1 = PG8_DPP(PG8_DPP(0.f, pu, 0x121), xu, 0x111), u2 = PG8_DPP(PG8_DPP(0.f, pu, 0x122), xu, 0x112);
                        const float Gv = wg0[j] * g2 + wg1[j] * g1 + wg2[j] * xg, Uv = wu0[j] * u2 + wu1[j] * u1 + wu2[j] * xu;
                        o[j] = Gv * __builtin_amdgcn_rcpf(1.0f + __expf(-Gv)) * Uv; }
                    const int r = ai * HALF + wr * 64 + m * 16 + fr, row = u.pm * 254 - 2 + r;
                    u32x2 w; w.x = cvt_pk_bf16(o[0], o[1]); w.y = cvt_pk_bf16(o[2], o[3]);
                    if (r >= 2 && row < 16384) *(u32x2*)(Aout + (size_t)row * 2816 + ch0 + 4 * n) = w; }
            }
        }
    }
};
template <class Epi, class Sched, bool ALIGN_EPI = false, bool SP2 = false>
__device__ __forceinline__ void gemm_phase(PG8_LAS unsigned char* lds, const Gemm g, const Sched& S, const Epi& E) {
    int tid = threadIdx.x; asm volatile("" : "+v"(tid));
    const int wid = __builtin_amdgcn_readfirstlane(tid >> 6), lane = tid & 63, wr = wid >> 2, wc = wid & 3, fr = lane & 15, fq = lane >> 4;
    const int K = g.K, nt = K / BK;
    unsigned voffA[2], voffB[2];
#pragma unroll
    for (int i = 0; i < 2; ++i) { int R, C; stage_rc(tid * 16 + i * 8192, R, C); const int Rb = Epi::PERM ? ((R & ~31) + perm32(R & 31)) : R;
        voffA[i] = (unsigned)(R * K + C) * 2u; voffB[i] = (unsigned)(Rb * K + C) * 2u; }
    const size_t kstep = (size_t)(BK * 2);
    const size_t hstep = (size_t)HALF * K * 2;
    const size_t tstep = 2 * hstep;
    const size_t tstepA = (size_t)g.arows * K * 2;
    const unsigned ldsw = (unsigned)wid * 1024u;
    const int aoff = lds_byte(wr * 64 + fr, fq * 8), boff = lds_byte(wc * 32 + fr, fq * 8);
#define PG8_SA(b, h) (((b) * 2 + (h)) * HTB)
#define PG8_SB(b, h) ((4 + (b) * 2 + (h)) * HTB)
#define PG8_STAGE(bufoff, gbase, voff) do { _Pragma("unroll") for (int _i = 0; _i < 2; ++_i) \
        __builtin_amdgcn_global_load_lds((const unsigned*)((const char*)(gbase) + (voff)[_i]), (PG8_LAS unsigned*)(lds + (bufoff) + ldsw + _i * 8192), 16, 0, 0); } while (0)
#define PG8_LDA(dst, b, h) do { _Pragma("unroll") for (int m = 0; m < 4; ++m) _Pragma("unroll") for (int k = 0; k < 2; ++k) dst[m][k] = *(const PG8_LAS bf16x8*)(lds + PG8_SA(b, h) + aoff + m * 2048 + k * 1024); } while (0)
#define PG8_LDB(dst, b, h) do { _Pragma("unroll") for (int n = 0; n < 2; ++n) _Pragma("unroll") for (int k = 0; k < 2; ++k) dst[n][k] = *(const PG8_LAS bf16x8*)(lds + PG8_SB(b, h) + boff + n * 2048 + k * 1024); } while (0)
#define PG8_MMA(ai, bj, At, Bt) do { __builtin_amdgcn_s_setprio(1); _Pragma("unroll") for (int m = 0; m < 4; ++m) _Pragma("unroll") for (int n = 0; n < 2; ++n) _Pragma("unroll") for (int k = 0; k < 2; ++k) \
        acc[ai][bj][m][n] = __builtin_amdgcn_mfma_f32_16x16x32_bf16(Bt[n][k], At[m][k], acc[ai][bj][m][n], 0, 0, 0); __builtin_amdgcn_s_setprio(0); } while (0)
#define PG8_WAIT_V(n) asm volatile("s_waitcnt vmcnt(" #n ")" ::: "memory")
#define PG8_WAIT_L(n) asm volatile("s_waitcnt lgkmcnt(" #n ")" ::: "memory")
#define PG8_BAR __builtin_amdgcn_s_barrier()
#define PG8_SCHED __builtin_amdgcn_sched_barrier(0)
    Unit cur, nxt; int ui = 0;
    if (!S.next(0, cur)) return;
    f32x4 acc[2][2][4][2];
#pragma unroll
    for (int a = 0; a < 2; ++a)
#pragma unroll
        for (int b = 0; b < 2; ++b)
#pragma unroll
            for (int m = 0; m < 4; ++m)
#pragma unroll
                for (int n = 0; n < 2; ++n) acc[a][b][m][n] = (f32x4){0.f, 0.f, 0.f, 0.f};
    bf16x8 At[4][2], B0[2][2], B1[2][2];
    const char* cA = (const char*)g.A + (size_t)cur.pm * tstepA; const char* cB = (const char*)g.Bt + (size_t)cur.pn * tstep;
    S.a_ready(cur);
    if constexpr (SP2) {
        PG8_STAGE(PG8_SB(0, 0), cB, voffB); PG8_STAGE(PG8_SB(0, 1), cB + hstep, voffB); PG8_STAGE(PG8_SA(0, 0), cA, voffA); PG8_STAGE(PG8_SA(0, 1), cA + hstep, voffA);
        if (wr == 1) PG8_BAR;
        PG8_WAIT_V(2); PG8_BAR;
        PG8_STAGE(PG8_SB(1, 0), cB + kstep, voffB); PG8_STAGE(PG8_SA(1, 0), cA + kstep, voffA); PG8_STAGE(PG8_SB(1, 1), cB + hstep + kstep, voffB);
        PG8_WAIT_V(6); PG8_BAR;
    } else {
        PG8_STAGE(PG8_SB(0, 0), cB, voffB); PG8_STAGE(PG8_SA(0, 0), cA, voffA); PG8_STAGE(PG8_SB(0, 1), cB + hstep, voffB); PG8_STAGE(PG8_SA(0, 1), cA + hstep, voffA);
        if (wr == 1) PG8_BAR;
        PG8_WAIT_V(4); PG8_BAR;
        PG8_STAGE(PG8_SB(1, 0), cB + kstep, voffB); PG8_STAGE(PG8_SA(1, 0), cA + kstep, voffA); PG8_STAGE(PG8_SB(1, 1), cB + hstep + kstep, voffB);
        PG8_WAIT_V(6); PG8_BAR;
    }
    for (;;) {
        const bool has_next = S.next(ui + 1, nxt);
        const char* nA = has_next ? (const char*)g.A + (size_t)nxt.pm * tstepA : cA; const char* nB = has_next ? (const char*)g.Bt + (size_t)nxt.pn * tstep : cB;
        for (int t = 0; t < nt; t += 2) {
            const bool last = (t == nt - 2);
            const char* a1 = cA + (size_t)(t + 1) * kstep;
            const char* a2 = last ? nA : cA + (size_t)(t + 2) * kstep; const char* b2 = last ? nB : cB + (size_t)(t + 2) * kstep;
            const char* a3 = a2 + kstep; const char* b3 = b2 + kstep;
            if (last && has_next) S.a_ready(nxt);
            if constexpr (SP2) {
            PG8_LDB(B0, 0, 0); PG8_LDB(B1, 0, 1); PG8_SCHED; PG8_LDA(At, 0, 0); PG8_STAGE(PG8_SA(1, 1), a1 + hstep, voffA);
            PG8_WAIT_V(8); PG8_WAIT_L(0); PG8_BAR; PG8_MMA(0, 0, At, B0); PG8_MMA(0, 1, At, B1); PG8_BAR; PG8_SCHED;
            PG8_LDA(At, 0, 1); PG8_STAGE(PG8_SB(0, 0), b2, voffB); PG8_STAGE(PG8_SB(0, 1), b2 + hstep, voffB); PG8_STAGE(PG8_SA(0, 0), a2, voffA);
            PG8_WAIT_V(8); PG8_WAIT_L(0); PG8_BAR; PG8_MMA(1, 0, At, B0); PG8_MMA(1, 1, At, B1); PG8_BAR; PG8_SCHED;
            PG8_LDB(B0, 1, 0); PG8_LDB(B1, 1, 1); PG8_SCHED; PG8_LDA(At, 1, 0); PG8_STAGE(PG8_SA(0, 1), a2 + hstep, voffA);
            PG8_WAIT_V(8); PG8_WAIT_L(0); PG8_BAR; PG8_MMA(0, 0, At, B0); PG8_MMA(0, 1, At, B1); PG8_BAR; PG8_SCHED;
            PG8_LDA(At, 1, 1); PG8_STAGE(PG8_SB(1, 0), b3, voffB); PG8_STAGE(PG8_SB(1, 1), b3 + hstep, voffB); PG8_STAGE(PG8_SA(1, 0), a3, voffA);
            PG8_WAIT_V(8); PG8_WAIT_L(0); PG8_BAR; PG8_MMA(1, 0, At, B0); PG8_MMA(1, 1, At, B1); PG8_BAR; PG8_SCHED;
            } else {
            PG8_LDB(B0, 0, 0); PG8_SCHED; PG8_LDA(At, 0, 0); PG8_STAGE(PG8_SA(1, 1), a1 + hstep, voffA);
            PG8_WAIT_L(8); PG8_BAR; PG8_WAIT_L(0); PG8_MMA(0, 0, At, B0); PG8_BAR; PG8_SCHED;
            PG8_LDB(B1, 0, 1); PG8_STAGE(PG8_SB(0, 0), b2, voffB);
            PG8_BAR; PG8_WAIT_L(0); PG8_MMA(0, 1, At, B1); PG8_BAR;
            PG8_LDA(At, 0, 1); PG8_STAGE(PG8_SA(0, 0), a2, voffA);
            PG8_BAR; PG8_WAIT_L(0); PG8_MMA(1, 0, At, B0); PG8_BAR; PG8_SCHED;
            PG8_STAGE(PG8_SB(0, 1), b2 + hstep, voffB);
            PG8_WAIT_V(6); PG8_BAR; PG8_MMA(1, 1, At, B1); PG8_BAR;
            PG8_LDB(B0, 1, 0); PG8_SCHED; PG8_LDA(At, 1, 0); PG8_STAGE(PG8_SA(0, 1), a2 + hstep, voffA);
            PG8_WAIT_L(8); PG8_BAR; PG8_WAIT_L(0); PG8_MMA(0, 0, At, B0); PG8_BAR; PG8_SCHED;
            PG8_LDB(B1, 1, 1); PG8_STAGE(PG8_SB(1, 0), b3, voffB);
            PG8_BAR; PG8_WAIT_L(0); PG8_MMA(0, 1, At, B1); PG8_BAR;
            PG8_LDA(At, 1, 1); PG8_STAGE(PG8_SA(1, 0), a3, voffA);
            PG8_BAR; PG8_WAIT_L(0); PG8_MMA(1, 0, At, B0); PG8_BAR; PG8_SCHED;
            PG8_STAGE(PG8_SB(1, 1), b3 + hstep, voffB);
            PG8_WAIT_V(6); PG8_BAR; PG8_MMA(1, 1, At, B1); PG8_BAR;
            }
        }
        if constexpr (ALIGN_EPI) { if (wr == 0) PG8_BAR; }
        if constexpr (!Epi::AFTER_DRAIN) { E(acc, cur, wr, wc, fr, fq); S.done(cur); }
        if (!has_next) break;
#pragma unroll
        for (int a = 0; a < 2; ++a)
#pragma unroll
            for (int b = 0; b < 2; ++b)
#pragma unroll
                for (int m = 0; m < 4; ++m)
#pragma unroll
                    for (int n = 0; n < 2; ++n) acc[a][b][m][n] = (f32x4){0.f, 0.f, 0.f, 0.f};
        cur = nxt; cA = nA; cB = nB; ++ui;
        if constexpr (ALIGN_EPI) { if (wr == 1) PG8_BAR; }
    }
    PG8_WAIT_V(0);
    if constexpr (!ALIGN_EPI) { if (wr == 0) PG8_BAR; }
    PG8_BAR;
    if constexpr (Epi::AFTER_DRAIN) { E.fused(acc, cur, wr, wc, fr, fq, lds, wid, lane); S.done(cur); }
#undef PG8_SA
#undef PG8_SB
#undef PG8_STAGE
#undef PG8_LDA
#undef PG8_LDB
#undef PG8_MMA
#undef PG8_WAIT_V
#undef PG8_WAIT_L
#undef PG8_BAR
#undef PG8_SCHED
}
}
constexpr int S = 16384, DM = 1024, DEPTH = 4, NIN = 2816, DFF = 2816, NUP = 5632;
constexpr float EPS = 1e-6f;
constexpr int NWAVES = 8, NTHR = 512;
constexpr size_t MiB = 1u << 20;
constexpr size_t WS_WIN = 1 * MiB, WS_WOUT = 23 * MiB, WS_WUP = 31 * MiB, WS_WDN = 75 * MiB;
constexpr size_t WS_PART = 97 * MiB;
constexpr size_t WS_XB = 98 * MiB + 4096;
constexpr size_t WS_P = 131 * MiB;
constexpr size_t WS_Y = 219 * MiB;
constexpr size_t WS_GU = 131 * MiB;
constexpr size_t WS_A = 219 * MiB;
constexpr size_t WS_END = 307 * MiB;
constexpr int LDS_BYTES = 147456;
#define LAS __attribute__((address_space(3)))
typedef unsigned short bf16;
typedef unsigned v4u __attribute__((ext_vector_type(4)));
typedef unsigned v2u __attribute__((ext_vector_type(2)));
typedef float f32x4 __attribute__((ext_vector_type(4)));
typedef float f32x16 __attribute__((ext_vector_type(16)));
typedef short bf16x8 __attribute__((ext_vector_type(8)));
#define LDS_WAIT() asm volatile("s_waitcnt lgkmcnt(0)" ::: "memory")
__device__ __forceinline__ unsigned pk2(float lo, float hi) { return pg8::cvt_pk_bf16(lo, hi); }
__device__ __forceinline__ float bflo(unsigned u) { return __uint_as_float(u << 16); }
__device__ __forceinline__ float bfhi(unsigned u) { return __uint_as_float(u & 0xffff0000u); }
__device__ __forceinline__ float bf1(bf16 v) { return __uint_as_float((unsigned)v << 16); }
__device__ __forceinline__ float wave_sum(float v) {
#pragma unroll
    for (int o = 1; o < 64; o <<= 1) v += __shfl_xor(v, o);
    return v;
}

__device__ __forceinline__ void cvt_item(const float* W, int K, int N, bf16* WT, const float* gain, int mode, LAS float* scr, int item, int lane) {
    const int nblk = N / 32, kb = item / nblk, nb = item % nblk, k0 = 64 * kb, n0 = 32 * nb;
    float wv[32];
#pragma unroll
    for (int i = 0; i < 32; ++i) { const int kk = 2 * i + (lane >> 5); wv[i] = W[(size_t)(k0 + kk) * N + n0 + (lane & 31)]; }
#pragma unroll
    for (int i = 0; i < 32; ++i) { const int kk = 2 * i + (lane >> 5); const float g = gain ? gain[k0 + kk] : 1.0f; scr[kk * 33 + (lane & 31)] = wv[i] * g; }
    LDS_WAIT(); asm volatile("" ::: "memory");
    const float cs = (mode == 1 && n0 >= 1280 && n0 < 1792) ? 0.125f : 1.0f;
    int rb = n0;
    if (mode == 2) { rb = (n0 < DFF) ? 256 * (n0 / 128) + (n0 % 128) : 256 * ((n0 - DFF) / 128) + 128 + ((n0 - DFF) % 128); }
    const int c = lane & 7;
#pragma unroll
    for (int j = 0; j < 4; ++j) { const int n = (lane >> 3) + 8 * j; const LAS float* s = scr + (8 * c) * 33 + n;
        v4u o; o.x = pk2(s[0 * 33] * cs, s[1 * 33] * cs); o.y = pk2(s[2 * 33] * cs, s[3 * 33] * cs); o.z = pk2(s[4 * 33] * cs, s[5 * 33] * cs); o.w = pk2(s[6 * 33] * cs, s[7 * 33] * cs);
        *(v4u*)(WT + (size_t)(rb + n) * K + k0 + 8 * c) = o; }
    LDS_WAIT(); asm volatile("" ::: "memory");
}

typedef __attribute__((address_space(1))) unsigned gu32;
#define XB_TMO      128
#define XB_XCNT(j)  (256  + 64 * (j))
#define XB_XSUB(j)  (1280 + 64 * (j))
#define XB_XGEN(j)  (2304 + 64 * (j))
#define XB_TOP      3328
#define XB_TOPGEN   3392
#define XCD_BAR_WORDS 3456
#define XB_SPIN_CAP (1u << 18)

__device__ __forceinline__ unsigned xb_ld(unsigned* p)              { return __hip_atomic_load(p, __ATOMIC_RELAXED, __HIP_MEMORY_SCOPE_AGENT); }
__device__ __forceinline__ unsigned xb_add(unsigned* p, unsigned v) { return __hip_atomic_fetch_add(p, v, __ATOMIC_RELAXED, __HIP_MEMORY_SCOPE_AGENT); }
__device__ __forceinline__ unsigned xb_xcc_id() { return (unsigned)__builtin_amdgcn_s_getreg((3 << 11) | 20) & 0xFu; }
#define XB_SPIN(cond, bar) do { unsigned _sp = 0; while (cond) { __builtin_amdgcn_s_sleep(1); \
    if ((++_sp & 255u) == 0u) { if (xb_ld(&(bar)[XB_TMO])) break; if (_sp > XB_SPIN_CAP) { atomicAdd(&(bar)[XB_TMO], 1u); break; } } } } while (0)

struct XcdBarrier {
    unsigned* bar; unsigned x;
    volatile LAS unsigned* st;
};

__device__ __forceinline__ XcdBarrier xcd_barrier_post(unsigned* bar, volatile LAS unsigned* st) {
    XcdBarrier b; b.bar = bar; b.x = xb_xcc_id(); b.st = st;
    if (threadIdx.x == 0) (void)xb_add(&bar[XB_XCNT(b.x)], 1u);
    return b;
}
__device__ __forceinline__ void xcd_barrier_complete(unsigned* bar, unsigned x, unsigned& nloc, unsigned& nx) {
    const unsigned G = gridDim.x * gridDim.y * gridDim.z;
    unsigned sum, cnt, mine, sp = 0u;
    for (;;) {
        sum = 0u; cnt = 0u; mine = 0u;
#pragma unroll
        for (unsigned j = 0; j < 16; ++j) { const unsigned c = xb_ld(&bar[XB_XCNT(j)]); sum += c; cnt += (c > 0u) ? 1u : 0u; mine = (j == x) ? c : mine; }
        if (sum == G) break;
        __builtin_amdgcn_s_sleep(1);
        if ((++sp & 255u) == 0u) { if (xb_ld(&bar[XB_TMO])) break; if (sp > XB_SPIN_CAP) { atomicAdd(&bar[XB_TMO], 1u); break; } }
    }
    nloc = mine > 0u ? mine : 1u; nx = cnt > 0u ? cnt : 1u;
}

__device__ __forceinline__ void xcd_barrier(const XcdBarrier& b) {
    asm volatile("s_waitcnt vmcnt(0)" ::: "memory");
    __syncthreads();
    if (threadIdx.x == 0) {
        unsigned* bar = b.bar;
        __builtin_amdgcn_s_waitcnt(0);
        unsigned nloc = b.st[0], nx = b.st[1];
        if (nloc == 0u) { xcd_barrier_complete(bar, b.x, nloc, nx); b.st[0] = nloc; b.st[1] = nx; }
        const unsigned old = xb_add(&bar[XB_XSUB(b.x)], 1u);
        const unsigned gen = old / nloc;
        if (old + 1u == (gen + 1u) * nloc) {
            __builtin_amdgcn_fence(__ATOMIC_RELEASE, "agent");
            asm volatile("s_waitcnt vmcnt(0)" ::: "memory");
            const unsigned og = xb_add(&bar[XB_TOP], 1u);
            const unsigned tg = og / nx;
            if (og + 1u == (tg + 1u) * nx) xb_add(&bar[XB_TOPGEN], 1u);
            else XB_SPIN(xb_ld(&bar[XB_TOPGEN]) == tg, bar);
            __builtin_amdgcn_fence(__ATOMIC_ACQUIRE, "agent");
            xb_add(&bar[XB_XGEN(b.x)], 1u);
            asm volatile("s_waitcnt vmcnt(0)" ::: "memory");
        } else {
            XB_SPIN(xb_ld(&bar[XB_XGEN(b.x)]) == gen, bar);
            __builtin_amdgcn_fence(__ATOMIC_ACQUIRE, "agent");
            asm volatile("s_waitcnt vmcnt(0)" ::: "memory");
        }
    }
    __syncthreads();
}

struct Args { const float* in[14]; float* out; unsigned char* ws; };

__device__ __forceinline__ void norm_store_rows(const LAS float* tile, bf16* Y, int t0, int coff, int wave, int lane) {
#pragma unroll 2
    for (int i = 0; i < 8; ++i) { const int r = wave * 8 + i; const f32x4 v = *(const LAS f32x4*)(tile + r * 260 + lane * 4);
        const float ss = wave_sum((v[0] * v[0] + v[1] * v[1]) + (v[2] * v[2] + v[3] * v[3]));
        const float rs = __builtin_amdgcn_rsqf(ss * (1.0f / 256.0f) + EPS);
        v2u o; o.x = pk2(v[0] * rs, v[1] * rs); o.y = pk2(v[2] * rs, v[3] * rs);
        *(v2u*)(Y + (size_t)(t0 + r) * DM + coff + lane * 4) = o; }
}

__device__ __forceinline__ void mixer_unit(LAS unsigned char* lds, int unit, const bf16* P, bf16* Y, const float* conv_w, const float* sgu_norm, const float* sgu_w, const float* sgu_b, int tid, int wave, int lane) {
    const int t0 = unit * 64;
    asm volatile("" : "+v"(tid), "+v"(lane));
    LAS bf16* vnT = (LAS bf16*)lds;
    LAS float* tile = (LAS float*)(lds + 69632);
    LAS float* sm_ss = (LAS float*)(lds + 69632 + 66560);
    {
        const int hd = wave, r = lane & 31, h = lane >> 5;
        const int pr = (r & 0x13) | ((r & 4) << 1) | ((r & 8) >> 1);
        LAS bf16* Vt = (LAS bf16*)(lds + wave * 5120);
        bf16x8 atri[2];
#pragma unroll
        for (int sI = 0; sI < 2; ++sI) { v4u t;
            t.x = ((16 * sI + 8 * h + 0 > pr) ? 0x3F80u : 0u) | ((16 * sI + 8 * h + 1 > pr) ? 0x3F800000u : 0u); t.y = ((16 * sI + 8 * h + 2 > pr) ? 0x3F80u : 0u) | ((16 * sI + 8 * h + 3 > pr) ? 0x3F800000u : 0u);
            t.z = ((16 * sI + 8 * h + 4 > pr) ? 0x3F80u : 0u) | ((16 * sI + 8 * h + 5 > pr) ? 0x3F800000u : 0u); t.w = ((16 * sI + 8 * h + 6 > pr) ? 0x3F80u : 0u) | ((16 * sI + 8 * h + 7 > pr) ? 0x3F800000u : 0u);
            atri[sI] = __builtin_bit_cast(bf16x8, t); }
        f32x16 oacc[2][2]; float ssq[2];
#pragma unroll
        for (int qh = 0; qh < 2; ++qh) {
            const int tq = t0 + 32 * qh;
            bf16x8 qf[4];
#pragma unroll
            for (int ks = 0; ks < 4; ++ks) qf[ks] = *(const bf16x8*)(P + (size_t)(tq + r) * NIN + 1280 + hd * 64 + 16 * ks + 8 * h);
            f32x16 o0 = {}, o1 = {};
            float ls = 0.f;
            bf16x8 kfn[4]; v4u vvn[4];
            { const bf16* kp = P + (size_t)(tq + pr) * NIN + 1792 + hd * 64 + 8 * h;
#pragma unroll
              for (int ks = 0; ks < 4; ++ks) kfn[ks] = *(const bf16x8*)(kp + 16 * ks);
#pragma unroll
              for (int i = 0; i < 4; ++i) vvn[i] = *(const v4u*)(P + (size_t)(tq + (lane >> 3) + 8 * i) * NIN + 2304 + hd * 64 + 8 * (lane & 7)); }
            for (int k0 = tq;; k0 -= 32) {
                const bool diag = (k0 == tq);
                f32x16 z = {};
#pragma unroll
                for (int ks = 0; ks < 4; ++ks) z = __builtin_amdgcn_mfma_f32_32x32x16_bf16(kfn[ks], qf[ks], z, 0, 0, 0);
#pragma unroll
                for (int i = 0; i < 4; ++i) { const int key = (lane >> 3) + 8 * i, c = lane & 7; const v4u vv = vvn[i];
                    LAS bf16* vd = Vt + (8 * c) * 40 + key;
                    vd[0] = (bf16)(vv.x & 0xffffu); vd[40] = (bf16)(vv.x >> 16); vd[80] = (bf16)(vv.y & 0xffffu); vd[120] = (bf16)(vv.y >> 16);
                    vd[160] = (bf16)(vv.z & 0xffffu); vd[200] = (bf16)(vv.z >> 16); vd[240] = (bf16)(vv.w & 0xffffu); vd[280] = (bf16)(vv.w >> 16); }
                if (k0 >= 32) { const bf16* kp = P + (size_t)(k0 - 32 + pr) * NIN + 1792 + hd * 64 + 8 * h;
#pragma unroll
                    for (int ks = 0; ks < 4; ++ks) kfn[ks] = *(const bf16x8*)(kp + 16 * ks);
#pragma unroll
                    for (int i = 0; i < 4; ++i) vvn[i] = *(const v4u*)(P + (size_t)(k0 - 32 + (lane >> 3) + 8 * i) * NIN + 2304 + hd * 64 + 8 * (lane & 7)); }
                f32x16 cin; float rowsum = 0.f; unsigned lh[8], ll[8];
#pragma unroll
                for (int j = 0; j < 16; j += 2) { float Lv[2];
#pragma unroll
                    for (int e2 = 0; e2 < 2; ++e2) { const int jj = j + e2; const int keyl = 16 * (jj >> 3) + 8 * h + (jj & 7); const bool valid = !diag || (keyl < r);
                        const float zz = z[jj]; const float ex = __expf(-fabsf(zz)); const float lsig = fminf(zz, 0.f) - __logf(1.0f + ex);
                        Lv[e2] = valid ? (lsig - zz) : 0.f; cin[jj] = lsig + ls; rowsum += Lv[e2]; }
                    const unsigned hp = pk2(Lv[0], Lv[1]); lh[j >> 1] = hp; ll[j >> 1] = pk2(Lv[0] - bflo(hp), Lv[1] - bfhi(hp)); }
                bf16x8 bh0 = __builtin_bit_cast(bf16x8, (v4u){lh[0], lh[1], lh[2], lh[3]}), bh1 = __builtin_bit_cast(bf16x8, (v4u){lh[4], lh[5], lh[6], lh[7]});
                bf16x8 bl0 = __builtin_bit_cast(bf16x8, (v4u){ll[0], ll[1], ll[2], ll[3]}), bl1 = __builtin_bit_cast(bf16x8, (v4u){ll[4], ll[5], ll[6], ll[7]});
                f32x16 lw = __builtin_amdgcn_mfma_f32_32x32x16_bf16(atri[0], bh0, cin, 0, 0, 0);
                lw = __builtin_amdgcn_mfma_f32_32x32x16_bf16(atri[1], bh1, lw, 0, 0, 0);
                lw = __builtin_amdgcn_mfma_f32_32x32x16_bf16(atri[0], bl0, lw, 0, 0, 0);
                lw = __builtin_amdgcn_mfma_f32_32x32x16_bf16(atri[1], bl1, lw, 0, 0, 0);
                unsigned wp[8];
#pragma unroll
                for (int j = 0; j < 16; j += 2) { float wv[2];
#pragma unroll
                    for (int e2 = 0; e2 < 2; ++e2) { const int jj = j + e2; const int keyl = 16 * (jj >> 3) + 8 * h + (jj & 7); const bool valid = !diag || (keyl < r);
                        wv[e2] = valid ? __expf(lw[jj]) : 0.f; }
                    wp[j >> 1] = pk2(wv[0], wv[1]); }
                const bf16x8 w0 = __builtin_bit_cast(bf16x8, (v4u){wp[0], wp[1], wp[2], wp[3]}), w1 = __builtin_bit_cast(bf16x8, (v4u){wp[4], wp[5], wp[6], wp[7]});
                const LAS bf16* vr = Vt + r * 40 + 8 * h;
                o0 = __builtin_amdgcn_mfma_f32_32x32x16_bf16(*(const LAS bf16x8*)(vr), w0, o0, 0, 0, 0);
                o0 = __builtin_amdgcn_mfma_f32_32x32x16_bf16(*(const LAS bf16x8*)(vr + 16), w1, o0, 0, 0, 0);
                o1 = __builtin_amdgcn_mfma_f32_32x32x16_bf16(*(const LAS bf16x8*)(vr + 32 * 40), w0, o1, 0, 0, 0);
                o1 = __builtin_amdgcn_mfma_f32_32x32x16_bf16(*(const LAS bf16x8*)(vr + 32 * 40 + 16), w1, o1, 0, 0, 0);
                ls += rowsum + __shfl_xor(rowsum, 32);
                if (k0 < 32 || __builtin_amdgcn_ballot_w64(ls > -104.0f) == 0ull) break;
            }
            float ss = 0.f;
#pragma unroll
            for (int j = 0; j < 16; ++j) ss += o0[j] * o0[j] + o1[j] * o1[j];
            ss += __shfl_xor(ss, 32);
            if (h == 0) sm_ss[(32 * qh + r) * 8 + hd] = ss;
            oacc[qh][0] = o0; oacc[qh][1] = o1; ssq[qh] = ss;
        }
        LDS_WAIT(); __syncthreads();
#pragma unroll
        for (int qh = 0; qh < 2; ++qh) {
            const f32x4 sa = *(const LAS f32x4*)(sm_ss + (32 * qh + r) * 8), sb = *(const LAS f32x4*)(sm_ss + (32 * qh + r) * 8 + 4);
            const float tot = ((sa[0] + sa[1]) + (sa[2] + sa[3])) + ((sb[0] + sb[1]) + (sb[2] + sb[3]));
            const float rs = __builtin_amdgcn_rsqf(tot * (1.0f / 512.0f) + EPS);
            bf16* yp = Y + (size_t)(t0 + 32 * qh + r) * DM + 512 + hd * 64 + 4 * h;
#pragma unroll
            for (int db = 0; db < 2; ++db)
#pragma unroll
                for (int g4 = 0; g4 < 4; ++g4) { const f32x16& o = oacc[qh][db]; v2u w; w.x = pk2(o[4 * g4 + 0] * rs, o[4 * g4 + 1] * rs); w.y = pk2(o[4 * g4 + 2] * rs, o[4 * g4 + 3] * rs);
                    *(v2u*)(yp + 32 * db + 8 * g4) = w; }
        }
    }
    {
        const int c = tid & 255, rh = tid >> 8, tb = t0 + 32 * rh;
        const float w0 = conv_w[c], w1 = conv_w[256 + c], w2 = conv_w[512 + c];
        float p2 = 0.f, p1 = 0.f;
        if (tb >= 2) { const bf16* r2 = P + (size_t)(tb - 2) * NIN; const bf16* r1 = P + (size_t)(tb - 1) * NIN; p2 = bf1(r2[256 + c]) * bf1(r2[512 + c]); p1 = bf1(r1[256 + c]) * bf1(r1[512 + c]); }
#pragma unroll 16
        for (int r = 0; r < 32; ++r) { const bf16* rp = P + (size_t)(tb + r) * NIN; const float p0 = bf1(rp[256 + c]) * bf1(rp[512 + c]);
            tile[(32 * rh + r) * 260 + c] = bf1(rp[c]) * (w0 * p2 + w1 * p1 + w2 * p0); p2 = p1; p1 = p0; }
    }
    LDS_WAIT(); __syncthreads();
    norm_store_rows(tile, Y, t0, 0, wave, lane);
    const int tc = t0 & ~127, dt = t0 - tc, ns = dt + 64;
    { v2u uu[16];
#pragma unroll
      for (int i = 0; i < 16; ++i) { const int s = wave + 8 * i; uu[i] = (s < ns) ? *(const v2u*)(P + (size_t)(tc + s) * NIN + 1024 + lane * 4) : (v2u){0u, 0u}; }
      const f32x4 g = *(const f32x4*)(sgu_norm + lane * 4);
#pragma unroll
      for (int i = 0; i < 16; ++i) { const int s = wave + 8 * i;
        if (s < ns) { const v2u u = uu[i];
        const float v0 = bflo(u.x), v1 = bfhi(u.x), v2 = bflo(u.y), v3 = bfhi(u.y);
        const float ss = wave_sum((v0 * v0 + v1 * v1) + (v2 * v2 + v3 * v3)); const float rs = __builtin_amdgcn_rsqf(ss * (1.0f / 256.0f) + EPS);
        const unsigned a = pk2(v0 * rs * g[0], v1 * rs * g[1]), b = pk2(v2 * rs * g[2], v3 * rs * g[3]);
        vnT[(lane * 4 + 0) * 136 + s] = (bf16)(a & 0xffffu); vnT[(lane * 4 + 1) * 136 + s] = (bf16)(a >> 16); vnT[(lane * 4 + 2) * 136 + s] = (bf16)(b & 0xffffu); vnT[(lane * 4 + 3) * 136 + s] = (bf16)(b >> 16); } } }
    LDS_WAIT(); __syncthreads();
    {
        const int h = wave >> 1, rh = wave & 1, r32 = lane & 31, hi = lane >> 5;
        const int tcl = dt + 32 * rh + r32;
        const float* wrow = sgu_w + ((size_t)h * 128 + tcl) * 128;
        f32x16 o0 = {}, o1 = {};
        const int nk = (dt + 32 * rh + 32) >> 4;
        f32x4 wa[8], wb[8];
#pragma unroll
        for (int ks = 0; ks < 8; ++ks) { const int s0 = ks * 16 + 8 * hi; if (ks < nk) { wa[ks] = *(const f32x4*)(wrow + s0); wb[ks] = *(const f32x4*)(wrow + s0 + 4); } else { wa[ks] = (f32x4){0.f, 0.f, 0.f, 0.f}; wb[ks] = wa[ks]; } }
#pragma unroll
        for (int ks = 0; ks < 8; ++ks) if (ks < nk) { const int s0 = ks * 16 + 8 * hi;
            float wv[8] = {wa[ks][0], wa[ks][1], wa[ks][2], wa[ks][3], wb[ks][0], wb[ks][1], wb[ks][2], wb[ks][3]};
#pragma unroll
            for (int i = 0; i < 8; ++i) wv[i] = (s0 + i <= tcl) ? wv[i] : 0.f;
            v4u ap; ap.x = pk2(wv[0], wv[1]); ap.y = pk2(wv[2], wv[3]); ap.z = pk2(wv[4], wv[5]); ap.w = pk2(wv[6], wv[7]);
            const bf16x8 af = __builtin_bit_cast(bf16x8, ap);
            const bf16x8 b0 = *(const LAS bf16x8*)(vnT + (h * 64 + r32) * 136 + s0), b1 = *(const LAS bf16x8*)(vnT + (h * 64 + 32 + r32) * 136 + s0);
            o0 = __builtin_amdgcn_mfma_f32_32x32x16_bf16(af, b0, o0, 0, 0, 0);
            o1 = __builtin_amdgcn_mfma_f32_32x32x16_bf16(af, b1, o1, 0, 0, 0); }
#pragma unroll
        for (int j = 0; j < 16; ++j) { const int rl = 32 * rh + (j & 3) + 8 * (j >> 2) + 4 * hi;
            const float bb = sgu_b[h * 128 + dt + rl]; const bf16* up = P + (size_t)(t0 + rl) * NIN + 768 + h * 64;
            tile[rl * 260 + h * 64 + r32] = bf1(up[r32]) * (o0[j] + bb);
            tile[rl * 260 + h * 64 + 32 + r32] = bf1(up[32 + r32]) * (o1[j] + bb); }
    }
    LDS_WAIT(); __syncthreads();
    norm_store_rows(tile, Y, t0, 256, wave, lane);
    LDS_WAIT(); __syncthreads();
}

__device__ __forceinline__ void ffn_gate_phase(const bf16* GU, bf16* A, const float* fconv, int hf, int gtid, int gthreads) {
    for (int it = gtid; it < 256 * 176; it += gthreads) { const int rb = it / 176, cgp = it % 176, pnl = cgp >> 4, cc = (cgp & 15) * 8, ch = 1408 * hf + 128 * pnl + cc;
        float wg[3][8], wu[3][8];
#pragma unroll
        for (int i = 0; i < 3; ++i) { const f32x4 a0 = *(const f32x4*)(fconv + (size_t)i * NUP + ch), a1 = *(const f32x4*)(fconv + (size_t)i * NUP + ch + 4), b0 = *(const f32x4*)(fconv + (size_t)i * NUP + DFF + ch), b1 = *(const f32x4*)(fconv + (size_t)i * NUP + DFF + ch + 4);
#pragma unroll
            for (int e = 0; e < 4; ++e) { wg[i][e] = a0[e]; wg[i][4 + e] = a1[e]; wu[i][e] = b0[e]; wu[i][4 + e] = b1[e]; } }
        float g2[8], g1[8], u2[8], u1[8];
#pragma unroll
        for (int e = 0; e < 8; ++e) { g2[e] = g1[e] = u2[e] = u1[e] = 0.f; }
        for (int r = -2; r < 64; ++r) { const int t = 64 * rb + r; float g0[8], u0[8];
            if (t >= 0) { const v4u gv = *(const v4u*)(GU + (size_t)t * NIN + 256 * pnl + cc), uv = *(const v4u*)(GU + (size_t)t * NIN + 256 * pnl + 128 + cc);
                g0[0] = bflo(gv.x); g0[1] = bfhi(gv.x); g0[2] = bflo(gv.y); g0[3] = bfhi(gv.y); g0[4] = bflo(gv.z); g0[5] = bfhi(gv.z); g0[6] = bflo(gv.w); g0[7] = bfhi(gv.w);
                u0[0] = bflo(uv.x); u0[1] = bfhi(uv.x); u0[2] = bflo(uv.y); u0[3] = bfhi(uv.y); u0[4] = bflo(uv.z); u0[5] = bfhi(uv.z); u0[6] = bflo(uv.w); u0[7] = bfhi(uv.w); }
            else {
#pragma unroll
                for (int e = 0; e < 8; ++e) { g0[e] = 0.f; u0[e] = 0.f; } }
            if (r >= 0) { float o[8];
#pragma unroll
                for (int e = 0; e < 8; ++e) { const float G = wg[0][e] * g2[e] + wg[1][e] * g1[e] + wg[2][e] * g0[e], U = wu[0][e] * u2[e] + wu[1][e] * u1[e] + wu[2][e] * u0[e];
                    o[e] = G * __builtin_amdgcn_rcpf(1.0f + __expf(-G)) * U; }
                v4u ov; ov.x = pk2(o[0], o[1]); ov.y = pk2(o[2], o[3]); ov.z = pk2(o[4], o[5]); ov.w = pk2(o[6], o[7]);
                *(v4u*)(A + (size_t)t * DFF + ch) = ov; }
#pragma unroll
            for (int e = 0; e < 8; ++e) { g2[e] = g1[e]; g1[e] = g0[e]; u2[e] = u1[e]; u1[e] = u0[e]; } }
    }
}
__global__ void __launch_bounds__(NTHR, 2) hybrid_fwd(Args args) {
    extern __shared__ __attribute__((aligned(16))) unsigned char lds_raw[];
    LAS unsigned char* lds = (LAS unsigned char*)lds_raw;
    cg::grid_group grid = cg::this_grid();
    volatile LAS unsigned* MISC = (volatile LAS unsigned*)(lds + LDS_BYTES - 64);
    if (threadIdx.x < 16) MISC[threadIdx.x] = 0u;
    __syncthreads();
    XcdBarrier xbar = xcd_barrier_post((unsigned*)args.ws, MISC);
    const int tid = threadIdx.x, lane = tid & 63, wave = __builtin_amdgcn_readfirstlane(tid >> 6);
    const int G = gridDim.x, bx = blockIdx.x;
    const int gw = bx * NWAVES + wave, NGW = G * NWAVES;
    unsigned char* ws = args.ws;
    const float* x_in = args.in[0]; const float* norm_mix = args.in[1]; const float* w_in = args.in[2]; const float* conv_w = args.in[3];
    const float* sgu_norm = args.in[4]; const float* sgu_w = args.in[5]; const float* sgu_b = args.in[6]; const float* out_norm = args.in[7];
    const float* w_out = args.in[8]; const float* norm_ffn = args.in[9]; const float* w_up = args.in[10]; const float* ffn_conv = args.in[11];
    const float* w_down = args.in[12]; const float* norm_final = args.in[13];
    float* xcur = args.out;
    bf16* Win_t = (bf16*)(ws + WS_WIN); bf16* Wout_t = (bf16*)(ws + WS_WOUT); bf16* Wup_t = (bf16*)(ws + WS_WUP); bf16* Wdn_t = (bf16*)(ws + WS_WDN);
    float* part = (float*)(ws + WS_PART); bf16* XB = (bf16*)(ws + WS_XB); bf16* P = (bf16*)(ws + WS_P); bf16* Y = (bf16*)(ws + WS_Y);
    bf16* GU = (bf16*)(ws + WS_GU); bf16* A = (bf16*)(ws + WS_A);

    {
        LAS float* scr = (LAS float*)(lds + wave * 16384);
        constexpr int I_IN = 16 * 88, I_OUT = 16 * 32, I_UP = 16 * 176, I_DN = 44 * 32, I_L = I_IN + I_OUT + I_UP + I_DN;
        for (int it = gw; it < DEPTH * I_L; it += NGW) { const int l = it / I_L; int r = it % I_L;
            if (r < I_IN) { cvt_item(w_in + (size_t)l * DM * NIN, DM, NIN, Win_t + (size_t)l * NIN * DM, norm_mix + l * DM, 1, scr, r, lane); continue; } r -= I_IN;
            if (r < I_OUT) { cvt_item(w_out + (size_t)l * DM * DM, DM, DM, Wout_t + (size_t)l * DM * DM, out_norm + l * DM, 0, scr, r, lane); continue; } r -= I_OUT;
            if (r < I_UP) { cvt_item(w_up + (size_t)l * DM * NUP, DM, NUP, Wup_t + (size_t)l * NUP * DM, norm_ffn + l * DM, 2, scr, r, lane); continue; } r -= I_UP;
            cvt_item(w_down + (size_t)l * DFF * DM, DFF, DM, Wdn_t + (size_t)l * DM * DFF, nullptr, 0, scr, r, lane); }
        for (int m = gw; m < S; m += NGW) { const f32x4* xr = (const f32x4*)(x_in + (size_t)m * DM) + lane; f32x4 v[4]; float ss = 0.f;
#pragma unroll
            for (int j = 0; j < 4; ++j) { v[j] = xr[64 * j]; ss += (v[j][0] * v[j][0] + v[j][1] * v[j][1]) + (v[j][2] * v[j][2] + v[j][3] * v[j][3]); }
            ss = wave_sum(ss);
            v2u* o8 = (v2u*)(XB + (size_t)m * DM) + lane;
#pragma unroll
            for (int j = 0; j < 4; ++j) { v2u o; o.x = pk2(v[j][0], v[j][1]); o.y = pk2(v[j][2], v[j][3]); o8[64 * j] = o; }
            if (lane < 16) part[(size_t)m * 16 + lane] = lane == 0 ? ss : 0.f; }
    }
    grid.sync();

    for (int l = 0; l < DEPTH; ++l) {
        { pg8::Gemm g{XB, Win_t + (size_t)l * NIN * DM, S, NIN, DM, 256}; pg8::StaticOrder So; So.init(S, NIN, G, bx);
          pg8::EpiScaleBf16 E{P, NIN, part, (LAS float*)(lds + 131072 + 8192)};
          pg8::gemm_phase<pg8::EpiScaleBf16, pg8::StaticOrder, true, true>(lds, g, So, E); }
        xcd_barrier(xbar);
        for (int u = bx; u < S / 64; u += G)
            mixer_unit(lds, u, P, Y, conv_w + l * 3 * 256, sgu_norm + l * 256, sgu_w + (size_t)l * 4 * 128 * 128, sgu_b + l * 4 * 128, tid, wave, lane);
        xcd_barrier(xbar);
        { pg8::Gemm g{Y, Wout_t + (size_t)l * DM * DM, S, DM, DM, 256}; pg8::StaticOrder So; So.init(S, DM, G, bx);
          pg8::EpiResid E{l == 0 ? x_in : xcur, xcur, XB, part};
          pg8::gemm_phase<pg8::EpiResid, pg8::StaticOrder, true, true>(lds, g, So, E); }
        xcd_barrier(xbar);
        { pg8::Gemm g{XB - 2 * DM, Wup_t + (size_t)l * NUP * DM, 65 * 256, NUP, DM, 254}; pg8::StaticOrder So; So.init(65 * 256, NUP, G, bx);
          pg8::EpiGate E{A, part, ffn_conv + (size_t)l * 3 * NUP, (LAS float*)(lds + 131072)};
          pg8::gemm_phase<pg8::EpiGate, pg8::StaticOrder, true, true>(lds, g, So, E); }
        xcd_barrier(xbar);
        { pg8::Gemm g{A, Wdn_t + (size_t)l * DM * DFF, S, DM, DFF, 256}; pg8::StaticOrder So; So.init(S, DM, G, bx);
          pg8::EpiResid E{xcur, xcur, XB, part};
          pg8::gemm_phase<pg8::EpiResid, pg8::StaticOrder, true, true>(lds, g, So, E); }
        xcd_barrier(xbar);
    }
    for (int m = gw; m < S; m += NGW) { f32x4* xr = (f32x4*)(xcur + (size_t)m * DM) + lane; f32x4 v[4]; float ss = 0.f;
#pragma unroll
        for (int j = 0; j < 4; ++j) { v[j] = xr[64 * j]; ss += (v[j][0] * v[j][0] + v[j][1] * v[j][1]) + (v[j][2] * v[j][2] + v[j][3] * v[j][3]); }
        const float rs = __builtin_amdgcn_rsqf(wave_sum(ss) * (1.0f / 1024.0f) + EPS);
#pragma unroll
        for (int j = 0; j < 4; ++j) { const f32x4 g = *((const f32x4*)norm_final + lane + 64 * j); xr[64 * j] = v[j] * rs * g; } }
}

extern "C" void kernel_launch(void* const* d_in, const int* in_sizes, int n_in, void* d_out, int out_size, void* d_ws, size_t ws_size, hipStream_t stream) {
    static int grid = 0;
    if (grid == 0) {
        if (n_in != 14 || out_size != S * DM || ws_size < WS_END) { fprintf(stderr, "kernel_launch: unexpected shapes / workspace (%d inputs, out %d, ws %zu)\n", n_in, out_size, ws_size); grid = -1; return; }
        int dev = 0, cus = 0, per_cu = 0;
        hipGetDevice(&dev); hipDeviceGetAttribute(&cus, hipDeviceAttributeMultiprocessorCount, dev);
        hipFuncSetAttribute((const void*)hybrid_fwd, hipFuncAttributeMaxDynamicSharedMemorySize, LDS_BYTES);
        hipOccupancyMaxActiveBlocksPerMultiprocessor(&per_cu, (const void*)hybrid_fwd, NTHR, LDS_BYTES);
        (void)hipGetLastError();
        if (per_cu < 1) per_cu = 1;
        grid = cus * 1;
    }
    if (grid < 0) return;
    hipMemsetAsync((unsigned char*)d_ws, 0, 16384, stream);
    hipMemsetAsync((unsigned char*)d_ws + WS_XB - 4096, 0, 4096, stream);
    Args a{};
    for (int i = 0; i < 14; ++i) a.in[i] = (const float*)d_in[i];
    a.out = (float*)d_out; a.ws = (unsigned char*)d_ws;
    void* kargs[] = {&a};
    hipError_t e = hipLaunchCooperativeKernel((const void*)hybrid_fwd, dim3(grid), dim3(NTHR), kargs, LDS_BYTES, stream);
    if (e != hipSuccess) fprintf(stderr, "cooperative launch failed: %s (grid %d)\n", hipGetErrorString(e), grid);
}
```

```cpp
#include <hip/hip_runtime.h>
#include <hip/hip_cooperative_groups.h>
#include <cstdio>
#include <cstdint>
namespace cg = cooperative_groups;
namespace pg8 {
#define PG8_LAS __attribute__((address_space(3)))
typedef unsigned short bf16_t;
typedef short bf16x8 __attribute__((ext_vector_type(8)));
typedef float f32x4 __attribute__((ext_vector_type(4)));
typedef unsigned u32x4 __attribute__((ext_vector_type(4)));
typedef unsigned u32x2 __attribute__((ext_vector_type(2)));
constexpr int BM = 256, BK = 64, HALF = 128, HTB = HALF * BK * 2  , STAGE_BYTES = 8 * HTB, NXCD = 8, WGM = 8;

__host__ __device__ __forceinline__ int lds_byte(int r, int c) { const int st = (r >> 4) * 2 + (c >> 5), rr = r & 15, cc = c & 31, ob = rr * 64 + cc * 2; return st * 1024 + (ob ^ (((ob >> 9) & 1) << 5)); }
__host__ __device__ __forceinline__ void stage_rc(int b, int& R, int& C) { const int st = b / 1024, sb = b % 1024, swz = sb ^ (((sb >> 9) & 1) << 5); R = (st >> 1) * 16 + swz / 64; C = (st & 1) * 32 + (swz % 64) / 2; }
__host__ __device__ __forceinline__ int perm32(int rho) { const int n = rho >> 4, i = rho & 15; return 8 * (i >> 2) + 4 * n + (i & 3); }

struct Unit { int pm, pn; };
struct Gemm { const bf16_t* A; const bf16_t* Bt; int M, N, K; int arows; };

struct StaticOrder {
    int nM, nN, nwg, G, c;
    __host__ __device__ void init(int M, int N, int G_, int c_) { nM = M / BM; nN = N / BM; nwg = nM * nN; G = G_; c = c_; }
    __host__ __device__ bool next(int i, Unit& u) const {
        const long L = (long)i * G + c; if (L >= nwg) return false;
        int wgid = (int)L; { const int q = nwg / NXCD, r = nwg % NXCD, xcd = wgid % NXCD, off = wgid / NXCD; wgid = (xcd < r ? xcd * (q + 1) : r * (q + 1) + (xcd - r) * q) + off; }
        const int nig = WGM * nN, gid = wgid / nig, fm = gid * WGM, gsz = (nM - fm) < WGM ? (nM - fm) : WGM;
        u.pm = fm + ((wgid % nig) % gsz); u.pn = (wgid % nig) / gsz; return true;
    }
    __device__ __forceinline__ void a_ready(const Unit&) const {}
    __device__ __forceinline__ void done(const Unit&) const {}
};

__device__ __forceinline__ unsigned cvt_pk_bf16(float lo, float hi) { unsigned r; asm volatile("v_cvt_pk_bf16_f32 %0, %1, %2" : "=v"(r) : "v"(lo), "v"(hi)); return r; }
struct EpiScaleBf16 {
    static constexpr bool PERM = true, AFTER_DRAIN = false;
    bf16_t* O; int ldc; const float* part; PG8_LAS float* rsl;
    __device__ __forceinline__ void operator()(const f32x4 (&acc)[2][2][4][2], const Unit& u, int wr, int wc, int fr, int fq) const {
        { const int t = (wr * 4 + wc) * 64 + fq * 16 + fr;
          if (t < 256) { const f32x4* pp = (const f32x4*)(part + (size_t)(u.pm * BM + t) * 16); const f32x4 a = pp[0], b = pp[1], c = pp[2], d = pp[3];
              const f32x4 s4 = (a + b) + (c + d); const float ss = (s4[0] + s4[1]) + (s4[2] + s4[3]); rsl[t] = __builtin_amdgcn_rsqf(ss * (1.0f / 1024.0f) + 1e-6f); } }
        asm volatile("s_waitcnt lgkmcnt(0)" ::: "memory"); __builtin_amdgcn_s_barrier(); asm volatile("" ::: "memory");
        const int row0 = u.pm * BM + wr * 64 + fr; const int col0 = u.pn * BM + wc * 32 + 8 * fq;
#pragma unroll
        for (int ai = 0; ai < 2; ++ai)
#pragma unroll
            for (int m = 0; m < 4; ++m) { const int row = row0 + ai * HALF + m * 16;
                const float rs = rsl[ai * HALF + wr * 64 + m * 16 + fr];
                bf16_t* rowp = O + (size_t)row * ldc + col0;
#pragma unroll
                for (int bj = 0; bj < 2; ++bj) { const f32x4 v0 = acc[ai][bj][m][0] * rs, v1 = acc[ai][bj][m][1] * rs;
                    u32x4 w; w.x = cvt_pk_bf16(v0[0], v0[1]); w.y = cvt_pk_bf16(v0[2], v0[3]); w.z = cvt_pk_bf16(v1[0], v1[1]); w.w = cvt_pk_bf16(v1[2], v1[3]);
                    *(u32x4*)(rowp + bj * HALF) = w; } }
    }
};
struct EpiResid {
    static constexpr bool PERM = true, AFTER_DRAIN = false;
    const float* base; float* out; bf16_t* xb; float* part;
    __device__ __forceinline__ void operator()(const f32x4 (&acc)[2][2][4][2], const Unit& u, int wr, int wc, int fr, int fq) const {
        const int row0 = u.pm * BM + wr * 64 + fr; const int col0 = u.pn * BM + wc * 32 + 8 * fq;
        f32x4 pre[3][4];
#define PG8_RLOAD(g_) do { const size_t o_ = (size_t)(row0 + ((g_) >> 2) * HALF + ((g_) & 3) * 16) * 1024 + col0; \
            pre[(g_) % 3][0] = *(const f32x4*)(base + o_); pre[(g_) % 3][1] = *(const f32x4*)(base + o_ + 4); pre[(g_) % 3][2] = *(const f32x4*)(base + o_ + HALF); pre[(g_) % 3][3] = *(const f32x4*)(base + o_ + HALF + 4); } while (0)
        PG8_RLOAD(0); PG8_RLOAD(1);
#pragma unroll
        for (int g = 0; g < 8; ++g) { const int ai = g >> 2, m = g & 3;
            if (g + 2 < 8) PG8_RLOAD(g + 2);
            asm volatile("" ::: "memory");
            const int row = row0 + ai * HALF + m * 16; const size_t off = (size_t)row * 1024 + col0; float ss = 0.f;
#pragma unroll
            for (int bj = 0; bj < 2; ++bj) { const f32x4 v0 = acc[ai][bj][m][0] + pre[g % 3][2 * bj], v1 = acc[ai][bj][m][1] + pre[g % 3][2 * bj + 1];
                *(f32x4*)(out + off + bj * HALF) = v0; *(f32x4*)(out + off + bj * HALF + 4) = v1;
                ss += (v0[0] * v0[0] + v0[1] * v0[1]) + (v0[2] * v0[2] + v0[3] * v0[3]) + (v1[0] * v1[0] + v1[1] * v1[1]) + (v1[2] * v1[2] + v1[3] * v1[3]);
                u32x4 w; w.x = cvt_pk_bf16(v0[0], v0[1]); w.y = cvt_pk_bf16(v0[2], v0[3]); w.z = cvt_pk_bf16(v1[0], v1[1]); w.w = cvt_pk_bf16(v1[2], v1[3]);
                *(u32x4*)(xb + off + bj * HALF) = w; }
            ss += __shfl_xor(ss, 16); ss += __shfl_xor(ss, 32);
            if (fq == 0) part[(size_t)row * 16 + u.pn * 4 + wc] = ss;
            asm volatile("" ::: "memory"); }
#undef PG8_RLOAD
    }
};
#define PG8_DPP(oldv, srcv, ctrl) __builtin_bit_cast(float, __builtin_amdgcn_update_dpp(__builtin_bit_cast(int, (float)(oldv)), __builtin_bit_cast(int, (float)(srcv)), (ctrl), 0xf, 0xf, false))
struct EpiGate {
    static constexpr bool PERM = true, AFTER_DRAIN = false;
    bf16_t* Aout; const float* part; const float* fconv; PG8_LAS float* xch;
    __device__ __forceinline__ void operator()(f32x4 (&acc)[2][2][4][2], const Unit& u, int wr, int wc, int fr, int fq) const {
        PG8_LAS float* rsl = xch + 2048;
        { const int t = (wr * 4 + wc) * 64 + fq * 16 + fr;
          if (t < 256) { const int row = u.pm * 254 - 2 + t; const bool ok = row >= 0 && row < 16384; const int rc = ok ? row : 0;
              const f32x4* pp = (const f32x4*)(part + (size_t)rc * 16); const f32x4 a = pp[0], b = pp[1], c = pp[2], d = pp[3];
              const f32x4 s4 = (a + b) + (c + d); const float ss = (s4[0] + s4[1]) + (s4[2] + s4[3]);
              rsl[t] = ok ? __builtin_amdgcn_rsqf(ss * (1.0f / 1024.0f) + 1e-6f) : 0.f; } }
        asm volatile("s_waitcnt lgkmcnt(0)" ::: "memory"); __builtin_amdgcn_s_barrier(); asm volatile("" ::: "memory");
        const int ccol = wc * 32 + 8 * fq;
#pragma unroll
        for (int ai = 0; ai < 2; ++ai)
#pragma unroll
            for (int m = 0; m < 4; ++m) { const float rs = rsl[ai * HALF + wr * 64 + m * 16 + fr];
#pragma unroll
                for (int bj = 0; bj < 2; ++bj) { acc[ai][bj][m][0] *= rs; acc[ai][bj][m][1] *= rs; } }
        if (fr >= 14) {
#pragma unroll
            for (int ai = 0; ai < 2; ++ai)
#pragma unroll
                for (int bj = 0; bj < 2; ++bj)
#pragma unroll
                    for (int n = 0; n < 2; ++n) *(PG8_LAS f32x4*)(xch + ((2 * ai + wr) * 2 + (fr & 1)) * 256 + bj * HALF + ccol + 4 * n) = acc[ai][bj][3][n];
        }
        asm volatile("s_waitcnt lgkmcnt(0)" ::: "memory"); __builtin_amdgcn_s_barrier(); asm volatile("" ::: "memory");
        const int ch0 = u.pn * HALF + ccol;
#pragma unroll
        for (int ai = 0; ai < 2; ++ai) {
            const int grp = 2 * ai + wr;
#pragma unroll
            for (int n = 0; n < 2; ++n) {
                asm volatile("" ::: "memory");
                const float* fw = fconv + ch0 + 4 * n;
                const f32x4 wg0 = *(const f32x4*)(fw), wg1 = *(const f32x4*)(fw + 5632), wg2 = *(const f32x4*)(fw + 2 * 5632);
                const f32x4 wu0 = *(const f32x4*)(fw + 2816), wu1 = *(const f32x4*)(fw + 5632 + 2816), wu2 = *(const f32x4*)(fw + 2 * 5632 + 2816);
                f32x4 xpg = {0.f, 0.f, 0.f, 0.f}, xpu = {0.f, 0.f, 0.f, 0.f};
                if (grp > 0) { xpg = *(const PG8_LAS f32x4*)(xch + ((grp - 1) * 2 + (fr & 1)) * 256 + ccol + 4 * n); xpu = *(const PG8_LAS f32x4*)(xch + ((grp - 1) * 2 + (fr & 1)) * 256 + HALF + ccol + 4 * n); }
#pragma unroll
                for (int m = 0; m < 4; ++m) {
                    float o[4];
#pragma unroll
                    for (int j = 0; j < 4; ++j) {
                        const float xg = acc[ai][0][m][n][j], xu = acc[ai][1][m][n][j];
                        const float pg = m > 0 ? acc[ai][0][m > 0 ? m - 1 : 0][n][j] : xpg[j], pu = m > 0 ? acc[ai][1][m > 0 ? m - 1 : 0][n][j] : xpu[j];
                        const float g1 = PG8_DPP(PG8_DPP(0.f, pg, 0x121), xg, 0x111), g2 = PG8_DPP(PG8_DPP(0.f, pg, 0x122), xg, 0x112);
                        const float u1 = PG8_DPP(PG8_DPP(0.f, pu, 0x121), xu, 0x111), u2 = PG8_DPP(PG8_DPP(0.f, pu, 0x122), xu, 0x112);
                        const float Gv = wg0[j] * g2 + wg1[j] * g1 + wg2[j] * xg, Uv = wu0[j] * u2 + wu1[j] * u1 + wu2[j] * xu;
                        o[j] = Gv * __builtin_amdgcn_rcpf(1.0f + __expf(-Gv)) * Uv; }
                    const int r = ai * HALF + wr * 64 + m * 16 + fr, row = u.pm * 254 - 2 + r;
                    u32x2 w; w.x = cvt_pk_bf16(o[0], o[1]); w.y = cvt_pk_bf16(o[2], o[3]);
                    if (r >= 2 && row < 16384) *(u32x2*)(Aout + (size_t)row * 2816 + ch0 + 4 * n) = w; }
            }
        }
    }
};
template <class Epi, class Sched, bool ALIGN_EPI = false, bool SP2 = false>
__device__ __forceinline__ void gemm_phase(PG8_LAS unsigned char* lds, const Gemm g, const Sched& S, const Epi& E) {
    int tid = threadIdx.x; asm volatile("" : "+v"(tid));
    const int wid = __builtin_amdgcn_readfirstlane(tid >> 6), lane = tid & 63, wr = wid >> 2, wc = wid & 3, fr = lane & 15, fq = lane >> 4;
    const int K = g.K, nt = K / BK;
    unsigned voffA[2], voffB[2];
#pragma unroll
    for (int i = 0; i < 2; ++i) { int R, C; stage_rc(tid * 16 + i * 8192, R, C); const int Rb = Epi::PERM ? ((R & ~31) + perm32(R & 31)) : R;
        voffA[i] = (unsigned)(R * K + C) * 2u; voffB[i] = (unsigned)(Rb * K + C) * 2u; }
    const size_t kstep = (size_t)(BK * 2);
    const size_t hstep = (size_t)HALF * K * 2;
    const size_t tstep = 2 * hstep;
    const size_t tstepA = (size_t)g.arows * K * 2;
    const unsigned ldsw = (unsigned)wid * 1024u;
    const int aoff = lds_byte(wr * 64 + fr, fq * 8), boff = lds_byte(wc * 32 + fr, fq * 8);
#define PG8_SA(b, h) (((b) * 2 + (h)) * HTB)
#define PG8_SB(b, h) ((4 + (b) * 2 + (h)) * HTB)
#define PG8_STAGE(bufoff, gbase, voff) do { _Pragma("unroll") for (int _i = 0; _i < 2; ++_i) \
        __builtin_amdgcn_global_load_lds((const unsigned*)((const char*)(gbase) + (voff)[_i]), (PG8_LAS unsigned*)(lds + (bufoff) + ldsw + _i * 8192), 16, 0, 0); } while (0)
#define PG8_LDA(dst, b, h) do { _Pragma("unroll") for (int m = 0; m < 4; ++m) _Pragma("unroll") for (int k = 0; k < 2; ++k) dst[m][k] = *(const PG8_LAS bf16x8*)(lds + PG8_SA(b, h) + aoff + m * 2048 + k * 1024); } while (0)
#define PG8_LDB(dst, b, h) do { _Pragma("unroll") for (int n = 0; n < 2; ++n) _Pragma("unroll") for (int k = 0; k < 2; ++k) dst[n][k] = *(const PG8_LAS bf16x8*)(lds + PG8_SB(b, h) + boff + n * 2048 + k * 1024); } while (0)
#define PG8_MMA(ai, bj, At, Bt) do { __builtin_amdgcn_s_setprio(1); _Pragma("unroll") for (int m = 0; m < 4; ++m) _Pragma("unroll") for (int n = 0; n < 2; ++n) _Pragma("unroll") for (int k = 0; k < 2; ++k) \
        acc[ai][bj][m][n] = __builtin_amdgcn_mfma_f32_16x16x32_bf16(Bt[n][k], At[m][k], acc[ai][bj][m][n], 0, 0, 0); __builtin_amdgcn_s_setprio(0); } while (0)
#define PG8_WAIT_V(n) asm volatile("s_waitcnt vmcnt(" #n ")" ::: "memory")
#define PG8_WAIT_L(n) asm volatile("s_waitcnt lgkmcnt(" #n ")" ::: "memory")
#define PG8_BAR __builtin_amdgcn_s_barrier()
#define PG8_SCHED __builtin_amdgcn_sched_barrier(0)
    Unit cur, nxt; int ui = 0;
    if (!S.next(0, cur)) return;
    f32x4 acc[2][2][4][2];
#pragma unroll
    for (int a = 0; a < 2; ++a)
#pragma unroll
        for (int b = 0; b < 2; ++b)
#pragma unroll
            for (int m = 0; m < 4; ++m)
#pragma unroll
                for (int n = 0; n < 2; ++n) acc[a][b][m][n] = (f32x4){0.f, 0.f, 0.f, 0.f};
    bf16x8 At[4][2], B0[2][2], B1[2][2];
    const char* cA = (const char*)g.A + (size_t)cur.pm * tstepA; const char* cB = (const char*)g.Bt + (size_t)cur.pn * tstep;
    S.a_ready(cur);
    if constexpr (SP2) {
        PG8_STAGE(PG8_SB(0, 0), cB, voffB); PG8_STAGE(PG8_SB(0, 1), cB + hstep, voffB); PG8_STAGE(PG8_SA(0, 0), cA, voffA); PG8_STAGE(PG8_SA(0, 1), cA + hstep, voffA);
        if (wr == 1) PG8_BAR;
        PG8_WAIT_V(2); PG8_BAR;
        PG8_STAGE(PG8_SB(1, 0), cB + kstep, voffB); PG8_STAGE(PG8_SA(1, 0), cA + kstep, voffA); PG8_STAGE(PG8_SB(1, 1), cB + hstep + kstep, voffB);
        PG8_WAIT_V(6); PG8_BAR;
    } else {
        PG8_STAGE(PG8_SB(0, 0), cB, voffB); PG8_STAGE(PG8_SA(0, 0), cA, voffA); PG8_STAGE(PG8_SB(0, 1), cB + hstep, voffB); PG8_STAGE(PG8_SA(0, 1), cA + hstep, voffA);
        if (wr == 1) PG8_BAR;
        PG8_WAIT_V(4); PG8_BAR;
        PG8_STAGE(PG8_SB(1, 0), cB + kstep, voffB); PG8_STAGE(PG8_SA(1, 0), cA + kstep, voffA); PG8_STAGE(PG8_SB(1, 1), cB + hstep + kstep, voffB);
        PG8_WAIT_V(6); PG8_BAR;
    }
    for (;;) {
        const bool has_next = S.next(ui + 1, nxt);
        const char* nA = has_next ? (const char*)g.A + (size_t)nxt.pm * tstepA : cA; const char* nB = has_next ? (const char*)g.Bt + (size_t)nxt.pn * tstep : cB;
        for (int t = 0; t < nt; t += 2) {
            const bool last = (t == nt - 2);
            const char* a1 = cA + (size_t)(t + 1) * kstep;
            const char* a2 = last ? nA : cA + (size_t)(t + 2) * kstep; const char* b2 = last ? nB : cB + (size_t)(t + 2) * kstep;
            const char* a3 = a2 + kstep; const char* b3 = b2 + kstep;
            if (last && has_next) S.a_ready(nxt);
            if constexpr (SP2) {
            PG8_LDB(B0, 0, 0); PG8_LDB(B1, 0, 1); PG8_SCHED; PG8_LDA(At, 0, 0); PG8_STAGE(PG8_SA(1, 1), a1 + hstep, voffA);
            PG8_WAIT_V(8); PG8_WAIT_L(0); PG8_BAR; PG8_MMA(0, 0, At, B0); PG8_MMA(0, 1, At, B1); PG8_BAR; PG8_SCHED;
            PG8_LDA(At, 0, 1); PG8_STAGE(PG8_SB(0, 0), b2, voffB); PG8_STAGE(PG8_SB(0, 1), b2 + hstep, voffB); PG8_STAGE(PG8_SA(0, 0), a2, voffA);
            PG8_WAIT_V(8); PG8_WAIT_L(0); PG8_BAR; PG8_MMA(1, 0, At, B0); PG8_MMA(1, 1, At, B1); PG8_BAR; PG8_SCHED;
            PG8_LDB(B0, 1, 0); PG8_LDB(B1, 1, 1); PG8_SCHED; PG8_LDA(At, 1, 0); PG8_STAGE(PG8_SA(0, 1), a2 + hstep, voffA);
            PG8_WAIT_V(8); PG8_WAIT_L(0); PG8_BAR; PG8_MMA(0, 0, At, B0); PG8_MMA(0, 1, At, B1); PG8_BAR; PG8_SCHED;
            PG8_LDA(At, 1, 1); PG8_STAGE(PG8_SB(1, 0), b3, voffB); PG8_STAGE(PG8_SB(1, 1), b3 + hstep, voffB); PG8_STAGE(PG8_SA(1, 0), a3, voffA);
            PG8_WAIT_V(8); PG8_WAIT_L(0); PG8_BAR; PG8_MMA(1, 0, At, B0); PG8_MMA(1, 1, At, B1); PG8_BAR; PG8_SCHED;
            } else {
            PG8_LDB(B0, 0, 0); PG8_SCHED; PG8_LDA(At, 0, 0); PG8_STAGE(PG8_SA(1, 1), a1 + hstep, voffA);
            PG8_WAIT_L(8); PG8_BAR; PG8_WAIT_L(0); PG8_MMA(0, 0, At, B0); PG8_BAR; PG8_SCHED;
            PG8_LDB(B1, 0, 1); PG8_STAGE(PG8_SB(0, 0), b2, voffB);
            PG8_BAR; PG8_WAIT_L(0); PG8_MMA(0, 1, At, B1); PG8_BAR;
            PG8_LDA(At, 0, 1); PG8_STAGE(PG8_SA(0, 0), a2, voffA);
            PG8_BAR; PG8_WAIT_L(0); PG8_MMA(1, 0, At, B0); PG8_BAR; PG8_SCHED;
            PG8_STAGE(PG8_SB(0, 1), b2 + hstep, voffB);
            PG8_WAIT_V(6); PG8_BAR; PG8_MMA(1, 1, At, B1); PG8_BAR;
            PG8_LDB(B0, 1, 0); PG8_SCHED; PG8_LDA(At, 1, 0); PG8_STAGE(PG8_SA(0, 1), a2 + hstep, voffA);
            PG8_WAIT_L(8); PG8_BAR; PG8_WAIT_L(0); PG8_MMA(0, 0, At, B0); PG8_BAR; PG8_SCHED;
            PG8_LDB(B1, 1, 1); PG8_STAGE(PG8_SB(1, 0), b3, voffB);
            PG8_BAR; PG8_WAIT_L(0); PG8_MMA(0, 1, At, B1); PG8_BAR;
            PG8_LDA(At, 1, 1); PG8_STAGE(PG8_SA(1, 0), a3, voffA);
            PG8_BAR; PG8_WAIT_L(0); PG8_MMA(1, 0, At, B0); PG8_BAR; PG8_SCHED;
            PG8_STAGE(PG8_SB(1, 1), b3 + hstep, voffB);
            PG8_WAIT_V(6); PG8_BAR; PG8_MMA(1, 1, At, B1); PG8_BAR;
            }
        }
        if constexpr (ALIGN_EPI) { if (wr == 0) PG8_BAR; }
        if constexpr (!Epi::AFTER_DRAIN) { E(acc, cur, wr, wc, fr, fq); S.done(cur); }
        if (!has_next) break;
#pragma unroll
        for (int a = 0; a < 2; ++a)
#pragma unroll
            for (int b = 0; b < 2; ++b)
#pragma unroll
                for (int m = 0; m < 4; ++m)
#pragma unroll
                    for (int n = 0; n < 2; ++n) acc[a][b][m][n] = (f32x4){0.f, 0.f, 0.f, 0.f};
        cur = nxt; cA = nA; cB = nB; ++ui;
        if constexpr (ALIGN_EPI) { if (wr == 1) PG8_BAR; }
    }
    PG8_WAIT_V(0);
    if constexpr (!ALIGN_EPI) { if (wr == 0) PG8_BAR; }
    PG8_BAR;
    if constexpr (Epi::AFTER_DRAIN) { E.fused(acc, cur, wr, wc, fr, fq, lds, wid, lane); S.done(cur); }
#undef PG8_SA
#undef PG8_SB
#undef PG8_STAGE
#undef PG8_LDA
#undef PG8_LDB
#undef PG8_MMA
#undef PG8_WAIT_V
#undef PG8_WAIT_L
#undef PG8_BAR
#undef PG8_SCHED
}
}
constexpr int S = 16384, DM = 1024, DEPTH = 4, NIN = 2816, DFF = 2816, NUP = 5632;
constexpr float EPS = 1e-6f;
constexpr int NWAVES = 8, NTHR = 512;
constexpr size_t MiB = 1u << 20;
constexpr size_t WS_WIN = 1 * MiB, WS_WOUT = 23 * MiB, WS_WUP = 31 * MiB, WS_WDN = 75 * MiB;
constexpr size_t WS_PART = 97 * MiB;
constexpr size_t WS_XB = 98 * MiB + 4096;
constexpr size_t WS_P = 131 * MiB;
constexpr size_t WS_Y = 219 * MiB;
constexpr size_t WS_GU = 131 * MiB;
constexpr size_t WS_A = 219 * MiB;
constexpr size_t WS_END = 307 * MiB;
constexpr int LDS_BYTES = 147456;
#define LAS __attribute__((address_space(3)))
typedef unsigned short bf16;
typedef unsigned v4u __attribute__((ext_vector_type(4)));
typedef unsigned v2u __attribute__((ext_vector_type(2)));
typedef float f32x4 __attribute__((ext_vector_type(4)));
typedef float f32x16 __attribute__((ext_vector_type(16)));
typedef short bf16x8 __attribute__((ext_vector_type(8)));
#define LDS_WAIT() asm volatile("s_waitcnt lgkmcnt(0)" ::: "memory")
__device__ __forceinline__ unsigned pk2(float lo, float hi) { return pg8::cvt_pk_bf16(lo, hi); }
__device__ __forceinline__ float bflo(unsigned u) { return __uint_as_float(u << 16); }
__device__ __forceinline__ float bfhi(unsigned u) { return __uint_as_float(u & 0xffff0000u); }
__device__ __forceinline__ float bf1(bf16 v) { return __uint_as_float((unsigned)v << 16); }
__device__ __forceinline__ float wave_sum(float v) {
#pragma unroll
    for (int o = 1; o < 64; o <<= 1) v += __shfl_xor(v, o);
    return v;
}

__device__ __forceinline__ void cvt_item(const float* W, int K, int N, bf16* WT, const float* gain, int mode, LAS float* scr, int item, int lane) {
    const int nblk = N / 32, kb = item / nblk, nb = item % nblk, k0 = 64 * kb, n0 = 32 * nb;
    float wv[32];
#pragma unroll
    for (int i = 0; i < 32; ++i) { const int kk = 2 * i + (lane >> 5); wv[i] = W[(size_t)(k0 + kk) * N + n0 + (lane & 31)]; }
#pragma unroll
    for (int i = 0; i < 32; ++i) { const int kk = 2 * i + (lane >> 5); const float g = gain ? gain[k0 + kk] : 1.0f; scr[kk * 33 + (lane & 31)] = wv[i] * g; }
    LDS_WAIT(); asm volatile("" ::: "memory");
    const float cs = (mode == 1 && n0 >= 1280 && n0 < 1792) ? 0.125f * 1.4426950408889634f : 1.0f;
    int rb = n0;
    if (mode == 2) { rb = (n0 < DFF) ? 256 * (n0 / 128) + (n0 % 128) : 256 * ((n0 - DFF) / 128) + 128 + ((n0 - DFF) % 128); }
    const int c = lane & 7;
#pragma unroll
    for (int j = 0; j < 4; ++j) { const int n = (lane >> 3) + 8 * j; const LAS float* s = scr + (8 * c) * 33 + n;
        v4u o; o.x = pk2(s[0 * 33] * cs, s[1 * 33] * cs); o.y = pk2(s[2 * 33] * cs, s[3 * 33] * cs); o.z = pk2(s[4 * 33] * cs, s[5 * 33] * cs); o.w = pk2(s[6 * 33] * cs, s[7 * 33] * cs);
        *(v4u*)(WT + (size_t)(rb + n) * K + k0 + 8 * c) = o; }
    LDS_WAIT(); asm volatile("" ::: "memory");
}

typedef __attribute__((address_space(1))) unsigned gu32;
#define XB_TMO      128
#define XB_XCNT(j)  (256  + 64 * (j))
#define XB_XSUB(j)  (1280 + 64 * (j))
#define XB_XGEN(j)  (2304 + 64 * (j))
#define XB_TOP      3328
#define XB_TOPGEN   3392
#define XCD_BAR_WORDS 3456
#define XB_SPIN_CAP (1u << 18)

__device__ __forceinline__ unsigned xb_ld(unsigned* p)              { return __hip_atomic_load(p, __ATOMIC_RELAXED, __HIP_MEMORY_SCOPE_AGENT); }
__device__ __forceinline__ unsigned xb_add(unsigned* p, unsigned v) { return __hip_atomic_fetch_add(p, v, __ATOMIC_RELAXED, __HIP_MEMORY_SCOPE_AGENT); }
__device__ __forceinline__ unsigned xb_xcc_id() { return (unsigned)__builtin_amdgcn_s_getreg((3 << 11) | 20) & 0xFu; }
#define XB_SPIN(cond, bar) do { unsigned _sp = 0; while (cond) { __builtin_amdgcn_s_sleep(1); \
    if ((++_sp & 255u) == 0u) { if (xb_ld(&(bar)[XB_TMO])) break; if (_sp > XB_SPIN_CAP) { atomicAdd(&(bar)[XB_TMO], 1u); break; } } } } while (0)

struct XcdBarrier {
    unsigned* bar; unsigned x;
    volatile LAS unsigned* st;
};

__device__ __forceinline__ XcdBarrier xcd_barrier_post(unsigned* bar, volatile LAS unsigned* st) {
    XcdBarrier b; b.bar = bar; b.x = xb_xcc_id(); b.st = st;
    if (threadIdx.x == 0) (void)xb_add(&bar[XB_XCNT(b.x)], 1u);
    return b;
}
__device__ __forceinline__ void xcd_barrier_complete(unsigned* bar, unsigned x, unsigned& nloc, unsigned& nx) {
    const unsigned G = gridDim.x * gridDim.y * gridDim.z;
    unsigned sum, cnt, mine, sp = 0u;
    for (;;) {
        sum = 0u; cnt = 0u; mine = 0u;
#pragma unroll
        for (unsigned j = 0; j < 16; ++j) { const unsigned c = xb_ld(&bar[XB_XCNT(j)]); sum += c; cnt += (c > 0u) ? 1u : 0u; mine = (j == x) ? c : mine; }
        if (sum == G) break;
        __builtin_amdgcn_s_sleep(1);
        if ((++sp & 255u) == 0u) { if (xb_ld(&bar[XB_TMO])) break; if (sp > XB_SPIN_CAP) { atomicAdd(&bar[XB_TMO], 1u); break; } }
    }
    nloc = mine > 0u ? mine : 1u; nx = cnt > 0u ? cnt : 1u;
}

__device__ __forceinline__ void xcd_barrier(const XcdBarrier& b) {
    asm volatile("s_waitcnt vmcnt(0)" ::: "memory");
    __syncthreads();
    if (threadIdx.x == 0) {
        unsigned* bar = b.bar;
        __builtin_amdgcn_s_waitcnt(0);
        unsigned nloc = b.st[0], nx = b.st[1];
        if (nloc == 0u) { xcd_barrier_complete(bar, b.x, nloc, nx); b.st[0] = nloc; b.st[1] = nx; }
        const unsigned old = xb_add(&bar[XB_XSUB(b.x)], 1u);
        const unsigned gen = old / nloc;
        if (old + 1u == (gen + 1u) * nloc) {
            __builtin_amdgcn_fence(__ATOMIC_RELEASE, "agent");
            asm volatile("s_waitcnt vmcnt(0)" ::: "memory");
            const unsigned og = xb_add(&bar[XB_TOP], 1u);
            const unsigned tg = og / nx;
            if (og + 1u == (tg + 1u) * nx) xb_add(&bar[XB_TOPGEN], 1u);
            else XB_SPIN(xb_ld(&bar[XB_TOPGEN]) == tg, bar);
            __builtin_amdgcn_fence(__ATOMIC_ACQUIRE, "agent");
            xb_add(&bar[XB_XGEN(b.x)], 1u);
            asm volatile("s_waitcnt vmcnt(0)" ::: "memory");
        } else {
            XB_SPIN(xb_ld(&bar[XB_XGEN(b.x)]) == gen, bar);
            __builtin_amdgcn_fence(__ATOMIC_ACQUIRE, "agent");
            asm volatile("s_waitcnt vmcnt(0)" ::: "memory");
        }
    }
    __syncthreads();
}

struct Args { const float* in[14]; float* out; unsigned char* ws; };

__device__ __forceinline__ void norm_store_rows(const LAS float* tile, bf16* Y, int t0, int coff, int wave, int lane) {
#pragma unroll 2
    for (int i = 0; i < 8; ++i) { const int r = wave * 8 + i; const f32x4 v = *(const LAS f32x4*)(tile + r * 260 + lane * 4);
        const float ss = wave_sum((v[0] * v[0] + v[1] * v[1]) + (v[2] * v[2] + v[3] * v[3]));
        const float rs = __builtin_amdgcn_rsqf(ss * (1.0f / 256.0f) + EPS);
        v2u o; o.x = pk2(v[0] * rs, v[1] * rs); o.y = pk2(v[2] * rs, v[3] * rs);
        *(v2u*)(Y + (size_t)(t0 + r) * DM + coff + lane * 4) = o; }
}

__device__ __forceinline__ void mixer_unit(LAS unsigned char* lds, int unit, const bf16* P, bf16* Y, const float* conv_w, const float* sgu_norm, const float* sgu_w, const float* sgu_b, int tid, int wave, int lane) {
    const int t0 = unit * 64;
    asm volatile("" : "+v"(tid), "+v"(lane));
    LAS bf16* vnT = (LAS bf16*)lds;
    LAS float* tile = (LAS float*)(lds + 69632);
    LAS float* sm_ss = (LAS float*)(lds + 69632 + 66560);
    {
        const int hd = wave, r = lane & 31, h = lane >> 5;
        const int pr = (r & 0x13) | ((r & 4) << 1) | ((r & 8) >> 1);
        LAS bf16* Vt = (LAS bf16*)(lds + wave * 5120);
        bf16x8 atri[2];
#pragma unroll
        for (int sI = 0; sI < 2; ++sI) { v4u t;
            t.x = ((16 * sI + 8 * h + 0 > pr) ? 0x3F80u : 0u) | ((16 * sI + 8 * h + 1 > pr) ? 0x3F800000u : 0u); t.y = ((16 * sI + 8 * h + 2 > pr) ? 0x3F80u : 0u) | ((16 * sI + 8 * h + 3 > pr) ? 0x3F800000u : 0u);
            t.z = ((16 * sI + 8 * h + 4 > pr) ? 0x3F80u : 0u) | ((16 * sI + 8 * h + 5 > pr) ? 0x3F800000u : 0u); t.w = ((16 * sI + 8 * h + 6 > pr) ? 0x3F80u : 0u) | ((16 * sI + 8 * h + 7 > pr) ? 0x3F800000u : 0u);
            atri[sI] = __builtin_bit_cast(bf16x8, t); }
        f32x16 oacc[2][2]; float ssq[2];
#pragma unroll
        for (int qh = 0; qh < 2; ++qh) {
            const int tq = t0 + 32 * qh;
            bf16x8 qf[4];
#pragma unroll
            for (int ks = 0; ks < 4; ++ks) qf[ks] = *(const bf16x8*)(P + (size_t)(tq + r) * NIN + 1280 + hd * 64 + 16 * ks + 8 * h);
            f32x16 o0 = {}, o1 = {};
            float ls = 0.f;
            bf16x8 kfn[4]; v4u vvn[4];
            { const bf16* kp = P + (size_t)(tq + pr) * NIN + 1792 + hd * 64 + 8 * h;
#pragma unroll
              for (int ks = 0; ks < 4; ++ks) kfn[ks] = *(const bf16x8*)(kp + 16 * ks);
#pragma unroll
              for (int i = 0; i < 4; ++i) vvn[i] = *(const v4u*)(P + (size_t)(tq + (lane >> 3) + 8 * i) * NIN + 2304 + hd * 64 + 8 * (lane & 7)); }
            for (int k0 = tq;; k0 -= 32) {
                const bool diag = (k0 == tq);
                f32x16 z = {};
#pragma unroll
                for (int ks = 0; ks < 4; ++ks) z = __builtin_amdgcn_mfma_f32_32x32x16_bf16(kfn[ks], qf[ks], z, 0, 0, 0);
#pragma unroll
                for (int i = 0; i < 4; ++i) { const int key = (lane >> 3) + 8 * i, c = lane & 7; const v4u vv = vvn[i];
                    LAS bf16* vd = Vt + (8 * c) * 40 + key;
                    vd[0] = (bf16)(vv.x & 0xffffu); vd[40] = (bf16)(vv.x >> 16); vd[80] = (bf16)(vv.y & 0xffffu); vd[120] = (bf16)(vv.y >> 16);
                    vd[160] = (bf16)(vv.z & 0xffffu); vd[200] = (bf16)(vv.z >> 16); vd[240] = (bf16)(vv.w & 0xffffu); vd[280] = (bf16)(vv.w >> 16); }
                if (k0 >= 32) { const bf16* kp = P + (size_t)(k0 - 32 + pr) * NIN + 1792 + hd * 64 + 8 * h;
#pragma unroll
                    for (int ks = 0; ks < 4; ++ks) kfn[ks] = *(const bf16x8*)(kp + 16 * ks);
#pragma unroll
                    for (int i = 0; i < 4; ++i) vvn[i] = *(const v4u*)(P + (size_t)(k0 - 32 + (lane >> 3) + 8 * i) * NIN + 2304 + hd * 64 + 8 * (lane & 7)); }
                f32x16 cin; float Lv[16];
#pragma unroll
                for (int jj = 0; jj < 16; ++jj) { const float zz = z[jj]; const float ex = __builtin_amdgcn_exp2f(-fabsf(zz)); const float lsig = fminf(zz, 0.f) - __builtin_amdgcn_logf(1.0f + ex);
                    Lv[jj] = lsig - zz; cin[jj] = lsig + ls; }
                if (diag) {
#pragma unroll
                    for (int jj = 0; jj < 16; ++jj) { const int keyl = 16 * (jj >> 3) + 8 * h + (jj & 7); Lv[jj] = (keyl < r) ? Lv[jj] : 0.f; } }
                float rowsum = 0.f; unsigned lh[8], ll[8];
#pragma unroll
                for (int j = 0; j < 16; j += 2) { rowsum += Lv[j] + Lv[j + 1];
                    const unsigned hp = pk2(Lv[j], Lv[j + 1]); lh[j >> 1] = hp; ll[j >> 1] = pk2(Lv[j] - bflo(hp), Lv[j + 1] - bfhi(hp)); }
                bf16x8 bh0 = __builtin_bit_cast(bf16x8, (v4u){lh[0], lh[1], lh[2], lh[3]}), bh1 = __builtin_bit_cast(bf16x8, (v4u){lh[4], lh[5], lh[6], lh[7]});
                bf16x8 bl0 = __builtin_bit_cast(bf16x8, (v4u){ll[0], ll[1], ll[2], ll[3]}), bl1 = __builtin_bit_cast(bf16x8, (v4u){ll[4], ll[5], ll[6], ll[7]});
                f32x16 lw = __builtin_amdgcn_mfma_f32_32x32x16_bf16(atri[0], bh0, cin, 0, 0, 0);
                lw = __builtin_amdgcn_mfma_f32_32x32x16_bf16(atri[1], bh1, lw, 0, 0, 0);
                lw = __builtin_amdgcn_mfma_f32_32x32x16_bf16(atri[0], bl0, lw, 0, 0, 0);
                lw = __builtin_amdgcn_mfma_f32_32x32x16_bf16(atri[1], bl1, lw, 0, 0, 0);
                float wv[16];
#pragma unroll
                for (int jj = 0; jj < 16; ++jj) wv[jj] = __builtin_amdgcn_exp2f(lw[jj]);
                if (diag) {
#pragma unroll
                    for (int jj = 0; jj < 16; ++jj) { const int keyl = 16 * (jj >> 3) + 8 * h + (jj & 7); wv[jj] = (keyl < r) ? wv[jj] : 0.f; } }
                unsigned wp[8];
#pragma unroll
                for (int j = 0; j < 16; j += 2) wp[j >> 1] = pk2(wv[j], wv[j + 1]);
                const bf16x8 w0 = __builtin_bit_cast(bf16x8, (v4u){wp[0], wp[1], wp[2], wp[3]}), w1 = __builtin_bit_cast(bf16x8, (v4u){wp[4], wp[5], wp[6], wp[7]});
                const LAS bf16* vr = Vt + r * 40 + 8 * h;
                o0 = __builtin_amdgcn_mfma_f32_32x32x16_bf16(*(const LAS bf16x8*)(vr), w0, o0, 0, 0, 0);
                o0 = __builtin_amdgcn_mfma_f32_32x32x16_bf16(*(const LAS bf16x8*)(vr + 16), w1, o0, 0, 0, 0);
                o1 = __builtin_amdgcn_mfma_f32_32x32x16_bf16(*(const LAS bf16x8*)(vr + 32 * 40), w0, o1, 0, 0, 0);
                o1 = __builtin_amdgcn_mfma_f32_32x32x16_bf16(*(const LAS bf16x8*)(vr + 32 * 40 + 16), w1, o1, 0, 0, 0);
                ls += rowsum + __shfl_xor(rowsum, 32);
                if (k0 < 32 || __builtin_amdgcn_ballot_w64(ls > -150.1f) == 0ull) break;
            }
            float ss = 0.f;
#pragma unroll
            for (int j = 0; j < 16; ++j) ss += o0[j] * o0[j] + o1[j] * o1[j];
            ss += __shfl_xor(ss, 32);
            if (h == 0) sm_ss[(32 * qh + r) * 8 + hd] = ss;
            oacc[qh][0] = o0; oacc[qh][1] = o1; ssq[qh] = ss;
        }
        LDS_WAIT(); __syncthreads();
#pragma unroll
        for (int qh = 0; qh < 2; ++qh) {
            const f32x4 sa = *(const LAS f32x4*)(sm_ss + (32 * qh + r) * 8), sb = *(const LAS f32x4*)(sm_ss + (32 * qh + r) * 8 + 4);
            const float tot = ((sa[0] + sa[1]) + (sa[2] + sa[3])) + ((sb[0] + sb[1]) + (sb[2] + sb[3]));
            const float rs = __builtin_amdgcn_rsqf(tot * (1.0f / 512.0f) + EPS);
            bf16* yp = Y + (size_t)(t0 + 32 * qh + r) * DM + 512 + hd * 64 + 4 * h;
#pragma unroll
            for (int db = 0; db < 2; ++db)
#pragma unroll
                for (int g4 = 0; g4 < 4; ++g4) { const f32x16& o = oacc[qh][db]; v2u w; w.x = pk2(o[4 * g4 + 0] * rs, o[4 * g4 + 1] * rs); w.y = pk2(o[4 * g4 + 2] * rs, o[4 * g4 + 3] * rs);
                    *(v2u*)(yp + 32 * db + 8 * g4) = w; }
        }
    }
    {
        const int c = tid & 255, rh = tid >> 8, tb = t0 + 32 * rh;
        const float w0 = conv_w[c], w1 = conv_w[256 + c], w2 = conv_w[512 + c];
        float p2 = 0.f, p1 = 0.f;
        if (tb >= 2) { const bf16* r2 = P + (size_t)(tb - 2) * NIN; const bf16* r1 = P + (size_t)(tb - 1) * NIN; p2 = bf1(r2[256 + c]) * bf1(r2[512 + c]); p1 = bf1(r1[256 + c]) * bf1(r1[512 + c]); }
#pragma unroll 16
        for (int r = 0; r < 32; ++r) { const bf16* rp = P + (size_t)(tb + r) * NIN; const float p0 = bf1(rp[256 + c]) * bf1(rp[512 + c]);
            tile[(32 * rh + r) * 260 + c] = bf1(rp[c]) * (w0 * p2 + w1 * p1 + w2 * p0); p2 = p1; p1 = p0; }
    }
    LDS_WAIT(); __syncthreads();
    norm_store_rows(tile, Y, t0, 0, wave, lane);
    const int tc = t0 & ~127, dt = t0 - tc, ns = dt + 64;
    { v2u uu[16];
#pragma unroll
      for (int i = 0; i < 16; ++i) { const int s = wave + 8 * i; uu[i] = (s < ns) ? *(const v2u*)(P + (size_t)(tc + s) * NIN + 1024 + lane * 4) : (v2u){0u, 0u}; }
      const f32x4 g = *(const f32x4*)(sgu_norm + lane * 4);
#pragma unroll
      for (int i = 0; i < 16; ++i) { const int s = wave + 8 * i;
        if (s < ns) { const v2u u = uu[i];
        const float v0 = bflo(u.x), v1 = bfhi(u.x), v2 = bflo(u.y), v3 = bfhi(u.y);
        const float ss = wave_sum((v0 * v0 + v1 * v1) + (v2 * v2 + v3 * v3)); const float rs = __builtin_amdgcn_rsqf(ss * (1.0f / 256.0f) + EPS);
        const unsigned a = pk2(v0 * rs * g[0], v1 * rs * g[1]), b = pk2(v2 * rs * g[2], v3 * rs * g[3]);
        vnT[(lane * 4 + 0) * 136 + s] = (bf16)(a & 0xffffu); vnT[(lane * 4 + 1) * 136 + s] = (bf16)(a >> 16); vnT[(lane * 4 + 2) * 136 + s] = (bf16)(b & 0xffffu); vnT[(lane * 4 + 3) * 136 + s] = (bf16)(b >> 16); } } }
    LDS_WAIT(); __syncthreads();
    {
        const int h = wave >> 1, rh = wave & 1, r32 = lane & 31, hi = lane >> 5;
        const int tcl = dt + 32 * rh + r32;
        const float* wrow = sgu_w + ((size_t)h * 128 + tcl) * 128;
        f32x16 o0 = {}, o1 = {};
        const int nk = (dt + 32 * rh + 32) >> 4;
        f32x4 wa[8], wb[8];
#pragma unroll
        for (int ks = 0; ks < 8; ++ks) { const int s0 = ks * 16 + 8 * hi; if (ks < nk) { wa[ks] = *(const f32x4*)(wrow + s0); wb[ks] = *(const f32x4*)(wrow + s0 + 4); } else { wa[ks] = (f32x4){0.f, 0.f, 0.f, 0.f}; wb[ks] = wa[ks]; } }
#pragma unroll
        for (int ks = 0; ks < 8; ++ks) if (ks < nk) { const int s0 = ks * 16 + 8 * hi;
            float wv[8] = {wa[ks][0], wa[ks][1], wa[ks][2], wa[ks][3], wb[ks][0], wb[ks][1], wb[ks][2], wb[ks][3]};
#pragma unroll
            for (int i = 0; i < 8; ++i) wv[i] = (s0 + i <= tcl) ? wv[i] : 0.f;
            v4u ap; ap.x = pk2(wv[0], wv[1]); ap.y = pk2(wv[2], wv[3]); ap.z = pk2(wv[4], wv[5]); ap.w = pk2(wv[6], wv[7]);
            const bf16x8 af = __builtin_bit_cast(bf16x8, ap);
            const bf16x8 b0 = *(const LAS bf16x8*)(vnT + (h * 64 + r32) * 136 + s0), b1 = *(const LAS bf16x8*)(vnT + (h * 64 + 32 + r32) * 136 + s0);
            o0 = __builtin_amdgcn_mfma_f32_32x32x16_bf16(af, b0, o0, 0, 0, 0);
            o1 = __builtin_amdgcn_mfma_f32_32x32x16_bf16(af, b1, o1, 0, 0, 0); }
#pragma unroll
        for (int j = 0; j < 16; ++j) { const int rl = 32 * rh + (j & 3) + 8 * (j >> 2) + 4 * hi;
            const float bb = sgu_b[h * 128 + dt + rl]; const bf16* up = P + (size_t)(t0 + rl) * NIN + 768 + h * 64;
            tile[rl * 260 + h * 64 + r32] = bf1(up[r32]) * (o0[j] + bb);
            tile[rl * 260 + h * 64 + 32 + r32] = bf1(up[32 + r32]) * (o1[j] + bb); }
    }
    LDS_WAIT(); __syncthreads();
    norm_store_rows(tile, Y, t0, 256, wave, lane);
    LDS_WAIT(); __syncthreads();
}

__device__ __forceinline__ void ffn_gate_phase(const bf16* GU, bf16* A, const float* fconv, int hf, int gtid, int gthreads) {
    for (int it = gtid; it < 256 * 176; it += gthreads) { const int rb = it / 176, cgp = it % 176, pnl = cgp >> 4, cc = (cgp & 15) * 8, ch = 1408 * hf + 128 * pnl + cc;
        float wg[3][8], wu[3][8];
#pragma unroll
        for (int i = 0; i < 3; ++i) { const f32x4 a0 = *(const f32x4*)(fconv + (size_t)i * NUP + ch), a1 = *(const f32x4*)(fconv + (size_t)i * NUP + ch + 4), b0 = *(const f32x4*)(fconv + (size_t)i * NUP + DFF + ch), b1 = *(const f32x4*)(fconv + (size_t)i * NUP + DFF + ch + 4);
#pragma unroll
            for (int e = 0; e < 4; ++e) { wg[i][e] = a0[e]; wg[i][4 + e] = a1[e]; wu[i][e] = b0[e]; wu[i][4 + e] = b1[e]; } }
        float g2[8], g1[8], u2[8], u1[8];
#pragma unroll
        for (int e = 0; e < 8; ++e) { g2[e] = g1[e] = u2[e] = u1[e] = 0.f; }
        for (int r = -2; r < 64; ++r) { const int t = 64 * rb + r; float g0[8], u0[8];
            if (t >= 0) { const v4u gv = *(const v4u*)(GU + (size_t)t * NIN + 256 * pnl + cc), uv = *(const v4u*)(GU + (size_t)t * NIN + 256 * pnl + 128 + cc);
                g0[0] = bflo(gv.x); g0[1] = bfhi(gv.x); g0[2] = bflo(gv.y); g0[3] = bfhi(gv.y); g0[4] = bflo(gv.z); g0[5] = bfhi(gv.z); g0[6] = bflo(gv.w); g0[7] = bfhi(gv.w);
                u0[0] = bflo(uv.x); u0[1] = bfhi(uv.x); u0[2] = bflo(uv.y); u0[3] = bfhi(uv.y); u0[4] = bflo(uv.z); u0[5] = bfhi(uv.z); u0[6] = bflo(uv.w); u0[7] = bfhi(uv.w); }
            else {
#pragma unroll
                for (int e = 0; e < 8; ++e) { g0[e] = 0.f; u0[e] = 0.f; } }
            if (r >= 0) { float o[8];
#pragma unroll
                for (int e = 0; e < 8; ++e) { const float G = wg[0][e] * g2[e] + wg[1][e] * g1[e] + wg[2][e] * g0[e], U = wu[0][e] * u2[e] + wu[1][e] * u1[e] + wu[2][e] * u0[e];
                    o[e] = G * __builtin_amdgcn_rcpf(1.0f + __expf(-G)) * U; }
                v4u ov; ov.x = pk2(o[0], o[1]); ov.y = pk2(o[2], o[3]); ov.z = pk2(o[4], o[5]); ov.w = pk2(o[6], o[7]);
                *(v4u*)(A + (size_t)t * DFF + ch) = ov; }
#pragma unroll
            for (int e = 0; e < 8; ++e) { g2[e] = g1[e]; g1[e] = g0[e]; u2[e] = u1[e]; u1[e] = u0[e]; } }
    }
}
__global__ void __launch_bounds__(NTHR, 2) hybrid_fwd(Args args) {
    extern __shared__ __attribute__((aligned(16))) unsigned char lds_raw[];
    LAS unsigned char* lds = (LAS unsigned char*)lds_raw;
    cg::grid_group grid = cg::this_grid();
    volatile LAS unsigned* MISC = (volatile LAS unsigned*)(lds + LDS_BYTES - 64);
    if (threadIdx.x < 16) MISC[threadIdx.x] = 0u;
    __syncthreads();
    XcdBarrier xbar = xcd_barrier_post((unsigned*)args.ws, MISC);
    const int tid = threadIdx.x, lane = tid & 63, wave = __builtin_amdgcn_readfirstlane(tid >> 6);
    const int G = gridDim.x, bx = blockIdx.x;
    const int gw = bx * NWAVES + wave, NGW = G * NWAVES;
    unsigned char* ws = args.ws;
    const float* x_in = args.in[0]; const float* norm_mix = args.in[1]; const float* w_in = args.in[2]; const float* conv_w = args.in[3];
    const float* sgu_norm = args.in[4]; const float* sgu_w = args.in[5]; const float* sgu_b = args.in[6]; const float* out_norm = args.in[7];
    const float* w_out = args.in[8]; const float* norm_ffn = args.in[9]; const float* w_up = args.in[10]; const float* ffn_conv = args.in[11];
    const float* w_down = args.in[12]; const float* norm_final = args.in[13];
    float* xcur = args.out;
    bf16* Win_t = (bf16*)(ws + WS_WIN); bf16* Wout_t = (bf16*)(ws + WS_WOUT); bf16* Wup_t = (bf16*)(ws + WS_WUP); bf16* Wdn_t = (bf16*)(ws + WS_WDN);
    float* part = (float*)(ws + WS_PART); bf16* XB = (bf16*)(ws + WS_XB); bf16* P = (bf16*)(ws + WS_P); bf16* Y = (bf16*)(ws + WS_Y);
    bf16* GU = (bf16*)(ws + WS_GU); bf16* A = (bf16*)(ws + WS_A);

    {
        LAS float* scr = (LAS float*)(lds + wave * 16384);
        constexpr int I_IN = 16 * 88, I_OUT = 16 * 32, I_UP = 16 * 176, I_DN = 44 * 32, I_L = I_IN + I_OUT + I_UP + I_DN;
        for (int it = gw; it < DEPTH * I_L; it += NGW) { const int l = it / I_L; int r = it % I_L;
            if (r < I_IN) { cvt_item(w_in + (size_t)l * DM * NIN, DM, NIN, Win_t + (size_t)l * NIN * DM, norm_mix + l * DM, 1, scr, r, lane); continue; } r -= I_IN;
            if (r < I_OUT) { cvt_item(w_out + (size_t)l * DM * DM, DM, DM, Wout_t + (size_t)l * DM * DM, out_norm + l * DM, 0, scr, r, lane); continue; } r -= I_OUT;
            if (r < I_UP) { cvt_item(w_up + (size_t)l * DM * NUP, DM, NUP, Wup_t + (size_t)l * NUP * DM, norm_ffn + l * DM, 2, scr, r, lane); continue; } r -= I_UP;
            cvt_item(w_down + (size_t)l * DFF * DM, DFF, DM, Wdn_t + (size_t)l * DM * DFF, nullptr, 0, scr, r, lane); }
        for (int m = gw; m < S; m += NGW) { const f32x4* xr = (const f32x4*)(x_in + (size_t)m * DM) + lane; f32x4 v[4]; float ss = 0.f;
#pragma unroll
            for (int j = 0; j < 4; ++j) { v[j] = xr[64 * j]; ss += (v[j][0] * v[j][0] + v[j][1] * v[j][1]) + (v[j][2] * v[j][2] + v[j][3] * v[j][3]); }
            ss = wave_sum(ss);
            v2u* o8 = (v2u*)(XB + (size_t)m * DM) + lane;
#pragma unroll
            for (int j = 0; j < 4; ++j) { v2u o; o.x = pk2(v[j][0], v[j][1]); o.y = pk2(v[j][2], v[j][3]); o8[64 * j] = o; }
            if (lane < 16) part[(size_t)m * 16 + lane] = lane == 0 ? ss : 0.f; }
    }
    grid.sync();

    for (int l = 0; l < DEPTH; ++l) {
        { pg8::Gemm g{XB, Win_t + (size_t)l * NIN * DM, S, NIN, DM, 256}; pg8::StaticOrder So; So.init(S, NIN, G, bx);
          pg8::EpiScaleBf16 E{P, NIN, part, (LAS float*)(lds + 131072 + 8192)};
          pg8::gemm_phase<pg8::EpiScaleBf16, pg8::StaticOrder, true, true>(lds, g, So, E); }
        xcd_barrier(xbar);
        for (int u = bx; u < S / 64; u += G)
            mixer_unit(lds, u, P, Y, conv_w + l * 3 * 256, sgu_norm + l * 256, sgu_w + (size_t)l * 4 * 128 * 128, sgu_b + l * 4 * 128, tid, wave, lane);
        xcd_barrier(xbar);
        { pg8::Gemm g{Y, Wout_t + (size_t)l * DM * DM, S, DM, DM, 256}; pg8::StaticOrder So; So.init(S, DM, G, bx);
          pg8::EpiResid E{l == 0 ? x_in : xcur, xcur, XB, part};
          pg8::gemm_phase<pg8::EpiResid, pg8::StaticOrder, true, true>(lds, g, So, E); }
        xcd_barrier(xbar);
        { pg8::Gemm g{XB - 2 * DM, Wup_t + (size_t)l * NUP * DM, 65 * 256, NUP, DM, 254}; pg8::StaticOrder So; So.init(65 * 256, NUP, G, bx);
          pg8::EpiGate E{A, part, ffn_conv + (size_t)l * 3 * NUP, (LAS float*)(lds + 131072)};
          pg8::gemm_phase<pg8::EpiGate, pg8::StaticOrder, true, true>(lds, g, So, E); }
        xcd_barrier(xbar);
        { pg8::Gemm g{A, Wdn_t + (size_t)l * DM * DFF, S, DM, DFF, 256}; pg8::StaticOrder So; So.init(S, DM, G, bx);
          pg8::EpiResid E{xcur, xcur, XB, part};
          pg8::gemm_phase<pg8::EpiResid, pg8::StaticOrder, true, true>(lds, g, So, E); }
        xcd_barrier(xbar);
    }
    for (int m = gw; m < S; m += NGW) { f32x4* xr = (f32x4*)(xcur + (size_t)m * DM) + lane; f32x4 v[4]; float ss = 0.f;
#pragma unroll
        for (int j = 0; j < 4; ++j) { v[j] = xr[64 * j]; ss += (v[j][0] * v[j][0] + v[j][1] * v[j][1]) + (v[j][2] * v[j][2] + v[j][3] * v[j][3]); }
        const float rs = __builtin_amdgcn_rsqf(wave_sum(ss) * (1.0f / 1024.0f) + EPS);
#pragma unroll
        for (int j = 0; j < 4; ++j) { const f32x4 g = *((const f32x4*)norm_final + lane + 64 * j); xr[64 * j] = v[j] * rs * g; } }
}

extern "C" void kernel_launch(void* const* d_in, const int* in_sizes, int n_in, void* d_out, int out_size, void* d_ws, size_t ws_size, hipStream_t stream) {
    static int grid = 0;
    if (grid == 0) {
        if (n_in != 14 || out_size != S * DM || ws_size < WS_END) { fprintf(stderr, "kernel_launch: unexpected shapes / workspace (%d inputs, out %d, ws %zu)\n", n_in, out_size, ws_size); grid = -1; return; }
        int dev = 0, cus = 0, per_cu = 0;
        hipGetDevice(&dev); hipDeviceGetAttribute(&cus, hipDeviceAttributeMultiprocessorCount, dev);
        hipFuncSetAttribute((const void*)hybrid_fwd, hipFuncAttributeMaxDynamicSharedMemorySize, LDS_BYTES);
        hipOccupancyMaxActiveBlocksPerMultiprocessor(&per_cu, (const void*)hybrid_fwd, NTHR, LDS_BYTES);
        (void)hipGetLastError();
        if (per_cu < 1) per_cu = 1;
        grid = cus * 1;
    }
    if (grid < 0) return;
    hipMemsetAsync((unsigned char*)d_ws, 0, 16384, stream);
    hipMemsetAsync((unsigned char*)d_ws + WS_XB - 4096, 0, 4096, stream);
    Args a{};
    for (int i = 0; i < 14; ++i) a.in[i] = (const float*)d_in[i];
    a.out = (float*)d_out; a.ws = (unsigned char*)d_ws;
    void* kargs[] = {&a};
    hipError_t e = hipLaunchCooperativeKernel((const void*)hybrid_fwd, dim3(grid), dim3(NTHR), kargs, LDS_BYTES, stream);
    if (e != hipSuccess) fprintf(stderr, "cooperative launch failed: %s (grid %d)\n", hipGetErrorString(e), grid);
}
```

```cpp
#include <hip/hip_runtime.h>
#include <hip/hip_cooperative_groups.h>
#include <cstdio>
#include <cstdint>
namespace cg = cooperative_groups;
namespace pg8 {
#define PG8_LAS __attribute__((address_space(3)))
typedef unsigned short bf16_t;
typedef short bf16x8 __attribute__((ext_vector_type(8)));
typedef float f32x4 __attribute__((ext_vector_type(4)));
typedef unsigned u32x4 __attribute__((ext_vector_type(4)));
typedef unsigned u32x2 __attribute__((ext_vector_type(2)));
constexpr int BM = 256, BK = 64, HALF = 128, HTB = HALF * BK * 2  , STAGE_BYTES = 8 * HTB, NXCD = 8, WGM = 8;

__host__ __device__ __forceinline__ int lds_byte(int r, int c) { const int st = (r >> 4) * 2 + (c >> 5), rr = r & 15, cc = c & 31, ob = rr * 64 + cc * 2; return st * 1024 + (ob ^ (((ob >> 9) & 1) << 5)); }
__host__ __device__ __forceinline__ void stage_rc(int b, int& R, int& C) { const int st = b / 1024, sb = b % 1024, swz = sb ^ (((sb >> 9) & 1) << 5); R = (st >> 1) * 16 + swz / 64; C = (st & 1) * 32 + (swz % 64) / 2; }
__host__ __device__ __forceinline__ int perm32(int rho) { const int n = rho >> 4, i = rho & 15; return 8 * (i >> 2) + 4 * n + (i & 3); }

struct Unit { int pm, pn; };
struct Gemm { const bf16_t* A; const bf16_t* Bt; int M, N, K; int arows; };

struct StaticOrder {
    int nM, nN, nwg, G, c;
    __host__ __device__ void init(int M, int N, int G_, int c_) { nM = M / BM; nN = N / BM; nwg = nM * nN; G = G_; c = c_; }
    __host__ __device__ bool next(int i, Unit& u) const {
        const long L = (long)i * G + c; if (L >= nwg) return false;
        int wgid = (int)L; { const int q = nwg / NXCD, r = nwg % NXCD, xcd = wgid % NXCD, off = wgid / NXCD; wgid = (xcd < r ? xcd * (q + 1) : r * (q + 1) + (xcd - r) * q) + off; }
        const int nig = WGM * nN, gid = wgid / nig, fm = gid * WGM, gsz = (nM - fm) < WGM ? (nM - fm) : WGM;
        u.pm = fm + ((wgid % nig) % gsz); u.pn = (wgid % nig) / gsz; return true;
    }
    __device__ __forceinline__ void a_ready(const Unit&) const {}
    __device__ __forceinline__ void done(const Unit&) const {}
};

__device__ __forceinline__ unsigned cvt_pk_bf16(float lo, float hi) { unsigned r; asm volatile("v_cvt_pk_bf16_f32 %0, %1, %2" : "=v"(r) : "v"(lo), "v"(hi)); return r; }
struct EpiScaleBf16 {
    static constexpr bool PERM = true, AFTER_DRAIN = false;
    bf16_t* O; int ldc; const float* part; PG8_LAS float* rsl;
    __device__ __forceinline__ void operator()(const f32x4 (&acc)[2][2][4][2], const Unit& u, int wr, int wc, int fr, int fq) const {
        { const int t = (wr * 4 + wc) * 64 + fq * 16 + fr;
          if (t < 256) { const f32x4* pp = (const f32x4*)(part + (size_t)(u.pm * BM + t) * 16); const f32x4 a = pp[0], b = pp[1], c = pp[2], d = pp[3];
              const f32x4 s4 = (a + b) + (c + d); const float ss = (s4[0] + s4[1]) + (s4[2] + s4[3]); rsl[t] = __builtin_amdgcn_rsqf(ss * (1.0f / 1024.0f) + 1e-6f); } }
        asm volatile("s_waitcnt lgkmcnt(0)" ::: "memory"); __builtin_amdgcn_s_barrier(); asm volatile("" ::: "memory");
        const int row0 = u.pm * BM + wr * 64 + fr; const int col0 = u.pn * BM + wc * 32 + 8 * fq;
#pragma unroll
        for (int ai = 0; ai < 2; ++ai)
#pragma unroll
            for (int m = 0; m < 4; ++m) { const int row = row0 + ai * HALF + m * 16;
                const float rs = rsl[ai * HALF + wr * 64 + m * 16 + fr];
                bf16_t* rowp = O + (size_t)row * ldc + col0;
#pragma unroll
                for (int bj = 0; bj < 2; ++bj) { const f32x4 v0 = acc[ai][bj][m][0] * rs, v1 = acc[ai][bj][m][1] * rs;
                    u32x4 w; w.x = cvt_pk_bf16(v0[0], v0[1]); w.y = cvt_pk_bf16(v0[2], v0[3]); w.z = cvt_pk_bf16(v1[0], v1[1]); w.w = cvt_pk_bf16(v1[2], v1[3]);
                    *(u32x4*)(rowp + bj * HALF) = w; } }
    }
};
struct EpiResid {
    static constexpr bool PERM = true, AFTER_DRAIN = false;
    const float* base; float* out; bf16_t* xb; float* part;
    __device__ __forceinline__ void operator()(const f32x4 (&acc)[2][2][4][2], const Unit& u, int wr, int wc, int fr, int fq) const {
        const int row0 = u.pm * BM + wr * 64 + fr; const int col0 = u.pn * BM + wc * 32 + 8 * fq;
        f32x4 pre[3][4];
#define PG8_RLOAD(g_) do { const size_t o_ = (size_t)(row0 + ((g_) >> 2) * HALF + ((g_) & 3) * 16) * 1024 + col0; \
            pre[(g_) % 3][0] = *(const f32x4*)(base + o_); pre[(g_) % 3][1] = *(const f32x4*)(base + o_ + 4); pre[(g_) % 3][2] = *(const f32x4*)(base + o_ + HALF); pre[(g_) % 3][3] = *(const f32x4*)(base + o_ + HALF + 4); } while (0)
        PG8_RLOAD(0); PG8_RLOAD(1);
#pragma unroll
        for (int g = 0; g < 8; ++g) { const int ai = g >> 2, m = g & 3;
            if (g + 2 < 8) PG8_RLOAD(g + 2);
            asm volatile("" ::: "memory");
            const int row = row0 + ai * HALF + m * 16; const size_t off = (size_t)row * 1024 + col0; float ss = 0.f;
#pragma unroll
            for (int bj = 0; bj < 2; ++bj) { const f32x4 v0 = acc[ai][bj][m][0] + pre[g % 3][2 * bj], v1 = acc[ai][bj][m][1] + pre[g % 3][2 * bj + 1];
                *(f32x4*)(out + off + bj * HALF) = v0; *(f32x4*)(out + off + bj * HALF + 4) = v1;
                ss += (v0[0] * v0[0] + v0[1] * v0[1]) + (v0[2] * v0[2] + v0[3] * v0[3]) + (v1[0] * v1[0] + v1[1] * v1[1]) + (v1[2] * v1[2] + v1[3] * v1[3]);
                u32x4 w; w.x = cvt_pk_bf16(v0[0], v0[1]); w.y = cvt_pk_bf16(v0[2], v0[3]); w.z = cvt_pk_bf16(v1[0], v1[1]); w.w = cvt_pk_bf16(v1[2], v1[3]);
                *(u32x4*)(xb + off + bj * HALF) = w; }
            ss += __shfl_xor(ss, 16); ss += __shfl_xor(ss, 32);
            if (fq == 0) part[(size_t)row * 16 + u.pn * 4 + wc] = ss;
            asm volatile("" ::: "memory"); }
#undef PG8_RLOAD
    }
};
#define PG8_DPP(oldv, srcv, ctrl) __builtin_bit_cast(float, __builtin_amdgcn_update_dpp(__builtin_bit_cast(int, (float)(oldv)), __builtin_bit_cast(int, (float)(srcv)), (ctrl), 0xf, 0xf, false))
struct EpiGate {
    static constexpr bool PERM = true, AFTER_DRAIN = false;
    bf16_t* Aout; const float* part; const float* fconv; PG8_LAS float* xch;
    __device__ __forceinline__ void operator()(f32x4 (&acc)[2][2][4][2], const Unit& u, int wr, int wc, int fr, int fq) const {
        PG8_LAS float* rsl = xch + 2048;
        { const int t = (wr * 4 + wc) * 64 + fq * 16 + fr;
          if (t < 256) { const int row = u.pm * 254 - 2 + t; const bool ok = row >= 0 && row < 16384; const int rc = ok ? row : 0;
              const f32x4* pp = (const f32x4*)(part + (size_t)rc * 16); const f32x4 a = pp[0], b = pp[1], c = pp[2], d = pp[3];
              const f32x4 s4 = (a + b) + (c + d); const float ss = (s4[0] + s4[1]) + (s4[2] + s4[3]);
              rsl[t] = ok ? __builtin_amdgcn_rsqf(ss * (1.0f / 1024.0f) + 1e-6f) : 0.f; } }
        asm volatile("s_waitcnt lgkmcnt(0)" ::: "memory"); __builtin_amdgcn_s_barrier(); asm volatile("" ::: "memory");
        const int ccol = wc * 32 + 8 * fq;
#pragma unroll
        for (int ai = 0; ai < 2; ++ai)
#pragma unroll
            for (int m = 0; m < 4; ++m) { const float rs = rsl[ai * HALF + wr * 64 + m * 16 + fr];
#pragma unroll
                for (int bj = 0; bj < 2; ++bj) { acc[ai][bj][m][0] *= rs; acc[ai][bj][m][1] *= rs; } }
        if (fr >= 14) {
#pragma unroll
            for (int ai = 0; ai < 2; ++ai)
#pragma unroll
                for (int bj = 0; bj < 2; ++bj)
#pragma unroll
                    for (int n = 0; n < 2; ++n) *(PG8_LAS f32x4*)(xch + ((2 * ai + wr) * 2 + (fr & 1)) * 256 + bj * HALF + ccol + 4 * n) = acc[ai][bj][3][n];
        }
        asm volatile("s_waitcnt lgkmcnt(0)" ::: "memory"); __builtin_amdgcn_s_barrier(); asm volatile("" ::: "memory");
        const int ch0 = u.pn * HALF + ccol;
#pragma unroll
        for (int ai = 0; ai < 2; ++ai) {
            const int grp = 2 * ai + wr;
#pragma unroll
            for (int n = 0; n < 2; ++n) {
                asm volatile("" ::: "memory");
                const float* fw = fconv + ch0 + 4 * n;
                const f32x4 wg0 = *(const f32x4*)(fw), wg1 = *(const f32x4*)(fw + 5632), wg2 = *(const f32x4*)(fw + 2 * 5632);
                const f32x4 wu0 = *(const f32x4*)(fw + 2816), wu1 = *(const f32x4*)(fw + 5632 + 2816), wu2 = *(const f32x4*)(fw + 2 * 5632 + 2816);
                f32x4 xpg = {0.f, 0.f, 0.f, 0.f}, xpu = {0.f, 0.f, 0.f, 0.f};
                if (grp > 0) { xpg = *(const PG8_LAS f32x4*)(xch + ((grp - 1) * 2 + (fr & 1)) * 256 + ccol + 4 * n); xpu = *(const PG8_LAS f32x4*)(xch + ((grp - 1) * 2 + (fr & 1)) * 256 + HALF + ccol + 4 * n); }
#pragma unroll
                for (int m = 0; m < 4; ++m) {
                    float o[4];
#pragma unroll
                    for (int j = 0; j < 4; ++j) {
                        const float xg = acc[ai][0][m][n][j], xu = acc[ai][1][m][n][j];
                        const float pg = m > 0 ? acc[ai][0][m > 0 ? m - 1 : 0][n][j] : xpg[j], pu = m > 0 ? acc[ai][1][m > 0 ? m - 1 : 0][n][j] : xpu[j];
                        const float g1 = PG8_DPP(PG8_DPP(0.f, pg, 0x121), xg, 0x111), g2 = PG8_DPP(PG8_DPP(0.f, pg, 0x122), xg, 0x112);
                        const float u1 = PG8_DPP(PG8_DPP(0.f, pu, 0x121), xu, 0x111), u2 = PG8_DPP(PG8_DPP(0.f, pu, 0x122), xu, 0x112);
                        const float Gv = wg0[j] * g2 + wg1[j] * g1 + wg2[j] * xg, Uv = wu0[j] * u2 + wu1[j] * u1 + wu2[j] * xu;
                        o[j] = Gv * __builtin_amdgcn_rcpf(1.0f + __expf(-Gv)) * Uv; }
                    const int r = ai * HALF + wr * 64 + m * 16 + fr, row = u.pm * 254 - 2 + r;
                    u32x2 w; w.x = cvt_pk_bf16(o[0], o[1]); w.y = cvt_pk_bf16(o[2], o[3]);
                    if (r >= 2 && row < 16384) *(u32x2*)(Aout + (size_t)row * 2816 + ch0 + 4 * n) = w; }
            }
        }
    }
};
template <class Epi, class Sched, bool ALIGN_EPI = false, bool SP2 = false>
__device__ __forceinline__ void gemm_phase(PG8_LAS unsigned char* lds, const Gemm g, const Sched& S, const Epi& E) {
    int tid = threadIdx.x; asm volatile("" : "+v"(tid));
    const int wid = __builtin_amdgcn_readfirstlane(tid >> 6), lane = tid & 63, wr = wid >> 2, wc = wid & 3, fr = lane & 15, fq = lane >> 4;
    const int K = g.K, nt = K / BK;
    unsigned voffA[2], voffB[2];
#pragma unroll
    for (int i = 0; i < 2; ++i) { int R, C; stage_rc(tid * 16 + i * 8192, R, C); const int Rb = Epi::PERM ? ((R & ~31) + perm32(R & 31)) : R;
        voffA[i] = (unsigned)(R * K + C) * 2u; voffB[i] = (unsigned)(Rb * K + C) * 2u; }
    const size_t kstep = (size_t)(BK * 2);
    const size_t hstep = (size_t)HALF * K * 2;
    const size_t tstep = 2 * hstep;
    const size_t tstepA = (size_t)g.arows * K * 2;
    const unsigned ldsw = (unsigned)wid * 1024u;
    const int aoff = lds_byte(wr * 64 + fr, fq * 8), boff = lds_byte(wc * 32 + fr, fq * 8);
#define PG8_SA(b, h) (((b) * 2 + (h)) * HTB)
#define PG8_SB(b, h) ((4 + (b) * 2 + (h)) * HTB)
#define PG8_STAGE(bufoff, gbase, voff) do { _Pragma("unroll") for (int _i = 0; _i < 2; ++_i) \
        __builtin_amdgcn_global_load_lds((const unsigned*)((const char*)(gbase) + (voff)[_i]), (PG8_LAS unsigned*)(lds + (bufoff) + ldsw + _i * 8192), 16, 0, 0); } while (0)
#define PG8_LDA(dst, b, h) do { _Pragma("unroll") for (int m = 0; m < 4; ++m) _Pragma("unroll") for (int k = 0; k < 2; ++k) dst[m][k] = *(const PG8_LAS bf16x8*)(lds + PG8_SA(b, h) + aoff + m * 2048 + k * 1024); } while (0)
#define PG8_LDB(dst, b, h) do { _Pragma("unroll") for (int n = 0; n < 2; ++n) _Pragma("unroll") for (int k = 0; k < 2; ++k) dst[n][k] = *(const PG8_LAS bf16x8*)(lds + PG8_SB(b, h) + boff + n * 2048 + k * 1024); } while (0)
#define PG8_MMA(ai, bj, At, Bt) do { __builtin_amdgcn_s_setprio(1); _Pragma("unroll") for (int m = 0; m < 4; ++m) _Pragma("unroll") for (int n = 0; n < 2; ++n) _Pragma("unroll") for (int k = 0; k < 2; ++k) \
        acc[ai][bj][m][n] = __builtin_amdgcn_mfma_f32_16x16x32_bf16(Bt[n][k], At[m][k], acc[ai][bj][m][n], 0, 0, 0); __builtin_amdgcn_s_setprio(0); } while (0)
#define PG8_WAIT_V(n) asm volatile("s_waitcnt vmcnt(" #n ")" ::: "memory")
#define PG8_WAIT_L(n) asm volatile("s_waitcnt lgkmcnt(" #n ")" ::: "memory")
#define PG8_BAR __builtin_amdgcn_s_barrier()
#define PG8_SCHED __builtin_amdgcn_sched_barrier(0)
    Unit cur, nxt; int ui = 0;
    if (!S.next(0, cur)) return;
    f32x4 acc[2][2][4][2];
#pragma unroll
    for (int a = 0; a < 2; ++a)
#pragma unroll
        for (int b = 0; b < 2; ++b)
#pragma unroll
            for (int m = 0; m < 4; ++m)
#pragma unroll
                for (int n = 0; n < 2; ++n) acc[a][b][m][n] = (f32x4){0.f, 0.f, 0.f, 0.f};
    bf16x8 At[4][2], B0[2][2], B1[2][2];
    const char* cA = (const char*)g.A + (size_t)cur.pm * tstepA; const char* cB = (const char*)g.Bt + (size_t)cur.pn * tstep;
    S.a_ready(cur);
    if constexpr (SP2) {
        PG8_STAGE(PG8_SB(0, 0), cB, voffB); PG8_STAGE(PG8_SB(0, 1), cB + hstep, voffB); PG8_STAGE(PG8_SA(0, 0), cA, voffA); PG8_STAGE(PG8_SA(0, 1), cA + hstep, voffA);
        if (wr == 1) PG8_BAR;
        PG8_WAIT_V(2); PG8_BAR;
        PG8_STAGE(PG8_SB(1, 0), cB + kstep, voffB); PG8_STAGE(PG8_SA(1, 0), cA + kstep, voffA); PG8_STAGE(PG8_SB(1, 1), cB + hstep + kstep, voffB);
        PG8_WAIT_V(6); PG8_BAR;
    } else {
        PG8_STAGE(PG8_SB(0, 0), cB, voffB); PG8_STAGE(PG8_SA(0, 0), cA, voffA); PG8_STAGE(PG8_SB(0, 1), cB + hstep, voffB); PG8_STAGE(PG8_SA(0, 1), cA + hstep, voffA);
        if (wr == 1) PG8_BAR;
        PG8_WAIT_V(4); PG8_BAR;
        PG8_STAGE(PG8_SB(1, 0), cB + kstep, voffB); PG8_STAGE(PG8_SA(1, 0), cA + kstep, voffA); PG8_STAGE(PG8_SB(1, 1), cB + hstep + kstep, voffB);
        PG8_WAIT_V(6); PG8_BAR;
    }
    for (;;) {
        const bool has_next = S.next(ui + 1, nxt);
        const char* nA = has_next ? (const char*)g.A + (size_t)nxt.pm * tstepA : cA; const char* nB = has_next ? (const char*)g.Bt + (size_t)nxt.pn * tstep : cB;
        for (int t = 0; t < nt; t += 2) {
            const bool last = (t == nt - 2);
            const char* a1 = cA + (size_t)(t + 1) * kstep;
            const char* a2 = last ? nA : cA + (size_t)(t + 2) * kstep; const char* b2 = last ? nB : cB + (size_t)(t + 2) * kstep;
            const char* a3 = a2 + kstep; const char* b3 = b2 + kstep;
            if (last && has_next) S.a_ready(nxt);
            if constexpr (SP2) {
            PG8_LDB(B0, 0, 0); PG8_LDB(B1, 0, 1); PG8_SCHED; PG8_LDA(At, 0, 0); PG8_STAGE(PG8_SA(1, 1), a1 + hstep, voffA);
            PG8_WAIT_V(8); PG8_WAIT_L(0); PG8_BAR; PG8_MMA(0, 0, At, B0); PG8_MMA(0, 1, At, B1); PG8_BAR; PG8_SCHED;
            PG8_LDA(At, 0, 1); PG8_STAGE(PG8_SB(0, 0), b2, voffB); PG8_STAGE(PG8_SB(0, 1), b2 + hstep, voffB); PG8_STAGE(PG8_SA(0, 0), a2, voffA);
            PG8_WAIT_V(8); PG8_WAIT_L(0); PG8_BAR; PG8_MMA(1, 0, At, B0); PG8_MMA(1, 1, At, B1); PG8_BAR; PG8_SCHED;
            PG8_LDB(B0, 1, 0); PG8_LDB(B1, 1, 1); PG8_SCHED; PG8_LDA(At, 1, 0); PG8_STAGE(PG8_SA(0, 1), a2 + hstep, voffA);
            PG8_WAIT_V(8); PG8_WAIT_L(0); PG8_BAR; PG8_MMA(0, 0, At, B0); PG8_MMA(0, 1, At, B1); PG8_BAR; PG8_SCHED;
            PG8_LDA(At, 1, 1); PG8_STAGE(PG8_SB(1, 0), b3, voffB); PG8_STAGE(PG8_SB(1, 1), b3 + hstep, voffB); PG8_STAGE(PG8_SA(1, 0), a3, voffA);
            PG8_WAIT_V(8); PG8_WAIT_L(0); PG8_BAR; PG8_MMA(1, 0, At, B0); PG8_MMA(1, 1, At, B1); PG8_BAR; PG8_SCHED;
            } else {
            PG8_LDB(B0, 0, 0); PG8_SCHED; PG8_LDA(At, 0, 0); PG8_STAGE(PG8_SA(1, 1), a1 + hstep, voffA);
            PG8_WAIT_L(8); PG8_BAR; PG8_WAIT_L(0); PG8_MMA(0, 0, At, B0); PG8_BAR; PG8_SCHED;
            PG8_LDB(B1, 0, 1); PG8_STAGE(PG8_SB(0, 0), b2, voffB);
            PG8_BAR; PG8_WAIT_L(0); PG8_MMA(0, 1, At, B1); PG8_BAR;
            PG8_LDA(At, 0, 1); PG8_STAGE(PG8_SA(0, 0), a2, voffA);
            PG8_BAR; PG8_WAIT_L(0); PG8_MMA(1, 0, At, B0); PG8_BAR; PG8_SCHED;
            PG8_STAGE(PG8_SB(0, 1), b2 + hstep, voffB);
            PG8_WAIT_V(6); PG8_BAR; PG8_MMA(1, 1, At, B1); PG8_BAR;
            PG8_LDB(B0, 1, 0); PG8_SCHED; PG8_LDA(At, 1, 0); PG8_STAGE(PG8_SA(0, 1), a2 + hstep, voffA);
            PG8_WAIT_L(8); PG8_BAR; PG8_WAIT_L(0); PG8_MMA(0, 0, At, B0); PG8_BAR; PG8_SCHED;
            PG8_LDB(B1, 1, 1); PG8_STAGE(PG8_SB(1, 0), b3, voffB);
            PG8_BAR; PG8_WAIT_L(0); PG8_MMA(0, 1, At, B1); PG8_BAR;
            PG8_LDA(At, 1, 1); PG8_STAGE(PG8_SA(1, 0), a3, voffA);
            PG8_BAR; PG8_WAIT_L(0); PG8_MMA(1, 0, At, B0); PG8_BAR; PG8_SCHED;
            PG8_STAGE(PG8_SB(1, 1), b3 + hstep, voffB);
            PG8_WAIT_V(6); PG8_BAR; PG8_MMA(1, 1, At, B1); PG8_BAR;
            }
        }
        if constexpr (ALIGN_EPI) { if (wr == 0) PG8_BAR; }
        if constexpr (!Epi::AFTER_DRAIN) { E(acc, cur, wr, wc, fr, fq); S.done(cur); }
        if (!has_next) break;
#pragma unroll
        for (int a = 0; a < 2; ++a)
#pragma unroll
            for (int b = 0; b < 2; ++b)
#pragma unroll
                for (int m = 0; m < 4; ++m)
#pragma unroll
                    for (int n = 0; n < 2; ++n) acc[a][b][m][n] = (f32x4){0.f, 0.f, 0.f, 0.f};
        cur = nxt; cA = nA; cB = nB; ++ui;
        if constexpr (ALIGN_EPI) { if (wr == 1) PG8_BAR; }
    }
    PG8_WAIT_V(0);
    if constexpr (!ALIGN_EPI) { if (wr == 0) PG8_BAR; }
    PG8_BAR;
    if constexpr (Epi::AFTER_DRAIN) { E.fused(acc, cur, wr, wc, fr, fq, lds, wid, lane); S.done(cur); }
#undef PG8_SA
#undef PG8_SB
#undef PG8_STAGE
#undef PG8_LDA
#undef PG8_LDB
#undef PG8_MMA
#undef PG8_WAIT_V
#undef PG8_WAIT_L
#undef PG8_BAR
#undef PG8_SCHED
}
}
constexpr int S = 16384, DM = 1024, DEPTH = 4, NIN = 2816, DFF = 2816, NUP = 5632;
constexpr float EPS = 1e-6f;
constexpr int NWAVES = 8, NTHR = 512;
constexpr size_t MiB = 1u << 20;
constexpr size_t WS_WIN = 1 * MiB, WS_WOUT = 23 * MiB, WS_WUP = 31 * MiB, WS_WDN = 75 * MiB;
constexpr size_t WS_PART = 97 * MiB;
constexpr size_t WS_XB = 98 * MiB + 4096;
constexpr size_t WS_P = 131 * MiB;
constexpr size_t WS_Y = 219 * MiB;
constexpr size_t WS_GU = 131 * MiB;
constexpr size_t WS_A = 219 * MiB;
constexpr size_t WS_END = 307 * MiB;
constexpr int LDS_BYTES = 147456;
#define LAS __attribute__((address_space(3)))
typedef unsigned short bf16;
typedef unsigned v4u __attribute__((ext_vector_type(4)));
typedef unsigned v2u __attribute__((ext_vector_type(2)));
typedef float f32x4 __attribute__((ext_vector_type(4)));
typedef float f32x16 __attribute__((ext_vector_type(16)));
typedef short bf16x8 __attribute__((ext_vector_type(8)));
#define LDS_WAIT() asm volatile("s_waitcnt lgkmcnt(0)" ::: "memory")
__device__ __forceinline__ unsigned pk2(float lo, float hi) { return pg8::cvt_pk_bf16(lo, hi); }
__device__ __forceinline__ float bflo(unsigned u) { return __uint_as_float(u << 16); }
__device__ __forceinline__ float bfhi(unsigned u) { return __uint_as_float(u & 0xffff0000u); }
__device__ __forceinline__ float bf1(bf16 v) { return __uint_as_float((unsigned)v << 16); }
__device__ __forceinline__ float wave_sum(float v) {
#pragma unroll
    for (int o = 1; o < 64; o <<= 1) v += __shfl_xor(v, o);
    return v;
}

__device__ __forceinline__ void cvt_item(const float* W, int K, int N, bf16* WT, const float* gain, int mode, LAS float* scr, int item, int lane) {
    const int nblk = N / 32, kb = item / nblk, nb = item % nblk, k0 = 64 * kb, n0 = 32 * nb;
    float wv[32];
#pragma unroll
    for (int i = 0; i < 32; ++i) { const int kk = 2 * i + (lane >> 5); wv[i] = W[(size_t)(k0 + kk) * N + n0 + (lane & 31)]; }
#pragma unroll
    for (int i = 0; i < 32; ++i) { const int kk = 2 * i + (lane >> 5); const float g = gain ? gain[k0 + kk] : 1.0f; scr[kk * 33 + (lane & 31)] = wv[i] * g; }
    LDS_WAIT(); asm volatile("" ::: "memory");
    const float cs = (mode == 1 && n0 >= 1280 && n0 < 1792) ? 0.125f * 1.4426950408889634f : 1.0f;
    int rb = n0;
    if (mode == 2) { rb = (n0 < DFF) ? 256 * (n0 / 128) + (n0 % 128) : 256 * ((n0 - DFF) / 128) + 128 + ((n0 - DFF) % 128); }
    const int c = lane & 7;
#pragma unroll
    for (int j = 0; j < 4; ++j) { const int n = (lane >> 3) + 8 * j; const LAS float* s = scr + (8 * c) * 33 + n;
        v4u o; o.x = pk2(s[0 * 33] * cs, s[1 * 33] * cs); o.y = pk2(s[2 * 33] * cs, s[3 * 33] * cs); o.z = pk2(s[4 * 33] * cs, s[5 * 33] * cs); o.w = pk2(s[6 * 33] * cs, s[7 * 33] * cs);
        *(v4u*)(WT + (size_t)(rb + n) * K + k0 + 8 * c) = o; }
    LDS_WAIT(); asm volatile("" ::: "memory");
}

typedef __attribute__((address_space(1))) unsigned gu32;
#define XB_TMO      128
#define XB_XCNT(j)  (256  + 64 * (j))
#define XB_XSUB(j)  (1280 + 64 * (j))
#define XB_XGEN(j)  (2304 + 64 * (j))
#define XB_TOP      3328
#define XB_TOPGEN   3392
#define XCD_BAR_WORDS 3456
#define XB_SPIN_CAP (1u << 18)

__device__ __forceinline__ unsigned xb_ld(unsigned* p)              { return __hip_atomic_load(p, __ATOMIC_RELAXED, __HIP_MEMORY_SCOPE_AGENT); }
__device__ __forceinline__ unsigned xb_add(unsigned* p, unsigned v) { return __hip_atomic_fetch_add(p, v, __ATOMIC_RELAXED, __HIP_MEMORY_SCOPE_AGENT); }
__device__ __forceinline__ unsigned xb_xcc_id() { return (unsigned)__builtin_amdgcn_s_getreg((3 << 11) | 20) & 0xFu; }
#define XB_SPIN(cond, bar) do { unsigned _sp = 0; while (cond) { __builtin_amdgcn_s_sleep(1); \
    if ((++_sp & 255u) == 0u) { if (xb_ld(&(bar)[XB_TMO])) break; if (_sp > XB_SPIN_CAP) { atomicAdd(&(bar)[XB_TMO], 1u); break; } } } } while (0)

struct XcdBarrier {
    unsigned* bar; unsigned x;
    volatile LAS unsigned* st;
};

__device__ __forceinline__ XcdBarrier xcd_barrier_post(unsigned* bar, volatile LAS unsigned* st) {
    XcdBarrier b; b.bar = bar; b.x = xb_xcc_id(); b.st = st;
    if (threadIdx.x == 0) (void)xb_add(&bar[XB_XCNT(b.x)], 1u);
    return b;
}
__device__ __forceinline__ void xcd_barrier_complete(unsigned* bar, unsigned x, unsigned& nloc, unsigned& nx) {
    const unsigned G = gridDim.x * gridDim.y * gridDim.z;
    unsigned sum, cnt, mine, sp = 0u;
    for (;;) {
        sum = 0u; cnt = 0u; mine = 0u;
#pragma unroll
        for (unsigned j = 0; j < 16; ++j) { const unsigned c = xb_ld(&bar[XB_XCNT(j)]); sum += c; cnt += (c > 0u) ? 1u : 0u; mine = (j == x) ? c : mine; }
        if (sum == G) break;
        __builtin_amdgcn_s_sleep(1);
        if ((++sp & 255u) == 0u) { if (xb_ld(&bar[XB_TMO])) break; if (sp > XB_SPIN_CAP) { atomicAdd(&bar[XB_TMO], 1u); break; } }
    }
    nloc = mine > 0u ? mine : 1u; nx = cnt > 0u ? cnt : 1u;
}

__device__ __forceinline__ void xcd_barrier(const XcdBarrier& b) {
    asm volatile("s_waitcnt vmcnt(0)" ::: "memory");
    __syncthreads();
    if (threadIdx.x == 0) {
        unsigned* bar = b.bar;
        __builtin_amdgcn_s_waitcnt(0);
        unsigned nloc = b.st[0], nx = b.st[1];
        if (nloc == 0u) { xcd_barrier_complete(bar, b.x, nloc, nx); b.st[0] = nloc; b.st[1] = nx; }
        const unsigned old = xb_add(&bar[XB_XSUB(b.x)], 1u);
        const unsigned gen = old / nloc;
        if (old + 1u == (gen + 1u) * nloc) {
            __builtin_amdgcn_fence(__ATOMIC_RELEASE, "agent");
            asm volatile("s_waitcnt vmcnt(0)" ::: "memory");
            const unsigned og = xb_add(&bar[XB_TOP], 1u);
            const unsigned tg = og / nx;
            if (og + 1u == (tg + 1u) * nx) xb_add(&bar[XB_TOPGEN], 1u);
            else XB_SPIN(xb_ld(&bar[XB_TOPGEN]) == tg, bar);
            __builtin_amdgcn_fence(__ATOMIC_ACQUIRE, "agent");
            xb_add(&bar[XB_XGEN(b.x)], 1u);
            asm volatile("s_waitcnt vmcnt(0)" ::: "memory");
        } else {
            XB_SPIN(xb_ld(&bar[XB_XGEN(b.x)]) == gen, bar);
            __builtin_amdgcn_fence(__ATOMIC_ACQUIRE, "agent");
            asm volatile("s_waitcnt vmcnt(0)" ::: "memory");
        }
    }
    __syncthreads();
}

struct Args { const float* in[14]; float* out; unsigned char* ws; };

__device__ __forceinline__ void norm_store_rows(const LAS float* tile, bf16* Y, int t0, int coff, int wave, int lane) {
#pragma unroll 2
    for (int i = 0; i < 8; ++i) { const int r = wave * 8 + i; const f32x4 v = *(const LAS f32x4*)(tile + r * 260 + lane * 4);
        const float ss = wave_sum((v[0] * v[0] + v[1] * v[1]) + (v[2] * v[2] + v[3] * v[3]));
        const float rs = __builtin_amdgcn_rsqf(ss * (1.0f / 256.0f) + EPS);
        v2u o; o.x = pk2(v[0] * rs, v[1] * rs); o.y = pk2(v[2] * rs, v[3] * rs);
        *(v2u*)(Y + (size_t)(t0 + r) * DM + coff + lane * 4) = o; }
}

__device__ __forceinline__ void mixer_unit(LAS unsigned char* lds, int unit, const bf16* P, bf16* Y, const float* conv_w, const float* sgu_norm, const float* sgu_w, const float* sgu_b, int tid, int wave, int lane) {
    const int t0 = unit * 64;
    asm volatile("" : "+v"(tid), "+v"(lane));
    LAS bf16* vnT = (LAS bf16*)lds;
    LAS float* tile = (LAS float*)(lds + 69632);
    LAS float* sm_ss = (LAS float*)(lds + 69632 + 66560);
    {
        const int hd = wave, r = lane & 31, h = lane >> 5;
        const int pr = (r & 0x13) | ((r & 4) << 1) | ((r & 8) >> 1);
        LAS bf16* Vt = (LAS bf16*)(lds + wave * 5120);
        bf16x8 atri[2];
#pragma unroll
        for (int sI = 0; sI < 2; ++sI) { v4u t;
            t.x = ((16 * sI + 8 * h + 0 > pr) ? 0x3F80u : 0u) | ((16 * sI + 8 * h + 1 > pr) ? 0x3F800000u : 0u); t.y = ((16 * sI + 8 * h + 2 > pr) ? 0x3F80u : 0u) | ((16 * sI + 8 * h + 3 > pr) ? 0x3F800000u : 0u);
            t.z = ((16 * sI + 8 * h + 4 > pr) ? 0x3F80u : 0u) | ((16 * sI + 8 * h + 5 > pr) ? 0x3F800000u : 0u); t.w = ((16 * sI + 8 * h + 6 > pr) ? 0x3F80u : 0u) | ((16 * sI + 8 * h + 7 > pr) ? 0x3F800000u : 0u);
            atri[sI] = __builtin_bit_cast(bf16x8, t); }
        f32x16 oacc[2][2];
        LAS bf16x8* Qs = (LAS bf16x8*)(lds + 40960 + wave * 8192);
#pragma unroll
        for (int ks = 0; ks < 4; ++ks) { Qs[ks * 64 + lane] = *(const bf16x8*)(P + (size_t)(t0 + r) * NIN + 1280 + hd * 64 + 16 * ks + 8 * h); Qs[(4 + ks) * 64 + lane] = *(const bf16x8*)(P + (size_t)(t0 + 32 + r) * NIN + 1280 + hd * 64 + 16 * ks + 8 * h); }
#pragma unroll
        for (int a = 0; a < 2; ++a)
#pragma unroll
            for (int b = 0; b < 2; ++b) oacc[a][b] = (f32x16){};
        float lsA = 0.f, lsB = 0.f; bool actA = true, actB = true;
        bf16x8 kfn[4]; v4u vvn[4];
        { const bf16* kp = P + (size_t)(t0 + 32 + pr) * NIN + 1792 + hd * 64 + 8 * h;
#pragma unroll
          for (int ks = 0; ks < 4; ++ks) kfn[ks] = *(const bf16x8*)(kp + 16 * ks);
#pragma unroll
          for (int i = 0; i < 4; ++i) vvn[i] = *(const v4u*)(P + (size_t)(t0 + 32 + (lane >> 3) + 8 * i) * NIN + 2304 + hd * 64 + 8 * (lane & 7)); }
#define SB_CHAIN(Z, O0, O1, LS, DIAGV) do { \
            f32x16 cin; float Lv[16]; \
            _Pragma("unroll") for (int jj = 0; jj < 16; ++jj) { const float zz = Z[jj]; const float ex = __builtin_amdgcn_exp2f(-fabsf(zz)); const float lsig = fminf(zz, 0.f) - __builtin_amdgcn_logf(1.0f + ex); \
                Lv[jj] = lsig - zz; cin[jj] = lsig + LS; } \
            if (DIAGV) { _Pragma("unroll") for (int jj = 0; jj < 16; ++jj) { const int keyl = 16 * (jj >> 3) + 8 * h + (jj & 7); Lv[jj] = (keyl < r) ? Lv[jj] : 0.f; } } \
            float rowsum = 0.f; unsigned lh[8], ll[8]; \
            _Pragma("unroll") for (int j = 0; j < 16; j += 2) { rowsum += Lv[j] + Lv[j + 1]; \
                const unsigned hp = pk2(Lv[j], Lv[j + 1]); lh[j >> 1] = hp; ll[j >> 1] = pk2(Lv[j] - bflo(hp), Lv[j + 1] - bfhi(hp)); } \
            const bf16x8 bh0 = __builtin_bit_cast(bf16x8, (v4u){lh[0], lh[1], lh[2], lh[3]}), bh1 = __builtin_bit_cast(bf16x8, (v4u){lh[4], lh[5], lh[6], lh[7]}); \
            const bf16x8 bl0 = __builtin_bit_cast(bf16x8, (v4u){ll[0], ll[1], ll[2], ll[3]}), bl1 = __builtin_bit_cast(bf16x8, (v4u){ll[4], ll[5], ll[6], ll[7]}); \
            f32x16 lw = __builtin_amdgcn_mfma_f32_32x32x16_bf16(atri[0], bh0, cin, 0, 0, 0); \
            lw = __builtin_amdgcn_mfma_f32_32x32x16_bf16(atri[1], bh1, lw, 0, 0, 0); \
            lw = __builtin_amdgcn_mfma_f32_32x32x16_bf16(atri[0], bl0, lw, 0, 0, 0); \
            lw = __builtin_amdgcn_mfma_f32_32x32x16_bf16(atri[1], bl1, lw, 0, 0, 0); \
            float wv[16]; \
            _Pragma("unroll") for (int jj = 0; jj < 16; ++jj) wv[jj] = __builtin_amdgcn_exp2f(lw[jj]); \
            if (DIAGV) { _Pragma("unroll") for (int jj = 0; jj < 16; ++jj) { const int keyl = 16 * (jj >> 3) + 8 * h + (jj & 7); wv[jj] = (keyl < r) ? wv[jj] : 0.f; } } \
            unsigned wp[8]; \
            _Pragma("unroll") for (int j = 0; j < 16; j += 2) wp[j >> 1] = pk2(wv[j], wv[j + 1]); \
            const bf16x8 w0 = __builtin_bit_cast(bf16x8, (v4u){wp[0], wp[1], wp[2], wp[3]}), w1 = __builtin_bit_cast(bf16x8, (v4u){wp[4], wp[5], wp[6], wp[7]}); \
            const LAS bf16* vr = Vt + r * 40 + 8 * h; \
            O0 = __builtin_amdgcn_mfma_f32_32x32x16_bf16(*(const LAS bf16x8*)(vr), w0, O0, 0, 0, 0); \
            O0 = __builtin_amdgcn_mfma_f32_32x32x16_bf16(*(const LAS bf16x8*)(vr + 16), w1, O0, 0, 0, 0); \
            O1 = __builtin_amdgcn_mfma_f32_32x32x16_bf16(*(const LAS bf16x8*)(vr + 32 * 40), w0, O1, 0, 0, 0); \
            O1 = __builtin_amdgcn_mfma_f32_32x32x16_bf16(*(const LAS bf16x8*)(vr + 32 * 40 + 16), w1, O1, 0, 0, 0); \
            LS += rowsum + __shfl_xor(rowsum, 32); } while (0)
        for (int k0 = t0 + 32;; k0 -= 32) {
            const bool doA = actA && (k0 <= t0);
            f32x16 zB = {}, zA = {};
            if (actB) {
#pragma unroll
                for (int ks = 0; ks < 4; ++ks) zB = __builtin_amdgcn_mfma_f32_32x32x16_bf16(kfn[ks], Qs[(4 + ks) * 64 + lane], zB, 0, 0, 0); }
            if (doA) {
#pragma unroll
                for (int ks = 0; ks < 4; ++ks) zA = __builtin_amdgcn_mfma_f32_32x32x16_bf16(kfn[ks], Qs[ks * 64 + lane], zA, 0, 0, 0); }
#pragma unroll
            for (int i = 0; i < 4; ++i) { const int key = (lane >> 3) + 8 * i, c = lane & 7; const v4u vv = vvn[i];
                LAS bf16* vd = Vt + (8 * c) * 40 + key;
                vd[0] = (bf16)(vv.x & 0xffffu); vd[40] = (bf16)(vv.x >> 16); vd[80] = (bf16)(vv.y & 0xffffu); vd[120] = (bf16)(vv.y >> 16);
                vd[160] = (bf16)(vv.z & 0xffffu); vd[200] = (bf16)(vv.z >> 16); vd[240] = (bf16)(vv.w & 0xffffu); vd[280] = (bf16)(vv.w >> 16); }
            if (k0 >= 32) { const bf16* kp = P + (size_t)(k0 - 32 + pr) * NIN + 1792 + hd * 64 + 8 * h;
#pragma unroll
                for (int ks = 0; ks < 4; ++ks) kfn[ks] = *(const bf16x8*)(kp + 16 * ks);
#pragma unroll
                for (int i = 0; i < 4; ++i) vvn[i] = *(const v4u*)(P + (size_t)(k0 - 32 + (lane >> 3) + 8 * i) * NIN + 2304 + hd * 64 + 8 * (lane & 7)); }
            if (actB) { const bool dg = (k0 == t0 + 32); SB_CHAIN(zB, oacc[1][0], oacc[1][1], lsB, dg);
                if (__builtin_amdgcn_ballot_w64(lsB > -150.1f) == 0ull) actB = false; }
            if (doA) { const bool dg = (k0 == t0); SB_CHAIN(zA, oacc[0][0], oacc[0][1], lsA, dg);
                if (__builtin_amdgcn_ballot_w64(lsA > -150.1f) == 0ull) actA = false; }
            if (k0 < 32 || !(actA || actB)) break;
        }
#undef SB_CHAIN
#pragma unroll
        for (int qh = 0; qh < 2; ++qh) { float ss = 0.f;
#pragma unroll
            for (int j = 0; j < 16; ++j) ss += oacc[qh][0][j] * oacc[qh][0][j] + oacc[qh][1][j] * oacc[qh][1][j];
            ss += __shfl_xor(ss, 32);
            if (h == 0) sm_ss[(32 * qh + r) * 8 + hd] = ss; }
        LDS_WAIT(); __syncthreads();
#pragma unroll
        for (int qh = 0; qh < 2; ++qh) {
            const f32x4 sa = *(const LAS f32x4*)(sm_ss + (32 * qh + r) * 8), sb = *(const LAS f32x4*)(sm_ss + (32 * qh + r) * 8 + 4);
            const float tot = ((sa[0] + sa[1]) + (sa[2] + sa[3])) + ((sb[0] + sb[1]) + (sb[2] + sb[3]));
            const float rs = __builtin_amdgcn_rsqf(tot * (1.0f / 512.0f) + EPS);
            bf16* yp = Y + (size_t)(t0 + 32 * qh + r) * DM + 512 + hd * 64 + 4 * h;
#pragma unroll
            for (int db = 0; db < 2; ++db)
#pragma unroll
                for (int g4 = 0; g4 < 4; ++g4) { const f32x16& o = oacc[qh][db]; v2u w; w.x = pk2(o[4 * g4 + 0] * rs, o[4 * g4 + 1] * rs); w.y = pk2(o[4 * g4 + 2] * rs, o[4 * g4 + 3] * rs);
                    *(v2u*)(yp + 32 * db + 8 * g4) = w; }
        }
    }
    {
        const int c = tid & 255, rh = tid >> 8, tb = t0 + 32 * rh;
        const float w0 = conv_w[c], w1 = conv_w[256 + c], w2 = conv_w[512 + c];
        float p2 = 0.f, p1 = 0.f;
        if (tb >= 2) { const bf16* r2 = P + (size_t)(tb - 2) * NIN; const bf16* r1 = P + (size_t)(tb - 1) * NIN; p2 = bf1(r2[256 + c]) * bf1(r2[512 + c]); p1 = bf1(r1[256 + c]) * bf1(r1[512 + c]); }
#pragma unroll 16
        for (int r = 0; r < 32; ++r) { const bf16* rp = P + (size_t)(tb + r) * NIN; const float p0 = bf1(rp[256 + c]) * bf1(rp[512 + c]);
            tile[(32 * rh + r) * 260 + c] = bf1(rp[c]) * (w0 * p2 + w1 * p1 + w2 * p0); p2 = p1; p1 = p0; }
    }
    LDS_WAIT(); __syncthreads();
    norm_store_rows(tile, Y, t0, 0, wave, lane);
    const int tc = t0 & ~127, dt = t0 - tc, ns = dt + 64;
    { v2u uu[16];
#pragma unroll
      for (int i = 0; i < 16; ++i) { const int s = wave + 8 * i; uu[i] = (s < ns) ? *(const v2u*)(P + (size_t)(tc + s) * NIN + 1024 + lane * 4) : (v2u){0u, 0u}; }
      const f32x4 g = *(const f32x4*)(sgu_norm + lane * 4);
#pragma unroll
      for (int i = 0; i < 16; ++i) { const int s = wave + 8 * i;
        if (s < ns) { const v2u u = uu[i];
        const float v0 = bflo(u.x), v1 = bfhi(u.x), v2 = bflo(u.y), v3 = bfhi(u.y);
        const float ss = wave_sum((v0 * v0 + v1 * v1) + (v2 * v2 + v3 * v3)); const float rs = __builtin_amdgcn_rsqf(ss * (1.0f / 256.0f) + EPS);
        const unsigned a = pk2(v0 * rs * g[0], v1 * rs * g[1]), b = pk2(v2 * rs * g[2], v3 * rs * g[3]);
        vnT[(lane * 4 + 0) * 136 + s] = (bf16)(a & 0xffffu); vnT[(lane * 4 + 1) * 136 + s] = (bf16)(a >> 16); vnT[(lane * 4 + 2) * 136 + s] = (bf16)(b & 0xffffu); vnT[(lane * 4 + 3) * 136 + s] = (bf16)(b >> 16); } } }
    LDS_WAIT(); __syncthreads();
    {
        const int h = wave >> 1, rh = wave & 1, r32 = lane & 31, hi = lane >> 5;
        const int tcl = dt + 32 * rh + r32;
        const float* wrow = sgu_w + ((size_t)h * 128 + tcl) * 128;
        f32x16 o0 = {}, o1 = {};
        const int nk = (dt + 32 * rh + 32) >> 4;
        f32x4 wa[8], wb[8];
#pragma unroll
        for (int ks = 0; ks < 8; ++ks) { const int s0 = ks * 16 + 8 * hi; if (ks < nk) { wa[ks] = *(const f32x4*)(wrow + s0); wb[ks] = *(const f32x4*)(wrow + s0 + 4); } else { wa[ks] = (f32x4){0.f, 0.f, 0.f, 0.f}; wb[ks] = wa[ks]; } }
#pragma unroll
        for (int ks = 0; ks < 8; ++ks) if (ks < nk) { const int s0 = ks * 16 + 8 * hi;
            float wv[8] = {wa[ks][0], wa[ks][1], wa[ks][2], wa[ks][3], wb[ks][0], wb[ks][1], wb[ks][2], wb[ks][3]};
#pragma unroll
            for (int i = 0; i < 8; ++i) wv[i] = (s0 + i <= tcl) ? wv[i] : 0.f;
            v4u ap; ap.x = pk2(wv[0], wv[1]); ap.y = pk2(wv[2], wv[3]); ap.z = pk2(wv[4], wv[5]); ap.w = pk2(wv[6], wv[7]);
            const bf16x8 af = __builtin_bit_cast(bf16x8, ap);
            const bf16x8 b0 = *(const LAS bf16x8*)(vnT + (h * 64 + r32) * 136 + s0), b1 = *(const LAS bf16x8*)(vnT + (h * 64 + 32 + r32) * 136 + s0);
            o0 = __builtin_amdgcn_mfma_f32_32x32x16_bf16(af, b0, o0, 0, 0, 0);
            o1 = __builtin_amdgcn_mfma_f32_32x32x16_bf16(af, b1, o1, 0, 0, 0); }
#pragma unroll
        for (int j = 0; j < 16; ++j) { const int rl = 32 * rh + (j & 3) + 8 * (j >> 2) + 4 * hi;
            const float bb = sgu_b[h * 128 + dt + rl]; const bf16* up = P + (size_t)(t0 + rl) * NIN + 768 + h * 64;
            tile[rl * 260 + h * 64 + r32] = bf1(up[r32]) * (o0[j] + bb);
            tile[rl * 260 + h * 64 + 32 + r32] = bf1(up[32 + r32]) * (o1[j] + bb); }
    }
    LDS_WAIT(); __syncthreads();
    norm_store_rows(tile, Y, t0, 256, wave, lane);
    LDS_WAIT(); __syncthreads();
}

__device__ __forceinline__ void ffn_gate_phase(const bf16* GU, bf16* A, const float* fconv, int hf, int gtid, int gthreads) {
    for (int it = gtid; it < 256 * 176; it += gthreads) { const int rb = it / 176, cgp = it % 176, pnl = cgp >> 4, cc = (cgp & 15) * 8, ch = 1408 * hf + 128 * pnl + cc;
        float wg[3][8], wu[3][8];
#pragma unroll
        for (int i = 0; i < 3; ++i) { const f32x4 a0 = *(const f32x4*)(fconv + (size_t)i * NUP + ch), a1 = *(const f32x4*)(fconv + (size_t)i * NUP + ch + 4), b0 = *(const f32x4*)(fconv + (size_t)i * NUP + DFF + ch), b1 = *(const f32x4*)(fconv + (size_t)i * NUP + DFF + ch + 4);
#pragma unroll
            for (int e = 0; e < 4; ++e) { wg[i][e] = a0[e]; wg[i][4 + e] = a1[e]; wu[i][e] = b0[e]; wu[i][4 + e] = b1[e]; } }
        float g2[8], g1[8], u2[8], u1[8];
#pragma unroll
        for (int e = 0; e < 8; ++e) { g2[e] = g1[e] = u2[e] = u1[e] = 0.f; }
        for (int r = -2; r < 64; ++r) { const int t = 64 * rb + r; float g0[8], u0[8];
            if (t >= 0) { const v4u gv = *(const v4u*)(GU + (size_t)t * NIN + 256 * pnl + cc), uv = *(const v4u*)(GU + (size_t)t * NIN + 256 * pnl + 128 + cc);
                g0[0] = bflo(gv.x); g0[1] = bfhi(gv.x); g0[2] = bflo(gv.y); g0[3] = bfhi(gv.y); g0[4] = bflo(gv.z); g0[5] = bfhi(gv.z); g0[6] = bflo(gv.w); g0[7] = bfhi(gv.w);
                u0[0] = bflo(uv.x); u0[1] = bfhi(uv.x); u0[2] = bflo(uv.y); u0[3] = bfhi(uv.y); u0[4] = bflo(uv.z); u0[5] = bfhi(uv.z); u0[6] = bflo(uv.w); u0[7] = bfhi(uv.w); }
            else {
#pragma unroll
                for (int e = 0; e < 8; ++e) { g0[e] = 0.f; u0[e] = 0.f; } }
            if (r >= 0) { float o[8];
#pragma unroll
                for (int e = 0; e < 8; ++e) { const float G = wg[0][e] * g2[e] + wg[1][e] * g1[e] + wg[2][e] * g0[e], U = wu[0][e] * u2[e] + wu[1][e] * u1[e] + wu[2][e] * u0[e];
                    o[e] = G * __builtin_amdgcn_rcpf(1.0f + __expf(-G)) * U; }
                v4u ov; ov.x = pk2(o[0], o[1]); ov.y = pk2(o[2], o[3]); ov.z = pk2(o[4], o[5]); ov.w = pk2(o[6], o[7]);
                *(v4u*)(A + (size_t)t * DFF + ch) = ov; }
#pragma unroll
            for (int e = 0; e < 8; ++e) { g2[e] = g1[e]; g1[e] = g0[e]; u2[e] = u1[e]; u1[e] = u0[e]; } }
    }
}
__global__ void __launch_bounds__(NTHR, 2) hybrid_fwd(Args args) {
    extern __shared__ __attribute__((aligned(16))) unsigned char lds_raw[];
    LAS unsigned char* lds = (LAS unsigned char*)lds_raw;
    cg::grid_group grid = cg::this_grid();
    volatile LAS unsigned* MISC = (volatile LAS unsigned*)(lds + LDS_BYTES - 64);
    if (threadIdx.x < 16) MISC[threadIdx.x] = 0u;
    __syncthreads();
    XcdBarrier xbar = xcd_barrier_post((unsigned*)args.ws, MISC);
    const int tid = threadIdx.x, lane = tid & 63, wave = __builtin_amdgcn_readfirstlane(tid >> 6);
    const int G = gridDim.x, bx = blockIdx.x;
    const int gw = bx * NWAVES + wave, NGW = G * NWAVES;
    unsigned char* ws = args.ws;
    const float* x_in = args.in[0]; const float* norm_mix = args.in[1]; const float* w_in = args.in[2]; const float* conv_w = args.in[3];
    const float* sgu_norm = args.in[4]; const float* sgu_w = args.in[5]; const float* sgu_b = args.in[6]; const float* out_norm = args.in[7];
    const float* w_out = args.in[8]; const float* norm_ffn = args.in[9]; const float* w_up = args.in[10]; const float* ffn_conv = args.in[11];
    const float* w_down = args.in[12]; const float* norm_final = args.in[13];
    float* xcur = args.out;
    bf16* Win_t = (bf16*)(ws + WS_WIN); bf16* Wout_t = (bf16*)(ws + WS_WOUT); bf16* Wup_t = (bf16*)(ws + WS_WUP); bf16* Wdn_t = (bf16*)(ws + WS_WDN);
    float* part = (float*)(ws + WS_PART); bf16* XB = (bf16*)(ws + WS_XB); bf16* P = (bf16*)(ws + WS_P); bf16* Y = (bf16*)(ws + WS_Y);
    bf16* GU = (bf16*)(ws + WS_GU); bf16* A = (bf16*)(ws + WS_A);

    {
        LAS float* scr = (LAS float*)(lds + wave * 16384);
        constexpr int I_IN = 16 * 88, I_OUT = 16 * 32, I_UP = 16 * 176, I_DN = 44 * 32, I_L = I_IN + I_OUT + I_UP + I_DN;
        for (int it = gw; it < DEPTH * I_L; it += NGW) { const int l = it / I_L; int r = it % I_L;
            if (r < I_IN) { cvt_item(w_in + (size_t)l * DM * NIN, DM, NIN, Win_t + (size_t)l * NIN * DM, norm_mix + l * DM, 1, scr, r, lane); continue; } r -= I_IN;
            if (r < I_OUT) { cvt_item(w_out + (size_t)l * DM * DM, DM, DM, Wout_t + (size_t)l * DM * DM, out_norm + l * DM, 0, scr, r, lane); continue; } r -= I_OUT;
            if (r < I_UP) { cvt_item(w_up + (size_t)l * DM * NUP, DM, NUP, Wup_t + (size_t)l * NUP * DM, norm_ffn + l * DM, 2, scr, r, lane); continue; } r -= I_UP;
            cvt_item(w_down + (size_t)l * DFF * DM, DFF, DM, Wdn_t + (size_t)l * DM * DFF, nullptr, 0, scr, r, lane); }
        for (int m = gw; m < S; m += NGW) { const f32x4* xr = (const f32x4*)(x_in + (size_t)m * DM) + lane; f32x4 v[4]; float ss = 0.f;
#pragma unroll
            for (int j = 0; j < 4; ++j) { v[j] = xr[64 * j]; ss += (v[j][0] * v[j][0] + v[j][1] * v[j][1]) + (v[j][2] * v[j][2] + v[j][3] * v[j][3]); }
            ss = wave_sum(ss);
            v2u* o8 = (v2u*)(XB + (size_t)m * DM) + lane;
#pragma unroll
            for (int j = 0; j < 4; ++j) { v2u o; o.x = pk2(v[j][0], v[j][1]); o.y = pk2(v[j][2], v[j][3]); o8[64 * j] = o; }
            if (lane < 16) part[(size_t)m * 16 + lane] = lane == 0 ? ss : 0.f; }
    }
    grid.sync();

    for (int l = 0; l < DEPTH; ++l) {
        { pg8::Gemm g{XB, Win_t + (size_t)l * NIN * DM, S, NIN, DM, 256}; pg8::StaticOrder So; So.init(S, NIN, G, bx);
          pg8::EpiScaleBf16 E{P, NIN, part, (LAS float*)(lds + 131072 + 8192)};
          pg8::gemm_phase<pg8::EpiScaleBf16, pg8::StaticOrder, true, true>(lds, g, So, E); }
        xcd_barrier(xbar);
        for (int u = bx; u < S / 64; u += G)
            mixer_unit(lds, u, P, Y, conv_w + l * 3 * 256, sgu_norm + l * 256, sgu_w + (size_t)l * 4 * 128 * 128, sgu_b + l * 4 * 128, tid, wave, lane);
        xcd_barrier(xbar);
        { pg8::Gemm g{Y, Wout_t + (size_t)l * DM * DM, S, DM, DM, 256}; pg8::StaticOrder So; So.init(S, DM, G, bx);
          pg8::EpiResid E{l == 0 ? x_in : xcur, xcur, XB, part};
          pg8::gemm_phase<pg8::EpiResid, pg8::StaticOrder, true, true>(lds, g, So, E); }
        xcd_barrier(xbar);
        { pg8::Gemm g{XB - 2 * DM, Wup_t + (size_t)l * NUP * DM, 65 * 256, NUP, DM, 254}; pg8::StaticOrder So; So.init(65 * 256, NUP, G, bx);
          pg8::EpiGate E{A, part, ffn_conv + (size_t)l * 3 * NUP, (LAS float*)(lds + 131072)};
          pg8::gemm_phase<pg8::EpiGate, pg8::StaticOrder, true, true>(lds, g, So, E); }
        xcd_barrier(xbar);
        { pg8::Gemm g{A, Wdn_t + (size_t)l * DM * DFF, S, DM, DFF, 256}; pg8::StaticOrder So; So.init(S, DM, G, bx);
          pg8::EpiResid E{xcur, xcur, XB, part};
          pg8::gemm_phase<pg8::EpiResid, pg8::StaticOrder, true, true>(lds, g, So, E); }
        xcd_barrier(xbar);
    }
    for (int m = gw; m < S; m += NGW) { f32x4* xr = (f32x4*)(xcur + (size_t)m * DM) + lane; f32x4 v[4]; float ss = 0.f;
#pragma unroll
        for (int j = 0; j < 4; ++j) { v[j] = xr[64 * j]; ss += (v[j][0] * v[j][0] + v[j][1] * v[j][1]) + (v[j][2] * v[j][2] + v[j][3] * v[j][3]); }
        const float rs = __builtin_amdgcn_rsqf(wave_sum(ss) * (1.0f / 1024.0f) + EPS);
#pragma unroll
        for (int j = 0; j < 4; ++j) { const f32x4 g = *((const f32x4*)norm_final + lane + 64 * j); xr[64 * j] = v[j] * rs * g; } }
}

extern "C" void kernel_launch(void* const* d_in, const int* in_sizes, int n_in, void* d_out, int out_size, void* d_ws, size_t ws_size, hipStream_t stream) {
    static int grid = 0;
    if (grid == 0) {
        if (n_in != 14 || out_size != S * DM || ws_size < WS_END) { fprintf(stderr, "kernel_launch: unexpected shapes / workspace (%d inputs, out %d, ws %zu)\n", n_in, out_size, ws_size); grid = -1; return; }
        int dev = 0, cus = 0, per_cu = 0;
        hipGetDevice(&dev); hipDeviceGetAttribute(&cus, hipDeviceAttributeMultiprocessorCount, dev);
        hipFuncSetAttribute((const void*)hybrid_fwd, hipFuncAttributeMaxDynamicSharedMemorySize, LDS_BYTES);
        hipOccupancyMaxActiveBlocksPerMultiprocessor(&per_cu, (const void*)hybrid_fwd, NTHR, LDS_BYTES);
        (void)hipGetLastError();
        if (per_cu < 1) per_cu = 1;
        grid = cus * 1;
    }
    if (grid < 0) return;
    hipMemsetAsync((unsigned char*)d_ws, 0, 16384, stream);
    hipMemsetAsync((unsigned char*)d_ws + WS_XB - 4096, 0, 4096, stream);
    Args a{};
    for (int i = 0; i < 14; ++i) a.in[i] = (const float*)d_in[i];
    a.out = (float*)d_out; a.ws = (unsigned char*)d_ws;
    void* kargs[] = {&a};
    hipError_t e = hipLaunchCooperativeKernel((const void*)hybrid_fwd, dim3(grid), dim3(NTHR), kargs, LDS_BYTES, stream);
    if (e != hipSuccess) fprintf(stderr, "cooperative launch failed: %s (grid %d)\n", hipGetErrorString(e), grid);
}
```

```cpp
#include <hip/hip_runtime.h>
#include <hip/hip_cooperative_groups.h>
#include <cstdio>
#include <cstdint>
namespace cg = cooperative_groups;
namespace pg8 {
#define PG8_LAS __attribute__((address_space(3)))
typedef unsigned short bf16_t;
typedef short bf16x8 __attribute__((ext_vector_type(8)));
typedef float f32x4 __attribute__((ext_vector_type(4)));
typedef unsigned u32x4 __attribute__((ext_vector_type(4)));
typedef unsigned u32x2 __attribute__((ext_vector_type(2)));
constexpr int BM = 256, BK = 64, HALF = 128, HTB = HALF * BK * 2  , STAGE_BYTES = 8 * HTB, NXCD = 8, WGM = 8;

__host__ __device__ __forceinline__ int lds_byte(int r, int c) { const int st = (r >> 4) * 2 + (c >> 5), rr = r & 15, cc = c & 31, ob = rr * 64 + cc * 2; return st * 1024 + (ob ^ (((ob >> 9) & 1) << 5)); }
__host__ __device__ __forceinline__ void stage_rc(int b, int& R, int& C) { const int st = b / 1024, sb = b % 1024, swz = sb ^ (((sb >> 9) & 1) << 5); R = (st >> 1) * 16 + swz / 64; C = (st & 1) * 32 + (swz % 64) / 2; }
__host__ __device__ __forceinline__ int perm32(int rho) { const int n = rho >> 4, i = rho & 15; return 8 * (i >> 2) + 4 * n + (i & 3); }

struct Unit { int pm, pn; };
struct Gemm { const bf16_t* A; const bf16_t* Bt; int M, N, K; int arows; };

struct StaticOrder {
    int nM, nN, nwg, G, c;
    __host__ __device__ void init(int M, int N, int G_, int c_) { nM = M / BM; nN = N / BM; nwg = nM * nN; G = G_; c = c_; }
    __host__ __device__ bool next(int i, Unit& u) const {
        const long L = (long)i * G + c; if (L >= nwg) return false;
        int wgid = (int)L; { const int q = nwg / NXCD, r = nwg % NXCD, xcd = wgid % NXCD, off = wgid / NXCD; wgid = (xcd < r ? xcd * (q + 1) : r * (q + 1) + (xcd - r) * q) + off; }
        const int nig = WGM * nN, gid = wgid / nig, fm = gid * WGM, gsz = (nM - fm) < WGM ? (nM - fm) : WGM;
        u.pm = fm + ((wgid % nig) % gsz); u.pn = (wgid % nig) / gsz; return true;
    }
    __device__ __forceinline__ void a_ready(const Unit&) const {}
    __device__ __forceinline__ void done(const Unit&) const {}
};

__device__ __forceinline__ unsigned cvt_pk_bf16(float lo, float hi) { unsigned r; asm volatile("v_cvt_pk_bf16_f32 %0, %1, %2" : "=v"(r) : "v"(lo), "v"(hi)); return r; }
struct EpiScaleBf16 {
    static constexpr bool PERM = true, AFTER_DRAIN = false;
    bf16_t* O; int ldc; const float* part; PG8_LAS float* rsl;
    __device__ __forceinline__ void operator()(const f32x4 (&acc)[2][2][4][2], const Unit& u, int wr, int wc, int fr, int fq) const {
        { const int t = (wr * 4 + wc) * 64 + fq * 16 + fr;
          if (t < 256) { const f32x4* pp = (const f32x4*)(part + (size_t)(u.pm * BM + t) * 16); const f32x4 a = pp[0], b = pp[1], c = pp[2], d = pp[3];
              const f32x4 s4 = (a + b) + (c + d); const float ss = (s4[0] + s4[1]) + (s4[2] + s4[3]); rsl[t] = __builtin_amdgcn_rsqf(ss * (1.0f / 1024.0f) + 1e-6f); } }
        asm volatile("s_waitcnt lgkmcnt(0)" ::: "memory"); __builtin_amdgcn_s_barrier(); asm volatile("" ::: "memory");
        const int row0 = u.pm * BM + wr * 64 + fr; const int col0 = u.pn * BM + wc * 32 + 8 * fq;
#pragma unroll
        for (int ai = 0; ai < 2; ++ai)
#pragma unroll
            for (int m = 0; m < 4; ++m) { const int row = row0 + ai * HALF + m * 16;
                const float rs = rsl[ai * HALF + wr * 64 + m * 16 + fr];
                bf16_t* rowp = O + (size_t)row * ldc + col0;
#pragma unroll
                for (int bj = 0; bj < 2; ++bj) { const f32x4 v0 = acc[ai][bj][m][0] * rs, v1 = acc[ai][bj][m][1] * rs;
                    u32x4 w; w.x = cvt_pk_bf16(v0[0], v0[1]); w.y = cvt_pk_bf16(v0[2], v0[3]); w.z = cvt_pk_bf16(v1[0], v1[1]); w.w = cvt_pk_bf16(v1[2], v1[3]);
                    *(u32x4*)(rowp + bj * HALF) = w; } }
    }
};
struct EpiResid {
    static constexpr bool PERM = true, AFTER_DRAIN = false;
    const float* base; float* out; bf16_t* xb; float* part;
    __device__ __forceinline__ void operator()(const f32x4 (&acc)[2][2][4][2], const Unit& u, int wr, int wc, int fr, int fq) const {
        const int row0 = u.pm * BM + wr * 64 + fr; const int col0 = u.pn * BM + wc * 32 + 8 * fq;
        f32x4 pre[3][4];
#define PG8_RLOAD(g_) do { const size_t o_ = (size_t)(row0 + ((g_) >> 2) * HALF + ((g_) & 3) * 16) * 1024 + col0; \
            pre[(g_) % 3][0] = *(const f32x4*)(base + o_); pre[(g_) % 3][1] = *(const f32x4*)(base + o_ + 4); pre[(g_) % 3][2] = *(const f32x4*)(base + o_ + HALF); pre[(g_) % 3][3] = *(const f32x4*)(base + o_ + HALF + 4); } while (0)
        PG8_RLOAD(0); PG8_RLOAD(1);
#pragma unroll
        for (int g = 0; g < 8; ++g) { const int ai = g >> 2, m = g & 3;
            if (g + 2 < 8) PG8_RLOAD(g + 2);
            asm volatile("" ::: "memory");
            const int row = row0 + ai * HALF + m * 16; const size_t off = (size_t)row * 1024 + col0; float ss = 0.f;
#pragma unroll
            for (int bj = 0; bj < 2; ++bj) { const f32x4 v0 = acc[ai][bj][m][0] + pre[g % 3][2 * bj], v1 = acc[ai][bj][m][1] + pre[g % 3][2 * bj + 1];
                *(f32x4*)(out + off + bj * HALF) = v0; *(f32x4*)(out + off + bj * HALF + 4) = v1;
                ss += (v0[0] * v0[0] + v0[1] * v0[1]) + (v0[2] * v0[2] + v0[3] * v0[3]) + (v1[0] * v1[0] + v1[1] * v1[1]) + (v1[2] * v1[2] + v1[3] * v1[3]);
                u32x4 w; w.x = cvt_pk_bf16(v0[0], v0[1]); w.y = cvt_pk_bf16(v0[2], v0[3]); w.z = cvt_pk_bf16(v1[0], v1[1]); w.w = cvt_pk_bf16(v1[2], v1[3]);
                *(u32x4*)(xb + off + bj * HALF) = w; }
            ss += __shfl_xor(ss, 16); ss += __shfl_xor(ss, 32);
            if (fq == 0) part[(size_t)row * 16 + u.pn * 4 + wc] = ss;
            asm volatile("" ::: "memory"); }
#undef PG8_RLOAD
    }
};
#define PG8_DPP(oldv, srcv, ctrl) __builtin_bit_cast(float, __builtin_amdgcn_update_dpp(__builtin_bit_cast(int, (float)(oldv)), __builtin_bit_cast(int, (float)(srcv)), (ctrl), 0xf, 0xf, false))
struct EpiGate {
    static constexpr bool PERM = true, AFTER_DRAIN = false;
    bf16_t* Aout; const float* part; const float* fconv; PG8_LAS float* xch;
    __device__ __forceinline__ void operator()(f32x4 (&acc)[2][2][4][2], const Unit& u, int wr, int wc, int fr, int fq) const {
        PG8_LAS float* rsl = xch + 2048;
        { const int t = (wr * 4 + wc) * 64 + fq * 16 + fr;
          if (t < 256) { const int row = u.pm * 254 - 2 + t; const bool ok = row >= 0 && row < 16384; const int rc = ok ? row : 0;
              const f32x4* pp = (const f32x4*)(part + (size_t)rc * 16); const f32x4 a = pp[0], b = pp[1], c = pp[2], d = pp[3];
              const f32x4 s4 = (a + b) + (c + d); const float ss = (s4[0] + s4[1]) + (s4[2] + s4[3]);
              rsl[t] = ok ? __builtin_amdgcn_rsqf(ss * (1.0f / 1024.0f) + 1e-6f) : 0.f; } }
        asm volatile("s_waitcnt lgkmcnt(0)" ::: "memory"); __builtin_amdgcn_s_barrier(); asm volatile("" ::: "memory");
        const int ccol = wc * 32 + 8 * fq;
#pragma unroll
        for (int ai = 0; ai < 2; ++ai)
#pragma unroll
            for (int m = 0; m < 4; ++m) { const float rs = rsl[ai * HALF + wr * 64 + m * 16 + fr];
#pragma unroll
                for (int bj = 0; bj < 2; ++bj) { acc[ai][bj][m][0] *= rs; acc[ai][bj][m][1] *= rs; } }
        if (fr >= 14) {
#pragma unroll
            for (int ai = 0; ai < 2; ++ai)
#pragma unroll
                for (int bj = 0; bj < 2; ++bj)
#pragma unroll
                    for (int n = 0; n < 2; ++n) *(PG8_LAS f32x4*)(xch + ((2 * ai + wr) * 2 + (fr & 1)) * 256 + bj * HALF + ccol + 4 * n) = acc[ai][bj][3][n];
        }
        asm volatile("s_waitcnt lgkmcnt(0)" ::: "memory"); __builtin_amdgcn_s_barrier(); asm volatile("" ::: "memory");
        const int ch0 = u.pn * HALF + ccol;
#pragma unroll
        for (int ai = 0; ai < 2; ++ai) {
            const int grp = 2 * ai + wr;
#pragma unroll
            for (int n = 0; n < 2; ++n) {
                asm volatile("" ::: "memory");
                const float* fw = fconv + ch0 + 4 * n;
                const f32x4 wg0 = *(const f32x4*)(fw), wg1 = *(const f32x4*)(fw + 5632), wg2 = *(const f32x4*)(fw + 2 * 5632);
                const f32x4 wu0 = *(const f32x4*)(fw + 2816), wu1 = *(const f32x4*)(fw + 5632 + 2816), wu2 = *(const f32x4*)(fw + 2 * 5632 + 2816);
                f32x4 xpg = {0.f, 0.f, 0.f, 0.f}, xpu = {0.f, 0.f, 0.f, 0.f};
                if (grp > 0) { xpg = *(const PG8_LAS f32x4*)(xch + ((grp - 1) * 2 + (fr & 1)) * 256 + ccol + 4 * n); xpu = *(const PG8_LAS f32x4*)(xch + ((grp - 1) * 2 + (fr & 1)) * 256 + HALF + ccol + 4 * n); }
#pragma unroll
                for (int m = 0; m < 4; ++m) {
                    float o[4];
#pragma unroll
                    for (int j = 0; j < 4; ++j) {
                        const float xg = acc[ai][0][m][n][j], xu = acc[ai][1][m][n][j];
                        const float pg = m > 0 ? acc[ai][0][m > 0 ? m - 1 : 0][n][j] : xpg[j], pu = m > 0 ? acc[ai][1][m > 0 ? m - 1 : 0][n][j] : xpu[j];
                        const float g1 = PG8_DPP(PG8_DPP(0.f, pg, 0x121), xg, 0x111), g2 = PG8_DPP(PG8_DPP(0.f, pg, 0x122), xg, 0x112);
                        const float u1 = PG8_DPP(PG8_DPP(0.f, pu, 0x121), xu, 0x111), u2 = PG8_DPP(PG8_DPP(0.f, pu, 0x122), xu, 0x112);
                        const float Gv = wg0[j] * g2 + wg1[j] * g1 + wg2[j] * xg, Uv = wu0[j] * u2 + wu1[j] * u1 + wu2[j] * xu;
                        o[j] = Gv * __builtin_amdgcn_rcpf(1.0f + __expf(-Gv)) * Uv; }
                    const int r = ai * HALF + wr * 64 + m * 16 + fr, row = u.pm * 254 - 2 + r;
                    u32x2 w; w.x = cvt_pk_bf16(o[0], o[1]); w.y = cvt_pk_bf16(o[2], o[3]);
                    if (r >= 2 && row < 16384) *(u32x2*)(Aout + (size_t)row * 2816 + ch0 + 4 * n) = w; }
            }
        }
    }
};
template <class Epi, class Sched, bool ALIGN_EPI = false, bool SP2 = false>
__device__ __forceinline__ void gemm_phase(PG8_LAS unsigned char* lds, const Gemm g, const Sched& S, const Epi& E) {
    int tid = threadIdx.x; asm volatile("" : "+v"(tid));
    const int wid = __builtin_amdgcn_readfirstlane(tid >> 6), lane = tid & 63, wr = wid >> 2, wc = wid & 3, fr = lane & 15, fq = lane >> 4;
    const int K = g.K, nt = K / BK;
    unsigned voffA[2], voffB[2];
#pragma unroll
    for (int i = 0; i < 2; ++i) { int R, C; stage_rc(tid * 16 + i * 8192, R, C); const int Rb = Epi::PERM ? ((R & ~31) + perm32(R & 31)) : R;
        voffA[i] = (unsigned)(R * K + C) * 2u; voffB[i] = (unsigned)(Rb * K + C) * 2u; }
    const size_t kstep = (size_t)(BK * 2);
    const size_t hstep = (size_t)HALF * K * 2;
    const size_t tstep = 2 * hstep;
    const size_t tstepA = (size_t)g.arows * K * 2;
    const unsigned ldsw = (unsigned)wid * 1024u;
    const int aoff = lds_byte(wr * 64 + fr, fq * 8), boff = lds_byte(wc * 32 + fr, fq * 8);
#define PG8_SA(b, h) (((b) * 2 + (h)) * HTB)
#define PG8_SB(b, h) ((4 + (b) * 2 + (h)) * HTB)
#define PG8_STAGE(bufoff, gbase, voff) do { _Pragma("unroll") for (int _i = 0; _i < 2; ++_i) \
        __builtin_amdgcn_global_load_lds((const unsigned*)((const char*)(gbase) + (voff)[_i]), (PG8_LAS unsigned*)(lds + (bufoff) + ldsw + _i * 8192), 16, 0, 0); } while (0)
#define PG8_LDA(dst, b, h) do { _Pragma("unroll") for (int m = 0; m < 4; ++m) _Pragma("unroll") for (int k = 0; k < 2; ++k) dst[m][k] = *(const PG8_LAS bf16x8*)(lds + PG8_SA(b, h) + aoff + m * 2048 + k * 1024); } while (0)
#define PG8_LDB(dst, b, h) do { _Pragma("unroll") for (int n = 0; n < 2; ++n) _Pragma("unroll") for (int k = 0; k < 2; ++k) dst[n][k] = *(const PG8_LAS bf16x8*)(lds + PG8_SB(b, h) + boff + n * 2048 + k * 1024); } while (0)
#define PG8_MMA(ai, bj, At, Bt) do { __builtin_amdgcn_s_setprio(1); _Pragma("unroll") for (int m = 0; m < 4; ++m) _Pragma("unroll") for (int n = 0; n < 2; ++n) _Pragma("unroll") for (int k = 0; k < 2; ++k) \
        acc[ai][bj][m][n] = __builtin_amdgcn_mfma_f32_16x16x32_bf16(Bt[n][k], At[m][k], acc[ai][bj][m][n], 0, 0, 0); __builtin_amdgcn_s_setprio(0); } while (0)
#define PG8_WAIT_V(n) asm volatile("s_waitcnt vmcnt(" #n ")" ::: "memory")
#define PG8_WAIT_L(n) asm volatile("s_waitcnt lgkmcnt(" #n ")" ::: "memory")
#define PG8_BAR __builtin_amdgcn_s_barrier()
#define PG8_SCHED __builtin_amdgcn_sched_barrier(0)
    Unit cur, nxt; int ui = 0;
    if (!S.next(0, cur)) return;
    f32x4 acc[2][2][4][2];
#pragma unroll
    for (int a = 0; a < 2; ++a)
#pragma unroll
        for (int b = 0; b < 2; ++b)
#pragma unroll
            for (int m = 0; m < 4; ++m)
#pragma unroll
                for (int n = 0; n < 2; ++n) acc[a][b][m][n] = (f32x4){0.f, 0.f, 0.f, 0.f};
    bf16x8 At[4][2], B0[2][2], B1[2][2];
    const char* cA = (const char*)g.A + (size_t)cur.pm * tstepA; const char* cB = (const char*)g.Bt + (size_t)cur.pn * tstep;
    S.a_ready(cur);
    if constexpr (SP2) {
        PG8_STAGE(PG8_SB(0, 0), cB, voffB); PG8_STAGE(PG8_SB(0, 1), cB + hstep, voffB); PG8_STAGE(PG8_SA(0, 0), cA, voffA); PG8_STAGE(PG8_SA(0, 1), cA + hstep, voffA);
        if (wr == 1) PG8_BAR;
        PG8_WAIT_V(2); PG8_BAR;
        PG8_STAGE(PG8_SB(1, 0), cB + kstep, voffB); PG8_STAGE(PG8_SA(1, 0), cA + kstep, voffA); PG8_STAGE(PG8_SB(1, 1), cB + hstep + kstep, voffB);
        PG8_WAIT_V(6); PG8_BAR;
    } else {
        PG8_STAGE(PG8_SB(0, 0), cB, voffB); PG8_STAGE(PG8_SA(0, 0), cA, voffA); PG8_STAGE(PG8_SB(0, 1), cB + hstep, voffB); PG8_STAGE(PG8_SA(0, 1), cA + hstep, voffA);
        if (wr == 1) PG8_BAR;
        PG8_WAIT_V(4); PG8_BAR;
        PG8_STAGE(PG8_SB(1, 0), cB + kstep, voffB); PG8_STAGE(PG8_SA(1, 0), cA + kstep, voffA); PG8_STAGE(PG8_SB(1, 1), cB + hstep + kstep, voffB);
        PG8_WAIT_V(6); PG8_BAR;
    }
    for (;;) {
        const bool has_next = S.next(ui + 1, nxt);
        const char* nA = has_next ? (const char*)g.A + (size_t)nxt.pm * tstepA : cA; const char* nB = has_next ? (const char*)g.Bt + (size_t)nxt.pn * tstep : cB;
        for (int t = 0; t < nt; t += 2) {
            const bool last = (t == nt - 2);
            const char* a1 = cA + (size_t)(t + 1) * kstep;
            const char* a2 = last ? nA : cA + (size_t)(t + 2) * kstep; const char* b2 = last ? nB : cB + (size_t)(t + 2) * kstep;
            const char* a3 = a2 + kstep; const char* b3 = b2 + kstep;
            if (last && has_next) S.a_ready(nxt);
            if constexpr (SP2) {
            PG8_LDB(B0, 0, 0); PG8_LDB(B1, 0, 1); PG8_SCHED; PG8_LDA(At, 0, 0); PG8_STAGE(PG8_SA(1, 1), a1 + hstep, voffA);
            PG8_WAIT_V(8); PG8_WAIT_L(0); PG8_BAR; PG8_MMA(0, 0, At, B0); PG8_MMA(0, 1, At, B1); PG8_BAR; PG8_SCHED;
            PG8_LDA(At, 0, 1); PG8_STAGE(PG8_SB(0, 0), b2, voffB); PG8_STAGE(PG8_SB(0, 1), b2 + hstep, voffB); PG8_STAGE(PG8_SA(0, 0), a2, voffA);
            PG8_WAIT_V(8); PG8_WAIT_L(0); PG8_BAR; PG8_MMA(1, 0, At, B0); PG8_MMA(1, 1, At, B1); PG8_BAR; PG8_SCHED;
            PG8_LDB(B0, 1, 0); PG8_LDB(B1, 1, 1); PG8_SCHED; PG8_LDA(At, 1, 0); PG8_STAGE(PG8_SA(0, 1), a2 + hstep, voffA);
            PG8_WAIT_V(8); PG8_WAIT_L(0); PG8_BAR; PG8_MMA(0, 0, At, B0); PG8_MMA(0, 1, At, B1); PG8_BAR; PG8_SCHED;
            PG8_LDA(At, 1, 1); PG8_STAGE(PG8_SB(1, 0), b3, voffB); PG8_STAGE(PG8_SB(1, 1), b3 + hstep, voffB); PG8_STAGE(PG8_SA(1, 0), a3, voffA);
            PG8_WAIT_V(8); PG8_WAIT_L(0); PG8_BAR; PG8_MMA(1, 0, At, B0); PG8_MMA(1, 1, At, B1); PG8_BAR; PG8_SCHED;
            } else {
            PG8_LDB(B0, 0, 0); PG8_SCHED; PG8_LDA(At, 0, 0); PG8_STAGE(PG8_SA(1, 1), a1 + hstep, voffA);
            PG8_WAIT_L(8); PG8_BAR; PG8_WAIT_L(0); PG8_MMA(0, 0, At, B0); PG8_BAR; PG8_SCHED;
            PG8_LDB(B1, 0, 1); PG8_STAGE(PG8_SB(0, 0), b2, voffB);
            PG8_BAR; PG8_WAIT_L(0); PG8_MMA(0, 1, At, B1); PG8_BAR;
            PG8_LDA(At, 0, 1); PG8_STAGE(PG8_SA(0, 0), a2, voffA);
            PG8_BAR; PG8_WAIT_L(0); PG8_MMA(1, 0, At, B0); PG8_BAR; PG8_SCHED;
            PG8_STAGE(PG8_SB(0, 1), b2 + hstep, voffB);
            PG8_WAIT_V(6); PG8_BAR; PG8_MMA(1, 1, At, B1); PG8_BAR;
            PG8_LDB(B0, 1, 0); PG8_SCHED; PG8_LDA(At, 1, 0); PG8_STAGE(PG8_SA(0, 1), a2 + hstep, voffA);
            PG8_WAIT_L(8); PG8_BAR; PG8_WAIT_L(0); PG8_MMA(0, 0, At, B0); PG8_BAR; PG8_SCHED;
            PG8_LDB(B1, 1, 1); PG8_STAGE(PG8_SB(1, 0), b3, voffB);
            PG8_BAR; PG8_WAIT_L(0); PG8_MMA(0, 1, At, B1); PG8_BAR;
            PG8_LDA(At, 1, 1); PG8_STAGE(PG8_SA(1, 0), a3, voffA);
            PG8_BAR; PG8_WAIT_L(0); PG8_MMA(1, 0, At, B0); PG8_BAR; PG8_SCHED;
            PG8_STAGE(PG8_SB(1, 1), b3 + hstep, voffB);
            PG8_WAIT_V(6); PG8_BAR; PG8_MMA(1, 1, At, B1); PG8_BAR;
            }
        }
        if constexpr (ALIGN_EPI) { if (wr == 0) PG8_BAR; }
        if constexpr (!Epi::AFTER_DRAIN) { E(acc, cur, wr, wc, fr, fq); S.done(cur); }
        if (!has_next) break;
#pragma unroll
        for (int a = 0; a < 2; ++a)
#pragma unroll
            for (int b = 0; b < 2; ++b)
#pragma unroll
                for (int m = 0; m < 4; ++m)
#pragma unroll
                    for (int n = 0; n < 2; ++n) acc[a][b][m][n] = (f32x4){0.f, 0.f, 0.f, 0.f};
        cur = nxt; cA = nA; cB = nB; ++ui;
        if constexpr (ALIGN_EPI) { if (wr == 1) PG8_BAR; }
    }
    PG8_WAIT_V(0);
    if constexpr (!ALIGN_EPI) { if (wr == 0) PG8_BAR; }
    PG8_BAR;
    if constexpr (Epi::AFTER_DRAIN) { E.fused(acc, cur, wr, wc, fr, fq, lds, wid, lane); S.done(cur); }
#undef PG8_SA
#undef PG8_SB
#undef PG8_STAGE
#undef PG8_LDA
#undef PG8_LDB
#undef PG8_MMA
#undef PG8_WAIT_V
#undef PG8_WAIT_L
#undef PG8_BAR
#undef PG8_SCHED
}
}
constexpr int S = 16384, DM = 1024, DEPTH = 4, NIN = 2816, DFF = 2816, NUP = 5632;
constexpr float EPS = 1e-6f;
constexpr int NWAVES = 8, NTHR = 512;
constexpr size_t MiB = 1u << 20;
constexpr size_t WS_WIN = 1 * MiB, WS_WOUT = 23 * MiB, WS_WUP = 31 * MiB, WS_WDN = 75 * MiB;
constexpr size_t WS_PART = 97 * MiB;
constexpr size_t WS_XB = 98 * MiB + 4096;
constexpr size_t WS_P = 131 * MiB;
constexpr size_t WS_Y = 219 * MiB;
constexpr size_t WS_GU = 131 * MiB;
constexpr size_t WS_A = 219 * MiB;
constexpr size_t WS_END = 307 * MiB;
constexpr int LDS_BYTES = 147456;
#define LAS __attribute__((address_space(3)))
typedef unsigned short bf16;
typedef unsigned v4u __attribute__((ext_vector_type(4)));
typedef unsigned v2u __attribute__((ext_vector_type(2)));
typedef float f32x4 __attribute__((ext_vector_type(4)));
typedef float f32x16 __attribute__((ext_vector_type(16)));
typedef short bf16x8 __attribute__((ext_vector_type(8)));
#define LDS_WAIT() asm volatile("s_waitcnt lgkmcnt(0)" ::: "memory")
__device__ __forceinline__ unsigned pk2(float lo, float hi) { return pg8::cvt_pk_bf16(lo, hi); }
__device__ __forceinline__ float bflo(unsigned u) { return __uint_as_float(u << 16); }
__device__ __forceinline__ float bfhi(unsigned u) { return __uint_as_float(u & 0xffff0000u); }
__device__ __forceinline__ float bf1(bf16 v) { return __uint_as_float((unsigned)v << 16); }
#define WS_DPP(v, ctrl) __builtin_bit_cast(float, __builtin_amdgcn_update_dpp(0, __builtin_bit_cast(int, (float)(v)), (ctrl), 0xf, 0xf, true))
__device__ __forceinline__ float wave_sum(float v) {
    v += WS_DPP(v, 0xB1); v += WS_DPP(v, 0x4E); v += WS_DPP(v, 0x141); v += WS_DPP(v, 0x140);
    const int iv = __builtin_bit_cast(int, v);
    const float a = __builtin_bit_cast(float, __builtin_amdgcn_readlane(iv, 0)), b = __builtin_bit_cast(float, __builtin_amdgcn_readlane(iv, 16));
    const float c = __builtin_bit_cast(float, __builtin_amdgcn_readlane(iv, 32)), d = __builtin_bit_cast(float, __builtin_amdgcn_readlane(iv, 48));
    return (a + b) + (c + d);
}

__device__ __forceinline__ void cvt_item(const float* W, int K, int N, bf16* WT, const float* gain, int mode, LAS float* scr, int item, int lane) {
    const int nblk = N / 32, kb = item / nblk, nb = item % nblk, k0 = 64 * kb, n0 = 32 * nb;
    float wv[32];
#pragma unroll
    for (int i = 0; i < 32; ++i) { const int kk = 2 * i + (lane >> 5); wv[i] = W[(size_t)(k0 + kk) * N + n0 + (lane & 31)]; }
#pragma unroll
    for (int i = 0; i < 32; ++i) { const int kk = 2 * i + (lane >> 5); const float g = gain ? gain[k0 + kk] : 1.0f; scr[kk * 33 + (lane & 31)] = wv[i] * g; }
    LDS_WAIT(); asm volatile("" ::: "memory");
    const float cs = (mode == 1 && n0 >= 1280 && n0 < 1792) ? 0.125f * 1.4426950408889634f : 1.0f;
    int rb = n0;
    if (mode == 2) { rb = (n0 < DFF) ? 256 * (n0 / 128) + (n0 % 128) : 256 * ((n0 - DFF) / 128) + 128 + ((n0 - DFF) % 128); }
    const int c = lane & 7;
#pragma unroll
    for (int j = 0; j < 4; ++j) { const int n = (lane >> 3) + 8 * j; const LAS float* s = scr + (8 * c) * 33 + n;
        v4u o; o.x = pk2(s[0 * 33] * cs, s[1 * 33] * cs); o.y = pk2(s[2 * 33] * cs, s[3 * 33] * cs); o.z = pk2(s[4 * 33] * cs, s[5 * 33] * cs); o.w = pk2(s[6 * 33] * cs, s[7 * 33] * cs);
        *(v4u*)(WT + (size_t)(rb + n) * K + k0 + 8 * c) = o; }
    LDS_WAIT(); asm volatile("" ::: "memory");
}

typedef __attribute__((address_space(1))) unsigned gu32;
#define XB_TMO      128
#define XB_XCNT(j)  (256  + 64 * (j))
#define XB_XSUB(j)  (1280 + 64 * (j))
#define XB_XGEN(j)  (2304 + 64 * (j))
#define XB_TOP      3328
#define XB_TOPGEN   3392
#define XCD_BAR_WORDS 3456
#define XB_SPIN_CAP (1u << 18)

__device__ __forceinline__ unsigned xb_ld(unsigned* p)              { return __hip_atomic_load(p, __ATOMIC_RELAXED, __HIP_MEMORY_SCOPE_AGENT); }
__device__ __forceinline__ unsigned xb_add(unsigned* p, unsigned v) { return __hip_atomic_fetch_add(p, v, __ATOMIC_RELAXED, __HIP_MEMORY_SCOPE_AGENT); }
__device__ __forceinline__ unsigned xb_xcc_id() { return (unsigned)__builtin_amdgcn_s_getreg((3 << 11) | 20) & 0xFu; }
#define XB_SPIN(cond, bar) do { unsigned _sp = 0; while (cond) { __builtin_amdgcn_s_sleep(1); \
    if ((++_sp & 255u) == 0u) { if (xb_ld(&(bar)[XB_TMO])) break; if (_sp > XB_SPIN_CAP) { atomicAdd(&(bar)[XB_TMO], 1u); break; } } } } while (0)

struct XcdBarrier {
    unsigned* bar; unsigned x;
    volatile LAS unsigned* st;
};

__device__ __forceinline__ XcdBarrier xcd_barrier_post(unsigned* bar, volatile LAS unsigned* st) {
    XcdBarrier b; b.bar = bar; b.x = xb_xcc_id(); b.st = st;
    if (threadIdx.x == 0) (void)xb_add(&bar[XB_XCNT(b.x)], 1u);
    return b;
}
__device__ __forceinline__ void xcd_barrier_complete(unsigned* bar, unsigned x, unsigned& nloc, unsigned& nx) {
    const unsigned G = gridDim.x * gridDim.y * gridDim.z;
    unsigned sum, cnt, mine, sp = 0u;
    for (;;) {
        sum = 0u; cnt = 0u; mine = 0u;
#pragma unroll
        for (unsigned j = 0; j < 16; ++j) { const unsigned c = xb_ld(&bar[XB_XCNT(j)]); sum += c; cnt += (c > 0u) ? 1u : 0u; mine = (j == x) ? c : mine; }
        if (sum == G) break;
        __builtin_amdgcn_s_sleep(1);
        if ((++sp & 255u) == 0u) { if (xb_ld(&bar[XB_TMO])) break; if (sp > XB_SPIN_CAP) { atomicAdd(&bar[XB_TMO], 1u); break; } }
    }
    nloc = mine > 0u ? mine : 1u; nx = cnt > 0u ? cnt : 1u;
}

__device__ __forceinline__ void xcd_barrier(const XcdBarrier& b) {
    asm volatile("s_waitcnt vmcnt(0)" ::: "memory");
    __syncthreads();
    if (threadIdx.x == 0) {
        unsigned* bar = b.bar;
        __builtin_amdgcn_s_waitcnt(0);
        unsigned nloc = b.st[0], nx = b.st[1];
        if (nloc == 0u) { xcd_barrier_complete(bar, b.x, nloc, nx); b.st[0] = nloc; b.st[1] = nx; }
        const unsigned old = xb_add(&bar[XB_XSUB(b.x)], 1u);
        const unsigned gen = old / nloc;
        if (old + 1u == (gen + 1u) * nloc) {
            __builtin_amdgcn_fence(__ATOMIC_RELEASE, "agent");
            asm volatile("s_waitcnt vmcnt(0)" ::: "memory");
            const unsigned og = xb_add(&bar[XB_TOP], 1u);
            const unsigned tg = og / nx;
            if (og + 1u == (tg + 1u) * nx) xb_add(&bar[XB_TOPGEN], 1u);
            else XB_SPIN(xb_ld(&bar[XB_TOPGEN]) == tg, bar);
            __builtin_amdgcn_fence(__ATOMIC_ACQUIRE, "agent");
            xb_add(&bar[XB_XGEN(b.x)], 1u);
            asm volatile("s_waitcnt vmcnt(0)" ::: "memory");
        } else {
            XB_SPIN(xb_ld(&bar[XB_XGEN(b.x)]) == gen, bar);
            __builtin_amdgcn_fence(__ATOMIC_ACQUIRE, "agent");
            asm volatile("s_waitcnt vmcnt(0)" ::: "memory");
        }
    }
    __syncthreads();
}

struct Args { const float* in[14]; float* out; unsigned char* ws; };

__device__ __forceinline__ void norm_store_rows(const LAS float* tile, bf16* Y, int t0, int coff, int wave, int lane) {
#pragma unroll 2
    for (int i = 0; i < 8; ++i) { const int r = wave * 8 + i; const f32x4 v = *(const LAS f32x4*)(tile + r * 260 + lane * 4);
        const float ss = wave_sum((v[0] * v[0] + v[1] * v[1]) + (v[2] * v[2] + v[3] * v[3]));
        const float rs = __builtin_amdgcn_rsqf(ss * (1.0f / 256.0f) + EPS);
        v2u o; o.x = pk2(v[0] * rs, v[1] * rs); o.y = pk2(v[2] * rs, v[3] * rs);
        *(v2u*)(Y + (size_t)(t0 + r) * DM + coff + lane * 4) = o; }
}

__device__ __forceinline__ void mixer_unit(LAS unsigned char* lds, int unit, const bf16* P, bf16* Y, const float* conv_w, const float* sgu_norm, const float* sgu_w, const float* sgu_b, int tid, int wave, int lane) {
    const int t0 = unit * 64;
    asm volatile("" : "+v"(tid), "+v"(lane));
    LAS bf16* vnT = (LAS bf16*)lds;
    LAS float* tile = (LAS float*)(lds + 69632);
    LAS float* sm_ss = (LAS float*)(lds + 69632 + 66560);
    {
        const int hd = wave, r = lane & 31, h = lane >> 5;
        const int pr = (r & 0x13) | ((r & 4) << 1) | ((r & 8) >> 1);
        LAS bf16* Vt = (LAS bf16*)(lds + wave * 5120);
        bf16x8 atri[2];
#pragma unroll
        for (int sI = 0; sI < 2; ++sI) { v4u t;
            t.x = ((16 * sI + 8 * h + 0 > pr) ? 0x3F80u : 0u) | ((16 * sI + 8 * h + 1 > pr) ? 0x3F800000u : 0u); t.y = ((16 * sI + 8 * h + 2 > pr) ? 0x3F80u : 0u) | ((16 * sI + 8 * h + 3 > pr) ? 0x3F800000u : 0u);
            t.z = ((16 * sI + 8 * h + 4 > pr) ? 0x3F80u : 0u) | ((16 * sI + 8 * h + 5 > pr) ? 0x3F800000u : 0u); t.w = ((16 * sI + 8 * h + 6 > pr) ? 0x3F80u : 0u) | ((16 * sI + 8 * h + 7 > pr) ? 0x3F800000u : 0u);
            atri[sI] = __builtin_bit_cast(bf16x8, t); }
        f32x16 oacc[2][2];
        LAS bf16x8* Qs = (LAS bf16x8*)(lds + 40960 + wave * 8192);
#pragma unroll
        for (int ks = 0; ks < 4; ++ks) { Qs[ks * 64 + lane] = *(const bf16x8*)(P + (size_t)(t0 + r) * NIN + 1280 + hd * 64 + 16 * ks + 8 * h); Qs[(4 + ks) * 64 + lane] = *(const bf16x8*)(P + (size_t)(t0 + 32 + r) * NIN + 1280 + hd * 64 + 16 * ks + 8 * h); }
#pragma unroll
        for (int a = 0; a < 2; ++a)
#pragma unroll
            for (int b = 0; b < 2; ++b) oacc[a][b] = (f32x16){};
        float lsA = 0.f, lsB = 0.f; bool actA = true, actB = true;
        bf16x8 kfn[4]; v4u vvn[4];
        { const bf16* kp = P + (size_t)(t0 + 32 + pr) * NIN + 1792 + hd * 64 + 8 * h;
#pragma unroll
          for (int ks = 0; ks < 4; ++ks) kfn[ks] = *(const bf16x8*)(kp + 16 * ks);
#pragma unroll
          for (int i = 0; i < 4; ++i) vvn[i] = *(const v4u*)(P + (size_t)(t0 + 32 + (lane >> 3) + 8 * i) * NIN + 2304 + hd * 64 + 8 * (lane & 7)); }
#define SB_CHAIN(Z, O0, O1, LS, DIAGV) do { \
            f32x16 cin; float Lv[16]; \
            _Pragma("unroll") for (int jj = 0; jj < 16; ++jj) { const float zz = Z[jj]; const float ex = __builtin_amdgcn_exp2f(-fabsf(zz)); const float lsig = fminf(zz, 0.f) - __builtin_amdgcn_logf(1.0f + ex); \
                Lv[jj] = lsig - zz; cin[jj] = lsig + LS; } \
            if (DIAGV) { _Pragma("unroll") for (int jj = 0; jj < 16; ++jj) { const int keyl = 16 * (jj >> 3) + 8 * h + (jj & 7); Lv[jj] = (keyl < r) ? Lv[jj] : 0.f; } } \
            float rowsum = 0.f; unsigned lh[8], ll[8]; \
            _Pragma("unroll") for (int j = 0; j < 16; j += 2) { rowsum += Lv[j] + Lv[j + 1]; \
                const unsigned hp = pk2(Lv[j], Lv[j + 1]); lh[j >> 1] = hp; ll[j >> 1] = pk2(Lv[j] - bflo(hp), Lv[j + 1] - bfhi(hp)); } \
            const bf16x8 bh0 = __builtin_bit_cast(bf16x8, (v4u){lh[0], lh[1], lh[2], lh[3]}), bh1 = __builtin_bit_cast(bf16x8, (v4u){lh[4], lh[5], lh[6], lh[7]}); \
            const bf16x8 bl0 = __builtin_bit_cast(bf16x8, (v4u){ll[0], ll[1], ll[2], ll[3]}), bl1 = __builtin_bit_cast(bf16x8, (v4u){ll[4], ll[5], ll[6], ll[7]}); \
            f32x16 lw = __builtin_amdgcn_mfma_f32_32x32x16_bf16(atri[0], bh0, cin, 0, 0, 0); \
            lw = __builtin_amdgcn_mfma_f32_32x32x16_bf16(atri[1], bh1, lw, 0, 0, 0); \
            lw = __builtin_amdgcn_mfma_f32_32x32x16_bf16(atri[0], bl0, lw, 0, 0, 0); \
            lw = __builtin_amdgcn_mfma_f32_32x32x16_bf16(atri[1], bl1, lw, 0, 0, 0); \
            float wv[16]; \
            _Pragma("unroll") for (int jj = 0; jj < 16; ++jj) wv[jj] = __builtin_amdgcn_exp2f(lw[jj]); \
            if (DIAGV) { _Pragma("unroll") for (int jj = 0; jj < 16; ++jj) { const int keyl = 16 * (jj >> 3) + 8 * h + (jj & 7); wv[jj] = (keyl < r) ? wv[jj] : 0.f; } } \
            unsigned wp[8]; \
            _Pragma("unroll") for (int j = 0; j < 16; j += 2) wp[j >> 1] = pk2(wv[j], wv[j + 1]); \
            const bf16x8 w0 = __builtin_bit_cast(bf16x8, (v4u){wp[0], wp[1], wp[2], wp[3]}), w1 = __builtin_bit_cast(bf16x8, (v4u){wp[4], wp[5], wp[6], wp[7]}); \
            const LAS bf16* vr = Vt + r * 40 + 8 * h; \
            O0 = __builtin_amdgcn_mfma_f32_32x32x16_bf16(*(const LAS bf16x8*)(vr), w0, O0, 0, 0, 0); \
            O0 = __builtin_amdgcn_mfma_f32_32x32x16_bf16(*(const LAS bf16x8*)(vr + 16), w1, O0, 0, 0, 0); \
            O1 = __builtin_amdgcn_mfma_f32_32x32x16_bf16(*(const LAS bf16x8*)(vr + 32 * 40), w0, O1, 0, 0, 0); \
            O1 = __builtin_amdgcn_mfma_f32_32x32x16_bf16(*(const LAS bf16x8*)(vr + 32 * 40 + 16), w1, O1, 0, 0, 0); \
            LS += rowsum + __shfl_xor(rowsum, 32); } while (0)
        for (int k0 = t0 + 32;; k0 -= 32) {
            const bool doA = actA && (k0 <= t0);
            f32x16 zB = {}, zA = {};
            if (actB) {
#pragma unroll
                for (int ks = 0; ks < 4; ++ks) zB = __builtin_amdgcn_mfma_f32_32x32x16_bf16(kfn[ks], Qs[(4 + ks) * 64 + lane], zB, 0, 0, 0); }
            if (doA) {
#pragma unroll
                for (int ks = 0; ks < 4; ++ks) zA = __builtin_amdgcn_mfma_f32_32x32x16_bf16(kfn[ks], Qs[ks * 64 + lane], zA, 0, 0, 0); }
#pragma unroll
            for (int i = 0; i < 4; ++i) { const int key = (lane >> 3) + 8 * i, c = lane & 7; const v4u vv = vvn[i];
                LAS bf16* vd = Vt + (8 * c) * 40 + key;
                vd[0] = (bf16)(vv.x & 0xffffu); vd[40] = (bf16)(vv.x >> 16); vd[80] = (bf16)(vv.y & 0xffffu); vd[120] = (bf16)(vv.y >> 16);
                vd[160] = (bf16)(vv.z & 0xffffu); vd[200] = (bf16)(vv.z >> 16); vd[240] = (bf16)(vv.w & 0xffffu); vd[280] = (bf16)(vv.w >> 16); }
            if (k0 >= 32) { const bf16* kp = P + (size_t)(k0 - 32 + pr) * NIN + 1792 + hd * 64 + 8 * h;
#pragma unroll
                for (int ks = 0; ks < 4; ++ks) kfn[ks] = *(const bf16x8*)(kp + 16 * ks);
#pragma unroll
                for (int i = 0; i < 4; ++i) vvn[i] = *(const v4u*)(P + (size_t)(k0 - 32 + (lane >> 3) + 8 * i) * NIN + 2304 + hd * 64 + 8 * (lane & 7)); }
            if (actB) { const bool dg = (k0 == t0 + 32); SB_CHAIN(zB, oacc[1][0], oacc[1][1], lsB, dg);
                if (__builtin_amdgcn_ballot_w64(lsB > -150.1f) == 0ull) actB = false; }
            if (doA) { const bool dg = (k0 == t0); SB_CHAIN(zA, oacc[0][0], oacc[0][1], lsA, dg);
                if (__builtin_amdgcn_ballot_w64(lsA > -150.1f) == 0ull) actA = false; }
            if (k0 < 32 || !(actA || actB)) break;
        }
#undef SB_CHAIN
#pragma unroll
        for (int qh = 0; qh < 2; ++qh) { float ss = 0.f;
#pragma unroll
            for (int j = 0; j < 16; ++j) ss += oacc[qh][0][j] * oacc[qh][0][j] + oacc[qh][1][j] * oacc[qh][1][j];
            ss += __shfl_xor(ss, 32);
            if (h == 0) sm_ss[(32 * qh + r) * 8 + hd] = ss; }
        LDS_WAIT(); __syncthreads();
#pragma unroll
        for (int qh = 0; qh < 2; ++qh) {
            const f32x4 sa = *(const LAS f32x4*)(sm_ss + (32 * qh + r) * 8), sb = *(const LAS f32x4*)(sm_ss + (32 * qh + r) * 8 + 4);
            const float tot = ((sa[0] + sa[1]) + (sa[2] + sa[3])) + ((sb[0] + sb[1]) + (sb[2] + sb[3]));
            const float rs = __builtin_amdgcn_rsqf(tot * (1.0f / 512.0f) + EPS);
            bf16* yp = Y + (size_t)(t0 + 32 * qh + r) * DM + 512 + hd * 64 + 4 * h;
#pragma unroll
            for (int db = 0; db < 2; ++db)
#pragma unroll
                for (int g4 = 0; g4 < 4; ++g4) { const f32x16& o = oacc[qh][db]; v2u w; w.x = pk2(o[4 * g4 + 0] * rs, o[4 * g4 + 1] * rs); w.y = pk2(o[4 * g4 + 2] * rs, o[4 * g4 + 3] * rs);
                    *(v2u*)(yp + 32 * db + 8 * g4) = w; }
        }
    }
    {
        const int c8 = (tid & 31) * 8, rg = tid >> 5, tb = t0 + 4 * rg;
        v4u gb[4], gc[6], hc[6];
#pragma unroll
        for (int i = 0; i < 6; ++i) { const int t = tb - 2 + i; const bool ok = t >= 0; const bf16* rp = P + (size_t)(ok ? t : 0) * NIN;
            gc[i] = ok ? *(const v4u*)(rp + 256 + c8) : (v4u){0u, 0u, 0u, 0u}; hc[i] = ok ? *(const v4u*)(rp + 512 + c8) : (v4u){0u, 0u, 0u, 0u};
            if (i >= 2) gb[i - 2] = *(const v4u*)(rp + c8); }
        float w0[8], w1[8], w2[8];
        { const f32x4 a0 = *(const f32x4*)(conv_w + c8), a1 = *(const f32x4*)(conv_w + c8 + 4), b0 = *(const f32x4*)(conv_w + 256 + c8), b1 = *(const f32x4*)(conv_w + 256 + c8 + 4), d0 = *(const f32x4*)(conv_w + 512 + c8), d1 = *(const f32x4*)(conv_w + 512 + c8 + 4);
#pragma unroll
          for (int e = 0; e < 4; ++e) { w0[e] = a0[e]; w0[4 + e] = a1[e]; w1[e] = b0[e]; w1[4 + e] = b1[e]; w2[e] = d0[e]; w2[4 + e] = d1[e]; } }
        float pr_[6][8];
#pragma unroll
        for (int i = 0; i < 6; ++i) { const unsigned ga[4] = {gc[i].x, gc[i].y, gc[i].z, gc[i].w}, ha[4] = {hc[i].x, hc[i].y, hc[i].z, hc[i].w};
#pragma unroll
            for (int e = 0; e < 4; ++e) { pr_[i][2 * e] = bflo(ga[e]) * bflo(ha[e]); pr_[i][2 * e + 1] = bfhi(ga[e]) * bfhi(ha[e]); } }
#pragma unroll
        for (int i = 0; i < 4; ++i) { const unsigned ba[4] = {gb[i].x, gb[i].y, gb[i].z, gb[i].w}; float o[8];
#pragma unroll
            for (int e = 0; e < 4; ++e) { o[2 * e] = bflo(ba[e]) * (w0[2 * e] * pr_[i][2 * e] + w1[2 * e] * pr_[i + 1][2 * e] + w2[2 * e] * pr_[i + 2][2 * e]);
                o[2 * e + 1] = bfhi(ba[e]) * (w0[2 * e + 1] * pr_[i][2 * e + 1] + w1[2 * e + 1] * pr_[i + 1][2 * e + 1] + w2[2 * e + 1] * pr_[i + 2][2 * e + 1]); }
            LAS f32x4* tp = (LAS f32x4*)(tile + (4 * rg + i) * 260 + c8); tp[0] = (f32x4){o[0], o[1], o[2], o[3]}; tp[1] = (f32x4){o[4], o[5], o[6], o[7]}; }
    }
    LDS_WAIT(); __syncthreads();
    norm_store_rows(tile, Y, t0, 0, wave, lane);
    const int tc = t0 & ~127, dt = t0 - tc, ns = dt + 64;
    { v2u uu[16];
#pragma unroll
      for (int i = 0; i < 16; ++i) { const int s = wave + 8 * i; uu[i] = (s < ns) ? *(const v2u*)(P + (size_t)(tc + s) * NIN + 1024 + lane * 4) : (v2u){0u, 0u}; }
      const f32x4 g = *(const f32x4*)(sgu_norm + lane * 4);
#pragma unroll
      for (int i = 0; i < 16; ++i) { const int s = wave + 8 * i;
        if (s < ns) { const v2u u = uu[i];
        const float v0 = bflo(u.x), v1 = bfhi(u.x), v2 = bflo(u.y), v3 = bfhi(u.y);
        const float ss = wave_sum((v0 * v0 + v1 * v1) + (v2 * v2 + v3 * v3)); const float rs = __builtin_amdgcn_rsqf(ss * (1.0f / 256.0f) + EPS);
        const unsigned a = pk2(v0 * rs * g[0], v1 * rs * g[1]), b = pk2(v2 * rs * g[2], v3 * rs * g[3]);
        vnT[(lane * 4 + 0) * 136 + s] = (bf16)(a & 0xffffu); vnT[(lane * 4 + 1) * 136 + s] = (bf16)(a >> 16); vnT[(lane * 4 + 2) * 136 + s] = (bf16)(b & 0xffffu); vnT[(lane * 4 + 3) * 136 + s] = (bf16)(b >> 16); } } }
    LDS_WAIT(); __syncthreads();
    {
        const int h = wave >> 1, rh = wave & 1, r32 = lane & 31, hi = lane >> 5;
        const int tcl = dt + 32 * rh + r32;
        const float* wrow = sgu_w + ((size_t)h * 128 + tcl) * 128;
        f32x16 o0 = {}, o1 = {};
        const int nk = (dt + 32 * rh + 32) >> 4;
        f32x4 wa[8], wb[8];
#pragma unroll
        for (int ks = 0; ks < 8; ++ks) { const int s0 = ks * 16 + 8 * hi; if (ks < nk) { wa[ks] = *(const f32x4*)(wrow + s0); wb[ks] = *(const f32x4*)(wrow + s0 + 4); } else { wa[ks] = (f32x4){0.f, 0.f, 0.f, 0.f}; wb[ks] = wa[ks]; } }
#pragma unroll
        for (int ks = 0; ks < 8; ++ks) if (ks < nk) { const int s0 = ks * 16 + 8 * hi;
            float wv[8] = {wa[ks][0], wa[ks][1], wa[ks][2], wa[ks][3], wb[ks][0], wb[ks][1], wb[ks][2], wb[ks][3]};
#pragma unroll
            for (int i = 0; i < 8; ++i) wv[i] = (s0 + i <= tcl) ? wv[i] : 0.f;
            v4u ap; ap.x = pk2(wv[0], wv[1]); ap.y = pk2(wv[2], wv[3]); ap.z = pk2(wv[4], wv[5]); ap.w = pk2(wv[6], wv[7]);
            const bf16x8 af = __builtin_bit_cast(bf16x8, ap);
            const bf16x8 b0 = *(const LAS bf16x8*)(vnT + (h * 64 + r32) * 136 + s0), b1 = *(const LAS bf16x8*)(vnT + (h * 64 + 32 + r32) * 136 + s0);
            o0 = __builtin_amdgcn_mfma_f32_32x32x16_bf16(af, b0, o0, 0, 0, 0);
            o1 = __builtin_amdgcn_mfma_f32_32x32x16_bf16(af, b1, o1, 0, 0, 0); }
#pragma unroll
        for (int j = 0; j < 16; ++j) { const int rl = 32 * rh + (j & 3) + 8 * (j >> 2) + 4 * hi;
            const float bb = sgu_b[h * 128 + dt + rl]; const bf16* up = P + (size_t)(t0 + rl) * NIN + 768 + h * 64;
            tile[rl * 260 + h * 64 + r32] = bf1(up[r32]) * (o0[j] + bb);
            tile[rl * 260 + h * 64 + 32 + r32] = bf1(up[32 + r32]) * (o1[j] + bb); }
    }
    LDS_WAIT(); __syncthreads();
    norm_store_rows(tile, Y, t0, 256, wave, lane);
    LDS_WAIT(); __syncthreads();
}

__device__ __forceinline__ void ffn_gate_phase(const bf16* GU, bf16* A, const float* fconv, int hf, int gtid, int gthreads) {
    for (int it = gtid; it < 256 * 176; it += gthreads) { const int rb = it / 176, cgp = it % 176, pnl = cgp >> 4, cc = (cgp & 15) * 8, ch = 1408 * hf + 128 * pnl + cc;
        float wg[3][8], wu[3][8];
#pragma unroll
        for (int i = 0; i < 3; ++i) { const f32x4 a0 = *(const f32x4*)(fconv + (size_t)i * NUP + ch), a1 = *(const f32x4*)(fconv + (size_t)i * NUP + ch + 4), b0 = *(const f32x4*)(fconv + (size_t)i * NUP + DFF + ch), b1 = *(const f32x4*)(fconv + (size_t)i * NUP + DFF + ch + 4);
#pragma unroll
            for (int e = 0; e < 4; ++e) { wg[i][e] = a0[e]; wg[i][4 + e] = a1[e]; wu[i][e] = b0[e]; wu[i][4 + e] = b1[e]; } }
        float g2[8], g1[8], u2[8], u1[8];
#pragma unroll
        for (int e = 0; e < 8; ++e) { g2[e] = g1[e] = u2[e] = u1[e] = 0.f; }
        for (int r = -2; r < 64; ++r) { const int t = 64 * rb + r; float g0[8], u0[8];
            if (t >= 0) { const v4u gv = *(const v4u*)(GU + (size_t)t * NIN + 256 * pnl + cc), uv = *(const v4u*)(GU + (size_t)t * NIN + 256 * pnl + 128 + cc);
                g0[0] = bflo(gv.x); g0[1] = bfhi(gv.x); g0[2] = bflo(gv.y); g0[3] = bfhi(gv.y); g0[4] = bflo(gv.z); g0[5] = bfhi(gv.z); g0[6] = bflo(gv.w); g0[7] = bfhi(gv.w);
                u0[0] = bflo(uv.x); u0[1] = bfhi(uv.x); u0[2] = bflo(uv.y); u0[3] = bfhi(uv.y); u0[4] = bflo(uv.z); u0[5] = bfhi(uv.z); u0[6] = bflo(uv.w); u0[7] = bfhi(uv.w); }
            else {
#pragma unroll
                for (int e = 0; e < 8; ++e) { g0[e] = 0.f; u0[e] = 0.f; } }
            if (r >= 0) { float o[8];
#pragma unroll
                for (int e = 0; e < 8; ++e) { const float G = wg[0][e] * g2[e] + wg[1][e] * g1[e] + wg[2][e] * g0[e], U = wu[0][e] * u2[e] + wu[1][e] * u1[e] + wu[2][e] * u0[e];
                    o[e] = G * __builtin_amdgcn_rcpf(1.0f + __expf(-G)) * U; }
                v4u ov; ov.x = pk2(o[0], o[1]); ov.y = pk2(o[2], o[3]); ov.z = pk2(o[4], o[5]); ov.w = pk2(o[6], o[7]);
                *(v4u*)(A + (size_t)t * DFF + ch) = ov; }
#pragma unroll
            for (int e = 0; e < 8; ++e) { g2[e] = g1[e]; g1[e] = g0[e]; u2[e] = u1[e]; u1[e] = u0[e]; } }
    }
}
__global__ void __launch_bounds__(NTHR, 2) hybrid_fwd(Args args) {
    extern __shared__ __attribute__((aligned(16))) unsigned char lds_raw[];
    LAS unsigned char* lds = (LAS unsigned char*)lds_raw;
    cg::grid_group grid = cg::this_grid();
    volatile LAS unsigned* MISC = (volatile LAS unsigned*)(lds + LDS_BYTES - 64);
    if (threadIdx.x < 16) MISC[threadIdx.x] = 0u;
    __syncthreads();
    XcdBarrier xbar = xcd_barrier_post((unsigned*)args.ws, MISC);
    const int tid = threadIdx.x, lane = tid & 63, wave = __builtin_amdgcn_readfirstlane(tid >> 6);
    const int G = gridDim.x, bx = blockIdx.x;
    const int gw = bx * NWAVES + wave, NGW = G * NWAVES;
    unsigned char* ws = args.ws;
    const float* x_in = args.in[0]; const float* norm_mix = args.in[1]; const float* w_in = args.in[2]; const float* conv_w = args.in[3];
    const float* sgu_norm = args.in[4]; const float* sgu_w = args.in[5]; const float* sgu_b = args.in[6]; const float* out_norm = args.in[7];
    const float* w_out = args.in[8]; const float* norm_ffn = args.in[9]; const float* w_up = args.in[10]; const float* ffn_conv = args.in[11];
    const float* w_down = args.in[12]; const float* norm_final = args.in[13];
    float* xcur = args.out;
    bf16* Win_t = (bf16*)(ws + WS_WIN); bf16* Wout_t = (bf16*)(ws + WS_WOUT); bf16* Wup_t = (bf16*)(ws + WS_WUP); bf16* Wdn_t = (bf16*)(ws + WS_WDN);
    float* part = (float*)(ws + WS_PART); bf16* XB = (bf16*)(ws + WS_XB); bf16* P = (bf16*)(ws + WS_P); bf16* Y = (bf16*)(ws + WS_Y);
    bf16* GU = (bf16*)(ws + WS_GU); bf16* A = (bf16*)(ws + WS_A);

    {
        LAS float* scr = (LAS float*)(lds + wave * 16384);
        constexpr int I_IN = 16 * 88, I_OUT = 16 * 32, I_UP = 16 * 176, I_DN = 44 * 32, I_L = I_IN + I_OUT + I_UP + I_DN;
        for (int it = gw; it < DEPTH * I_L; it += NGW) { const int l = it / I_L; int r = it % I_L;
            if (r < I_IN) { cvt_item(w_in + (size_t)l * DM * NIN, DM, NIN, Win_t + (size_t)l * NIN * DM, norm_mix + l * DM, 1, scr, r, lane); continue; } r -= I_IN;
            if (r < I_OUT) { cvt_item(w_out + (size_t)l * DM * DM, DM, DM, Wout_t + (size_t)l * DM * DM, out_norm + l * DM, 0, scr, r, lane); continue; } r -= I_OUT;
            if (r < I_UP) { cvt_item(w_up + (size_t)l * DM * NUP, DM, NUP, Wup_t + (size_t)l * NUP * DM, norm_ffn + l * DM, 2, scr, r, lane); continue; } r -= I_UP;
            cvt_item(w_down + (size_t)l * DFF * DM, DFF, DM, Wdn_t + (size_t)l * DM * DFF, nullptr, 0, scr, r, lane); }
        for (int m = gw; m < S; m += NGW) { const f32x4* xr = (const f32x4*)(x_in + (size_t)m * DM) + lane; f32x4 v[4]; float ss = 0.f;
#pragma unroll
            for (int j = 0; j < 4; ++j) { v[j] = xr[64 * j]; ss += (v[j][0] * v[j][0] + v[j][1] * v[j][1]) + (v[j][2] * v[j][2] + v[j][3] * v[j][3]); }
            ss = wave_sum(ss);
            v2u* o8 = (v2u*)(XB + (size_t)m * DM) + lane;
#pragma unroll
            for (int j = 0; j < 4; ++j) { v2u o; o.x = pk2(v[j][0], v[j][1]); o.y = pk2(v[j][2], v[j][3]); o8[64 * j] = o; }
            if (lane < 16) part[(size_t)m * 16 + lane] = lane == 0 ? ss : 0.f; }
    }
    grid.sync();

    for (int l = 0; l < DEPTH; ++l) {
        { pg8::Gemm g{XB, Win_t + (size_t)l * NIN * DM, S, NIN, DM, 256}; pg8::StaticOrder So; So.init(S, NIN, G, bx);
          pg8::EpiScaleBf16 E{P, NIN, part, (LAS float*)(lds + 131072 + 8192)};
          pg8::gemm_phase<pg8::EpiScaleBf16, pg8::StaticOrder, true, true>(lds, g, So, E); }
        xcd_barrier(xbar);
        for (int u = bx; u < S / 64; u += G)
            mixer_unit(lds, u, P, Y, conv_w + l * 3 * 256, sgu_norm + l * 256, sgu_w + (size_t)l * 4 * 128 * 128, sgu_b + l * 4 * 128, tid, wave, lane);
        xcd_barrier(xbar);
        { pg8::Gemm g{Y, Wout_t + (size_t)l * DM * DM, S, DM, DM, 256}; pg8::StaticOrder So; So.init(S, DM, G, bx);
          pg8::EpiResid E{l == 0 ? x_in : xcur, xcur, XB, part};
          pg8::gemm_phase<pg8::EpiResid, pg8::StaticOrder, true, true>(lds, g, So, E); }
        xcd_barrier(xbar);
        { pg8::Gemm g{XB - 2 * DM, Wup_t + (size_t)l * NUP * DM, 65 * 256, NUP, DM, 254}; pg8::StaticOrder So; So.init(65 * 256, NUP, G, bx);
          pg8::EpiGate E{A, part, ffn_conv + (size_t)l * 3 * NUP, (LAS float*)(lds + 131072)};
          pg8::gemm_phase<pg8::EpiGate, pg8::StaticOrder, true, true>(lds, g, So, E); }
        xcd_barrier(xbar);
        { pg8::Gemm g{A, Wdn_t + (size_t)l * DM * DFF, S, DM, DFF, 256}; pg8::StaticOrder So; So.init(S, DM, G, bx);
          pg8::EpiResid E{xcur, xcur, XB, part};
          pg8::gemm_phase<pg8::EpiResid, pg8::StaticOrder, true, true>(lds, g, So, E); }
        xcd_barrier(xbar);
    }
    for (int m = gw; m < S; m += NGW) { f32x4* xr = (f32x4*)(xcur + (size_t)m * DM) + lane; f32x4 v[4]; float ss = 0.f;
#pragma unroll
        for (int j = 0; j < 4; ++j) { v[j] = xr[64 * j]; ss += (v[j][0] * v[j][0] + v[j][1] * v[j][1]) + (v[j][2] * v[j][2] + v[j][3] * v[j][3]); }
        const float rs = __builtin_amdgcn_rsqf(wave_sum(ss) * (1.0f / 1024.0f) + EPS);
#pragma unroll
        for (int j = 0; j < 4; ++j) { const f32x4 g = *((const f32x4*)norm_final + lane + 64 * j); xr[64 * j] = v[j] * rs * g; } }
}

extern "C" void kernel_launch(void* const* d_in, const int* in_sizes, int n_in, void* d_out, int out_size, void* d_ws, size_t ws_size, hipStream_t stream) {
    static int grid = 0;
    if (grid == 0) {
        if (n_in != 14 || out_size != S * DM || ws_size < WS_END) { fprintf(stderr, "kernel_launch: unexpected shapes / workspace (%d inputs, out %d, ws %zu)\n", n_in, out_size, ws_size); grid = -1; return; }
        int dev = 0, cus = 0, per_cu = 0;
        hipGetDevice(&dev); hipDeviceGetAttribute(&cus, hipDeviceAttributeMultiprocessorCount, dev);
        hipFuncSetAttribute((const void*)hybrid_fwd, hipFuncAttributeMaxDynamicSharedMemorySize, LDS_BYTES);
        hipOccupancyMaxActiveBlocksPerMultiprocessor(&per_cu, (const void*)hybrid_fwd, NTHR, LDS_BYTES);
        (void)hipGetLastError();
        if (per_cu < 1) per_cu = 1;
        grid = cus * 1;
    }
    if (grid < 0) return;
    hipMemsetAsync((unsigned char*)d_ws, 0, 16384, stream);
    hipMemsetAsync((unsigned char*)d_ws + WS_XB - 4096, 0, 4096, stream);
    Args a{};
    for (int i = 0; i < 14; ++i) a.in[i] = (const float*)d_in[i];
    a.out = (float*)d_out; a.ws = (unsigned char*)d_ws;
    void* kargs[] = {&a};
    hipError_t e = hipLaunchCooperativeKernel((const void*)hybrid_fwd, dim3(grid), dim3(NTHR), kargs, LDS_BYTES, stream);
    if (e != hipSuccess) fprintf(stderr, "cooperative launch failed: %s (grid %d)\n", hipGetErrorString(e), grid);
}
```

```cpp
#include <hip/hip_runtime.h>
#include <hip/hip_cooperative_groups.h>
#include <cstdio>
#include <cstdint>
namespace cg = cooperative_groups;
namespace pg8 {
#define PG8_LAS __attribute__((address_space(3)))
typedef unsigned short bf16_t;
typedef short bf16x8 __attribute__((ext_vector_type(8)));
typedef float f32x4 __attribute__((ext_vector_type(4)));
typedef unsigned u32x4 __attribute__((ext_vector_type(4)));
typedef unsigned u32x2 __attribute__((ext_vector_type(2)));
constexpr int BM = 256, BK = 64, HALF = 128, HTB = HALF * BK * 2  , STAGE_BYTES = 8 * HTB, NXCD = 8, WGM = 8;

__host__ __device__ __forceinline__ int lds_byte(int r, int c) { const int st = (r >> 4) * 2 + (c >> 5), rr = r & 15, cc = c & 31, ob = rr * 64 + cc * 2; return st * 1024 + (ob ^ (((ob >> 9) & 1) << 5)); }
__host__ __device__ __forceinline__ void stage_rc(int b, int& R, int& C) { const int st = b / 1024, sb = b % 1024, swz = sb ^ (((sb >> 9) & 1) << 5); R = (st >> 1) * 16 + swz / 64; C = (st & 1) * 32 + (swz % 64) / 2; }
__host__ __device__ __forceinline__ int perm32(int rho) { const int n = rho >> 4, i = rho & 15; return 8 * (i >> 2) + 4 * n + (i & 3); }

struct Unit { int pm, pn; };
struct Gemm { const bf16_t* A; const bf16_t* Bt; int M, N, K; int arows; };

struct StaticOrder {
    int nM, nN, nwg, G, c;
    __host__ __device__ void init(int M, int N, int G_, int c_) { nM = M / BM; nN = N / BM; nwg = nM * nN; G = G_; c = c_; }
    __host__ __device__ bool next(int i, Unit& u) const {
        const long L = (long)i * G + c; if (L >= nwg) return false;
        int wgid = (int)L; { const int q = nwg / NXCD, r = nwg % NXCD, xcd = wgid % NXCD, off = wgid / NXCD; wgid = (xcd < r ? xcd * (q + 1) : r * (q + 1) + (xcd - r) * q) + off; }
        const int nig = WGM * nN, gid = wgid / nig, fm = gid * WGM, gsz = (nM - fm) < WGM ? (nM - fm) : WGM;
        u.pm = fm + ((wgid % nig) % gsz); u.pn = (wgid % nig) / gsz; return true;
    }
    __device__ __forceinline__ void a_ready(const Unit&) const {}
    __device__ __forceinline__ void done(const Unit&) const {}
};

__device__ __forceinline__ unsigned cvt_pk_bf16(float lo, float hi) { unsigned r; asm volatile("v_cvt_pk_bf16_f32 %0, %1, %2" : "=v"(r) : "v"(lo), "v"(hi)); return r; }
struct EpiScaleBf16 {
    static constexpr bool PERM = true, AFTER_DRAIN = false;
    bf16_t* O; int ldc; const float* part; PG8_LAS float* rsl;
    __device__ __forceinline__ void operator()(const f32x4 (&acc)[2][2][4][2], const Unit& u, int wr, int wc, int fr, int fq) const {
        { const int t = (wr * 4 + wc) * 64 + fq * 16 + fr;
          if (t < 256) { const f32x4* pp = (const f32x4*)(part + (size_t)(u.pm * BM + t) * 16); const f32x4 a = pp[0], b = pp[1], c = pp[2], d = pp[3];
              const f32x4 s4 = (a + b) + (c + d); const float ss = (s4[0] + s4[1]) + (s4[2] + s4[3]); rsl[t] = __builtin_amdgcn_rsqf(ss * (1.0f / 1024.0f) + 1e-6f); } }
        asm volatile("s_waitcnt lgkmcnt(0)" ::: "memory"); __builtin_amdgcn_s_barrier(); asm volatile("" ::: "memory");
        const int row0 = u.pm * BM + wr * 64 + fr; const int col0 = u.pn * BM + wc * 32 + 8 * fq;
#pragma unroll
        for (int ai = 0; ai < 2; ++ai)
#pragma unroll
            for (int m = 0; m < 4; ++m) { const int row = row0 + ai * HALF + m * 16;
                const float rs = rsl[ai * HALF + wr * 64 + m * 16 + fr];
                bf16_t* rowp = O + (size_t)row * ldc + col0;
#pragma unroll
                for (int bj = 0; bj < 2; ++bj) { const f32x4 v0 = acc[ai][bj][m][0] * rs, v1 = acc[ai][bj][m][1] * rs;
                    u32x4 w; w.x = cvt_pk_bf16(v0[0], v0[1]); w.y = cvt_pk_bf16(v0[2], v0[3]); w.z = cvt_pk_bf16(v1[0], v1[1]); w.w = cvt_pk_bf16(v1[2], v1[3]);
                    *(u32x4*)(rowp + bj * HALF) = w; } }
    }
};
struct EpiResid {
    static constexpr bool PERM = true, AFTER_DRAIN = false;
    const float* base; float* out; bf16_t* xb; float* part;
    __device__ __forceinline__ void operator()(const f32x4 (&acc)[2][2][4][2], const Unit& u, int wr, int wc, int fr, int fq) const {
        const int row0 = u.pm * BM + wr * 64 + fr; const int col0 = u.pn * BM + wc * 32 + 8 * fq;
        f32x4 pre[3][4];
#define PG8_RLOAD(g_) do { const size_t o_ = (size_t)(row0 + ((g_) >> 2) * HALF + ((g_) & 3) * 16) * 1024 + col0; \
            pre[(g_) % 3][0] = *(const f32x4*)(base + o_); pre[(g_) % 3][1] = *(const f32x4*)(base + o_ + 4); pre[(g_) % 3][2] = *(const f32x4*)(base + o_ + HALF); pre[(g_) % 3][3] = *(const f32x4*)(base + o_ + HALF + 4); } while (0)
        PG8_RLOAD(0); PG8_RLOAD(1);
#pragma unroll
        for (int g = 0; g < 8; ++g) { const int ai = g >> 2, m = g & 3;
            if (g + 2 < 8) PG8_RLOAD(g + 2);
            asm volatile("" ::: "memory");
            const int row = row0 + ai * HALF + m * 16; const size_t off = (size_t)row * 1024 + col0; float ss = 0.f;
#pragma unroll
            for (int bj = 0; bj < 2; ++bj) { const f32x4 v0 = acc[ai][bj][m][0] + pre[g % 3][2 * bj], v1 = acc[ai][bj][m][1] + pre[g % 3][2 * bj + 1];
                *(f32x4*)(out + off + bj * HALF) = v0; *(f32x4*)(out + off + bj * HALF + 4) = v1;
                ss += (v0[0] * v0[0] + v0[1] * v0[1]) + (v0[2] * v0[2] + v0[3] * v0[3]) + (v1[0] * v1[0] + v1[1] * v1[1]) + (v1[2] * v1[2] + v1[3] * v1[3]);
                u32x4 w; w.x = cvt_pk_bf16(v0[0], v0[1]); w.y = cvt_pk_bf16(v0[2], v0[3]); w.z = cvt_pk_bf16(v1[0], v1[1]); w.w = cvt_pk_bf16(v1[2], v1[3]);
                *(u32x4*)(xb + off + bj * HALF) = w; }
            ss += __shfl_xor(ss, 16); ss += __shfl_xor(ss, 32);
            if (fq == 0) part[(size_t)row * 16 + u.pn * 4 + wc] = ss;
            asm volatile("" ::: "memory"); }
#undef PG8_RLOAD
    }
};
#define PG8_DPP(oldv, srcv, ctrl) __builtin_bit_cast(float, __builtin_amdgcn_update_dpp(__builtin_bit_cast(int, (float)(oldv)), __builtin_bit_cast(int, (float)(srcv)), (ctrl), 0xf, 0xf, false))
struct EpiGate {
    static constexpr bool PERM = true, AFTER_DRAIN = false;
    bf16_t* Aout; const float* part; const float* fconv; PG8_LAS float* xch;
    __device__ __forceinline__ void operator()(f32x4 (&acc)[2][2][4][2], const Unit& u, int wr, int wc, int fr, int fq) const {
        PG8_LAS float* rsl = xch + 2048;
        { const int t = (wr * 4 + wc) * 64 + fq * 16 + fr;
          if (t < 256) { const int row = u.pm * 254 - 2 + t; const bool ok = row >= 0 && row < 16384; const int rc = ok ? row : 0;
              const f32x4* pp = (const f32x4*)(part + (size_t)rc * 16); const f32x4 a = pp[0], b = pp[1], c = pp[2], d = pp[3];
              const f32x4 s4 = (a + b) + (c + d); const float ss = (s4[0] + s4[1]) + (s4[2] + s4[3]);
              rsl[t] = ok ? __builtin_amdgcn_rsqf(ss * (1.0f / 1024.0f) + 1e-6f) : 0.f; } }
        asm volatile("s_waitcnt lgkmcnt(0)" ::: "memory"); __builtin_amdgcn_s_barrier(); asm volatile("" ::: "memory");
        const int ccol = wc * 32 + 8 * fq;
#pragma unroll
        for (int ai = 0; ai < 2; ++ai)
#pragma unroll
            for (int m = 0; m < 4; ++m) { const float rs = rsl[ai * HALF + wr * 64 + m * 16 + fr];
#pragma unroll
                for (int bj = 0; bj < 2; ++bj) { acc[ai][bj][m][0] *= rs; acc[ai][bj][m][1] *= rs; } }
        if (fr >= 14) {
#pragma unroll
            for (int ai = 0; ai < 2; ++ai)
#pragma unroll
                for (int bj = 0; bj < 2; ++bj)
#pragma unroll
                    for (int n = 0; n < 2; ++n) *(PG8_LAS f32x4*)(xch + ((2 * ai + wr) * 2 + (fr & 1)) * 256 + bj * HALF + ccol + 4 * n) = acc[ai][bj][3][n];
        }
        asm volatile("s_waitcnt lgkmcnt(0)" ::: "memory"); __builtin_amdgcn_s_barrier(); asm volatile("" ::: "memory");
        const int ch0 = u.pn * HALF + ccol;
#pragma unroll
        for (int ai = 0; ai < 2; ++ai) {
            const int grp = 2 * ai + wr;
#pragma unroll
            for (int n = 0; n < 2; ++n) {
                asm volatile("" ::: "memory");
                const float* fw = fconv + ch0 + 4 * n;
                const f32x4 wg0 = *(const f32x4*)(fw), wg1 = *(const f32x4*)(fw + 5632), wg2 = *(const f32x4*)(fw + 2 * 5632);
                const f32x4 wu0 = *(const f32x4*)(fw + 2816), wu1 = *(const f32x4*)(fw + 5632 + 2816), wu2 = *(const f32x4*)(fw + 2 * 5632 + 2816);
                f32x4 xpg = {0.f, 0.f, 0.f, 0.f}, xpu = {0.f, 0.f, 0.f, 0.f};
                if (grp > 0) { xpg = *(const PG8_LAS f32x4*)(xch + ((grp - 1) * 2 + (fr & 1)) * 256 + ccol + 4 * n); xpu = *(const PG8_LAS f32x4*)(xch + ((grp - 1) * 2 + (fr & 1)) * 256 + HALF + ccol + 4 * n); }
#pragma unroll
                for (int m = 0; m < 4; ++m) {
                    float o[4];
#pragma unroll
                    for (int j = 0; j < 4; ++j) {
                        const float xg = acc[ai][0][m][n][j], xu = acc[ai][1][m][n][j];
                        const float pg = m > 0 ? acc[ai][0][m > 0 ? m - 1 : 0][n][j] : xpg[j], pu = m > 0 ? acc[ai][1][m > 0 ? m - 1 : 0][n][j] : xpu[j];
                        const float g1 = PG8_DPP(PG8_DPP(0.f, pg, 0x121), xg, 0x111), g2 = PG8_DPP(PG8_DPP(0.f, pg, 0x122), xg, 0x112);
                        const float u1 = PG8_DPP(PG8_DPP(0.f, pu, 0x121), xu, 0x111), u2 = PG8_DPP(PG8_DPP(0.f, pu, 0x122), xu, 0x112);
                        const float Gv = wg0[j] * g2 + wg1[j] * g1 + wg2[j] * xg, Uv = wu0[j] * u2 + wu1[j] * u1 + wu2[j] * xu;
                        o[j] = Gv * __builtin_amdgcn_rcpf(1.0f + __expf(-Gv)) * Uv; }
                    const int r = ai * HALF + wr * 64 + m * 16 + fr, row = u.pm * 254 - 2 + r;
                    u32x2 w; w.x = cvt_pk_bf16(o[0], o[1]); w.y = cvt_pk_bf16(o[2], o[3]);
                    if (r >= 2 && row < 16384) *(u32x2*)(Aout + (size_t)row * 2816 + ch0 + 4 * n) = w; }
            }
        }
    }
};
template <class Epi, class Sched, bool ALIGN_EPI = false, bool SP2 = false>
__device__ __forceinline__ void gemm_phase(PG8_LAS unsigned char* lds, const Gemm g, const Sched& S, const Epi& E) {
    int tid = threadIdx.x; asm volatile("" : "+v"(tid));
    const int wid = __builtin_amdgcn_readfirstlane(tid >> 6), lane = tid & 63, wr = wid >> 2, wc = wid & 3, fr = lane & 15, fq = lane >> 4;
    const int K = g.K, nt = K / BK;
    unsigned voffA[2], voffB[2];
#pragma unroll
    for (int i = 0; i < 2; ++i) { int R, C; stage_rc(tid * 16 + i * 8192, R, C); const int Rb = Epi::PERM ? ((R & ~31) + perm32(R & 31)) : R;
        voffA[i] = (unsigned)(R * K + C) * 2u; voffB[i] = (unsigned)(Rb * K + C) * 2u; }
    const size_t kstep = (size_t)(BK * 2);
    const size_t hstep = (size_t)HALF * K * 2;
    const size_t tstep = 2 * hstep;
    const size_t tstepA = (size_t)g.arows * K * 2;
    const unsigned ldsw = (unsigned)wid * 1024u;
    const int aoff = lds_byte(wr * 64 + fr, fq * 8), boff = lds_byte(wc * 32 + fr, fq * 8);
#define PG8_SA(b, h) (((b) * 2 + (h)) * HTB)
#define PG8_SB(b, h) ((4 + (b) * 2 + (h)) * HTB)
#define PG8_STAGE(bufoff, gbase, voff) do { _Pragma("unroll") for (int _i = 0; _i < 2; ++_i) \
        __builtin_amdgcn_global_load_lds((const unsigned*)((const char*)(gbase) + (voff)[_i]), (PG8_LAS unsigned*)(lds + (bufoff) + ldsw + _i * 8192), 16, 0, 0); } while (0)
#define PG8_LDA(dst, b, h) do { _Pragma("unroll") for (int m = 0; m < 4; ++m) _Pragma("unroll") for (int k = 0; k < 2; ++k) dst[m][k] = *(const PG8_LAS bf16x8*)(lds + PG8_SA(b, h) + aoff + m * 2048 + k * 1024); } while (0)
#define PG8_LDB(dst, b, h) do { _Pragma("unroll") for (int n = 0; n < 2; ++n) _Pragma("unroll") for (int k = 0; k < 2; ++k) dst[n][k] = *(const PG8_LAS bf16x8*)(lds + PG8_SB(b, h) + boff + n * 2048 + k * 1024); } while (0)
#define PG8_MMA(ai, bj, At, Bt) do { __builtin_amdgcn_s_setprio(1); _Pragma("unroll") for (int m = 0; m < 4; ++m) _Pragma("unroll") for (int n = 0; n < 2; ++n) _Pragma("unroll") for (int k = 0; k < 2; ++k) \
        acc[ai][bj][m][n] = __builtin_amdgcn_mfma_f32_16x16x32_bf16(Bt[n][k], At[m][k], acc[ai][bj][m][n], 0, 0, 0); __builtin_amdgcn_s_setprio(0); } while (0)
#define PG8_WAIT_V(n) asm volatile("s_waitcnt vmcnt(" #n ")" ::: "memory")
#define PG8_WAIT_L(n) asm volatile("s_waitcnt lgkmcnt(" #n ")" ::: "memory")
#define PG8_BAR __builtin_amdgcn_s_barrier()
#define PG8_SCHED __builtin_amdgcn_sched_barrier(0)
    Unit cur, nxt; int ui = 0;
    if (!S.next(0, cur)) return;
    f32x4 acc[2][2][4][2];
#pragma unroll
    for (int a = 0; a < 2; ++a)
#pragma unroll
        for (int b = 0; b < 2; ++b)
#pragma unroll
            for (int m = 0; m < 4; ++m)
#pragma unroll
                for (int n = 0; n < 2; ++n) acc[a][b][m][n] = (f32x4){0.f, 0.f, 0.f, 0.f};
    bf16x8 At[4][2], B0[2][2], B1[2][2];
    const char* cA = (const char*)g.A + (size_t)cur.pm * tstepA; const char* cB = (const char*)g.Bt + (size_t)cur.pn * tstep;
    S.a_ready(cur);
    if constexpr (SP2) {
        PG8_STAGE(PG8_SB(0, 0), cB, voffB); PG8_STAGE(PG8_SB(0, 1), cB + hstep, voffB); PG8_STAGE(PG8_SA(0, 0), cA, voffA); PG8_STAGE(PG8_SA(0, 1), cA + hstep, voffA);
        if (wr == 1) PG8_BAR;
        PG8_WAIT_V(2); PG8_BAR;
        PG8_STAGE(PG8_SB(1, 0), cB + kstep, voffB); PG8_STAGE(PG8_SA(1, 0), cA + kstep, voffA); PG8_STAGE(PG8_SB(1, 1), cB + hstep + kstep, voffB);
        PG8_WAIT_V(6); PG8_BAR;
    } else {
        PG8_STAGE(PG8_SB(0, 0), cB, voffB); PG8_STAGE(PG8_SA(0, 0), cA, voffA); PG8_STAGE(PG8_SB(0, 1), cB + hstep, voffB); PG8_STAGE(PG8_SA(0, 1), cA + hstep, voffA);
        if (wr == 1) PG8_BAR;
        PG8_WAIT_V(4); PG8_BAR;
        PG8_STAGE(PG8_SB(1, 0), cB + kstep, voffB); PG8_STAGE(PG8_SA(1, 0), cA + kstep, voffA); PG8_STAGE(PG8_SB(1, 1), cB + hstep + kstep, voffB);
        PG8_WAIT_V(6); PG8_BAR;
    }
    for (;;) {
        const bool has_next = S.next(ui + 1, nxt);
        const char* nA = has_next ? (const char*)g.A + (size_t)nxt.pm * tstepA : cA; const char* nB = has_next ? (const char*)g.Bt + (size_t)nxt.pn * tstep : cB;
        for (int t = 0; t < nt; t += 2) {
            const bool last = (t == nt - 2);
            const char* a1 = cA + (size_t)(t + 1) * kstep;
            const char* a2 = last ? nA : cA + (size_t)(t + 2) * kstep; const char* b2 = last ? nB : cB + (size_t)(t + 2) * kstep;
            const char* a3 = a2 + kstep; const char* b3 = b2 + kstep;
            if (last && has_next) S.a_ready(nxt);
            if constexpr (SP2) {
            PG8_LDB(B0, 0, 0); PG8_LDB(B1, 0, 1); PG8_SCHED; PG8_LDA(At, 0, 0); PG8_STAGE(PG8_SA(1, 1), a1 + hstep, voffA);
            PG8_WAIT_V(8); PG8_WAIT_L(0); PG8_BAR; PG8_MMA(0, 0, At, B0); PG8_MMA(0, 1, At, B1); PG8_BAR; PG8_SCHED;
            PG8_LDA(At, 0, 1); PG8_STAGE(PG8_SB(0, 0), b2, voffB); PG8_STAGE(PG8_SB(0, 1), b2 + hstep, voffB); PG8_STAGE(PG8_SA(0, 0), a2, voffA);
            PG8_WAIT_V(8); PG8_WAIT_L(0); PG8_BAR; PG8_MMA(1, 0, At, B0); PG8_MMA(1, 1, At, B1); PG8_BAR; PG8_SCHED;
            PG8_LDB(B0, 1, 0); PG8_LDB(B1, 1, 1); PG8_SCHED; PG8_LDA(At, 1, 0); PG8_STAGE(PG8_SA(0, 1), a2 + hstep, voffA);
            PG8_WAIT_V(8); PG8_WAIT_L(0); PG8_BAR; PG8_MMA(0, 0, At, B0); PG8_MMA(0, 1, At, B1); PG8_BAR; PG8_SCHED;
            PG8_LDA(At, 1, 1); PG8_STAGE(PG8_SB(1, 0), b3, voffB); PG8_STAGE(PG8_SB(1, 1), b3 + hstep, voffB); PG8_STAGE(PG8_SA(1, 0), a3, voffA);
            PG8_WAIT_V(8); PG8_WAIT_L(0); PG8_BAR; PG8_MMA(1, 0, At, B0); PG8_MMA(1, 1, At, B1); PG8_BAR; PG8_SCHED;
            } else {
            PG8_LDB(B0, 0, 0); PG8_SCHED; PG8_LDA(At, 0, 0); PG8_STAGE(PG8_SA(1, 1), a1 + hstep, voffA);
            PG8_WAIT_L(8); PG8_BAR; PG8_WAIT_L(0); PG8_MMA(0, 0, At, B0); PG8_BAR; PG8_SCHED;
            PG8_LDB(B1, 0, 1); PG8_STAGE(PG8_SB(0, 0), b2, voffB);
            PG8_BAR; PG8_WAIT_L(0); PG8_MMA(0, 1, At, B1); PG8_BAR;
            PG8_LDA(At, 0, 1); PG8_STAGE(PG8_SA(0, 0), a2, voffA);
            PG8_BAR; PG8_WAIT_L(0); PG8_MMA(1, 0, At, B0); PG8_BAR; PG8_SCHED;
            PG8_STAGE(PG8_SB(0, 1), b2 + hstep, voffB);
            PG8_WAIT_V(6); PG8_BAR; PG8_MMA(1, 1, At, B1); PG8_BAR;
            PG8_LDB(B0, 1, 0); PG8_SCHED; PG8_LDA(At, 1, 0); PG8_STAGE(PG8_SA(0, 1), a2 + hstep, voffA);
            PG8_WAIT_L(8); PG8_BAR; PG8_WAIT_L(0); PG8_MMA(0, 0, At, B0); PG8_BAR; PG8_SCHED;
            PG8_LDB(B1, 1, 1); PG8_STAGE(PG8_SB(1, 0), b3, voffB);
            PG8_BAR; PG8_WAIT_L(0); PG8_MMA(0, 1, At, B1); PG8_BAR;
            PG8_LDA(At, 1, 1); PG8_STAGE(PG8_SA(1, 0), a3, voffA);
            PG8_BAR; PG8_WAIT_L(0); PG8_MMA(1, 0, At, B0); PG8_BAR; PG8_SCHED;
            PG8_STAGE(PG8_SB(1, 1), b3 + hstep, voffB);
            PG8_WAIT_V(6); PG8_BAR; PG8_MMA(1, 1, At, B1); PG8_BAR;
            }
        }
        if constexpr (ALIGN_EPI) { if (wr == 0) PG8_BAR; }
        if constexpr (!Epi::AFTER_DRAIN) { E(acc, cur, wr, wc, fr, fq); S.done(cur); }
        if (!has_next) break;
#pragma unroll
        for (int a = 0; a < 2; ++a)
#pragma unroll
            for (int b = 0; b < 2; ++b)
#pragma unroll
                for (int m = 0; m < 4; ++m)
#pragma unroll
                    for (int n = 0; n < 2; ++n) acc[a][b][m][n] = (f32x4){0.f, 0.f, 0.f, 0.f};
        cur = nxt; cA = nA; cB = nB; ++ui;
        if constexpr (ALIGN_EPI) { if (wr == 1) PG8_BAR; }
    }
    PG8_WAIT_V(0);
    if constexpr (!ALIGN_EPI) { if (wr == 0) PG8_BAR; }
    PG8_BAR;
    if constexpr (Epi::AFTER_DRAIN) { E.fused(acc, cur, wr, wc, fr, fq, lds, wid, lane); S.done(cur); }
#undef PG8_SA
#undef PG8_SB
#undef PG8_STAGE
#undef PG8_LDA
#undef PG8_LDB
#undef PG8_MMA
#undef PG8_WAIT_V
#undef PG8_WAIT_L
#undef PG8_BAR
#undef PG8_SCHED
}
}
constexpr int S = 16384, DM = 1024, DEPTH = 4, NIN = 2816, DFF = 2816, NUP = 5632;
constexpr float EPS = 1e-6f;
constexpr int NWAVES = 8, NTHR = 512;
constexpr size_t MiB = 1u << 20;
constexpr size_t WS_WIN = 1 * MiB, WS_WOUT = 23 * MiB, WS_WUP = 31 * MiB, WS_WDN = 75 * MiB;
constexpr size_t WS_PART = 97 * MiB;
constexpr size_t WS_XB = 98 * MiB + 4096;
constexpr size_t WS_P = 131 * MiB;
constexpr size_t WS_Y = 219 * MiB;
constexpr size_t WS_GU = 131 * MiB;
constexpr size_t WS_A = 219 * MiB;
constexpr size_t WS_END = 307 * MiB;
constexpr int LDS_BYTES = 147456;
#define LAS __attribute__((address_space(3)))
typedef unsigned short bf16;
typedef unsigned v4u __attribute__((ext_vector_type(4)));
typedef unsigned v2u __attribute__((ext_vector_type(2)));
typedef float f32x4 __attribute__((ext_vector_type(4)));
typedef float f32x16 __attribute__((ext_vector_type(16)));
typedef short bf16x8 __attribute__((ext_vector_type(8)));
#define LDS_WAIT() asm volatile("s_waitcnt lgkmcnt(0)" ::: "memory")
__device__ __forceinline__ unsigned pk2(float lo, float hi) { return pg8::cvt_pk_bf16(lo, hi); }
__device__ __forceinline__ float bflo(unsigned u) { return __uint_as_float(u << 16); }
__device__ __forceinline__ float bfhi(unsigned u) { return __uint_as_float(u & 0xffff0000u); }
__device__ __forceinline__ float bf1(bf16 v) { return __uint_as_float((unsigned)v << 16); }
#define WS_DPP(v, ctrl) __builtin_bit_cast(float, __builtin_amdgcn_update_dpp(0, __builtin_bit_cast(int, (float)(v)), (ctrl), 0xf, 0xf, true))
__device__ __forceinline__ float wave_sum(float v) {
    v += WS_DPP(v, 0xB1); v += WS_DPP(v, 0x4E); v += WS_DPP(v, 0x141); v += WS_DPP(v, 0x140);
    const int iv = __builtin_bit_cast(int, v);
    const float a = __builtin_bit_cast(float, __builtin_amdgcn_readlane(iv, 0)), b = __builtin_bit_cast(float, __builtin_amdgcn_readlane(iv, 16));
    const float c = __builtin_bit_cast(float, __builtin_amdgcn_readlane(iv, 32)), d = __builtin_bit_cast(float, __builtin_amdgcn_readlane(iv, 48));
    return (a + b) + (c + d);
}

__device__ __forceinline__ void cvt_item(const float* W, int K, int N, bf16* WT, const float* gain, int mode, LAS float* scr, int item, int lane) {
    const int nblk = N / 32, kb = item / nblk, nb = item % nblk, k0 = 64 * kb, n0 = 32 * nb;
    float wv[32];
#pragma unroll
    for (int i = 0; i < 32; ++i) { const int kk = 2 * i + (lane >> 5); wv[i] = W[(size_t)(k0 + kk) * N + n0 + (lane & 31)]; }
#pragma unroll
    for (int i = 0; i < 32; ++i) { const int kk = 2 * i + (lane >> 5); const float g = gain ? gain[k0 + kk] : 1.0f; scr[kk * 33 + (lane & 31)] = wv[i] * g; }
    LDS_WAIT(); asm volatile("" ::: "memory");
    const float cs = (mode == 1 && n0 >= 1280 && n0 < 1792) ? 0.125f * 1.4426950408889634f : 1.0f;
    int rb = n0;
    if (mode == 2) { rb = (n0 < DFF) ? 256 * (n0 / 128) + (n0 % 128) : 256 * ((n0 - DFF) / 128) + 128 + ((n0 - DFF) % 128); }
    const int c = lane & 7;
#pragma unroll
    for (int j = 0; j < 4; ++j) { const int n = (lane >> 3) + 8 * j; const LAS float* s = scr + (8 * c) * 33 + n;
        v4u o; o.x = pk2(s[0 * 33] * cs, s[1 * 33] * cs); o.y = pk2(s[2 * 33] * cs, s[3 * 33] * cs); o.z = pk2(s[4 * 33] * cs, s[5 * 33] * cs); o.w = pk2(s[6 * 33] * cs, s[7 * 33] * cs);
        *(v4u*)(WT + (size_t)(rb + n) * K + k0 + 8 * c) = o; }
    LDS_WAIT(); asm volatile("" ::: "memory");
}

typedef __attribute__((address_space(1))) unsigned gu32;
#define XB_TMO      128
#define XB_XCNT(j)  (256  + 64 * (j))
#define XB_XSUB(j)  (1280 + 64 * (j))
#define XB_XGEN(j)  (2304 + 64 * (j))
#define XB_TOP      3328
#define XB_TOPGEN   3392
#define XCD_BAR_WORDS 3456
#define XB_SPIN_CAP (1u << 18)

__device__ __forceinline__ unsigned xb_ld(unsigned* p)              { return __hip_atomic_load(p, __ATOMIC_RELAXED, __HIP_MEMORY_SCOPE_AGENT); }
__device__ __forceinline__ unsigned xb_add(unsigned* p, unsigned v) { return __hip_atomic_fetch_add(p, v, __ATOMIC_RELAXED, __HIP_MEMORY_SCOPE_AGENT); }
__device__ __forceinline__ unsigned xb_xcc_id() { return (unsigned)__builtin_amdgcn_s_getreg((3 << 11) | 20) & 0xFu; }
#define XB_SPIN(cond, bar) do { unsigned _sp = 0; while (cond) { __builtin_amdgcn_s_sleep(1); \
    if ((++_sp & 255u) == 0u) { if (xb_ld(&(bar)[XB_TMO])) break; if (_sp > XB_SPIN_CAP) { atomicAdd(&(bar)[XB_TMO], 1u); break; } } } } while (0)

struct XcdBarrier {
    unsigned* bar; unsigned x;
    volatile LAS unsigned* st;
};

__device__ __forceinline__ XcdBarrier xcd_barrier_post(unsigned* bar, volatile LAS unsigned* st) {
    XcdBarrier b; b.bar = bar; b.x = xb_xcc_id(); b.st = st;
    if (threadIdx.x == 0) (void)xb_add(&bar[XB_XCNT(b.x)], 1u);
    return b;
}
__device__ __forceinline__ void xcd_barrier_complete(unsigned* bar, unsigned x, unsigned& nloc, unsigned& nx) {
    const unsigned G = gridDim.x * gridDim.y * gridDim.z;
    unsigned sum, cnt, mine, sp = 0u;
    for (;;) {
        sum = 0u; cnt = 0u; mine = 0u;
#pragma unroll
        for (unsigned j = 0; j < 16; ++j) { const unsigned c = xb_ld(&bar[XB_XCNT(j)]); sum += c; cnt += (c > 0u) ? 1u : 0u; mine = (j == x) ? c : mine; }
        if (sum == G) break;
        __builtin_amdgcn_s_sleep(1);
        if ((++sp & 255u) == 0u) { if (xb_ld(&bar[XB_TMO])) break; if (sp > XB_SPIN_CAP) { atomicAdd(&bar[XB_TMO], 1u); break; } }
    }
    nloc = mine > 0u ? mine : 1u; nx = cnt > 0u ? cnt : 1u;
}

__device__ __forceinline__ void xcd_barrier(const XcdBarrier& b) {
    asm volatile("s_waitcnt vmcnt(0)" ::: "memory");
    __syncthreads();
    if (threadIdx.x == 0) {
        unsigned* bar = b.bar;
        __builtin_amdgcn_s_waitcnt(0);
        unsigned nloc = b.st[0], nx = b.st[1];
        if (nloc == 0u) { xcd_barrier_complete(bar, b.x, nloc, nx); b.st[0] = nloc; b.st[1] = nx; }
        const unsigned old = xb_add(&bar[XB_XSUB(b.x)], 1u);
        const unsigned gen = old / nloc;
        if (old + 1u == (gen + 1u) * nloc) {
            __builtin_amdgcn_fence(__ATOMIC_RELEASE, "agent");
            asm volatile("s_waitcnt vmcnt(0)" ::: "memory");
            const unsigned og = xb_add(&bar[XB_TOP], 1u);
            const unsigned tg = og / nx;
            if (og + 1u == (tg + 1u) * nx) xb_add(&bar[XB_TOPGEN], 1u);
            else XB_SPIN(xb_ld(&bar[XB_TOPGEN]) == tg, bar);
            __builtin_amdgcn_fence(__ATOMIC_ACQUIRE, "agent");
            xb_add(&bar[XB_XGEN(b.x)], 1u);
            asm volatile("s_waitcnt vmcnt(0)" ::: "memory");
        } else {
            XB_SPIN(xb_ld(&bar[XB_XGEN(b.x)]) == gen, bar);
            __builtin_amdgcn_fence(__ATOMIC_ACQUIRE, "agent");
            asm volatile("s_waitcnt vmcnt(0)" ::: "memory");
        }
    }
    __syncthreads();
}

struct CvtSrc { const float *w_in, *w_out, *w_up, *w_down, *norm_mix, *out_norm, *norm_ffn; bf16 *Win_t, *Wout_t, *Wup_t, *Wdn_t; };
__device__ __forceinline__ void cvt_layer_item(const CvtSrc& c, int l, int r, LAS float* scr, int lane) {
    const float* W; bf16* WT; const float* gain; int K, N, mode;
    if (r < 1408) { W = c.w_in + (size_t)l * DM * NIN; K = DM; N = NIN; WT = c.Win_t + (size_t)l * NIN * DM; gain = c.norm_mix + l * DM; mode = 1; }
    else if (r < 1920) { r -= 1408; W = c.w_out + (size_t)l * DM * DM; K = DM; N = DM; WT = c.Wout_t + (size_t)l * DM * DM; gain = c.out_norm + l * DM; mode = 0; }
    else if (r < 4736) { r -= 1920; W = c.w_up + (size_t)l * DM * NUP; K = DM; N = NUP; WT = c.Wup_t + (size_t)l * NUP * DM; gain = c.norm_ffn + l * DM; mode = 2; }
    else { r -= 4736; W = c.w_down + (size_t)l * DFF * DM; K = DFF; N = DM; WT = c.Wdn_t + (size_t)l * DM * DFF; gain = nullptr; mode = 0; }
    cvt_item(W, K, N, WT, gain, mode, scr, r, lane);
}
__device__ __forceinline__ const float* ldptr(const volatile LAS unsigned* PT, int k) {
    const unsigned lo = __builtin_amdgcn_readfirstlane(PT[2 * k]), hi = __builtin_amdgcn_readfirstlane(PT[2 * k + 1]);
    return (const float*)(((unsigned long long)hi << 32) | lo);
}
struct Args { const float* in[14]; float* out; unsigned char* ws; };

__device__ __forceinline__ void norm_store_rows(const LAS float* tile, bf16* Y, int t0, int coff, int wave, int lane) {
#pragma unroll 2
    for (int i = 0; i < 8; ++i) { const int r = wave * 8 + i; const f32x4 v = *(const LAS f32x4*)(tile + r * 260 + lane * 4);
        const float ss = wave_sum((v[0] * v[0] + v[1] * v[1]) + (v[2] * v[2] + v[3] * v[3]));
        const float rs = __builtin_amdgcn_rsqf(ss * (1.0f / 256.0f) + EPS);
        v2u o; o.x = pk2(v[0] * rs, v[1] * rs); o.y = pk2(v[2] * rs, v[3] * rs);
        *(v2u*)(Y + (size_t)(t0 + r) * DM + coff + lane * 4) = o; }
}

__device__ __forceinline__ void mixer_unit(LAS unsigned char* lds, int unit, const bf16* P, bf16* Y, const float* conv_w, const float* sgu_norm, const float* sgu_w, const float* sgu_b, int tid, int wave, int lane) {
    const int t0 = unit * 64;
    asm volatile("" : "+v"(tid), "+v"(lane));
    LAS bf16* vnT = (LAS bf16*)lds;
    LAS float* tile = (LAS float*)(lds + 69632);
    LAS float* sm_ss = (LAS float*)(lds + 69632 + 66560);
    {
        const int hd = wave, r = lane & 31, h = lane >> 5;
        const int pr = (r & 0x13) | ((r & 4) << 1) | ((r & 8) >> 1);
        LAS bf16* Vt = (LAS bf16*)(lds + wave * 5120);
        bf16x8 atri[2];
#pragma unroll
        for (int sI = 0; sI < 2; ++sI) { v4u t;
            t.x = ((16 * sI + 8 * h + 0 > pr) ? 0x3F80u : 0u) | ((16 * sI + 8 * h + 1 > pr) ? 0x3F800000u : 0u); t.y = ((16 * sI + 8 * h + 2 > pr) ? 0x3F80u : 0u) | ((16 * sI + 8 * h + 3 > pr) ? 0x3F800000u : 0u);
            t.z = ((16 * sI + 8 * h + 4 > pr) ? 0x3F80u : 0u) | ((16 * sI + 8 * h + 5 > pr) ? 0x3F800000u : 0u); t.w = ((16 * sI + 8 * h + 6 > pr) ? 0x3F80u : 0u) | ((16 * sI + 8 * h + 7 > pr) ? 0x3F800000u : 0u);
            atri[sI] = __builtin_bit_cast(bf16x8, t); }
        f32x16 oacc[2][2];
        LAS bf16x8* Qs = (LAS bf16x8*)(lds + 40960 + wave * 8192);
#pragma unroll
        for (int ks = 0; ks < 4; ++ks) { Qs[ks * 64 + lane] = *(const bf16x8*)(P + (size_t)(t0 + r) * NIN + 1280 + hd * 64 + 16 * ks + 8 * h); Qs[(4 + ks) * 64 + lane] = *(const bf16x8*)(P + (size_t)(t0 + 32 + r) * NIN + 1280 + hd * 64 + 16 * ks + 8 * h); }
#pragma unroll
        for (int a = 0; a < 2; ++a)
#pragma unroll
            for (int b = 0; b < 2; ++b) oacc[a][b] = (f32x16){};
        float lsA = 0.f, lsB = 0.f; bool actA = true, actB = true;
        bf16x8 kfn[4]; v4u vvn[4];
        { const bf16* kp = P + (size_t)(t0 + 32 + pr) * NIN + 1792 + hd * 64 + 8 * h;
#pragma unroll
          for (int ks = 0; ks < 4; ++ks) kfn[ks] = *(const bf16x8*)(kp + 16 * ks);
#pragma unroll
          for (int i = 0; i < 4; ++i) vvn[i] = *(const v4u*)(P + (size_t)(t0 + 32 + (lane >> 3) + 8 * i) * NIN + 2304 + hd * 64 + 8 * (lane & 7)); }
#define SB_CHAIN(Z, O0, O1, LS, DIAGV) do { \
            f32x16 cin; float Lv[16]; \
            _Pragma("unroll") for (int jj = 0; jj < 16; ++jj) { const float zz = Z[jj]; const float ex = __builtin_amdgcn_exp2f(-fabsf(zz)); const float lsig = fminf(zz, 0.f) - __builtin_amdgcn_logf(1.0f + ex); \
                Lv[jj] = lsig - zz; cin[jj] = lsig + LS; } \
            if (DIAGV) { _Pragma("unroll") for (int jj = 0; jj < 16; ++jj) { const int keyl = 16 * (jj >> 3) + 8 * h + (jj & 7); Lv[jj] = (keyl < r) ? Lv[jj] : 0.f; } } \
            float rowsum = 0.f; unsigned lh[8], ll[8]; \
            _Pragma("unroll") for (int j = 0; j < 16; j += 2) { rowsum += Lv[j] + Lv[j + 1]; \
                const unsigned hp = pk2(Lv[j], Lv[j + 1]); lh[j >> 1] = hp; ll[j >> 1] = pk2(Lv[j] - bflo(hp), Lv[j + 1] - bfhi(hp)); } \
            const bf16x8 bh0 = __builtin_bit_cast(bf16x8, (v4u){lh[0], lh[1], lh[2], lh[3]}), bh1 = __builtin_bit_cast(bf16x8, (v4u){lh[4], lh[5], lh[6], lh[7]}); \
            const bf16x8 bl0 = __builtin_bit_cast(bf16x8, (v4u){ll[0], ll[1], ll[2], ll[3]}), bl1 = __builtin_bit_cast(bf16x8, (v4u){ll[4], ll[5], ll[6], ll[7]}); \
            f32x16 lw = __builtin_amdgcn_mfma_f32_32x32x16_bf16(atri[0], bh0, cin, 0, 0, 0); \
            lw = __builtin_amdgcn_mfma_f32_32x32x16_bf16(atri[1], bh1, lw, 0, 0, 0); \
            lw = __builtin_amdgcn_mfma_f32_32x32x16_bf16(atri[0], bl0, lw, 0, 0, 0); \
            lw = __builtin_amdgcn_mfma_f32_32x32x16_bf16(atri[1], bl1, lw, 0, 0, 0); \
            float wv[16]; \
            _Pragma("unroll") for (int jj = 0; jj < 16; ++jj) wv[jj] = __builtin_amdgcn_exp2f(lw[jj]); \
            if (DIAGV) { _Pragma("unroll") for (int jj = 0; jj < 16; ++jj) { const int keyl = 16 * (jj >> 3) + 8 * h + (jj & 7); wv[jj] = (keyl < r) ? wv[jj] : 0.f; } } \
            unsigned wp[8]; \
            _Pragma("unroll") for (int j = 0; j < 16; j += 2) wp[j >> 1] = pk2(wv[j], wv[j + 1]); \
            const bf16x8 w0 = __builtin_bit_cast(bf16x8, (v4u){wp[0], wp[1], wp[2], wp[3]}), w1 = __builtin_bit_cast(bf16x8, (v4u){wp[4], wp[5], wp[6], wp[7]}); \
            const LAS bf16* vr = Vt + r * 40 + 8 * h; \
            O0 = __builtin_amdgcn_mfma_f32_32x32x16_bf16(*(const LAS bf16x8*)(vr), w0, O0, 0, 0, 0); \
            O0 = __builtin_amdgcn_mfma_f32_32x32x16_bf16(*(const LAS bf16x8*)(vr + 16), w1, O0, 0, 0, 0); \
            O1 = __builtin_amdgcn_mfma_f32_32x32x16_bf16(*(const LAS bf16x8*)(vr + 32 * 40), w0, O1, 0, 0, 0); \
            O1 = __builtin_amdgcn_mfma_f32_32x32x16_bf16(*(const LAS bf16x8*)(vr + 32 * 40 + 16), w1, O1, 0, 0, 0); \
            LS += rowsum + __shfl_xor(rowsum, 32); } while (0)
        for (int k0 = t0 + 32;; k0 -= 32) {
            const bool doA = actA && (k0 <= t0);
            f32x16 zB = {}, zA = {};
            if (actB) {
#pragma unroll
                for (int ks = 0; ks < 4; ++ks) zB = __builtin_amdgcn_mfma_f32_32x32x16_bf16(kfn[ks], Qs[(4 + ks) * 64 + lane], zB, 0, 0, 0); }
            if (doA) {
#pragma unroll
                for (int ks = 0; ks < 4; ++ks) zA = __builtin_amdgcn_mfma_f32_32x32x16_bf16(kfn[ks], Qs[ks * 64 + lane], zA, 0, 0, 0); }
#pragma unroll
            for (int i = 0; i < 4; ++i) { const int key = (lane >> 3) + 8 * i, c = lane & 7; const v4u vv = vvn[i];
                LAS bf16* vd = Vt + (8 * c) * 40 + key;
                vd[0] = (bf16)(vv.x & 0xffffu); vd[40] = (bf16)(vv.x >> 16); vd[80] = (bf16)(vv.y & 0xffffu); vd[120] = (bf16)(vv.y >> 16);
                vd[160] = (bf16)(vv.z & 0xffffu); vd[200] = (bf16)(vv.z >> 16); vd[240] = (bf16)(vv.w & 0xffffu); vd[280] = (bf16)(vv.w >> 16); }
            if (k0 >= 32) { const bf16* kp = P + (size_t)(k0 - 32 + pr) * NIN + 1792 + hd * 64 + 8 * h;
#pragma unroll
                for (int ks = 0; ks < 4; ++ks) kfn[ks] = *(const bf16x8*)(kp + 16 * ks);
#pragma unroll
                for (int i = 0; i < 4; ++i) vvn[i] = *(const v4u*)(P + (size_t)(k0 - 32 + (lane >> 3) + 8 * i) * NIN + 2304 + hd * 64 + 8 * (lane & 7)); }
            if (actB) { const bool dg = (k0 == t0 + 32); SB_CHAIN(zB, oacc[1][0], oacc[1][1], lsB, dg);
                if (__builtin_amdgcn_ballot_w64(lsB > -150.1f) == 0ull) actB = false; }
            if (doA) { const bool dg = (k0 == t0); SB_CHAIN(zA, oacc[0][0], oacc[0][1], lsA, dg);
                if (__builtin_amdgcn_ballot_w64(lsA > -150.1f) == 0ull) actA = false; }
            if (k0 < 32 || !(actA || actB)) break;
        }
#undef SB_CHAIN
#pragma unroll
        for (int qh = 0; qh < 2; ++qh) { float ss = 0.f;
#pragma unroll
            for (int j = 0; j < 16; ++j) ss += oacc[qh][0][j] * oacc[qh][0][j] + oacc[qh][1][j] * oacc[qh][1][j];
            ss += __shfl_xor(ss, 32);
            if (h == 0) sm_ss[(32 * qh + r) * 8 + hd] = ss; }
        LDS_WAIT(); __syncthreads();
#pragma unroll
        for (int qh = 0; qh < 2; ++qh) {
            const f32x4 sa = *(const LAS f32x4*)(sm_ss + (32 * qh + r) * 8), sb = *(const LAS f32x4*)(sm_ss + (32 * qh + r) * 8 + 4);
            const float tot = ((sa[0] + sa[1]) + (sa[2] + sa[3])) + ((sb[0] + sb[1]) + (sb[2] + sb[3]));
            const float rs = __builtin_amdgcn_rsqf(tot * (1.0f / 512.0f) + EPS);
            bf16* yp = Y + (size_t)(t0 + 32 * qh + r) * DM + 512 + hd * 64 + 4 * h;
#pragma unroll
            for (int db = 0; db < 2; ++db)
#pragma unroll
                for (int g4 = 0; g4 < 4; ++g4) { const f32x16& o = oacc[qh][db]; v2u w; w.x = pk2(o[4 * g4 + 0] * rs, o[4 * g4 + 1] * rs); w.y = pk2(o[4 * g4 + 2] * rs, o[4 * g4 + 3] * rs);
                    *(v2u*)(yp + 32 * db + 8 * g4) = w; }
        }
    }
    {
        const int c8 = (tid & 31) * 8, rg = tid >> 5, tb = t0 + 4 * rg;
        v4u gb[4], gc[6], hc[6];
#pragma unroll
        for (int i = 0; i < 6; ++i) { const int t = tb - 2 + i; const bool ok = t >= 0; const bf16* rp = P + (size_t)(ok ? t : 0) * NIN;
            gc[i] = ok ? *(const v4u*)(rp + 256 + c8) : (v4u){0u, 0u, 0u, 0u}; hc[i] = ok ? *(const v4u*)(rp + 512 + c8) : (v4u){0u, 0u, 0u, 0u};
            if (i >= 2) gb[i - 2] = *(const v4u*)(rp + c8); }
        float w0[8], w1[8], w2[8];
        { const f32x4 a0 = *(const f32x4*)(conv_w + c8), a1 = *(const f32x4*)(conv_w + c8 + 4), b0 = *(const f32x4*)(conv_w + 256 + c8), b1 = *(const f32x4*)(conv_w + 256 + c8 + 4), d0 = *(const f32x4*)(conv_w + 512 + c8), d1 = *(const f32x4*)(conv_w + 512 + c8 + 4);
#pragma unroll
          for (int e = 0; e < 4; ++e) { w0[e] = a0[e]; w0[4 + e] = a1[e]; w1[e] = b0[e]; w1[4 + e] = b1[e]; w2[e] = d0[e]; w2[4 + e] = d1[e]; } }
        float pr_[6][8];
#pragma unroll
        for (int i = 0; i < 6; ++i) { const unsigned ga[4] = {gc[i].x, gc[i].y, gc[i].z, gc[i].w}, ha[4] = {hc[i].x, hc[i].y, hc[i].z, hc[i].w};
#pragma unroll
            for (int e = 0; e < 4; ++e) { pr_[i][2 * e] = bflo(ga[e]) * bflo(ha[e]); pr_[i][2 * e + 1] = bfhi(ga[e]) * bfhi(ha[e]); } }
#pragma unroll
        for (int i = 0; i < 4; ++i) { const unsigned ba[4] = {gb[i].x, gb[i].y, gb[i].z, gb[i].w}; float o[8];
#pragma unroll
            for (int e = 0; e < 4; ++e) { o[2 * e] = bflo(ba[e]) * (w0[2 * e] * pr_[i][2 * e] + w1[2 * e] * pr_[i + 1][2 * e] + w2[2 * e] * pr_[i + 2][2 * e]);
                o[2 * e + 1] = bfhi(ba[e]) * (w0[2 * e + 1] * pr_[i][2 * e + 1] + w1[2 * e + 1] * pr_[i + 1][2 * e + 1] + w2[2 * e + 1] * pr_[i + 2][2 * e + 1]); }
            LAS f32x4* tp = (LAS f32x4*)(tile + (4 * rg + i) * 260 + c8); tp[0] = (f32x4){o[0], o[1], o[2], o[3]}; tp[1] = (f32x4){o[4], o[5], o[6], o[7]}; }
    }
    LDS_WAIT(); __syncthreads();
    norm_store_rows(tile, Y, t0, 0, wave, lane);
    const int tc = t0 & ~127, dt = t0 - tc, ns = dt + 64;
    { v2u uu[16];
#pragma unroll
      for (int i = 0; i < 16; ++i) { const int s = wave + 8 * i; uu[i] = (s < ns) ? *(const v2u*)(P + (size_t)(tc + s) * NIN + 1024 + lane * 4) : (v2u){0u, 0u}; }
      const f32x4 g = *(const f32x4*)(sgu_norm + lane * 4);
#pragma unroll
      for (int i = 0; i < 16; ++i) { const int s = wave + 8 * i;
        if (s < ns) { const v2u u = uu[i];
        const float v0 = bflo(u.x), v1 = bfhi(u.x), v2 = bflo(u.y), v3 = bfhi(u.y);
        const float ss = wave_sum((v0 * v0 + v1 * v1) + (v2 * v2 + v3 * v3)); const float rs = __builtin_amdgcn_rsqf(ss * (1.0f / 256.0f) + EPS);
        const unsigned a = pk2(v0 * rs * g[0], v1 * rs * g[1]), b = pk2(v2 * rs * g[2], v3 * rs * g[3]);
        vnT[(lane * 4 + 0) * 136 + s] = (bf16)(a & 0xffffu); vnT[(lane * 4 + 1) * 136 + s] = (bf16)(a >> 16); vnT[(lane * 4 + 2) * 136 + s] = (bf16)(b & 0xffffu); vnT[(lane * 4 + 3) * 136 + s] = (bf16)(b >> 16); } } }
    LDS_WAIT(); __syncthreads();
    {
        const int h = wave >> 1, rh = wave & 1, r32 = lane & 31, hi = lane >> 5;
        const int tcl = dt + 32 * rh + r32;
        const float* wrow = sgu_w + ((size_t)h * 128 + tcl) * 128;
        f32x16 o0 = {}, o1 = {};
        const int nk = (dt + 32 * rh + 32) >> 4;
        f32x4 wa[8], wb[8];
#pragma unroll
        for (int ks = 0; ks < 8; ++ks) { const int s0 = ks * 16 + 8 * hi; if (ks < nk) { wa[ks] = *(const f32x4*)(wrow + s0); wb[ks] = *(const f32x4*)(wrow + s0 + 4); } else { wa[ks] = (f32x4){0.f, 0.f, 0.f, 0.f}; wb[ks] = wa[ks]; } }
#pragma unroll
        for (int ks = 0; ks < 8; ++ks) if (ks < nk) { const int s0 = ks * 16 + 8 * hi;
            float wv[8] = {wa[ks][0], wa[ks][1], wa[ks][2], wa[ks][3], wb[ks][0], wb[ks][1], wb[ks][2], wb[ks][3]};
#pragma unroll
            for (int i = 0; i < 8; ++i) wv[i] = (s0 + i <= tcl) ? wv[i] : 0.f;
            v4u ap; ap.x = pk2(wv[0], wv[1]); ap.y = pk2(wv[2], wv[3]); ap.z = pk2(wv[4], wv[5]); ap.w = pk2(wv[6], wv[7]);
            const bf16x8 af = __builtin_bit_cast(bf16x8, ap);
            const bf16x8 b0 = *(const LAS bf16x8*)(vnT + (h * 64 + r32) * 136 + s0), b1 = *(const LAS bf16x8*)(vnT + (h * 64 + 32 + r32) * 136 + s0);
            o0 = __builtin_amdgcn_mfma_f32_32x32x16_bf16(af, b0, o0, 0, 0, 0);
            o1 = __builtin_amdgcn_mfma_f32_32x32x16_bf16(af, b1, o1, 0, 0, 0); }
#pragma unroll
        for (int j = 0; j < 16; ++j) { const int rl = 32 * rh + (j & 3) + 8 * (j >> 2) + 4 * hi;
            const float bb = sgu_b[h * 128 + dt + rl]; const bf16* up = P + (size_t)(t0 + rl) * NIN + 768 + h * 64;
            tile[rl * 260 + h * 64 + r32] = bf1(up[r32]) * (o0[j] + bb);
            tile[rl * 260 + h * 64 + 32 + r32] = bf1(up[32 + r32]) * (o1[j] + bb); }
    }
    LDS_WAIT(); __syncthreads();
    norm_store_rows(tile, Y, t0, 256, wave, lane);
    LDS_WAIT(); __syncthreads();
}

__device__ __forceinline__ void ffn_gate_phase(const bf16* GU, bf16* A, const float* fconv, int hf, int gtid, int gthreads) {
    for (int it = gtid; it < 256 * 176; it += gthreads) { const int rb = it / 176, cgp = it % 176, pnl = cgp >> 4, cc = (cgp & 15) * 8, ch = 1408 * hf + 128 * pnl + cc;
        float wg[3][8], wu[3][8];
#pragma unroll
        for (int i = 0; i < 3; ++i) { const f32x4 a0 = *(const f32x4*)(fconv + (size_t)i * NUP + ch), a1 = *(const f32x4*)(fconv + (size_t)i * NUP + ch + 4), b0 = *(const f32x4*)(fconv + (size_t)i * NUP + DFF + ch), b1 = *(const f32x4*)(fconv + (size_t)i * NUP + DFF + ch + 4);
#pragma unroll
            for (int e = 0; e < 4; ++e) { wg[i][e] = a0[e]; wg[i][4 + e] = a1[e]; wu[i][e] = b0[e]; wu[i][4 + e] = b1[e]; } }
        float g2[8], g1[8], u2[8], u1[8];
#pragma unroll
        for (int e = 0; e < 8; ++e) { g2[e] = g1[e] = u2[e] = u1[e] = 0.f; }
        for (int r = -2; r < 64; ++r) { const int t = 64 * rb + r; float g0[8], u0[8];
            if (t >= 0) { const v4u gv = *(const v4u*)(GU + (size_t)t * NIN + 256 * pnl + cc), uv = *(const v4u*)(GU + (size_t)t * NIN + 256 * pnl + 128 + cc);
                g0[0] = bflo(gv.x); g0[1] = bfhi(gv.x); g0[2] = bflo(gv.y); g0[3] = bfhi(gv.y); g0[4] = bflo(gv.z); g0[5] = bfhi(gv.z); g0[6] = bflo(gv.w); g0[7] = bfhi(gv.w);
                u0[0] = bflo(uv.x); u0[1] = bfhi(uv.x); u0[2] = bflo(uv.y); u0[3] = bfhi(uv.y); u0[4] = bflo(uv.z); u0[5] = bfhi(uv.z); u0[6] = bflo(uv.w); u0[7] = bfhi(uv.w); }
            else {
#pragma unroll
                for (int e = 0; e < 8; ++e) { g0[e] = 0.f; u0[e] = 0.f; } }
            if (r >= 0) { float o[8];
#pragma unroll
                for (int e = 0; e < 8; ++e) { const float G = wg[0][e] * g2[e] + wg[1][e] * g1[e] + wg[2][e] * g0[e], U = wu[0][e] * u2[e] + wu[1][e] * u1[e] + wu[2][e] * u0[e];
                    o[e] = G * __builtin_amdgcn_rcpf(1.0f + __expf(-G)) * U; }
                v4u ov; ov.x = pk2(o[0], o[1]); ov.y = pk2(o[2], o[3]); ov.z = pk2(o[4], o[5]); ov.w = pk2(o[6], o[7]);
                *(v4u*)(A + (size_t)t * DFF + ch) = ov; }
#pragma unroll
            for (int e = 0; e < 8; ++e) { g2[e] = g1[e]; g1[e] = g0[e]; u2[e] = u1[e]; u1[e] = u0[e]; } }
    }
}
__global__ void __launch_bounds__(NTHR, 2) hybrid_fwd(Args args) {
    extern __shared__ __attribute__((aligned(16))) unsigned char lds_raw[];
    LAS unsigned char* lds = (LAS unsigned char*)lds_raw;
    cg::grid_group grid = cg::this_grid();
    volatile LAS unsigned* MISC = (volatile LAS unsigned*)(lds + LDS_BYTES - 64);
    volatile LAS unsigned* PT = (volatile LAS unsigned*)(lds + LDS_BYTES - 256);
    if (threadIdx.x < 16) MISC[threadIdx.x] = 0u;
    if (threadIdx.x == 0) {
#define PUTP(k) { const unsigned long long v_ = (unsigned long long)args.in[k]; PT[2 * (k)] = (unsigned)v_; PT[2 * (k) + 1] = (unsigned)(v_ >> 32); }
        PUTP(0) PUTP(1) PUTP(2) PUTP(3) PUTP(4) PUTP(5) PUTP(6) PUTP(7) PUTP(8) PUTP(9) PUTP(10) PUTP(11) PUTP(12) PUTP(13)
#undef PUTP
    }
    __syncthreads();
    XcdBarrier xbar = xcd_barrier_post((unsigned*)args.ws, MISC);
    const int tid = threadIdx.x, lane = tid & 63, wave = __builtin_amdgcn_readfirstlane(tid >> 6);
    const int G = gridDim.x, bx = blockIdx.x;
    const int gw = bx * NWAVES + wave, NGW = G * NWAVES;
    unsigned char* ws = args.ws;
#define INP(k) ldptr(PT, (k))
#define MAKE_CS() const CvtSrc cs{INP(2), INP(8), INP(10), INP(12), INP(1), INP(7), INP(9), Win_t, Wout_t, Wup_t, Wdn_t}
    float* xo = args.out;
#define PHASE_PTRS() unsigned char* w_ = ws; float* xcur = xo; asm volatile("" : "+s"(w_), "+s"(xcur)); \
    bf16* Win_t = (bf16*)(w_ + WS_WIN); bf16* Wout_t = (bf16*)(w_ + WS_WOUT); bf16* Wup_t = (bf16*)(w_ + WS_WUP); bf16* Wdn_t = (bf16*)(w_ + WS_WDN); \
    float* part = (float*)(w_ + WS_PART); bf16* XB = (bf16*)(w_ + WS_XB); bf16* P = (bf16*)(w_ + WS_P); bf16* Y = (bf16*)(w_ + WS_Y); bf16* A = (bf16*)(w_ + WS_A); \
    (void)Win_t; (void)Wout_t; (void)Wup_t; (void)Wdn_t; (void)part; (void)XB; (void)P; (void)Y; (void)A; (void)xcur

    for (int step = -1; step < 5 * DEPTH; ++step) {
        const int l = step < 0 ? 0 : step / 5, ph = step < 0 ? -1 : step % 5;
        int cvt_layer = -1, cvt_first = 0, cvt_n = 0, cvt_nu = 0;
        if (ph < 0) {
            PHASE_PTRS(); const float* x_in = INP(0);
            int gw_ = gw, lane_ = lane; asm volatile("" : "+s"(gw_), "+v"(lane_));
            for (int m = gw_; m < S; m += NGW) { const f32x4* xr = (const f32x4*)(x_in + (size_t)m * DM) + lane_; f32x4 v[4]; float ss = 0.f;
#pragma unroll
                for (int j = 0; j < 4; ++j) { v[j] = xr[64 * j]; ss += (v[j][0] * v[j][0] + v[j][1] * v[j][1]) + (v[j][2] * v[j][2] + v[j][3] * v[j][3]); }
                ss = wave_sum(ss);
                v2u* o8 = (v2u*)(XB + (size_t)m * DM) + lane_;
#pragma unroll
                for (int j = 0; j < 4; ++j) { v2u o; o.x = pk2(v[j][0], v[j][1]); o.y = pk2(v[j][2], v[j][3]); o8[64 * j] = o; }
                if (lane_ < 16) part[(size_t)m * 16 + lane_] = lane_ == 0 ? ss : 0.f; }
            cvt_layer = 0; cvt_first = 0; cvt_n = 6144; cvt_nu = 0;
        } else if (ph == 0) {
            PHASE_PTRS(); pg8::Gemm g{XB, Win_t + (size_t)l * NIN * DM, S, NIN, DM, 256}; pg8::StaticOrder So; So.init(S, NIN, G, bx);
            pg8::EpiScaleBf16 E{P, NIN, part, (LAS float*)(lds + 131072 + 8192)};
            pg8::gemm_phase<pg8::EpiScaleBf16, pg8::StaticOrder, true, true>(lds, g, So, E);
            if (l + 1 < DEPTH) { cvt_layer = l + 1; cvt_first = 0; cvt_n = 1920; cvt_nu = (S / 256) * (NIN / 256); }
        } else if (ph == 1) {
            PHASE_PTRS();
            for (int u = bx; u < S / 64; u += G)
                mixer_unit(lds, u, P, Y, INP(3) + l * 3 * 256, INP(4) + l * 256, INP(5) + (size_t)l * 4 * 128 * 128, INP(6) + l * 4 * 128, tid, wave, lane);
        } else if (ph == 2) {
            PHASE_PTRS(); pg8::Gemm g{Y, Wout_t + (size_t)l * DM * DM, S, DM, DM, 256}; pg8::StaticOrder So; So.init(S, DM, G, bx);
            pg8::EpiResid E{l == 0 ? INP(0) : (const float*)xcur, xcur, XB, part};
            pg8::gemm_phase<pg8::EpiResid, pg8::StaticOrder, true, true>(lds, g, So, E);
        } else if (ph == 3) {
            PHASE_PTRS(); pg8::Gemm g{XB - 2 * DM, Wup_t + (size_t)l * NUP * DM, 65 * 256, NUP, DM, 254}; pg8::StaticOrder So; So.init(65 * 256, NUP, G, bx);
            pg8::EpiGate E{A, part, INP(11) + (size_t)l * 3 * NUP, (LAS float*)(lds + 131072)};
            pg8::gemm_phase<pg8::EpiGate, pg8::StaticOrder, true, true>(lds, g, So, E);
            if (l + 1 < DEPTH) { cvt_layer = l + 1; cvt_first = 1920; cvt_n = 4224; cvt_nu = 65 * (NUP / 256); }
        } else {
            PHASE_PTRS(); pg8::Gemm g{A, Wdn_t + (size_t)l * DM * DFF, S, DM, DFF, 256}; pg8::StaticOrder So; So.init(S, DM, G, bx);
            pg8::EpiResid E{xcur, xcur, XB, part};
            pg8::gemm_phase<pg8::EpiResid, pg8::StaticOrder, true, true>(lds, g, So, E);
        }
        if (cvt_layer >= 0) {
            const int first_idle = cvt_nu > 0 ? cvt_nu - ((cvt_nu + G - 1) / G - 1) * G : 0; const bool some_idle = first_idle < G;
            if (!some_idle || bx >= first_idle) { const int nw = (some_idle ? G - first_idle : G) * NWAVES, iw = (some_idle ? bx - first_idle : bx) * NWAVES + wave;
                PHASE_PTRS(); LAS float* scr = (LAS float*)(lds + wave * 16384); int lane_ = lane; asm volatile("" : "+v"(lane_));
                MAKE_CS(); for (int it = iw; it < cvt_n; it += nw) cvt_layer_item(cs, cvt_layer, cvt_first + it, scr, lane_); } }
        if (step < 0) grid.sync(); else xcd_barrier(xbar);
    }
    const float* nfin = INP(13); float* xcur = xo;
    for (int m = gw; m < S; m += NGW) { f32x4* xr = (f32x4*)(xcur + (size_t)m * DM) + lane; f32x4 v[4]; float ss = 0.f;
#pragma unroll
        for (int j = 0; j < 4; ++j) { v[j] = xr[64 * j]; ss += (v[j][0] * v[j][0] + v[j][1] * v[j][1]) + (v[j][2] * v[j][2] + v[j][3] * v[j][3]); }
        const float rs = __builtin_amdgcn_rsqf(wave_sum(ss) * (1.0f / 1024.0f) + EPS);
#pragma unroll
        for (int j = 0; j < 4; ++j) { const f32x4 g = *((const f32x4*)nfin + lane + 64 * j); xr[64 * j] = v[j] * rs * g; } }
}

extern "C" void kernel_launch(void* const* d_in, const int* in_sizes, int n_in, void* d_out, int out_size, void* d_ws, size_t ws_size, hipStream_t stream) {
    static int grid = 0;
    if (grid == 0) {
        if (n_in != 14 || out_size != S * DM || ws_size < WS_END) { fprintf(stderr, "kernel_launch: unexpected shapes / workspace (%d inputs, out %d, ws %zu)\n", n_in, out_size, ws_size); grid = -1; return; }
        int dev = 0, cus = 0, per_cu = 0;
        hipGetDevice(&dev); hipDeviceGetAttribute(&cus, hipDeviceAttributeMultiprocessorCount, dev);
        hipFuncSetAttribute((const void*)hybrid_fwd, hipFuncAttributeMaxDynamicSharedMemorySize, LDS_BYTES);
        hipOccupancyMaxActiveBlocksPerMultiprocessor(&per_cu, (const void*)hybrid_fwd, NTHR, LDS_BYTES);
        (void)hipGetLastError();
        if (per_cu < 1) per_cu = 1;
        grid = cus * 1;
    }
    if (grid < 0) return;
    hipMemsetAsync((unsigned char*)d_ws, 0, 16384, stream);
    hipMemsetAsync((unsigned char*)d_ws + WS_XB - 4096, 0, 4096, stream);
    Args a{};
    for (int i = 0; i < 14; ++i) a.in[i] = (const float*)d_in[i];
    a.out = (float*)d_out; a.ws = (unsigned char*)d_ws;
    void* kargs[] = {&a};
    hipError_t e = hipLaunchCooperativeKernel((const void*)hybrid_fwd, dim3(grid), dim3(NTHR), kargs, LDS_BYTES, stream);
    if (e != hipSuccess) fprintf(stderr, "cooperative launch failed: %s (grid %d)\n", hipGetErrorString(e), grid);
}
```

```cpp
#include <hip/hip_runtime.h>
#include <hip/hip_cooperative_groups.h>
#include <cstdio>
#include <cstdint>
namespace cg = cooperative_groups;
namespace pg8 {
#define PG8_LAS __attribute__((address_space(3)))
typedef unsigned short bf16_t;
typedef short bf16x8 __attribute__((ext_vector_type(8)));
typedef float f32x4 __attribute__((ext_vector_type(4)));
typedef unsigned u32x4 __attribute__((ext_vector_type(4)));
typedef unsigned u32x2 __attribute__((ext_vector_type(2)));
constexpr int BM = 256, BK = 64, HALF = 128, HTB = HALF * BK * 2  , STAGE_BYTES = 8 * HTB, NXCD = 8, WGM = 8;

__host__ __device__ __forceinline__ int lds_byte(int r, int c) { const int st = (r >> 4) * 2 + (c >> 5), rr = r & 15, cc = c & 31, ob = rr * 64 + cc * 2; return st * 1024 + (ob ^ (((ob >> 9) & 1) << 5)); }
__host__ __device__ __forceinline__ void stage_rc(int b, int& R, int& C) { const int st = b / 1024, sb = b % 1024, swz = sb ^ (((sb >> 9) & 1) << 5); R = (st >> 1) * 16 + swz / 64; C = (st & 1) * 32 + (swz % 64) / 2; }
__host__ __device__ __forceinline__ int perm32(int rho) { const int n = rho >> 4, i = rho & 15; return 8 * (i >> 2) + 4 * n + (i & 3); }

struct Unit { int pm, pn; };
struct Gemm { const bf16_t* A; const bf16_t* Bt; int M, N, K; int arows; };

struct StaticOrder {
    int nM, nN, nwg, G, c;
    __host__ __device__ void init(int M, int N, int G_, int c_) { nM = M / BM; nN = N / BM; nwg = nM * nN; G = G_; c = c_; }
    __host__ __device__ bool next(int i, Unit& u) const {
        const long L = (long)i * G + c; if (L >= nwg) return false;
        int wgid = (int)L; { const int q = nwg / NXCD, r = nwg % NXCD, xcd = wgid % NXCD, off = wgid / NXCD; wgid = (xcd < r ? xcd * (q + 1) : r * (q + 1) + (xcd - r) * q) + off; }
        const int nig = WGM * nN, gid = wgid / nig, fm = gid * WGM, gsz = (nM - fm) < WGM ? (nM - fm) : WGM;
        u.pm = fm + ((wgid % nig) % gsz); u.pn = (wgid % nig) / gsz; return true;
    }
    __device__ __forceinline__ void a_ready(const Unit&) const {}
    __device__ __forceinline__ void done(const Unit&) const {}
};

__device__ __forceinline__ unsigned cvt_pk_bf16(float lo, float hi) { unsigned r; asm volatile("v_cvt_pk_bf16_f32 %0, %1, %2" : "=v"(r) : "v"(lo), "v"(hi)); return r; }
struct EpiScaleBf16 {
    static constexpr bool PERM = true, AFTER_DRAIN = false;
    bf16_t* O; int ldc; const float* part; PG8_LAS float* rsl;
    __device__ __forceinline__ void operator()(const f32x4 (&acc)[2][2][4][2], const Unit& u, int wr, int wc, int fr, int fq) const {
        { const int t = (wr * 4 + wc) * 64 + fq * 16 + fr;
          if (t < 256) { const f32x4* pp = (const f32x4*)(part + (size_t)(u.pm * BM + t) * 16); const f32x4 a = pp[0], b = pp[1], c = pp[2], d = pp[3];
              const f32x4 s4 = (a + b) + (c + d); const float ss = (s4[0] + s4[1]) + (s4[2] + s4[3]); rsl[t] = __builtin_amdgcn_rsqf(ss * (1.0f / 1024.0f) + 1e-6f); } }
        asm volatile("s_waitcnt lgkmcnt(0)" ::: "memory"); __builtin_amdgcn_s_barrier(); asm volatile("" ::: "memory");
        const int row0 = u.pm * BM + wr * 64 + fr; const int col0 = u.pn * BM + wc * 32 + 8 * fq;
#pragma unroll
        for (int ai = 0; ai < 2; ++ai)
#pragma unroll
            for (int m = 0; m < 4; ++m) { const int row = row0 + ai * HALF + m * 16;
                const float rs = rsl[ai * HALF + wr * 64 + m * 16 + fr];
                bf16_t* rowp = O + (size_t)row * ldc + col0;
#pragma unroll
                for (int bj = 0; bj < 2; ++bj) { const f32x4 v0 = acc[ai][bj][m][0] * rs, v1 = acc[ai][bj][m][1] * rs;
                    u32x4 w; w.x = cvt_pk_bf16(v0[0], v0[1]); w.y = cvt_pk_bf16(v0[2], v0[3]); w.z = cvt_pk_bf16(v1[0], v1[1]); w.w = cvt_pk_bf16(v1[2], v1[3]);
                    *(u32x4*)(rowp + bj * HALF) = w; } }
    }
};
struct EpiResid {
    static constexpr bool PERM = true, AFTER_DRAIN = false;
    bf16_t* xb; float* part;
    __device__ __forceinline__ void operator()(const f32x4 (&acc)[2][2][4][2], const Unit& u, int wr, int wc, int fr, int fq) const {
        const int row0 = u.pm * BM + wr * 64 + fr; const int col0 = u.pn * BM + wc * 32 + 8 * fq;
        u32x4 pre[3][2];
#define PG8_RLOAD(g_) do { const size_t o_ = (size_t)(row0 + ((g_) >> 2) * HALF + ((g_) & 3) * 16) * 1024 + col0; \
            pre[(g_) % 3][0] = *(const u32x4*)(xb + o_); pre[(g_) % 3][1] = *(const u32x4*)(xb + o_ + HALF); } while (0)
        PG8_RLOAD(0); PG8_RLOAD(1);
#pragma unroll
        for (int g = 0; g < 8; ++g) { const int ai = g >> 2, m = g & 3;
            if (g + 2 < 8) PG8_RLOAD(g + 2);
            asm volatile("" ::: "memory");
            const int row = row0 + ai * HALF + m * 16; const size_t off = (size_t)row * 1024 + col0; float ss = 0.f;
#pragma unroll
            for (int bj = 0; bj < 2; ++bj) { const u32x4 b = pre[g % 3][bj];
                const f32x4 b0 = {__uint_as_float(b.x << 16), __uint_as_float(b.x & 0xffff0000u), __uint_as_float(b.y << 16), __uint_as_float(b.y & 0xffff0000u)};
                const f32x4 b1 = {__uint_as_float(b.z << 16), __uint_as_float(b.z & 0xffff0000u), __uint_as_float(b.w << 16), __uint_as_float(b.w & 0xffff0000u)};
                const f32x4 v0 = acc[ai][bj][m][0] + b0, v1 = acc[ai][bj][m][1] + b1;
                ss += (v0[0] * v0[0] + v0[1] * v0[1]) + (v0[2] * v0[2] + v0[3] * v0[3]) + (v1[0] * v1[0] + v1[1] * v1[1]) + (v1[2] * v1[2] + v1[3] * v1[3]);
                u32x4 w; w.x = cvt_pk_bf16(v0[0], v0[1]); w.y = cvt_pk_bf16(v0[2], v0[3]); w.z = cvt_pk_bf16(v1[0], v1[1]); w.w = cvt_pk_bf16(v1[2], v1[3]);
                *(u32x4*)(xb + off + bj * HALF) = w; }
            ss += __shfl_xor(ss, 16); ss += __shfl_xor(ss, 32);
            if (fq == 0) part[(size_t)row * 16 + u.pn * 4 + wc] = ss;
            asm volatile("" ::: "memory"); }
#undef PG8_RLOAD
    }
};
#define PG8_DPP(oldv, srcv, ctrl) __builtin_bit_cast(float, __builtin_amdgcn_update_dpp(__builtin_bit_cast(int, (float)(oldv)), __builtin_bit_cast(int, (float)(srcv)), (ctrl), 0xf, 0xf, false))
struct EpiGate {
    static constexpr bool PERM = true, AFTER_DRAIN = false;
    bf16_t* Aout; const float* part; const float* fconv; PG8_LAS float* xch;
    __device__ __forceinline__ void operator()(f32x4 (&acc)[2][2][4][2], const Unit& u, int wr, int wc, int fr, int fq) const {
        PG8_LAS float* rsl = xch + 2048;
        { const int t = (wr * 4 + wc) * 64 + fq * 16 + fr;
          if (t < 256) { const int row = u.pm * 254 - 2 + t; const bool ok = row >= 0 && row < 16384; const int rc = ok ? row : 0;
              const f32x4* pp = (const f32x4*)(part + (size_t)rc * 16); const f32x4 a = pp[0], b = pp[1], c = pp[2], d = pp[3];
              const f32x4 s4 = (a + b) + (c + d); const float ss = (s4[0] + s4[1]) + (s4[2] + s4[3]);
              rsl[t] = ok ? __builtin_amdgcn_rsqf(ss * (1.0f / 1024.0f) + 1e-6f) : 0.f; } }
        asm volatile("s_waitcnt lgkmcnt(0)" ::: "memory"); __builtin_amdgcn_s_barrier(); asm volatile("" ::: "memory");
        const int ccol = wc * 32 + 8 * fq;
#pragma unroll
        for (int ai = 0; ai < 2; ++ai)
#pragma unroll
            for (int m = 0; m < 4; ++m) { const float rs = rsl[ai * HALF + wr * 64 + m * 16 + fr];
#pragma unroll
                for (int bj = 0; bj < 2; ++bj) { acc[ai][bj][m][0] *= rs; acc[ai][bj][m][1] *= rs; } }
        if (fr >= 14) {
#pragma unroll
            for (int ai = 0; ai < 2; ++ai)
#pragma unroll
                for (int bj = 0; bj < 2; ++bj)
#pragma unroll
                    for (int n = 0; n < 2; ++n) *(PG8_LAS f32x4*)(xch + ((2 * ai + wr) * 2 + (fr & 1)) * 256 + bj * HALF + ccol + 4 * n) = acc[ai][bj][3][n];
        }
        asm volatile("s_waitcnt lgkmcnt(0)" ::: "memory"); __builtin_amdgcn_s_barrier(); asm volatile("" ::: "memory");
        const int ch0 = u.pn * HALF + ccol;
#pragma unroll
        for (int ai = 0; ai < 2; ++ai) {
            const int grp = 2 * ai + wr;
#pragma unroll
            for (int n = 0; n < 2; ++n) {
                asm volatile("" ::: "memory");
                const float* fw = fconv + ch0 + 4 * n;
                const f32x4 wg0 = *(const f32x4*)(fw), wg1 = *(const f32x4*)(fw + 5632), wg2 = *(const f32x4*)(fw + 2 * 5632);
                const f32x4 wu0 = *(const f32x4*)(fw + 2816), wu1 = *(const f32x4*)(fw + 5632 + 2816), wu2 = *(const f32x4*)(fw + 2 * 5632 + 2816);
                f32x4 xpg = {0.f, 0.f, 0.f, 0.f}, xpu = {0.f, 0.f, 0.f, 0.f};
                if (grp > 0) { xpg = *(const PG8_LAS f32x4*)(xch + ((grp - 1) * 2 + (fr & 1)) * 256 + ccol + 4 * n); xpu = *(const PG8_LAS f32x4*)(xch + ((grp - 1) * 2 + (fr & 1)) * 256 + HALF + ccol + 4 * n); }
#pragma unroll
                for (int m = 0; m < 4; ++m) {
                    float o[4];
#pragma unroll
                    for (int j = 0; j < 4; ++j) {
                        const float xg = acc[ai][0][m][n][j], xu = acc[ai][1][m][n][j];
                        const float pg = m > 0 ? acc[ai][0][m > 0 ? m - 1 : 0][n][j] : xpg[j], pu = m > 0 ? acc[ai][1][m > 0 ? m - 1 : 0][n][j] : xpu[j];
                        const float g1 = PG8_DPP(PG8_DPP(0.f, pg, 0x121), xg, 0x111), g2 = PG8_DPP(PG8_DPP(0.f, pg, 0x122), xg, 0x112);
                        const float u1 = PG8_DPP(PG8_DPP(0.f, pu, 0x121), xu, 0x111), u2 = PG8_DPP(PG8_DPP(0.f, pu, 0x122), xu, 0x112);
                        const float Gv = wg0[j] * g2 + wg1[j] * g1 + wg2[j] * xg, Uv = wu0[j] * u2 + wu1[j] * u1 + wu2[j] * xu;
                        o[j] = Gv * __builtin_amdgcn_rcpf(1.0f + __expf(-Gv)) * Uv; }
                    const int r = ai * HALF + wr * 64 + m * 16 + fr, row = u.pm * 254 - 2 + r;
                    u32x2 w; w.x = cvt_pk_bf16(o[0], o[1]); w.y = cvt_pk_bf16(o[2], o[3]);
                    if (r >= 2 && row < 16384) *(u32x2*)(Aout + (size_t)row * 2816 + ch0 + 4 * n) = w; }
            }
        }
    }
};
template <class Epi, class Sched, bool ALIGN_EPI = false, bool SP2 = false>
__device__ __forceinline__ void gemm_phase(PG8_LAS unsigned char* lds, const Gemm g, const Sched& S, const Epi& E) {
    int tid = threadIdx.x; asm volatile("" : "+v"(tid));
    const int wid = __builtin_amdgcn_readfirstlane(tid >> 6), lane = tid & 63, wr = wid >> 2, wc = wid & 3, fr = lane & 15, fq = lane >> 4;
    const int K = g.K, nt = K / BK;
    unsigned voffA[2], voffB[2];
#pragma unroll
    for (int i = 0; i < 2; ++i) { int R, C; stage_rc(tid * 16 + i * 8192, R, C); const int Rb = Epi::PERM ? ((R & ~31) + perm32(R & 31)) : R;
        voffA[i] = (unsigned)(R * K + C) * 2u; voffB[i] = (unsigned)(Rb * K + C) * 2u; }
    const size_t kstep = (size_t)(BK * 2);
    const size_t hstep = (size_t)HALF * K * 2;
    const size_t tstep = 2 * hstep;
    const size_t tstepA = (size_t)g.arows * K * 2;
    const unsigned ldsw = (unsigned)wid * 1024u;
    const int aoff = lds_byte(wr * 64 + fr, fq * 8), boff = lds_byte(wc * 32 + fr, fq * 8);
#define PG8_SA(b, h) (((b) * 2 + (h)) * HTB)
#define PG8_SB(b, h) ((4 + (b) * 2 + (h)) * HTB)
#define PG8_STAGE(bufoff, gbase, voff) do { _Pragma("unroll") for (int _i = 0; _i < 2; ++_i) \
        __builtin_amdgcn_global_load_lds((const unsigned*)((const char*)(gbase) + (voff)[_i]), (PG8_LAS unsigned*)(lds + (bufoff) + ldsw + _i * 8192), 16, 0, 0); } while (0)
#define PG8_LDA(dst, b, h) do { _Pragma("unroll") for (int m = 0; m < 4; ++m) _Pragma("unroll") for (int k = 0; k < 2; ++k) dst[m][k] = *(const PG8_LAS bf16x8*)(lds + PG8_SA(b, h) + aoff + m * 2048 + k * 1024); } while (0)
#define PG8_LDB(dst, b, h) do { _Pragma("unroll") for (int n = 0; n < 2; ++n) _Pragma("unroll") for (int k = 0; k < 2; ++k) dst[n][k] = *(const PG8_LAS bf16x8*)(lds + PG8_SB(b, h) + boff + n * 2048 + k * 1024); } while (0)
#define PG8_MMA(ai, bj, At, Bt) do { __builtin_amdgcn_s_setprio(1); _Pragma("unroll") for (int m = 0; m < 4; ++m) _Pragma("unroll") for (int n = 0; n < 2; ++n) _Pragma("unroll") for (int k = 0; k < 2; ++k) \
        acc[ai][bj][m][n] = __builtin_amdgcn_mfma_f32_16x16x32_bf16(Bt[n][k], At[m][k], acc[ai][bj][m][n], 0, 0, 0); __builtin_amdgcn_s_setprio(0); } while (0)
#define PG8_WAIT_V(n) asm volatile("s_waitcnt vmcnt(" #n ")" ::: "memory")
#define PG8_WAIT_L(n) asm volatile("s_waitcnt lgkmcnt(" #n ")" ::: "memory")
#define PG8_BAR __builtin_amdgcn_s_barrier()
#define PG8_SCHED __builtin_amdgcn_sched_barrier(0)
    Unit cur, nxt; int ui = 0;
    if (!S.next(0, cur)) return;
    f32x4 acc[2][2][4][2];
#pragma unroll
    for (int a = 0; a < 2; ++a)
#pragma unroll
        for (int b = 0; b < 2; ++b)
#pragma unroll
            for (int m = 0; m < 4; ++m)
#pragma unroll
                for (int n = 0; n < 2; ++n) acc[a][b][m][n] = (f32x4){0.f, 0.f, 0.f, 0.f};
    bf16x8 At[4][2], B0[2][2], B1[2][2];
    const char* cA = (const char*)g.A + (size_t)cur.pm * tstepA; const char* cB = (const char*)g.Bt + (size_t)cur.pn * tstep;
    S.a_ready(cur);
    if constexpr (SP2) {
        PG8_STAGE(PG8_SB(0, 0), cB, voffB); PG8_STAGE(PG8_SB(0, 1), cB + hstep, voffB); PG8_STAGE(PG8_SA(0, 0), cA, voffA); PG8_STAGE(PG8_SA(0, 1), cA + hstep, voffA);
        if (wr == 1) PG8_BAR;
        PG8_WAIT_V(2); PG8_BAR;
        PG8_STAGE(PG8_SB(1, 0), cB + kstep, voffB); PG8_STAGE(PG8_SA(1, 0), cA + kstep, voffA); PG8_STAGE(PG8_SB(1, 1), cB + hstep + kstep, voffB);
        PG8_WAIT_V(6); PG8_BAR;
    } else {
        PG8_STAGE(PG8_SB(0, 0), cB, voffB); PG8_STAGE(PG8_SA(0, 0), cA, voffA); PG8_STAGE(PG8_SB(0, 1), cB + hstep, voffB); PG8_STAGE(PG8_SA(0, 1), cA + hstep, voffA);
        if (wr == 1) PG8_BAR;
        PG8_WAIT_V(4); PG8_BAR;
        PG8_STAGE(PG8_SB(1, 0), cB + kstep, voffB); PG8_STAGE(PG8_SA(1, 0), cA + kstep, voffA); PG8_STAGE(PG8_SB(1, 1), cB + hstep + kstep, voffB);
        PG8_WAIT_V(6); PG8_BAR;
    }
    for (;;) {
        const bool has_next = S.next(ui + 1, nxt);
        const char* nA = has_next ? (const char*)g.A + (size_t)nxt.pm * tstepA : cA; const char* nB = has_next ? (const char*)g.Bt + (size_t)nxt.pn * tstep : cB;
        for (int t = 0; t < nt; t += 2) {
            const bool last = (t == nt - 2);
            const char* a1 = cA + (size_t)(t + 1) * kstep;
            const char* a2 = last ? nA : cA + (size_t)(t + 2) * kstep; const char* b2 = last ? nB : cB + (size_t)(t + 2) * kstep;
            const char* a3 = a2 + kstep; const char* b3 = b2 + kstep;
            if (last && has_next) S.a_ready(nxt);
            if constexpr (SP2) {
            PG8_LDB(B0, 0, 0); PG8_LDB(B1, 0, 1); PG8_SCHED; PG8_LDA(At, 0, 0); PG8_STAGE(PG8_SA(1, 1), a1 + hstep, voffA);
            PG8_WAIT_V(8); PG8_WAIT_L(0); PG8_BAR; PG8_MMA(0, 0, At, B0); PG8_MMA(0, 1, At, B1); PG8_BAR; PG8_SCHED;
            PG8_LDA(At, 0, 1); PG8_STAGE(PG8_SB(0, 0), b2, voffB); PG8_STAGE(PG8_SB(0, 1), b2 + hstep, voffB); PG8_STAGE(PG8_SA(0, 0), a2, voffA);
            PG8_WAIT_V(8); PG8_WAIT_L(0); PG8_BAR; PG8_MMA(1, 0, At, B0); PG8_MMA(1, 1, At, B1); PG8_BAR; PG8_SCHED;
            PG8_LDB(B0, 1, 0); PG8_LDB(B1, 1, 1); PG8_SCHED; PG8_LDA(At, 1, 0); PG8_STAGE(PG8_SA(0, 1), a2 + hstep, voffA);
            PG8_WAIT_V(8); PG8_WAIT_L(0); PG8_BAR; PG8_MMA(0, 0, At, B0); PG8_MMA(0, 1, At, B1); PG8_BAR; PG8_SCHED;
            PG8_LDA(At, 1, 1); PG8_STAGE(PG8_SB(1, 0), b3, voffB); PG8_STAGE(PG8_SB(1, 1), b3 + hstep, voffB); PG8_STAGE(PG8_SA(1, 0), a3, voffA);
            PG8_WAIT_V(8); PG8_WAIT_L(0); PG8_BAR; PG8_MMA(1, 0, At, B0); PG8_MMA(1, 1, At, B1); PG8_BAR; PG8_SCHED;
            } else {
            PG8_LDB(B0, 0, 0); PG8_SCHED; PG8_LDA(At, 0, 0); PG8_STAGE(PG8_SA(1, 1), a1 + hstep, voffA);
            PG8_WAIT_L(8); PG8_BAR; PG8_WAIT_L(0); PG8_MMA(0, 0, At, B0); PG8_BAR; PG8_SCHED;
            PG8_LDB(B1, 0, 1); PG8_STAGE(PG8_SB(0, 0), b2, voffB);
            PG8_BAR; PG8_WAIT_L(0); PG8_MMA(0, 1, At, B1); PG8_BAR;
            PG8_LDA(At, 0, 1); PG8_STAGE(PG8_SA(0, 0), a2, voffA);
            PG8_BAR; PG8_WAIT_L(0); PG8_MMA(1, 0, At, B0); PG8_BAR; PG8_SCHED;
            PG8_STAGE(PG8_SB(0, 1), b2 + hstep, voffB);
            PG8_WAIT_V(6); PG8_BAR; PG8_MMA(1, 1, At, B1); PG8_BAR;
            PG8_LDB(B0, 1, 0); PG8_SCHED; PG8_LDA(At, 1, 0); PG8_STAGE(PG8_SA(0, 1), a2 + hstep, voffA);
            PG8_WAIT_L(8); PG8_BAR; PG8_WAIT_L(0); PG8_MMA(0, 0, At, B0); PG8_BAR; PG8_SCHED;
            PG8_LDB(B1, 1, 1); PG8_STAGE(PG8_SB(1, 0), b3, voffB);
            PG8_BAR; PG8_WAIT_L(0); PG8_MMA(0, 1, At, B1); PG8_BAR;
            PG8_LDA(At, 1, 1); PG8_STAGE(PG8_SA(1, 0), a3, voffA);
            PG8_BAR; PG8_WAIT_L(0); PG8_MMA(1, 0, At, B0); PG8_BAR; PG8_SCHED;
            PG8_STAGE(PG8_SB(1, 1), b3 + hstep, voffB);
            PG8_WAIT_V(6); PG8_BAR; PG8_MMA(1, 1, At, B1); PG8_BAR;
            }
        }
        if constexpr (ALIGN_EPI) { if (wr == 0) PG8_BAR; }
        if constexpr (!Epi::AFTER_DRAIN) { E(acc, cur, wr, wc, fr, fq); S.done(cur); }
        if (!has_next) break;
#pragma unroll
        for (int a = 0; a < 2; ++a)
#pragma unroll
            for (int b = 0; b < 2; ++b)
#pragma unroll
                for (int m = 0; m < 4; ++m)
#pragma unroll
                    for (int n = 0; n < 2; ++n) acc[a][b][m][n] = (f32x4){0.f, 0.f, 0.f, 0.f};
        cur = nxt; cA = nA; cB = nB; ++ui;
        if constexpr (ALIGN_EPI) { if (wr == 1) PG8_BAR; }
    }
    PG8_WAIT_V(0);
    if constexpr (!ALIGN_EPI) { if (wr == 0) PG8_BAR; }
    PG8_BAR;
    if constexpr (Epi::AFTER_DRAIN) { E.fused(acc, cur, wr, wc, fr, fq, lds, wid, lane); S.done(cur); }
#undef PG8_SA
#undef PG8_SB
#undef PG8_STAGE
#undef PG8_LDA
#undef PG8_LDB
#undef PG8_MMA
#undef PG8_WAIT_V
#undef PG8_WAIT_L
#undef PG8_BAR
#undef PG8_SCHED
}
}
constexpr int S = 16384, DM = 1024, DEPTH = 4, NIN = 2816, DFF = 2816, NUP = 5632;
constexpr float EPS = 1e-6f;
constexpr int NWAVES = 8, NTHR = 512;
constexpr size_t MiB = 1u << 20;
constexpr size_t WS_WIN = 1 * MiB, WS_WOUT = 23 * MiB, WS_WUP = 31 * MiB, WS_WDN = 75 * MiB;
constexpr size_t WS_PART = 97 * MiB;
constexpr size_t WS_XB = 98 * MiB + 4096;
constexpr size_t WS_P = 131 * MiB;
constexpr size_t WS_Y = 219 * MiB;
constexpr size_t WS_GU = 131 * MiB;
constexpr size_t WS_A = 219 * MiB;
constexpr size_t WS_END = 307 * MiB;
constexpr int LDS_BYTES = 147456;
#define LAS __attribute__((address_space(3)))
typedef unsigned short bf16;
typedef unsigned v4u __attribute__((ext_vector_type(4)));
typedef unsigned v2u __attribute__((ext_vector_type(2)));
typedef float f32x4 __attribute__((ext_vector_type(4)));
typedef float f32x16 __attribute__((ext_vector_type(16)));
typedef short bf16x8 __attribute__((ext_vector_type(8)));
#define LDS_WAIT() asm volatile("s_waitcnt lgkmcnt(0)" ::: "memory")
__device__ __forceinline__ unsigned pk2(float lo, float hi) { return pg8::cvt_pk_bf16(lo, hi); }
__device__ __forceinline__ float bflo(unsigned u) { return __uint_as_float(u << 16); }
__device__ __forceinline__ float bfhi(unsigned u) { return __uint_as_float(u & 0xffff0000u); }
__device__ __forceinline__ float bf1(bf16 v) { return __uint_as_float((unsigned)v << 16); }
#define WS_DPP(v, ctrl) __builtin_bit_cast(float, __builtin_amdgcn_update_dpp(0, __builtin_bit_cast(int, (float)(v)), (ctrl), 0xf, 0xf, true))
__device__ __forceinline__ float wave_sum(float v) {
    v += WS_DPP(v, 0xB1); v += WS_DPP(v, 0x4E); v += WS_DPP(v, 0x141); v += WS_DPP(v, 0x140);
    const int iv = __builtin_bit_cast(int, v);
    const float a = __builtin_bit_cast(float, __builtin_amdgcn_readlane(iv, 0)), b = __builtin_bit_cast(float, __builtin_amdgcn_readlane(iv, 16));
    const float c = __builtin_bit_cast(float, __builtin_amdgcn_readlane(iv, 32)), d = __builtin_bit_cast(float, __builtin_amdgcn_readlane(iv, 48));
    return (a + b) + (c + d);
}

__device__ __forceinline__ void cvt_item(const float* W, int K, int N, bf16* WT, const float* gain, int mode, LAS float* scr, int item, int lane) {
    const int nblk = N / 32, kb = item / nblk, nb = item % nblk, k0 = 64 * kb, n0 = 32 * nb;
    float wv[32];
#pragma unroll
    for (int i = 0; i < 32; ++i) { const int kk = 2 * i + (lane >> 5); wv[i] = W[(size_t)(k0 + kk) * N + n0 + (lane & 31)]; }
#pragma unroll
    for (int i = 0; i < 32; ++i) { const int kk = 2 * i + (lane >> 5); const float g = gain ? gain[k0 + kk] : 1.0f; scr[kk * 33 + (lane & 31)] = wv[i] * g; }
    LDS_WAIT(); asm volatile("" ::: "memory");
    const float cs = (mode == 1 && n0 >= 1280 && n0 < 1792) ? 0.125f * 1.4426950408889634f : 1.0f;
    int rb = n0;
    if (mode == 2) { rb = (n0 < DFF) ? 256 * (n0 / 128) + (n0 % 128) : 256 * ((n0 - DFF) / 128) + 128 + ((n0 - DFF) % 128); }
    const int c = lane & 7;
#pragma unroll
    for (int j = 0; j < 4; ++j) { const int n = (lane >> 3) + 8 * j; const LAS float* s = scr + (8 * c) * 33 + n;
        v4u o; o.x = pk2(s[0 * 33] * cs, s[1 * 33] * cs); o.y = pk2(s[2 * 33] * cs, s[3 * 33] * cs); o.z = pk2(s[4 * 33] * cs, s[5 * 33] * cs); o.w = pk2(s[6 * 33] * cs, s[7 * 33] * cs);
        *(v4u*)(WT + (size_t)(rb + n) * K + k0 + 8 * c) = o; }
    LDS_WAIT(); asm volatile("" ::: "memory");
}

typedef __attribute__((address_space(1))) unsigned gu32;
#define XB_TMO      128
#define XB_XCNT(j)  (256  + 64 * (j))
#define XB_XSUB(j)  (1280 + 64 * (j))
#define XB_XGEN(j)  (2304 + 64 * (j))
#define XB_TOP      3328
#define XB_TOPGEN   3392
#define XCD_BAR_WORDS 3456
#define XB_SPIN_CAP (1u << 18)

__device__ __forceinline__ unsigned xb_ld(unsigned* p)              { return __hip_atomic_load(p, __ATOMIC_RELAXED, __HIP_MEMORY_SCOPE_AGENT); }
__device__ __forceinline__ unsigned xb_add(unsigned* p, unsigned v) { return __hip_atomic_fetch_add(p, v, __ATOMIC_RELAXED, __HIP_MEMORY_SCOPE_AGENT); }
__device__ __forceinline__ unsigned xb_xcc_id() { return (unsigned)__builtin_amdgcn_s_getreg((3 << 11) | 20) & 0xFu; }
#define XB_SPIN(cond, bar) do { unsigned _sp = 0; while (cond) { __builtin_amdgcn_s_sleep(1); \
    if ((++_sp & 255u) == 0u) { if (xb_ld(&(bar)[XB_TMO])) break; if (_sp > XB_SPIN_CAP) { atomicAdd(&(bar)[XB_TMO], 1u); break; } } } } while (0)

struct XcdBarrier {
    unsigned* bar; unsigned x;
    volatile LAS unsigned* st;
};

__device__ __forceinline__ XcdBarrier xcd_barrier_post(unsigned* bar, volatile LAS unsigned* st) {
    XcdBarrier b; b.bar = bar; b.x = xb_xcc_id(); b.st = st;
    if (threadIdx.x == 0) (void)xb_add(&bar[XB_XCNT(b.x)], 1u);
    return b;
}
__device__ __forceinline__ void xcd_barrier_complete(unsigned* bar, unsigned x, unsigned& nloc, unsigned& nx) {
    const unsigned G = gridDim.x * gridDim.y * gridDim.z;
    unsigned sum, cnt, mine, sp = 0u;
    for (;;) {
        sum = 0u; cnt = 0u; mine = 0u;
#pragma unroll
        for (unsigned j = 0; j < 16; ++j) { const unsigned c = xb_ld(&bar[XB_XCNT(j)]); sum += c; cnt += (c > 0u) ? 1u : 0u; mine = (j == x) ? c : mine; }
        if (sum == G) break;
        __builtin_amdgcn_s_sleep(1);
        if ((++sp & 255u) == 0u) { if (xb_ld(&bar[XB_TMO])) break; if (sp > XB_SPIN_CAP) { atomicAdd(&bar[XB_TMO], 1u); break; } }
    }
    nloc = mine > 0u ? mine : 1u; nx = cnt > 0u ? cnt : 1u;
}

__device__ __forceinline__ void xcd_barrier(const XcdBarrier& b) {
    asm volatile("s_waitcnt vmcnt(0)" ::: "memory");
    __syncthreads();
    if (threadIdx.x == 0) {
        unsigned* bar = b.bar;
        __builtin_amdgcn_s_waitcnt(0);
        unsigned nloc = b.st[0], nx = b.st[1];
        if (nloc == 0u) { xcd_barrier_complete(bar, b.x, nloc, nx); b.st[0] = nloc; b.st[1] = nx; }
        const unsigned old = xb_add(&bar[XB_XSUB(b.x)], 1u);
        const unsigned gen = old / nloc;
        if (old + 1u == (gen + 1u) * nloc) {
            __builtin_amdgcn_fence(__ATOMIC_RELEASE, "agent");
            asm volatile("s_waitcnt vmcnt(0)" ::: "memory");
            const unsigned og = xb_add(&bar[XB_TOP], 1u);
            const unsigned tg = og / nx;
            if (og + 1u == (tg + 1u) * nx) xb_add(&bar[XB_TOPGEN], 1u);
            else XB_SPIN(xb_ld(&bar[XB_TOPGEN]) == tg, bar);
            __builtin_amdgcn_fence(__ATOMIC_ACQUIRE, "agent");
            xb_add(&bar[XB_XGEN(b.x)], 1u);
            asm volatile("s_waitcnt vmcnt(0)" ::: "memory");
        } else {
            XB_SPIN(xb_ld(&bar[XB_XGEN(b.x)]) == gen, bar);
            __builtin_amdgcn_fence(__ATOMIC_ACQUIRE, "agent");
            asm volatile("s_waitcnt vmcnt(0)" ::: "memory");
        }
    }
    __syncthreads();
}

struct CvtSrc { const float *w_in, *w_out, *w_up, *w_down, *norm_mix, *out_norm, *norm_ffn; bf16 *Win_t, *Wout_t, *Wup_t, *Wdn_t; };
__device__ __forceinline__ void cvt_layer_item(const CvtSrc& c, int l, int r, LAS float* scr, int lane) {
    const float* W; bf16* WT; const float* gain; int K, N, mode;
    if (r < 1408) { W = c.w_in + (size_t)l * DM * NIN; K = DM; N = NIN; WT = c.Win_t + (size_t)l * NIN * DM; gain = c.norm_mix + l * DM; mode = 1; }
    else if (r < 1920) { r -= 1408; W = c.w_out + (size_t)l * DM * DM; K = DM; N = DM; WT = c.Wout_t + (size_t)l * DM * DM; gain = c.out_norm + l * DM; mode = 0; }
    else if (r < 4736) { r -= 1920; W = c.w_up + (size_t)l * DM * NUP; K = DM; N = NUP; WT = c.Wup_t + (size_t)l * NUP * DM; gain = c.norm_ffn + l * DM; mode = 2; }
    else { r -= 4736; W = c.w_down + (size_t)l * DFF * DM; K = DFF; N = DM; WT = c.Wdn_t + (size_t)l * DM * DFF; gain = nullptr; mode = 0; }
    cvt_item(W, K, N, WT, gain, mode, scr, r, lane);
}
__device__ __forceinline__ const float* ldptr(const volatile LAS unsigned* PT, int k) {
    const unsigned lo = __builtin_amdgcn_readfirstlane(PT[2 * k]), hi = __builtin_amdgcn_readfirstlane(PT[2 * k + 1]);
    return (const float*)(((unsigned long long)hi << 32) | lo);
}
struct Args { const float* in[14]; float* out; unsigned char* ws; };

__device__ __forceinline__ void norm_store_rows(const LAS float* tile, bf16* Y, int t0, int coff, int wave, int lane) {
#pragma unroll 2
    for (int i = 0; i < 8; ++i) { const int r = wave * 8 + i; const f32x4 v = *(const LAS f32x4*)(tile + r * 260 + lane * 4);
        const float ss = wave_sum((v[0] * v[0] + v[1] * v[1]) + (v[2] * v[2] + v[3] * v[3]));
        const float rs = __builtin_amdgcn_rsqf(ss * (1.0f / 256.0f) + EPS);
        v2u o; o.x = pk2(v[0] * rs, v[1] * rs); o.y = pk2(v[2] * rs, v[3] * rs);
        *(v2u*)(Y + (size_t)(t0 + r) * DM + coff + lane * 4) = o; }
}

__device__ __forceinline__ void mixer_unit(LAS unsigned char* lds, int unit, const bf16* P, bf16* Y, const float* conv_w, const float* sgu_norm, const float* sgu_w, const float* sgu_b, int tid, int wave, int lane) {
    const int t0 = unit * 64;
    asm volatile("" : "+v"(tid), "+v"(lane));
    LAS bf16* vnT = (LAS bf16*)lds;
    LAS float* tile = (LAS float*)(lds + 69632);
    LAS float* sm_ss = (LAS float*)(lds + 69632 + 66560);
    {
        const int hd = wave, r = lane & 31, h = lane >> 5;
        const int pr = (r & 0x13) | ((r & 4) << 1) | ((r & 8) >> 1);
        LAS bf16* Vt = (LAS bf16*)(lds + wave * 5120);
        bf16x8 atri[2];
#pragma unroll
        for (int sI = 0; sI < 2; ++sI) { v4u t;
            t.x = ((16 * sI + 8 * h + 0 > pr) ? 0x3F80u : 0u) | ((16 * sI + 8 * h + 1 > pr) ? 0x3F800000u : 0u); t.y = ((16 * sI + 8 * h + 2 > pr) ? 0x3F80u : 0u) | ((16 * sI + 8 * h + 3 > pr) ? 0x3F800000u : 0u);
            t.z = ((16 * sI + 8 * h + 4 > pr) ? 0x3F80u : 0u) | ((16 * sI + 8 * h + 5 > pr) ? 0x3F800000u : 0u); t.w = ((16 * sI + 8 * h + 6 > pr) ? 0x3F80u : 0u) | ((16 * sI + 8 * h + 7 > pr) ? 0x3F800000u : 0u);
            atri[sI] = __builtin_bit_cast(bf16x8, t); }
        f32x16 oacc[2][2];
        LAS bf16x8* Qs = (LAS bf16x8*)(lds + 40960 + wave * 8192);
#pragma unroll
        for (int ks = 0; ks < 4; ++ks) { Qs[ks * 64 + lane] = *(const bf16x8*)(P + (size_t)(t0 + r) * NIN + 1280 + hd * 64 + 16 * ks + 8 * h); Qs[(4 + ks) * 64 + lane] = *(const bf16x8*)(P + (size_t)(t0 + 32 + r) * NIN + 1280 + hd * 64 + 16 * ks + 8 * h); }
#pragma unroll
        for (int a = 0; a < 2; ++a)
#pragma unroll
            for (int b = 0; b < 2; ++b) oacc[a][b] = (f32x16){};
        float lsA = 0.f, lsB = 0.f; bool actA = true, actB = true;
        bf16x8 kfn[4]; v4u vvn[4];
        { const bf16* kp = P + (size_t)(t0 + 32 + pr) * NIN + 1792 + hd * 64 + 8 * h;
#pragma unroll
          for (int ks = 0; ks < 4; ++ks) kfn[ks] = *(const bf16x8*)(kp + 16 * ks);
#pragma unroll
          for (int i = 0; i < 4; ++i) vvn[i] = *(const v4u*)(P + (size_t)(t0 + 32 + (lane >> 3) + 8 * i) * NIN + 2304 + hd * 64 + 8 * (lane & 7)); }
#define SB_CHAIN(Z, O0, O1, LS, DIAGV) do { \
            f32x16 cin; float Lv[16]; \
            _Pragma("unroll") for (int jj = 0; jj < 16; ++jj) { const float zz = Z[jj]; const float ex = __builtin_amdgcn_exp2f(-fabsf(zz)); const float lsig = fminf(zz, 0.f) - __builtin_amdgcn_logf(1.0f + ex); \
                Lv[jj] = lsig - zz; cin[jj] = lsig + LS; } \
            if (DIAGV) { _Pragma("unroll") for (int jj = 0; jj < 16; ++jj) { const int keyl = 16 * (jj >> 3) + 8 * h + (jj & 7); Lv[jj] = (keyl < r) ? Lv[jj] : 0.f; } } \
            float rowsum = 0.f; unsigned lh[8], ll[8]; \
            _Pragma("unroll") for (int j = 0; j < 16; j += 2) { rowsum += Lv[j] + Lv[j + 1]; \
                const unsigned hp = pk2(Lv[j], Lv[j + 1]); lh[j >> 1] = hp; ll[j >> 1] = pk2(Lv[j] - bflo(hp), Lv[j + 1] - bfhi(hp)); } \
            const bf16x8 bh0 = __builtin_bit_cast(bf16x8, (v4u){lh[0], lh[1], lh[2], lh[3]}), bh1 = __builtin_bit_cast(bf16x8, (v4u){lh[4], lh[5], lh[6], lh[7]}); \
            const bf16x8 bl0 = __builtin_bit_cast(bf16x8, (v4u){ll[0], ll[1], ll[2], ll[3]}), bl1 = __builtin_bit_cast(bf16x8, (v4u){ll[4], ll[5], ll[6], ll[7]}); \
            f32x16 lw = __builtin_amdgcn_mfma_f32_32x32x16_bf16(atri[0], bh0, cin, 0, 0, 0); \
            lw = __builtin_amdgcn_mfma_f32_32x32x16_bf16(atri[1], bh1, lw, 0, 0, 0); \
            lw = __builtin_amdgcn_mfma_f32_32x32x16_bf16(atri[0], bl0, lw, 0, 0, 0); \
            lw = __builtin_amdgcn_mfma_f32_32x32x16_bf16(atri[1], bl1, lw, 0, 0, 0); \
            float wv[16]; \
            _Pragma("unroll") for (int jj = 0; jj < 16; ++jj) wv[jj] = __builtin_amdgcn_exp2f(lw[jj]); \
            if (DIAGV) { _Pragma("unroll") for (int jj = 0; jj < 16; ++jj) { const int keyl = 16 * (jj >> 3) + 8 * h + (jj & 7); wv[jj] = (keyl < r) ? wv[jj] : 0.f; } } \
            unsigned wp[8]; \
            _Pragma("unroll") for (int j = 0; j < 16; j += 2) wp[j >> 1] = pk2(wv[j], wv[j + 1]); \
            const bf16x8 w0 = __builtin_bit_cast(bf16x8, (v4u){wp[0], wp[1], wp[2], wp[3]}), w1 = __builtin_bit_cast(bf16x8, (v4u){wp[4], wp[5], wp[6], wp[7]}); \
            const LAS bf16* vr = Vt + r * 40 + 8 * h; \
            O0 = __builtin_amdgcn_mfma_f32_32x32x16_bf16(*(const LAS bf16x8*)(vr), w0, O0, 0, 0, 0); \
            O0 = __builtin_amdgcn_mfma_f32_32x32x16_bf16(*(const LAS bf16x8*)(vr + 16), w1, O0, 0, 0, 0); \
            O1 = __builtin_amdgcn_mfma_f32_32x32x16_bf16(*(const LAS bf16x8*)(vr + 32 * 40), w0, O1, 0, 0, 0); \
            O1 = __builtin_amdgcn_mfma_f32_32x32x16_bf16(*(const LAS bf16x8*)(vr + 32 * 40 + 16), w1, O1, 0, 0, 0); \
            LS += rowsum + __shfl_xor(rowsum, 32); } while (0)
        for (int k0 = t0 + 32;; k0 -= 32) {
            const bool doA = actA && (k0 <= t0);
            f32x16 zB = {}, zA = {};
            if (actB) {
#pragma unroll
                for (int ks = 0; ks < 4; ++ks) zB = __builtin_amdgcn_mfma_f32_32x32x16_bf16(kfn[ks], Qs[(4 + ks) * 64 + lane], zB, 0, 0, 0); }
            if (doA) {
#pragma unroll
                for (int ks = 0; ks < 4; ++ks) zA = __builtin_amdgcn_mfma_f32_32x32x16_bf16(kfn[ks], Qs[ks * 64 + lane], zA, 0, 0, 0); }
#pragma unroll
            for (int i = 0; i < 4; ++i) { const int key = (lane >> 3) + 8 * i, c = lane & 7; const v4u vv = vvn[i];
                LAS bf16* vd = Vt + (8 * c) * 40 + key;
                vd[0] = (bf16)(vv.x & 0xffffu); vd[40] = (bf16)(vv.x >> 16); vd[80] = (bf16)(vv.y & 0xffffu); vd[120] = (bf16)(vv.y >> 16);
                vd[160] = (bf16)(vv.z & 0xffffu); vd[200] = (bf16)(vv.z >> 16); vd[240] = (bf16)(vv.w & 0xffffu); vd[280] = (bf16)(vv.w >> 16); }
            if (k0 >= 32) { const bf16* kp = P + (size_t)(k0 - 32 + pr) * NIN + 1792 + hd * 64 + 8 * h;
#pragma unroll
                for (int ks = 0; ks < 4; ++ks) kfn[ks] = *(const bf16x8*)(kp + 16 * ks);
#pragma unroll
                for (int i = 0; i < 4; ++i) vvn[i] = *(const v4u*)(P + (size_t)(k0 - 32 + (lane >> 3) + 8 * i) * NIN + 2304 + hd * 64 + 8 * (lane & 7)); }
            if (actB) { const bool dg = (k0 == t0 + 32); SB_CHAIN(zB, oacc[1][0], oacc[1][1], lsB, dg);
                if (__builtin_amdgcn_ballot_w64(lsB > -150.1f) == 0ull) actB = false; }
            if (doA) { const bool dg = (k0 == t0); SB_CHAIN(zA, oacc[0][0], oacc[0][1], lsA, dg);
                if (__builtin_amdgcn_ballot_w64(lsA > -150.1f) == 0ull) actA = false; }
            if (k0 < 32 || !(actA || actB)) break;
        }
#undef SB_CHAIN
#pragma unroll
        for (int qh = 0; qh < 2; ++qh) { float ss = 0.f;
#pragma unroll
            for (int j = 0; j < 16; ++j) ss += oacc[qh][0][j] * oacc[qh][0][j] + oacc[qh][1][j] * oacc[qh][1][j];
            ss += __shfl_xor(ss, 32);
            if (h == 0) sm_ss[(32 * qh + r) * 8 + hd] = ss; }
        LDS_WAIT(); __syncthreads();
#pragma unroll
        for (int qh = 0; qh < 2; ++qh) {
            const f32x4 sa = *(const LAS f32x4*)(sm_ss + (32 * qh + r) * 8), sb = *(const LAS f32x4*)(sm_ss + (32 * qh + r) * 8 + 4);
            const float tot = ((sa[0] + sa[1]) + (sa[2] + sa[3])) + ((sb[0] + sb[1]) + (sb[2] + sb[3]));
            const float rs = __builtin_amdgcn_rsqf(tot * (1.0f / 512.0f) + EPS);
            bf16* yp = Y + (size_t)(t0 + 32 * qh + r) * DM + 512 + hd * 64 + 4 * h;
#pragma unroll
            for (int db = 0; db < 2; ++db)
#pragma unroll
                for (int g4 = 0; g4 < 4; ++g4) { const f32x16& o = oacc[qh][db]; v2u w; w.x = pk2(o[4 * g4 + 0] * rs, o[4 * g4 + 1] * rs); w.y = pk2(o[4 * g4 + 2] * rs, o[4 * g4 + 3] * rs);
                    *(v2u*)(yp + 32 * db + 8 * g4) = w; }
        }
    }
    {
        const int c8 = (tid & 31) * 8, rg = tid >> 5, tb = t0 + 4 * rg;
        v4u gb[4], gc[6], hc[6];
#pragma unroll
        for (int i = 0; i < 6; ++i) { const int t = tb - 2 + i; const bool ok = t >= 0; const bf16* rp = P + (size_t)(ok ? t : 0) * NIN;
            gc[i] = ok ? *(const v4u*)(rp + 256 + c8) : (v4u){0u, 0u, 0u, 0u}; hc[i] = ok ? *(const v4u*)(rp + 512 + c8) : (v4u){0u, 0u, 0u, 0u};
            if (i >= 2) gb[i - 2] = *(const v4u*)(rp + c8); }
        float w0[8], w1[8], w2[8];
        { const f32x4 a0 = *(const f32x4*)(conv_w + c8), a1 = *(const f32x4*)(conv_w + c8 + 4), b0 = *(const f32x4*)(conv_w + 256 + c8), b1 = *(const f32x4*)(conv_w + 256 + c8 + 4), d0 = *(const f32x4*)(conv_w + 512 + c8), d1 = *(const f32x4*)(conv_w + 512 + c8 + 4);
#pragma unroll
          for (int e = 0; e < 4; ++e) { w0[e] = a0[e]; w0[4 + e] = a1[e]; w1[e] = b0[e]; w1[4 + e] = b1[e]; w2[e] = d0[e]; w2[4 + e] = d1[e]; } }
        float pr_[6][8];
#pragma unroll
        for (int i = 0; i < 6; ++i) { const unsigned ga[4] = {gc[i].x, gc[i].y, gc[i].z, gc[i].w}, ha[4] = {hc[i].x, hc[i].y, hc[i].z, hc[i].w};
#pragma unroll
            for (int e = 0; e < 4; ++e) { pr_[i][2 * e] = bflo(ga[e]) * bflo(ha[e]); pr_[i][2 * e + 1] = bfhi(ga[e]) * bfhi(ha[e]); } }
#pragma unroll
        for (int i = 0; i < 4; ++i) { const unsigned ba[4] = {gb[i].x, gb[i].y, gb[i].z, gb[i].w}; float o[8];
#pragma unroll
            for (int e = 0; e < 4; ++e) { o[2 * e] = bflo(ba[e]) * (w0[2 * e] * pr_[i][2 * e] + w1[2 * e] * pr_[i + 1][2 * e] + w2[2 * e] * pr_[i + 2][2 * e]);
                o[2 * e + 1] = bfhi(ba[e]) * (w0[2 * e + 1] * pr_[i][2 * e + 1] + w1[2 * e + 1] * pr_[i + 1][2 * e + 1] + w2[2 * e + 1] * pr_[i + 2][2 * e + 1]); }
            LAS f32x4* tp = (LAS f32x4*)(tile + (4 * rg + i) * 260 + c8); tp[0] = (f32x4){o[0], o[1], o[2], o[3]}; tp[1] = (f32x4){o[4], o[5], o[6], o[7]}; }
    }
    LDS_WAIT(); __syncthreads();
    norm_store_rows(tile, Y, t0, 0, wave, lane);
    const int tc = t0 & ~127, dt = t0 - tc, ns = dt + 64;
    { v2u uu[16];
#pragma unroll
      for (int i = 0; i < 16; ++i) { const int s = wave + 8 * i; uu[i] = (s < ns) ? *(const v2u*)(P + (size_t)(tc + s) * NIN + 1024 + lane * 4) : (v2u){0u, 0u}; }
      const f32x4 g = *(const f32x4*)(sgu_norm + lane * 4);
#pragma unroll
      for (int i = 0; i < 16; ++i) { const int s = wave + 8 * i;
        if (s < ns) { const v2u u = uu[i];
        const float v0 = bflo(u.x), v1 = bfhi(u.x), v2 = bflo(u.y), v3 = bfhi(u.y);
        const float ss = wave_sum((v0 * v0 + v1 * v1) + (v2 * v2 + v3 * v3)); const float rs = __builtin_amdgcn_rsqf(ss * (1.0f / 256.0f) + EPS);
        const unsigned a = pk2(v0 * rs * g[0], v1 * rs * g[1]), b = pk2(v2 * rs * g[2], v3 * rs * g[3]);
        vnT[(lane * 4 + 0) * 136 + s] = (bf16)(a & 0xffffu); vnT[(lane * 4 + 1) * 136 + s] = (bf16)(a >> 16); vnT[(lane * 4 + 2) * 136 + s] = (bf16)(b & 0xffffu); vnT[(lane * 4 + 3) * 136 + s] = (bf16)(b >> 16); } } }
    LDS_WAIT(); __syncthreads();
    {
        const int h = wave >> 1, rh = wave & 1, r32 = lane & 31, hi = lane >> 5;
        const int tcl = dt + 32 * rh + r32;
        const float* wrow = sgu_w + ((size_t)h * 128 + tcl) * 128;
        f32x16 o0 = {}, o1 = {};
        const int nk = (dt + 32 * rh + 32) >> 4;
        f32x4 wa[8], wb[8];
#pragma unroll
        for (int ks = 0; ks < 8; ++ks) { const int s0 = ks * 16 + 8 * hi; if (ks < nk) { wa[ks] = *(const f32x4*)(wrow + s0); wb[ks] = *(const f32x4*)(wrow + s0 + 4); } else { wa[ks] = (f32x4){0.f, 0.f, 0.f, 0.f}; wb[ks] = wa[ks]; } }
#pragma unroll
        for (int ks = 0; ks < 8; ++ks) if (ks < nk) { const int s0 = ks * 16 + 8 * hi;
            float wv[8] = {wa[ks][0], wa[ks][1], wa[ks][2], wa[ks][3], wb[ks][0], wb[ks][1], wb[ks][2], wb[ks][3]};
#pragma unroll
            for (int i = 0; i < 8; ++i) wv[i] = (s0 + i <= tcl) ? wv[i] : 0.f;
            v4u ap; ap.x = pk2(wv[0], wv[1]); ap.y = pk2(wv[2], wv[3]); ap.z = pk2(wv[4], wv[5]); ap.w = pk2(wv[6], wv[7]);
            const bf16x8 af = __builtin_bit_cast(bf16x8, ap);
            const bf16x8 b0 = *(const LAS bf16x8*)(vnT + (h * 64 + r32) * 136 + s0), b1 = *(const LAS bf16x8*)(vnT + (h * 64 + 32 + r32) * 136 + s0);
            o0 = __builtin_amdgcn_mfma_f32_32x32x16_bf16(af, b0, o0, 0, 0, 0);
            o1 = __builtin_amdgcn_mfma_f32_32x32x16_bf16(af, b1, o1, 0, 0, 0); }
#pragma unroll
        for (int j = 0; j < 16; ++j) { const int rl = 32 * rh + (j & 3) + 8 * (j >> 2) + 4 * hi;
            const float bb = sgu_b[h * 128 + dt + rl]; const bf16* up = P + (size_t)(t0 + rl) * NIN + 768 + h * 64;
            tile[rl * 260 + h * 64 + r32] = bf1(up[r32]) * (o0[j] + bb);
            tile[rl * 260 + h * 64 + 32 + r32] = bf1(up[32 + r32]) * (o1[j] + bb); }
    }
    LDS_WAIT(); __syncthreads();
    norm_store_rows(tile, Y, t0, 256, wave, lane);
    LDS_WAIT(); __syncthreads();
}

__device__ __forceinline__ void ffn_gate_phase(const bf16* GU, bf16* A, const float* fconv, int hf, int gtid, int gthreads) {
    for (int it = gtid; it < 256 * 176; it += gthreads) { const int rb = it / 176, cgp = it % 176, pnl = cgp >> 4, cc = (cgp & 15) * 8, ch = 1408 * hf + 128 * pnl + cc;
        float wg[3][8], wu[3][8];
#pragma unroll
        for (int i = 0; i < 3; ++i) { const f32x4 a0 = *(const f32x4*)(fconv + (size_t)i * NUP + ch), a1 = *(const f32x4*)(fconv + (size_t)i * NUP + ch + 4), b0 = *(const f32x4*)(fconv + (size_t)i * NUP + DFF + ch), b1 = *(const f32x4*)(fconv + (size_t)i * NUP + DFF + ch + 4);
#pragma unroll
            for (int e = 0; e < 4; ++e) { wg[i][e] = a0[e]; wg[i][4 + e] = a1[e]; wu[i][e] = b0[e]; wu[i][4 + e] = b1[e]; } }
        float g2[8], g1[8], u2[8], u1[8];
#pragma unroll
        for (int e = 0; e < 8; ++e) { g2[e] = g1[e] = u2[e] = u1[e] = 0.f; }
        for (int r = -2; r < 64; ++r) { const int t = 64 * rb + r; float g0[8], u0[8];
            if (t >= 0) { const v4u gv = *(const v4u*)(GU + (size_t)t * NIN + 256 * pnl + cc), uv = *(const v4u*)(GU + (size_t)t * NIN + 256 * pnl + 128 + cc);
                g0[0] = bflo(gv.x); g0[1] = bfhi(gv.x); g0[2] = bflo(gv.y); g0[3] = bfhi(gv.y); g0[4] = bflo(gv.z); g0[5] = bfhi(gv.z); g0[6] = bflo(gv.w); g0[7] = bfhi(gv.w);
                u0[0] = bflo(uv.x); u0[1] = bfhi(uv.x); u0[2] = bflo(uv.y); u0[3] = bfhi(uv.y); u0[4] = bflo(uv.z); u0[5] = bfhi(uv.z); u0[6] = bflo(uv.w); u0[7] = bfhi(uv.w); }
            else {
#pragma unroll
                for (int e = 0; e < 8; ++e) { g0[e] = 0.f; u0[e] = 0.f; } }
            if (r >= 0) { float o[8];
#pragma unroll
                for (int e = 0; e < 8; ++e) { const float G = wg[0][e] * g2[e] + wg[1][e] * g1[e] + wg[2][e] * g0[e], U = wu[0][e] * u2[e] + wu[1][e] * u1[e] + wu[2][e] * u0[e];
                    o[e] = G * __builtin_amdgcn_rcpf(1.0f + __expf(-G)) * U; }
                v4u ov; ov.x = pk2(o[0], o[1]); ov.y = pk2(o[2], o[3]); ov.z = pk2(o[4], o[5]); ov.w = pk2(o[6], o[7]);
                *(v4u*)(A + (size_t)t * DFF + ch) = ov; }
#pragma unroll
            for (int e = 0; e < 8; ++e) { g2[e] = g1[e]; g1[e] = g0[e]; u2[e] = u1[e]; u1[e] = u0[e]; } }
    }
}
__global__ void __launch_bounds__(NTHR, 2) hybrid_fwd(Args args) {
    extern __shared__ __attribute__((aligned(16))) unsigned char lds_raw[];
    LAS unsigned char* lds = (LAS unsigned char*)lds_raw;
    cg::grid_group grid = cg::this_grid();
    volatile LAS unsigned* MISC = (volatile LAS unsigned*)(lds + LDS_BYTES - 64);
    volatile LAS unsigned* PT = (volatile LAS unsigned*)(lds + LDS_BYTES - 256);
    if (threadIdx.x < 16) MISC[threadIdx.x] = 0u;
    if (threadIdx.x == 0) {
#define PUTP(k) { const unsigned long long v_ = (unsigned long long)args.in[k]; PT[2 * (k)] = (unsigned)v_; PT[2 * (k) + 1] = (unsigned)(v_ >> 32); }
        PUTP(0) PUTP(1) PUTP(2) PUTP(3) PUTP(4) PUTP(5) PUTP(6) PUTP(7) PUTP(8) PUTP(9) PUTP(10) PUTP(11) PUTP(12) PUTP(13)
#undef PUTP
    }
    __syncthreads();
    XcdBarrier xbar = xcd_barrier_post((unsigned*)args.ws, MISC);
    const int tid = threadIdx.x, lane = tid & 63, wave = __builtin_amdgcn_readfirstlane(tid >> 6);
    const int G = gridDim.x, bx = blockIdx.x;
    const int gw = bx * NWAVES + wave, NGW = G * NWAVES;
    unsigned char* ws = args.ws;
#define INP(k) ldptr(PT, (k))
#define MAKE_CS() const CvtSrc cs{INP(2), INP(8), INP(10), INP(12), INP(1), INP(7), INP(9), Win_t, Wout_t, Wup_t, Wdn_t}
    float* xo = args.out;
#define PHASE_PTRS() unsigned char* w_ = ws; float* xcur = xo; asm volatile("" : "+s"(w_), "+s"(xcur)); \
    bf16* Win_t = (bf16*)(w_ + WS_WIN); bf16* Wout_t = (bf16*)(w_ + WS_WOUT); bf16* Wup_t = (bf16*)(w_ + WS_WUP); bf16* Wdn_t = (bf16*)(w_ + WS_WDN); \
    float* part = (float*)(w_ + WS_PART); bf16* XB = (bf16*)(w_ + WS_XB); bf16* P = (bf16*)(w_ + WS_P); bf16* Y = (bf16*)(w_ + WS_Y); bf16* A = (bf16*)(w_ + WS_A); \
    (void)Win_t; (void)Wout_t; (void)Wup_t; (void)Wdn_t; (void)part; (void)XB; (void)P; (void)Y; (void)A; (void)xcur

    for (int step = -1; step < 5 * DEPTH; ++step) {
        const int l = step < 0 ? 0 : step / 5, ph = step < 0 ? -1 : step % 5;
        int cvt_layer = -1, cvt_first = 0, cvt_n = 0, cvt_nu = 0;
        if (ph < 0) {
            PHASE_PTRS(); const float* x_in = INP(0);
            int gw_ = gw, lane_ = lane; asm volatile("" : "+s"(gw_), "+v"(lane_));
            for (int m = gw_; m < S; m += NGW) { const f32x4* xr = (const f32x4*)(x_in + (size_t)m * DM) + lane_; f32x4 v[4]; float ss = 0.f;
#pragma unroll
                for (int j = 0; j < 4; ++j) { v[j] = xr[64 * j]; ss += (v[j][0] * v[j][0] + v[j][1] * v[j][1]) + (v[j][2] * v[j][2] + v[j][3] * v[j][3]); }
                ss = wave_sum(ss);
                v2u* o8 = (v2u*)(XB + (size_t)m * DM) + lane_;
#pragma unroll
                for (int j = 0; j < 4; ++j) { v2u o; o.x = pk2(v[j][0], v[j][1]); o.y = pk2(v[j][2], v[j][3]); o8[64 * j] = o; }
                if (lane_ < 16) part[(size_t)m * 16 + lane_] = lane_ == 0 ? ss : 0.f; }
            cvt_layer = 0; cvt_first = 0; cvt_n = 6144; cvt_nu = 0;
        } else if (ph == 0) {
            PHASE_PTRS(); pg8::Gemm g{XB, Win_t + (size_t)l * NIN * DM, S, NIN, DM, 256}; pg8::StaticOrder So; So.init(S, NIN, G, bx);
            pg8::EpiScaleBf16 E{P, NIN, part, (LAS float*)(lds + 131072 + 8192)};
            pg8::gemm_phase<pg8::EpiScaleBf16, pg8::StaticOrder, true, true>(lds, g, So, E);
            if (l + 1 < DEPTH) { cvt_layer = l + 1; cvt_first = 0; cvt_n = 1920; cvt_nu = (S / 256) * (NIN / 256); }
        } else if (ph == 1) {
            PHASE_PTRS();
            for (int u = bx; u < S / 64; u += G)
                mixer_unit(lds, u, P, Y, INP(3) + l * 3 * 256, INP(4) + l * 256, INP(5) + (size_t)l * 4 * 128 * 128, INP(6) + l * 4 * 128, tid, wave, lane);
        } else if (ph == 2) {
            PHASE_PTRS(); pg8::Gemm g{Y, Wout_t + (size_t)l * DM * DM, S, DM, DM, 256}; pg8::StaticOrder So; So.init(S, DM, G, bx);
            pg8::EpiResid E{XB, part};
            pg8::gemm_phase<pg8::EpiResid, pg8::StaticOrder, true, true>(lds, g, So, E);
        } else if (ph == 3) {
            PHASE_PTRS(); pg8::Gemm g{XB - 2 * DM, Wup_t + (size_t)l * NUP * DM, 65 * 256, NUP, DM, 254}; pg8::StaticOrder So; So.init(65 * 256, NUP, G, bx);
            pg8::EpiGate E{A, part, INP(11) + (size_t)l * 3 * NUP, (LAS float*)(lds + 131072)};
            pg8::gemm_phase<pg8::EpiGate, pg8::StaticOrder, true, true>(lds, g, So, E);
            if (l + 1 < DEPTH) { cvt_layer = l + 1; cvt_first = 1920; cvt_n = 4224; cvt_nu = 65 * (NUP / 256); }
        } else {
            PHASE_PTRS(); pg8::Gemm g{A, Wdn_t + (size_t)l * DM * DFF, S, DM, DFF, 256}; pg8::StaticOrder So; So.init(S, DM, G, bx);
            pg8::EpiResid E{XB, part};
            pg8::gemm_phase<pg8::EpiResid, pg8::StaticOrder, true, true>(lds, g, So, E);
        }
        if (cvt_layer >= 0) {
            const int first_idle = cvt_nu > 0 ? cvt_nu - ((cvt_nu + G - 1) / G - 1) * G : 0; const bool some_idle = first_idle < G;
            if (!some_idle || bx >= first_idle) { const int nw = (some_idle ? G - first_idle : G) * NWAVES, iw = (some_idle ? bx - first_idle : bx) * NWAVES + wave;
                PHASE_PTRS(); LAS float* scr = (LAS float*)(lds + wave * 16384); int lane_ = lane; asm volatile("" : "+v"(lane_));
                MAKE_CS(); for (int it = iw; it < cvt_n; it += nw) cvt_layer_item(cs, cvt_layer, cvt_first + it, scr, lane_); } }
        if (step < 0) grid.sync(); else xcd_barrier(xbar);
    }
    { const float* nfin = INP(13); const bf16* XBf = (const bf16*)(ws + WS_XB);
      for (int m = gw; m < S; m += NGW) { const v2u* xr = (const v2u*)(XBf + (size_t)m * DM) + lane; f32x4 v[4]; float ss = 0.f;
#pragma unroll
        for (int j = 0; j < 4; ++j) { const v2u u = xr[64 * j]; v[j] = (f32x4){bflo(u.x), bfhi(u.x), bflo(u.y), bfhi(u.y)}; ss += (v[j][0] * v[j][0] + v[j][1] * v[j][1]) + (v[j][2] * v[j][2] + v[j][3] * v[j][3]); }
        const float rs = __builtin_amdgcn_rsqf(wave_sum(ss) * (1.0f / 1024.0f) + EPS);
        f32x4* orow = (f32x4*)(xo + (size_t)m * DM) + lane;
#pragma unroll
        for (int j = 0; j < 4; ++j) { const f32x4 g = *((const f32x4*)nfin + lane + 64 * j); orow[64 * j] = v[j] * rs * g; } } }
}

extern "C" void kernel_launch(void* const* d_in, const int* in_sizes, int n_in, void* d_out, int out_size, void* d_ws, size_t ws_size, hipStream_t stream) {
    static int grid = 0;
    if (grid == 0) {
        if (n_in != 14 || out_size != S * DM || ws_size < WS_END) { fprintf(stderr, "kernel_launch: unexpected shapes / workspace (%d inputs, out %d, ws %zu)\n", n_in, out_size, ws_size); grid = -1; return; }
        int dev = 0, cus = 0, per_cu = 0;
        hipGetDevice(&dev); hipDeviceGetAttribute(&cus, hipDeviceAttributeMultiprocessorCount, dev);
        hipFuncSetAttribute((const void*)hybrid_fwd, hipFuncAttributeMaxDynamicSharedMemorySize, LDS_BYTES);
        hipOccupancyMaxActiveBlocksPerMultiprocessor(&per_cu, (const void*)hybrid_fwd, NTHR, LDS_BYTES);
        (void)hipGetLastError();
        if (per_cu < 1) per_cu = 1;
        grid = cus * 1;
    }
    if (grid < 0) return;
    hipMemsetAsync((unsigned char*)d_ws, 0, 16384, stream);
    hipMemsetAsync((unsigned char*)d_ws + WS_XB - 4096, 0, 4096, stream);
    Args a{};
    for (int i = 0; i < 14; ++i) a.in[i] = (const float*)d_in[i];
    a.out = (float*)d_out; a.ws = (unsigned char*)d_ws;
    void* kargs[] = {&a};
    hipError_t e = hipLaunchCooperativeKernel((const void*)hybrid_fwd, dim3(grid), dim3(NTHR), kargs, LDS_BYTES, stream);
    if (e != hipSuccess) fprintf(stderr, "cooperative launch failed: %s (grid %d)\n", hipGetErrorString(e), grid);
}
```

```cpp
#include <hip/hip_runtime.h>
#include <hip/hip_cooperative_groups.h>
#include <cstdio>
#include <cstdint>
namespace cg = cooperative_groups;
namespace pg8 {
#define PG8_LAS __attribute__((address_space(3)))
typedef unsigned short bf16_t;
typedef short bf16x8 __attribute__((ext_vector_type(8)));
typedef float f32x4 __attribute__((ext_vector_type(4)));
typedef unsigned u32x4 __attribute__((ext_vector_type(4)));
typedef unsigned u32x2 __attribute__((ext_vector_type(2)));
constexpr int BM = 256, BK = 64, HALF = 128, HTB = HALF * BK * 2  , STAGE_BYTES = 8 * HTB, NXCD = 8, WGM = 8;

__host__ __device__ __forceinline__ int lds_byte(int r, int c) { const int st = (r >> 4) * 2 + (c >> 5), rr = r & 15, cc = c & 31, ob = rr * 64 + cc * 2; return st * 1024 + (ob ^ (((ob >> 9) & 1) << 5)); }
__host__ __device__ __forceinline__ void stage_rc(int b, int& R, int& C) { const int st = b / 1024, sb = b % 1024, swz = sb ^ (((sb >> 9) & 1) << 5); R = (st >> 1) * 16 + swz / 64; C = (st & 1) * 32 + (swz % 64) / 2; }
__host__ __device__ __forceinline__ int perm32(int rho) { const int n = rho >> 4, i = rho & 15; return 8 * (i >> 2) + 4 * n + (i & 3); }

struct Unit { int pm, pn; };
struct Gemm { const bf16_t* A; const bf16_t* Bt; int M, N, K; int arows; };

struct StaticOrder {
    int nM, nN, nwg, G, c;
    __host__ __device__ void init(int M, int N, int G_, int c_) { nM = M / BM; nN = N / BM; nwg = nM * nN; G = G_; c = c_; }
    __host__ __device__ bool next(int i, Unit& u) const {
        const long L = (long)i * G + c; if (L >= nwg) return false;
        int wgid = (int)L; { const int q = nwg / NXCD, r = nwg % NXCD, xcd = wgid % NXCD, off = wgid / NXCD; wgid = (xcd < r ? xcd * (q + 1) : r * (q + 1) + (xcd - r) * q) + off; }
        const int nig = WGM * nN, gid = wgid / nig, fm = gid * WGM, gsz = (nM - fm) < WGM ? (nM - fm) : WGM;
        u.pm = fm + ((wgid % nig) % gsz); u.pn = (wgid % nig) / gsz; return true;
    }
    __device__ __forceinline__ void a_ready(const Unit&) const {}
    __device__ __forceinline__ void done(const Unit&) const {}
};

__device__ __forceinline__ unsigned cvt_pk_bf16(float lo, float hi) { unsigned r; asm volatile("v_cvt_pk_bf16_f32 %0, %1, %2" : "=v"(r) : "v"(lo), "v"(hi)); return r; }
struct EpiScaleBf16 {
    static constexpr bool PERM = true, AFTER_DRAIN = false;
    bf16_t* O; int ldc; const float* part; PG8_LAS float* rsl;
    __device__ __forceinline__ void operator()(const f32x4 (&acc)[2][2][4][2], const Unit& u, int wr, int wc, int fr, int fq) const {
        { const int t = (wr * 4 + wc) * 64 + fq * 16 + fr;
          if (t < 256) { const f32x4* pp = (const f32x4*)(part + (size_t)(u.pm * BM + t) * 16); const f32x4 a = pp[0], b = pp[1], c = pp[2], d = pp[3];
              const f32x4 s4 = (a + b) + (c + d); const float ss = (s4[0] + s4[1]) + (s4[2] + s4[3]); rsl[t] = __builtin_amdgcn_rsqf(ss * (1.0f / 1024.0f) + 1e-6f); } }
        asm volatile("s_waitcnt lgkmcnt(0)" ::: "memory"); __builtin_amdgcn_s_barrier(); asm volatile("" ::: "memory");
        const int row0 = u.pm * BM + wr * 64 + fr; const int col0 = u.pn * BM + wc * 32 + 8 * fq;
#pragma unroll
        for (int ai = 0; ai < 2; ++ai)
#pragma unroll
            for (int m = 0; m < 4; ++m) { const int row = row0 + ai * HALF + m * 16;
                const float rs = rsl[ai * HALF + wr * 64 + m * 16 + fr];
                bf16_t* rowp = O + (size_t)row * ldc + col0;
#pragma unroll
                for (int bj = 0; bj < 2; ++bj) { const f32x4 v0 = acc[ai][bj][m][0] * rs, v1 = acc[ai][bj][m][1] * rs;
                    u32x4 w; w.x = cvt_pk_bf16(v0[0], v0[1]); w.y = cvt_pk_bf16(v0[2], v0[3]); w.z = cvt_pk_bf16(v1[0], v1[1]); w.w = cvt_pk_bf16(v1[2], v1[3]);
                    *(u32x4*)(rowp + bj * HALF) = w; } }
    }
};
struct EpiResid {
    static constexpr bool PERM = true, AFTER_DRAIN = false;
    bf16_t* xb; float* part;
    __device__ __forceinline__ void operator()(const f32x4 (&acc)[2][2][4][2], const Unit& u, int wr, int wc, int fr, int fq) const {
        const int row0 = u.pm * BM + wr * 64 + fr; const int col0 = u.pn * BM + wc * 32 + 8 * fq;
        u32x4 pre[3][2];
#define PG8_RLOAD(g_) do { const size_t o_ = (size_t)(row0 + ((g_) >> 2) * HALF + ((g_) & 3) * 16) * 1024 + col0; \
            pre[(g_) % 3][0] = *(const u32x4*)(xb + o_); pre[(g_) % 3][1] = *(const u32x4*)(xb + o_ + HALF); } while (0)
        PG8_RLOAD(0); PG8_RLOAD(1);
#pragma unroll
        for (int g = 0; g < 8; ++g) { const int ai = g >> 2, m = g & 3;
            if (g + 2 < 8) PG8_RLOAD(g + 2);
            asm volatile("" ::: "memory");
            const int row = row0 + ai * HALF + m * 16; const size_t off = (size_t)row * 1024 + col0; float ss = 0.f;
#pragma unroll
            for (int bj = 0; bj < 2; ++bj) { const u32x4 b = pre[g % 3][bj];
                const f32x4 b0 = {__uint_as_float(b.x << 16), __uint_as_float(b.x & 0xffff0000u), __uint_as_float(b.y << 16), __uint_as_float(b.y & 0xffff0000u)};
                const f32x4 b1 = {__uint_as_float(b.z << 16), __uint_as_float(b.z & 0xffff0000u), __uint_as_float(b.w << 16), __uint_as_float(b.w & 0xffff0000u)};
                const f32x4 v0 = acc[ai][bj][m][0] + b0, v1 = acc[ai][bj][m][1] + b1;
                ss += (v0[0] * v0[0] + v0[1] * v0[1]) + (v0[2] * v0[2] + v0[3] * v0[3]) + (v1[0] * v1[0] + v1[1] * v1[1]) + (v1[2] * v1[2] + v1[3] * v1[3]);
                u32x4 w; w.x = cvt_pk_bf16(v0[0], v0[1]); w.y = cvt_pk_bf16(v0[2], v0[3]); w.z = cvt_pk_bf16(v1[0], v1[1]); w.w = cvt_pk_bf16(v1[2], v1[3]);
                *(u32x4*)(xb + off + bj * HALF) = w; }
            ss += __shfl_xor(ss, 16); ss += __shfl_xor(ss, 32);
            if (fq == 0) part[(size_t)row * 16 + u.pn * 4 + wc] = ss;
            asm volatile("" ::: "memory"); }
#undef PG8_RLOAD
    }
};
#define PG8_DPP(oldv, srcv, ctrl) __builtin_bit_cast(float, __builtin_amdgcn_update_dpp(__builtin_bit_cast(int, (float)(oldv)), __builtin_bit_cast(int, (float)(srcv)), (ctrl), 0xf, 0xf, false))
#define PG8_ROR(srcv, ctrl) __builtin_bit_cast(float, __builtin_amdgcn_mov_dpp(__builtin_bit_cast(int, (float)(srcv)), (ctrl), 0xf, 0xf, true))
struct EpiGate {
    static constexpr bool PERM = true, AFTER_DRAIN = false;
    bf16_t* Aout; const float* part; const float* fconv; PG8_LAS float* xch;
    __device__ __forceinline__ void operator()(f32x4 (&acc)[2][2][4][2], const Unit& u, int wr, int wc, int fr, int fq) const {
        PG8_LAS float* rsl = xch + 2048;
        { const int t = (wr * 4 + wc) * 64 + fq * 16 + fr;
          if (t < 256) { const int row = u.pm * 254 - 2 + t; const bool ok = row >= 0 && row < 16384; const int rc = ok ? row : 0;
              const f32x4* pp = (const f32x4*)(part + (size_t)rc * 16); const f32x4 a = pp[0], b = pp[1], c = pp[2], d = pp[3];
              const f32x4 s4 = (a + b) + (c + d); const float ss = (s4[0] + s4[1]) + (s4[2] + s4[3]);
              rsl[t] = ok ? __builtin_amdgcn_rsqf(ss * (1.0f / 1024.0f) + 1e-6f) : 0.f; } }
        asm volatile("s_waitcnt lgkmcnt(0)" ::: "memory"); __builtin_amdgcn_s_barrier(); asm volatile("" ::: "memory");
        const int ccol = wc * 32 + 8 * fq;
#pragma unroll
        for (int ai = 0; ai < 2; ++ai)
#pragma unroll
            for (int m = 0; m < 4; ++m) { const float rs = rsl[ai * HALF + wr * 64 + m * 16 + fr];
#pragma unroll
                for (int bj = 0; bj < 2; ++bj) { acc[ai][bj][m][0] *= rs; acc[ai][bj][m][1] *= rs; } }
        if (fr >= 14) {
#pragma unroll
            for (int ai = 0; ai < 2; ++ai)
#pragma unroll
                for (int bj = 0; bj < 2; ++bj)
#pragma unroll
                    for (int n = 0; n < 2; ++n) *(PG8_LAS f32x4*)(xch + ((2 * ai + wr) * 2 + (fr & 1)) * 256 + bj * HALF + ccol + 4 * n) = acc[ai][bj][3][n];
        }
        asm volatile("s_waitcnt lgkmcnt(0)" ::: "memory"); __builtin_amdgcn_s_barrier(); asm volatile("" ::: "memory");
        const int ch0 = u.pn * HALF + ccol;
#pragma unroll
        for (int ai = 0; ai < 2; ++ai) {
            const int grp = 2 * ai + wr;
#pragma unroll
            for (int n = 0; n < 2; ++n) {
                asm volatile("" ::: "memory");
                const float* fw = fconv + ch0 + 4 * n;
                const f32x4 wg0 = *(const f32x4*)(fw), wg1 = *(const f32x4*)(fw + 5632), wg2 = *(const f32x4*)(fw + 2 * 5632);
                const f32x4 wu0 = *(const f32x4*)(fw + 2816), wu1 = *(const f32x4*)(fw + 5632 + 2816), wu2 = *(const f32x4*)(fw + 2 * 5632 + 2816);
                f32x4 xpg = {0.f, 0.f, 0.f, 0.f}, xpu = {0.f, 0.f, 0.f, 0.f};
                if (grp > 0) { xpg = *(const PG8_LAS f32x4*)(xch + ((grp - 1) * 2 + (fr & 1)) * 256 + ccol + 4 * n); xpu = *(const PG8_LAS f32x4*)(xch + ((grp - 1) * 2 + (fr & 1)) * 256 + HALF + ccol + 4 * n); }
#pragma unroll
                for (int m = 0; m < 4; ++m) {
                    float o[4];
#pragma unroll
                    for (int j = 0; j < 4; ++j) {
                        const float xg = acc[ai][0][m][n][j], xu = acc[ai][1][m][n][j];
                        const float pg = m > 0 ? acc[ai][0][m > 0 ? m - 1 : 0][n][j] : xpg[j], pu = m > 0 ? acc[ai][1][m > 0 ? m - 1 : 0][n][j] : xpu[j];
                        const float g1 = PG8_DPP(PG8_ROR(pg, 0x121), xg, 0x111), g2 = PG8_DPP(PG8_ROR(pg, 0x122), xg, 0x112);
                        const float u1 = PG8_DPP(PG8_ROR(pu, 0x121), xu, 0x111), u2 = PG8_DPP(PG8_ROR(pu, 0x122), xu, 0x112);
                        const float Gv = wg0[j] * g2 + wg1[j] * g1 + wg2[j] * xg, Uv = wu0[j] * u2 + wu1[j] * u1 + wu2[j] * xu;
                        o[j] = Gv * __builtin_amdgcn_rcpf(1.0f + __expf(-Gv)) * Uv; }
                    const int r = ai * HALF + wr * 64 + m * 16 + fr, row = u.pm * 254 - 2 + r;
                    u32x2 w; w.x = cvt_pk_bf16(o[0], o[1]); w.y = cvt_pk_bf16(o[2], o[3]);
                    if (r >= 2 && row < 16384) *(u32x2*)(Aout + (size_t)row * 2816 + ch0 + 4 * n) = w; }
            }
        }
    }
};
template <class Epi, class Sched, bool ALIGN_EPI = false, bool SP2 = false>
__device__ __forceinline__ void gemm_phase(PG8_LAS unsigned char* lds, const Gemm g, const Sched& S, const Epi& E) {
    int tid = threadIdx.x; asm volatile("" : "+v"(tid));
    const int wid = __builtin_amdgcn_readfirstlane(tid >> 6), lane = tid & 63, wr = wid >> 2, wc = wid & 3, fr = lane & 15, fq = lane >> 4;
    const int K = g.K, nt = K / BK;
    unsigned voffA[2], voffB[2];
#pragma unroll
    for (int i = 0; i < 2; ++i) { int R, C; stage_rc(tid * 16 + i * 8192, R, C); const int Rb = Epi::PERM ? ((R & ~31) + perm32(R & 31)) : R;
        voffA[i] = (unsigned)(R * K + C) * 2u; voffB[i] = (unsigned)(Rb * K + C) * 2u; }
    const size_t kstep = (size_t)(BK * 2);
    const size_t hstep = (size_t)HALF * K * 2;
    const size_t tstep = 2 * hstep;
    const size_t tstepA = (size_t)g.arows * K * 2;
    const unsigned ldsw = (unsigned)wid * 1024u;
    const int aoff = lds_byte(wr * 64 + fr, fq * 8), boff = lds_byte(wc * 32 + fr, fq * 8);
#define PG8_SA(b, h) (((b) * 2 + (h)) * HTB)
#define PG8_SB(b, h) ((4 + (b) * 2 + (h)) * HTB)
#define PG8_STAGE(bufoff, gbase, voff) do { _Pragma("unroll") for (int _i = 0; _i < 2; ++_i) \
        __builtin_amdgcn_global_load_lds((const unsigned*)((const char*)(gbase) + (voff)[_i]), (PG8_LAS unsigned*)(lds + (bufoff) + ldsw + _i * 8192), 16, 0, 0); } while (0)
#define PG8_LDA(dst, b, h) do { _Pragma("unroll") for (int m = 0; m < 4; ++m) _Pragma("unroll") for (int k = 0; k < 2; ++k) dst[m][k] = *(const PG8_LAS bf16x8*)(lds + PG8_SA(b, h) + aoff + m * 2048 + k * 1024); } while (0)
#define PG8_LDB(dst, b, h) do { _Pragma("unroll") for (int n = 0; n < 2; ++n) _Pragma("unroll") for (int k = 0; k < 2; ++k) dst[n][k] = *(const PG8_LAS bf16x8*)(lds + PG8_SB(b, h) + boff + n * 2048 + k * 1024); } while (0)
#define PG8_MMA(ai, bj, At, Bt) do { __builtin_amdgcn_s_setprio(1); _Pragma("unroll") for (int m = 0; m < 4; ++m) _Pragma("unroll") for (int n = 0; n < 2; ++n) _Pragma("unroll") for (int k = 0; k < 2; ++k) \
        acc[ai][bj][m][n] = __builtin_amdgcn_mfma_f32_16x16x32_bf16(Bt[n][k], At[m][k], acc[ai][bj][m][n], 0, 0, 0); __builtin_amdgcn_s_setprio(0); } while (0)
#define PG8_WAIT_V(n) asm volatile("s_waitcnt vmcnt(" #n ")" ::: "memory")
#define PG8_WAIT_L(n) asm volatile("s_waitcnt lgkmcnt(" #n ")" ::: "memory")
#define PG8_BAR __builtin_amdgcn_s_barrier()
#define PG8_SCHED __builtin_amdgcn_sched_barrier(0)
    Unit cur, nxt; int ui = 0;
    if (!S.next(0, cur)) return;
    f32x4 acc[2][2][4][2];
#pragma unroll
    for (int a = 0; a < 2; ++a)
#pragma unroll
        for (int b = 0; b < 2; ++b)
#pragma unroll
            for (int m = 0; m < 4; ++m)
#pragma unroll
                for (int n = 0; n < 2; ++n) acc[a][b][m][n] = (f32x4){0.f, 0.f, 0.f, 0.f};
    bf16x8 At[4][2], B0[2][2], B1[2][2];
    const char* cA = (const char*)g.A + (size_t)cur.pm * tstepA; const char* cB = (const char*)g.Bt + (size_t)cur.pn * tstep;
    S.a_ready(cur);
    if constexpr (SP2) {
        PG8_STAGE(PG8_SB(0, 0), cB, voffB); PG8_STAGE(PG8_SB(0, 1), cB + hstep, voffB); PG8_STAGE(PG8_SA(0, 0), cA, voffA); PG8_STAGE(PG8_SA(0, 1), cA + hstep, voffA);
        if (wr == 1) PG8_BAR;
        PG8_WAIT_V(2); PG8_BAR;
        PG8_STAGE(PG8_SB(1, 0), cB + kstep, voffB); PG8_STAGE(PG8_SA(1, 0), cA + kstep, voffA); PG8_STAGE(PG8_SB(1, 1), cB + hstep + kstep, voffB);
        PG8_WAIT_V(6); PG8_BAR;
    } else {
        PG8_STAGE(PG8_SB(0, 0), cB, voffB); PG8_STAGE(PG8_SA(0, 0), cA, voffA); PG8_STAGE(PG8_SB(0, 1), cB + hstep, voffB); PG8_STAGE(PG8_SA(0, 1), cA + hstep, voffA);
        if (wr == 1) PG8_BAR;
        PG8_WAIT_V(4); PG8_BAR;
        PG8_STAGE(PG8_SB(1, 0), cB + kstep, voffB); PG8_STAGE(PG8_SA(1, 0), cA + kstep, voffA); PG8_STAGE(PG8_SB(1, 1), cB + hstep + kstep, voffB);
        PG8_WAIT_V(6); PG8_BAR;
    }
    for (;;) {
        const bool has_next = S.next(ui + 1, nxt);
        const char* nA = has_next ? (const char*)g.A + (size_t)nxt.pm * tstepA : cA; const char* nB = has_next ? (const char*)g.Bt + (size_t)nxt.pn * tstep : cB;
        for (int t = 0; t < nt; t += 2) {
            const bool last = (t == nt - 2);
            const char* a1 = cA + (size_t)(t + 1) * kstep;
            const char* a2 = last ? nA : cA + (size_t)(t + 2) * kstep; const char* b2 = last ? nB : cB + (size_t)(t + 2) * kstep;
            const char* a3 = a2 + kstep; const char* b3 = b2 + kstep;
            if (last && has_next) S.a_ready(nxt);
            if constexpr (SP2) {
            PG8_LDB(B0, 0, 0); PG8_LDB(B1, 0, 1); PG8_SCHED; PG8_LDA(At, 0, 0); PG8_STAGE(PG8_SA(1, 1), a1 + hstep, voffA);
            PG8_WAIT_V(8); PG8_WAIT_L(0); PG8_BAR; PG8_MMA(0, 0, At, B0); PG8_MMA(0, 1, At, B1); PG8_BAR; PG8_SCHED;
            PG8_LDA(At, 0, 1); PG8_STAGE(PG8_SB(0, 0), b2, voffB); PG8_STAGE(PG8_SB(0, 1), b2 + hstep, voffB); PG8_STAGE(PG8_SA(0, 0), a2, voffA);
            PG8_WAIT_V(8); PG8_WAIT_L(0); PG8_BAR; PG8_MMA(1, 0, At, B0); PG8_MMA(1, 1, At, B1); PG8_BAR; PG8_SCHED;
            PG8_LDB(B0, 1, 0); PG8_LDB(B1, 1, 1); PG8_SCHED; PG8_LDA(At, 1, 0); PG8_STAGE(PG8_SA(0, 1), a2 + hstep, voffA);
            PG8_WAIT_V(8); PG8_WAIT_L(0); PG8_BAR; PG8_MMA(0, 0, At, B0); PG8_MMA(0, 1, At, B1); PG8_BAR; PG8_SCHED;
            PG8_LDA(At, 1, 1); PG8_STAGE(PG8_SB(1, 0), b3, voffB); PG8_STAGE(PG8_SB(1, 1), b3 + hstep, voffB); PG8_STAGE(PG8_SA(1, 0), a3, voffA);
            PG8_WAIT_V(8); PG8_WAIT_L(0); PG8_BAR; PG8_MMA(1, 0, At, B0); PG8_MMA(1, 1, At, B1); PG8_BAR; PG8_SCHED;
            } else {
            PG8_LDB(B0, 0, 0); PG8_SCHED; PG8_LDA(At, 0, 0); PG8_STAGE(PG8_SA(1, 1), a1 + hstep, voffA);
            PG8_WAIT_L(8); PG8_BAR; PG8_WAIT_L(0); PG8_MMA(0, 0, At, B0); PG8_BAR; PG8_SCHED;
            PG8_LDB(B1, 0, 1); PG8_STAGE(PG8_SB(0, 0), b2, voffB);
            PG8_BAR; PG8_WAIT_L(0); PG8_MMA(0, 1, At, B1); PG8_BAR;
            PG8_LDA(At, 0, 1); PG8_STAGE(PG8_SA(0, 0), a2, voffA);
            PG8_BAR; PG8_WAIT_L(0); PG8_MMA(1, 0, At, B0); PG8_BAR; PG8_SCHED;
            PG8_STAGE(PG8_SB(0, 1), b2 + hstep, voffB);
            PG8_WAIT_V(6); PG8_BAR; PG8_MMA(1, 1, At, B1); PG8_BAR;
            PG8_LDB(B0, 1, 0); PG8_SCHED; PG8_LDA(At, 1, 0); PG8_STAGE(PG8_SA(0, 1), a2 + hstep, voffA);
            PG8_WAIT_L(8); PG8_BAR; PG8_WAIT_L(0); PG8_MMA(0, 0, At, B0); PG8_BAR; PG8_SCHED;
            PG8_LDB(B1, 1, 1); PG8_STAGE(PG8_SB(1, 0), b3, voffB);
            PG8_BAR; PG8_WAIT_L(0); PG8_MMA(0, 1, At, B1); PG8_BAR;
            PG8_LDA(At, 1, 1); PG8_STAGE(PG8_SA(1, 0), a3, voffA);
            PG8_BAR; PG8_WAIT_L(0); PG8_MMA(1, 0, At, B0); PG8_BAR; PG8_SCHED;
            PG8_STAGE(PG8_SB(1, 1), b3 + hstep, voffB);
            PG8_WAIT_V(6); PG8_BAR; PG8_MMA(1, 1, At, B1); PG8_BAR;
            }
        }
        if constexpr (ALIGN_EPI) { if (wr == 0) PG8_BAR; }
        if constexpr (!Epi::AFTER_DRAIN) { E(acc, cur, wr, wc, fr, fq); S.done(cur); }
        if (!has_next) break;
#pragma unroll
        for (int a = 0; a < 2; ++a)
#pragma unroll
            for (int b = 0; b < 2; ++b)
#pragma unroll
                for (int m = 0; m < 4; ++m)
#pragma unroll
                    for (int n = 0; n < 2; ++n) acc[a][b][m][n] = (f32x4){0.f, 0.f, 0.f, 0.f};
        cur = nxt; cA = nA; cB = nB; ++ui;
        if constexpr (ALIGN_EPI) { if (wr == 1) PG8_BAR; }
    }
    PG8_WAIT_V(0);
    if constexpr (!ALIGN_EPI) { if (wr == 0) PG8_BAR; }
    PG8_BAR;
    if constexpr (Epi::AFTER_DRAIN) { E.fused(acc, cur, wr, wc, fr, fq, lds, wid, lane); S.done(cur); }
#undef PG8_SA
#undef PG8_SB
#undef PG8_STAGE
#undef PG8_LDA
#undef PG8_LDB
#undef PG8_MMA
#undef PG8_WAIT_V
#undef PG8_WAIT_L
#undef PG8_BAR
#undef PG8_SCHED
}
}
constexpr int S = 16384, DM = 1024, DEPTH = 4, NIN = 2816, DFF = 2816, NUP = 5632;
constexpr float EPS = 1e-6f;
constexpr int NWAVES = 8, NTHR = 512;
constexpr size_t MiB = 1u << 20;
constexpr size_t WS_WIN = 1 * MiB, WS_WOUT = 23 * MiB, WS_WUP = 31 * MiB, WS_WDN = 75 * MiB;
constexpr size_t WS_PART = 97 * MiB;
constexpr size_t WS_XB = 98 * MiB + 4096;
constexpr size_t WS_P = 131 * MiB;
constexpr size_t WS_Y = 219 * MiB;
constexpr size_t WS_GU = 131 * MiB;
constexpr size_t WS_A = 219 * MiB;
constexpr size_t WS_END = 307 * MiB;
constexpr int LDS_BYTES = 147456;
#define LAS __attribute__((address_space(3)))
typedef unsigned short bf16;
typedef unsigned v4u __attribute__((ext_vector_type(4)));
typedef unsigned v2u __attribute__((ext_vector_type(2)));
typedef float f32x4 __attribute__((ext_vector_type(4)));
typedef float f32x16 __attribute__((ext_vector_type(16)));
typedef short bf16x8 __attribute__((ext_vector_type(8)));
#define LDS_WAIT() asm volatile("s_waitcnt lgkmcnt(0)" ::: "memory")
__device__ __forceinline__ unsigned pk2(float lo, float hi) { return pg8::cvt_pk_bf16(lo, hi); }
__device__ __forceinline__ float bflo(unsigned u) { return __uint_as_float(u << 16); }
__device__ __forceinline__ float bfhi(unsigned u) { return __uint_as_float(u & 0xffff0000u); }
__device__ __forceinline__ float bf1(bf16 v) { return __uint_as_float((unsigned)v << 16); }
#define WS_DPP(v, ctrl) __builtin_bit_cast(float, __builtin_amdgcn_update_dpp(0, __builtin_bit_cast(int, (float)(v)), (ctrl), 0xf, 0xf, true))
__device__ __forceinline__ float wave_sum(float v) {
    v += WS_DPP(v, 0xB1); v += WS_DPP(v, 0x4E); v += WS_DPP(v, 0x141); v += WS_DPP(v, 0x140);
    const int iv = __builtin_bit_cast(int, v);
    const float a = __builtin_bit_cast(float, __builtin_amdgcn_readlane(iv, 0)), b = __builtin_bit_cast(float, __builtin_amdgcn_readlane(iv, 16));
    const float c = __builtin_bit_cast(float, __builtin_amdgcn_readlane(iv, 32)), d = __builtin_bit_cast(float, __builtin_amdgcn_readlane(iv, 48));
    return (a + b) + (c + d);
}

__device__ __forceinline__ void cvt_item(const float* W, int K, int N, bf16* WT, const float* gain, int mode, LAS float* scr, int item, int lane) {
    const int nblk = N / 32, kb = item / nblk, nb = item % nblk, k0 = 64 * kb, n0 = 32 * nb;
    float wv[32];
#pragma unroll
    for (int i = 0; i < 32; ++i) { const int kk = 2 * i + (lane >> 5); wv[i] = W[(size_t)(k0 + kk) * N + n0 + (lane & 31)]; }
#pragma unroll
    for (int i = 0; i < 32; ++i) { const int kk = 2 * i + (lane >> 5); const float g = gain ? gain[k0 + kk] : 1.0f; scr[kk * 33 + (lane & 31)] = wv[i] * g; }
    LDS_WAIT(); asm volatile("" ::: "memory");
    const float cs = (mode == 1 && n0 >= 1280 && n0 < 1792) ? 0.125f * 1.4426950408889634f : 1.0f;
    int rb = n0;
    if (mode == 2) { rb = (n0 < DFF) ? 256 * (n0 / 128) + (n0 % 128) : 256 * ((n0 - DFF) / 128) + 128 + ((n0 - DFF) % 128); }
    const int c = lane & 7;
#pragma unroll
    for (int j = 0; j < 4; ++j) { const int n = (lane >> 3) + 8 * j; const LAS float* s = scr + (8 * c) * 33 + n;
        v4u o; o.x = pk2(s[0 * 33] * cs, s[1 * 33] * cs); o.y = pk2(s[2 * 33] * cs, s[3 * 33] * cs); o.z = pk2(s[4 * 33] * cs, s[5 * 33] * cs); o.w = pk2(s[6 * 33] * cs, s[7 * 33] * cs);
        *(v4u*)(WT + (size_t)(rb + n) * K + k0 + 8 * c) = o; }
    LDS_WAIT(); asm volatile("" ::: "memory");
}

typedef __attribute__((address_space(1))) unsigned gu32;
#define XB_TMO      128
#define XB_XCNT(j)  (256  + 64 * (j))
#define XB_XSUB(j)  (1280 + 64 * (j))
#define XB_XGEN(j)  (2304 + 64 * (j))
#define XB_TOP      3328
#define XB_TOPGEN   3392
#define XCD_BAR_WORDS 3456
#define XB_SPIN_CAP (1u << 18)

__device__ __forceinline__ unsigned xb_ld(unsigned* p)              { return __hip_atomic_load(p, __ATOMIC_RELAXED, __HIP_MEMORY_SCOPE_AGENT); }
__device__ __forceinline__ unsigned xb_add(unsigned* p, unsigned v) { return __hip_atomic_fetch_add(p, v, __ATOMIC_RELAXED, __HIP_MEMORY_SCOPE_AGENT); }
__device__ __forceinline__ unsigned xb_xcc_id() { return (unsigned)__builtin_amdgcn_s_getreg((3 << 11) | 20) & 0xFu; }
#define XB_SPIN(cond, bar) do { unsigned _sp = 0; while (cond) { __builtin_amdgcn_s_sleep(1); \
    if ((++_sp & 255u) == 0u) { if (xb_ld(&(bar)[XB_TMO])) break; if (_sp > XB_SPIN_CAP) { atomicAdd(&(bar)[XB_TMO], 1u); break; } } } } while (0)

struct XcdBarrier {
    unsigned* bar; unsigned x;
    volatile LAS unsigned* st;
};

__device__ __forceinline__ XcdBarrier xcd_barrier_post(unsigned* bar, volatile LAS unsigned* st) {
    XcdBarrier b; b.bar = bar; b.x = xb_xcc_id(); b.st = st;
    if (threadIdx.x == 0) (void)xb_add(&bar[XB_XCNT(b.x)], 1u);
    return b;
}
__device__ __forceinline__ void xcd_barrier_complete(unsigned* bar, unsigned x, unsigned& nloc, unsigned& nx) {
    const unsigned G = gridDim.x * gridDim.y * gridDim.z;
    unsigned sum, cnt, mine, sp = 0u;
    for (;;) {
        sum = 0u; cnt = 0u; mine = 0u;
#pragma unroll
        for (unsigned j = 0; j < 16; ++j) { const unsigned c = xb_ld(&bar[XB_XCNT(j)]); sum += c; cnt += (c > 0u) ? 1u : 0u; mine = (j == x) ? c : mine; }
        if (sum == G) break;
        __builtin_amdgcn_s_sleep(1);
        if ((++sp & 255u) == 0u) { if (xb_ld(&bar[XB_TMO])) break; if (sp > XB_SPIN_CAP) { atomicAdd(&bar[XB_TMO], 1u); break; } }
    }
    nloc = mine > 0u ? mine : 1u; nx = cnt > 0u ? cnt : 1u;
}

__device__ __forceinline__ void xcd_barrier(const XcdBarrier& b) {
    asm volatile("s_waitcnt vmcnt(0)" ::: "memory");
    __syncthreads();
    if (threadIdx.x == 0) {
        unsigned* bar = b.bar;
        __builtin_amdgcn_s_waitcnt(0);
        unsigned nloc = b.st[0], nx = b.st[1];
        if (nloc == 0u) { xcd_barrier_complete(bar, b.x, nloc, nx); b.st[0] = nloc; b.st[1] = nx; }
        const unsigned old = xb_add(&bar[XB_XSUB(b.x)], 1u);
        const unsigned gen = old / nloc;
        if (old + 1u == (gen + 1u) * nloc) {
            __builtin_amdgcn_fence(__ATOMIC_RELEASE, "agent");
            asm volatile("s_waitcnt vmcnt(0)" ::: "memory");
            const unsigned og = xb_add(&bar[XB_TOP], 1u);
            const unsigned tg = og / nx;
            if (og + 1u == (tg + 1u) * nx) xb_add(&bar[XB_TOPGEN], 1u);
            else XB_SPIN(xb_ld(&bar[XB_TOPGEN]) == tg, bar);
            __builtin_amdgcn_fence(__ATOMIC_ACQUIRE, "agent");
            xb_add(&bar[XB_XGEN(b.x)], 1u);
            asm volatile("s_waitcnt vmcnt(0)" ::: "memory");
        } else {
            XB_SPIN(xb_ld(&bar[XB_XGEN(b.x)]) == gen, bar);
            __builtin_amdgcn_fence(__ATOMIC_ACQUIRE, "agent");
            asm volatile("s_waitcnt vmcnt(0)" ::: "memory");
        }
    }
    __syncthreads();
}

struct CvtSrc { const float *w_in, *w_out, *w_up, *w_down, *norm_mix, *out_norm, *norm_ffn; bf16 *Win_t, *Wout_t, *Wup_t, *Wdn_t; };
__device__ __forceinline__ void cvt_layer_item(const CvtSrc& c, int l, int r, LAS float* scr, int lane) {
    const float* W; bf16* WT; const float* gain; int K, N, mode;
    if (r < 1408) { W = c.w_in + (size_t)l * DM * NIN; K = DM; N = NIN; WT = c.Win_t + (size_t)l * NIN * DM; gain = c.norm_mix + l * DM; mode = 1; }
    else if (r < 1920) { r -= 1408; W = c.w_out + (size_t)l * DM * DM; K = DM; N = DM; WT = c.Wout_t + (size_t)l * DM * DM; gain = c.out_norm + l * DM; mode = 0; }
    else if (r < 4736) { r -= 1920; W = c.w_up + (size_t)l * DM * NUP; K = DM; N = NUP; WT = c.Wup_t + (size_t)l * NUP * DM; gain = c.norm_ffn + l * DM; mode = 2; }
    else { r -= 4736; W = c.w_down + (size_t)l * DFF * DM; K = DFF; N = DM; WT = c.Wdn_t + (size_t)l * DM * DFF; gain = nullptr; mode = 0; }
    cvt_item(W, K, N, WT, gain, mode, scr, r, lane);
}
__device__ __forceinline__ const float* ldptr(const volatile LAS unsigned* PT, int k) {
    const unsigned lo = __builtin_amdgcn_readfirstlane(PT[2 * k]), hi = __builtin_amdgcn_readfirstlane(PT[2 * k + 1]);
    return (const float*)(((unsigned long long)hi << 32) | lo);
}
struct Args { const float* in[14]; float* out; unsigned char* ws; };

__device__ __forceinline__ void norm_store_rows(const LAS float* tile, bf16* Y, int t0, int coff, int wave, int lane) {
#pragma unroll 2
    for (int i = 0; i < 8; ++i) { const int r = wave * 8 + i; const f32x4 v = *(const LAS f32x4*)(tile + r * 260 + lane * 4);
        const float ss = wave_sum((v[0] * v[0] + v[1] * v[1]) + (v[2] * v[2] + v[3] * v[3]));
        const float rs = __builtin_amdgcn_rsqf(ss * (1.0f / 256.0f) + EPS);
        v2u o; o.x = pk2(v[0] * rs, v[1] * rs); o.y = pk2(v[2] * rs, v[3] * rs);
        *(v2u*)(Y + (size_t)(t0 + r) * DM + coff + lane * 4) = o; }
}

__device__ __forceinline__ void mixer_unit(LAS unsigned char* lds, int unit, const bf16* P, bf16* Y, const float* conv_w, const float* sgu_norm, const float* sgu_w, const float* sgu_b, int tid, int wave, int lane) {
    const int t0 = unit * 64;
    asm volatile("" : "+v"(tid), "+v"(lane));
    LAS bf16* vnT = (LAS bf16*)lds;
    LAS float* tile = (LAS float*)(lds + 69632);
    LAS float* sm_ss = (LAS float*)(lds + 69632 + 66560);
    {
        const int hd = wave, r = lane & 31, h = lane >> 5;
        const int pr = (r & 0x13) | ((r & 4) << 1) | ((r & 8) >> 1);
        LAS bf16* Vt = (LAS bf16*)(lds + wave * 5120);
        bf16x8 atri[2];
#pragma unroll
        for (int sI = 0; sI < 2; ++sI) { v4u t;
            t.x = ((16 * sI + 8 * h + 0 > pr) ? 0x3F80u : 0u) | ((16 * sI + 8 * h + 1 > pr) ? 0x3F800000u : 0u); t.y = ((16 * sI + 8 * h + 2 > pr) ? 0x3F80u : 0u) | ((16 * sI + 8 * h + 3 > pr) ? 0x3F800000u : 0u);
            t.z = ((16 * sI + 8 * h + 4 > pr) ? 0x3F80u : 0u) | ((16 * sI + 8 * h + 5 > pr) ? 0x3F800000u : 0u); t.w = ((16 * sI + 8 * h + 6 > pr) ? 0x3F80u : 0u) | ((16 * sI + 8 * h + 7 > pr) ? 0x3F800000u : 0u);
            atri[sI] = __builtin_bit_cast(bf16x8, t); }
        f32x16 oacc[2][2];
        bf16x8 kfn[4]; v4u vvn[4];
        { const bf16* kp = P + (size_t)(t0 + 32 + pr) * NIN + 1792 + hd * 64 + 8 * h;
#pragma unroll
          for (int ks = 0; ks < 4; ++ks) kfn[ks] = *(const bf16x8*)(kp + 16 * ks);
#pragma unroll
          for (int i = 0; i < 4; ++i) vvn[i] = *(const v4u*)(P + (size_t)(t0 + 32 + (lane >> 3) + 8 * i) * NIN + 2304 + hd * 64 + 8 * (lane & 7)); }
        LAS bf16x8* Qs = (LAS bf16x8*)(lds + 40960 + wave * 8192);
#pragma unroll
        for (int ks = 0; ks < 4; ++ks) { Qs[ks * 64 + lane] = *(const bf16x8*)(P + (size_t)(t0 + r) * NIN + 1280 + hd * 64 + 16 * ks + 8 * h); Qs[(4 + ks) * 64 + lane] = *(const bf16x8*)(P + (size_t)(t0 + 32 + r) * NIN + 1280 + hd * 64 + 16 * ks + 8 * h); }
#pragma unroll
        for (int a = 0; a < 2; ++a)
#pragma unroll
            for (int b = 0; b < 2; ++b) oacc[a][b] = (f32x16){};
        float lsA = 0.f, lsB = 0.f; bool actA = true, actB = true;
#define SB_CHAIN(Z, O0, O1, LS, DIAGV) do { \
            f32x16 cin; float Lv[16]; \
            _Pragma("unroll") for (int jj = 0; jj < 16; ++jj) { const float zz = Z[jj]; const float ex = __builtin_amdgcn_exp2f(-fabsf(zz)); const float lsig = fminf(zz, 0.f) - __builtin_amdgcn_logf(1.0f + ex); \
                Lv[jj] = lsig - zz; cin[jj] = lsig + LS; } \
            if (DIAGV) { _Pragma("unroll") for (int jj = 0; jj < 16; ++jj) { const int keyl = 16 * (jj >> 3) + 8 * h + (jj & 7); Lv[jj] = (keyl < r) ? Lv[jj] : 0.f; } } \
            float rowsum = 0.f; unsigned lh[8], ll[8]; \
            _Pragma("unroll") for (int j = 0; j < 16; j += 2) { rowsum += Lv[j] + Lv[j + 1]; \
                const unsigned hp = pk2(Lv[j], Lv[j + 1]); lh[j >> 1] = hp; ll[j >> 1] = pk2(Lv[j] - bflo(hp), Lv[j + 1] - bfhi(hp)); } \
            const bf16x8 bh0 = __builtin_bit_cast(bf16x8, (v4u){lh[0], lh[1], lh[2], lh[3]}), bh1 = __builtin_bit_cast(bf16x8, (v4u){lh[4], lh[5], lh[6], lh[7]}); \
            const bf16x8 bl0 = __builtin_bit_cast(bf16x8, (v4u){ll[0], ll[1], ll[2], ll[3]}), bl1 = __builtin_bit_cast(bf16x8, (v4u){ll[4], ll[5], ll[6], ll[7]}); \
            f32x16 lw = __builtin_amdgcn_mfma_f32_32x32x16_bf16(atri[0], bh0, cin, 0, 0, 0); \
            lw = __builtin_amdgcn_mfma_f32_32x32x16_bf16(atri[1], bh1, lw, 0, 0, 0); \
            lw = __builtin_amdgcn_mfma_f32_32x32x16_bf16(atri[0], bl0, lw, 0, 0, 0); \
            lw = __builtin_amdgcn_mfma_f32_32x32x16_bf16(atri[1], bl1, lw, 0, 0, 0); \
            float wv[16]; \
            _Pragma("unroll") for (int jj = 0; jj < 16; ++jj) wv[jj] = __builtin_amdgcn_exp2f(lw[jj]); \
            if (DIAGV) { _Pragma("unroll") for (int jj = 0; jj < 16; ++jj) { const int keyl = 16 * (jj >> 3) + 8 * h + (jj & 7); wv[jj] = (keyl < r) ? wv[jj] : 0.f; } } \
            unsigned wp[8]; \
            _Pragma("unroll") for (int j = 0; j < 16; j += 2) wp[j >> 1] = pk2(wv[j], wv[j + 1]); \
            const bf16x8 w0 = __builtin_bit_cast(bf16x8, (v4u){wp[0], wp[1], wp[2], wp[3]}), w1 = __builtin_bit_cast(bf16x8, (v4u){wp[4], wp[5], wp[6], wp[7]}); \
            const LAS bf16* vr = Vt + r * 40 + 8 * h; \
            O0 = __builtin_amdgcn_mfma_f32_32x32x16_bf16(*(const LAS bf16x8*)(vr), w0, O0, 0, 0, 0); \
            O0 = __builtin_amdgcn_mfma_f32_32x32x16_bf16(*(const LAS bf16x8*)(vr + 16), w1, O0, 0, 0, 0); \
            O1 = __builtin_amdgcn_mfma_f32_32x32x16_bf16(*(const LAS bf16x8*)(vr + 32 * 40), w0, O1, 0, 0, 0); \
            O1 = __builtin_amdgcn_mfma_f32_32x32x16_bf16(*(const LAS bf16x8*)(vr + 32 * 40 + 16), w1, O1, 0, 0, 0); \
            LS += rowsum + __shfl_xor(rowsum, 32); } while (0)
        for (int k0 = t0 + 32;; k0 -= 32) {
            const bool doA = actA && (k0 <= t0);
            f32x16 zB = {}, zA = {};
            if (actB) {
#pragma unroll
                for (int ks = 0; ks < 4; ++ks) zB = __builtin_amdgcn_mfma_f32_32x32x16_bf16(kfn[ks], Qs[(4 + ks) * 64 + lane], zB, 0, 0, 0); }
            if (doA) {
#pragma unroll
                for (int ks = 0; ks < 4; ++ks) zA = __builtin_amdgcn_mfma_f32_32x32x16_bf16(kfn[ks], Qs[ks * 64 + lane], zA, 0, 0, 0); }
#pragma unroll
            for (int i = 0; i < 4; ++i) { const int key = (lane >> 3) + 8 * i, c = lane & 7; const v4u vv = vvn[i];
                LAS bf16* vd = Vt + (8 * c) * 40 + key;
                vd[0] = (bf16)(vv.x & 0xffffu); vd[40] = (bf16)(vv.x >> 16); vd[80] = (bf16)(vv.y & 0xffffu); vd[120] = (bf16)(vv.y >> 16);
                vd[160] = (bf16)(vv.z & 0xffffu); vd[200] = (bf16)(vv.z >> 16); vd[240] = (bf16)(vv.w & 0xffffu); vd[280] = (bf16)(vv.w >> 16); }
            if (k0 >= 32) { const bf16* kp = P + (size_t)(k0 - 32 + pr) * NIN + 1792 + hd * 64 + 8 * h;
#pragma unroll
                for (int ks = 0; ks < 4; ++ks) kfn[ks] = *(const bf16x8*)(kp + 16 * ks);
#pragma unroll
                for (int i = 0; i < 4; ++i) vvn[i] = *(const v4u*)(P + (size_t)(k0 - 32 + (lane >> 3) + 8 * i) * NIN + 2304 + hd * 64 + 8 * (lane & 7)); }
            if (actB) { const bool dg = (k0 == t0 + 32); SB_CHAIN(zB, oacc[1][0], oacc[1][1], lsB, dg);
                if (__builtin_amdgcn_ballot_w64(lsB > -150.1f) == 0ull) actB = false; }
            if (doA) { const bool dg = (k0 == t0); SB_CHAIN(zA, oacc[0][0], oacc[0][1], lsA, dg);
                if (__builtin_amdgcn_ballot_w64(lsA > -150.1f) == 0ull) actA = false; }
            if (k0 < 32 || !(actA || actB)) break;
        }
#undef SB_CHAIN
#pragma unroll
        for (int qh = 0; qh < 2; ++qh) { float ss = 0.f;
#pragma unroll
            for (int j = 0; j < 16; ++j) ss += oacc[qh][0][j] * oacc[qh][0][j] + oacc[qh][1][j] * oacc[qh][1][j];
            ss += __shfl_xor(ss, 32);
            if (h == 0) sm_ss[(32 * qh + r) * 8 + hd] = ss; }
        LDS_WAIT(); __syncthreads();
#pragma unroll
        for (int qh = 0; qh < 2; ++qh) {
            const f32x4 sa = *(const LAS f32x4*)(sm_ss + (32 * qh + r) * 8), sb = *(const LAS f32x4*)(sm_ss + (32 * qh + r) * 8 + 4);
            const float tot = ((sa[0] + sa[1]) + (sa[2] + sa[3])) + ((sb[0] + sb[1]) + (sb[2] + sb[3]));
            const float rs = __builtin_amdgcn_rsqf(tot * (1.0f / 512.0f) + EPS);
            bf16* yp = Y + (size_t)(t0 + 32 * qh + r) * DM + 512 + hd * 64 + 4 * h;
#pragma unroll
            for (int db = 0; db < 2; ++db)
#pragma unroll
                for (int g4 = 0; g4 < 4; ++g4) { const f32x16& o = oacc[qh][db]; v2u w; w.x = pk2(o[4 * g4 + 0] * rs, o[4 * g4 + 1] * rs); w.y = pk2(o[4 * g4 + 2] * rs, o[4 * g4 + 3] * rs);
                    *(v2u*)(yp + 32 * db + 8 * g4) = w; }
        }
    }
    const int c8 = (tid & 31) * 8, rg = tid >> 5, tb = t0 + 4 * rg;
    v4u gb[4], gc[6], hc[6];
#pragma unroll
    for (int i = 0; i < 6; ++i) { const int t = tb - 2 + i; const bool ok = t >= 0; const bf16* rp = P + (size_t)(ok ? t : 0) * NIN;
        gc[i] = ok ? *(const v4u*)(rp + 256 + c8) : (v4u){0u, 0u, 0u, 0u}; hc[i] = ok ? *(const v4u*)(rp + 512 + c8) : (v4u){0u, 0u, 0u, 0u};
        if (i >= 2) gb[i - 2] = *(const v4u*)(rp + c8); }
    const int tc = t0 & ~127, dt = t0 - tc, ns = dt + 64;
    v2u uu[16];
#pragma unroll
    for (int i = 0; i < 16; ++i) { const int s = wave + 8 * i; uu[i] = (s < ns) ? *(const v2u*)(P + (size_t)(tc + s) * NIN + 1024 + lane * 4) : (v2u){0u, 0u}; }
    const int h = wave >> 1, rh = wave & 1, r32 = lane & 31, hi = lane >> 5;
    const int tcl = dt + 32 * rh + r32;
    const int nk = (dt + 32 * rh + 32) >> 4;
    f32x4 wa[8], wb[8];
    { const float* wrow = sgu_w + ((size_t)h * 128 + tcl) * 128;
#pragma unroll
      for (int ks = 0; ks < 8; ++ks) { const int s0 = ks * 16 + 8 * hi; if (ks < nk) { wa[ks] = *(const f32x4*)(wrow + s0); wb[ks] = *(const f32x4*)(wrow + s0 + 4); } else { wa[ks] = (f32x4){0.f, 0.f, 0.f, 0.f}; wb[ks] = wa[ks]; } } }
    {
        float w0[8], w1[8], w2[8];
        { const f32x4 a0 = *(const f32x4*)(conv_w + c8), a1 = *(const f32x4*)(conv_w + c8 + 4), b0 = *(const f32x4*)(conv_w + 256 + c8), b1 = *(const f32x4*)(conv_w + 256 + c8 + 4), d0 = *(const f32x4*)(conv_w + 512 + c8), d1 = *(const f32x4*)(conv_w + 512 + c8 + 4);
#pragma unroll
          for (int e = 0; e < 4; ++e) { w0[e] = a0[e]; w0[4 + e] = a1[e]; w1[e] = b0[e]; w1[4 + e] = b1[e]; w2[e] = d0[e]; w2[4 + e] = d1[e]; } }
        float pr_[6][8];
#pragma unroll
        for (int i = 0; i < 6; ++i) { const unsigned ga[4] = {gc[i].x, gc[i].y, gc[i].z, gc[i].w}, ha[4] = {hc[i].x, hc[i].y, hc[i].z, hc[i].w};
#pragma unroll
            for (int e = 0; e < 4; ++e) { pr_[i][2 * e] = bflo(ga[e]) * bflo(ha[e]); pr_[i][2 * e + 1] = bfhi(ga[e]) * bfhi(ha[e]); } }
#pragma unroll
        for (int i = 0; i < 4; ++i) { const unsigned ba[4] = {gb[i].x, gb[i].y, gb[i].z, gb[i].w}; float o[8];
#pragma unroll
            for (int e = 0; e < 4; ++e) { o[2 * e] = bflo(ba[e]) * (w0[2 * e] * pr_[i][2 * e] + w1[2 * e] * pr_[i + 1][2 * e] + w2[2 * e] * pr_[i + 2][2 * e]);
                o[2 * e + 1] = bfhi(ba[e]) * (w0[2 * e + 1] * pr_[i][2 * e + 1] + w1[2 * e + 1] * pr_[i + 1][2 * e + 1] + w2[2 * e + 1] * pr_[i + 2][2 * e + 1]); }
            LAS f32x4* tp = (LAS f32x4*)(tile + (4 * rg + i) * 260 + c8); tp[0] = (f32x4){o[0], o[1], o[2], o[3]}; tp[1] = (f32x4){o[4], o[5], o[6], o[7]}; }
    }
    LDS_WAIT(); __syncthreads();
    norm_store_rows(tile, Y, t0, 0, wave, lane);
    { const f32x4 g = *(const f32x4*)(sgu_norm + lane * 4);
#pragma unroll
      for (int i = 0; i < 16; ++i) { const int s = wave + 8 * i;
        if (s < ns) { const v2u u = uu[i];
        const float v0 = bflo(u.x), v1 = bfhi(u.x), v2 = bflo(u.y), v3 = bfhi(u.y);
        const float ss = wave_sum((v0 * v0 + v1 * v1) + (v2 * v2 + v3 * v3)); const float rs = __builtin_amdgcn_rsqf(ss * (1.0f / 256.0f) + EPS);
        const unsigned a = pk2(v0 * rs * g[0], v1 * rs * g[1]), b = pk2(v2 * rs * g[2], v3 * rs * g[3]);
        vnT[(lane * 4 + 0) * 136 + s] = (bf16)(a & 0xffffu); vnT[(lane * 4 + 1) * 136 + s] = (bf16)(a >> 16); vnT[(lane * 4 + 2) * 136 + s] = (bf16)(b & 0xffffu); vnT[(lane * 4 + 3) * 136 + s] = (bf16)(b >> 16); } } }
    float ug0[16], ug1[16], bbv[16];
#pragma unroll
    for (int j = 0; j < 16; ++j) { const int rl = 32 * rh + (j & 3) + 8 * (j >> 2) + 4 * hi; const bf16* up = P + (size_t)(t0 + rl) * NIN + 768 + h * 64;
        ug0[j] = bf1(up[r32]); ug1[j] = bf1(up[32 + r32]); bbv[j] = sgu_b[h * 128 + dt + rl]; }
    LDS_WAIT(); __syncthreads();
    {
        f32x16 o0 = {}, o1 = {};
#pragma unroll
        for (int ks = 0; ks < 8; ++ks) if (ks < nk) { const int s0 = ks * 16 + 8 * hi;
            float wv[8] = {wa[ks][0], wa[ks][1], wa[ks][2], wa[ks][3], wb[ks][0], wb[ks][1], wb[ks][2], wb[ks][3]};
#pragma unroll
            for (int i = 0; i < 8; ++i) wv[i] = (s0 + i <= tcl) ? wv[i] : 0.f;
            v4u ap; ap.x = pk2(wv[0], wv[1]); ap.y = pk2(wv[2], wv[3]); ap.z = pk2(wv[4], wv[5]); ap.w = pk2(wv[6], wv[7]);
            const bf16x8 af = __builtin_bit_cast(bf16x8, ap);
            const bf16x8 b0 = *(const LAS bf16x8*)(vnT + (h * 64 + r32) * 136 + s0), b1 = *(const LAS bf16x8*)(vnT + (h * 64 + 32 + r32) * 136 + s0);
            o0 = __builtin_amdgcn_mfma_f32_32x32x16_bf16(af, b0, o0, 0, 0, 0);
            o1 = __builtin_amdgcn_mfma_f32_32x32x16_bf16(af, b1, o1, 0, 0, 0); }
#pragma unroll
        for (int j = 0; j < 16; ++j) { const int rl = 32 * rh + (j & 3) + 8 * (j >> 2) + 4 * hi;
            tile[rl * 260 + h * 64 + r32] = ug0[j] * (o0[j] + bbv[j]);
            tile[rl * 260 + h * 64 + 32 + r32] = ug1[j] * (o1[j] + bbv[j]); }
    }
    LDS_WAIT(); __syncthreads();
    norm_store_rows(tile, Y, t0, 256, wave, lane);
    LDS_WAIT(); __syncthreads();
}

__device__ __forceinline__ void ffn_gate_phase(const bf16* GU, bf16* A, const float* fconv, int hf, int gtid, int gthreads) {
    for (int it = gtid; it < 256 * 176; it += gthreads) { const int rb = it / 176, cgp = it % 176, pnl = cgp >> 4, cc = (cgp & 15) * 8, ch = 1408 * hf + 128 * pnl + cc;
        float wg[3][8], wu[3][8];
#pragma unroll
        for (int i = 0; i < 3; ++i) { const f32x4 a0 = *(const f32x4*)(fconv + (size_t)i * NUP + ch), a1 = *(const f32x4*)(fconv + (size_t)i * NUP + ch + 4), b0 = *(const f32x4*)(fconv + (size_t)i * NUP + DFF + ch), b1 = *(const f32x4*)(fconv + (size_t)i * NUP + DFF + ch + 4);
#pragma unroll
            for (int e = 0; e < 4; ++e) { wg[i][e] = a0[e]; wg[i][4 + e] = a1[e]; wu[i][e] = b0[e]; wu[i][4 + e] = b1[e]; } }
        float g2[8], g1[8], u2[8], u1[8];
#pragma unroll
        for (int e = 0; e < 8; ++e) { g2[e] = g1[e] = u2[e] = u1[e] = 0.f; }
        for (int r = -2; r < 64; ++r) { const int t = 64 * rb + r; float g0[8], u0[8];
            if (t >= 0) { const v4u gv = *(const v4u*)(GU + (size_t)t * NIN + 256 * pnl + cc), uv = *(const v4u*)(GU + (size_t)t * NIN + 256 * pnl + 128 + cc);
                g0[0] = bflo(gv.x); g0[1] = bfhi(gv.x); g0[2] = bflo(gv.y); g0[3] = bfhi(gv.y); g0[4] = bflo(gv.z); g0[5] = bfhi(gv.z); g0[6] = bflo(gv.w); g0[7] = bfhi(gv.w);
                u0[0] = bflo(uv.x); u0[1] = bfhi(uv.x); u0[2] = bflo(uv.y); u0[3] = bfhi(uv.y); u0[4] = bflo(uv.z); u0[5] = bfhi(uv.z); u0[6] = bflo(uv.w); u0[7] = bfhi(uv.w); }
            else {
#pragma unroll
                for (int e = 0; e < 8; ++e) { g0[e] = 0.f; u0[e] = 0.f; } }
            if (r >= 0) { float o[8];
#pragma unroll
                for (int e = 0; e < 8; ++e) { const float G = wg[0][e] * g2[e] + wg[1][e] * g1[e] + wg[2][e] * g0[e], U = wu[0][e] * u2[e] + wu[1][e] * u1[e] + wu[2][e] * u0[e];
                    o[e] = G * __builtin_amdgcn_rcpf(1.0f + __expf(-G)) * U; }
                v4u ov; ov.x = pk2(o[0], o[1]); ov.y = pk2(o[2], o[3]); ov.z = pk2(o[4], o[5]); ov.w = pk2(o[6], o[7]);
                *(v4u*)(A + (size_t)t * DFF + ch) = ov; }
#pragma unroll
            for (int e = 0; e < 8; ++e) { g2[e] = g1[e]; g1[e] = g0[e]; u2[e] = u1[e]; u1[e] = u0[e]; } }
    }
}
__global__ void __launch_bounds__(NTHR, 2) hybrid_fwd(Args args) {
    extern __shared__ __attribute__((aligned(16))) unsigned char lds_raw[];
    LAS unsigned char* lds = (LAS unsigned char*)lds_raw;
    cg::grid_group grid = cg::this_grid();
    volatile LAS unsigned* MISC = (volatile LAS unsigned*)(lds + LDS_BYTES - 64);
    volatile LAS unsigned* PT = (volatile LAS unsigned*)(lds + LDS_BYTES - 256);
    if (threadIdx.x < 16) MISC[threadIdx.x] = 0u;
    if (threadIdx.x == 0) {
#define PUTP(k) { const unsigned long long v_ = (unsigned long long)args.in[k]; PT[2 * (k)] = (unsigned)v_; PT[2 * (k) + 1] = (unsigned)(v_ >> 32); }
        PUTP(0) PUTP(1) PUTP(2) PUTP(3) PUTP(4) PUTP(5) PUTP(6) PUTP(7) PUTP(8) PUTP(9) PUTP(10) PUTP(11) PUTP(12) PUTP(13)
#undef PUTP
    }
    __syncthreads();
    XcdBarrier xbar = xcd_barrier_post((unsigned*)args.ws, MISC);
    const int tid = threadIdx.x, lane = tid & 63, wave = __builtin_amdgcn_readfirstlane(tid >> 6);
    const int G = gridDim.x, bx = blockIdx.x;
    const int gw = bx * NWAVES + wave, NGW = G * NWAVES;
    unsigned char* ws = args.ws;
#define INP(k) ldptr(PT, (k))
#define MAKE_CS() const CvtSrc cs{INP(2), INP(8), INP(10), INP(12), INP(1), INP(7), INP(9), Win_t, Wout_t, Wup_t, Wdn_t}
    float* xo = args.out;
#define PHASE_PTRS() unsigned char* w_ = ws; float* xcur = xo; asm volatile("" : "+s"(w_), "+s"(xcur)); \
    bf16* Win_t = (bf16*)(w_ + WS_WIN); bf16* Wout_t = (bf16*)(w_ + WS_WOUT); bf16* Wup_t = (bf16*)(w_ + WS_WUP); bf16* Wdn_t = (bf16*)(w_ + WS_WDN); \
    float* part = (float*)(w_ + WS_PART); bf16* XB = (bf16*)(w_ + WS_XB); bf16* P = (bf16*)(w_ + WS_P); bf16* Y = (bf16*)(w_ + WS_Y); bf16* A = (bf16*)(w_ + WS_A); \
    (void)Win_t; (void)Wout_t; (void)Wup_t; (void)Wdn_t; (void)part; (void)XB; (void)P; (void)Y; (void)A; (void)xcur

    for (int step = -1; step < 5 * DEPTH; ++step) {
        const int l = step < 0 ? 0 : step / 5, ph = step < 0 ? -1 : step % 5;
        int cvt_layer = -1, cvt_first = 0, cvt_n = 0, cvt_nu = 0;
        if (ph < 0) {
            PHASE_PTRS(); const float* x_in = INP(0);
            int gw_ = gw, lane_ = lane; asm volatile("" : "+s"(gw_), "+v"(lane_));
            for (int m = gw_; m < S; m += NGW) { const f32x4* xr = (const f32x4*)(x_in + (size_t)m * DM) + lane_; f32x4 v[4]; float ss = 0.f;
#pragma unroll
                for (int j = 0; j < 4; ++j) { v[j] = xr[64 * j]; ss += (v[j][0] * v[j][0] + v[j][1] * v[j][1]) + (v[j][2] * v[j][2] + v[j][3] * v[j][3]); }
                ss = wave_sum(ss);
                v2u* o8 = (v2u*)(XB + (size_t)m * DM) + lane_;
#pragma unroll
                for (int j = 0; j < 4; ++j) { v2u o; o.x = pk2(v[j][0], v[j][1]); o.y = pk2(v[j][2], v[j][3]); o8[64 * j] = o; }
                if (lane_ < 16) part[(size_t)m * 16 + lane_] = lane_ == 0 ? ss : 0.f; }
            cvt_layer = 0; cvt_first = 0; cvt_n = 6144; cvt_nu = 0;
        } else if (ph == 0) {
            PHASE_PTRS(); pg8::Gemm g{XB, Win_t + (size_t)l * NIN * DM, S, NIN, DM, 256}; pg8::StaticOrder So; So.init(S, NIN, G, bx);
            pg8::EpiScaleBf16 E{P, NIN, part, (LAS float*)(lds + 131072 + 8192)};
            pg8::gemm_phase<pg8::EpiScaleBf16, pg8::StaticOrder, true, true>(lds, g, So, E);
            if (l + 1 < DEPTH) { cvt_layer = l + 1; cvt_first = 0; cvt_n = 1920; cvt_nu = (S / 256) * (NIN / 256); }
        } else if (ph == 1) {
            PHASE_PTRS();
            for (int u = bx; u < S / 64; u += G)
                mixer_unit(lds, u, P, Y, INP(3) + l * 3 * 256, INP(4) + l * 256, INP(5) + (size_t)l * 4 * 128 * 128, INP(6) + l * 4 * 128, tid, wave, lane);
        } else if (ph == 2) {
            PHASE_PTRS(); pg8::Gemm g{Y, Wout_t + (size_t)l * DM * DM, S, DM, DM, 256}; pg8::StaticOrder So; So.init(S, DM, G, bx);
            pg8::EpiResid E{XB, part};
            pg8::gemm_phase<pg8::EpiResid, pg8::StaticOrder, true, true>(lds, g, So, E);
        } else if (ph == 3) {
            PHASE_PTRS(); pg8::Gemm g{XB - 2 * DM, Wup_t + (size_t)l * NUP * DM, 65 * 256, NUP, DM, 254}; pg8::StaticOrder So; So.init(65 * 256, NUP, G, bx);
            pg8::EpiGate E{A, part, INP(11) + (size_t)l * 3 * NUP, (LAS float*)(lds + 131072)};
            pg8::gemm_phase<pg8::EpiGate, pg8::StaticOrder, true, true>(lds, g, So, E);
            if (l + 1 < DEPTH) { cvt_layer = l + 1; cvt_first = 1920; cvt_n = 4224; cvt_nu = 65 * (NUP / 256); }
        } else {
            PHASE_PTRS(); pg8::Gemm g{A, Wdn_t + (size_t)l * DM * DFF, S, DM, DFF, 256}; pg8::StaticOrder So; So.init(S, DM, G, bx);
            pg8::EpiResid E{XB, part};
            pg8::gemm_phase<pg8::EpiResid, pg8::StaticOrder, true, true>(lds, g, So, E);
        }
        if (cvt_layer >= 0) {
            const int first_idle = cvt_nu > 0 ? cvt_nu - ((cvt_nu + G - 1) / G - 1) * G : 0; const bool some_idle = first_idle < G;
            if (!some_idle || bx >= first_idle) { const int nw = (some_idle ? G - first_idle : G) * NWAVES, iw = (some_idle ? bx - first_idle : bx) * NWAVES + wave;
                PHASE_PTRS(); LAS float* scr = (LAS float*)(lds + wave * 16384); int lane_ = lane; asm volatile("" : "+v"(lane_));
                MAKE_CS(); for (int it = iw; it < cvt_n; it += nw) cvt_layer_item(cs, cvt_layer, cvt_first + it, scr, lane_); } }
        if (step < 0) grid.sync(); else xcd_barrier(xbar);
    }
    { const float* nfin = INP(13); const bf16* XBf = (const bf16*)(ws + WS_XB);
      for (int m = gw; m < S; m += NGW) { const v2u* xr = (const v2u*)(XBf + (size_t)m * DM) + lane; f32x4 v[4]; float ss = 0.f;
#pragma unroll
        for (int j = 0; j < 4; ++j) { const v2u u = xr[64 * j]; v[j] = (f32x4){bflo(u.x), bfhi(u.x), bflo(u.y), bfhi(u.y)}; ss += (v[j][0] * v[j][0] + v[j][1] * v[j][1]) + (v[j][2] * v[j][2] + v[j][3] * v[j][3]); }
        const float rs = __builtin_amdgcn_rsqf(wave_sum(ss) * (1.0f / 1024.0f) + EPS);
        f32x4* orow = (f32x4*)(xo + (size_t)m * DM) + lane;
#pragma unroll
        for (int j = 0; j < 4; ++j) { const f32x4 g = *((const f32x4*)nfin + lane + 64 * j); orow[64 * j] = v[j] * rs * g; } } }
}

extern "C" void kernel_launch(void* const* d_in, const int* in_sizes, int n_in, void* d_out, int out_size, void* d_ws, size_t ws_size, hipStream_t stream) {
    static int grid = 0;
    if (grid == 0) {
        if (n_in != 14 || out_size != S * DM || ws_size < WS_END) { fprintf(stderr, "kernel_launch: unexpected shapes / workspace (%d inputs, out %d, ws %zu)\n", n_in, out_size, ws_size); grid = -1; return; }
        int dev = 0, cus = 0, per_cu = 0;
        hipGetDevice(&dev); hipDeviceGetAttribute(&cus, hipDeviceAttributeMultiprocessorCount, dev);
        hipFuncSetAttribute((const void*)hybrid_fwd, hipFuncAttributeMaxDynamicSharedMemorySize, LDS_BYTES);
        hipOccupancyMaxActiveBlocksPerMultiprocessor(&per_cu, (const void*)hybrid_fwd, NTHR, LDS_BYTES);
        (void)hipGetLastError();
        if (per_cu < 1) per_cu = 1;
        grid = cus * 1;
    }
    if (grid < 0) return;
    hipMemsetAsync((unsigned char*)d_ws, 0, 16384, stream);
    hipMemsetAsync((unsigned char*)d_ws + WS_XB - 4096, 0, 4096, stream);
    Args a{};
    for (int i = 0; i < 14; ++i) a.in[i] = (const float*)d_in[i];
    a.out = (float*)d_out; a.ws = (unsigned char*)d_ws;
    void* kargs[] = {&a};
    hipError_t e = hipLaunchCooperativeKernel((const void*)hybrid_fwd, dim3(grid), dim3(NTHR), kargs, LDS_BYTES, stream);
    if (e != hipSuccess) fprintf(stderr, "cooperative launch failed: %s (grid %d)\n", hipGetErrorString(e), grid);
}
```

```cpp
#include <hip/hip_runtime.h>
#include <hip/hip_cooperative_groups.h>
#include <cstdio>
#include <cstdint>
namespace cg = cooperative_groups;
namespace pg8 {
#define PG8_LAS __attribute__((address_space(3)))
typedef unsigned short bf16_t;
typedef short bf16x8 __attribute__((ext_vector_type(8)));
typedef float f32x4 __attribute__((ext_vector_type(4)));
typedef unsigned u32x4 __attribute__((ext_vector_type(4)));
typedef unsigned u32x2 __attribute__((ext_vector_type(2)));
constexpr int BM = 256, BK = 64, HALF = 128, HTB = HALF * BK * 2  , STAGE_BYTES = 8 * HTB, NXCD = 8, WGM = 8;

__host__ __device__ __forceinline__ int lds_byte(int r, int c) { const int st = (r >> 4) * 2 + (c >> 5), rr = r & 15, cc = c & 31, ob = rr * 64 + cc * 2; return st * 1024 + (ob ^ (((ob >> 9) & 1) << 5)); }
__host__ __device__ __forceinline__ void stage_rc(int b, int& R, int& C) { const int st = b / 1024, sb = b % 1024, swz = sb ^ (((sb >> 9) & 1) << 5); R = (st >> 1) * 16 + swz / 64; C = (st & 1) * 32 + (swz % 64) / 2; }
__host__ __device__ __forceinline__ int perm32(int rho) { const int n = rho >> 4, i = rho & 15; return 8 * (i >> 2) + 4 * n + (i & 3); }

struct Unit { int pm, pn; };
struct Gemm { const bf16_t* A; const bf16_t* Bt; int M, N, K; int arows; };

struct StaticOrder {
    int nM, nN, nwg, G, c;
    __host__ __device__ void init(int M, int N, int G_, int c_) { nM = M / BM; nN = N / BM; nwg = nM * nN; G = G_; c = c_; }
    __host__ __device__ bool next(int i, Unit& u) const {
        const long L = (long)i * G + c; if (L >= nwg) return false;
        int wgid = (int)L; { const int q = nwg / NXCD, r = nwg % NXCD, xcd = wgid % NXCD, off = wgid / NXCD; wgid = (xcd < r ? xcd * (q + 1) : r * (q + 1) + (xcd - r) * q) + off; }
        const int nig = WGM * nN, gid = wgid / nig, fm = gid * WGM, gsz = (nM - fm) < WGM ? (nM - fm) : WGM;
        u.pm = fm + ((wgid % nig) % gsz); u.pn = (wgid % nig) / gsz; return true;
    }
    __device__ __forceinline__ void a_ready(const Unit&) const {}
    __device__ __forceinline__ void done(const Unit&) const {}
};

__device__ __forceinline__ unsigned cvt_pk_bf16(float lo, float hi) { unsigned r; asm volatile("v_cvt_pk_bf16_f32 %0, %1, %2" : "=v"(r) : "v"(lo), "v"(hi)); return r; }
struct EpiScaleBf16 {
    static constexpr bool PERM = true, AFTER_DRAIN = false;
    bf16_t* O; int ldc; const float* part; PG8_LAS float* rsl;
    __device__ __forceinline__ void operator()(const f32x4 (&acc)[2][2][4][2], const Unit& u, int wr, int wc, int fr, int fq) const {
        { const int t = (wr * 4 + wc) * 64 + fq * 16 + fr;
          if (t < 256) { const __attribute__((address_space(1))) f32x4* pp = (const __attribute__((address_space(1))) f32x4*)(part + (size_t)(u.pm * BM + t) * 16); const f32x4 a = pp[0], b = pp[1], c = pp[2], d = pp[3];
              const f32x4 s4 = (a + b) + (c + d); const float ss = (s4[0] + s4[1]) + (s4[2] + s4[3]); rsl[t] = __builtin_amdgcn_rsqf(ss * (1.0f / 1024.0f) + 1e-6f); } }
        asm volatile("s_waitcnt lgkmcnt(0)" ::: "memory"); __builtin_amdgcn_s_barrier(); asm volatile("" ::: "memory");
        const int row0 = u.pm * BM + wr * 64 + fr; const int col0 = u.pn * BM + wc * 32 + 8 * fq;
#pragma unroll
        for (int ai = 0; ai < 2; ++ai)
#pragma unroll
            for (int m = 0; m < 4; ++m) { const int row = row0 + ai * HALF + m * 16;
                const float rs = rsl[ai * HALF + wr * 64 + m * 16 + fr];
                bf16_t* rowp = O + (size_t)row * ldc + col0;
#pragma unroll
                for (int bj = 0; bj < 2; ++bj) { const f32x4 v0 = acc[ai][bj][m][0] * rs, v1 = acc[ai][bj][m][1] * rs;
                    u32x4 w; w.x = cvt_pk_bf16(v0[0], v0[1]); w.y = cvt_pk_bf16(v0[2], v0[3]); w.z = cvt_pk_bf16(v1[0], v1[1]); w.w = cvt_pk_bf16(v1[2], v1[3]);
                    *(__attribute__((address_space(1))) u32x4*)(rowp + bj * HALF) = w; } }
    }
};
struct EpiResid {
    static constexpr bool PERM = true, AFTER_DRAIN = false;
    bf16_t* xb; float* part;
    __device__ __forceinline__ void operator()(const f32x4 (&acc)[2][2][4][2], const Unit& u, int wr, int wc, int fr, int fq) const {
        const int row0 = u.pm * BM + wr * 64 + fr; const int col0 = u.pn * BM + wc * 32 + 8 * fq;
        u32x4 pre[3][2];
#define PG8_RLOAD(g_) do { const size_t o_ = (size_t)(row0 + ((g_) >> 2) * HALF + ((g_) & 3) * 16) * 1024 + col0; \
            pre[(g_) % 3][0] = *(const __attribute__((address_space(1))) u32x4*)(xb + o_); pre[(g_) % 3][1] = *(const __attribute__((address_space(1))) u32x4*)(xb + o_ + HALF); } while (0)
        PG8_RLOAD(0); PG8_RLOAD(1);
#pragma unroll
        for (int g = 0; g < 8; ++g) { const int ai = g >> 2, m = g & 3;
            if (g + 2 < 8) PG8_RLOAD(g + 2);
            asm volatile("" ::: "memory");
            const int row = row0 + ai * HALF + m * 16; const size_t off = (size_t)row * 1024 + col0; float ss = 0.f;
#pragma unroll
            for (int bj = 0; bj < 2; ++bj) { const u32x4 b = pre[g % 3][bj];
                const f32x4 b0 = {__uint_as_float(b.x << 16), __uint_as_float(b.x & 0xffff0000u), __uint_as_float(b.y << 16), __uint_as_float(b.y & 0xffff0000u)};
                const f32x4 b1 = {__uint_as_float(b.z << 16), __uint_as_float(b.z & 0xffff0000u), __uint_as_float(b.w << 16), __uint_as_float(b.w & 0xffff0000u)};
                const f32x4 v0 = acc[ai][bj][m][0] + b0, v1 = acc[ai][bj][m][1] + b1;
                ss += (v0[0] * v0[0] + v0[1] * v0[1]) + (v0[2] * v0[2] + v0[3] * v0[3]) + (v1[0] * v1[0] + v1[1] * v1[1]) + (v1[2] * v1[2] + v1[3] * v1[3]);
                u32x4 w; w.x = cvt_pk_bf16(v0[0], v0[1]); w.y = cvt_pk_bf16(v0[2], v0[3]); w.z = cvt_pk_bf16(v1[0], v1[1]); w.w = cvt_pk_bf16(v1[2], v1[3]);
                *(__attribute__((address_space(1))) u32x4*)(xb + off + bj * HALF) = w; }
            ss += __shfl_xor(ss, 16); ss += __shfl_xor(ss, 32);
            if (fq == 0) ((__attribute__((address_space(1))) float*)part)[(size_t)row * 16 + u.pn * 4 + wc] = ss;
            asm volatile("" ::: "memory"); }
#undef PG8_RLOAD
    }
};
#define PG8_DPP(oldv, srcv, ctrl) __builtin_bit_cast(float, __builtin_amdgcn_update_dpp(__builtin_bit_cast(int, (float)(oldv)), __builtin_bit_cast(int, (float)(srcv)), (ctrl), 0xf, 0xf, false))
#define PG8_ROR(srcv, ctrl) __builtin_bit_cast(float, __builtin_amdgcn_mov_dpp(__builtin_bit_cast(int, (float)(srcv)), (ctrl), 0xf, 0xf, true))
struct EpiGate {
    static constexpr bool PERM = true, AFTER_DRAIN = false;
    bf16_t* Aout; const float* part; const float* fconv; PG8_LAS float* xch;
    __device__ __forceinline__ void operator()(f32x4 (&acc)[2][2][4][2], const Unit& u, int wr, int wc, int fr, int fq) const {
        PG8_LAS float* rsl = xch + 2048;
        { const int t = (wr * 4 + wc) * 64 + fq * 16 + fr;
          if (t < 256) { const int row = u.pm * 254 - 2 + t; const bool ok = row >= 0 && row < 16384; const int rc = ok ? row : 0;
              const __attribute__((address_space(1))) f32x4* pp = (const __attribute__((address_space(1))) f32x4*)(part + (size_t)rc * 16); const f32x4 a = pp[0], b = pp[1], c = pp[2], d = pp[3];
              const f32x4 s4 = (a + b) + (c + d); const float ss = (s4[0] + s4[1]) + (s4[2] + s4[3]);
              rsl[t] = ok ? __builtin_amdgcn_rsqf(ss * (1.0f / 1024.0f) + 1e-6f) : 0.f; } }
        asm volatile("s_waitcnt lgkmcnt(0)" ::: "memory"); __builtin_amdgcn_s_barrier(); asm volatile("" ::: "memory");
        const int ccol = wc * 32 + 8 * fq;
#pragma unroll
        for (int ai = 0; ai < 2; ++ai)
#pragma unroll
            for (int m = 0; m < 4; ++m) { const float rs = rsl[ai * HALF + wr * 64 + m * 16 + fr];
#pragma unroll
                for (int bj = 0; bj < 2; ++bj) { acc[ai][bj][m][0] *= rs; acc[ai][bj][m][1] *= rs; } }
        if (fr >= 14) {
#pragma unroll
            for (int ai = 0; ai < 2; ++ai)
#pragma unroll
                for (int bj = 0; bj < 2; ++bj)
#pragma unroll
                    for (int n = 0; n < 2; ++n) *(PG8_LAS f32x4*)(xch + ((2 * ai + wr) * 2 + (fr & 1)) * 256 + bj * HALF + ccol + 4 * n) = acc[ai][bj][3][n];
        }
        asm volatile("s_waitcnt lgkmcnt(0)" ::: "memory"); __builtin_amdgcn_s_barrier(); asm volatile("" ::: "memory");
        const int ch0 = u.pn * HALF + ccol;
#pragma unroll
        for (int ai = 0; ai < 2; ++ai) {
            const int grp = 2 * ai + wr;
#pragma unroll
            for (int n = 0; n < 2; ++n) {
                asm volatile("" ::: "memory");
                const float* fw = fconv + ch0 + 4 * n;
                const f32x4 wg0 = *(const __attribute__((address_space(1))) f32x4*)(fw), wg1 = *(const __attribute__((address_space(1))) f32x4*)(fw + 5632), wg2 = *(const __attribute__((address_space(1))) f32x4*)(fw + 2 * 5632);
                const f32x4 wu0 = *(const __attribute__((address_space(1))) f32x4*)(fw + 2816), wu1 = *(const __attribute__((address_space(1))) f32x4*)(fw + 5632 + 2816), wu2 = *(const __attribute__((address_space(1))) f32x4*)(fw + 2 * 5632 + 2816);
                f32x4 xpg = {0.f, 0.f, 0.f, 0.f}, xpu = {0.f, 0.f, 0.f, 0.f};
                if (grp > 0) { xpg = *(const PG8_LAS f32x4*)(xch + ((grp - 1) * 2 + (fr & 1)) * 256 + ccol + 4 * n); xpu = *(const PG8_LAS f32x4*)(xch + ((grp - 1) * 2 + (fr & 1)) * 256 + HALF + ccol + 4 * n); }
#pragma unroll
                for (int m = 0; m < 4; ++m) {
                    float o[4];
#pragma unroll
                    for (int j = 0; j < 4; ++j) {
                        const float xg = acc[ai][0][m][n][j], xu = acc[ai][1][m][n][j];
                        const float pg = m > 0 ? acc[ai][0][m > 0 ? m - 1 : 0][n][j] : xpg[j], pu = m > 0 ? acc[ai][1][m > 0 ? m - 1 : 0][n][j] : xpu[j];
                        const float g1 = PG8_DPP(PG8_ROR(pg, 0x121), xg, 0x111), g2 = PG8_DPP(PG8_ROR(pg, 0x122), xg, 0x112);
                        const float u1 = PG8_DPP(PG8_ROR(pu, 0x121), xu, 0x111), u2 = PG8_DPP(PG8_ROR(pu, 0x122), xu, 0x112);
                        const float Gv = wg0[j] * g2 + wg1[j] * g1 + wg2[j] * xg, Uv = wu0[j] * u2 + wu1[j] * u1 + wu2[j] * xu;
                        o[j] = Gv * __builtin_amdgcn_rcpf(1.0f + __expf(-Gv)) * Uv; }
                    const int r = ai * HALF + wr * 64 + m * 16 + fr, row = u.pm * 254 - 2 + r;
                    u32x2 w; w.x = cvt_pk_bf16(o[0], o[1]); w.y = cvt_pk_bf16(o[2], o[3]);
                    if (r >= 2 && row < 16384) *(__attribute__((address_space(1))) u32x2*)(Aout + (size_t)row * 2816 + ch0 + 4 * n) = w; }
            }
        }
    }
};
template <class Epi, class Sched, bool ALIGN_EPI = false, bool SP2 = false>
__device__ __forceinline__ void gemm_phase(PG8_LAS unsigned char* lds, const Gemm g, const Sched& S, const Epi& E) {
    int tid = threadIdx.x; asm volatile("" : "+v"(tid));
    const int wid = __builtin_amdgcn_readfirstlane(tid >> 6), lane = tid & 63, wr = wid >> 2, wc = wid & 3, fr = lane & 15, fq = lane >> 4;
    const int K = g.K, nt = K / BK;
    unsigned voffA[2], voffB[2];
#pragma unroll
    for (int i = 0; i < 2; ++i) { int R, C; stage_rc(tid * 16 + i * 8192, R, C); const int Rb = Epi::PERM ? ((R & ~31) + perm32(R & 31)) : R;
        voffA[i] = (unsigned)(R * K + C) * 2u; voffB[i] = (unsigned)(Rb * K + C) * 2u; }
    const size_t kstep = (size_t)(BK * 2);
    const size_t hstep = (size_t)HALF * K * 2;
    const size_t tstep = 2 * hstep;
    const size_t tstepA = (size_t)g.arows * K * 2;
    const unsigned ldsw = (unsigned)wid * 1024u;
    const int aoff = lds_byte(wr * 64 + fr, fq * 8), boff = lds_byte(wc * 32 + fr, fq * 8);
#define PG8_SA(b, h) (((b) * 2 + (h)) * HTB)
#define PG8_SB(b, h) ((4 + (b) * 2 + (h)) * HTB)
#define PG8_STAGE(bufoff, gbase, voff) do { _Pragma("unroll") for (int _i = 0; _i < 2; ++_i) \
        __builtin_amdgcn_global_load_lds((const unsigned*)((const char*)(gbase) + (voff)[_i]), (PG8_LAS unsigned*)(lds + (bufoff) + ldsw + _i * 8192), 16, 0, 0); } while (0)
#define PG8_LDA(dst, b, h) do { _Pragma("unroll") for (int m = 0; m < 4; ++m) _Pragma("unroll") for (int k = 0; k < 2; ++k) dst[m][k] = *(const PG8_LAS bf16x8*)(lds + PG8_SA(b, h) + aoff + m * 2048 + k * 1024); } while (0)
#define PG8_LDB(dst, b, h) do { _Pragma("unroll") for (int n = 0; n < 2; ++n) _Pragma("unroll") for (int k = 0; k < 2; ++k) dst[n][k] = *(const PG8_LAS bf16x8*)(lds + PG8_SB(b, h) + boff + n * 2048 + k * 1024); } while (0)
#define PG8_MMA(ai, bj, At, Bt) do { __builtin_amdgcn_s_setprio(1); _Pragma("unroll") for (int m = 0; m < 4; ++m) _Pragma("unroll") for (int n = 0; n < 2; ++n) _Pragma("unroll") for (int k = 0; k < 2; ++k) \
        acc[ai][bj][m][n] = __builtin_amdgcn_mfma_f32_16x16x32_bf16(Bt[n][k], At[m][k], acc[ai][bj][m][n], 0, 0, 0); __builtin_amdgcn_s_setprio(0); } while (0)
#define PG8_WAIT_V(n) asm volatile("s_waitcnt vmcnt(" #n ")" ::: "memory")
#define PG8_WAIT_L(n) asm volatile("s_waitcnt lgkmcnt(" #n ")" ::: "memory")
#define PG8_BAR __builtin_amdgcn_s_barrier()
#define PG8_SCHED __builtin_amdgcn_sched_barrier(0)
    Unit cur, nxt; int ui = 0;
    if (!S.next(0, cur)) return;
    f32x4 acc[2][2][4][2];
#pragma unroll
    for (int a = 0; a < 2; ++a)
#pragma unroll
        for (int b = 0; b < 2; ++b)
#pragma unroll
            for (int m = 0; m < 4; ++m)
#pragma unroll
                for (int n = 0; n < 2; ++n) acc[a][b][m][n] = (f32x4){0.f, 0.f, 0.f, 0.f};
    bf16x8 At[4][2], B0[2][2], B1[2][2];
    const char* cA = (const char*)g.A + (size_t)cur.pm * tstepA; const char* cB = (const char*)g.Bt + (size_t)cur.pn * tstep;
    S.a_ready(cur);
    if constexpr (SP2) {
        PG8_STAGE(PG8_SB(0, 0), cB, voffB); PG8_STAGE(PG8_SB(0, 1), cB + hstep, voffB); PG8_STAGE(PG8_SA(0, 0), cA, voffA); PG8_STAGE(PG8_SA(0, 1), cA + hstep, voffA);
        if (wr == 1) PG8_BAR;
        PG8_WAIT_V(2); PG8_BAR;
        PG8_STAGE(PG8_SB(1, 0), cB + kstep, voffB); PG8_STAGE(PG8_SA(1, 0), cA + kstep, voffA); PG8_STAGE(PG8_SB(1, 1), cB + hstep + kstep, voffB);
        PG8_WAIT_V(6); PG8_BAR;
    } else {
        PG8_STAGE(PG8_SB(0, 0), cB, voffB); PG8_STAGE(PG8_SA(0, 0), cA, voffA); PG8_STAGE(PG8_SB(0, 1), cB + hstep, voffB); PG8_STAGE(PG8_SA(0, 1), cA + hstep, voffA);
        if (wr == 1) PG8_BAR;
        PG8_WAIT_V(4); PG8_BAR;
        PG8_STAGE(PG8_SB(1, 0), cB + kstep, voffB); PG8_STAGE(PG8_SA(1, 0), cA + kstep, voffA); PG8_STAGE(PG8_SB(1, 1), cB + hstep + kstep, voffB);
        PG8_WAIT_V(6); PG8_BAR;
    }
    for (;;) {
        const bool has_next = S.next(ui + 1, nxt);
        const char* nA = has_next ? (const char*)g.A + (size_t)nxt.pm * tstepA : cA; const char* nB = has_next ? (const char*)g.Bt + (size_t)nxt.pn * tstep : cB;
        for (int t = 0; t < nt; t += 2) {
            const bool last = (t == nt - 2);
            const char* a1 = cA + (size_t)(t + 1) * kstep;
            const char* a2 = last ? nA : cA + (size_t)(t + 2) * kstep; const char* b2 = last ? nB : cB + (size_t)(t + 2) * kstep;
            const char* a3 = a2 + kstep; const char* b3 = b2 + kstep;
            if (last && has_next) S.a_ready(nxt);
            if constexpr (SP2) {
            PG8_LDB(B0, 0, 0); PG8_LDB(B1, 0, 1); PG8_SCHED; PG8_LDA(At, 0, 0); PG8_STAGE(PG8_SA(1, 1), a1 + hstep, voffA);
            PG8_WAIT_V(8); PG8_WAIT_L(0); PG8_BAR; PG8_MMA(0, 0, At, B0); PG8_MMA(0, 1, At, B1); PG8_BAR; PG8_SCHED;
            PG8_LDA(At, 0, 1); PG8_STAGE(PG8_SB(0, 0), b2, voffB); PG8_STAGE(PG8_SB(0, 1), b2 + hstep, voffB); PG8_STAGE(PG8_SA(0, 0), a2, voffA);
            PG8_WAIT_V(8); PG8_WAIT_L(0); PG8_BAR; PG8_MMA(1, 0, At, B0); PG8_MMA(1, 1, At, B1); PG8_BAR; PG8_SCHED;
            PG8_LDB(B0, 1, 0); PG8_LDB(B1, 1, 1); PG8_SCHED; PG8_LDA(At, 1, 0); PG8_STAGE(PG8_SA(0, 1), a2 + hstep, voffA);
            PG8_WAIT_V(8); PG8_WAIT_L(0); PG8_BAR; PG8_MMA(0, 0, At, B0); PG8_MMA(0, 1, At, B1); PG8_BAR; PG8_SCHED;
            PG8_LDA(At, 1, 1); PG8_STAGE(PG8_SB(1, 0), b3, voffB); PG8_STAGE(PG8_SB(1, 1), b3 + hstep, voffB); PG8_STAGE(PG8_SA(1, 0), a3, voffA);
            PG8_WAIT_V(8); PG8_WAIT_L(0); PG8_BAR; PG8_MMA(1, 0, At, B0); PG8_MMA(1, 1, At, B1); PG8_BAR; PG8_SCHED;
            } else {
            PG8_LDB(B0, 0, 0); PG8_SCHED; PG8_LDA(At, 0, 0); PG8_STAGE(PG8_SA(1, 1), a1 + hstep, voffA);
            PG8_WAIT_L(8); PG8_BAR; PG8_WAIT_L(0); PG8_MMA(0, 0, At, B0); PG8_BAR; PG8_SCHED;
            PG8_LDB(B1, 0, 1); PG8_STAGE(PG8_SB(0, 0), b2, voffB);
            PG8_BAR; PG8_WAIT_L(0); PG8_MMA(0, 1, At, B1); PG8_BAR;
            PG8_LDA(At, 0, 1); PG8_STAGE(PG8_SA(0, 0), a2, voffA);
            PG8_BAR; PG8_WAIT_L(0); PG8_MMA(1, 0, At, B0); PG8_BAR; PG8_SCHED;
            PG8_STAGE(PG8_SB(0, 1), b2 + hstep, voffB);
            PG8_WAIT_V(6); PG8_BAR; PG8_MMA(1, 1, At, B1); PG8_BAR;
            PG8_LDB(B0, 1, 0); PG8_SCHED; PG8_LDA(At, 1, 0); PG8_STAGE(PG8_SA(0, 1), a2 + hstep, voffA);
            PG8_WAIT_L(8); PG8_BAR; PG8_WAIT_L(0); PG8_MMA(0, 0, At, B0); PG8_BAR; PG8_SCHED;
            PG8_LDB(B1, 1, 1); PG8_STAGE(PG8_SB(1, 0), b3, voffB);
            PG8_BAR; PG8_WAIT_L(0); PG8_MMA(0, 1, At, B1); PG8_BAR;
            PG8_LDA(At, 1, 1); PG8_STAGE(PG8_SA(1, 0), a3, voffA);
            PG8_BAR; PG8_WAIT_L(0); PG8_MMA(1, 0, At, B0); PG8_BAR; PG8_SCHED;
            PG8_STAGE(PG8_SB(1, 1), b3 + hstep, voffB);
            PG8_WAIT_V(6); PG8_BAR; PG8_MMA(1, 1, At, B1); PG8_BAR;
            }
        }
        if constexpr (ALIGN_EPI) { if (wr == 0) PG8_BAR; }
        if constexpr (!Epi::AFTER_DRAIN) { E(acc, cur, wr, wc, fr, fq); S.done(cur); }
        if (!has_next) break;
#pragma unroll
        for (int a = 0; a < 2; ++a)
#pragma unroll
            for (int b = 0; b < 2; ++b)
#pragma unroll
                for (int m = 0; m < 4; ++m)
#pragma unroll
                    for (int n = 0; n < 2; ++n) acc[a][b][m][n] = (f32x4){0.f, 0.f, 0.f, 0.f};
        cur = nxt; cA = nA; cB = nB; ++ui;
        if constexpr (ALIGN_EPI) { if (wr == 1) PG8_BAR; }
    }
    PG8_WAIT_V(0);
    if constexpr (!ALIGN_EPI) { if (wr == 0) PG8_BAR; }
    PG8_BAR;
    if constexpr (Epi::AFTER_DRAIN) { E.fused(acc, cur, wr, wc, fr, fq, lds, wid, lane); S.done(cur); }
#undef PG8_SA
#undef PG8_SB
#undef PG8_STAGE
#undef PG8_LDA
#undef PG8_LDB
#undef PG8_MMA
#undef PG8_WAIT_V
#undef PG8_WAIT_L
#undef PG8_BAR
#undef PG8_SCHED
}
}
constexpr int S = 16384, DM = 1024, DEPTH = 4, NIN = 2816, DFF = 2816, NUP = 5632;
constexpr float EPS = 1e-6f;
constexpr int NWAVES = 8, NTHR = 512;
constexpr size_t MiB = 1u << 20;
constexpr size_t WS_WIN = 1 * MiB, WS_WOUT = 23 * MiB, WS_WUP = 31 * MiB, WS_WDN = 75 * MiB;
constexpr size_t WS_PART = 97 * MiB;
constexpr size_t WS_XB = 98 * MiB + 4096;
constexpr size_t WS_P = 131 * MiB;
constexpr size_t WS_Y = 219 * MiB;
constexpr size_t WS_GU = 131 * MiB;
constexpr size_t WS_A = 219 * MiB;
constexpr size_t WS_END = 307 * MiB;
constexpr int LDS_BYTES = 147456;
#define LAS __attribute__((address_space(3)))
typedef unsigned short bf16;
typedef unsigned v4u __attribute__((ext_vector_type(4)));
typedef unsigned v2u __attribute__((ext_vector_type(2)));
typedef float f32x4 __attribute__((ext_vector_type(4)));
typedef float f32x16 __attribute__((ext_vector_type(16)));
typedef short bf16x8 __attribute__((ext_vector_type(8)));
#define LDS_WAIT() asm volatile("s_waitcnt lgkmcnt(0)" ::: "memory")
__device__ __forceinline__ unsigned pk2(float lo, float hi) { return pg8::cvt_pk_bf16(lo, hi); }
__device__ __forceinline__ float bflo(unsigned u) { return __uint_as_float(u << 16); }
__device__ __forceinline__ float bfhi(unsigned u) { return __uint_as_float(u & 0xffff0000u); }
__device__ __forceinline__ float bf1(bf16 v) { return __uint_as_float((unsigned)v << 16); }
#define WS_DPP(v, ctrl) __builtin_bit_cast(float, __builtin_amdgcn_update_dpp(0, __builtin_bit_cast(int, (float)(v)), (ctrl), 0xf, 0xf, true))
__device__ __forceinline__ float wave_sum(float v) {
    v += WS_DPP(v, 0xB1); v += WS_DPP(v, 0x4E); v += WS_DPP(v, 0x141); v += WS_DPP(v, 0x140);
    const int iv = __builtin_bit_cast(int, v);
    const float a = __builtin_bit_cast(float, __builtin_amdgcn_readlane(iv, 0)), b = __builtin_bit_cast(float, __builtin_amdgcn_readlane(iv, 16));
    const float c = __builtin_bit_cast(float, __builtin_amdgcn_readlane(iv, 32)), d = __builtin_bit_cast(float, __builtin_amdgcn_readlane(iv, 48));
    return (a + b) + (c + d);
}

__device__ __forceinline__ void cvt_item(const float* W, int K, int N, bf16* WT, const float* gain, int mode, LAS float* scr, int item, int lane) {
    const int nblk = N / 32, kb = item / nblk, nb = item % nblk, k0 = 64 * kb, n0 = 32 * nb;
    float wv[32];
#pragma unroll
    for (int i = 0; i < 32; ++i) { const int kk = 2 * i + (lane >> 5); wv[i] = ((const __attribute__((address_space(1))) float*)W)[(size_t)(k0 + kk) * N + n0 + (lane & 31)]; }
#pragma unroll
    for (int i = 0; i < 32; ++i) { const int kk = 2 * i + (lane >> 5); const float g = gain ? ((const __attribute__((address_space(1))) float*)gain)[k0 + kk] : 1.0f; scr[kk * 33 + (lane & 31)] = wv[i] * g; }
    LDS_WAIT(); asm volatile("" ::: "memory");
    const float cs = (mode == 1 && n0 >= 1280 && n0 < 1792) ? 0.125f * 1.4426950408889634f : 1.0f;
    int rb = n0;
    if (mode == 2) { rb = (n0 < DFF) ? 256 * (n0 / 128) + (n0 % 128) : 256 * ((n0 - DFF) / 128) + 128 + ((n0 - DFF) % 128); }
    const int c = lane & 7;
#pragma unroll
    for (int j = 0; j < 4; ++j) { const int n = (lane >> 3) + 8 * j; const LAS float* s = scr + (8 * c) * 33 + n;
        v4u o; o.x = pk2(s[0 * 33] * cs, s[1 * 33] * cs); o.y = pk2(s[2 * 33] * cs, s[3 * 33] * cs); o.z = pk2(s[4 * 33] * cs, s[5 * 33] * cs); o.w = pk2(s[6 * 33] * cs, s[7 * 33] * cs);
        *(__attribute__((address_space(1))) v4u*)(WT + (size_t)(rb + n) * K + k0 + 8 * c) = o; }
    LDS_WAIT(); asm volatile("" ::: "memory");
}

typedef __attribute__((address_space(1))) unsigned gu32;
#define XB_TMO      128
#define XB_XCNT(j)  (256  + 64 * (j))
#define XB_XSUB(j)  (1280 + 64 * (j))
#define XB_XGEN(j)  (2304 + 64 * (j))
#define XB_TOP      3328
#define XB_TOPGEN   3392
#define XCD_BAR_WORDS 3456
#define XB_SPIN_CAP (1u << 18)

__device__ __forceinline__ unsigned xb_ld(unsigned* p)              { return __hip_atomic_load(p, __ATOMIC_RELAXED, __HIP_MEMORY_SCOPE_AGENT); }
__device__ __forceinline__ unsigned xb_add(unsigned* p, unsigned v) { return __hip_atomic_fetch_add(p, v, __ATOMIC_RELAXED, __HIP_MEMORY_SCOPE_AGENT); }
__device__ __forceinline__ unsigned xb_xcc_id() { return (unsigned)__builtin_amdgcn_s_getreg((3 << 11) | 20) & 0xFu; }
#define XB_SPIN(cond, bar) do { unsigned _sp = 0; while (cond) { __builtin_amdgcn_s_sleep(1); \
    if ((++_sp & 255u) == 0u) { if (xb_ld(&(bar)[XB_TMO])) break; if (_sp > XB_SPIN_CAP) { atomicAdd(&(bar)[XB_TMO], 1u); break; } } } } while (0)

struct XcdBarrier {
    unsigned* bar; unsigned x;
    volatile LAS unsigned* st;
};

__device__ __forceinline__ XcdBarrier xcd_barrier_post(unsigned* bar, volatile LAS unsigned* st) {
    XcdBarrier b; b.bar = bar; b.x = xb_xcc_id(); b.st = st;
    if (threadIdx.x == 0) (void)xb_add(&bar[XB_XCNT(b.x)], 1u);
    return b;
}
__device__ __forceinline__ void xcd_barrier_complete(unsigned* bar, unsigned x, unsigned& nloc, unsigned& nx) {
    const unsigned G = gridDim.x * gridDim.y * gridDim.z;
    unsigned sum, cnt, mine, sp = 0u;
    for (;;) {
        sum = 0u; cnt = 0u; mine = 0u;
#pragma unroll
        for (unsigned j = 0; j < 16; ++j) { const unsigned c = xb_ld(&bar[XB_XCNT(j)]); sum += c; cnt += (c > 0u) ? 1u : 0u; mine = (j == x) ? c : mine; }
        if (sum == G) break;
        __builtin_amdgcn_s_sleep(1);
        if ((++sp & 255u) == 0u) { if (xb_ld(&bar[XB_TMO])) break; if (sp > XB_SPIN_CAP) { atomicAdd(&bar[XB_TMO], 1u); break; } }
    }
    nloc = mine > 0u ? mine : 1u; nx = cnt > 0u ? cnt : 1u;
}

__device__ __forceinline__ void xcd_barrier(const XcdBarrier& b) {
    asm volatile("s_waitcnt vmcnt(0)" ::: "memory");
    __syncthreads();
    if (threadIdx.x == 0) {
        unsigned* bar = b.bar;
        __builtin_amdgcn_s_waitcnt(0);
        unsigned nloc = b.st[0], nx = b.st[1];
        if (nloc == 0u) { xcd_barrier_complete(bar, b.x, nloc, nx); b.st[0] = nloc; b.st[1] = nx; }
        const unsigned old = xb_add(&bar[XB_XSUB(b.x)], 1u);
        const unsigned gen = old / nloc;
        if (old + 1u == (gen + 1u) * nloc) {
            __builtin_amdgcn_fence(__ATOMIC_RELEASE, "agent");
            asm volatile("s_waitcnt vmcnt(0)" ::: "memory");
            const unsigned og = xb_add(&bar[XB_TOP], 1u);
            const unsigned tg = og / nx;
            if (og + 1u == (tg + 1u) * nx) xb_add(&bar[XB_TOPGEN], 1u);
            else XB_SPIN(xb_ld(&bar[XB_TOPGEN]) == tg, bar);
            __builtin_amdgcn_fence(__ATOMIC_ACQUIRE, "agent");
            xb_add(&bar[XB_XGEN(b.x)], 1u);
            asm volatile("s_waitcnt vmcnt(0)" ::: "memory");
        } else {
            XB_SPIN(xb_ld(&bar[XB_XGEN(b.x)]) == gen, bar);
            __builtin_amdgcn_fence(__ATOMIC_ACQUIRE, "agent");
            asm volatile("s_waitcnt vmcnt(0)" ::: "memory");
        }
    }
    __syncthreads();
}

struct CvtSrc { const float *w_in, *w_out, *w_up, *w_down, *norm_mix, *out_norm, *norm_ffn; bf16 *Win_t, *Wout_t, *Wup_t, *Wdn_t; };
__device__ __forceinline__ void cvt_layer_item(const CvtSrc& c, int l, int r, LAS float* scr, int lane) {
    const float* W; bf16* WT; const float* gain; int K, N, mode;
    if (r < 1408) { W = c.w_in + (size_t)l * DM * NIN; K = DM; N = NIN; WT = c.Win_t + (size_t)l * NIN * DM; gain = c.norm_mix + l * DM; mode = 1; }
    else if (r < 1920) { r -= 1408; W = c.w_out + (size_t)l * DM * DM; K = DM; N = DM; WT = c.Wout_t + (size_t)l * DM * DM; gain = c.out_norm + l * DM; mode = 0; }
    else if (r < 4736) { r -= 1920; W = c.w_up + (size_t)l * DM * NUP; K = DM; N = NUP; WT = c.Wup_t + (size_t)l * NUP * DM; gain = c.norm_ffn + l * DM; mode = 2; }
    else { r -= 4736; W = c.w_down + (size_t)l * DFF * DM; K = DFF; N = DM; WT = c.Wdn_t + (size_t)l * DM * DFF; gain = nullptr; mode = 0; }
    cvt_item(W, K, N, WT, gain, mode, scr, r, lane);
}
__device__ __forceinline__ const float* ldptr(const volatile LAS unsigned* PT, int k) {
    const unsigned lo = __builtin_amdgcn_readfirstlane(PT[2 * k]), hi = __builtin_amdgcn_readfirstlane(PT[2 * k + 1]);
    return (const float*)(const __attribute__((address_space(1))) float*)(((unsigned long long)hi << 32) | lo);
}
struct Args { const float* in[14]; float* out; unsigned char* ws; };

__device__ __forceinline__ void norm_store_rows(const LAS float* tile, bf16* Y, int t0, int coff, int wave, int lane) {
#pragma unroll 2
    for (int i = 0; i < 8; ++i) { const int r = wave * 8 + i; const f32x4 v = *(const LAS f32x4*)(tile + r * 260 + lane * 4);
        const float ss = wave_sum((v[0] * v[0] + v[1] * v[1]) + (v[2] * v[2] + v[3] * v[3]));
        const float rs = __builtin_amdgcn_rsqf(ss * (1.0f / 256.0f) + EPS);
        v2u o; o.x = pk2(v[0] * rs, v[1] * rs); o.y = pk2(v[2] * rs, v[3] * rs);
        *(__attribute__((address_space(1))) v2u*)(Y + (size_t)(t0 + r) * DM + coff + lane * 4) = o; }
}

__device__ __forceinline__ void mixer_unit(LAS unsigned char* lds, int unit, const bf16* P, bf16* Y, const float* conv_w, const float* sgu_norm, const float* sgu_w, const float* sgu_b, int tid, int wave, int lane) {
    const int t0 = unit * 64;
    asm volatile("" : "+v"(tid), "+v"(lane));
    LAS bf16* vnT = (LAS bf16*)lds;
    LAS float* tile = (LAS float*)(lds + 69632);
    LAS float* sm_ss = (LAS float*)(lds + 69632 + 66560);
    {
        const int hd = wave, r = lane & 31, h = lane >> 5;
        const int pr = (r & 0x13) | ((r & 4) << 1) | ((r & 8) >> 1);
        LAS bf16* Vt = (LAS bf16*)(lds + wave * 5120);
        bf16x8 atri[2];
#pragma unroll
        for (int sI = 0; sI < 2; ++sI) { v4u t;
            t.x = ((16 * sI + 8 * h + 0 > pr) ? 0x3F80u : 0u) | ((16 * sI + 8 * h + 1 > pr) ? 0x3F800000u : 0u); t.y = ((16 * sI + 8 * h + 2 > pr) ? 0x3F80u : 0u) | ((16 * sI + 8 * h + 3 > pr) ? 0x3F800000u : 0u);
            t.z = ((16 * sI + 8 * h + 4 > pr) ? 0x3F80u : 0u) | ((16 * sI + 8 * h + 5 > pr) ? 0x3F800000u : 0u); t.w = ((16 * sI + 8 * h + 6 > pr) ? 0x3F80u : 0u) | ((16 * sI + 8 * h + 7 > pr) ? 0x3F800000u : 0u);
            atri[sI] = __builtin_bit_cast(bf16x8, t); }
        f32x16 oacc[2][2];
        bf16x8 kfn[4]; v4u vvn[4];
        { const bf16* kp = P + (size_t)(t0 + 32 + pr) * NIN + 1792 + hd * 64 + 8 * h;
#pragma unroll
          for (int ks = 0; ks < 4; ++ks) kfn[ks] = *(const __attribute__((address_space(1))) bf16x8*)(kp + 16 * ks);
#pragma unroll
          for (int i = 0; i < 4; ++i) vvn[i] = *(const __attribute__((address_space(1))) v4u*)(P + (size_t)(t0 + 32 + (lane >> 3) + 8 * i) * NIN + 2304 + hd * 64 + 8 * (lane & 7)); }
        LAS bf16x8* Qs = (LAS bf16x8*)(lds + 40960 + wave * 8192);
#pragma unroll
        for (int ks = 0; ks < 4; ++ks) { Qs[ks * 64 + lane] = *(const __attribute__((address_space(1))) bf16x8*)(P + (size_t)(t0 + r) * NIN + 1280 + hd * 64 + 16 * ks + 8 * h); Qs[(4 + ks) * 64 + lane] = *(const __attribute__((address_space(1))) bf16x8*)(P + (size_t)(t0 + 32 + r) * NIN + 1280 + hd * 64 + 16 * ks + 8 * h); }
#pragma unroll
        for (int a = 0; a < 2; ++a)
#pragma unroll
            for (int b = 0; b < 2; ++b) oacc[a][b] = (f32x16){};
        float lsA = 0.f, lsB = 0.f; bool actA = true, actB = true;
#define SB_CHAIN(Z, O0, O1, LS, DIAGV) do { \
            f32x16 cin; float Lv[16]; \
            _Pragma("unroll") for (int jj = 0; jj < 16; ++jj) { const float zz = Z[jj]; const float ex = __builtin_amdgcn_exp2f(-fabsf(zz)); const float lsig = fminf(zz, 0.f) - __builtin_amdgcn_logf(1.0f + ex); \
                Lv[jj] = lsig - zz; cin[jj] = lsig + LS; } \
            if (DIAGV) { _Pragma("unroll") for (int jj = 0; jj < 16; ++jj) { const int keyl = 16 * (jj >> 3) + 8 * h + (jj & 7); Lv[jj] = (keyl < r) ? Lv[jj] : 0.f; } } \
            float rowsum = 0.f; unsigned lh[8], ll[8]; \
            _Pragma("unroll") for (int j = 0; j < 16; j += 2) { rowsum += Lv[j] + Lv[j + 1]; \
                const unsigned hp = pk2(Lv[j], Lv[j + 1]); lh[j >> 1] = hp; ll[j >> 1] = pk2(Lv[j] - bflo(hp), Lv[j + 1] - bfhi(hp)); } \
            const bf16x8 bh0 = __builtin_bit_cast(bf16x8, (v4u){lh[0], lh[1], lh[2], lh[3]}), bh1 = __builtin_bit_cast(bf16x8, (v4u){lh[4], lh[5], lh[6], lh[7]}); \
            const bf16x8 bl0 = __builtin_bit_cast(bf16x8, (v4u){ll[0], ll[1], ll[2], ll[3]}), bl1 = __builtin_bit_cast(bf16x8, (v4u){ll[4], ll[5], ll[6], ll[7]}); \
            f32x16 lw = __builtin_amdgcn_mfma_f32_32x32x16_bf16(atri[0], bh0, cin, 0, 0, 0); \
            lw = __builtin_amdgcn_mfma_f32_32x32x16_bf16(atri[1], bh1, lw, 0, 0, 0); \
            lw = __builtin_amdgcn_mfma_f32_32x32x16_bf16(atri[0], bl0, lw, 0, 0, 0); \
            lw = __builtin_amdgcn_mfma_f32_32x32x16_bf16(atri[1], bl1, lw, 0, 0, 0); \
            float wv[16]; \
            _Pragma("unroll") for (int jj = 0; jj < 16; ++jj) wv[jj] = __builtin_amdgcn_exp2f(lw[jj]); \
            if (DIAGV) { _Pragma("unroll") for (int jj = 0; jj < 16; ++jj) { const int keyl = 16 * (jj >> 3) + 8 * h + (jj & 7); wv[jj] = (keyl < r) ? wv[jj] : 0.f; } } \
            unsigned wp[8]; \
            _Pragma("unroll") for (int j = 0; j < 16; j += 2) wp[j >> 1] = pk2(wv[j], wv[j + 1]); \
            const bf16x8 w0 = __builtin_bit_cast(bf16x8, (v4u){wp[0], wp[1], wp[2], wp[3]}), w1 = __builtin_bit_cast(bf16x8, (v4u){wp[4], wp[5], wp[6], wp[7]}); \
            const LAS bf16* vr = Vt + r * 40 + 8 * h; \
            O0 = __builtin_amdgcn_mfma_f32_32x32x16_bf16(*(const LAS bf16x8*)(vr), w0, O0, 0, 0, 0); \
            O0 = __builtin_amdgcn_mfma_f32_32x32x16_bf16(*(const LAS bf16x8*)(vr + 16), w1, O0, 0, 0, 0); \
            O1 = __builtin_amdgcn_mfma_f32_32x32x16_bf16(*(const LAS bf16x8*)(vr + 32 * 40), w0, O1, 0, 0, 0); \
            O1 = __builtin_amdgcn_mfma_f32_32x32x16_bf16(*(const LAS bf16x8*)(vr + 32 * 40 + 16), w1, O1, 0, 0, 0); \
            LS += rowsum + __shfl_xor(rowsum, 32); } while (0)
        for (int k0 = t0 + 32;; k0 -= 32) {
            const bool doA = actA && (k0 <= t0);
            f32x16 zB = {}, zA = {};
            if (actB) {
#pragma unroll
                for (int ks = 0; ks < 4; ++ks) zB = __builtin_amdgcn_mfma_f32_32x32x16_bf16(kfn[ks], Qs[(4 + ks) * 64 + lane], zB, 0, 0, 0); }
            if (doA) {
#pragma unroll
                for (int ks = 0; ks < 4; ++ks) zA = __builtin_amdgcn_mfma_f32_32x32x16_bf16(kfn[ks], Qs[ks * 64 + lane], zA, 0, 0, 0); }
#pragma unroll
            for (int i = 0; i < 4; ++i) { const int key = (lane >> 3) + 8 * i, c = lane & 7; const v4u vv = vvn[i];
                LAS bf16* vd = Vt + (8 * c) * 40 + key;
                vd[0] = (bf16)(vv.x & 0xffffu); vd[40] = (bf16)(vv.x >> 16); vd[80] = (bf16)(vv.y & 0xffffu); vd[120] = (bf16)(vv.y >> 16);
                vd[160] = (bf16)(vv.z & 0xffffu); vd[200] = (bf16)(vv.z >> 16); vd[240] = (bf16)(vv.w & 0xffffu); vd[280] = (bf16)(vv.w >> 16); }
            if (k0 >= 32) { const bf16* kp = P + (size_t)(k0 - 32 + pr) * NIN + 1792 + hd * 64 + 8 * h;
#pragma unroll
                for (int ks = 0; ks < 4; ++ks) kfn[ks] = *(const __attribute__((address_space(1))) bf16x8*)(kp + 16 * ks);
#pragma unroll
                for (int i = 0; i < 4; ++i) vvn[i] = *(const __attribute__((address_space(1))) v4u*)(P + (size_t)(k0 - 32 + (lane >> 3) + 8 * i) * NIN + 2304 + hd * 64 + 8 * (lane & 7)); }
            if (actB) { const bool dg = (k0 == t0 + 32); SB_CHAIN(zB, oacc[1][0], oacc[1][1], lsB, dg);
                if (__builtin_amdgcn_ballot_w64(lsB > -150.1f) == 0ull) actB = false; }
            if (doA) { const bool dg = (k0 == t0); SB_CHAIN(zA, oacc[0][0], oacc[0][1], lsA, dg);
                if (__builtin_amdgcn_ballot_w64(lsA > -150.1f) == 0ull) actA = false; }
            if (k0 < 32 || !(actA || actB)) break;
        }
#undef SB_CHAIN
#pragma unroll
        for (int qh = 0; qh < 2; ++qh) { float ss = 0.f;
#pragma unroll
            for (int j = 0; j < 16; ++j) ss += oacc[qh][0][j] * oacc[qh][0][j] + oacc[qh][1][j] * oacc[qh][1][j];
            ss += __shfl_xor(ss, 32);
            if (h == 0) sm_ss[(32 * qh + r) * 8 + hd] = ss; }
        LDS_WAIT(); __syncthreads();
#pragma unroll
        for (int qh = 0; qh < 2; ++qh) {
            const f32x4 sa = *(const LAS f32x4*)(sm_ss + (32 * qh + r) * 8), sb = *(const LAS f32x4*)(sm_ss + (32 * qh + r) * 8 + 4);
            const float tot = ((sa[0] + sa[1]) + (sa[2] + sa[3])) + ((sb[0] + sb[1]) + (sb[2] + sb[3]));
            const float rs = __builtin_amdgcn_rsqf(tot * (1.0f / 512.0f) + EPS);
            bf16* yp = Y + (size_t)(t0 + 32 * qh + r) * DM + 512 + hd * 64 + 4 * h;
#pragma unroll
            for (int db = 0; db < 2; ++db)
#pragma unroll
                for (int g4 = 0; g4 < 4; ++g4) { const f32x16& o = oacc[qh][db]; v2u w; w.x = pk2(o[4 * g4 + 0] * rs, o[4 * g4 + 1] * rs); w.y = pk2(o[4 * g4 + 2] * rs, o[4 * g4 + 3] * rs);
                    *(__attribute__((address_space(1))) v2u*)(yp + 32 * db + 8 * g4) = w; }
        }
    }
    const int c8 = (tid & 31) * 8, rg = tid >> 5, tb = t0 + 4 * rg;
    v4u gb[4], gc[6], hc[6];
#pragma unroll
    for (int i = 0; i < 6; ++i) { const int t = tb - 2 + i; const bool ok = t >= 0; const bf16* rp = P + (size_t)(ok ? t : 0) * NIN;
        gc[i] = ok ? *(const __attribute__((address_space(1))) v4u*)(rp + 256 + c8) : (v4u){0u, 0u, 0u, 0u}; hc[i] = ok ? *(const __attribute__((address_space(1))) v4u*)(rp + 512 + c8) : (v4u){0u, 0u, 0u, 0u};
        if (i >= 2) gb[i - 2] = *(const __attribute__((address_space(1))) v4u*)(rp + c8); }
    const int tc = t0 & ~127, dt = t0 - tc, ns = dt + 64;
    v2u uu[16];
#pragma unroll
    for (int i = 0; i < 16; ++i) { const int s = wave + 8 * i; uu[i] = (s < ns) ? *(const __attribute__((address_space(1))) v2u*)(P + (size_t)(tc + s) * NIN + 1024 + lane * 4) : (v2u){0u, 0u}; }
    const int h = wave >> 1, rh = wave & 1, r32 = lane & 31, hi = lane >> 5;
    const int tcl = dt + 32 * rh + r32;
    const int nk = (dt + 32 * rh + 32) >> 4;
    f32x4 wa[8], wb[8];
    { const float* wrow = sgu_w + ((size_t)h * 128 + tcl) * 128;
#pragma unroll
      for (int ks = 0; ks < 8; ++ks) { const int s0 = ks * 16 + 8 * hi; if (ks < nk) { wa[ks] = *(const __attribute__((address_space(1))) f32x4*)(wrow + s0); wb[ks] = *(const __attribute__((address_space(1))) f32x4*)(wrow + s0 + 4); } else { wa[ks] = (f32x4){0.f, 0.f, 0.f, 0.f}; wb[ks] = wa[ks]; } } }
    {
        float w0[8], w1[8], w2[8];
        { const f32x4 a0 = *(const __attribute__((address_space(1))) f32x4*)(conv_w + c8), a1 = *(const __attribute__((address_space(1))) f32x4*)(conv_w + c8 + 4), b0 = *(const __attribute__((address_space(1))) f32x4*)(conv_w + 256 + c8), b1 = *(const __attribute__((address_space(1))) f32x4*)(conv_w + 256 + c8 + 4), d0 = *(const __attribute__((address_space(1))) f32x4*)(conv_w + 512 + c8), d1 = *(const __attribute__((address_space(1))) f32x4*)(conv_w + 512 + c8 + 4);
#pragma unroll
          for (int e = 0; e < 4; ++e) { w0[e] = a0[e]; w0[4 + e] = a1[e]; w1[e] = b0[e]; w1[4 + e] = b1[e]; w2[e] = d0[e]; w2[4 + e] = d1[e]; } }
        float pr_[6][8];
#pragma unroll
        for (int i = 0; i < 6; ++i) { const unsigned ga[4] = {gc[i].x, gc[i].y, gc[i].z, gc[i].w}, ha[4] = {hc[i].x, hc[i].y, hc[i].z, hc[i].w};
#pragma unroll
            for (int e = 0; e < 4; ++e) { pr_[i][2 * e] = bflo(ga[e]) * bflo(ha[e]); pr_[i][2 * e + 1] = bfhi(ga[e]) * bfhi(ha[e]); } }
#pragma unroll
        for (int i = 0; i < 4; ++i) { const unsigned ba[4] = {gb[i].x, gb[i].y, gb[i].z, gb[i].w}; float o[8];
#pragma unroll
            for (int e = 0; e < 4; ++e) { o[2 * e] = bflo(ba[e]) * (w0[2 * e] * pr_[i][2 * e] + w1[2 * e] * pr_[i + 1][2 * e] + w2[2 * e] * pr_[i + 2][2 * e]);
                o[2 * e + 1] = bfhi(ba[e]) * (w0[2 * e + 1] * pr_[i][2 * e + 1] + w1[2 * e + 1] * pr_[i + 1][2 * e + 1] + w2[2 * e + 1] * pr_[i + 2][2 * e + 1]); }
            LAS f32x4* tp = (LAS f32x4*)(tile + (4 * rg + i) * 260 + c8); tp[0] = (f32x4){o[0], o[1], o[2], o[3]}; tp[1] = (f32x4){o[4], o[5], o[6], o[7]}; }
    }
    LDS_WAIT(); __syncthreads();
    norm_store_rows(tile, Y, t0, 0, wave, lane);
    { const f32x4 g = *(const __attribute__((address_space(1))) f32x4*)(sgu_norm + lane * 4);
#pragma unroll
      for (int i = 0; i < 16; ++i) { const int s = wave + 8 * i;
        if (s < ns) { const v2u u = uu[i];
        const float v0 = bflo(u.x), v1 = bfhi(u.x), v2 = bflo(u.y), v3 = bfhi(u.y);
        const float ss = wave_sum((v0 * v0 + v1 * v1) + (v2 * v2 + v3 * v3)); const float rs = __builtin_amdgcn_rsqf(ss * (1.0f / 256.0f) + EPS);
        const unsigned a = pk2(v0 * rs * g[0], v1 * rs * g[1]), b = pk2(v2 * rs * g[2], v3 * rs * g[3]);
        vnT[(lane * 4 + 0) * 136 + s] = (bf16)(a & 0xffffu); vnT[(lane * 4 + 1) * 136 + s] = (bf16)(a >> 16); vnT[(lane * 4 + 2) * 136 + s] = (bf16)(b & 0xffffu); vnT[(lane * 4 + 3) * 136 + s] = (bf16)(b >> 16); } } }
    float ug0[16], ug1[16], bbv[16];
#pragma unroll
    for (int j = 0; j < 16; ++j) { const int rl = 32 * rh + (j & 3) + 8 * (j >> 2) + 4 * hi; const bf16* up = P + (size_t)(t0 + rl) * NIN + 768 + h * 64;
        ug0[j] = bf1(((const __attribute__((address_space(1))) bf16*)up)[r32]); ug1[j] = bf1(((const __attribute__((address_space(1))) bf16*)up)[32 + r32]); bbv[j] = ((const __attribute__((address_space(1))) float*)sgu_b)[h * 128 + dt + rl]; }
    LDS_WAIT(); __syncthreads();
    {
        f32x16 o0 = {}, o1 = {};
#pragma unroll
        for (int ks = 0; ks < 8; ++ks) if (ks < nk) { const int s0 = ks * 16 + 8 * hi;
            float wv[8] = {wa[ks][0], wa[ks][1], wa[ks][2], wa[ks][3], wb[ks][0], wb[ks][1], wb[ks][2], wb[ks][3]};
#pragma unroll
            for (int i = 0; i < 8; ++i) wv[i] = (s0 + i <= tcl) ? wv[i] : 0.f;
            v4u ap; ap.x = pk2(wv[0], wv[1]); ap.y = pk2(wv[2], wv[3]); ap.z = pk2(wv[4], wv[5]); ap.w = pk2(wv[6], wv[7]);
            const bf16x8 af = __builtin_bit_cast(bf16x8, ap);
            const bf16x8 b0 = *(const LAS bf16x8*)(vnT + (h * 64 + r32) * 136 + s0), b1 = *(const LAS bf16x8*)(vnT + (h * 64 + 32 + r32) * 136 + s0);
            o0 = __builtin_amdgcn_mfma_f32_32x32x16_bf16(af, b0, o0, 0, 0, 0);
            o1 = __builtin_amdgcn_mfma_f32_32x32x16_bf16(af, b1, o1, 0, 0, 0); }
#pragma unroll
        for (int j = 0; j < 16; ++j) { const int rl = 32 * rh + (j & 3) + 8 * (j >> 2) + 4 * hi;
            tile[rl * 260 + h * 64 + r32] = ug0[j] * (o0[j] + bbv[j]);
            tile[rl * 260 + h * 64 + 32 + r32] = ug1[j] * (o1[j] + bbv[j]); }
    }
    LDS_WAIT(); __syncthreads();
    norm_store_rows(tile, Y, t0, 256, wave, lane);
    LDS_WAIT(); __syncthreads();
}

__device__ __forceinline__ void ffn_gate_phase(const bf16* GU, bf16* A, const float* fconv, int hf, int gtid, int gthreads) {
    for (int it = gtid; it < 256 * 176; it += gthreads) { const int rb = it / 176, cgp = it % 176, pnl = cgp >> 4, cc = (cgp & 15) * 8, ch = 1408 * hf + 128 * pnl + cc;
        float wg[3][8], wu[3][8];
#pragma unroll
        for (int i = 0; i < 3; ++i) { const f32x4 a0 = *(const __attribute__((address_space(1))) f32x4*)(fconv + (size_t)i * NUP + ch), a1 = *(const __attribute__((address_space(1))) f32x4*)(fconv + (size_t)i * NUP + ch + 4), b0 = *(const __attribute__((address_space(1))) f32x4*)(fconv + (size_t)i * NUP + DFF + ch), b1 = *(const __attribute__((address_space(1))) f32x4*)(fconv + (size_t)i * NUP + DFF + ch + 4);
#pragma unroll
            for (int e = 0; e < 4; ++e) { wg[i][e] = a0[e]; wg[i][4 + e] = a1[e]; wu[i][e] = b0[e]; wu[i][4 + e] = b1[e]; } }
        float g2[8], g1[8], u2[8], u1[8];
#pragma unroll
        for (int e = 0; e < 8; ++e) { g2[e] = g1[e] = u2[e] = u1[e] = 0.f; }
        for (int r = -2; r < 64; ++r) { const int t = 64 * rb + r; float g0[8], u0[8];
            if (t >= 0) { const v4u gv = *(const __attribute__((address_space(1))) v4u*)(GU + (size_t)t * NIN + 256 * pnl + cc), uv = *(const __attribute__((address_space(1))) v4u*)(GU + (size_t)t * NIN + 256 * pnl + 128 + cc);
                g0[0] = bflo(gv.x); g0[1] = bfhi(gv.x); g0[2] = bflo(gv.y); g0[3] = bfhi(gv.y); g0[4] = bflo(gv.z); g0[5] = bfhi(gv.z); g0[6] = bflo(gv.w); g0[7] = bfhi(gv.w);
                u0[0] = bflo(uv.x); u0[1] = bfhi(uv.x); u0[2] = bflo(uv.y); u0[3] = bfhi(uv.y); u0[4] = bflo(uv.z); u0[5] = bfhi(uv.z); u0[6] = bflo(uv.w); u0[7] = bfhi(uv.w); }
            else {
#pragma unroll
                for (int e = 0; e < 8; ++e) { g0[e] = 0.f; u0[e] = 0.f; } }
            if (r >= 0) { float o[8];
#pragma unroll
                for (int e = 0; e < 8; ++e) { const float G = wg[0][e] * g2[e] + wg[1][e] * g1[e] + wg[2][e] * g0[e], U = wu[0][e] * u2[e] + wu[1][e] * u1[e] + wu[2][e] * u0[e];
                    o[e] = G * __builtin_amdgcn_rcpf(1.0f + __expf(-G)) * U; }
                v4u ov; ov.x = pk2(o[0], o[1]); ov.y = pk2(o[2], o[3]); ov.z = pk2(o[4], o[5]); ov.w = pk2(o[6], o[7]);
                *(__attribute__((address_space(1))) v4u*)(A + (size_t)t * DFF + ch) = ov; }
#pragma unroll
            for (int e = 0; e < 8; ++e) { g2[e] = g1[e]; g1[e] = g0[e]; u2[e] = u1[e]; u1[e] = u0[e]; } }
    }
}
__global__ void __launch_bounds__(NTHR, 2) hybrid_fwd(Args args) {
    extern __shared__ __attribute__((aligned(16))) unsigned char lds_raw[];
    LAS unsigned char* lds = (LAS unsigned char*)lds_raw;
    cg::grid_group grid = cg::this_grid();
    volatile LAS unsigned* MISC = (volatile LAS unsigned*)(lds + LDS_BYTES - 64);
    volatile LAS unsigned* PT = (volatile LAS unsigned*)(lds + LDS_BYTES - 256);
    if (threadIdx.x < 16) MISC[threadIdx.x] = 0u;
    if (threadIdx.x == 0) {
#define PUTP(k) { const unsigned long long v_ = (unsigned long long)args.in[k]; PT[2 * (k)] = (unsigned)v_; PT[2 * (k) + 1] = (unsigned)(v_ >> 32); }
        PUTP(0) PUTP(1) PUTP(2) PUTP(3) PUTP(4) PUTP(5) PUTP(6) PUTP(7) PUTP(8) PUTP(9) PUTP(10) PUTP(11) PUTP(12) PUTP(13)
#undef PUTP
    }
    __syncthreads();
    XcdBarrier xbar = xcd_barrier_post((unsigned*)args.ws, MISC);
    const int tid = threadIdx.x, lane = tid & 63, wave = __builtin_amdgcn_readfirstlane(tid >> 6);
    const int G = gridDim.x, bx = blockIdx.x;
    const int gw = bx * NWAVES + wave, NGW = G * NWAVES;
    unsigned char* ws = args.ws;
#define INP(k) ldptr(PT, (k))
#define MAKE_CS() const CvtSrc cs{INP(2), INP(8), INP(10), INP(12), INP(1), INP(7), INP(9), Win_t, Wout_t, Wup_t, Wdn_t}
    float* xo = args.out;
#define PHASE_PTRS() unsigned char* w_ = ws; float* xcur = xo; asm volatile("" : "+s"(w_), "+s"(xcur)); \
    w_ = (unsigned char*)(__attribute__((address_space(1))) unsigned char*)w_; xcur = (float*)(__attribute__((address_space(1))) float*)xcur;     \
    bf16* Win_t = (bf16*)(w_ + WS_WIN); bf16* Wout_t = (bf16*)(w_ + WS_WOUT); bf16* Wup_t = (bf16*)(w_ + WS_WUP); bf16* Wdn_t = (bf16*)(w_ + WS_WDN); \
    float* part = (float*)(w_ + WS_PART); bf16* XB = (bf16*)(w_ + WS_XB); bf16* P = (bf16*)(w_ + WS_P); bf16* Y = (bf16*)(w_ + WS_Y); bf16* A = (bf16*)(w_ + WS_A); \
    (void)Win_t; (void)Wout_t; (void)Wup_t; (void)Wdn_t; (void)part; (void)XB; (void)P; (void)Y; (void)A; (void)xcur

    for (int step = -1; step < 5 * DEPTH; ++step) {
        const int l = step < 0 ? 0 : step / 5, ph = step < 0 ? -1 : step % 5;
        int cvt_layer = -1, cvt_first = 0, cvt_n = 0, cvt_nu = 0;
        if (ph < 0) {
            PHASE_PTRS(); const float* x_in = INP(0);
            int gw_ = gw, lane_ = lane; asm volatile("" : "+s"(gw_), "+v"(lane_));
            for (int m = gw_; m < S; m += NGW) { const __attribute__((address_space(1))) f32x4* xr = (const __attribute__((address_space(1))) f32x4*)(x_in + (size_t)m * DM) + lane_; f32x4 v[4]; float ss = 0.f;
#pragma unroll
                for (int j = 0; j < 4; ++j) { v[j] = xr[64 * j]; ss += (v[j][0] * v[j][0] + v[j][1] * v[j][1]) + (v[j][2] * v[j][2] + v[j][3] * v[j][3]); }
                ss = wave_sum(ss);
                __attribute__((address_space(1))) v2u* o8 = (__attribute__((address_space(1))) v2u*)(XB + (size_t)m * DM) + lane_;
#pragma unroll
                for (int j = 0; j < 4; ++j) { v2u o; o.x = pk2(v[j][0], v[j][1]); o.y = pk2(v[j][2], v[j][3]); o8[64 * j] = o; }
                if (lane_ < 16) ((__attribute__((address_space(1))) float*)part)[(size_t)m * 16 + lane_] = lane_ == 0 ? ss : 0.f; }
            cvt_layer = 0; cvt_first = 0; cvt_n = 6144; cvt_nu = 0;
        } else if (ph == 0) {
            PHASE_PTRS(); pg8::Gemm g{XB, Win_t + (size_t)l * NIN * DM, S, NIN, DM, 256}; pg8::StaticOrder So; So.init(S, NIN, G, bx);
            pg8::EpiScaleBf16 E{P, NIN, part, (LAS float*)(lds + 131072 + 8192)};
            pg8::gemm_phase<pg8::EpiScaleBf16, pg8::StaticOrder, true, true>(lds, g, So, E);
            if (l + 1 < DEPTH) { cvt_layer = l + 1; cvt_first = 0; cvt_n = 1920; cvt_nu = (S / 256) * (NIN / 256); }
        } else if (ph == 1) {
            PHASE_PTRS();
            for (int u = bx; u < S / 64; u += G)
                mixer_unit(lds, u, P, Y, INP(3) + l * 3 * 256, INP(4) + l * 256, INP(5) + (size_t)l * 4 * 128 * 128, INP(6) + l * 4 * 128, tid, wave, lane);
        } else if (ph == 2) {
            PHASE_PTRS(); pg8::Gemm g{Y, Wout_t + (size_t)l * DM * DM, S, DM, DM, 256}; pg8::StaticOrder So; So.init(S, DM, G, bx);
            pg8::EpiResid E{XB, part};
            pg8::gemm_phase<pg8::EpiResid, pg8::StaticOrder, true, true>(lds, g, So, E);
        } else if (ph == 3) {
            PHASE_PTRS(); pg8::Gemm g{XB - 2 * DM, Wup_t + (size_t)l * NUP * DM, 65 * 256, NUP, DM, 254}; pg8::StaticOrder So; So.init(65 * 256, NUP, G, bx);
            pg8::EpiGate E{A, part, INP(11) + (size_t)l * 3 * NUP, (LAS float*)(lds + 131072)};
            pg8::gemm_phase<pg8::EpiGate, pg8::StaticOrder, true, true>(lds, g, So, E);
            if (l + 1 < DEPTH) { cvt_layer = l + 1; cvt_first = 1920; cvt_n = 4224; cvt_nu = 65 * (NUP / 256); }
        } else {
            PHASE_PTRS(); pg8::Gemm g{A, Wdn_t + (size_t)l * DM * DFF, S, DM, DFF, 256}; pg8::StaticOrder So; So.init(S, DM, G, bx);
            pg8::EpiResid E{XB, part};
            pg8::gemm_phase<pg8::EpiResid, pg8::StaticOrder, true, true>(lds, g, So, E);
        }
        if (cvt_layer >= 0) {
            const int first_idle = cvt_nu > 0 ? cvt_nu - ((cvt_nu + G - 1) / G - 1) * G : 0; const bool some_idle = first_idle < G;
            if (!some_idle || bx >= first_idle) { const int nw = (some_idle ? G - first_idle : G) * NWAVES, iw = (some_idle ? bx - first_idle : bx) * NWAVES + wave;
                PHASE_PTRS(); LAS float* scr = (LAS float*)(lds + wave * 16384); int lane_ = lane; asm volatile("" : "+v"(lane_));
                MAKE_CS(); for (int it = iw; it < cvt_n; it += nw) cvt_layer_item(cs, cvt_layer, cvt_first + it, scr, lane_); } }
        if (step < 0) grid.sync(); else xcd_barrier(xbar);
    }
    { const float* nfin = INP(13); const bf16* XBf = (const bf16*)(ws + WS_XB);
      for (int m = gw; m < S; m += NGW) { const __attribute__((address_space(1))) v2u* xr = (const __attribute__((address_space(1))) v2u*)(XBf + (size_t)m * DM) + lane; f32x4 v[4]; float ss = 0.f;
#pragma unroll
        for (int j = 0; j < 4; ++j) { const v2u u = xr[64 * j]; v[j] = (f32x4){bflo(u.x), bfhi(u.x), bflo(u.y), bfhi(u.y)}; ss += (v[j][0] * v[j][0] + v[j][1] * v[j][1]) + (v[j][2] * v[j][2] + v[j][3] * v[j][3]); }
        const float rs = __builtin_amdgcn_rsqf(wave_sum(ss) * (1.0f / 1024.0f) + EPS);
        __attribute__((address_space(1))) f32x4* orow = (__attribute__((address_space(1))) f32x4*)(xo + (size_t)m * DM) + lane;
#pragma unroll
        for (int j = 0; j < 4; ++j) { const f32x4 g = *((const __attribute__((address_space(1))) f32x4*)nfin + lane + 64 * j); orow[64 * j] = v[j] * rs * g; } } }
}

extern "C" void kernel_launch(void* const* d_in, const int* in_sizes, int n_in, void* d_out, int out_size, void* d_ws, size_t ws_size, hipStream_t stream) {
    static int grid = 0;
    if (grid == 0) {
        if (n_in != 14 || out_size != S * DM || ws_size < WS_END) { fprintf(stderr, "kernel_launch: unexpected shapes / workspace (%d inputs, out %d, ws %zu)\n", n_in, out_size, ws_size); grid = -1; return; }
        int dev = 0, cus = 0, per_cu = 0;
        hipGetDevice(&dev); hipDeviceGetAttribute(&cus, hipDeviceAttributeMultiprocessorCount, dev);
        hipFuncSetAttribute((const void*)hybrid_fwd, hipFuncAttributeMaxDynamicSharedMemorySize, LDS_BYTES);
        hipOccupancyMaxActiveBlocksPerMultiprocessor(&per_cu, (const void*)hybrid_fwd, NTHR, LDS_BYTES);
        (void)hipGetLastError();
        if (per_cu < 1) per_cu = 1;
        grid = cus * 1;
    }
    if (grid < 0) return;
    hipMemsetAsync((unsigned char*)d_ws, 0, 16384, stream);
    hipMemsetAsync((unsigned char*)d_ws + WS_XB - 4096, 0, 4096, stream);
    Args a{};
    for (int i = 0; i < 14; ++i) a.in[i] = (const float*)d_in[i];
    a.out = (float*)d_out; a.ws = (unsigned char*)d_ws;
    void* kargs[] = {&a};
    hipError_t e = hipLaunchCooperativeKernel((const void*)hybrid_fwd, dim3(grid), dim3(NTHR), kargs, LDS_BYTES, stream);
    if (e != hipSuccess) fprintf(stderr, "cooperative launch failed: %s (grid %d)\n", hipGetErrorString(e), grid);
}
```

```cpp
#include <hip/hip_runtime.h>
#include <hip/hip_cooperative_groups.h>
#include <cstdio>
#include <cstdint>
namespace cg = cooperative_groups;
namespace pg8 {
#define PG8_LAS __attribute__((address_space(3)))
typedef unsigned short bf16_t;
typedef short bf16x8 __attribute__((ext_vector_type(8)));
typedef float f32x4 __attribute__((ext_vector_type(4)));
typedef unsigned u32x4 __attribute__((ext_vector_type(4)));
typedef unsigned u32x2 __attribute__((ext_vector_type(2)));
constexpr int BM = 256, BK = 64, HALF = 128, HTB = HALF * BK * 2  , STAGE_BYTES = 8 * HTB, NXCD = 8, WGM = 8;

__host__ __device__ __forceinline__ int lds_byte(int r, int c) { const int st = (r >> 4) * 2 + (c >> 5), rr = r & 15, cc = c & 31, ob = rr * 64 + cc * 2; return st * 1024 + (ob ^ (((ob >> 9) & 1) << 5)); }
__host__ __device__ __forceinline__ void stage_rc(int b, int& R, int& C) { const int st = b / 1024, sb = b % 1024, swz = sb ^ (((sb >> 9) & 1) << 5); R = (st >> 1) * 16 + swz / 64; C = (st & 1) * 32 + (swz % 64) / 2; }
__host__ __device__ __forceinline__ int perm32(int rho) { const int n = rho >> 4, i = rho & 15; return 8 * (i >> 2) + 4 * n + (i & 3); }

struct Unit { int pm, pn; };
struct Gemm { const bf16_t* A; const bf16_t* Bt; int M, N, K; int arows; };

struct StaticOrder {
    int nM, nN, nwg, G, c;
    __host__ __device__ void init(int M, int N, int G_, int c_) { nM = M / BM; nN = N / BM; nwg = nM * nN; G = G_; c = c_; }
    __host__ __device__ bool next(int i, Unit& u) const {
        const long L = (long)i * G + c; if (L >= nwg) return false;
        int wgid = (int)L; { const int q = nwg / NXCD, r = nwg % NXCD, xcd = wgid % NXCD, off = wgid / NXCD; wgid = (xcd < r ? xcd * (q + 1) : r * (q + 1) + (xcd - r) * q) + off; }
        const int nig = WGM * nN, gid = wgid / nig, fm = gid * WGM, gsz = (nM - fm) < WGM ? (nM - fm) : WGM;
        u.pm = fm + ((wgid % nig) % gsz); u.pn = (wgid % nig) / gsz; return true;
    }
    __device__ __forceinline__ void a_ready(const Unit&) const {}
    __device__ __forceinline__ void done(const Unit&) const {}
};

__device__ __forceinline__ unsigned cvt_pk_bf16(float lo, float hi) { unsigned r; asm volatile("v_cvt_pk_bf16_f32 %0, %1, %2" : "=v"(r) : "v"(lo), "v"(hi)); return r; }
struct EpiScaleBf16 {
    static constexpr bool PERM = true, AFTER_DRAIN = false, PERMA = false;
    bf16_t* O; int ldc; const float* part; PG8_LAS float* rsl;
    __device__ __forceinline__ void operator()(const f32x4 (&acc)[2][2][4][2], const Unit& u, int wr, int wc, int fr, int fq) const {
        { const int t = (wr * 4 + wc) * 64 + fq * 16 + fr;
          if (t < 256) { const __attribute__((address_space(1))) f32x4* pp = (const __attribute__((address_space(1))) f32x4*)(part + (size_t)(u.pm * BM + t) * 16); const f32x4 a = pp[0], b = pp[1], c = pp[2], d = pp[3];
              const f32x4 s4 = (a + b) + (c + d); const float ss = (s4[0] + s4[1]) + (s4[2] + s4[3]); rsl[t] = __builtin_amdgcn_rsqf(ss * (1.0f / 1024.0f) + 1e-6f); } }
        asm volatile("s_waitcnt lgkmcnt(0)" ::: "memory"); __builtin_amdgcn_s_barrier(); asm volatile("" ::: "memory");
        const int row0 = u.pm * BM + wr * 64 + fr; const int col0 = u.pn * BM + wc * 32 + 8 * fq;
#pragma unroll
        for (int ai = 0; ai < 2; ++ai)
#pragma unroll
            for (int m = 0; m < 4; ++m) { const int row = row0 + ai * HALF + m * 16;
                const float rs = rsl[ai * HALF + wr * 64 + m * 16 + fr];
                bf16_t* rowp = O + (size_t)row * ldc + col0;
#pragma unroll
                for (int bj = 0; bj < 2; ++bj) { const f32x4 v0 = acc[ai][bj][m][0] * rs, v1 = acc[ai][bj][m][1] * rs;
                    u32x4 w; w.x = cvt_pk_bf16(v0[0], v0[1]); w.y = cvt_pk_bf16(v0[2], v0[3]); w.z = cvt_pk_bf16(v1[0], v1[1]); w.w = cvt_pk_bf16(v1[2], v1[3]);
                    *(__attribute__((address_space(1))) u32x4*)(rowp + bj * HALF) = w; } }
    }
};
struct EpiResid {
    static constexpr bool PERM = true, AFTER_DRAIN = false, PERMA = false;
    bf16_t* xb; float* part;
    __device__ __forceinline__ void operator()(const f32x4 (&acc)[2][2][4][2], const Unit& u, int wr, int wc, int fr, int fq) const {
        const int row0 = u.pm * BM + wr * 64 + fr; const int col0 = u.pn * BM + wc * 32 + 8 * fq;
        u32x4 pre[3][2];
#define PG8_RLOAD(g_) do { const size_t o_ = (size_t)(row0 + ((g_) >> 2) * HALF + ((g_) & 3) * 16) * 1024 + col0; \
            pre[(g_) % 3][0] = *(const __attribute__((address_space(1))) u32x4*)(xb + o_); pre[(g_) % 3][1] = *(const __attribute__((address_space(1))) u32x4*)(xb + o_ + HALF); } while (0)
        PG8_RLOAD(0); PG8_RLOAD(1);
#pragma unroll
        for (int g = 0; g < 8; ++g) { const int ai = g >> 2, m = g & 3;
            if (g + 2 < 8) PG8_RLOAD(g + 2);
            asm volatile("" ::: "memory");
            const int row = row0 + ai * HALF + m * 16; const size_t off = (size_t)row * 1024 + col0; float ss = 0.f;
#pragma unroll
            for (int bj = 0; bj < 2; ++bj) { const u32x4 b = pre[g % 3][bj];
                const f32x4 b0 = {__uint_as_float(b.x << 16), __uint_as_float(b.x & 0xffff0000u), __uint_as_float(b.y << 16), __uint_as_float(b.y & 0xffff0000u)};
                const f32x4 b1 = {__uint_as_float(b.z << 16), __uint_as_float(b.z & 0xffff0000u), __uint_as_float(b.w << 16), __uint_as_float(b.w & 0xffff0000u)};
                const f32x4 v0 = acc[ai][bj][m][0] + b0, v1 = acc[ai][bj][m][1] + b1;
                ss += (v0[0] * v0[0] + v0[1] * v0[1]) + (v0[2] * v0[2] + v0[3] * v0[3]) + (v1[0] * v1[0] + v1[1] * v1[1]) + (v1[2] * v1[2] + v1[3] * v1[3]);
                u32x4 w; w.x = cvt_pk_bf16(v0[0], v0[1]); w.y = cvt_pk_bf16(v0[2], v0[3]); w.z = cvt_pk_bf16(v1[0], v1[1]); w.w = cvt_pk_bf16(v1[2], v1[3]);
                *(__attribute__((address_space(1))) u32x4*)(xb + off + bj * HALF) = w; }
            ss += __shfl_xor(ss, 16); ss += __shfl_xor(ss, 32);
            if (fq == 0) ((__attribute__((address_space(1))) float*)part)[(size_t)row * 16 + u.pn * 4 + wc] = ss;
            asm volatile("" ::: "memory"); }
#undef PG8_RLOAD
    }
};
#define PG8_DPP(oldv, srcv, ctrl) __builtin_bit_cast(float, __builtin_amdgcn_update_dpp(__builtin_bit_cast(int, (float)(oldv)), __builtin_bit_cast(int, (float)(srcv)), (ctrl), 0xf, 0xf, false))
struct EpiGate {
    static constexpr bool PERM = true, AFTER_DRAIN = false, PERMA = true;
    bf16_t* Aout; const float* part; const float* fconv; PG8_LAS float* xch;
    __device__ __forceinline__ void operator()(f32x4 (&acc)[2][2][4][2], const Unit& u, int wr, int wc, int fr, int fq) const {
        PG8_LAS float* rsl = xch + 2048;
        { const int t = (wr * 4 + wc) * 64 + fq * 16 + fr;
          if (t < 256) { const int row = u.pm * 254 - 2 + t; const bool ok = row >= 0 && row < 16384; const int rc = ok ? row : 0;
              const __attribute__((address_space(1))) f32x4* pp = (const __attribute__((address_space(1))) f32x4*)(part + (size_t)rc * 16); const f32x4 a = pp[0], b = pp[1], c = pp[2], d = pp[3];
              const f32x4 s4 = (a + b) + (c + d); const float ss = (s4[0] + s4[1]) + (s4[2] + s4[3]);
              rsl[t] = ok ? __builtin_amdgcn_rsqf(ss * (1.0f / 1024.0f) + 1e-6f) : 0.f; } }
        asm volatile("s_waitcnt lgkmcnt(0)" ::: "memory"); __builtin_amdgcn_s_barrier(); asm volatile("" ::: "memory");
        const int ccol = wc * 32 + 8 * fq;
#pragma unroll
        for (int ai = 0; ai < 2; ++ai) { const f32x4 rs4 = *(const PG8_LAS f32x4*)(rsl + ai * HALF + wr * 64 + 4 * fr);
#pragma unroll
            for (int m = 0; m < 4; ++m)
#pragma unroll
                for (int bj = 0; bj < 2; ++bj) { acc[ai][bj][m][0] *= rs4[m]; acc[ai][bj][m][1] *= rs4[m]; } }
        if (fr == 15) {
#pragma unroll
            for (int ai = 0; ai < 2; ++ai)
#pragma unroll
                for (int bj = 0; bj < 2; ++bj)
#pragma unroll
                    for (int n = 0; n < 2; ++n) { *(PG8_LAS f32x4*)(xch + ((2 * ai + wr) * 2 + 0) * 256 + bj * HALF + ccol + 4 * n) = acc[ai][bj][2][n]; *(PG8_LAS f32x4*)(xch + ((2 * ai + wr) * 2 + 1) * 256 + bj * HALF + ccol + 4 * n) = acc[ai][bj][3][n]; }
        }
        asm volatile("s_waitcnt lgkmcnt(0)" ::: "memory"); __builtin_amdgcn_s_barrier(); asm volatile("" ::: "memory");
        const int ch0 = u.pn * HALF + ccol;
#pragma unroll
        for (int ai = 0; ai < 2; ++ai) {
            const int grp = 2 * ai + wr;
#pragma unroll
            for (int n = 0; n < 2; ++n) {
                asm volatile("" ::: "memory");
                const float* fw = fconv + ch0 + 4 * n;
                const f32x4 wg0 = *(const __attribute__((address_space(1))) f32x4*)(fw), wg1 = *(const __attribute__((address_space(1))) f32x4*)(fw + 5632), wg2 = *(const __attribute__((address_space(1))) f32x4*)(fw + 2 * 5632);
                const f32x4 wu0 = *(const __attribute__((address_space(1))) f32x4*)(fw + 2816), wu1 = *(const __attribute__((address_space(1))) f32x4*)(fw + 5632 + 2816), wu2 = *(const __attribute__((address_space(1))) f32x4*)(fw + 2 * 5632 + 2816);
                f32x4 g62 = {0.f, 0.f, 0.f, 0.f}, g63 = g62, u62 = g62, u63 = g62;
                if (grp > 0) { const PG8_LAS float* xb_ = xch + ((grp - 1) * 2) * 256 + ccol + 4 * n;
                    g62 = *(const PG8_LAS f32x4*)(xb_); g63 = *(const PG8_LAS f32x4*)(xb_ + 256); u62 = *(const PG8_LAS f32x4*)(xb_ + HALF); u63 = *(const PG8_LAS f32x4*)(xb_ + 256 + HALF); }
                float o[4][4];
#pragma unroll
                for (int j = 0; j < 4; ++j) {
                    const float g0 = acc[ai][0][0][n][j], g1 = acc[ai][0][1][n][j], g2 = acc[ai][0][2][n][j], g3 = acc[ai][0][3][n][j];
                    const float u0 = acc[ai][1][0][n][j], u1 = acc[ai][1][1][n][j], u2 = acc[ai][1][2][n][j], u3 = acc[ai][1][3][n][j];
                    const float gm1 = PG8_DPP(g63[j], g3, 0x111), gm2 = PG8_DPP(g62[j], g2, 0x111);
                    const float um1 = PG8_DPP(u63[j], u3, 0x111), um2 = PG8_DPP(u62[j], u2, 0x111);
                    const float G0 = wg0[j] * gm2 + wg1[j] * gm1 + wg2[j] * g0, G1 = wg0[j] * gm1 + wg1[j] * g0 + wg2[j] * g1, G2 = wg0[j] * g0 + wg1[j] * g1 + wg2[j] * g2, G3 = wg0[j] * g1 + wg1[j] * g2 + wg2[j] * g3;
                    const float U0 = wu0[j] * um2 + wu1[j] * um1 + wu2[j] * u0, U1 = wu0[j] * um1 + wu1[j] * u0 + wu2[j] * u1, U2 = wu0[j] * u0 + wu1[j] * u1 + wu2[j] * u2, U3 = wu0[j] * u1 + wu1[j] * u2 + wu2[j] * u3;
                    o[0][j] = G0 * __builtin_amdgcn_rcpf(1.0f + __expf(-G0)) * U0; o[1][j] = G1 * __builtin_amdgcn_rcpf(1.0f + __expf(-G1)) * U1;
                    o[2][j] = G2 * __builtin_amdgcn_rcpf(1.0f + __expf(-G2)) * U2; o[3][j] = G3 * __builtin_amdgcn_rcpf(1.0f + __expf(-G3)) * U3; }
#pragma unroll
                for (int m = 0; m < 4; ++m) { const int r = ai * HALF + wr * 64 + 4 * fr + m, row = u.pm * 254 - 2 + r;
                    u32x2 w; w.x = cvt_pk_bf16(o[m][0], o[m][1]); w.y = cvt_pk_bf16(o[m][2], o[m][3]);
                    if (r >= 2 && row < 16384) *(__attribute__((address_space(1))) u32x2*)(Aout + (size_t)row * 2816 + ch0 + 4 * n) = w; }
            }
        }
    }
};
template <class Epi, class Sched, bool ALIGN_EPI = false, bool SP2 = false>
__device__ __forceinline__ void gemm_phase(PG8_LAS unsigned char* lds, const Gemm g, const Sched& S, const Epi& E) {
    int tid = threadIdx.x; asm volatile("" : "+v"(tid));
    const int wid = __builtin_amdgcn_readfirstlane(tid >> 6), lane = tid & 63, wr = wid >> 2, wc = wid & 3, fr = lane & 15, fq = lane >> 4;
    const int K = g.K, nt = K / BK;
    unsigned voffA[2], voffB[2];
#pragma unroll
    for (int i = 0; i < 2; ++i) { int R, C; stage_rc(tid * 16 + i * 8192, R, C); const int Rb = Epi::PERM ? ((R & ~31) + perm32(R & 31)) : R;
        const int Ra = Epi::PERMA ? ((R & ~63) + 4 * (R & 15) + ((R >> 4) & 3)) : R;
        voffA[i] = (unsigned)(Ra * K + C) * 2u; voffB[i] = (unsigned)(Rb * K + C) * 2u; }
    const size_t kstep = (size_t)(BK * 2);
    const size_t hstep = (size_t)HALF * K * 2;
    const size_t tstep = 2 * hstep;
    const size_t tstepA = (size_t)g.arows * K * 2;
    const unsigned ldsw = (unsigned)wid * 1024u;
    const int aoff = lds_byte(wr * 64 + fr, fq * 8), boff = lds_byte(wc * 32 + fr, fq * 8);
#define PG8_SA(b, h) (((b) * 2 + (h)) * HTB)
#define PG8_SB(b, h) ((4 + (b) * 2 + (h)) * HTB)
#define PG8_STAGE(bufoff, gbase, voff) do { _Pragma("unroll") for (int _i = 0; _i < 2; ++_i) \
        __builtin_amdgcn_global_load_lds((const unsigned*)((const char*)(gbase) + (voff)[_i]), (PG8_LAS unsigned*)(lds + (bufoff) + ldsw + _i * 8192), 16, 0, 0); } while (0)
#define PG8_LDA(dst, b, h) do { _Pragma("unroll") for (int m = 0; m < 4; ++m) _Pragma("unroll") for (int k = 0; k < 2; ++k) dst[m][k] = *(const PG8_LAS bf16x8*)(lds + PG8_SA(b, h) + aoff + m * 2048 + k * 1024); } while (0)
#define PG8_LDB(dst, b, h) do { _Pragma("unroll") for (int n = 0; n < 2; ++n) _Pragma("unroll") for (int k = 0; k < 2; ++k) dst[n][k] = *(const PG8_LAS bf16x8*)(lds + PG8_SB(b, h) + boff + n * 2048 + k * 1024); } while (0)
#define PG8_MMA(ai, bj, At, Bt) do { __builtin_amdgcn_s_setprio(1); _Pragma("unroll") for (int m = 0; m < 4; ++m) _Pragma("unroll") for (int n = 0; n < 2; ++n) _Pragma("unroll") for (int k = 0; k < 2; ++k) \
        acc[ai][bj][m][n] = __builtin_amdgcn_mfma_f32_16x16x32_bf16(Bt[n][k], At[m][k], acc[ai][bj][m][n], 0, 0, 0); __builtin_amdgcn_s_setprio(0); } while (0)
#define PG8_WAIT_V(n) asm volatile("s_waitcnt vmcnt(" #n ")" ::: "memory")
#define PG8_WAIT_L(n) asm volatile("s_waitcnt lgkmcnt(" #n ")" ::: "memory")
#define PG8_BAR __builtin_amdgcn_s_barrier()
#define PG8_SCHED __builtin_amdgcn_sched_barrier(0)
    Unit cur, nxt; int ui = 0;
    if (!S.next(0, cur)) return;
    f32x4 acc[2][2][4][2];
#pragma unroll
    for (int a = 0; a < 2; ++a)
#pragma unroll
        for (int b = 0; b < 2; ++b)
#pragma unroll
            for (int m = 0; m < 4; ++m)
#pragma unroll
                for (int n = 0; n < 2; ++n) acc[a][b][m][n] = (f32x4){0.f, 0.f, 0.f, 0.f};
    bf16x8 At[4][2], B0[2][2], B1[2][2];
    const char* cA = (const char*)g.A + (size_t)cur.pm * tstepA; const char* cB = (const char*)g.Bt + (size_t)cur.pn * tstep;
    S.a_ready(cur);
    if constexpr (SP2) {
        PG8_STAGE(PG8_SB(0, 0), cB, voffB); PG8_STAGE(PG8_SB(0, 1), cB + hstep, voffB); PG8_STAGE(PG8_SA(0, 0), cA, voffA); PG8_STAGE(PG8_SA(0, 1), cA + hstep, voffA);
        if (wr == 1) PG8_BAR;
        PG8_WAIT_V(2); PG8_BAR;
        PG8_STAGE(PG8_SB(1, 0), cB + kstep, voffB); PG8_STAGE(PG8_SA(1, 0), cA + kstep, voffA); PG8_STAGE(PG8_SB(1, 1), cB + hstep + kstep, voffB);
        PG8_WAIT_V(6); PG8_BAR;
    } else {
        PG8_STAGE(PG8_SB(0, 0), cB, voffB); PG8_STAGE(PG8_SA(0, 0), cA, voffA); PG8_STAGE(PG8_SB(0, 1), cB + hstep, voffB); PG8_STAGE(PG8_SA(0, 1), cA + hstep, voffA);
        if (wr == 1) PG8_BAR;
        PG8_WAIT_V(4); PG8_BAR;
        PG8_STAGE(PG8_SB(1, 0), cB + kstep, voffB); PG8_STAGE(PG8_SA(1, 0), cA + kstep, voffA); PG8_STAGE(PG8_SB(1, 1), cB + hstep + kstep, voffB);
        PG8_WAIT_V(6); PG8_BAR;
    }
    for (;;) {
        const bool has_next = S.next(ui + 1, nxt);
        const char* nA = has_next ? (const char*)g.A + (size_t)nxt.pm * tstepA : cA; const char* nB = has_next ? (const char*)g.Bt + (size_t)nxt.pn * tstep : cB;
        for (int t = 0; t < nt; t += 2) {
            const bool last = (t == nt - 2);
            const char* a1 = cA + (size_t)(t + 1) * kstep;
            const char* a2 = last ? nA : cA + (size_t)(t + 2) * kstep; const char* b2 = last ? nB : cB + (size_t)(t + 2) * kstep;
            const char* a3 = a2 + kstep; const char* b3 = b2 + kstep;
            if (last && has_next) S.a_ready(nxt);
            if constexpr (SP2) {
            PG8_LDB(B0, 0, 0); PG8_LDB(B1, 0, 1); PG8_SCHED; PG8_LDA(At, 0, 0); PG8_STAGE(PG8_SA(1, 1), a1 + hstep, voffA);
            PG8_WAIT_V(8); PG8_WAIT_L(0); PG8_BAR; PG8_MMA(0, 0, At, B0); PG8_MMA(0, 1, At, B1); PG8_BAR; PG8_SCHED;
            PG8_LDA(At, 0, 1); PG8_STAGE(PG8_SB(0, 0), b2, voffB); PG8_STAGE(PG8_SB(0, 1), b2 + hstep, voffB); PG8_STAGE(PG8_SA(0, 0), a2, voffA);
            PG8_WAIT_V(8); PG8_WAIT_L(0); PG8_BAR; PG8_MMA(1, 0, At, B0); PG8_MMA(1, 1, At, B1); PG8_BAR; PG8_SCHED;
            PG8_LDB(B0, 1, 0); PG8_LDB(B1, 1, 1); PG8_SCHED; PG8_LDA(At, 1, 0); PG8_STAGE(PG8_SA(0, 1), a2 + hstep, voffA);
            PG8_WAIT_V(8); PG8_WAIT_L(0); PG8_BAR; PG8_MMA(0, 0, At, B0); PG8_MMA(0, 1, At, B1); PG8_BAR; PG8_SCHED;
            PG8_LDA(At, 1, 1); PG8_STAGE(PG8_SB(1, 0), b3, voffB); PG8_STAGE(PG8_SB(1, 1), b3 + hstep, voffB); PG8_STAGE(PG8_SA(1, 0), a3, voffA);
            PG8_WAIT_V(8); PG8_WAIT_L(0); PG8_BAR; PG8_MMA(1, 0, At, B0); PG8_MMA(1, 1, At, B1); PG8_BAR; PG8_SCHED;
            } else {
            PG8_LDB(B0, 0, 0); PG8_SCHED; PG8_LDA(At, 0, 0); PG8_STAGE(PG8_SA(1, 1), a1 + hstep, voffA);
            PG8_WAIT_L(8); PG8_BAR; PG8_WAIT_L(0); PG8_MMA(0, 0, At, B0); PG8_BAR; PG8_SCHED;
            PG8_LDB(B1, 0, 1); PG8_STAGE(PG8_SB(0, 0), b2, voffB);
            PG8_BAR; PG8_WAIT_L(0); PG8_MMA(0, 1, At, B1); PG8_BAR;
            PG8_LDA(At, 0, 1); PG8_STAGE(PG8_SA(0, 0), a2, voffA);
            PG8_BAR; PG8_WAIT_L(0); PG8_MMA(1, 0, At, B0); PG8_BAR; PG8_SCHED;
            PG8_STAGE(PG8_SB(0, 1), b2 + hstep, voffB);
            PG8_WAIT_V(6); PG8_BAR; PG8_MMA(1, 1, At, B1); PG8_BAR;
            PG8_LDB(B0, 1, 0); PG8_SCHED; PG8_LDA(At, 1, 0); PG8_STAGE(PG8_SA(0, 1), a2 + hstep, voffA);
            PG8_WAIT_L(8); PG8_BAR; PG8_WAIT_L(0); PG8_MMA(0, 0, At, B0); PG8_BAR; PG8_SCHED;
            PG8_LDB(B1, 1, 1); PG8_STAGE(PG8_SB(1, 0), b3, voffB);
            PG8_BAR; PG8_WAIT_L(0); PG8_MMA(0, 1, At, B1); PG8_BAR;
            PG8_LDA(At, 1, 1); PG8_STAGE(PG8_SA(1, 0), a3, voffA);
            PG8_BAR; PG8_WAIT_L(0); PG8_MMA(1, 0, At, B0); PG8_BAR; PG8_SCHED;
            PG8_STAGE(PG8_SB(1, 1), b3 + hstep, voffB);
            PG8_WAIT_V(6); PG8_BAR; PG8_MMA(1, 1, At, B1); PG8_BAR;
            }
        }
        if constexpr (ALIGN_EPI) { if (wr == 0) PG8_BAR; }
        if constexpr (!Epi::AFTER_DRAIN) { E(acc, cur, wr, wc, fr, fq); S.done(cur); }
        if (!has_next) break;
#pragma unroll
        for (int a = 0; a < 2; ++a)
#pragma unroll
            for (int b = 0; b < 2; ++b)
#pragma unroll
                for (int m = 0; m < 4; ++m)
#pragma unroll
                    for (int n = 0; n < 2; ++n) acc[a][b][m][n] = (f32x4){0.f, 0.f, 0.f, 0.f};
        cur = nxt; cA = nA; cB = nB; ++ui;
        if constexpr (ALIGN_EPI) { if (wr == 1) PG8_BAR; }
    }
    PG8_WAIT_V(0);
    if constexpr (!ALIGN_EPI) { if (wr == 0) PG8_BAR; }
    PG8_BAR;
    if constexpr (Epi::AFTER_DRAIN) { E.fused(acc, cur, wr, wc, fr, fq, lds, wid, lane); S.done(cur); }
#undef PG8_SA
#undef PG8_SB
#undef PG8_STAGE
#undef PG8_LDA
#undef PG8_LDB
#undef PG8_MMA
#undef PG8_WAIT_V
#undef PG8_WAIT_L
#undef PG8_BAR
#undef PG8_SCHED
}
}
constexpr int S = 16384, DM = 1024, DEPTH = 4, NIN = 2816, DFF = 2816, NUP = 5632;
constexpr float EPS = 1e-6f;
constexpr int NWAVES = 8, NTHR = 512;
constexpr size_t MiB = 1u << 20;
constexpr size_t WS_WIN = 1 * MiB, WS_WOUT = 23 * MiB, WS_WUP = 31 * MiB, WS_WDN = 75 * MiB;
constexpr size_t WS_PART = 97 * MiB;
constexpr size_t WS_XB = 98 * MiB + 4096;
constexpr size_t WS_P = 131 * MiB;
constexpr size_t WS_Y = 219 * MiB;
constexpr size_t WS_GU = 131 * MiB;
constexpr size_t WS_A = 219 * MiB;
constexpr size_t WS_END = 307 * MiB;
constexpr int LDS_BYTES = 147456;
#define LAS __attribute__((address_space(3)))
typedef unsigned short bf16;
typedef unsigned v4u __attribute__((ext_vector_type(4)));
typedef unsigned v2u __attribute__((ext_vector_type(2)));
typedef float f32x4 __attribute__((ext_vector_type(4)));
typedef float f32x16 __attribute__((ext_vector_type(16)));
typedef short bf16x8 __attribute__((ext_vector_type(8)));
#define LDS_WAIT() asm volatile("s_waitcnt lgkmcnt(0)" ::: "memory")
__device__ __forceinline__ unsigned pk2(float lo, float hi) { return pg8::cvt_pk_bf16(lo, hi); }
__device__ __forceinline__ float bflo(unsigned u) { return __uint_as_float(u << 16); }
__device__ __forceinline__ float bfhi(unsigned u) { return __uint_as_float(u & 0xffff0000u); }
__device__ __forceinline__ float bf1(bf16 v) { return __uint_as_float((unsigned)v << 16); }
#define WS_DPP(v, ctrl) __builtin_bit_cast(float, __builtin_amdgcn_update_dpp(0, __builtin_bit_cast(int, (float)(v)), (ctrl), 0xf, 0xf, true))
__device__ __forceinline__ float wave_sum(float v) {
    v += WS_DPP(v, 0xB1); v += WS_DPP(v, 0x4E); v += WS_DPP(v, 0x141); v += WS_DPP(v, 0x140);
    const int iv = __builtin_bit_cast(int, v);
    const float a = __builtin_bit_cast(float, __builtin_amdgcn_readlane(iv, 0)), b = __builtin_bit_cast(float, __builtin_amdgcn_readlane(iv, 16));
    const float c = __builtin_bit_cast(float, __builtin_amdgcn_readlane(iv, 32)), d = __builtin_bit_cast(float, __builtin_amdgcn_readlane(iv, 48));
    return (a + b) + (c + d);
}

__device__ __forceinline__ void cvt_item(const float* W, int K, int N, bf16* WT, const float* gain, int mode, LAS float* scr, int item, int lane) {
    const int nblk = N / 32, kb = item / nblk, nb = item % nblk, k0 = 64 * kb, n0 = 32 * nb;
    float wv[32];
#pragma unroll
    for (int i = 0; i < 32; ++i) { const int kk = 2 * i + (lane >> 5); wv[i] = ((const __attribute__((address_space(1))) float*)W)[(size_t)(k0 + kk) * N + n0 + (lane & 31)]; }
#pragma unroll
    for (int i = 0; i < 32; ++i) { const int kk = 2 * i + (lane >> 5); const float g = gain ? ((const __attribute__((address_space(1))) float*)gain)[k0 + kk] : 1.0f; scr[kk * 33 + (lane & 31)] = wv[i] * g; }
    LDS_WAIT(); asm volatile("" ::: "memory");
    const float cs = (mode == 1 && n0 >= 1280 && n0 < 1792) ? 0.125f * 1.4426950408889634f : 1.0f;
    int rb = n0;
    if (mode == 2) { rb = (n0 < DFF) ? 256 * (n0 / 128) + (n0 % 128) : 256 * ((n0 - DFF) / 128) + 128 + ((n0 - DFF) % 128); }
    const int c = lane & 7;
#pragma unroll
    for (int j = 0; j < 4; ++j) { const int n = (lane >> 3) + 8 * j; const LAS float* s = scr + (8 * c) * 33 + n;
        v4u o; o.x = pk2(s[0 * 33] * cs, s[1 * 33] * cs); o.y = pk2(s[2 * 33] * cs, s[3 * 33] * cs); o.z = pk2(s[4 * 33] * cs, s[5 * 33] * cs); o.w = pk2(s[6 * 33] * cs, s[7 * 33] * cs);
        *(__attribute__((address_space(1))) v4u*)(WT + (size_t)(rb + n) * K + k0 + 8 * c) = o; }
    LDS_WAIT(); asm volatile("" ::: "memory");
}

typedef __attribute__((address_space(1))) unsigned gu32;
#define XB_TMO      128
#define XB_XCNT(j)  (256  + 64 * (j))
#define XB_XSUB(j)  (1280 + 64 * (j))
#define XB_XGEN(j)  (2304 + 64 * (j))
#define XB_TOP      3328
#define XB_TOPGEN   3392
#define XCD_BAR_WORDS 3456
#define XB_SPIN_CAP (1u << 18)

__device__ __forceinline__ unsigned xb_ld(unsigned* p)              { return __hip_atomic_load(p, __ATOMIC_RELAXED, __HIP_MEMORY_SCOPE_AGENT); }
__device__ __forceinline__ unsigned xb_add(unsigned* p, unsigned v) { return __hip_atomic_fetch_add(p, v, __ATOMIC_RELAXED, __HIP_MEMORY_SCOPE_AGENT); }
__device__ __forceinline__ unsigned xb_xcc_id() { return (unsigned)__builtin_amdgcn_s_getreg((3 << 11) | 20) & 0xFu; }
#define XB_SPIN(cond, bar) do { unsigned _sp = 0; while (cond) { __builtin_amdgcn_s_sleep(1); \
    if ((++_sp & 255u) == 0u) { if (xb_ld(&(bar)[XB_TMO])) break; if (_sp > XB_SPIN_CAP) { atomicAdd(&(bar)[XB_TMO], 1u); break; } } } } while (0)

struct XcdBarrier {
    unsigned* bar; unsigned x;
    volatile LAS unsigned* st;
};

__device__ __forceinline__ XcdBarrier xcd_barrier_post(unsigned* bar, volatile LAS unsigned* st) {
    XcdBarrier b; b.bar = bar; b.x = xb_xcc_id(); b.st = st;
    if (threadIdx.x == 0) (void)xb_add(&bar[XB_XCNT(b.x)], 1u);
    return b;
}
__device__ __forceinline__ void xcd_barrier_complete(unsigned* bar, unsigned x, unsigned& nloc, unsigned& nx) {
    const unsigned G = gridDim.x * gridDim.y * gridDim.z;
    unsigned sum, cnt, mine, sp = 0u;
    for (;;) {
        sum = 0u; cnt = 0u; mine = 0u;
#pragma unroll
        for (unsigned j = 0; j < 16; ++j) { const unsigned c = xb_ld(&bar[XB_XCNT(j)]); sum += c; cnt += (c > 0u) ? 1u : 0u; mine = (j == x) ? c : mine; }
        if (sum == G) break;
        __builtin_amdgcn_s_sleep(1);
        if ((++sp & 255u) == 0u) { if (xb_ld(&bar[XB_TMO])) break; if (sp > XB_SPIN_CAP) { atomicAdd(&bar[XB_TMO], 1u); break; } }
    }
    nloc = mine > 0u ? mine : 1u; nx = cnt > 0u ? cnt : 1u;
}

__device__ __forceinline__ void xcd_barrier(const XcdBarrier& b) {
    asm volatile("s_waitcnt vmcnt(0)" ::: "memory");
    __syncthreads();
    if (threadIdx.x == 0) {
        unsigned* bar = b.bar;
        __builtin_amdgcn_s_waitcnt(0);
        unsigned nloc = b.st[0], nx = b.st[1];
        if (nloc == 0u) { xcd_barrier_complete(bar, b.x, nloc, nx); b.st[0] = nloc; b.st[1] = nx; }
        const unsigned old = xb_add(&bar[XB_XSUB(b.x)], 1u);
        const unsigned gen = old / nloc;
        if (old + 1u == (gen + 1u) * nloc) {
            __builtin_amdgcn_fence(__ATOMIC_RELEASE, "agent");
            asm volatile("s_waitcnt vmcnt(0)" ::: "memory");
            const unsigned og = xb_add(&bar[XB_TOP], 1u);
            const unsigned tg = og / nx;
            if (og + 1u == (tg + 1u) * nx) xb_add(&bar[XB_TOPGEN], 1u);
            else XB_SPIN(xb_ld(&bar[XB_TOPGEN]) == tg, bar);
            __builtin_amdgcn_fence(__ATOMIC_ACQUIRE, "agent");
            xb_add(&bar[XB_XGEN(b.x)], 1u);
            asm volatile("s_waitcnt vmcnt(0)" ::: "memory");
        } else {
            XB_SPIN(xb_ld(&bar[XB_XGEN(b.x)]) == gen, bar);
            __builtin_amdgcn_fence(__ATOMIC_ACQUIRE, "agent");
            asm volatile("s_waitcnt vmcnt(0)" ::: "memory");
        }
    }
    __syncthreads();
}

struct CvtSrc { const float *w_in, *w_out, *w_up, *w_down, *norm_mix, *out_norm, *norm_ffn; bf16 *Win_t, *Wout_t, *Wup_t, *Wdn_t; };
__device__ __forceinline__ void cvt_layer_item(const CvtSrc& c, int l, int r, LAS float* scr, int lane) {
    const float* W; bf16* WT; const float* gain; int K, N, mode;
    if (r < 1408) { W = c.w_in + (size_t)l * DM * NIN; K = DM; N = NIN; WT = c.Win_t + (size_t)l * NIN * DM; gain = c.norm_mix + l * DM; mode = 1; }
    else if (r < 1920) { r -= 1408; W = c.w_out + (size_t)l * DM * DM; K = DM; N = DM; WT = c.Wout_t + (size_t)l * DM * DM; gain = c.out_norm + l * DM; mode = 0; }
    else if (r < 4736) { r -= 1920; W = c.w_up + (size_t)l * DM * NUP; K = DM; N = NUP; WT = c.Wup_t + (size_t)l * NUP * DM; gain = c.norm_ffn + l * DM; mode = 2; }
    else { r -= 4736; W = c.w_down + (size_t)l * DFF * DM; K = DFF; N = DM; WT = c.Wdn_t + (size_t)l * DM * DFF; gain = nullptr; mode = 0; }
    cvt_item(W, K, N, WT, gain, mode, scr, r, lane);
}
__device__ __forceinline__ const float* ldptr(const volatile LAS unsigned* PT, int k) {
    const unsigned lo = __builtin_amdgcn_readfirstlane(PT[2 * k]), hi = __builtin_amdgcn_readfirstlane(PT[2 * k + 1]);
    return (const float*)(const __attribute__((address_space(1))) float*)(((unsigned long long)hi << 32) | lo);
}
struct Args { const float* in[14]; float* out; unsigned char* ws; };

__device__ __forceinline__ void norm_store_rows(const LAS float* tile, bf16* Y, int t0, int coff, int wave, int lane) {
#pragma unroll 2
    for (int i = 0; i < 8; ++i) { const int r = wave * 8 + i; const f32x4 v = *(const LAS f32x4*)(tile + r * 260 + lane * 4);
        const float ss = wave_sum((v[0] * v[0] + v[1] * v[1]) + (v[2] * v[2] + v[3] * v[3]));
        const float rs = __builtin_amdgcn_rsqf(ss * (1.0f / 256.0f) + EPS);
        v2u o; o.x = pk2(v[0] * rs, v[1] * rs); o.y = pk2(v[2] * rs, v[3] * rs);
        *(__attribute__((address_space(1))) v2u*)(Y + (size_t)(t0 + r) * DM + coff + lane * 4) = o; }
}

__device__ __forceinline__ void mixer_unit(LAS unsigned char* lds, int unit, const bf16* P, bf16* Y, const float* conv_w, const float* sgu_norm, const float* sgu_w, const float* sgu_b, int tid, int wave, int lane) {
    const int t0 = unit * 64;
    asm volatile("" : "+v"(tid), "+v"(lane));
    LAS bf16* vnT = (LAS bf16*)lds;
    LAS float* tile = (LAS float*)(lds + 69632);
    LAS float* sm_ss = (LAS float*)(lds + 69632 + 66560);
    {
        const int hd = wave, r = lane & 31, h = lane >> 5;
        const int pr = (r & 0x13) | ((r & 4) << 1) | ((r & 8) >> 1);
        LAS bf16* Vt = (LAS bf16*)(lds + wave * 5120);
        bf16x8 atri[2];
#pragma unroll
        for (int sI = 0; sI < 2; ++sI) { v4u t;
            t.x = ((16 * sI + 8 * h + 0 > pr) ? 0x3F80u : 0u) | ((16 * sI + 8 * h + 1 > pr) ? 0x3F800000u : 0u); t.y = ((16 * sI + 8 * h + 2 > pr) ? 0x3F80u : 0u) | ((16 * sI + 8 * h + 3 > pr) ? 0x3F800000u : 0u);
            t.z = ((16 * sI + 8 * h + 4 > pr) ? 0x3F80u : 0u) | ((16 * sI + 8 * h + 5 > pr) ? 0x3F800000u : 0u); t.w = ((16 * sI + 8 * h + 6 > pr) ? 0x3F80u : 0u) | ((16 * sI + 8 * h + 7 > pr) ? 0x3F800000u : 0u);
            atri[sI] = __builtin_bit_cast(bf16x8, t); }
        f32x16 oacc[2][2];
        bf16x8 kfn[4]; v4u vvn[4];
        { const bf16* kp = P + (size_t)(t0 + 32 + pr) * NIN + 1792 + hd * 64 + 8 * h;
#pragma unroll
          for (int ks = 0; ks < 4; ++ks) kfn[ks] = *(const __attribute__((address_space(1))) bf16x8*)(kp + 16 * ks);
#pragma unroll
          for (int i = 0; i < 4; ++i) vvn[i] = *(const __attribute__((address_space(1))) v4u*)(P + (size_t)(t0 + 32 + (lane >> 3) + 8 * i) * NIN + 2304 + hd * 64 + 8 * (lane & 7)); }
        LAS bf16x8* Qs = (LAS bf16x8*)(lds + 40960 + wave * 8192);
#pragma unroll
        for (int ks = 0; ks < 4; ++ks) { Qs[ks * 64 + lane] = *(const __attribute__((address_space(1))) bf16x8*)(P + (size_t)(t0 + r) * NIN + 1280 + hd * 64 + 16 * ks + 8 * h); Qs[(4 + ks) * 64 + lane] = *(const __attribute__((address_space(1))) bf16x8*)(P + (size_t)(t0 + 32 + r) * NIN + 1280 + hd * 64 + 16 * ks + 8 * h); }
#pragma unroll
        for (int a = 0; a < 2; ++a)
#pragma unroll
            for (int b = 0; b < 2; ++b) oacc[a][b] = (f32x16){};
        float lsA = 0.f, lsB = 0.f; bool actA = true, actB = true;
#define SB_CHAIN(Z, O0, O1, LS, DIAGV) do { \
            f32x16 cin; float Lv[16]; \
            _Pragma("unroll") for (int jj = 0; jj < 16; ++jj) { const float zz = Z[jj]; const float ex = __builtin_amdgcn_exp2f(-fabsf(zz)); const float lsig = fminf(zz, 0.f) - __builtin_amdgcn_logf(1.0f + ex); \
                Lv[jj] = lsig - zz; cin[jj] = lsig + LS; } \
            if (DIAGV) { _Pragma("unroll") for (int jj = 0; jj < 16; ++jj) { const int keyl = 16 * (jj >> 3) + 8 * h + (jj & 7); Lv[jj] = (keyl < r) ? Lv[jj] : 0.f; } } \
            float rowsum = 0.f; unsigned lh[8], ll[8]; \
            _Pragma("unroll") for (int j = 0; j < 16; j += 2) { rowsum += Lv[j] + Lv[j + 1]; \
                const unsigned hp = pk2(Lv[j], Lv[j + 1]); lh[j >> 1] = hp; ll[j >> 1] = pk2(Lv[j] - bflo(hp), Lv[j + 1] - bfhi(hp)); } \
            const bf16x8 bh0 = __builtin_bit_cast(bf16x8, (v4u){lh[0], lh[1], lh[2], lh[3]}), bh1 = __builtin_bit_cast(bf16x8, (v4u){lh[4], lh[5], lh[6], lh[7]}); \
            const bf16x8 bl0 = __builtin_bit_cast(bf16x8, (v4u){ll[0], ll[1], ll[2], ll[3]}), bl1 = __builtin_bit_cast(bf16x8, (v4u){ll[4], ll[5], ll[6], ll[7]}); \
            f32x16 lw = __builtin_amdgcn_mfma_f32_32x32x16_bf16(atri[0], bh0, cin, 0, 0, 0); \
            lw = __builtin_amdgcn_mfma_f32_32x32x16_bf16(atri[1], bh1, lw, 0, 0, 0); \
            lw = __builtin_amdgcn_mfma_f32_32x32x16_bf16(atri[0], bl0, lw, 0, 0, 0); \
            lw = __builtin_amdgcn_mfma_f32_32x32x16_bf16(atri[1], bl1, lw, 0, 0, 0); \
            float wv[16]; \
            _Pragma("unroll") for (int jj = 0; jj < 16; ++jj) wv[jj] = __builtin_amdgcn_exp2f(lw[jj]); \
            if (DIAGV) { _Pragma("unroll") for (int jj = 0; jj < 16; ++jj) { const int keyl = 16 * (jj >> 3) + 8 * h + (jj & 7); wv[jj] = (keyl < r) ? wv[jj] : 0.f; } } \
            unsigned wp[8]; \
            _Pragma("unroll") for (int j = 0; j < 16; j += 2) wp[j >> 1] = pk2(wv[j], wv[j + 1]); \
            const bf16x8 w0 = __builtin_bit_cast(bf16x8, (v4u){wp[0], wp[1], wp[2], wp[3]}), w1 = __builtin_bit_cast(bf16x8, (v4u){wp[4], wp[5], wp[6], wp[7]}); \
            const LAS bf16* vr = Vt + r * 40 + 8 * h; \
            O0 = __builtin_amdgcn_mfma_f32_32x32x16_bf16(*(const LAS bf16x8*)(vr), w0, O0, 0, 0, 0); \
            O0 = __builtin_amdgcn_mfma_f32_32x32x16_bf16(*(const LAS bf16x8*)(vr + 16), w1, O0, 0, 0, 0); \
            O1 = __builtin_amdgcn_mfma_f32_32x32x16_bf16(*(const LAS bf16x8*)(vr + 32 * 40), w0, O1, 0, 0, 0); \
            O1 = __builtin_amdgcn_mfma_f32_32x32x16_bf16(*(const LAS bf16x8*)(vr + 32 * 40 + 16), w1, O1, 0, 0, 0); \
            LS += rowsum + __shfl_xor(rowsum, 32); } while (0)
        for (int k0 = t0 + 32;; k0 -= 32) {
            const bool doA = actA && (k0 <= t0);
            f32x16 zB = {}, zA = {};
            if (actB) {
#pragma unroll
                for (int ks = 0; ks < 4; ++ks) zB = __builtin_amdgcn_mfma_f32_32x32x16_bf16(kfn[ks], Qs[(4 + ks) * 64 + lane], zB, 0, 0, 0); }
            if (doA) {
#pragma unroll
                for (int ks = 0; ks < 4; ++ks) zA = __builtin_amdgcn_mfma_f32_32x32x16_bf16(kfn[ks], Qs[ks * 64 + lane], zA, 0, 0, 0); }
#pragma unroll
            for (int i = 0; i < 4; ++i) { const int key = (lane >> 3) + 8 * i, c = lane & 7; const v4u vv = vvn[i];
                LAS bf16* vd = Vt + (8 * c) * 40 + key;
                vd[0] = (bf16)(vv.x & 0xffffu); vd[40] = (bf16)(vv.x >> 16); vd[80] = (bf16)(vv.y & 0xffffu); vd[120] = (bf16)(vv.y >> 16);
                vd[160] = (bf16)(vv.z & 0xffffu); vd[200] = (bf16)(vv.z >> 16); vd[240] = (bf16)(vv.w & 0xffffu); vd[280] = (bf16)(vv.w >> 16); }
            if (k0 >= 32) { const bf16* kp = P + (size_t)(k0 - 32 + pr) * NIN + 1792 + hd * 64 + 8 * h;
#pragma unroll
                for (int ks = 0; ks < 4; ++ks) kfn[ks] = *(const __attribute__((address_space(1))) bf16x8*)(kp + 16 * ks);
#pragma unroll
                for (int i = 0; i < 4; ++i) vvn[i] = *(const __attribute__((address_space(1))) v4u*)(P + (size_t)(k0 - 32 + (lane >> 3) + 8 * i) * NIN + 2304 + hd * 64 + 8 * (lane & 7)); }
            if (actB) { const bool dg = (k0 == t0 + 32); SB_CHAIN(zB, oacc[1][0], oacc[1][1], lsB, dg);
                if (__builtin_amdgcn_ballot_w64(lsB > -150.1f) == 0ull) actB = false; }
            if (doA) { const bool dg = (k0 == t0); SB_CHAIN(zA, oacc[0][0], oacc[0][1], lsA, dg);
                if (__builtin_amdgcn_ballot_w64(lsA > -150.1f) == 0ull) actA = false; }
            if (k0 < 32 || !(actA || actB)) break;
        }
#undef SB_CHAIN
#pragma unroll
        for (int qh = 0; qh < 2; ++qh) { float ss = 0.f;
#pragma unroll
            for (int j = 0; j < 16; ++j) ss += oacc[qh][0][j] * oacc[qh][0][j] + oacc[qh][1][j] * oacc[qh][1][j];
            ss += __shfl_xor(ss, 32);
            if (h == 0) sm_ss[(32 * qh + r) * 8 + hd] = ss; }
        LDS_WAIT(); __syncthreads();
#pragma unroll
        for (int qh = 0; qh < 2; ++qh) {
            const f32x4 sa = *(const LAS f32x4*)(sm_ss + (32 * qh + r) * 8), sb = *(const LAS f32x4*)(sm_ss + (32 * qh + r) * 8 + 4);
            const float tot = ((sa[0] + sa[1]) + (sa[2] + sa[3])) + ((sb[0] + sb[1]) + (sb[2] + sb[3]));
            const float rs = __builtin_amdgcn_rsqf(tot * (1.0f / 512.0f) + EPS);
            bf16* yp = Y + (size_t)(t0 + 32 * qh + r) * DM + 512 + hd * 64 + 4 * h;
#pragma unroll
            for (int db = 0; db < 2; ++db)
#pragma unroll
                for (int g4 = 0; g4 < 4; ++g4) { const f32x16& o = oacc[qh][db]; v2u w; w.x = pk2(o[4 * g4 + 0] * rs, o[4 * g4 + 1] * rs); w.y = pk2(o[4 * g4 + 2] * rs, o[4 * g4 + 3] * rs);
                    *(__attribute__((address_space(1))) v2u*)(yp + 32 * db + 8 * g4) = w; }
        }
    }
    const int c8 = (tid & 31) * 8, rg = tid >> 5, tb = t0 + 4 * rg;
    v4u gb[4], gc[6], hc[6];
#pragma unroll
    for (int i = 0; i < 6; ++i) { const int t = tb - 2 + i; const bool ok = t >= 0; const bf16* rp = P + (size_t)(ok ? t : 0) * NIN;
        gc[i] = ok ? *(const __attribute__((address_space(1))) v4u*)(rp + 256 + c8) : (v4u){0u, 0u, 0u, 0u}; hc[i] = ok ? *(const __attribute__((address_space(1))) v4u*)(rp + 512 + c8) : (v4u){0u, 0u, 0u, 0u};
        if (i >= 2) gb[i - 2] = *(const __attribute__((address_space(1))) v4u*)(rp + c8); }
    const int tc = t0 & ~127, dt = t0 - tc, ns = dt + 64;
    v2u uu[16];
#pragma unroll
    for (int i = 0; i < 16; ++i) { const int s = wave + 8 * i; uu[i] = (s < ns) ? *(const __attribute__((address_space(1))) v2u*)(P + (size_t)(tc + s) * NIN + 1024 + lane * 4) : (v2u){0u, 0u}; }
    const int h = wave >> 1, rh = wave & 1, r32 = lane & 31, hi = lane >> 5;
    const int tcl = dt + 32 * rh + r32;
    const int nk = (dt + 32 * rh + 32) >> 4;
    f32x4 wa[8], wb[8];
    { const float* wrow = sgu_w + ((size_t)h * 128 + tcl) * 128;
#pragma unroll
      for (int ks = 0; ks < 8; ++ks) { const int s0 = ks * 16 + 8 * hi; if (ks < nk) { wa[ks] = *(const __attribute__((address_space(1))) f32x4*)(wrow + s0); wb[ks] = *(const __attribute__((address_space(1))) f32x4*)(wrow + s0 + 4); } else { wa[ks] = (f32x4){0.f, 0.f, 0.f, 0.f}; wb[ks] = wa[ks]; } } }
    {
        float w0[8], w1[8], w2[8];
        { const f32x4 a0 = *(const __attribute__((address_space(1))) f32x4*)(conv_w + c8), a1 = *(const __attribute__((address_space(1))) f32x4*)(conv_w + c8 + 4), b0 = *(const __attribute__((address_space(1))) f32x4*)(conv_w + 256 + c8), b1 = *(const __attribute__((address_space(1))) f32x4*)(conv_w + 256 + c8 + 4), d0 = *(const __attribute__((address_space(1))) f32x4*)(conv_w + 512 + c8), d1 = *(const __attribute__((address_space(1))) f32x4*)(conv_w + 512 + c8 + 4);
#pragma unroll
          for (int e = 0; e < 4; ++e) { w0[e] = a0[e]; w0[4 + e] = a1[e]; w1[e] = b0[e]; w1[4 + e] = b1[e]; w2[e] = d0[e]; w2[4 + e] = d1[e]; } }
        float pr_[6][8];
#pragma unroll
        for (int i = 0; i < 6; ++i) { const unsigned ga[4] = {gc[i].x, gc[i].y, gc[i].z, gc[i].w}, ha[4] = {hc[i].x, hc[i].y, hc[i].z, hc[i].w};
#pragma unroll
            for (int e = 0; e < 4; ++e) { pr_[i][2 * e] = bflo(ga[e]) * bflo(ha[e]); pr_[i][2 * e + 1] = bfhi(ga[e]) * bfhi(ha[e]); } }
#pragma unroll
        for (int i = 0; i < 4; ++i) { const unsigned ba[4] = {gb[i].x, gb[i].y, gb[i].z, gb[i].w}; float o[8];
#pragma unroll
            for (int e = 0; e < 4; ++e) { o[2 * e] = bflo(ba[e]) * (w0[2 * e] * pr_[i][2 * e] + w1[2 * e] * pr_[i + 1][2 * e] + w2[2 * e] * pr_[i + 2][2 * e]);
                o[2 * e + 1] = bfhi(ba[e]) * (w0[2 * e + 1] * pr_[i][2 * e + 1] + w1[2 * e + 1] * pr_[i + 1][2 * e + 1] + w2[2 * e + 1] * pr_[i + 2][2 * e + 1]); }
            LAS f32x4* tp = (LAS f32x4*)(tile + (4 * rg + i) * 260 + c8); tp[0] = (f32x4){o[0], o[1], o[2], o[3]}; tp[1] = (f32x4){o[4], o[5], o[6], o[7]}; }
    }
    LDS_WAIT(); __syncthreads();
    norm_store_rows(tile, Y, t0, 0, wave, lane);
    { const f32x4 g = *(const __attribute__((address_space(1))) f32x4*)(sgu_norm + lane * 4);
#pragma unroll
      for (int i = 0; i < 16; ++i) { const int s = wave + 8 * i;
        if (s < ns) { const v2u u = uu[i];
        const float v0 = bflo(u.x), v1 = bfhi(u.x), v2 = bflo(u.y), v3 = bfhi(u.y);
        const float ss = wave_sum((v0 * v0 + v1 * v1) + (v2 * v2 + v3 * v3)); const float rs = __builtin_amdgcn_rsqf(ss * (1.0f / 256.0f) + EPS);
        const unsigned a = pk2(v0 * rs * g[0], v1 * rs * g[1]), b = pk2(v2 * rs * g[2], v3 * rs * g[3]);
        vnT[(lane * 4 + 0) * 136 + s] = (bf16)(a & 0xffffu); vnT[(lane * 4 + 1) * 136 + s] = (bf16)(a >> 16); vnT[(lane * 4 + 2) * 136 + s] = (bf16)(b & 0xffffu); vnT[(lane * 4 + 3) * 136 + s] = (bf16)(b >> 16); } } }
    float ug0[16], ug1[16], bbv[16];
#pragma unroll
    for (int j = 0; j < 16; ++j) { const int rl = 32 * rh + (j & 3) + 8 * (j >> 2) + 4 * hi; const bf16* up = P + (size_t)(t0 + rl) * NIN + 768 + h * 64;
        ug0[j] = bf1(((const __attribute__((address_space(1))) bf16*)up)[r32]); ug1[j] = bf1(((const __attribute__((address_space(1))) bf16*)up)[32 + r32]); bbv[j] = ((const __attribute__((address_space(1))) float*)sgu_b)[h * 128 + dt + rl]; }
    LDS_WAIT(); __syncthreads();
    {
        f32x16 o0 = {}, o1 = {};
#pragma unroll
        for (int ks = 0; ks < 8; ++ks) if (ks < nk) { const int s0 = ks * 16 + 8 * hi;
            float wv[8] = {wa[ks][0], wa[ks][1], wa[ks][2], wa[ks][3], wb[ks][0], wb[ks][1], wb[ks][2], wb[ks][3]};
#pragma unroll
            for (int i = 0; i < 8; ++i) wv[i] = (s0 + i <= tcl) ? wv[i] : 0.f;
            v4u ap; ap.x = pk2(wv[0], wv[1]); ap.y = pk2(wv[2], wv[3]); ap.z = pk2(wv[4], wv[5]); ap.w = pk2(wv[6], wv[7]);
            const bf16x8 af = __builtin_bit_cast(bf16x8, ap);
            const bf16x8 b0 = *(const LAS bf16x8*)(vnT + (h * 64 + r32) * 136 + s0), b1 = *(const LAS bf16x8*)(vnT + (h * 64 + 32 + r32) * 136 + s0);
            o0 = __builtin_amdgcn_mfma_f32_32x32x16_bf16(af, b0, o0, 0, 0, 0);
            o1 = __builtin_amdgcn_mfma_f32_32x32x16_bf16(af, b1, o1, 0, 0, 0); }
#pragma unroll
        for (int j = 0; j < 16; ++j) { const int rl = 32 * rh + (j & 3) + 8 * (j >> 2) + 4 * hi;
            tile[rl * 260 + h * 64 + r32] = ug0[j] * (o0[j] + bbv[j]);
            tile[rl * 260 + h * 64 + 32 + r32] = ug1[j] * (o1[j] + bbv[j]); }
    }
    LDS_WAIT(); __syncthreads();
    norm_store_rows(tile, Y, t0, 256, wave, lane);
    LDS_WAIT(); __syncthreads();
}

__device__ __forceinline__ void ffn_gate_phase(const bf16* GU, bf16* A, const float* fconv, int hf, int gtid, int gthreads) {
    for (int it = gtid; it < 256 * 176; it += gthreads) { const int rb = it / 176, cgp = it % 176, pnl = cgp >> 4, cc = (cgp & 15) * 8, ch = 1408 * hf + 128 * pnl + cc;
        float wg[3][8], wu[3][8];
#pragma unroll
        for (int i = 0; i < 3; ++i) { const f32x4 a0 = *(const __attribute__((address_space(1))) f32x4*)(fconv + (size_t)i * NUP + ch), a1 = *(const __attribute__((address_space(1))) f32x4*)(fconv + (size_t)i * NUP + ch + 4), b0 = *(const __attribute__((address_space(1))) f32x4*)(fconv + (size_t)i * NUP + DFF + ch), b1 = *(const __attribute__((address_space(1))) f32x4*)(fconv + (size_t)i * NUP + DFF + ch + 4);
#pragma unroll
            for (int e = 0; e < 4; ++e) { wg[i][e] = a0[e]; wg[i][4 + e] = a1[e]; wu[i][e] = b0[e]; wu[i][4 + e] = b1[e]; } }
        float g2[8], g1[8], u2[8], u1[8];
#pragma unroll
        for (int e = 0; e < 8; ++e) { g2[e] = g1[e] = u2[e] = u1[e] = 0.f; }
        for (int r = -2; r < 64; ++r) { const int t = 64 * rb + r; float g0[8], u0[8];
            if (t >= 0) { const v4u gv = *(const __attribute__((address_space(1))) v4u*)(GU + (size_t)t * NIN + 256 * pnl + cc), uv = *(const __attribute__((address_space(1))) v4u*)(GU + (size_t)t * NIN + 256 * pnl + 128 + cc);
                g0[0] = bflo(gv.x); g0[1] = bfhi(gv.x); g0[2] = bflo(gv.y); g0[3] = bfhi(gv.y); g0[4] = bflo(gv.z); g0[5] = bfhi(gv.z); g0[6] = bflo(gv.w); g0[7] = bfhi(gv.w);
                u0[0] = bflo(uv.x); u0[1] = bfhi(uv.x); u0[2] = bflo(uv.y); u0[3] = bfhi(uv.y); u0[4] = bflo(uv.z); u0[5] = bfhi(uv.z); u0[6] = bflo(uv.w); u0[7] = bfhi(uv.w); }
            else {
#pragma unroll
                for (int e = 0; e < 8; ++e) { g0[e] = 0.f; u0[e] = 0.f; } }
            if (r >= 0) { float o[8];
#pragma unroll
                for (int e = 0; e < 8; ++e) { const float G = wg[0][e] * g2[e] + wg[1][e] * g1[e] + wg[2][e] * g0[e], U = wu[0][e] * u2[e] + wu[1][e] * u1[e] + wu[2][e] * u0[e];
                    o[e] = G * __builtin_amdgcn_rcpf(1.0f + __expf(-G)) * U; }
                v4u ov; ov.x = pk2(o[0], o[1]); ov.y = pk2(o[2], o[3]); ov.z = pk2(o[4], o[5]); ov.w = pk2(o[6], o[7]);
                *(__attribute__((address_space(1))) v4u*)(A + (size_t)t * DFF + ch) = ov; }
#pragma unroll
            for (int e = 0; e < 8; ++e) { g2[e] = g1[e]; g1[e] = g0[e]; u2[e] = u1[e]; u1[e] = u0[e]; } }
    }
}
__global__ void __launch_bounds__(NTHR, 2) hybrid_fwd(Args args) {
    extern __shared__ __attribute__((aligned(16))) unsigned char lds_raw[];
    LAS unsigned char* lds = (LAS unsigned char*)lds_raw;
    cg::grid_group grid = cg::this_grid();
    volatile LAS unsigned* MISC = (volatile LAS unsigned*)(lds + LDS_BYTES - 64);
    volatile LAS unsigned* PT = (volatile LAS unsigned*)(lds + LDS_BYTES - 256);
    if (threadIdx.x < 16) MISC[threadIdx.x] = 0u;
    if (threadIdx.x == 0) {
#define PUTP(k) { const unsigned long long v_ = (unsigned long long)args.in[k]; PT[2 * (k)] = (unsigned)v_; PT[2 * (k) + 1] = (unsigned)(v_ >> 32); }
        PUTP(0) PUTP(1) PUTP(2) PUTP(3) PUTP(4) PUTP(5) PUTP(6) PUTP(7) PUTP(8) PUTP(9) PUTP(10) PUTP(11) PUTP(12) PUTP(13)
#undef PUTP
    }
    __syncthreads();
    XcdBarrier xbar = xcd_barrier_post((unsigned*)args.ws, MISC);
    const int tid = threadIdx.x, lane = tid & 63, wave = __builtin_amdgcn_readfirstlane(tid >> 6);
    const int G = gridDim.x, bx = blockIdx.x;
    const int gw = bx * NWAVES + wave, NGW = G * NWAVES;
    unsigned char* ws = args.ws;
#define INP(k) ldptr(PT, (k))
#define MAKE_CS() const CvtSrc cs{INP(2), INP(8), INP(10), INP(12), INP(1), INP(7), INP(9), Win_t, Wout_t, Wup_t, Wdn_t}
    float* xo = args.out;
#define PHASE_PTRS() unsigned char* w_ = ws; float* xcur = xo; asm volatile("" : "+s"(w_), "+s"(xcur)); \
    w_ = (unsigned char*)(__attribute__((address_space(1))) unsigned char*)w_; xcur = (float*)(__attribute__((address_space(1))) float*)xcur;     \
    bf16* Win_t = (bf16*)(w_ + WS_WIN); bf16* Wout_t = (bf16*)(w_ + WS_WOUT); bf16* Wup_t = (bf16*)(w_ + WS_WUP); bf16* Wdn_t = (bf16*)(w_ + WS_WDN); \
    float* part = (float*)(w_ + WS_PART); bf16* XB = (bf16*)(w_ + WS_XB); bf16* P = (bf16*)(w_ + WS_P); bf16* Y = (bf16*)(w_ + WS_Y); bf16* A = (bf16*)(w_ + WS_A); \
    (void)Win_t; (void)Wout_t; (void)Wup_t; (void)Wdn_t; (void)part; (void)XB; (void)P; (void)Y; (void)A; (void)xcur

    for (int step = -1; step < 5 * DEPTH; ++step) {
        const int l = step < 0 ? 0 : step / 5, ph = step < 0 ? -1 : step % 5;
        int cvt_layer = -1, cvt_first = 0, cvt_n = 0, cvt_nu = 0;
        if (ph < 0) {
            PHASE_PTRS(); const float* x_in = INP(0);
            int gw_ = gw, lane_ = lane; asm volatile("" : "+s"(gw_), "+v"(lane_));
            for (int m = gw_; m < S; m += NGW) { const __attribute__((address_space(1))) f32x4* xr = (const __attribute__((address_space(1))) f32x4*)(x_in + (size_t)m * DM) + lane_; f32x4 v[4]; float ss = 0.f;
#pragma unroll
                for (int j = 0; j < 4; ++j) { v[j] = xr[64 * j]; ss += (v[j][0] * v[j][0] + v[j][1] * v[j][1]) + (v[j][2] * v[j][2] + v[j][3] * v[j][3]); }
                ss = wave_sum(ss);
                __attribute__((address_space(1))) v2u* o8 = (__attribute__((address_space(1))) v2u*)(XB + (size_t)m * DM) + lane_;
#pragma unroll
                for (int j = 0; j < 4; ++j) { v2u o; o.x = pk2(v[j][0], v[j][1]); o.y = pk2(v[j][2], v[j][3]); o8[64 * j] = o; }
                if (lane_ < 16) ((__attribute__((address_space(1))) float*)part)[(size_t)m * 16 + lane_] = lane_ == 0 ? ss : 0.f; }
            cvt_layer = 0; cvt_first = 0; cvt_n = 6144; cvt_nu = 0;
        } else if (ph == 0) {
            PHASE_PTRS(); pg8::Gemm g{XB, Win_t + (size_t)l * NIN * DM, S, NIN, DM, 256}; pg8::StaticOrder So; So.init(S, NIN, G, bx);
            pg8::EpiScaleBf16 E{P, NIN, part, (LAS float*)(lds + 131072 + 8192)};
            pg8::gemm_phase<pg8::EpiScaleBf16, pg8::StaticOrder, true, true>(lds, g, So, E);
            if (l + 1 < DEPTH) { cvt_layer = l + 1; cvt_first = 0; cvt_n = 1920; cvt_nu = (S / 256) * (NIN / 256); }
        } else if (ph == 1) {
            PHASE_PTRS();
            for (int u = bx; u < S / 64; u += G)
                mixer_unit(lds, u, P, Y, INP(3) + l * 3 * 256, INP(4) + l * 256, INP(5) + (size_t)l * 4 * 128 * 128, INP(6) + l * 4 * 128, tid, wave, lane);
        } else if (ph == 2) {
            PHASE_PTRS(); pg8::Gemm g{Y, Wout_t + (size_t)l * DM * DM, S, DM, DM, 256}; pg8::StaticOrder So; So.init(S, DM, G, bx);
            pg8::EpiResid E{XB, part};
            pg8::gemm_phase<pg8::EpiResid, pg8::StaticOrder, true, true>(lds, g, So, E);
        } else if (ph == 3) {
            PHASE_PTRS(); pg8::Gemm g{XB - 2 * DM, Wup_t + (size_t)l * NUP * DM, 65 * 256, NUP, DM, 254}; pg8::StaticOrder So; So.init(65 * 256, NUP, G, bx);
            pg8::EpiGate E{A, part, INP(11) + (size_t)l * 3 * NUP, (LAS float*)(lds + 131072)};
            pg8::gemm_phase<pg8::EpiGate, pg8::StaticOrder, true, true>(lds, g, So, E);
            if (l + 1 < DEPTH) { cvt_layer = l + 1; cvt_first = 1920; cvt_n = 4224; cvt_nu = 65 * (NUP / 256); }
        } else {
            PHASE_PTRS(); pg8::Gemm g{A, Wdn_t + (size_t)l * DM * DFF, S, DM, DFF, 256}; pg8::StaticOrder So; So.init(S, DM, G, bx);
            pg8::EpiResid E{XB, part};
            pg8::gemm_phase<pg8::EpiResid, pg8::StaticOrder, true, true>(lds, g, So, E);
        }
        if (cvt_layer >= 0) {
            const int first_idle = cvt_nu > 0 ? cvt_nu - ((cvt_nu + G - 1) / G - 1) * G : 0; const bool some_idle = first_idle < G;
            if (!some_idle || bx >= first_idle) { const int nw = (some_idle ? G - first_idle : G) * NWAVES, iw = (some_idle ? bx - first_idle : bx) * NWAVES + wave;
                PHASE_PTRS(); LAS float* scr = (LAS float*)(lds + wave * 16384); int lane_ = lane; asm volatile("" : "+v"(lane_));
                MAKE_CS(); for (int it = iw; it < cvt_n; it += nw) cvt_layer_item(cs, cvt_layer, cvt_first + it, scr, lane_); } }
        if (step < 0) grid.sync(); else xcd_barrier(xbar);
    }
    { const float* nfin = INP(13); const bf16* XBf = (const bf16*)(ws + WS_XB);
      for (int m = gw; m < S; m += NGW) { const __attribute__((address_space(1))) v2u* xr = (const __attribute__((address_space(1))) v2u*)(XBf + (size_t)m * DM) + lane; f32x4 v[4]; float ss = 0.f;
#pragma unroll
        for (int j = 0; j < 4; ++j) { const v2u u = xr[64 * j]; v[j] = (f32x4){bflo(u.x), bfhi(u.x), bflo(u.y), bfhi(u.y)}; ss += (v[j][0] * v[j][0] + v[j][1] * v[j][1]) + (v[j][2] * v[j][2] + v[j][3] * v[j][3]); }
        const float rs = __builtin_amdgcn_rsqf(wave_sum(ss) * (1.0f / 1024.0f) + EPS);
        __attribute__((address_space(1))) f32x4* orow = (__attribute__((address_space(1))) f32x4*)(xo + (size_t)m * DM) + lane;
#pragma unroll
        for (int j = 0; j < 4; ++j) { const f32x4 g = *((const __attribute__((address_space(1))) f32x4*)nfin + lane + 64 * j); orow[64 * j] = v[j] * rs * g; } } }
}

extern "C" void kernel_launch(void* const* d_in, const int* in_sizes, int n_in, void* d_out, int out_size, void* d_ws, size_t ws_size, hipStream_t stream) {
    static int grid = 0;
    if (grid == 0) {
        if (n_in != 14 || out_size != S * DM || ws_size < WS_END) { fprintf(stderr, "kernel_launch: unexpected shapes / workspace (%d inputs, out %d, ws %zu)\n", n_in, out_size, ws_size); grid = -1; return; }
        int dev = 0, cus = 0, per_cu = 0;
        hipGetDevice(&dev); hipDeviceGetAttribute(&cus, hipDeviceAttributeMultiprocessorCount, dev);
        hipFuncSetAttribute((const void*)hybrid_fwd, hipFuncAttributeMaxDynamicSharedMemorySize, LDS_BYTES);
        hipOccupancyMaxActiveBlocksPerMultiprocessor(&per_cu, (const void*)hybrid_fwd, NTHR, LDS_BYTES);
        (void)hipGetLastError();
        if (per_cu < 1) per_cu = 1;
        grid = cus * 1;
    }
    if (grid < 0) return;
    hipMemsetAsync((unsigned char*)d_ws, 0, 16384, stream);
    hipMemsetAsync((unsigned char*)d_ws + WS_XB - 4096, 0, 4096, stream);
    Args a{};
    for (int i = 0; i < 14; ++i) a.in[i] = (const float*)d_in[i];
    a.out = (float*)d_out; a.ws = (unsigned char*)d_ws;
    void* kargs[] = {&a};
    hipError_t e = hipLaunchCooperativeKernel((const void*)hybrid_fwd, dim3(grid), dim3(NTHR), kargs, LDS_BYTES, stream);
    if (e != hipSuccess) fprintf(stderr, "cooperative launch failed: %s (grid %d)\n", hipGetErrorString(e), grid);
}
```

```cpp
#include <hip/hip_runtime.h>
#include <hip/hip_cooperative_groups.h>
#include <cstdio>
#include <cstdint>
namespace cg = cooperative_groups;
namespace pg8 {
#define PG8_LAS __attribute__((address_space(3)))
typedef unsigned short bf16_t;
typedef short bf16x8 __attribute__((ext_vector_type(8)));
typedef float f32x4 __attribute__((ext_vector_type(4)));
typedef unsigned u32x4 __attribute__((ext_vector_type(4)));
typedef unsigned u32x2 __attribute__((ext_vector_type(2)));
constexpr int BM = 256, BK = 64, HALF = 128, HTB = HALF * BK * 2  , STAGE_BYTES = 8 * HTB, NXCD = 8, WGM = 8;

__host__ __device__ __forceinline__ int lds_byte(int r, int c) { const int st = (r >> 4) * 2 + (c >> 5), rr = r & 15, cc = c & 31, ob = rr * 64 + cc * 2; return st * 1024 + (ob ^ (((ob >> 9) & 1) << 5)); }
__host__ __device__ __forceinline__ void stage_rc(int b, int& R, int& C) { const int st = b / 1024, sb = b % 1024, swz = sb ^ (((sb >> 9) & 1) << 5); R = (st >> 1) * 16 + swz / 64; C = (st & 1) * 32 + (swz % 64) / 2; }
__host__ __device__ __forceinline__ int perm32(int rho) { const int n = rho >> 4, i = rho & 15; return 8 * (i >> 2) + 4 * n + (i & 3); }

struct Unit { int pm, pn; };
struct Gemm { const bf16_t* A; const bf16_t* Bt; int M, N, K; int arows; };

struct StaticOrder {
    int nM, nN, nwg, G, c;
    __host__ __device__ void init(int M, int N, int G_, int c_) { nM = M / BM; nN = N / BM; nwg = nM * nN; G = G_; c = c_; }
    __host__ __device__ bool next(int i, Unit& u) const {
        const long L = (long)i * G + c; if (L >= nwg) return false;
        int wgid = (int)L; { const int q = nwg / NXCD, r = nwg % NXCD, xcd = wgid % NXCD, off = wgid / NXCD; wgid = (xcd < r ? xcd * (q + 1) : r * (q + 1) + (xcd - r) * q) + off; }
        const int nig = WGM * nN, gid = wgid / nig, fm = gid * WGM, gsz = (nM - fm) < WGM ? (nM - fm) : WGM;
        u.pm = fm + ((wgid % nig) % gsz); u.pn = (wgid % nig) / gsz; return true;
    }
    __device__ __forceinline__ void a_ready(const Unit&) const {}
    __device__ __forceinline__ void done(const Unit&) const {}
};

__device__ __forceinline__ unsigned cvt_pk_bf16(float lo, float hi) { unsigned r; asm volatile("v_cvt_pk_bf16_f32 %0, %1, %2" : "=v"(r) : "v"(lo), "v"(hi)); return r; }
struct EpiScaleBf16 {
    static constexpr bool PERM = true, AFTER_DRAIN = false, PERMA = false;
    bf16_t* O; int ldc; const float* part; PG8_LAS float* rsl;
    __device__ __forceinline__ void operator()(const f32x4 (&acc)[2][2][4][2], const Unit& u, int wr, int wc, int fr, int fq) const {
        { const int t = (wr * 4 + wc) * 64 + fq * 16 + fr;
          if (t < 256) { const __attribute__((address_space(1))) f32x4* pp = (const __attribute__((address_space(1))) f32x4*)(part + (size_t)(u.pm * BM + t) * 16); const f32x4 a = pp[0], b = pp[1], c = pp[2], d = pp[3];
              const f32x4 s4 = (a + b) + (c + d); const float ss = (s4[0] + s4[1]) + (s4[2] + s4[3]); rsl[t] = __builtin_amdgcn_rsqf(ss * (1.0f / 1024.0f) + 1e-6f); } }
        asm volatile("s_waitcnt lgkmcnt(0)" ::: "memory"); __builtin_amdgcn_s_barrier(); asm volatile("" ::: "memory");
        const int row0 = u.pm * BM + wr * 64 + fr; const int col0 = u.pn * BM + wc * 32 + 8 * fq;
#pragma unroll
        for (int ai = 0; ai < 2; ++ai)
#pragma unroll
            for (int m = 0; m < 4; ++m) { const int row = row0 + ai * HALF + m * 16;
                const float rs = rsl[ai * HALF + wr * 64 + m * 16 + fr];
                bf16_t* rowp = O + (size_t)row * ldc + col0;
#pragma unroll
                for (int bj = 0; bj < 2; ++bj) { const f32x4 v0 = acc[ai][bj][m][0] * rs, v1 = acc[ai][bj][m][1] * rs;
                    u32x4 w; w.x = cvt_pk_bf16(v0[0], v0[1]); w.y = cvt_pk_bf16(v0[2], v0[3]); w.z = cvt_pk_bf16(v1[0], v1[1]); w.w = cvt_pk_bf16(v1[2], v1[3]);
                    *(__attribute__((address_space(1))) u32x4*)(rowp + bj * HALF) = w; } }
    }
};
struct EpiResid {
    static constexpr bool PERM = true, AFTER_DRAIN = false, PERMA = false;
    bf16_t* xb; float* part;
    __device__ __forceinline__ void operator()(const f32x4 (&acc)[2][2][4][2], const Unit& u, int wr, int wc, int fr, int fq) const {
        const int row0 = u.pm * BM + wr * 64 + fr; const int col0 = u.pn * BM + wc * 32 + 8 * fq;
        u32x4 pre[3][2];
#define PG8_RLOAD(g_) do { const size_t o_ = (size_t)(row0 + ((g_) >> 2) * HALF + ((g_) & 3) * 16) * 1024 + col0; \
            pre[(g_) % 3][0] = *(const __attribute__((address_space(1))) u32x4*)(xb + o_); pre[(g_) % 3][1] = *(const __attribute__((address_space(1))) u32x4*)(xb + o_ + HALF); } while (0)
        PG8_RLOAD(0); PG8_RLOAD(1);
#pragma unroll
        for (int g = 0; g < 8; ++g) { const int ai = g >> 2, m = g & 3;
            if (g + 2 < 8) PG8_RLOAD(g + 2);
            asm volatile("" ::: "memory");
            const int row = row0 + ai * HALF + m * 16; const size_t off = (size_t)row * 1024 + col0; float ss = 0.f;
#pragma unroll
            for (int bj = 0; bj < 2; ++bj) { const u32x4 b = pre[g % 3][bj];
                const f32x4 b0 = {__uint_as_float(b.x << 16), __uint_as_float(b.x & 0xffff0000u), __uint_as_float(b.y << 16), __uint_as_float(b.y & 0xffff0000u)};
                const f32x4 b1 = {__uint_as_float(b.z << 16), __uint_as_float(b.z & 0xffff0000u), __uint_as_float(b.w << 16), __uint_as_float(b.w & 0xffff0000u)};
                const f32x4 v0 = acc[ai][bj][m][0] + b0, v1 = acc[ai][bj][m][1] + b1;
                ss += (v0[0] * v0[0] + v0[1] * v0[1]) + (v0[2] * v0[2] + v0[3] * v0[3]) + (v1[0] * v1[0] + v1[1] * v1[1]) + (v1[2] * v1[2] + v1[3] * v1[3]);
                u32x4 w; w.x = cvt_pk_bf16(v0[0], v0[1]); w.y = cvt_pk_bf16(v0[2], v0[3]); w.z = cvt_pk_bf16(v1[0], v1[1]); w.w = cvt_pk_bf16(v1[2], v1[3]);
                *(__attribute__((address_space(1))) u32x4*)(xb + off + bj * HALF) = w; }
            ss += __shfl_xor(ss, 16); ss += __shfl_xor(ss, 32);
            if (fq == 0) ((__attribute__((address_space(1))) float*)part)[(size_t)row * 16 + u.pn * 4 + wc] = ss;
            asm volatile("" ::: "memory"); }
#undef PG8_RLOAD
    }
};
#define PG8_DPP(oldv, srcv, ctrl) __builtin_bit_cast(float, __builtin_amdgcn_update_dpp(__builtin_bit_cast(int, (float)(oldv)), __builtin_bit_cast(int, (float)(srcv)), (ctrl), 0xf, 0xf, false))
struct EpiGate {
    static constexpr bool PERM = true, AFTER_DRAIN = false, PERMA = true;
    bf16_t* Aout; const float* part; const float* fconv; PG8_LAS float* xch;
    __device__ __forceinline__ void operator()(f32x4 (&acc)[2][2][4][2], const Unit& u, int wr, int wc, int fr, int fq) const {
        PG8_LAS float* rsl = xch + 2048;
        { const int t = (wr * 4 + wc) * 64 + fq * 16 + fr;
          if (t < 256) { const int row = u.pm * 254 - 2 + t; const bool ok = row >= 0 && row < 16384; const int rc = ok ? row : 0;
              const __attribute__((address_space(1))) f32x4* pp = (const __attribute__((address_space(1))) f32x4*)(part + (size_t)rc * 16); const f32x4 a = pp[0], b = pp[1], c = pp[2], d = pp[3];
              const f32x4 s4 = (a + b) + (c + d); const float ss = (s4[0] + s4[1]) + (s4[2] + s4[3]);
              rsl[t] = ok ? __builtin_amdgcn_rsqf(ss * (1.0f / 1024.0f) + 1e-6f) : 0.f; } }
        asm volatile("s_waitcnt lgkmcnt(0)" ::: "memory"); __builtin_amdgcn_s_barrier(); asm volatile("" ::: "memory");
        const int ccol = wc * 32 + 8 * fq;
#pragma unroll
        for (int ai = 0; ai < 2; ++ai) { const f32x4 rs4 = *(const PG8_LAS f32x4*)(rsl + ai * HALF + wr * 64 + 4 * fr);
#pragma unroll
            for (int m = 0; m < 4; ++m)
#pragma unroll
                for (int bj = 0; bj < 2; ++bj) { acc[ai][bj][m][0] *= rs4[m]; acc[ai][bj][m][1] *= rs4[m]; } }
        if (fr == 15) {
#pragma unroll
            for (int ai = 0; ai < 2; ++ai)
#pragma unroll
                for (int bj = 0; bj < 2; ++bj)
#pragma unroll
                    for (int n = 0; n < 2; ++n) { *(PG8_LAS f32x4*)(xch + ((2 * ai + wr) * 2 + 0) * 256 + bj * HALF + ccol + 4 * n) = acc[ai][bj][2][n]; *(PG8_LAS f32x4*)(xch + ((2 * ai + wr) * 2 + 1) * 256 + bj * HALF + ccol + 4 * n) = acc[ai][bj][3][n]; }
        }
        asm volatile("s_waitcnt lgkmcnt(0)" ::: "memory"); __builtin_amdgcn_s_barrier(); asm volatile("" ::: "memory");
        const int ch0 = u.pn * HALF + ccol;
#pragma unroll
        for (int ai = 0; ai < 2; ++ai) {
            const int grp = 2 * ai + wr;
            u32x2 keep[4];
#pragma unroll
            for (int n = 0; n < 2; ++n) {
                asm volatile("" ::: "memory");
                const float* fw = fconv + ch0 + 4 * n;
                const f32x4 wg0 = *(const __attribute__((address_space(1))) f32x4*)(fw), wg1 = *(const __attribute__((address_space(1))) f32x4*)(fw + 5632), wg2 = *(const __attribute__((address_space(1))) f32x4*)(fw + 2 * 5632);
                const f32x4 wu0 = *(const __attribute__((address_space(1))) f32x4*)(fw + 2816), wu1 = *(const __attribute__((address_space(1))) f32x4*)(fw + 5632 + 2816), wu2 = *(const __attribute__((address_space(1))) f32x4*)(fw + 2 * 5632 + 2816);
                f32x4 g62 = {0.f, 0.f, 0.f, 0.f}, g63 = g62, u62 = g62, u63 = g62;
                if (grp > 0) { const PG8_LAS float* xb_ = xch + ((grp - 1) * 2) * 256 + ccol + 4 * n;
                    g62 = *(const PG8_LAS f32x4*)(xb_); g63 = *(const PG8_LAS f32x4*)(xb_ + 256); u62 = *(const PG8_LAS f32x4*)(xb_ + HALF); u63 = *(const PG8_LAS f32x4*)(xb_ + 256 + HALF); }
                float o[4][4];
#pragma unroll
                for (int j = 0; j < 4; ++j) {
                    const float g0 = acc[ai][0][0][n][j], g1 = acc[ai][0][1][n][j], g2 = acc[ai][0][2][n][j], g3 = acc[ai][0][3][n][j];
                    const float u0 = acc[ai][1][0][n][j], u1 = acc[ai][1][1][n][j], u2 = acc[ai][1][2][n][j], u3 = acc[ai][1][3][n][j];
                    const float gm1 = PG8_DPP(g63[j], g3, 0x111), gm2 = PG8_DPP(g62[j], g2, 0x111);
                    const float um1 = PG8_DPP(u63[j], u3, 0x111), um2 = PG8_DPP(u62[j], u2, 0x111);
                    const float G0 = wg0[j] * gm2 + wg1[j] * gm1 + wg2[j] * g0, G1 = wg0[j] * gm1 + wg1[j] * g0 + wg2[j] * g1, G2 = wg0[j] * g0 + wg1[j] * g1 + wg2[j] * g2, G3 = wg0[j] * g1 + wg1[j] * g2 + wg2[j] * g3;
                    const float U0 = wu0[j] * um2 + wu1[j] * um1 + wu2[j] * u0, U1 = wu0[j] * um1 + wu1[j] * u0 + wu2[j] * u1, U2 = wu0[j] * u0 + wu1[j] * u1 + wu2[j] * u2, U3 = wu0[j] * u1 + wu1[j] * u2 + wu2[j] * u3;
                    o[0][j] = G0 * __builtin_amdgcn_rcpf(1.0f + __expf(-G0)) * U0; o[1][j] = G1 * __builtin_amdgcn_rcpf(1.0f + __expf(-G1)) * U1;
                    o[2][j] = G2 * __builtin_amdgcn_rcpf(1.0f + __expf(-G2)) * U2; o[3][j] = G3 * __builtin_amdgcn_rcpf(1.0f + __expf(-G3)) * U3; }
#pragma unroll
                for (int m = 0; m < 4; ++m) { const int r = ai * HALF + wr * 64 + 4 * fr + m, row = u.pm * 254 - 2 + r;
                    u32x2 w; w.x = cvt_pk_bf16(o[m][0], o[m][1]); w.y = cvt_pk_bf16(o[m][2], o[m][3]);
                    if (n == 0) keep[m] = w;
                    else if (r >= 2 && row < 16384) { u32x4 w4; w4.x = keep[m].x; w4.y = keep[m].y; w4.z = w.x; w4.w = w.y; *(__attribute__((address_space(1))) u32x4*)(Aout + (size_t)row * 2816 + ch0) = w4; } }
            }
        }
    }
};
template <class Epi, class Sched, bool ALIGN_EPI = false, bool SP2 = false>
__device__ __forceinline__ void gemm_phase(PG8_LAS unsigned char* lds, const Gemm g, const Sched& S, const Epi& E) {
    int tid = threadIdx.x; asm volatile("" : "+v"(tid));
    const int wid = __builtin_amdgcn_readfirstlane(tid >> 6), lane = tid & 63, wr = wid >> 2, wc = wid & 3, fr = lane & 15, fq = lane >> 4;
    const int K = g.K, nt = K / BK;
    unsigned voffA[2], voffB[2];
#pragma unroll
    for (int i = 0; i < 2; ++i) { int R, C; stage_rc(tid * 16 + i * 8192, R, C); const int Rb = Epi::PERM ? ((R & ~31) + perm32(R & 31)) : R;
        const int Ra = Epi::PERMA ? ((R & ~63) + 4 * (R & 15) + ((R >> 4) & 3)) : R;
        voffA[i] = (unsigned)(Ra * K + C) * 2u; voffB[i] = (unsigned)(Rb * K + C) * 2u; }
    const size_t kstep = (size_t)(BK * 2);
    const size_t hstep = (size_t)HALF * K * 2;
    const size_t tstep = 2 * hstep;
    const size_t tstepA = (size_t)g.arows * K * 2;
    const unsigned ldsw = (unsigned)wid * 1024u;
    const int aoff = lds_byte(wr * 64 + fr, fq * 8), boff = lds_byte(wc * 32 + fr, fq * 8);
#define PG8_SA(b, h) (((b) * 2 + (h)) * HTB)
#define PG8_SB(b, h) ((4 + (b) * 2 + (h)) * HTB)
#define PG8_STAGE(bufoff, gbase, voff) do { _Pragma("unroll") for (int _i = 0; _i < 2; ++_i) \
        __builtin_amdgcn_global_load_lds((const unsigned*)((const char*)(gbase) + (voff)[_i]), (PG8_LAS unsigned*)(lds + (bufoff) + ldsw + _i * 8192), 16, 0, 0); } while (0)
#define PG8_LDA(dst, b, h) do { _Pragma("unroll") for (int m = 0; m < 4; ++m) _Pragma("unroll") for (int k = 0; k < 2; ++k) dst[m][k] = *(const PG8_LAS bf16x8*)(lds + PG8_SA(b, h) + aoff + m * 2048 + k * 1024); } while (0)
#define PG8_LDB(dst, b, h) do { _Pragma("unroll") for (int n = 0; n < 2; ++n) _Pragma("unroll") for (int k = 0; k < 2; ++k) dst[n][k] = *(const PG8_LAS bf16x8*)(lds + PG8_SB(b, h) + boff + n * 2048 + k * 1024); } while (0)
#define PG8_MMA(ai, bj, At, Bt) do { __builtin_amdgcn_s_setprio(1); _Pragma("unroll") for (int m = 0; m < 4; ++m) _Pragma("unroll") for (int n = 0; n < 2; ++n) _Pragma("unroll") for (int k = 0; k < 2; ++k) \
        acc[ai][bj][m][n] = __builtin_amdgcn_mfma_f32_16x16x32_bf16(Bt[n][k], At[m][k], acc[ai][bj][m][n], 0, 0, 0); __builtin_amdgcn_s_setprio(0); } while (0)
#define PG8_WAIT_V(n) asm volatile("s_waitcnt vmcnt(" #n ")" ::: "memory")
#define PG8_WAIT_L(n) asm volatile("s_waitcnt lgkmcnt(" #n ")" ::: "memory")
#define PG8_BAR __builtin_amdgcn_s_barrier()
#define PG8_SCHED __builtin_amdgcn_sched_barrier(0)
    Unit cur, nxt; int ui = 0;
    if (!S.next(0, cur)) return;
    f32x4 acc[2][2][4][2];
#pragma unroll
    for (int a = 0; a < 2; ++a)
#pragma unroll
        for (int b = 0; b < 2; ++b)
#pragma unroll
            for (int m = 0; m < 4; ++m)
#pragma unroll
                for (int n = 0; n < 2; ++n) acc[a][b][m][n] = (f32x4){0.f, 0.f, 0.f, 0.f};
    bf16x8 At[4][2], B0[2][2], B1[2][2];
    const char* cA = (const char*)g.A + (size_t)cur.pm * tstepA; const char* cB = (const char*)g.Bt + (size_t)cur.pn * tstep;
    S.a_ready(cur);
    if constexpr (SP2) {
        PG8_STAGE(PG8_SB(0, 0), cB, voffB); PG8_STAGE(PG8_SB(0, 1), cB + hstep, voffB); PG8_STAGE(PG8_SA(0, 0), cA, voffA); PG8_STAGE(PG8_SA(0, 1), cA + hstep, voffA);
        if (wr == 1) PG8_BAR;
        PG8_WAIT_V(2); PG8_BAR;
        PG8_STAGE(PG8_SB(1, 0), cB + kstep, voffB); PG8_STAGE(PG8_SA(1, 0), cA + kstep, voffA); PG8_STAGE(PG8_SB(1, 1), cB + hstep + kstep, voffB);
        PG8_WAIT_V(6); PG8_BAR;
    } else {
        PG8_STAGE(PG8_SB(0, 0), cB, voffB); PG8_STAGE(PG8_SA(0, 0), cA, voffA); PG8_STAGE(PG8_SB(0, 1), cB + hstep, voffB); PG8_STAGE(PG8_SA(0, 1), cA + hstep, voffA);
        if (wr == 1) PG8_BAR;
        PG8_WAIT_V(4); PG8_BAR;
        PG8_STAGE(PG8_SB(1, 0), cB + kstep, voffB); PG8_STAGE(PG8_SA(1, 0), cA + kstep, voffA); PG8_STAGE(PG8_SB(1, 1), cB + hstep + kstep, voffB);
        PG8_WAIT_V(6); PG8_BAR;
    }
    for (;;) {
        const bool has_next = S.next(ui + 1, nxt);
        const char* nA = has_next ? (const char*)g.A + (size_t)nxt.pm * tstepA : cA; const char* nB = has_next ? (const char*)g.Bt + (size_t)nxt.pn * tstep : cB;
        for (int t = 0; t < nt; t += 2) {
            const bool last = (t == nt - 2);
            const char* a1 = cA + (size_t)(t + 1) * kstep;
            const char* a2 = last ? nA : cA + (size_t)(t + 2) * kstep; const char* b2 = last ? nB : cB + (size_t)(t + 2) * kstep;
            const char* a3 = a2 + kstep; const char* b3 = b2 + kstep;
            if (last && has_next) S.a_ready(nxt);
            if constexpr (SP2) {
            PG8_LDB(B0, 0, 0); PG8_LDB(B1, 0, 1); PG8_SCHED; PG8_LDA(At, 0, 0); PG8_STAGE(PG8_SA(1, 1), a1 + hstep, voffA);
            PG8_WAIT_V(8); PG8_WAIT_L(0); PG8_BAR; PG8_MMA(0, 0, At, B0); PG8_MMA(0, 1, At, B1); PG8_BAR; PG8_SCHED;
            PG8_LDA(At, 0, 1); PG8_STAGE(PG8_SB(0, 0), b2, voffB); PG8_STAGE(PG8_SB(0, 1), b2 + hstep, voffB); PG8_STAGE(PG8_SA(0, 0), a2, voffA);
            PG8_WAIT_V(8); PG8_WAIT_L(0); PG8_BAR; PG8_MMA(1, 0, At, B0); PG8_MMA(1, 1, At, B1); PG8_BAR; PG8_SCHED;
            PG8_LDB(B0, 1, 0); PG8_LDB(B1, 1, 1); PG8_SCHED; PG8_LDA(At, 1, 0); PG8_STAGE(PG8_SA(0, 1), a2 + hstep, voffA);
            PG8_WAIT_V(8); PG8_WAIT_L(0); PG8_BAR; PG8_MMA(0, 0, At, B0); PG8_MMA(0, 1, At, B1); PG8_BAR; PG8_SCHED;
            PG8_LDA(At, 1, 1); PG8_STAGE(PG8_SB(1, 0), b3, voffB); PG8_STAGE(PG8_SB(1, 1), b3 + hstep, voffB); PG8_STAGE(PG8_SA(1, 0), a3, voffA);
            PG8_WAIT_V(8); PG8_WAIT_L(0); PG8_BAR; PG8_MMA(1, 0, At, B0); PG8_MMA(1, 1, At, B1); PG8_BAR; PG8_SCHED;
            } else {
            PG8_LDB(B0, 0, 0); PG8_SCHED; PG8_LDA(At, 0, 0); PG8_STAGE(PG8_SA(1, 1), a1 + hstep, voffA);
            PG8_WAIT_L(8); PG8_BAR; PG8_WAIT_L(0); PG8_MMA(0, 0, At, B0); PG8_BAR; PG8_SCHED;
            PG8_LDB(B1, 0, 1); PG8_STAGE(PG8_SB(0, 0), b2, voffB);
            PG8_BAR; PG8_WAIT_L(0); PG8_MMA(0, 1, At, B1); PG8_BAR;
            PG8_LDA(At, 0, 1); PG8_STAGE(PG8_SA(0, 0), a2, voffA);
            PG8_BAR; PG8_WAIT_L(0); PG8_MMA(1, 0, At, B0); PG8_BAR; PG8_SCHED;
            PG8_STAGE(PG8_SB(0, 1), b2 + hstep, voffB);
            PG8_WAIT_V(6); PG8_BAR; PG8_MMA(1, 1, At, B1); PG8_BAR;
            PG8_LDB(B0, 1, 0); PG8_SCHED; PG8_LDA(At, 1, 0); PG8_STAGE(PG8_SA(0, 1), a2 + hstep, voffA);
            PG8_WAIT_L(8); PG8_BAR; PG8_WAIT_L(0); PG8_MMA(0, 0, At, B0); PG8_BAR; PG8_SCHED;
            PG8_LDB(B1, 1, 1); PG8_STAGE(PG8_SB(1, 0), b3, voffB);
            PG8_BAR; PG8_WAIT_L(0); PG8_MMA(0, 1, At, B1); PG8_BAR;
            PG8_LDA(At, 1, 1); PG8_STAGE(PG8_SA(1, 0), a3, voffA);
            PG8_BAR; PG8_WAIT_L(0); PG8_MMA(1, 0, At, B0); PG8_BAR; PG8_SCHED;
            PG8_STAGE(PG8_SB(1, 1), b3 + hstep, voffB);
            PG8_WAIT_V(6); PG8_BAR; PG8_MMA(1, 1, At, B1); PG8_BAR;
            }
        }
        if constexpr (ALIGN_EPI) { if (wr == 0) PG8_BAR; }
        if constexpr (!Epi::AFTER_DRAIN) { E(acc, cur, wr, wc, fr, fq); S.done(cur); }
        if (!has_next) break;
#pragma unroll
        for (int a = 0; a < 2; ++a)
#pragma unroll
            for (int b = 0; b < 2; ++b)
#pragma unroll
                for (int m = 0; m < 4; ++m)
#pragma unroll
                    for (int n = 0; n < 2; ++n) acc[a][b][m][n] = (f32x4){0.f, 0.f, 0.f, 0.f};
        cur = nxt; cA = nA; cB = nB; ++ui;
        if constexpr (ALIGN_EPI) { if (wr == 1) PG8_BAR; }
    }
    PG8_WAIT_V(0);
    if constexpr (!ALIGN_EPI) { if (wr == 0) PG8_BAR; }
    PG8_BAR;
    if constexpr (Epi::AFTER_DRAIN) { E.fused(acc, cur, wr, wc, fr, fq, lds, wid, lane); S.done(cur); }
#undef PG8_SA
#undef PG8_SB
#undef PG8_STAGE
#undef PG8_LDA
#undef PG8_LDB
#undef PG8_MMA
#undef PG8_WAIT_V
#undef PG8_WAIT_L
#undef PG8_BAR
#undef PG8_SCHED
}
}
constexpr int S = 16384, DM = 1024, DEPTH = 4, NIN = 2816, DFF = 2816, NUP = 5632;
constexpr float EPS = 1e-6f;
constexpr int NWAVES = 8, NTHR = 512;
constexpr size_t MiB = 1u << 20;
constexpr size_t WS_WIN = 1 * MiB, WS_WOUT = 23 * MiB, WS_WUP = 31 * MiB, WS_WDN = 75 * MiB;
constexpr size_t WS_PART = 97 * MiB;
constexpr size_t WS_XB = 98 * MiB + 4096;
constexpr size_t WS_P = 131 * MiB;
constexpr size_t WS_Y = 219 * MiB;
constexpr size_t WS_GU = 131 * MiB;
constexpr size_t WS_A = 219 * MiB;
constexpr size_t WS_END = 307 * MiB;
constexpr int LDS_BYTES = 147456;
#define LAS __attribute__((address_space(3)))
typedef unsigned short bf16;
typedef unsigned v4u __attribute__((ext_vector_type(4)));
typedef unsigned v2u __attribute__((ext_vector_type(2)));
typedef float f32x4 __attribute__((ext_vector_type(4)));
typedef float f32x16 __attribute__((ext_vector_type(16)));
typedef short bf16x8 __attribute__((ext_vector_type(8)));
#define LDS_WAIT() asm volatile("s_waitcnt lgkmcnt(0)" ::: "memory")
__device__ __forceinline__ unsigned pk2(float lo, float hi) { return pg8::cvt_pk_bf16(lo, hi); }
__device__ __forceinline__ float bflo(unsigned u) { return __uint_as_float(u << 16); }
__device__ __forceinline__ float bfhi(unsigned u) { return __uint_as_float(u & 0xffff0000u); }
__device__ __forceinline__ float bf1(bf16 v) { return __uint_as_float((unsigned)v << 16); }
#define WS_DPP(v, ctrl) __builtin_bit_cast(float, __builtin_amdgcn_update_dpp(0, __builtin_bit_cast(int, (float)(v)), (ctrl), 0xf, 0xf, true))
__device__ __forceinline__ float wave_sum(float v) {
    v += WS_DPP(v, 0xB1); v += WS_DPP(v, 0x4E); v += WS_DPP(v, 0x141); v += WS_DPP(v, 0x140);
    const int iv = __builtin_bit_cast(int, v);
    const float a = __builtin_bit_cast(float, __builtin_amdgcn_readlane(iv, 0)), b = __builtin_bit_cast(float, __builtin_amdgcn_readlane(iv, 16));
    const float c = __builtin_bit_cast(float, __builtin_amdgcn_readlane(iv, 32)), d = __builtin_bit_cast(float, __builtin_amdgcn_readlane(iv, 48));
    return (a + b) + (c + d);
}

__device__ __forceinline__ void cvt_item(const float* W, int K, int N, bf16* WT, const float* gain, int mode, LAS float* scr, int item, int lane) {
    const int nblk = N / 32, kb = item / nblk, nb = item % nblk, k0 = 64 * kb, n0 = 32 * nb;
    float wv[32];
#pragma unroll
    for (int i = 0; i < 32; ++i) { const int kk = 2 * i + (lane >> 5); wv[i] = ((const __attribute__((address_space(1))) float*)W)[(size_t)(k0 + kk) * N + n0 + (lane & 31)]; }
#pragma unroll
    for (int i = 0; i < 32; ++i) { const int kk = 2 * i + (lane >> 5); const float g = gain ? ((const __attribute__((address_space(1))) float*)gain)[k0 + kk] : 1.0f; scr[kk * 33 + (lane & 31)] = wv[i] * g; }
    LDS_WAIT(); asm volatile("" ::: "memory");
    const float cs = (mode == 1 && n0 >= 1280 && n0 < 1792) ? 0.125f * 1.4426950408889634f : 1.0f;
    int rb = n0;
    if (mode == 2) { rb = (n0 < DFF) ? 256 * (n0 / 128) + (n0 % 128) : 256 * ((n0 - DFF) / 128) + 128 + ((n0 - DFF) % 128); }
    const int c = lane & 7;
#pragma unroll
    for (int j = 0; j < 4; ++j) { const int n = (lane >> 3) + 8 * j; const LAS float* s = scr + (8 * c) * 33 + n;
        v4u o; o.x = pk2(s[0 * 33] * cs, s[1 * 33] * cs); o.y = pk2(s[2 * 33] * cs, s[3 * 33] * cs); o.z = pk2(s[4 * 33] * cs, s[5 * 33] * cs); o.w = pk2(s[6 * 33] * cs, s[7 * 33] * cs);
        *(__attribute__((address_space(1))) v4u*)(WT + (size_t)(rb + n) * K + k0 + 8 * c) = o; }
    LDS_WAIT(); asm volatile("" ::: "memory");
}

typedef __attribute__((address_space(1))) unsigned gu32;
#define XB_TMO      128
#define XB_XCNT(j)  (256  + 64 * (j))
#define XB_XSUB(j)  (1280 + 64 * (j))
#define XB_XGEN(j)  (2304 + 64 * (j))
#define XB_TOP      3328
#define XB_TOPGEN   3392
#define XCD_BAR_WORDS 3456
#define XB_SPIN_CAP (1u << 18)

__device__ __forceinline__ unsigned xb_ld(unsigned* p)              { return __hip_atomic_load(p, __ATOMIC_RELAXED, __HIP_MEMORY_SCOPE_AGENT); }
__device__ __forceinline__ unsigned xb_add(unsigned* p, unsigned v) { return __hip_atomic_fetch_add(p, v, __ATOMIC_RELAXED, __HIP_MEMORY_SCOPE_AGENT); }
__device__ __forceinline__ unsigned xb_xcc_id() { return (unsigned)__builtin_amdgcn_s_getreg((3 << 11) | 20) & 0xFu; }
#define XB_SPIN(cond, bar) do { unsigned _sp = 0; while (cond) { __builtin_amdgcn_s_sleep(1); \
    if ((++_sp & 255u) == 0u) { if (xb_ld(&(bar)[XB_TMO])) break; if (_sp > XB_SPIN_CAP) { atomicAdd(&(bar)[XB_TMO], 1u); break; } } } } while (0)

struct XcdBarrier {
    unsigned* bar; unsigned x;
    volatile LAS unsigned* st;
};

__device__ __forceinline__ XcdBarrier xcd_barrier_post(unsigned* bar, volatile LAS unsigned* st) {
    XcdBarrier b; b.bar = bar; b.x = xb_xcc_id(); b.st = st;
    if (threadIdx.x == 0) (void)xb_add(&bar[XB_XCNT(b.x)], 1u);
    return b;
}
__device__ __forceinline__ void xcd_barrier_complete(unsigned* bar, unsigned x, unsigned& nloc, unsigned& nx) {
    const unsigned G = gridDim.x * gridDim.y * gridDim.z;
    unsigned sum, cnt, mine, sp = 0u;
    for (;;) {
        sum = 0u; cnt = 0u; mine = 0u;
#pragma unroll
        for (unsigned j = 0; j < 16; ++j) { const unsigned c = xb_ld(&bar[XB_XCNT(j)]); sum += c; cnt += (c > 0u) ? 1u : 0u; mine = (j == x) ? c : mine; }
        if (sum == G) break;
        __builtin_amdgcn_s_sleep(1);
        if ((++sp & 255u) == 0u) { if (xb_ld(&bar[XB_TMO])) break; if (sp > XB_SPIN_CAP) { atomicAdd(&bar[XB_TMO], 1u); break; } }
    }
    nloc = mine > 0u ? mine : 1u; nx = cnt > 0u ? cnt : 1u;
}

__device__ __forceinline__ void xcd_barrier(const XcdBarrier& b) {
    asm volatile("s_waitcnt vmcnt(0)" ::: "memory");
    __syncthreads();
    if (threadIdx.x == 0) {
        unsigned* bar = b.bar;
        __builtin_amdgcn_s_waitcnt(0);
        unsigned nloc = b.st[0], nx = b.st[1];
        if (nloc == 0u) { xcd_barrier_complete(bar, b.x, nloc, nx); b.st[0] = nloc; b.st[1] = nx; }
        const unsigned old = xb_add(&bar[XB_XSUB(b.x)], 1u);
        const unsigned gen = old / nloc;
        if (old + 1u == (gen + 1u) * nloc) {
            __builtin_amdgcn_fence(__ATOMIC_RELEASE, "agent");
            asm volatile("s_waitcnt vmcnt(0)" ::: "memory");
            const unsigned og = xb_add(&bar[XB_TOP], 1u);
            const unsigned tg = og / nx;
            if (og + 1u == (tg + 1u) * nx) xb_add(&bar[XB_TOPGEN], 1u);
            else XB_SPIN(xb_ld(&bar[XB_TOPGEN]) == tg, bar);
            __builtin_amdgcn_fence(__ATOMIC_ACQUIRE, "agent");
            xb_add(&bar[XB_XGEN(b.x)], 1u);
            asm volatile("s_waitcnt vmcnt(0)" ::: "memory");
        } else {
            XB_SPIN(xb_ld(&bar[XB_XGEN(b.x)]) == gen, bar);
            __builtin_amdgcn_fence(__ATOMIC_ACQUIRE, "agent");
            asm volatile("s_waitcnt vmcnt(0)" ::: "memory");
        }
    }
    __syncthreads();
}

struct CvtSrc { const float *w_in, *w_out, *w_up, *w_down, *norm_mix, *out_norm, *norm_ffn; bf16 *Win_t, *Wout_t, *Wup_t, *Wdn_t; };
__device__ __forceinline__ void cvt_layer_item(const CvtSrc& c, int l, int r, LAS float* scr, int lane) {
    const float* W; bf16* WT; const float* gain; int K, N, mode;
    if (r < 1408) { W = c.w_in + (size_t)l * DM * NIN; K = DM; N = NIN; WT = c.Win_t + (size_t)l * NIN * DM; gain = c.norm_mix + l * DM; mode = 1; }
    else if (r < 1920) { r -= 1408; W = c.w_out + (size_t)l * DM * DM; K = DM; N = DM; WT = c.Wout_t + (size_t)l * DM * DM; gain = c.out_norm + l * DM; mode = 0; }
    else if (r < 4736) { r -= 1920; W = c.w_up + (size_t)l * DM * NUP; K = DM; N = NUP; WT = c.Wup_t + (size_t)l * NUP * DM; gain = c.norm_ffn + l * DM; mode = 2; }
    else { r -= 4736; W = c.w_down + (size_t)l * DFF * DM; K = DFF; N = DM; WT = c.Wdn_t + (size_t)l * DM * DFF; gain = nullptr; mode = 0; }
    cvt_item(W, K, N, WT, gain, mode, scr, r, lane);
}
__device__ __forceinline__ const float* ldptr(const volatile LAS unsigned* PT, int k) {
    const unsigned lo = __builtin_amdgcn_readfirstlane(PT[2 * k]), hi = __builtin_amdgcn_readfirstlane(PT[2 * k + 1]);
    return (const float*)(const __attribute__((address_space(1))) float*)(((unsigned long long)hi << 32) | lo);
}
struct Args { const float* in[14]; float* out; unsigned char* ws; };

__device__ __forceinline__ void norm_store_rows(const LAS float* tile, bf16* Y, int t0, int coff, int wave, int lane) {
#pragma unroll 2
    for (int i = 0; i < 8; ++i) { const int r = wave * 8 + i; const f32x4 v = *(const LAS f32x4*)(tile + r * 260 + lane * 4);
        const float ss = wave_sum((v[0] * v[0] + v[1] * v[1]) + (v[2] * v[2] + v[3] * v[3]));
        const float rs = __builtin_amdgcn_rsqf(ss * (1.0f / 256.0f) + EPS);
        v2u o; o.x = pk2(v[0] * rs, v[1] * rs); o.y = pk2(v[2] * rs, v[3] * rs);
        *(__attribute__((address_space(1))) v2u*)(Y + (size_t)(t0 + r) * DM + coff + lane * 4) = o; }
}

__device__ __forceinline__ void mixer_unit(LAS unsigned char* lds, int unit, const bf16* P, bf16* Y, const float* conv_w, const float* sgu_norm, const float* sgu_w, const float* sgu_b, int tid, int wave, int lane) {
    const int t0 = unit * 64;
    asm volatile("" : "+v"(tid), "+v"(lane));
    LAS bf16* vnT = (LAS bf16*)lds;
    LAS float* tile = (LAS float*)(lds + 69632);
    LAS float* sm_ss = (LAS float*)(lds + 69632 + 66560);
    {
        const int hd = wave, r = lane & 31, h = lane >> 5;
        const int pr = (r & 0x13) | ((r & 4) << 1) | ((r & 8) >> 1);
        LAS bf16* Vt = (LAS bf16*)(lds + wave * 5120);
        bf16x8 atri[2];
#pragma unroll
        for (int sI = 0; sI < 2; ++sI) { v4u t;
            t.x = ((16 * sI + 8 * h + 0 > pr) ? 0x3F80u : 0u) | ((16 * sI + 8 * h + 1 > pr) ? 0x3F800000u : 0u); t.y = ((16 * sI + 8 * h + 2 > pr) ? 0x3F80u : 0u) | ((16 * sI + 8 * h + 3 > pr) ? 0x3F800000u : 0u);
            t.z = ((16 * sI + 8 * h + 4 > pr) ? 0x3F80u : 0u) | ((16 * sI + 8 * h + 5 > pr) ? 0x3F800000u : 0u); t.w = ((16 * sI + 8 * h + 6 > pr) ? 0x3F80u : 0u) | ((16 * sI + 8 * h + 7 > pr) ? 0x3F800000u : 0u);
            atri[sI] = __builtin_bit_cast(bf16x8, t); }
        f32x16 oacc[2][2];
        bf16x8 kfn[4]; v4u vvn[4];
        { const bf16* kp = P + (size_t)(t0 + 32 + pr) * NIN + 1792 + hd * 64 + 8 * h;
#pragma unroll
          for (int ks = 0; ks < 4; ++ks) kfn[ks] = *(const __attribute__((address_space(1))) bf16x8*)(kp + 16 * ks);
#pragma unroll
          for (int i = 0; i < 4; ++i) vvn[i] = *(const __attribute__((address_space(1))) v4u*)(P + (size_t)(t0 + 32 + (lane >> 3) + 8 * i) * NIN + 2304 + hd * 64 + 8 * (lane & 7)); }
        LAS bf16x8* Qs = (LAS bf16x8*)(lds + 40960 + wave * 8192);
#pragma unroll
        for (int ks = 0; ks < 4; ++ks) { Qs[ks * 64 + lane] = *(const __attribute__((address_space(1))) bf16x8*)(P + (size_t)(t0 + r) * NIN + 1280 + hd * 64 + 16 * ks + 8 * h); Qs[(4 + ks) * 64 + lane] = *(const __attribute__((address_space(1))) bf16x8*)(P + (size_t)(t0 + 32 + r) * NIN + 1280 + hd * 64 + 16 * ks + 8 * h); }
#pragma unroll
        for (int a = 0; a < 2; ++a)
#pragma unroll
            for (int b = 0; b < 2; ++b) oacc[a][b] = (f32x16){};
        float lsA = 0.f, lsB = 0.f; bool actA = true, actB = true;
#define SB_CHAIN(Z, O0, O1, LS, DIAGV) do { \
            f32x16 cin; float Lv[16]; \
            _Pragma("unroll") for (int jj = 0; jj < 16; ++jj) { const float zz = Z[jj]; const float ex = __builtin_amdgcn_exp2f(-fabsf(zz)); const float lsig = fminf(zz, 0.f) - __builtin_amdgcn_logf(1.0f + ex); \
                Lv[jj] = lsig - zz; cin[jj] = lsig + LS; } \
            if (DIAGV) { _Pragma("unroll") for (int jj = 0; jj < 16; ++jj) { const int keyl = 16 * (jj >> 3) + 8 * h + (jj & 7); Lv[jj] = (keyl < r) ? Lv[jj] : 0.f; } } \
            float rowsum = 0.f; unsigned lh[8], ll[8]; \
            _Pragma("unroll") for (int j = 0; j < 16; j += 2) { rowsum += Lv[j] + Lv[j + 1]; \
                const unsigned hp = pk2(Lv[j], Lv[j + 1]); lh[j >> 1] = hp; ll[j >> 1] = pk2(Lv[j] - bflo(hp), Lv[j + 1] - bfhi(hp)); } \
            const bf16x8 bh0 = __builtin_bit_cast(bf16x8, (v4u){lh[0], lh[1], lh[2], lh[3]}), bh1 = __builtin_bit_cast(bf16x8, (v4u){lh[4], lh[5], lh[6], lh[7]}); \
            const bf16x8 bl0 = __builtin_bit_cast(bf16x8, (v4u){ll[0], ll[1], ll[2], ll[3]}), bl1 = __builtin_bit_cast(bf16x8, (v4u){ll[4], ll[5], ll[6], ll[7]}); \
            f32x16 lw = __builtin_amdgcn_mfma_f32_32x32x16_bf16(atri[0], bh0, cin, 0, 0, 0); \
            lw = __builtin_amdgcn_mfma_f32_32x32x16_bf16(atri[1], bh1, lw, 0, 0, 0); \
            lw = __builtin_amdgcn_mfma_f32_32x32x16_bf16(atri[0], bl0, lw, 0, 0, 0); \
            lw = __builtin_amdgcn_mfma_f32_32x32x16_bf16(atri[1], bl1, lw, 0, 0, 0); \
            float wv[16]; \
            _Pragma("unroll") for (int jj = 0; jj < 16; ++jj) wv[jj] = __builtin_amdgcn_exp2f(lw[jj]); \
            if (DIAGV) { _Pragma("unroll") for (int jj = 0; jj < 16; ++jj) { const int keyl = 16 * (jj >> 3) + 8 * h + (jj & 7); wv[jj] = (keyl < r) ? wv[jj] : 0.f; } } \
            unsigned wp[8]; \
            _Pragma("unroll") for (int j = 0; j < 16; j += 2) wp[j >> 1] = pk2(wv[j], wv[j + 1]); \
            const bf16x8 w0 = __builtin_bit_cast(bf16x8, (v4u){wp[0], wp[1], wp[2], wp[3]}), w1 = __builtin_bit_cast(bf16x8, (v4u){wp[4], wp[5], wp[6], wp[7]}); \
            const LAS bf16* vr = Vt + r * 40 + 8 * h; \
            O0 = __builtin_amdgcn_mfma_f32_32x32x16_bf16(*(const LAS bf16x8*)(vr), w0, O0, 0, 0, 0); \
            O0 = __builtin_amdgcn_mfma_f32_32x32x16_bf16(*(const LAS bf16x8*)(vr + 16), w1, O0, 0, 0, 0); \
            O1 = __builtin_amdgcn_mfma_f32_32x32x16_bf16(*(const LAS bf16x8*)(vr + 32 * 40), w0, O1, 0, 0, 0); \
            O1 = __builtin_amdgcn_mfma_f32_32x32x16_bf16(*(const LAS bf16x8*)(vr + 32 * 40 + 16), w1, O1, 0, 0, 0); \
            LS += rowsum + __shfl_xor(rowsum, 32); } while (0)
        for (int k0 = t0 + 32;; k0 -= 32) {
            const bool doA = actA && (k0 <= t0);
            f32x16 zB = {}, zA = {};
            if (actB) {
#pragma unroll
                for (int ks = 0; ks < 4; ++ks) zB = __builtin_amdgcn_mfma_f32_32x32x16_bf16(kfn[ks], Qs[(4 + ks) * 64 + lane], zB, 0, 0, 0); }
            if (doA) {
#pragma unroll
                for (int ks = 0; ks < 4; ++ks) zA = __builtin_amdgcn_mfma_f32_32x32x16_bf16(kfn[ks], Qs[ks * 64 + lane], zA, 0, 0, 0); }
#pragma unroll
            for (int i = 0; i < 4; ++i) { const int key = (lane >> 3) + 8 * i, c = lane & 7; const v4u vv = vvn[i];
                LAS bf16* vd = Vt + (8 * c) * 40 + key;
                vd[0] = (bf16)(vv.x & 0xffffu); vd[40] = (bf16)(vv.x >> 16); vd[80] = (bf16)(vv.y & 0xffffu); vd[120] = (bf16)(vv.y >> 16);
                vd[160] = (bf16)(vv.z & 0xffffu); vd[200] = (bf16)(vv.z >> 16); vd[240] = (bf16)(vv.w & 0xffffu); vd[280] = (bf16)(vv.w >> 16); }
            if (k0 >= 32) { const bf16* kp = P + (size_t)(k0 - 32 + pr) * NIN + 1792 + hd * 64 + 8 * h;
#pragma unroll
                for (int ks = 0; ks < 4; ++ks) kfn[ks] = *(const __attribute__((address_space(1))) bf16x8*)(kp + 16 * ks);
#pragma unroll
                for (int i = 0; i < 4; ++i) vvn[i] = *(const __attribute__((address_space(1))) v4u*)(P + (size_t)(k0 - 32 + (lane >> 3) + 8 * i) * NIN + 2304 + hd * 64 + 8 * (lane & 7)); }
            if (actB) { const bool dg = (k0 == t0 + 32); SB_CHAIN(zB, oacc[1][0], oacc[1][1], lsB, dg);
                if (__builtin_amdgcn_ballot_w64(lsB > -150.1f) == 0ull) actB = false; }
            if (doA) { const bool dg = (k0 == t0); SB_CHAIN(zA, oacc[0][0], oacc[0][1], lsA, dg);
                if (__builtin_amdgcn_ballot_w64(lsA > -150.1f) == 0ull) actA = false; }
            if (k0 < 32 || !(actA || actB)) break;
        }
#undef SB_CHAIN
#pragma unroll
        for (int qh = 0; qh < 2; ++qh) { float ss = 0.f;
#pragma unroll
            for (int j = 0; j < 16; ++j) ss += oacc[qh][0][j] * oacc[qh][0][j] + oacc[qh][1][j] * oacc[qh][1][j];
            ss += __shfl_xor(ss, 32);
            if (h == 0) sm_ss[(32 * qh + r) * 8 + hd] = ss; }
        LDS_WAIT(); __syncthreads();
#pragma unroll
        for (int qh = 0; qh < 2; ++qh) {
            const f32x4 sa = *(const LAS f32x4*)(sm_ss + (32 * qh + r) * 8), sb = *(const LAS f32x4*)(sm_ss + (32 * qh + r) * 8 + 4);
            const float tot = ((sa[0] + sa[1]) + (sa[2] + sa[3])) + ((sb[0] + sb[1]) + (sb[2] + sb[3]));
            const float rs = __builtin_amdgcn_rsqf(tot * (1.0f / 512.0f) + EPS);
            bf16* yp = Y + (size_t)(t0 + 32 * qh + r) * DM + 512 + hd * 64 + 4 * h;
#pragma unroll
            for (int db = 0; db < 2; ++db)
#pragma unroll
                for (int g4 = 0; g4 < 4; ++g4) { const f32x16& o = oacc[qh][db]; v2u w; w.x = pk2(o[4 * g4 + 0] * rs, o[4 * g4 + 1] * rs); w.y = pk2(o[4 * g4 + 2] * rs, o[4 * g4 + 3] * rs);
                    *(__attribute__((address_space(1))) v2u*)(yp + 32 * db + 8 * g4) = w; }
        }
    }
    const int c8 = (tid & 31) * 8, rg = tid >> 5, tb = t0 + 4 * rg;
    v4u gb[4], gc[6], hc[6];
#pragma unroll
    for (int i = 0; i < 6; ++i) { const int t = tb - 2 + i; const bool ok = t >= 0; const bf16* rp = P + (size_t)(ok ? t : 0) * NIN;
        gc[i] = ok ? *(const __attribute__((address_space(1))) v4u*)(rp + 256 + c8) : (v4u){0u, 0u, 0u, 0u}; hc[i] = ok ? *(const __attribute__((address_space(1))) v4u*)(rp + 512 + c8) : (v4u){0u, 0u, 0u, 0u};
        if (i >= 2) gb[i - 2] = *(const __attribute__((address_space(1))) v4u*)(rp + c8); }
    const int tc = t0 & ~127, dt = t0 - tc, ns = dt + 64;
    v2u uu[16];
#pragma unroll
    for (int i = 0; i < 16; ++i) { const int s = wave + 8 * i; uu[i] = (s < ns) ? *(const __attribute__((address_space(1))) v2u*)(P + (size_t)(tc + s) * NIN + 1024 + lane * 4) : (v2u){0u, 0u}; }
    const int h = wave >> 1, rh = wave & 1, r32 = lane & 31, hi = lane >> 5;
    const int tcl = dt + 32 * rh + r32;
    const int nk = (dt + 32 * rh + 32) >> 4;
    f32x4 wa[8], wb[8];
    { const float* wrow = sgu_w + ((size_t)h * 128 + tcl) * 128;
#pragma unroll
      for (int ks = 0; ks < 8; ++ks) { const int s0 = ks * 16 + 8 * hi; if (ks < nk) { wa[ks] = *(const __attribute__((address_space(1))) f32x4*)(wrow + s0); wb[ks] = *(const __attribute__((address_space(1))) f32x4*)(wrow + s0 + 4); } else { wa[ks] = (f32x4){0.f, 0.f, 0.f, 0.f}; wb[ks] = wa[ks]; } } }
    {
        float w0[8], w1[8], w2[8];
        { const f32x4 a0 = *(const __attribute__((address_space(1))) f32x4*)(conv_w + c8), a1 = *(const __attribute__((address_space(1))) f32x4*)(conv_w + c8 + 4), b0 = *(const __attribute__((address_space(1))) f32x4*)(conv_w + 256 + c8), b1 = *(const __attribute__((address_space(1))) f32x4*)(conv_w + 256 + c8 + 4), d0 = *(const __attribute__((address_space(1))) f32x4*)(conv_w + 512 + c8), d1 = *(const __attribute__((address_space(1))) f32x4*)(conv_w + 512 + c8 + 4);
#pragma unroll
          for (int e = 0; e < 4; ++e) { w0[e] = a0[e]; w0[4 + e] = a1[e]; w1[e] = b0[e]; w1[4 + e] = b1[e]; w2[e] = d0[e]; w2[4 + e] = d1[e]; } }
        float pr_[6][8];
#pragma unroll
        for (int i = 0; i < 6; ++i) { const unsigned ga[4] = {gc[i].x, gc[i].y, gc[i].z, gc[i].w}, ha[4] = {hc[i].x, hc[i].y, hc[i].z, hc[i].w};
#pragma unroll
            for (int e = 0; e < 4; ++e) { pr_[i][2 * e] = bflo(ga[e]) * bflo(ha[e]); pr_[i][2 * e + 1] = bfhi(ga[e]) * bfhi(ha[e]); } }
#pragma unroll
        for (int i = 0; i < 4; ++i) { const unsigned ba[4] = {gb[i].x, gb[i].y, gb[i].z, gb[i].w}; float o[8];
#pragma unroll
            for (int e = 0; e < 4; ++e) { o[2 * e] = bflo(ba[e]) * (w0[2 * e] * pr_[i][2 * e] + w1[2 * e] * pr_[i + 1][2 * e] + w2[2 * e] * pr_[i + 2][2 * e]);
                o[2 * e + 1] = bfhi(ba[e]) * (w0[2 * e + 1] * pr_[i][2 * e + 1] + w1[2 * e + 1] * pr_[i + 1][2 * e + 1] + w2[2 * e + 1] * pr_[i + 2][2 * e + 1]); }
            LAS f32x4* tp = (LAS f32x4*)(tile + (4 * rg + i) * 260 + c8); tp[0] = (f32x4){o[0], o[1], o[2], o[3]}; tp[1] = (f32x4){o[4], o[5], o[6], o[7]}; }
    }
    LDS_WAIT(); __syncthreads();
    norm_store_rows(tile, Y, t0, 0, wave, lane);
    { const f32x4 g = *(const __attribute__((address_space(1))) f32x4*)(sgu_norm + lane * 4);
#pragma unroll
      for (int i = 0; i < 16; ++i) { const int s = wave + 8 * i;
        if (s < ns) { const v2u u = uu[i];
        const float v0 = bflo(u.x), v1 = bfhi(u.x), v2 = bflo(u.y), v3 = bfhi(u.y);
        const float ss = wave_sum((v0 * v0 + v1 * v1) + (v2 * v2 + v3 * v3)); const float rs = __builtin_amdgcn_rsqf(ss * (1.0f / 256.0f) + EPS);
        const unsigned a = pk2(v0 * rs * g[0], v1 * rs * g[1]), b = pk2(v2 * rs * g[2], v3 * rs * g[3]);
        vnT[(lane * 4 + 0) * 136 + s] = (bf16)(a & 0xffffu); vnT[(lane * 4 + 1) * 136 + s] = (bf16)(a >> 16); vnT[(lane * 4 + 2) * 136 + s] = (bf16)(b & 0xffffu); vnT[(lane * 4 + 3) * 136 + s] = (bf16)(b >> 16); } } }
    float ug0[16], ug1[16], bbv[16];
#pragma unroll
    for (int j = 0; j < 16; ++j) { const int rl = 32 * rh + (j & 3) + 8 * (j >> 2) + 4 * hi; const bf16* up = P + (size_t)(t0 + rl) * NIN + 768 + h * 64;
        ug0[j] = bf1(((const __attribute__((address_space(1))) bf16*)up)[r32]); ug1[j] = bf1(((const __attribute__((address_space(1))) bf16*)up)[32 + r32]); bbv[j] = ((const __attribute__((address_space(1))) float*)sgu_b)[h * 128 + dt + rl]; }
    LDS_WAIT(); __syncthreads();
    {
        f32x16 o0 = {}, o1 = {};
#pragma unroll
        for (int ks = 0; ks < 8; ++ks) if (ks < nk) { const int s0 = ks * 16 + 8 * hi;
            float wv[8] = {wa[ks][0], wa[ks][1], wa[ks][2], wa[ks][3], wb[ks][0], wb[ks][1], wb[ks][2], wb[ks][3]};
#pragma unroll
            for (int i = 0; i < 8; ++i) wv[i] = (s0 + i <= tcl) ? wv[i] : 0.f;
            v4u ap; ap.x = pk2(wv[0], wv[1]); ap.y = pk2(wv[2], wv[3]); ap.z = pk2(wv[4], wv[5]); ap.w = pk2(wv[6], wv[7]);
            const bf16x8 af = __builtin_bit_cast(bf16x8, ap);
            const bf16x8 b0 = *(const LAS bf16x8*)(vnT + (h * 64 + r32) * 136 + s0), b1 = *(const LAS bf16x8*)(vnT + (h * 64 + 32 + r32) * 136 + s0);
            o0 = __builtin_amdgcn_mfma_f32_32x32x16_bf16(af, b0, o0, 0, 0, 0);
            o1 = __builtin_amdgcn_mfma_f32_32x32x16_bf16(af, b1, o1, 0, 0, 0); }
#pragma unroll
        for (int j = 0; j < 16; ++j) { const int rl = 32 * rh + (j & 3) + 8 * (j >> 2) + 4 * hi;
            tile[rl * 260 + h * 64 + r32] = ug0[j] * (o0[j] + bbv[j]);
            tile[rl * 260 + h * 64 + 32 + r32] = ug1[j] * (o1[j] + bbv[j]); }
    }
    LDS_WAIT(); __syncthreads();
    norm_store_rows(tile, Y, t0, 256, wave, lane);
    LDS_WAIT(); __syncthreads();
}

__device__ __forceinline__ void ffn_gate_phase(const bf16* GU, bf16* A, const float* fconv, int hf, int gtid, int gthreads) {
    for (int it = gtid; it < 256 * 176; it += gthreads) { const int rb = it / 176, cgp = it % 176, pnl = cgp >> 4, cc = (cgp & 15) * 8, ch = 1408 * hf + 128 * pnl + cc;
        float wg[3][8], wu[3][8];
#pragma unroll
        for (int i = 0; i < 3; ++i) { const f32x4 a0 = *(const __attribute__((address_space(1))) f32x4*)(fconv + (size_t)i * NUP + ch), a1 = *(const __attribute__((address_space(1))) f32x4*)(fconv + (size_t)i * NUP + ch + 4), b0 = *(const __attribute__((address_space(1))) f32x4*)(fconv + (size_t)i * NUP + DFF + ch), b1 = *(const __attribute__((address_space(1))) f32x4*)(fconv + (size_t)i * NUP + DFF + ch + 4);
#pragma unroll
            for (int e = 0; e < 4; ++e) { wg[i][e] = a0[e]; wg[i][4 + e] = a1[e]; wu[i][e] = b0[e]; wu[i][4 + e] = b1[e]; } }
        float g2[8], g1[8], u2[8], u1[8];
#pragma unroll
        for (int e = 0; e < 8; ++e) { g2[e] = g1[e] = u2[e] = u1[e] = 0.f; }
        for (int r = -2; r < 64; ++r) { const int t = 64 * rb + r; float g0[8], u0[8];
            if (t >= 0) { const v4u gv = *(const __attribute__((address_space(1))) v4u*)(GU + (size_t)t * NIN + 256 * pnl + cc), uv = *(const __attribute__((address_space(1))) v4u*)(GU + (size_t)t * NIN + 256 * pnl + 128 + cc);
                g0[0] = bflo(gv.x); g0[1] = bfhi(gv.x); g0[2] = bflo(gv.y); g0[3] = bfhi(gv.y); g0[4] = bflo(gv.z); g0[5] = bfhi(gv.z); g0[6] = bflo(gv.w); g0[7] = bfhi(gv.w);
                u0[0] = bflo(uv.x); u0[1] = bfhi(uv.x); u0[2] = bflo(uv.y); u0[3] = bfhi(uv.y); u0[4] = bflo(uv.z); u0[5] = bfhi(uv.z); u0[6] = bflo(uv.w); u0[7] = bfhi(uv.w); }
            else {
#pragma unroll
                for (int e = 0; e < 8; ++e) { g0[e] = 0.f; u0[e] = 0.f; } }
            if (r >= 0) { float o[8];
#pragma unroll
                for (int e = 0; e < 8; ++e) { const float G = wg[0][e] * g2[e] + wg[1][e] * g1[e] + wg[2][e] * g0[e], U = wu[0][e] * u2[e] + wu[1][e] * u1[e] + wu[2][e] * u0[e];
                    o[e] = G * __builtin_amdgcn_rcpf(1.0f + __expf(-G)) * U; }
                v4u ov; ov.x = pk2(o[0], o[1]); ov.y = pk2(o[2], o[3]); ov.z = pk2(o[4], o[5]); ov.w = pk2(o[6], o[7]);
                *(__attribute__((address_space(1))) v4u*)(A + (size_t)t * DFF + ch) = ov; }
#pragma unroll
            for (int e = 0; e < 8; ++e) { g2[e] = g1[e]; g1[e] = g0[e]; u2[e] = u1[e]; u1[e] = u0[e]; } }
    }
}
__global__ void __launch_bounds__(NTHR, 2) hybrid_fwd(Args args) {
    extern __shared__ __attribute__((aligned(16))) unsigned char lds_raw[];
    LAS unsigned char* lds = (LAS unsigned char*)lds_raw;
    cg::grid_group grid = cg::this_grid();
    volatile LAS unsigned* MISC = (volatile LAS unsigned*)(lds + LDS_BYTES - 64);
    volatile LAS unsigned* PT = (volatile LAS unsigned*)(lds + LDS_BYTES - 256);
    if (threadIdx.x < 16) MISC[threadIdx.x] = 0u;
    if (threadIdx.x == 0) {
#define PUTP(k) { const unsigned long long v_ = (unsigned long long)args.in[k]; PT[2 * (k)] = (unsigned)v_; PT[2 * (k) + 1] = (unsigned)(v_ >> 32); }
        PUTP(0) PUTP(1) PUTP(2) PUTP(3) PUTP(4) PUTP(5) PUTP(6) PUTP(7) PUTP(8) PUTP(9) PUTP(10) PUTP(11) PUTP(12) PUTP(13)
#undef PUTP
    }
    __syncthreads();
    XcdBarrier xbar = xcd_barrier_post((unsigned*)args.ws, MISC);
    const int tid = threadIdx.x, lane = tid & 63, wave = __builtin_amdgcn_readfirstlane(tid >> 6);
    const int G = gridDim.x, bx = blockIdx.x;
    const int gw = bx * NWAVES + wave, NGW = G * NWAVES;
    unsigned char* ws = args.ws;
#define INP(k) ldptr(PT, (k))
#define MAKE_CS() const CvtSrc cs{INP(2), INP(8), INP(10), INP(12), INP(1), INP(7), INP(9), Win_t, Wout_t, Wup_t, Wdn_t}
    float* xo = args.out;
#define PHASE_PTRS() unsigned char* w_ = ws; float* xcur = xo; asm volatile("" : "+s"(w_), "+s"(xcur)); \
    w_ = (unsigned char*)(__attribute__((address_space(1))) unsigned char*)w_; xcur = (float*)(__attribute__((address_space(1))) float*)xcur;     \
    bf16* Win_t = (bf16*)(w_ + WS_WIN); bf16* Wout_t = (bf16*)(w_ + WS_WOUT); bf16* Wup_t = (bf16*)(w_ + WS_WUP); bf16* Wdn_t = (bf16*)(w_ + WS_WDN); \
    float* part = (float*)(w_ + WS_PART); bf16* XB = (bf16*)(w_ + WS_XB); bf16* P = (bf16*)(w_ + WS_P); bf16* Y = (bf16*)(w_ + WS_Y); bf16* A = (bf16*)(w_ + WS_A); \
    (void)Win_t; (void)Wout_t; (void)Wup_t; (void)Wdn_t; (void)part; (void)XB; (void)P; (void)Y; (void)A; (void)xcur

    for (int step = -1; step < 5 * DEPTH; ++step) {
        const int l = step < 0 ? 0 : step / 5, ph = step < 0 ? -1 : step % 5;
        int cvt_layer = -1, cvt_first = 0, cvt_n = 0, cvt_nu = 0;
        if (ph < 0) {
            PHASE_PTRS(); const float* x_in = INP(0);
            int gw_ = gw, lane_ = lane; asm volatile("" : "+s"(gw_), "+v"(lane_));
            for (int m = gw_; m < S; m += NGW) { const __attribute__((address_space(1))) f32x4* xr = (const __attribute__((address_space(1))) f32x4*)(x_in + (size_t)m * DM) + lane_; f32x4 v[4]; float ss = 0.f;
#pragma unroll
                for (int j = 0; j < 4; ++j) { v[j] = xr[64 * j]; ss += (v[j][0] * v[j][0] + v[j][1] * v[j][1]) + (v[j][2] * v[j][2] + v[j][3] * v[j][3]); }
                ss = wave_sum(ss);
                __attribute__((address_space(1))) v2u* o8 = (__attribute__((address_space(1))) v2u*)(XB + (size_t)m * DM) + lane_;
#pragma unroll
                for (int j = 0; j < 4; ++j) { v2u o; o.x = pk2(v[j][0], v[j][1]); o.y = pk2(v[j][2], v[j][3]); o8[64 * j] = o; }
                if (lane_ < 16) ((__attribute__((address_space(1))) float*)part)[(size_t)m * 16 + lane_] = lane_ == 0 ? ss : 0.f; }
            cvt_layer = 0; cvt_first = 0; cvt_n = 6144; cvt_nu = 0;
        } else if (ph == 0) {
            PHASE_PTRS(); pg8::Gemm g{XB, Win_t + (size_t)l * NIN * DM, S, NIN, DM, 256}; pg8::StaticOrder So; So.init(S, NIN, G, bx);
            pg8::EpiScaleBf16 E{P, NIN, part, (LAS float*)(lds + 131072 + 8192)};
            pg8::gemm_phase<pg8::EpiScaleBf16, pg8::StaticOrder, true, true>(lds, g, So, E);
            if (l + 1 < DEPTH) { cvt_layer = l + 1; cvt_first = 0; cvt_n = 1920; cvt_nu = (S / 256) * (NIN / 256); }
        } else if (ph == 1) {
            PHASE_PTRS();
            for (int u = bx; u < S / 64; u += G)
                mixer_unit(lds, u, P, Y, INP(3) + l * 3 * 256, INP(4) + l * 256, INP(5) + (size_t)l * 4 * 128 * 128, INP(6) + l * 4 * 128, tid, wave, lane);
        } else if (ph == 2) {
            PHASE_PTRS(); pg8::Gemm g{Y, Wout_t + (size_t)l * DM * DM, S, DM, DM, 256}; pg8::StaticOrder So; So.init(S, DM, G, bx);
            pg8::EpiResid E{XB, part};
            pg8::gemm_phase<pg8::EpiResid, pg8::StaticOrder, true, true>(lds, g, So, E);
        } else if (ph == 3) {
            PHASE_PTRS(); pg8::Gemm g{XB - 2 * DM, Wup_t + (size_t)l * NUP * DM, 65 * 256, NUP, DM, 254}; pg8::StaticOrder So; So.init(65 * 256, NUP, G, bx);
            pg8::EpiGate E{A, part, INP(11) + (size_t)l * 3 * NUP, (LAS float*)(lds + 131072)};
            pg8::gemm_phase<pg8::EpiGate, pg8::StaticOrder, true, true>(lds, g, So, E);
            if (l + 1 < DEPTH) { cvt_layer = l + 1; cvt_first = 1920; cvt_n = 4224; cvt_nu = 65 * (NUP / 256); }
        } else {
            PHASE_PTRS(); pg8::Gemm g{A, Wdn_t + (size_t)l * DM * DFF, S, DM, DFF, 256}; pg8::StaticOrder So; So.init(S, DM, G, bx);
            pg8::EpiResid E{XB, part};
            pg8::gemm_phase<pg8::EpiResid, pg8::StaticOrder, true, true>(lds, g, So, E);
        }
        if (cvt_layer >= 0) {
            const int first_idle = cvt_nu > 0 ? cvt_nu - ((cvt_nu + G - 1) / G - 1) * G : 0; const bool some_idle = first_idle < G;
            if (!some_idle || bx >= first_idle) { const int nw = (some_idle ? G - first_idle : G) * NWAVES, iw = (some_idle ? bx - first_idle : bx) * NWAVES + wave;
                PHASE_PTRS(); LAS float* scr = (LAS float*)(lds + wave * 16384); int lane_ = lane; asm volatile("" : "+v"(lane_));
                MAKE_CS(); for (int it = iw; it < cvt_n; it += nw) cvt_layer_item(cs, cvt_layer, cvt_first + it, scr, lane_); } }
        if (step < 0) grid.sync(); else xcd_barrier(xbar);
    }
    { const float* nfin = INP(13); const bf16* XBf = (const bf16*)(ws + WS_XB);
      for (int m = gw; m < S; m += NGW) { const __attribute__((address_space(1))) v2u* xr = (const __attribute__((address_space(1))) v2u*)(XBf + (size_t)m * DM) + lane; f32x4 v[4]; float ss = 0.f;
#pragma unroll
        for (int j = 0; j < 4; ++j) { const v2u u = xr[64 * j]; v[j] = (f32x4){bflo(u.x), bfhi(u.x), bflo(u.y), bfhi(u.y)}; ss += (v[j][0] * v[j][0] + v[j][1] * v[j][1]) + (v[j][2] * v[j][2] + v[j][3] * v[j][3]); }
        const float rs = __builtin_amdgcn_rsqf(wave_sum(ss) * (1.0f / 1024.0f) + EPS);
        __attribute__((address_space(1))) f32x4* orow = (__attribute__((address_space(1))) f32x4*)(xo + (size_t)m * DM) + lane;
#pragma unroll
        for (int j = 0; j < 4; ++j) { const f32x4 g = *((const __attribute__((address_space(1))) f32x4*)nfin + lane + 64 * j); orow[64 * j] = v[j] * rs * g; } } }
}

extern "C" void kernel_launch(void* const* d_in, const int* in_sizes, int n_in, void* d_out, int out_size, void* d_ws, size_t ws_size, hipStream_t stream) {
    static int grid = 0;
    if (grid == 0) {
        if (n_in != 14 || out_size != S * DM || ws_size < WS_END) { fprintf(stderr, "kernel_launch: unexpected shapes / workspace (%d inputs, out %d, ws %zu)\n", n_in, out_size, ws_size); grid = -1; return; }
        int dev = 0, cus = 0, per_cu = 0;
        hipGetDevice(&dev); hipDeviceGetAttribute(&cus, hipDeviceAttributeMultiprocessorCount, dev);
        hipFuncSetAttribute((const void*)hybrid_fwd, hipFuncAttributeMaxDynamicSharedMemorySize, LDS_BYTES);
        hipOccupancyMaxActiveBlocksPerMultiprocessor(&per_cu, (const void*)hybrid_fwd, NTHR, LDS_BYTES);
        (void)hipGetLastError();
        if (per_cu < 1) per_cu = 1;
        grid = cus * 1;
    }
    if (grid < 0) return;
    hipMemsetAsync((unsigned char*)d_ws, 0, 16384, stream);
    hipMemsetAsync((unsigned char*)d_ws + WS_XB - 4096, 0, 4096, stream);
    Args a{};
    for (int i = 0; i < 14; ++i) a.in[i] = (const float*)d_in[i];
    a.out = (float*)d_out; a.ws = (unsigned char*)d_ws;
    void* kargs[] = {&a};
    hipError_t e = hipLaunchCooperativeKernel((const void*)hybrid_fwd, dim3(grid), dim3(NTHR), kargs, LDS_BYTES, stream);
    if (e != hipSuccess) fprintf(stderr, "cooperative launch failed: %s (grid %d)\n", hipGetErrorString(e), grid);
}
```

```cpp
#include <hip/hip_runtime.h>
#include <hip/hip_cooperative_groups.h>
#include <cstdio>
#include <cstdint>
namespace cg = cooperative_groups;
namespace pg8 {
#define PG8_LAS __attribute__((address_space(3)))
typedef unsigned short bf16_t;
typedef short bf16x8 __attribute__((ext_vector_type(8)));
typedef float f32x4 __attribute__((ext_vector_type(4)));
typedef unsigned u32x4 __attribute__((ext_vector_type(4)));
typedef unsigned u32x2 __attribute__((ext_vector_type(2)));
constexpr int BM = 256, BK = 64, HALF = 128, HTB = HALF * BK * 2  , STAGE_BYTES = 8 * HTB, NXCD = 8, WGM = 8;

__host__ __device__ __forceinline__ int lds_byte(int r, int c) { const int st = (r >> 4) * 2 + (c >> 5), rr = r & 15, cc = c & 31, ob = rr * 64 + cc * 2; return st * 1024 + (ob ^ (((ob >> 9) & 1) << 5)); }
__host__ __device__ __forceinline__ void stage_rc(int b, int& R, int& C) { const int st = b / 1024, sb = b % 1024, swz = sb ^ (((sb >> 9) & 1) << 5); R = (st >> 1) * 16 + swz / 64; C = (st & 1) * 32 + (swz % 64) / 2; }
__host__ __device__ __forceinline__ int perm32(int rho) { const int n = rho >> 4, i = rho & 15; return 8 * (i >> 2) + 4 * n + (i & 3); }

struct Unit { int pm, pn; };
struct Gemm { const bf16_t* A; const bf16_t* Bt; int M, N, K; int arows; };

struct StaticOrder {
    int nM, nN, nwg, G, c;
    __host__ __device__ void init(int M, int N, int G_, int c_) { nM = M / BM; nN = N / BM; nwg = nM * nN; G = G_; c = c_; }
    __host__ __device__ bool next(int i, Unit& u) const {
        const long L = (long)i * G + c; if (L >= nwg) return false;
        int wgid = (int)L; { const int q = nwg / NXCD, r = nwg % NXCD, xcd = wgid % NXCD, off = wgid / NXCD; wgid = (xcd < r ? xcd * (q + 1) : r * (q + 1) + (xcd - r) * q) + off; }
        const int nig = WGM * nN, gid = wgid / nig, fm = gid * WGM, gsz = (nM - fm) < WGM ? (nM - fm) : WGM;
        u.pm = fm + ((wgid % nig) % gsz); u.pn = (wgid % nig) / gsz; return true;
    }
    __device__ __forceinline__ void a_ready(const Unit&) const {}
    __device__ __forceinline__ void done(const Unit&) const {}
};

__device__ __forceinline__ unsigned cvt_pk_bf16(float lo, float hi) { unsigned r; asm volatile("v_cvt_pk_bf16_f32 %0, %1, %2" : "=v"(r) : "v"(lo), "v"(hi)); return r; }
struct EpiScaleBf16 {
    static constexpr bool PERM = true, AFTER_DRAIN = false, PERMA = false, WIDE = true;
    bf16_t* O; int ldc; const float* part; PG8_LAS float* rsl;
    __device__ __forceinline__ void operator()(const f32x4 (&acc)[2][2][4][2], const Unit& u, int wr, int wc, int fr, int fq) const {
        { const int t = (wr * 4 + wc) * 64 + fq * 16 + fr;
          if (t < 256) { const __attribute__((address_space(1))) f32x4* pp = (const __attribute__((address_space(1))) f32x4*)(part + (size_t)(u.pm * BM + t) * 16); const f32x4 a = pp[0], b = pp[1], c = pp[2], d = pp[3];
              const f32x4 s4 = (a + b) + (c + d); const float ss = (s4[0] + s4[1]) + (s4[2] + s4[3]); rsl[t] = __builtin_amdgcn_rsqf(ss * (1.0f / 1024.0f) + 1e-6f); } }
        asm volatile("s_waitcnt lgkmcnt(0)" ::: "memory"); __builtin_amdgcn_s_barrier(); asm volatile("" ::: "memory");
        const int row0 = u.pm * BM + wr * 64 + fr; const int col0 = u.pn * BM + wc * 64 + 8 * fq;
#pragma unroll
        for (int ai = 0; ai < 2; ++ai)
#pragma unroll
            for (int m = 0; m < 4; ++m) { const int row = row0 + ai * HALF + m * 16;
                const float rs = rsl[ai * HALF + wr * 64 + m * 16 + fr];
                bf16_t* rowp = O + (size_t)row * ldc + col0;
#pragma unroll
                for (int bj = 0; bj < 2; ++bj) { const f32x4 v0 = acc[ai][bj][m][0] * rs, v1 = acc[ai][bj][m][1] * rs;
                    u32x4 w; w.x = cvt_pk_bf16(v0[0], v0[1]); w.y = cvt_pk_bf16(v0[2], v0[3]); w.z = cvt_pk_bf16(v1[0], v1[1]); w.w = cvt_pk_bf16(v1[2], v1[3]);
                    *(__attribute__((address_space(1))) u32x4*)(rowp + bj * 32) = w; } }
    }
};
struct EpiResid {
    static constexpr bool PERM = true, AFTER_DRAIN = false, PERMA = false, WIDE = true;
    bf16_t* xb; float* part;
    __device__ __forceinline__ void operator()(const f32x4 (&acc)[2][2][4][2], const Unit& u, int wr, int wc, int fr, int fq) const {
        const int row0 = u.pm * BM + wr * 64 + fr; const int col0 = u.pn * BM + wc * 64 + 8 * fq;
        u32x4 pre[3][2];
#define PG8_RLOAD(g_) do { const size_t o_ = (size_t)(row0 + ((g_) >> 2) * HALF + ((g_) & 3) * 16) * 1024 + col0; \
            pre[(g_) % 3][0] = *(const __attribute__((address_space(1))) u32x4*)(xb + o_); pre[(g_) % 3][1] = *(const __attribute__((address_space(1))) u32x4*)(xb + o_ + 32); } while (0)
        PG8_RLOAD(0); PG8_RLOAD(1);
#pragma unroll
        for (int g = 0; g < 8; ++g) { const int ai = g >> 2, m = g & 3;
            if (g + 2 < 8) PG8_RLOAD(g + 2);
            asm volatile("" ::: "memory");
            const int row = row0 + ai * HALF + m * 16; const size_t off = (size_t)row * 1024 + col0; float ss = 0.f;
#pragma unroll
            for (int bj = 0; bj < 2; ++bj) { const u32x4 b = pre[g % 3][bj];
                const f32x4 b0 = {__uint_as_float(b.x << 16), __uint_as_float(b.x & 0xffff0000u), __uint_as_float(b.y << 16), __uint_as_float(b.y & 0xffff0000u)};
                const f32x4 b1 = {__uint_as_float(b.z << 16), __uint_as_float(b.z & 0xffff0000u), __uint_as_float(b.w << 16), __uint_as_float(b.w & 0xffff0000u)};
                const f32x4 v0 = acc[ai][bj][m][0] + b0, v1 = acc[ai][bj][m][1] + b1;
                ss += (v0[0] * v0[0] + v0[1] * v0[1]) + (v0[2] * v0[2] + v0[3] * v0[3]) + (v1[0] * v1[0] + v1[1] * v1[1]) + (v1[2] * v1[2] + v1[3] * v1[3]);
                u32x4 w; w.x = cvt_pk_bf16(v0[0], v0[1]); w.y = cvt_pk_bf16(v0[2], v0[3]); w.z = cvt_pk_bf16(v1[0], v1[1]); w.w = cvt_pk_bf16(v1[2], v1[3]);
                *(__attribute__((address_space(1))) u32x4*)(xb + off + bj * 32) = w; }
            ss += __shfl_xor(ss, 16); ss += __shfl_xor(ss, 32);
            if (fq == 0) ((__attribute__((address_space(1))) float*)part)[(size_t)row * 16 + u.pn * 4 + wc] = ss;
            asm volatile("" ::: "memory"); }
#undef PG8_RLOAD
    }
};
#define PG8_DPP(oldv, srcv, ctrl) __builtin_bit_cast(float, __builtin_amdgcn_update_dpp(__builtin_bit_cast(int, (float)(oldv)), __builtin_bit_cast(int, (float)(srcv)), (ctrl), 0xf, 0xf, false))
struct EpiGate {
    static constexpr bool PERM = true, AFTER_DRAIN = false, PERMA = true, WIDE = false;
    bf16_t* Aout; const float* part; const float* fconv; PG8_LAS float* xch;
    __device__ __forceinline__ void operator()(f32x4 (&acc)[2][2][4][2], const Unit& u, int wr, int wc, int fr, int fq) const {
        PG8_LAS float* rsl = xch + 2048;
        { const int t = (wr * 4 + wc) * 64 + fq * 16 + fr;
          if (t < 256) { const int row = u.pm * 254 - 2 + t; const bool ok = row >= 0 && row < 16384; const int rc = ok ? row : 0;
              const __attribute__((address_space(1))) f32x4* pp = (const __attribute__((address_space(1))) f32x4*)(part + (size_t)rc * 16); const f32x4 a = pp[0], b = pp[1], c = pp[2], d = pp[3];
              const f32x4 s4 = (a + b) + (c + d); const float ss = (s4[0] + s4[1]) + (s4[2] + s4[3]);
              rsl[t] = ok ? __builtin_amdgcn_rsqf(ss * (1.0f / 1024.0f) + 1e-6f) : 0.f; } }
        asm volatile("s_waitcnt lgkmcnt(0)" ::: "memory"); __builtin_amdgcn_s_barrier(); asm volatile("" ::: "memory");
        const int ccol = wc * 32 + 8 * fq;
#pragma unroll
        for (int ai = 0; ai < 2; ++ai) { const f32x4 rs4 = *(const PG8_LAS f32x4*)(rsl + ai * HALF + wr * 64 + 4 * fr);
#pragma unroll
            for (int m = 0; m < 4; ++m)
#pragma unroll
                for (int bj = 0; bj < 2; ++bj) { acc[ai][bj][m][0] *= rs4[m]; acc[ai][bj][m][1] *= rs4[m]; } }
        if (fr == 15) {
#pragma unroll
            for (int ai = 0; ai < 2; ++ai)
#pragma unroll
                for (int bj = 0; bj < 2; ++bj)
#pragma unroll
                    for (int n = 0; n < 2; ++n) { *(PG8_LAS f32x4*)(xch + ((2 * ai + wr) * 2 + 0) * 256 + bj * HALF + ccol + 4 * n) = acc[ai][bj][2][n]; *(PG8_LAS f32x4*)(xch + ((2 * ai + wr) * 2 + 1) * 256 + bj * HALF + ccol + 4 * n) = acc[ai][bj][3][n]; }
        }
        asm volatile("s_waitcnt lgkmcnt(0)" ::: "memory"); __builtin_amdgcn_s_barrier(); asm volatile("" ::: "memory");
        const int ch0 = u.pn * HALF + ccol;
#pragma unroll
        for (int ai = 0; ai < 2; ++ai) {
            const int grp = 2 * ai + wr;
            u32x2 keep[4];
#pragma unroll
            for (int n = 0; n < 2; ++n) {
                asm volatile("" ::: "memory");
                const float* fw = fconv + ch0 + 4 * n;
                const f32x4 wg0 = *(const __attribute__((address_space(1))) f32x4*)(fw), wg1 = *(const __attribute__((address_space(1))) f32x4*)(fw + 5632), wg2 = *(const __attribute__((address_space(1))) f32x4*)(fw + 2 * 5632);
                const f32x4 wu0 = *(const __attribute__((address_space(1))) f32x4*)(fw + 2816), wu1 = *(const __attribute__((address_space(1))) f32x4*)(fw + 5632 + 2816), wu2 = *(const __attribute__((address_space(1))) f32x4*)(fw + 2 * 5632 + 2816);
                f32x4 g62 = {0.f, 0.f, 0.f, 0.f}, g63 = g62, u62 = g62, u63 = g62;
                if (grp > 0) { const PG8_LAS float* xb_ = xch + ((grp - 1) * 2) * 256 + ccol + 4 * n;
                    g62 = *(const PG8_LAS f32x4*)(xb_); g63 = *(const PG8_LAS f32x4*)(xb_ + 256); u62 = *(const PG8_LAS f32x4*)(xb_ + HALF); u63 = *(const PG8_LAS f32x4*)(xb_ + 256 + HALF); }
                float o[4][4];
#pragma unroll
                for (int j = 0; j < 4; ++j) {
                    const float g0 = acc[ai][0][0][n][j], g1 = acc[ai][0][1][n][j], g2 = acc[ai][0][2][n][j], g3 = acc[ai][0][3][n][j];
                    const float u0 = acc[ai][1][0][n][j], u1 = acc[ai][1][1][n][j], u2 = acc[ai][1][2][n][j], u3 = acc[ai][1][3][n][j];
                    const float gm1 = PG8_DPP(g63[j], g3, 0x111), gm2 = PG8_DPP(g62[j], g2, 0x111);
                    const float um1 = PG8_DPP(u63[j], u3, 0x111), um2 = PG8_DPP(u62[j], u2, 0x111);
                    const float G0 = wg0[j] * gm2 + wg1[j] * gm1 + wg2[j] * g0, G1 = wg0[j] * gm1 + wg1[j] * g0 + wg2[j] * g1, G2 = wg0[j] * g0 + wg1[j] * g1 + wg2[j] * g2, G3 = wg0[j] * g1 + wg1[j] * g2 + wg2[j] * g3;
                    const float U0 = wu0[j] * um2 + wu1[j] * um1 + wu2[j] * u0, U1 = wu0[j] * um1 + wu1[j] * u0 + wu2[j] * u1, U2 = wu0[j] * u0 + wu1[j] * u1 + wu2[j] * u2, U3 = wu0[j] * u1 + wu1[j] * u2 + wu2[j] * u3;
                    o[0][j] = G0 * __builtin_amdgcn_rcpf(1.0f + __expf(-G0)) * U0; o[1][j] = G1 * __builtin_amdgcn_rcpf(1.0f + __expf(-G1)) * U1;
                    o[2][j] = G2 * __builtin_amdgcn_rcpf(1.0f + __expf(-G2)) * U2; o[3][j] = G3 * __builtin_amdgcn_rcpf(1.0f + __expf(-G3)) * U3; }
#pragma unroll
                for (int m = 0; m < 4; ++m) { const int r = ai * HALF + wr * 64 + 4 * fr + m, row = u.pm * 254 - 2 + r;
                    u32x2 w; w.x = cvt_pk_bf16(o[m][0], o[m][1]); w.y = cvt_pk_bf16(o[m][2], o[m][3]);
                    if (n == 0) keep[m] = w;
                    else if (r >= 2 && row < 16384) { u32x4 w4; w4.x = keep[m].x; w4.y = keep[m].y; w4.z = w.x; w4.w = w.y; *(__attribute__((address_space(1))) u32x4*)(Aout + (size_t)row * 2816 + ch0) = w4; } }
            }
        }
    }
};
template <class Epi, class Sched, bool ALIGN_EPI = false, bool SP2 = false>
__device__ __forceinline__ void gemm_phase(PG8_LAS unsigned char* lds, const Gemm g, const Sched& S, const Epi& E) {
    int tid = threadIdx.x; asm volatile("" : "+v"(tid));
    const int wid = __builtin_amdgcn_readfirstlane(tid >> 6), lane = tid & 63, wr = wid >> 2, wc = wid & 3, fr = lane & 15, fq = lane >> 4;
    const int K = g.K, nt = K / BK;
    unsigned voffA[2], voffB[2];
#pragma unroll
    for (int i = 0; i < 2; ++i) { int R, C; stage_rc(tid * 16 + i * 8192, R, C); const int Rb = Epi::WIDE ? (64 * (R >> 5) + perm32(R & 31)) : Epi::PERM ? ((R & ~31) + perm32(R & 31)) : R;
        const int Ra = Epi::PERMA ? ((R & ~63) + 4 * (R & 15) + ((R >> 4) & 3)) : R;
        voffA[i] = (unsigned)(Ra * K + C) * 2u; voffB[i] = (unsigned)(Rb * K + C) * 2u; }
    const size_t kstep = (size_t)(BK * 2);
    const size_t hstep = (size_t)HALF * K * 2;
    const size_t hstepB = Epi::WIDE ? (size_t)32 * K * 2 : hstep;
    const size_t tstep = 2 * hstep;
    const size_t tstepA = (size_t)g.arows * K * 2;
    const unsigned ldsw = (unsigned)wid * 1024u;
    const int aoff = lds_byte(wr * 64 + fr, fq * 8), boff = lds_byte(wc * 32 + fr, fq * 8);
#define PG8_SA(b, h) (((b) * 2 + (h)) * HTB)
#define PG8_SB(b, h) ((4 + (b) * 2 + (h)) * HTB)
#define PG8_STAGE(bufoff, gbase, voff) do { _Pragma("unroll") for (int _i = 0; _i < 2; ++_i) \
        __builtin_amdgcn_global_load_lds((const unsigned*)((const char*)(gbase) + (voff)[_i]), (PG8_LAS unsigned*)(lds + (bufoff) + ldsw + _i * 8192), 16, 0, 0); } while (0)
#define PG8_LDA(dst, b, h) do { _Pragma("unroll") for (int m = 0; m < 4; ++m) _Pragma("unroll") for (int k = 0; k < 2; ++k) dst[m][k] = *(const PG8_LAS bf16x8*)(lds + PG8_SA(b, h) + aoff + m * 2048 + k * 1024); } while (0)
#define PG8_LDB(dst, b, h) do { _Pragma("unroll") for (int n = 0; n < 2; ++n) _Pragma("unroll") for (int k = 0; k < 2; ++k) dst[n][k] = *(const PG8_LAS bf16x8*)(lds + PG8_SB(b, h) + boff + n * 2048 + k * 1024); } while (0)
#define PG8_MMA(ai, bj, At, Bt) do { __builtin_amdgcn_s_setprio(1); _Pragma("unroll") for (int m = 0; m < 4; ++m) _Pragma("unroll") for (int n = 0; n < 2; ++n) _Pragma("unroll") for (int k = 0; k < 2; ++k) \
        acc[ai][bj][m][n] = __builtin_amdgcn_mfma_f32_16x16x32_bf16(Bt[n][k], At[m][k], acc[ai][bj][m][n], 0, 0, 0); __builtin_amdgcn_s_setprio(0); } while (0)
#define PG8_WAIT_V(n) asm volatile("s_waitcnt vmcnt(" #n ")" ::: "memory")
#define PG8_WAIT_L(n) asm volatile("s_waitcnt lgkmcnt(" #n ")" ::: "memory")
#define PG8_BAR __builtin_amdgcn_s_barrier()
#define PG8_SCHED __builtin_amdgcn_sched_barrier(0)
    Unit cur, nxt; int ui = 0;
    if (!S.next(0, cur)) return;
    f32x4 acc[2][2][4][2];
#pragma unroll
    for (int a = 0; a < 2; ++a)
#pragma unroll
        for (int b = 0; b < 2; ++b)
#pragma unroll
            for (int m = 0; m < 4; ++m)
#pragma unroll
                for (int n = 0; n < 2; ++n) acc[a][b][m][n] = (f32x4){0.f, 0.f, 0.f, 0.f};
    bf16x8 At[4][2], B0[2][2], B1[2][2];
    const char* cA = (const char*)g.A + (size_t)cur.pm * tstepA; const char* cB = (const char*)g.Bt + (size_t)cur.pn * tstep;
    S.a_ready(cur);
    if constexpr (SP2) {
        PG8_STAGE(PG8_SB(0, 0), cB, voffB); PG8_STAGE(PG8_SB(0, 1), cB + hstepB, voffB); PG8_STAGE(PG8_SA(0, 0), cA, voffA); PG8_STAGE(PG8_SA(0, 1), cA + hstep, voffA);
        if (wr == 1) PG8_BAR;
        PG8_WAIT_V(2); PG8_BAR;
        PG8_STAGE(PG8_SB(1, 0), cB + kstep, voffB); PG8_STAGE(PG8_SA(1, 0), cA + kstep, voffA); PG8_STAGE(PG8_SB(1, 1), cB + hstepB + kstep, voffB);
        PG8_WAIT_V(6); PG8_BAR;
    } else {
        PG8_STAGE(PG8_SB(0, 0), cB, voffB); PG8_STAGE(PG8_SA(0, 0), cA, voffA); PG8_STAGE(PG8_SB(0, 1), cB + hstepB, voffB); PG8_STAGE(PG8_SA(0, 1), cA + hstep, voffA);
        if (wr == 1) PG8_BAR;
        PG8_WAIT_V(4); PG8_BAR;
        PG8_STAGE(PG8_SB(1, 0), cB + kstep, voffB); PG8_STAGE(PG8_SA(1, 0), cA + kstep, voffA); PG8_STAGE(PG8_SB(1, 1), cB + hstepB + kstep, voffB);
        PG8_WAIT_V(6); PG8_BAR;
    }
    for (;;) {
        const bool has_next = S.next(ui + 1, nxt);
        const char* nA = has_next ? (const char*)g.A + (size_t)nxt.pm * tstepA : cA; const char* nB = has_next ? (const char*)g.Bt + (size_t)nxt.pn * tstep : cB;
        for (int t = 0; t < nt; t += 2) {
            const bool last = (t == nt - 2);
            const char* a1 = cA + (size_t)(t + 1) * kstep;
            const char* a2 = last ? nA : cA + (size_t)(t + 2) * kstep; const char* b2 = last ? nB : cB + (size_t)(t + 2) * kstep;
            const char* a3 = a2 + kstep; const char* b3 = b2 + kstep;
            if (last && has_next) S.a_ready(nxt);
            if constexpr (SP2) {
            PG8_LDB(B0, 0, 0); PG8_LDB(B1, 0, 1); PG8_SCHED; PG8_LDA(At, 0, 0); PG8_STAGE(PG8_SA(1, 1), a1 + hstep, voffA);
            PG8_WAIT_V(8); PG8_WAIT_L(0); PG8_BAR; PG8_MMA(0, 0, At, B0); PG8_MMA(0, 1, At, B1); PG8_BAR; PG8_SCHED;
            PG8_LDA(At, 0, 1); PG8_STAGE(PG8_SB(0, 0), b2, voffB); PG8_STAGE(PG8_SB(0, 1), b2 + hstepB, voffB); PG8_STAGE(PG8_SA(0, 0), a2, voffA);
            PG8_WAIT_V(8); PG8_WAIT_L(0); PG8_BAR; PG8_MMA(1, 0, At, B0); PG8_MMA(1, 1, At, B1); PG8_BAR; PG8_SCHED;
            PG8_LDB(B0, 1, 0); PG8_LDB(B1, 1, 1); PG8_SCHED; PG8_LDA(At, 1, 0); PG8_STAGE(PG8_SA(0, 1), a2 + hstep, voffA);
            PG8_WAIT_V(8); PG8_WAIT_L(0); PG8_BAR; PG8_MMA(0, 0, At, B0); PG8_MMA(0, 1, At, B1); PG8_BAR; PG8_SCHED;
            PG8_LDA(At, 1, 1); PG8_STAGE(PG8_SB(1, 0), b3, voffB); PG8_STAGE(PG8_SB(1, 1), b3 + hstepB, voffB); PG8_STAGE(PG8_SA(1, 0), a3, voffA);
            PG8_WAIT_V(8); PG8_WAIT_L(0); PG8_BAR; PG8_MMA(1, 0, At, B0); PG8_MMA(1, 1, At, B1); PG8_BAR; PG8_SCHED;
            } else {
            PG8_LDB(B0, 0, 0); PG8_SCHED; PG8_LDA(At, 0, 0); PG8_STAGE(PG8_SA(1, 1), a1 + hstep, voffA);
            PG8_WAIT_L(8); PG8_BAR; PG8_WAIT_L(0); PG8_MMA(0, 0, At, B0); PG8_BAR; PG8_SCHED;
            PG8_LDB(B1, 0, 1); PG8_STAGE(PG8_SB(0, 0), b2, voffB);
            PG8_BAR; PG8_WAIT_L(0); PG8_MMA(0, 1, At, B1); PG8_BAR;
            PG8_LDA(At, 0, 1); PG8_STAGE(PG8_SA(0, 0), a2, voffA);
            PG8_BAR; PG8_WAIT_L(0); PG8_MMA(1, 0, At, B0); PG8_BAR; PG8_SCHED;
            PG8_STAGE(PG8_SB(0, 1), b2 + hstepB, voffB);
            PG8_WAIT_V(6); PG8_BAR; PG8_MMA(1, 1, At, B1); PG8_BAR;
            PG8_LDB(B0, 1, 0); PG8_SCHED; PG8_LDA(At, 1, 0); PG8_STAGE(PG8_SA(0, 1), a2 + hstep, voffA);
            PG8_WAIT_L(8); PG8_BAR; PG8_WAIT_L(0); PG8_MMA(0, 0, At, B0); PG8_BAR; PG8_SCHED;
            PG8_LDB(B1, 1, 1); PG8_STAGE(PG8_SB(1, 0), b3, voffB);
            PG8_BAR; PG8_WAIT_L(0); PG8_MMA(0, 1, At, B1); PG8_BAR;
            PG8_LDA(At, 1, 1); PG8_STAGE(PG8_SA(1, 0), a3, voffA);
            PG8_BAR; PG8_WAIT_L(0); PG8_MMA(1, 0, At, B0); PG8_BAR; PG8_SCHED;
            PG8_STAGE(PG8_SB(1, 1), b3 + hstepB, voffB);
            PG8_WAIT_V(6); PG8_BAR; PG8_MMA(1, 1, At, B1); PG8_BAR;
            }
        }
        if constexpr (ALIGN_EPI) { if (wr == 0) PG8_BAR; }
        if constexpr (!Epi::AFTER_DRAIN) { E(acc, cur, wr, wc, fr, fq); S.done(cur); }
        if (!has_next) break;
#pragma unroll
        for (int a = 0; a < 2; ++a)
#pragma unroll
            for (int b = 0; b < 2; ++b)
#pragma unroll
                for (int m = 0; m < 4; ++m)
#pragma unroll
                    for (int n = 0; n < 2; ++n) acc[a][b][m][n] = (f32x4){0.f, 0.f, 0.f, 0.f};
        cur = nxt; cA = nA; cB = nB; ++ui;
        if constexpr (ALIGN_EPI) { if (wr == 1) PG8_BAR; }
    }
    PG8_WAIT_V(0);
    if constexpr (!ALIGN_EPI) { if (wr == 0) PG8_BAR; }
    PG8_BAR;
    if constexpr (Epi::AFTER_DRAIN) { E.fused(acc, cur, wr, wc, fr, fq, lds, wid, lane); S.done(cur); }
#undef PG8_SA
#undef PG8_SB
#undef PG8_STAGE
#undef PG8_LDA
#undef PG8_LDB
#undef PG8_MMA
#undef PG8_WAIT_V
#undef PG8_WAIT_L
#undef PG8_BAR
#undef PG8_SCHED
}
}
constexpr int S = 16384, DM = 1024, DEPTH = 4, NIN = 2816, DFF = 2816, NUP = 5632;
constexpr float EPS = 1e-6f;
constexpr int NWAVES = 8, NTHR = 512;
constexpr size_t MiB = 1u << 20;
constexpr size_t WS_WIN = 1 * MiB, WS_WOUT = 23 * MiB, WS_WUP = 31 * MiB, WS_WDN = 75 * MiB;
constexpr size_t WS_PART = 97 * MiB;
constexpr size_t WS_BAR = 98 * MiB;
constexpr size_t WS_XB = 98 * MiB + 16384 + 4096;
constexpr size_t WS_P = 131 * MiB;
constexpr size_t WS_Y = 219 * MiB;
constexpr size_t WS_A = 131 * MiB;
constexpr size_t WS_END = 251 * MiB;
constexpr int LDS_BYTES = 147456;
#define LAS __attribute__((address_space(3)))
typedef unsigned short bf16;
typedef unsigned v4u __attribute__((ext_vector_type(4)));
typedef unsigned v2u __attribute__((ext_vector_type(2)));
typedef float f32x4 __attribute__((ext_vector_type(4)));
typedef float f32x16 __attribute__((ext_vector_type(16)));
typedef short bf16x8 __attribute__((ext_vector_type(8)));
#define LDS_WAIT() asm volatile("s_waitcnt lgkmcnt(0)" ::: "memory")
__device__ __forceinline__ unsigned pk2(float lo, float hi) { return pg8::cvt_pk_bf16(lo, hi); }
__device__ __forceinline__ float bflo(unsigned u) { return __uint_as_float(u << 16); }
__device__ __forceinline__ float bfhi(unsigned u) { return __uint_as_float(u & 0xffff0000u); }
__device__ __forceinline__ float bf1(bf16 v) { return __uint_as_float((unsigned)v << 16); }
#define WS_DPP(v, ctrl) __builtin_bit_cast(float, __builtin_amdgcn_update_dpp(0, __builtin_bit_cast(int, (float)(v)), (ctrl), 0xf, 0xf, true))
__device__ __forceinline__ float wave_sum(float v) {
    v += WS_DPP(v, 0xB1); v += WS_DPP(v, 0x4E); v += WS_DPP(v, 0x141); v += WS_DPP(v, 0x140);
    const int iv = __builtin_bit_cast(int, v);
    const float a = __builtin_bit_cast(float, __builtin_amdgcn_readlane(iv, 0)), b = __builtin_bit_cast(float, __builtin_amdgcn_readlane(iv, 16));
    const float c = __builtin_bit_cast(float, __builtin_amdgcn_readlane(iv, 32)), d = __builtin_bit_cast(float, __builtin_amdgcn_readlane(iv, 48));
    return (a + b) + (c + d);
}

__device__ __forceinline__ void cvt_item(const float* W, int K, int N, bf16* WT, const float* gain, int mode, LAS float* scr, int item, int lane) {
    const int nblk = N / 32, kb = item / nblk, nb = item % nblk, k0 = 64 * kb, n0 = 32 * nb;
    float wv[32];
#pragma unroll
    for (int i = 0; i < 32; ++i) { const int kk = 2 * i + (lane >> 5); wv[i] = __builtin_nontemporal_load(((const __attribute__((address_space(1))) float*)W) + (size_t)(k0 + kk) * N + n0 + (lane & 31)); }
#pragma unroll
    for (int i = 0; i < 32; ++i) { const int kk = 2 * i + (lane >> 5); const float g = gain ? ((const __attribute__((address_space(1))) float*)gain)[k0 + kk] : 1.0f; scr[kk * 33 + (lane & 31)] = wv[i] * g; }
    LDS_WAIT(); asm volatile("" ::: "memory");
    const float cs = (mode == 1 && n0 >= 1280 && n0 < 1792) ? 0.125f * 1.4426950408889634f : 1.0f;
    int rb = n0;
    if (mode == 2) { rb = (n0 < DFF) ? 256 * (n0 / 128) + (n0 % 128) : 256 * ((n0 - DFF) / 128) + 128 + ((n0 - DFF) % 128); }
    const int c = lane & 7;
#pragma unroll
    for (int j = 0; j < 4; ++j) { const int n = (lane >> 3) + 8 * j; const LAS float* s = scr + (8 * c) * 33 + n;
        v4u o; o.x = pk2(s[0 * 33] * cs, s[1 * 33] * cs); o.y = pk2(s[2 * 33] * cs, s[3 * 33] * cs); o.z = pk2(s[4 * 33] * cs, s[5 * 33] * cs); o.w = pk2(s[6 * 33] * cs, s[7 * 33] * cs);
        __builtin_nontemporal_store(o, (__attribute__((address_space(1))) v4u*)(WT + (size_t)(rb + n) * K + k0 + 8 * c)); }
    LDS_WAIT(); asm volatile("" ::: "memory");
}

typedef __attribute__((address_space(1))) unsigned gu32;
#define XB_TMO      128
#define XB_XCNT(j)  (256  + 64 * (j))
#define XB_XSUB(j)  (1280 + 64 * (j))
#define XB_XGEN(j)  (2304 + 64 * (j))
#define XB_TOP      3328
#define XB_TOPGEN   3392
#define XCD_BAR_WORDS 3456
#define XB_SPIN_CAP (1u << 18)

__device__ __forceinline__ unsigned xb_ld(unsigned* p)              { return __hip_atomic_load(p, __ATOMIC_RELAXED, __HIP_MEMORY_SCOPE_AGENT); }
__device__ __forceinline__ unsigned xb_add(unsigned* p, unsigned v) { return __hip_atomic_fetch_add(p, v, __ATOMIC_RELAXED, __HIP_MEMORY_SCOPE_AGENT); }
__device__ __forceinline__ unsigned xb_xcc_id() { return (unsigned)__builtin_amdgcn_s_getreg((3 << 11) | 20) & 0xFu; }
#define XB_SPIN(cond, bar) do { unsigned _sp = 0; while (cond) { __builtin_amdgcn_s_sleep(1); \
    if ((++_sp & 255u) == 0u) { if (xb_ld(&(bar)[XB_TMO])) break; if (_sp > XB_SPIN_CAP) { atomicAdd(&(bar)[XB_TMO], 1u); break; } } } } while (0)

struct XcdBarrier {
    unsigned* bar; unsigned x;
    volatile LAS unsigned* st;
};

__device__ __forceinline__ XcdBarrier xcd_barrier_post(unsigned* bar, volatile LAS unsigned* st) {
    XcdBarrier b; b.bar = bar; b.x = xb_xcc_id(); b.st = st;
    if (threadIdx.x == 0) (void)xb_add(&bar[XB_XCNT(b.x)], 1u);
    return b;
}
__device__ __forceinline__ void xcd_barrier_complete(unsigned* bar, unsigned x, unsigned& nloc, unsigned& nx) {
    const unsigned G = gridDim.x * gridDim.y * gridDim.z;
    unsigned sum, cnt, mine, sp = 0u;
    for (;;) {
        sum = 0u; cnt = 0u; mine = 0u;
#pragma unroll
        for (unsigned j = 0; j < 16; ++j) { const unsigned c = xb_ld(&bar[XB_XCNT(j)]); sum += c; cnt += (c > 0u) ? 1u : 0u; mine = (j == x) ? c : mine; }
        if (sum == G) break;
        __builtin_amdgcn_s_sleep(1);
        if ((++sp & 255u) == 0u) { if (xb_ld(&bar[XB_TMO])) break; if (sp > XB_SPIN_CAP) { atomicAdd(&bar[XB_TMO], 1u); break; } }
    }
    nloc = mine > 0u ? mine : 1u; nx = cnt > 0u ? cnt : 1u;
}

__device__ __forceinline__ void xcd_barrier(const XcdBarrier& b) {
    asm volatile("s_waitcnt vmcnt(0)" ::: "memory");
    __syncthreads();
    if (threadIdx.x == 0) {
        unsigned* bar = b.bar;
        __builtin_amdgcn_s_waitcnt(0);
        unsigned nloc = b.st[0], nx = b.st[1];
        if (nloc == 0u) { xcd_barrier_complete(bar, b.x, nloc, nx); b.st[0] = nloc; b.st[1] = nx; }
        const unsigned old = xb_add(&bar[XB_XSUB(b.x)], 1u);
        const unsigned gen = old / nloc;
        if (old + 1u == (gen + 1u) * nloc) {
            __builtin_amdgcn_fence(__ATOMIC_RELEASE, "agent");
            asm volatile("s_waitcnt vmcnt(0)" ::: "memory");
            const unsigned og = xb_add(&bar[XB_TOP], 1u);
            const unsigned tg = og / nx;
            if (og + 1u == (tg + 1u) * nx) xb_add(&bar[XB_TOPGEN], 1u);
            else XB_SPIN(xb_ld(&bar[XB_TOPGEN]) == tg, bar);
            __builtin_amdgcn_fence(__ATOMIC_ACQUIRE, "agent");
            xb_add(&bar[XB_XGEN(b.x)], 1u);
            asm volatile("s_waitcnt vmcnt(0)" ::: "memory");
        } else {
            XB_SPIN(xb_ld(&bar[XB_XGEN(b.x)]) == gen, bar);
            __builtin_amdgcn_fence(__ATOMIC_ACQUIRE, "agent");
            asm volatile("s_waitcnt vmcnt(0)" ::: "memory");
        }
    }
    __syncthreads();
}

struct CvtSrc { const float *w_in, *w_out, *w_up, *w_down, *norm_mix, *out_norm, *norm_ffn; bf16 *Win_t, *Wout_t, *Wup_t, *Wdn_t; };
__device__ __forceinline__ void cvt_layer_item(const CvtSrc& c, int l, int r, LAS float* scr, int lane) {
    const float* W; bf16* WT; const float* gain; int K, N, mode;
    if (r < 1408) { W = c.w_in + (size_t)l * DM * NIN; K = DM; N = NIN; WT = c.Win_t + (size_t)l * NIN * DM; gain = c.norm_mix + l * DM; mode = 1; }
    else if (r < 1920) { r -= 1408; W = c.w_out + (size_t)l * DM * DM; K = DM; N = DM; WT = c.Wout_t + (size_t)l * DM * DM; gain = c.out_norm + l * DM; mode = 0; }
    else if (r < 4736) { r -= 1920; W = c.w_up + (size_t)l * DM * NUP; K = DM; N = NUP; WT = c.Wup_t + (size_t)l * NUP * DM; gain = c.norm_ffn + l * DM; mode = 2; }
    else { r -= 4736; W = c.w_down + (size_t)l * DFF * DM; K = DFF; N = DM; WT = c.Wdn_t + (size_t)l * DM * DFF; gain = nullptr; mode = 0; }
    cvt_item(W, K, N, WT, gain, mode, scr, r, lane);
}
__device__ __forceinline__ const float* ldptr(const volatile LAS unsigned* PT, int k) {
    const unsigned lo = __builtin_amdgcn_readfirstlane(PT[2 * k]), hi = __builtin_amdgcn_readfirstlane(PT[2 * k + 1]);
    return (const float*)(const __attribute__((address_space(1))) float*)(((unsigned long long)hi << 32) | lo);
}
struct Args { const float* in[14]; float* out; unsigned char* ws; };

__device__ __forceinline__ void norm_store_rows(const LAS float* tile, bf16* Y, int t0, int coff, int wave, int lane) {
#pragma unroll 2
    for (int i = 0; i < 8; ++i) { const int r = wave * 8 + i; const f32x4 v = *(const LAS f32x4*)(tile + r * 260 + lane * 4);
        const float ss = wave_sum((v[0] * v[0] + v[1] * v[1]) + (v[2] * v[2] + v[3] * v[3]));
        const float rs = __builtin_amdgcn_rsqf(ss * (1.0f / 256.0f) + EPS);
        v2u o; o.x = pk2(v[0] * rs, v[1] * rs); o.y = pk2(v[2] * rs, v[3] * rs);
        *(__attribute__((address_space(1))) v2u*)(Y + (size_t)(t0 + r) * DM + coff + lane * 4) = o; }
}

typedef short v4i16_t __attribute__((ext_vector_type(4)));
__device__ __forceinline__ bf16x8 vtfrag(const LAS bf16* p) {
    const v4i16_t lo = __builtin_amdgcn_ds_read_tr16_b64_v4i16((LAS v4i16_t*)p), hi = __builtin_amdgcn_ds_read_tr16_b64_v4i16((LAS v4i16_t*)(p + 4 * 96));
    return (bf16x8){lo[0], lo[1], lo[2], lo[3], hi[0], hi[1], hi[2], hi[3]};
}
__device__ __forceinline__ void mixer_unit(LAS unsigned char* lds, int unit, const bf16* P, bf16* Y, const float* conv_w, const float* sgu_norm, const float* sgu_w, const float* sgu_b, int tid, int wave, int lane) {
    const int t0 = unit * 64;
    asm volatile("" : "+v"(tid), "+v"(lane));
    LAS bf16* vnT = (LAS bf16*)lds;
    LAS float* tile = (LAS float*)(lds + 69632);
    LAS float* sm_ss = (LAS float*)(lds + 69632 + 66560);
    {
        const int hd = wave, r = lane & 31, h = lane >> 5;
        const int pr = (r & 0x13) | ((r & 4) << 1) | ((r & 8) >> 1);
        LAS bf16* Vr = (LAS bf16*)(lds + wave * 6144);
        const LAS bf16* vtb = Vr + (8 * h + ((lane & 15) >> 2)) * 96 + 16 * ((lane >> 4) & 1) + 4 * (lane & 3);
        f32x16 oacc[2][2];
        bf16x8 kfn[4]; v4u vvn[4];
        { const bf16* kp = P + (size_t)(t0 + 32 + pr) * NIN + 1792 + hd * 64 + 8 * h;
#pragma unroll
          for (int ks = 0; ks < 4; ++ks) kfn[ks] = *(const __attribute__((address_space(1))) bf16x8*)(kp + 16 * ks);
#pragma unroll
          for (int i = 0; i < 4; ++i) vvn[i] = *(const __attribute__((address_space(1))) v4u*)(P + (size_t)(t0 + 32 + (lane >> 3) + 8 * i) * NIN + 2304 + hd * 64 + 8 * (lane & 7)); }
        bf16x8 kf2[4]; v4u vv2[4];
        { const bf16* kp = P + (size_t)(t0 + pr) * NIN + 1792 + hd * 64 + 8 * h;
#pragma unroll
          for (int ks = 0; ks < 4; ++ks) kf2[ks] = *(const __attribute__((address_space(1))) bf16x8*)(kp + 16 * ks);
#pragma unroll
          for (int i = 0; i < 4; ++i) vv2[i] = *(const __attribute__((address_space(1))) v4u*)(P + (size_t)(t0 + (lane >> 3) + 8 * i) * NIN + 2304 + hd * 64 + 8 * (lane & 7)); }
        LAS bf16x8* Qs = (LAS bf16x8*)(lds + 49152 + wave * 8192);
#pragma unroll
        for (int ks = 0; ks < 4; ++ks) { Qs[ks * 64 + lane] = *(const __attribute__((address_space(1))) bf16x8*)(P + (size_t)(t0 + r) * NIN + 1280 + hd * 64 + 16 * ks + 8 * h); Qs[(4 + ks) * 64 + lane] = *(const __attribute__((address_space(1))) bf16x8*)(P + (size_t)(t0 + 32 + r) * NIN + 1280 + hd * 64 + 16 * ks + 8 * h); }
#pragma unroll
        for (int a = 0; a < 2; ++a)
#pragma unroll
            for (int b = 0; b < 2; ++b) oacc[a][b] = (f32x16){};
        float lsA = 1.0f, lsB = 1.0f; bool actA = true, actB = true;
#define SB_CHAIN(Z, O0, O1, SURV, DIAGV) do { \
            float om[16], be[16]; \
            _Pragma("unroll") for (int jj = 0; jj < 16; ++jj) { const float zz = Z[jj]; const float ex = __builtin_amdgcn_exp2f(-fabsf(zz)); const float rr = __builtin_amdgcn_rcpf(1.0f + ex); const float er = ex * rr; \
                be[jj] = zz >= 0.f ? rr : er; om[jj] = zz >= 0.f ? er : rr; } \
            if (DIAGV) { _Pragma("unroll") for (int jj = 0; jj < 16; ++jj) { const int keyl = 16 * (jj >> 3) + 8 * h + (jj & 7); const bool valid = keyl < r; om[jj] = valid ? om[jj] : 1.0f; be[jj] = valid ? be[jj] : 0.f; } } \
            float sl[8], sh[8]; sl[7] = 1.0f; sh[7] = 1.0f; \
            _Pragma("unroll") for (int i = 6; i >= 0; --i) { sl[i] = sl[i + 1] * om[i + 1]; sh[i] = sh[i + 1] * om[8 + i + 1]; } \
            const float pl = sl[0] * om[0], ph = sh[0] * om[8]; \
            const float plx = __shfl_xor(pl, 32), phx = __shfl_xor(ph, 32); \
            const float hh = ph * phx; \
            const float sc_hi = SURV * (h ? 1.0f : phx), sc_lo = SURV * (hh * (h ? 1.0f : plx)); \
            unsigned wp[8]; \
            _Pragma("unroll") for (int i = 0; i < 8; i += 2) { wp[i >> 1] = pk2(be[i] * sl[i] * sc_lo, be[i + 1] * sl[i + 1] * sc_lo); wp[4 + (i >> 1)] = pk2(be[8 + i] * sh[i] * sc_hi, be[9 + i] * sh[i + 1] * sc_hi); } \
            SURV *= (pl * plx) * hh; \
            const bf16x8 w0 = __builtin_bit_cast(bf16x8, (v4u){wp[0], wp[1], wp[2], wp[3]}), w1 = __builtin_bit_cast(bf16x8, (v4u){wp[4], wp[5], wp[6], wp[7]}); \
            O0 = __builtin_amdgcn_mfma_f32_32x32x16_bf16(vtfrag(vtb), w0, O0, 0, 0, 0); \
            O0 = __builtin_amdgcn_mfma_f32_32x32x16_bf16(vtfrag(vtb + 16 * 96), w1, O0, 0, 0, 0); \
            O1 = __builtin_amdgcn_mfma_f32_32x32x16_bf16(vtfrag(vtb + 32), w0, O1, 0, 0, 0); \
            O1 = __builtin_amdgcn_mfma_f32_32x32x16_bf16(vtfrag(vtb + 16 * 96 + 32), w1, O1, 0, 0, 0); } while (0)
        for (int k0 = t0 + 32;; k0 -= 32) {
            const bool doA = actA && (k0 <= t0);
            f32x16 zB = {}, zA = {};
            if (actB) {
#pragma unroll
                for (int ks = 0; ks < 4; ++ks) zB = __builtin_amdgcn_mfma_f32_32x32x16_bf16(kfn[ks], Qs[(4 + ks) * 64 + lane], zB, 0, 0, 0); }
            if (doA) {
#pragma unroll
                for (int ks = 0; ks < 4; ++ks) zA = __builtin_amdgcn_mfma_f32_32x32x16_bf16(kfn[ks], Qs[ks * 64 + lane], zA, 0, 0, 0); }
#pragma unroll
            for (int i = 0; i < 4; ++i) { const int key = (lane >> 3) + 8 * i, c = lane & 7; *(LAS v4u*)(Vr + key * 96 + 8 * c) = vvn[i]; }
#pragma unroll
            for (int ks = 0; ks < 4; ++ks) kfn[ks] = kf2[ks];
#pragma unroll
            for (int i = 0; i < 4; ++i) vvn[i] = vv2[i];
            if (k0 >= 64) { const bf16* kp = P + (size_t)(k0 - 64 + pr) * NIN + 1792 + hd * 64 + 8 * h;
#pragma unroll
                for (int ks = 0; ks < 4; ++ks) kf2[ks] = *(const __attribute__((address_space(1))) bf16x8*)(kp + 16 * ks);
#pragma unroll
                for (int i = 0; i < 4; ++i) vv2[i] = *(const __attribute__((address_space(1))) v4u*)(P + (size_t)(k0 - 64 + (lane >> 3) + 8 * i) * NIN + 2304 + hd * 64 + 8 * (lane & 7)); }
            if (actB) { const bool dg = (k0 == t0 + 32); SB_CHAIN(zB, oacc[1][0], oacc[1][1], lsB, dg);
                if (__builtin_amdgcn_ballot_w64(lsB > 1e-37f) == 0ull) actB = false; }
            if (doA) { const bool dg = (k0 == t0); SB_CHAIN(zA, oacc[0][0], oacc[0][1], lsA, dg);
                if (__builtin_amdgcn_ballot_w64(lsA > 1e-37f) == 0ull) actA = false; }
            if (k0 < 32 || !(actA || actB)) break;
        }
#undef SB_CHAIN
#pragma unroll
        for (int qh = 0; qh < 2; ++qh) { float ss = 0.f;
#pragma unroll
            for (int j = 0; j < 16; ++j) ss += oacc[qh][0][j] * oacc[qh][0][j] + oacc[qh][1][j] * oacc[qh][1][j];
            ss += __shfl_xor(ss, 32);
            if (h == 0) sm_ss[(32 * qh + r) * 8 + hd] = ss; }
        LDS_WAIT(); __syncthreads();
#pragma unroll
        for (int qh = 0; qh < 2; ++qh) {
            const f32x4 sa = *(const LAS f32x4*)(sm_ss + (32 * qh + r) * 8), sb = *(const LAS f32x4*)(sm_ss + (32 * qh + r) * 8 + 4);
            const float tot = ((sa[0] + sa[1]) + (sa[2] + sa[3])) + ((sb[0] + sb[1]) + (sb[2] + sb[3]));
            const float rs = __builtin_amdgcn_rsqf(tot * (1.0f / 512.0f) + EPS);
            bf16* yp = Y + (size_t)(t0 + 32 * qh + r) * DM + 512 + hd * 64 + 8 * h;
#pragma unroll
            for (int db = 0; db < 2; ++db)
#pragma unroll
                for (int kk = 0; kk < 2; ++kk) { const f32x16& o = oacc[qh][db]; const int ga = 8 * kk, gb2 = 8 * kk + 4;
                    const unsigned ax = pk2(o[ga + 0] * rs, o[ga + 1] * rs), ay = pk2(o[ga + 2] * rs, o[ga + 3] * rs), bx_ = pk2(o[gb2 + 0] * rs, o[gb2 + 1] * rs), by_ = pk2(o[gb2 + 2] * rs, o[gb2 + 3] * rs);
                    auto sx = __builtin_amdgcn_permlane32_swap(ax, bx_, false, false), sy = __builtin_amdgcn_permlane32_swap(ay, by_, false, false);
                    v4u w; w.x = sx[0]; w.y = sy[0]; w.z = sx[1]; w.w = sy[1];
                    *(__attribute__((address_space(1))) v4u*)(yp + 32 * db + 16 * kk) = w; }
        }
    }
    const int c8 = (tid & 31) * 8, rg = tid >> 5, tb = t0 + 4 * rg;
    v4u gb[4], gc[6], hc[6];
#pragma unroll
    for (int i = 0; i < 6; ++i) { const int t = tb - 2 + i; const bool ok = t >= 0; const bf16* rp = P + (size_t)(ok ? t : 0) * NIN;
        gc[i] = ok ? *(const __attribute__((address_space(1))) v4u*)(rp + 256 + c8) : (v4u){0u, 0u, 0u, 0u}; hc[i] = ok ? *(const __attribute__((address_space(1))) v4u*)(rp + 512 + c8) : (v4u){0u, 0u, 0u, 0u};
        if (i >= 2) gb[i - 2] = *(const __attribute__((address_space(1))) v4u*)(rp + c8); }
    const int tc = t0 & ~127, dt = t0 - tc, ns = dt + 64;
    v2u uu[16];
#pragma unroll
    for (int i = 0; i < 16; ++i) { const int s = wave + 8 * i; uu[i] = (s < ns) ? *(const __attribute__((address_space(1))) v2u*)(P + (size_t)(tc + s) * NIN + 1024 + lane * 4) : (v2u){0u, 0u}; }
    const int h = wave >> 1, rh = wave & 1, r32 = lane & 31, hi = lane >> 5;
    const int tcl = dt + 32 * rh + r32;
    const int nk = (dt + 32 * rh + 32) >> 4;
    f32x4 wa[8], wb[8];
    { const float* wrow = sgu_w + ((size_t)h * 128 + tcl) * 128;
#pragma unroll
      for (int ks = 0; ks < 8; ++ks) { const int s0 = ks * 16 + 8 * hi; if (ks < nk) { wa[ks] = *(const __attribute__((address_space(1))) f32x4*)(wrow + s0); wb[ks] = *(const __attribute__((address_space(1))) f32x4*)(wrow + s0 + 4); } else { wa[ks] = (f32x4){0.f, 0.f, 0.f, 0.f}; wb[ks] = wa[ks]; } } }
    {
        float w0[8], w1[8], w2[8];
        { const f32x4 a0 = *(const __attribute__((address_space(1))) f32x4*)(conv_w + c8), a1 = *(const __attribute__((address_space(1))) f32x4*)(conv_w + c8 + 4), b0 = *(const __attribute__((address_space(1))) f32x4*)(conv_w + 256 + c8), b1 = *(const __attribute__((address_space(1))) f32x4*)(conv_w + 256 + c8 + 4), d0 = *(const __attribute__((address_space(1))) f32x4*)(conv_w + 512 + c8), d1 = *(const __attribute__((address_space(1))) f32x4*)(conv_w + 512 + c8 + 4);
#pragma unroll
          for (int e = 0; e < 4; ++e) { w0[e] = a0[e]; w0[4 + e] = a1[e]; w1[e] = b0[e]; w1[4 + e] = b1[e]; w2[e] = d0[e]; w2[4 + e] = d1[e]; } }
        float pr_[6][8];
#pragma unroll
        for (int i = 0; i < 6; ++i) { const unsigned ga[4] = {gc[i].x, gc[i].y, gc[i].z, gc[i].w}, ha[4] = {hc[i].x, hc[i].y, hc[i].z, hc[i].w};
#pragma unroll
            for (int e = 0; e < 4; ++e) { pr_[i][2 * e] = bflo(ga[e]) * bflo(ha[e]); pr_[i][2 * e + 1] = bfhi(ga[e]) * bfhi(ha[e]); } }
#pragma unroll
        for (int i = 0; i < 4; ++i) { const unsigned ba[4] = {gb[i].x, gb[i].y, gb[i].z, gb[i].w}; float o[8];
#pragma unroll
            for (int e = 0; e < 4; ++e) { o[2 * e] = bflo(ba[e]) * (w0[2 * e] * pr_[i][2 * e] + w1[2 * e] * pr_[i + 1][2 * e] + w2[2 * e] * pr_[i + 2][2 * e]);
                o[2 * e + 1] = bfhi(ba[e]) * (w0[2 * e + 1] * pr_[i][2 * e + 1] + w1[2 * e + 1] * pr_[i + 1][2 * e + 1] + w2[2 * e + 1] * pr_[i + 2][2 * e + 1]); }
            LAS f32x4* tp = (LAS f32x4*)(tile + (4 * rg + i) * 260 + c8); tp[0] = (f32x4){o[0], o[1], o[2], o[3]}; tp[1] = (f32x4){o[4], o[5], o[6], o[7]}; }
    }
    LDS_WAIT(); __syncthreads();
    norm_store_rows(tile, Y, t0, 0, wave, lane);
    { const f32x4 g = *(const __attribute__((address_space(1))) f32x4*)(sgu_norm + lane * 4);
#pragma unroll
      for (int i = 0; i < 16; ++i) { const int s = wave + 8 * i;
        if (s < ns) { const v2u u = uu[i];
        const float v0 = bflo(u.x), v1 = bfhi(u.x), v2 = bflo(u.y), v3 = bfhi(u.y);
        const float ss = wave_sum((v0 * v0 + v1 * v1) + (v2 * v2 + v3 * v3)); const float rs = __builtin_amdgcn_rsqf(ss * (1.0f / 256.0f) + EPS);
        const unsigned a = pk2(v0 * rs * g[0], v1 * rs * g[1]), b = pk2(v2 * rs * g[2], v3 * rs * g[3]);
        const int sx = s ^ (((lane >> 1) & 7) << 3);
        vnT[(lane * 4 + 0) * 136 + sx] = (bf16)(a & 0xffffu); vnT[(lane * 4 + 1) * 136 + sx] = (bf16)(a >> 16); vnT[(lane * 4 + 2) * 136 + sx] = (bf16)(b & 0xffffu); vnT[(lane * 4 + 3) * 136 + sx] = (bf16)(b >> 16); } } }
    float ug0[16], ug1[16], bbv[16];
#pragma unroll
    for (int j = 0; j < 16; ++j) { const int rl = 32 * rh + (j & 3) + 8 * (j >> 2) + 4 * hi; const bf16* up = P + (size_t)(t0 + rl) * NIN + 768 + h * 64;
        ug0[j] = bf1(((const __attribute__((address_space(1))) bf16*)up)[r32]); ug1[j] = bf1(((const __attribute__((address_space(1))) bf16*)up)[32 + r32]); bbv[j] = ((const __attribute__((address_space(1))) float*)sgu_b)[h * 128 + dt + rl]; }
    LDS_WAIT(); __syncthreads();
    {
        f32x16 o0 = {}, o1 = {};
#pragma unroll
        for (int ks = 0; ks < 8; ++ks) if (ks < nk) { const int s0 = ks * 16 + 8 * hi;
            float wv[8] = {wa[ks][0], wa[ks][1], wa[ks][2], wa[ks][3], wb[ks][0], wb[ks][1], wb[ks][2], wb[ks][3]};
#pragma unroll
            for (int i = 0; i < 8; ++i) wv[i] = (s0 + i <= tcl) ? wv[i] : 0.f;
            v4u ap; ap.x = pk2(wv[0], wv[1]); ap.y = pk2(wv[2], wv[3]); ap.z = pk2(wv[4], wv[5]); ap.w = pk2(wv[6], wv[7]);
            const bf16x8 af = __builtin_bit_cast(bf16x8, ap);
            const int sw = s0 ^ (((r32 >> 3) & 3) << 3);
            const bf16x8 b0 = *(const LAS bf16x8*)(vnT + (h * 64 + r32) * 136 + sw), b1 = *(const LAS bf16x8*)(vnT + (h * 64 + 32 + r32) * 136 + (sw ^ 32));
            o0 = __builtin_amdgcn_mfma_f32_32x32x16_bf16(af, b0, o0, 0, 0, 0);
            o1 = __builtin_amdgcn_mfma_f32_32x32x16_bf16(af, b1, o1, 0, 0, 0); }
#pragma unroll
        for (int j = 0; j < 16; ++j) { const int rl = 32 * rh + (j & 3) + 8 * (j >> 2) + 4 * hi;
            tile[rl * 260 + h * 64 + r32] = ug0[j] * (o0[j] + bbv[j]);
            tile[rl * 260 + h * 64 + 32 + r32] = ug1[j] * (o1[j] + bbv[j]); }
    }
    LDS_WAIT(); __syncthreads();
    norm_store_rows(tile, Y, t0, 256, wave, lane);
    LDS_WAIT(); __syncthreads();
}

__global__ void __launch_bounds__(NTHR, 2) hybrid_fwd(Args args) {
    extern __shared__ __attribute__((aligned(16))) unsigned char lds_raw[];
    LAS unsigned char* lds = (LAS unsigned char*)lds_raw;
    cg::grid_group grid = cg::this_grid();
    volatile LAS unsigned* MISC = (volatile LAS unsigned*)(lds + LDS_BYTES - 64);
    volatile LAS unsigned* PT = (volatile LAS unsigned*)(lds + LDS_BYTES - 256);
    if (threadIdx.x < 16) MISC[threadIdx.x] = 0u;
    if (threadIdx.x == 0) {
#define PUTP(k) { const unsigned long long v_ = (unsigned long long)args.in[k]; PT[2 * (k)] = (unsigned)v_; PT[2 * (k) + 1] = (unsigned)(v_ >> 32); }
        PUTP(0) PUTP(1) PUTP(2) PUTP(3) PUTP(4) PUTP(5) PUTP(6) PUTP(7) PUTP(8) PUTP(9) PUTP(10) PUTP(11) PUTP(12) PUTP(13)
#undef PUTP
    }
    __syncthreads();
    XcdBarrier xbar = xcd_barrier_post((unsigned*)(args.ws + WS_BAR), MISC);
    const int tid = threadIdx.x, lane = tid & 63, wave = __builtin_amdgcn_readfirstlane(tid >> 6);
    const int G = gridDim.x, bx = blockIdx.x;
    const int gw = bx * NWAVES + wave, NGW = G * NWAVES;
    unsigned char* ws = args.ws;
#define INP(k) ldptr(PT, (k))
#define MAKE_CS() const CvtSrc cs{INP(2), INP(8), INP(10), INP(12), INP(1), INP(7), INP(9), Win_t, Wout_t, Wup_t, Wdn_t}
    float* xo = args.out;
#define PHASE_PTRS() unsigned char* w_ = ws; float* xcur = xo; asm volatile("" : "+s"(w_), "+s"(xcur)); \
    w_ = (unsigned char*)(__attribute__((address_space(1))) unsigned char*)w_; xcur = (float*)(__attribute__((address_space(1))) float*)xcur;     \
    bf16* Win_t = (bf16*)(w_ + WS_WIN); bf16* Wout_t = (bf16*)(w_ + WS_WOUT); bf16* Wup_t = (bf16*)(w_ + WS_WUP); bf16* Wdn_t = (bf16*)(w_ + WS_WDN); \
    float* part = (float*)(w_ + WS_PART); bf16* XB = (bf16*)(w_ + WS_XB); bf16* P = (bf16*)(w_ + WS_P); bf16* Y = (bf16*)(w_ + WS_Y); bf16* A = (bf16*)(w_ + WS_A); \
    (void)Win_t; (void)Wout_t; (void)Wup_t; (void)Wdn_t; (void)part; (void)XB; (void)P; (void)Y; (void)A; (void)xcur

    for (int step = -1; step < 5 * DEPTH; ++step) {
        const int l = step < 0 ? 0 : step / 5, ph = step < 0 ? -1 : step % 5;
        int cvt_layer = -1, cvt_first = 0, cvt_n = 0, cvt_nu = 0;
        if (ph < 0) {
            PHASE_PTRS(); const float* x_in = INP(0);
            int gw_ = gw, lane_ = lane; asm volatile("" : "+s"(gw_), "+v"(lane_));
            for (int m = gw_; m < S; m += NGW) { const __attribute__((address_space(1))) f32x4* xr = (const __attribute__((address_space(1))) f32x4*)(x_in + (size_t)m * DM) + lane_; f32x4 v[4]; float ss = 0.f;
#pragma unroll
                for (int j = 0; j < 4; ++j) { v[j] = __builtin_nontemporal_load(xr + 64 * j); ss += (v[j][0] * v[j][0] + v[j][1] * v[j][1]) + (v[j][2] * v[j][2] + v[j][3] * v[j][3]); }
                ss = wave_sum(ss);
                __attribute__((address_space(1))) v2u* o8 = (__attribute__((address_space(1))) v2u*)(XB + (size_t)m * DM) + lane_;
#pragma unroll
                for (int j = 0; j < 4; ++j) { v2u o; o.x = pk2(v[j][0], v[j][1]); o.y = pk2(v[j][2], v[j][3]); o8[64 * j] = o; }
                if (lane_ < 16) ((__attribute__((address_space(1))) float*)part)[(size_t)m * 16 + lane_] = lane_ == 0 ? ss : 0.f; }
            cvt_layer = 0; cvt_first = 0; cvt_n = 6144; cvt_nu = 0;
        } else if (ph == 0) {
            PHASE_PTRS(); pg8::Gemm g{XB, Win_t + (size_t)l * NIN * DM, S, NIN, DM, 256}; pg8::StaticOrder So; So.init(S, NIN, G, bx);
            pg8::EpiScaleBf16 E{P, NIN, part, (LAS float*)(lds + 131072 + 8192)};
            pg8::gemm_phase<pg8::EpiScaleBf16, pg8::StaticOrder, true, true>(lds, g, So, E);
            if (l + 1 < DEPTH) { cvt_layer = l + 1; cvt_first = 0; cvt_n = 1920; cvt_nu = (S / 256) * (NIN / 256); }
        } else if (ph == 1) {
            PHASE_PTRS();
            for (int u = bx; u < S / 64; u += G)
                mixer_unit(lds, u, P, Y, INP(3) + l * 3 * 256, INP(4) + l * 256, INP(5) + (size_t)l * 4 * 128 * 128, INP(6) + l * 4 * 128, tid, wave, lane);
        } else if (ph == 2) {
            PHASE_PTRS(); pg8::Gemm g{Y, Wout_t + (size_t)l * DM * DM, S, DM, DM, 256}; pg8::StaticOrder So; So.init(S, DM, G, bx);
            pg8::EpiResid E{XB, part};
            pg8::gemm_phase<pg8::EpiResid, pg8::StaticOrder, true, true>(lds, g, So, E);
        } else if (ph == 3) {
            PHASE_PTRS(); pg8::Gemm g{XB - 2 * DM, Wup_t + (size_t)l * NUP * DM, 65 * 256, NUP, DM, 254}; pg8::StaticOrder So; So.init(65 * 256, NUP, G, bx);
            pg8::EpiGate E{A, part, INP(11) + (size_t)l * 3 * NUP, (LAS float*)(lds + 131072)};
            pg8::gemm_phase<pg8::EpiGate, pg8::StaticOrder, true, true>(lds, g, So, E);
            if (l + 1 < DEPTH) { cvt_layer = l + 1; cvt_first = 1920; cvt_n = 4224; cvt_nu = 65 * (NUP / 256); }
        } else {
            PHASE_PTRS(); pg8::Gemm g{A, Wdn_t + (size_t)l * DM * DFF, S, DM, DFF, 256}; pg8::StaticOrder So; So.init(S, DM, G, bx);
            pg8::EpiResid E{XB, part};
            pg8::gemm_phase<pg8::EpiResid, pg8::StaticOrder, true, true>(lds, g, So, E);
        }
        if (cvt_layer >= 0) {
            const int first_idle = cvt_nu > 0 ? cvt_nu - ((cvt_nu + G - 1) / G - 1) * G : 0; const bool some_idle = first_idle < G;
            if (!some_idle || bx >= first_idle) { const int nw = (some_idle ? G - first_idle : G) * NWAVES, iw = (some_idle ? bx - first_idle : bx) * NWAVES + wave;
                PHASE_PTRS(); LAS float* scr = (LAS float*)(lds + wave * 16384); int lane_ = lane; asm volatile("" : "+v"(lane_));
                MAKE_CS(); for (int it = iw; it < cvt_n; it += nw) cvt_layer_item(cs, cvt_layer, cvt_first + it, scr, lane_); } }
        if (ws == nullptr) grid.sync();
        xcd_barrier(xbar);
    }
    { const float* nfin = INP(13); const bf16* XBf = (const bf16*)(ws + WS_XB);
      for (int m = gw; m < S; m += NGW) { const __attribute__((address_space(1))) v2u* xr = (const __attribute__((address_space(1))) v2u*)(XBf + (size_t)m * DM) + lane; f32x4 v[4]; float ss = 0.f;
#pragma unroll
        for (int j = 0; j < 4; ++j) { const v2u u = xr[64 * j]; v[j] = (f32x4){bflo(u.x), bfhi(u.x), bflo(u.y), bfhi(u.y)}; ss += (v[j][0] * v[j][0] + v[j][1] * v[j][1]) + (v[j][2] * v[j][2] + v[j][3] * v[j][3]); }
        const float rs = __builtin_amdgcn_rsqf(wave_sum(ss) * (1.0f / 1024.0f) + EPS);
        __attribute__((address_space(1))) f32x4* orow = (__attribute__((address_space(1))) f32x4*)(xo + (size_t)m * DM) + lane;
#pragma unroll
        for (int j = 0; j < 4; ++j) { const f32x4 g = *((const __attribute__((address_space(1))) f32x4*)nfin + lane + 64 * j); __builtin_nontemporal_store(v[j] * rs * g, orow + 64 * j); } } }
}

extern "C" void kernel_launch(void* const* d_in, const int* in_sizes, int n_in, void* d_out, int out_size, void* d_ws, size_t ws_size, hipStream_t stream) {
    static int grid = 0;
    if (grid == 0) {
        if (n_in != 14 || out_size != S * DM || ws_size < WS_END) { fprintf(stderr, "kernel_launch: unexpected shapes / workspace (%d inputs, out %d, ws %zu)\n", n_in, out_size, ws_size); grid = -1; return; }
        int dev = 0, cus = 0;
        hipGetDevice(&dev); hipDeviceGetAttribute(&cus, hipDeviceAttributeMultiprocessorCount, dev);
        hipFuncSetAttribute((const void*)hybrid_fwd, hipFuncAttributeMaxDynamicSharedMemorySize, LDS_BYTES);
        (void)hipGetLastError();
        grid = cus * 1;
    }
    if (grid < 0) return;
    hipMemsetAsync((unsigned char*)d_ws + WS_BAR, 0, 16384 + 4096, stream);
    Args a{};
    for (int i = 0; i < 14; ++i) a.in[i] = (const float*)d_in[i];
    a.out = (float*)d_out; a.ws = (unsigned char*)d_ws;
    void* kargs[] = {&a};
    hipError_t e = hipLaunchCooperativeKernel((const void*)hybrid_fwd, dim3(grid), dim3(NTHR), kargs, LDS_BYTES, stream);
    if (e != hipSuccess) fprintf(stderr, "cooperative launch failed: %s (grid %d)\n", hipGetErrorString(e), grid);
}
```

```cpp
#include <hip/hip_runtime.h>
#include <hip/hip_cooperative_groups.h>
#include <cstdio>
#include <cstdint>
namespace cg = cooperative_groups;
namespace pg8 {
#define PG8_LAS __attribute__((address_space(3)))
typedef unsigned short bf16_t;
typedef short bf16x8 __attribute__((ext_vector_type(8)));
typedef float f32x4 __attribute__((ext_vector_type(4)));
typedef unsigned u32x4 __attribute__((ext_vector_type(4)));
typedef unsigned u32x2 __attribute__((ext_vector_type(2)));
constexpr int BM = 256, BK = 64, HALF = 128, HTB = HALF * BK * 2  , STAGE_BYTES = 8 * HTB, NXCD = 8, WGM = 8;

__host__ __device__ __forceinline__ int lds_byte(int r, int c) { const int st = (r >> 4) * 2 + (c >> 5), rr = r & 15, cc = c & 31, ob = rr * 64 + cc * 2; return st * 1024 + (ob ^ (((ob >> 9) & 1) << 5)); }
__host__ __device__ __forceinline__ void stage_rc(int b, int& R, int& C) { const int st = b / 1024, sb = b % 1024, swz = sb ^ (((sb >> 9) & 1) << 5); R = (st >> 1) * 16 + swz / 64; C = (st & 1) * 32 + (swz % 64) / 2; }
__host__ __device__ __forceinline__ int perm32(int rho) { const int n = rho >> 4, i = rho & 15; return 8 * (i >> 2) + 4 * n + (i & 3); }

struct Unit { int pm, pn; };
struct Gemm { const bf16_t* A; const bf16_t* Bt; int M, N, K; int arows; };

struct StaticOrder {
    int nM, nN, nwg, G, c;
    __host__ __device__ void init(int M, int N, int G_, int c_) { nM = M / BM; nN = N / BM; nwg = nM * nN; G = G_; c = c_; }
    __host__ __device__ bool next(int i, Unit& u) const {
        const long L = (long)i * G + c; if (L >= nwg) return false;
        int wgid = (int)L; { const int q = nwg / NXCD, r = nwg % NXCD, xcd = wgid % NXCD, off = wgid / NXCD; wgid = (xcd < r ? xcd * (q + 1) : r * (q + 1) + (xcd - r) * q) + off; }
        const int nig = WGM * nN, gid = wgid / nig, fm = gid * WGM, gsz = (nM - fm) < WGM ? (nM - fm) : WGM;
        u.pm = fm + ((wgid % nig) % gsz); u.pn = (wgid % nig) / gsz; return true;
    }
    __device__ __forceinline__ void a_ready(const Unit&) const {}
    __device__ __forceinline__ void done(const Unit&) const {}
};

__device__ __forceinline__ unsigned cvt_pk_bf16(float lo, float hi) { unsigned r; asm volatile("v_cvt_pk_bf16_f32 %0, %1, %2" : "=v"(r) : "v"(lo), "v"(hi)); return r; }
struct EpiScaleBf16 {
    static constexpr bool PERM = true, AFTER_DRAIN = false, PERMA = false, WIDE = true;
    bf16_t* O; int ldc; const float* part; PG8_LAS float* rsl;
    __device__ __forceinline__ void operator()(const f32x4 (&acc)[2][2][4][2], const Unit& u, int wr, int wc, int fr, int fq) const {
        { const int t = (wr * 4 + wc) * 64 + fq * 16 + fr;
          if (t < 256) { const __attribute__((address_space(1))) f32x4* pp = (const __attribute__((address_space(1))) f32x4*)(part + (size_t)(u.pm * BM + t) * 16); const f32x4 a = pp[0], b = pp[1], c = pp[2], d = pp[3];
              const f32x4 s4 = (a + b) + (c + d); const float ss = (s4[0] + s4[1]) + (s4[2] + s4[3]); rsl[t] = __builtin_amdgcn_rsqf(ss * (1.0f / 1024.0f) + 1e-6f); } }
        asm volatile("s_waitcnt lgkmcnt(0)" ::: "memory"); __builtin_amdgcn_s_barrier(); asm volatile("" ::: "memory");
        const int row0 = u.pm * BM + wr * 64 + fr; const int col0 = u.pn * BM + wc * 64 + 8 * fq;
#pragma unroll
        for (int ai = 0; ai < 2; ++ai)
#pragma unroll
            for (int m = 0; m < 4; ++m) { const int row = row0 + ai * HALF + m * 16;
                const float rs = rsl[ai * HALF + wr * 64 + m * 16 + fr];
                bf16_t* rowp = O + (size_t)row * ldc + col0;
#pragma unroll
                for (int bj = 0; bj < 2; ++bj) { const f32x4 v0 = acc[ai][bj][m][0] * rs, v1 = acc[ai][bj][m][1] * rs;
                    u32x4 w; w.x = cvt_pk_bf16(v0[0], v0[1]); w.y = cvt_pk_bf16(v0[2], v0[3]); w.z = cvt_pk_bf16(v1[0], v1[1]); w.w = cvt_pk_bf16(v1[2], v1[3]);
                    *(__attribute__((address_space(1))) u32x4*)(rowp + bj * 32) = w; } }
    }
};
struct EpiResid {
    static constexpr bool PERM = true, AFTER_DRAIN = false, PERMA = false, WIDE = true;
    bf16_t* xb; float* part;
    __device__ __forceinline__ void operator()(const f32x4 (&acc)[2][2][4][2], const Unit& u, int wr, int wc, int fr, int fq) const {
        const int row0 = u.pm * BM + wr * 64 + fr; const int col0 = u.pn * BM + wc * 64 + 8 * fq;
        u32x4 pre[3][2];
#define PG8_RLOAD(g_) do { const size_t o_ = (size_t)(row0 + ((g_) >> 2) * HALF + ((g_) & 3) * 16) * 1024 + col0; \
            pre[(g_) % 3][0] = *(const __attribute__((address_space(1))) u32x4*)(xb + o_); pre[(g_) % 3][1] = *(const __attribute__((address_space(1))) u32x4*)(xb + o_ + 32); } while (0)
        PG8_RLOAD(0); PG8_RLOAD(1);
#pragma unroll
        for (int g = 0; g < 8; ++g) { const int ai = g >> 2, m = g & 3;
            if (g + 2 < 8) PG8_RLOAD(g + 2);
            asm volatile("" ::: "memory");
            const int row = row0 + ai * HALF + m * 16; const size_t off = (size_t)row * 1024 + col0; float ss = 0.f;
#pragma unroll
            for (int bj = 0; bj < 2; ++bj) { const u32x4 b = pre[g % 3][bj];
                const f32x4 b0 = {__uint_as_float(b.x << 16), __uint_as_float(b.x & 0xffff0000u), __uint_as_float(b.y << 16), __uint_as_float(b.y & 0xffff0000u)};
                const f32x4 b1 = {__uint_as_float(b.z << 16), __uint_as_float(b.z & 0xffff0000u), __uint_as_float(b.w << 16), __uint_as_float(b.w & 0xffff0000u)};
                const f32x4 v0 = acc[ai][bj][m][0] + b0, v1 = acc[ai][bj][m][1] + b1;
                ss += (v0[0] * v0[0] + v0[1] * v0[1]) + (v0[2] * v0[2] + v0[3] * v0[3]) + (v1[0] * v1[0] + v1[1] * v1[1]) + (v1[2] * v1[2] + v1[3] * v1[3]);
                u32x4 w; w.x = cvt_pk_bf16(v0[0], v0[1]); w.y = cvt_pk_bf16(v0[2], v0[3]); w.z = cvt_pk_bf16(v1[0], v1[1]); w.w = cvt_pk_bf16(v1[2], v1[3]);
                *(__attribute__((address_space(1))) u32x4*)(xb + off + bj * 32) = w; }
            ss += __shfl_xor(ss, 16); ss += __shfl_xor(ss, 32);
            if (fq == 0) ((__attribute__((address_space(1))) float*)part)[(size_t)row * 16 + u.pn * 4 + wc] = ss;
            asm volatile("" ::: "memory"); }
#undef PG8_RLOAD
    }
};
#define PG8_DPP(oldv, srcv, ctrl) __builtin_bit_cast(float, __builtin_amdgcn_update_dpp(__builtin_bit_cast(int, (float)(oldv)), __builtin_bit_cast(int, (float)(srcv)), (ctrl), 0xf, 0xf, false))
struct EpiGate {
    static constexpr bool PERM = true, AFTER_DRAIN = false, PERMA = true, WIDE = false;
    bf16_t* Aout; const float* part; const float* fconv; PG8_LAS float* xch;
    __device__ __forceinline__ void operator()(f32x4 (&acc)[2][2][4][2], const Unit& u, int wr, int wc, int fr, int fq) const {
        PG8_LAS float* rsl = xch + 2048;
        { const int t = (wr * 4 + wc) * 64 + fq * 16 + fr;
          if (t < 256) { const int row = u.pm * 254 - 2 + t; const bool ok = row >= 0 && row < 16384; const int rc = ok ? row : 0;
              const __attribute__((address_space(1))) f32x4* pp = (const __attribute__((address_space(1))) f32x4*)(part + (size_t)rc * 16); const f32x4 a = pp[0], b = pp[1], c = pp[2], d = pp[3];
              const f32x4 s4 = (a + b) + (c + d); const float ss = (s4[0] + s4[1]) + (s4[2] + s4[3]);
              rsl[t] = ok ? __builtin_amdgcn_rsqf(ss * (1.0f / 1024.0f) + 1e-6f) : 0.f; } }
        asm volatile("s_waitcnt lgkmcnt(0)" ::: "memory"); __builtin_amdgcn_s_barrier(); asm volatile("" ::: "memory");
        const int ccol = wc * 32 + 8 * fq;
#pragma unroll
        for (int ai = 0; ai < 2; ++ai) { const f32x4 rs4 = *(const PG8_LAS f32x4*)(rsl + ai * HALF + wr * 64 + 4 * fr);
#pragma unroll
            for (int m = 0; m < 4; ++m)
#pragma unroll
                for (int bj = 0; bj < 2; ++bj) { acc[ai][bj][m][0] *= rs4[m]; acc[ai][bj][m][1] *= rs4[m]; } }
        if (fr == 15) {
#pragma unroll
            for (int ai = 0; ai < 2; ++ai)
#pragma unroll
                for (int bj = 0; bj < 2; ++bj)
#pragma unroll
                    for (int n = 0; n < 2; ++n) { *(PG8_LAS f32x4*)(xch + ((2 * ai + wr) * 2 + 0) * 256 + bj * HALF + ccol + 4 * n) = acc[ai][bj][2][n]; *(PG8_LAS f32x4*)(xch + ((2 * ai + wr) * 2 + 1) * 256 + bj * HALF + ccol + 4 * n) = acc[ai][bj][3][n]; }
        }
        asm volatile("s_waitcnt lgkmcnt(0)" ::: "memory"); __builtin_amdgcn_s_barrier(); asm volatile("" ::: "memory");
        const int ch0 = u.pn * HALF + ccol;
#pragma unroll
        for (int ai = 0; ai < 2; ++ai) {
            const int grp = 2 * ai + wr;
            u32x2 keep[4];
#pragma unroll
            for (int n = 0; n < 2; ++n) {
                asm volatile("" ::: "memory");
                const float* fw = fconv + ch0 + 4 * n;
                const f32x4 wg0 = *(const __attribute__((address_space(1))) f32x4*)(fw), wg1 = *(const __attribute__((address_space(1))) f32x4*)(fw + 5632), wg2 = *(const __attribute__((address_space(1))) f32x4*)(fw + 2 * 5632);
                const f32x4 wu0 = *(const __attribute__((address_space(1))) f32x4*)(fw + 2816), wu1 = *(const __attribute__((address_space(1))) f32x4*)(fw + 5632 + 2816), wu2 = *(const __attribute__((address_space(1))) f32x4*)(fw + 2 * 5632 + 2816);
                f32x4 g62 = {0.f, 0.f, 0.f, 0.f}, g63 = g62, u62 = g62, u63 = g62;
                if (grp > 0) { const PG8_LAS float* xb_ = xch + ((grp - 1) * 2) * 256 + ccol + 4 * n;
                    g62 = *(const PG8_LAS f32x4*)(xb_); g63 = *(const PG8_LAS f32x4*)(xb_ + 256); u62 = *(const PG8_LAS f32x4*)(xb_ + HALF); u63 = *(const PG8_LAS f32x4*)(xb_ + 256 + HALF); }
                float o[4][4];
#pragma unroll
                for (int j = 0; j < 4; ++j) {
                    const float g0 = acc[ai][0][0][n][j], g1 = acc[ai][0][1][n][j], g2 = acc[ai][0][2][n][j], g3 = acc[ai][0][3][n][j];
                    const float u0 = acc[ai][1][0][n][j], u1 = acc[ai][1][1][n][j], u2 = acc[ai][1][2][n][j], u3 = acc[ai][1][3][n][j];
                    const float gm1 = PG8_DPP(g63[j], g3, 0x111), gm2 = PG8_DPP(g62[j], g2, 0x111);
                    const float um1 = PG8_DPP(u63[j], u3, 0x111), um2 = PG8_DPP(u62[j], u2, 0x111);
                    const float G0 = wg0[j] * gm2 + wg1[j] * gm1 + wg2[j] * g0, G1 = wg0[j] * gm1 + wg1[j] * g0 + wg2[j] * g1, G2 = wg0[j] * g0 + wg1[j] * g1 + wg2[j] * g2, G3 = wg0[j] * g1 + wg1[j] * g2 + wg2[j] * g3;
                    const float U0 = wu0[j] * um2 + wu1[j] * um1 + wu2[j] * u0, U1 = wu0[j] * um1 + wu1[j] * u0 + wu2[j] * u1, U2 = wu0[j] * u0 + wu1[j] * u1 + wu2[j] * u2, U3 = wu0[j] * u1 + wu1[j] * u2 + wu2[j] * u3;
                    o[0][j] = G0 * __builtin_amdgcn_rcpf(1.0f + __expf(-G0)) * U0; o[1][j] = G1 * __builtin_amdgcn_rcpf(1.0f + __expf(-G1)) * U1;
                    o[2][j] = G2 * __builtin_amdgcn_rcpf(1.0f + __expf(-G2)) * U2; o[3][j] = G3 * __builtin_amdgcn_rcpf(1.0f + __expf(-G3)) * U3; }
#pragma unroll
                for (int m = 0; m < 4; ++m) { const int r = ai * HALF + wr * 64 + 4 * fr + m, row = u.pm * 254 - 2 + r;
                    u32x2 w; w.x = cvt_pk_bf16(o[m][0], o[m][1]); w.y = cvt_pk_bf16(o[m][2], o[m][3]);
                    if (n == 0) keep[m] = w;
                    else if (r >= 2 && row < 16384) { u32x4 w4; w4.x = keep[m].x; w4.y = keep[m].y; w4.z = w.x; w4.w = w.y; *(__attribute__((address_space(1))) u32x4*)(Aout + (size_t)row * 2816 + ch0) = w4; } }
            }
        }
    }
};
template <class Epi, class Sched, bool ALIGN_EPI = false, bool SP2 = false>
__device__ __forceinline__ void gemm_phase(PG8_LAS unsigned char* lds, const Gemm g, const Sched& S, const Epi& E) {
    int tid = threadIdx.x; asm volatile("" : "+v"(tid));
    const int wid = __builtin_amdgcn_readfirstlane(tid >> 6), lane = tid & 63, wr = wid >> 2, wc = wid & 3, fr = lane & 15, fq = lane >> 4;
    const int K = g.K, nt = K / BK;
    unsigned voffA[2], voffB[2];
#pragma unroll
    for (int i = 0; i < 2; ++i) { int R, C; stage_rc(tid * 16 + i * 8192, R, C); const int Rb = Epi::WIDE ? (64 * (R >> 5) + perm32(R & 31)) : Epi::PERM ? ((R & ~31) + perm32(R & 31)) : R;
        const int Ra = Epi::PERMA ? ((R & ~63) + 4 * (R & 15) + ((R >> 4) & 3)) : R;
        voffA[i] = (unsigned)(Ra * K + C) * 2u; voffB[i] = (unsigned)(Rb * K + C) * 2u; }
    const size_t kstep = (size_t)(BK * 2);
    const size_t hstep = (size_t)HALF * K * 2;
    const size_t hstepB = Epi::WIDE ? (size_t)32 * K * 2 : hstep;
    const size_t tstep = 2 * hstep;
    const size_t tstepA = (size_t)g.arows * K * 2;
    const unsigned ldsw = (unsigned)wid * 1024u;
    const int aoff = lds_byte(wr * 64 + fr, fq * 8), boff = lds_byte(wc * 32 + fr, fq * 8);
#define PG8_SA(b, h) (((b) * 2 + (h)) * HTB)
#define PG8_SB(b, h) ((4 + (b) * 2 + (h)) * HTB)
#define PG8_STAGE(bufoff, gbase, voff) do { _Pragma("unroll") for (int _i = 0; _i < 2; ++_i) \
        __builtin_amdgcn_global_load_lds((const unsigned*)((const char*)(gbase) + (voff)[_i]), (PG8_LAS unsigned*)(lds + (bufoff) + ldsw + _i * 8192), 16, 0, 0); } while (0)
#define PG8_LDA(dst, b, h) do { _Pragma("unroll") for (int m = 0; m < 4; ++m) _Pragma("unroll") for (int k = 0; k < 2; ++k) dst[m][k] = *(const PG8_LAS bf16x8*)(lds + PG8_SA(b, h) + aoff + m * 2048 + k * 1024); } while (0)
#define PG8_LDB(dst, b, h) do { _Pragma("unroll") for (int n = 0; n < 2; ++n) _Pragma("unroll") for (int k = 0; k < 2; ++k) dst[n][k] = *(const PG8_LAS bf16x8*)(lds + PG8_SB(b, h) + boff + n * 2048 + k * 1024); } while (0)
#define PG8_MMA(ai, bj, At, Bt) do { __builtin_amdgcn_s_setprio(1); _Pragma("unroll") for (int m = 0; m < 4; ++m) _Pragma("unroll") for (int n = 0; n < 2; ++n) _Pragma("unroll") for (int k = 0; k < 2; ++k) \
        acc[ai][bj][m][n] = __builtin_amdgcn_mfma_f32_16x16x32_bf16(Bt[n][k], At[m][k], acc[ai][bj][m][n], 0, 0, 0); __builtin_amdgcn_s_setprio(0); } while (0)
#define PG8_WAIT_V(n) asm volatile("s_waitcnt vmcnt(" #n ")" ::: "memory")
#define PG8_WAIT_L(n) asm volatile("s_waitcnt lgkmcnt(" #n ")" ::: "memory")
#define PG8_BAR __builtin_amdgcn_s_barrier()
#define PG8_SCHED __builtin_amdgcn_sched_barrier(0)
    Unit cur, nxt; int ui = 0;
    if (!S.next(0, cur)) return;
    f32x4 acc[2][2][4][2];
#pragma unroll
    for (int a = 0; a < 2; ++a)
#pragma unroll
        for (int b = 0; b < 2; ++b)
#pragma unroll
            for (int m = 0; m < 4; ++m)
#pragma unroll
                for (int n = 0; n < 2; ++n) acc[a][b][m][n] = (f32x4){0.f, 0.f, 0.f, 0.f};
    bf16x8 At[4][2], B0[2][2], B1[2][2];
    const char* cA = (const char*)g.A + (size_t)cur.pm * tstepA; const char* cB = (const char*)g.Bt + (size_t)cur.pn * tstep;
    S.a_ready(cur);
    if constexpr (SP2) {
        PG8_STAGE(PG8_SB(0, 0), cB, voffB); PG8_STAGE(PG8_SB(0, 1), cB + hstepB, voffB); PG8_STAGE(PG8_SA(0, 0), cA, voffA); PG8_STAGE(PG8_SA(0, 1), cA + hstep, voffA);
        if (wr == 1) PG8_BAR;
        PG8_WAIT_V(2); PG8_BAR;
        PG8_STAGE(PG8_SB(1, 0), cB + kstep, voffB); PG8_STAGE(PG8_SA(1, 0), cA + kstep, voffA); PG8_STAGE(PG8_SB(1, 1), cB + hstepB + kstep, voffB);
        PG8_WAIT_V(6); PG8_BAR;
    } else {
        PG8_STAGE(PG8_SB(0, 0), cB, voffB); PG8_STAGE(PG8_SA(0, 0), cA, voffA); PG8_STAGE(PG8_SB(0, 1), cB + hstepB, voffB); PG8_STAGE(PG8_SA(0, 1), cA + hstep, voffA);
        if (wr == 1) PG8_BAR;
        PG8_WAIT_V(4); PG8_BAR;
        PG8_STAGE(PG8_SB(1, 0), cB + kstep, voffB); PG8_STAGE(PG8_SA(1, 0), cA + kstep, voffA); PG8_STAGE(PG8_SB(1, 1), cB + hstepB + kstep, voffB);
        PG8_WAIT_V(6); PG8_BAR;
    }
    for (;;) {
        const bool has_next = S.next(ui + 1, nxt);
        const char* nA = has_next ? (const char*)g.A + (size_t)nxt.pm * tstepA : cA; const char* nB = has_next ? (const char*)g.Bt + (size_t)nxt.pn * tstep : cB;
        for (int t = 0; t < nt; t += 2) {
            const bool last = (t == nt - 2);
            const char* a1 = cA + (size_t)(t + 1) * kstep;
            const char* a2 = last ? nA : cA + (size_t)(t + 2) * kstep; const char* b2 = last ? nB : cB + (size_t)(t + 2) * kstep;
            const char* a3 = a2 + kstep; const char* b3 = b2 + kstep;
            if (last && has_next) S.a_ready(nxt);
            if constexpr (SP2) {
            PG8_LDB(B0, 0, 0); PG8_LDB(B1, 0, 1); PG8_SCHED; PG8_LDA(At, 0, 0); PG8_STAGE(PG8_SA(1, 1), a1 + hstep, voffA);
            PG8_WAIT_V(8); PG8_WAIT_L(0); PG8_BAR; PG8_MMA(0, 0, At, B0); PG8_MMA(0, 1, At, B1); PG8_BAR; PG8_SCHED;
            PG8_LDA(At, 0, 1); PG8_STAGE(PG8_SB(0, 0), b2, voffB); PG8_STAGE(PG8_SB(0, 1), b2 + hstepB, voffB); PG8_STAGE(PG8_SA(0, 0), a2, voffA);
            PG8_WAIT_V(8); PG8_WAIT_L(0); PG8_BAR; PG8_MMA(1, 0, At, B0); PG8_MMA(1, 1, At, B1); PG8_BAR; PG8_SCHED;
            PG8_LDB(B0, 1, 0); PG8_LDB(B1, 1, 1); PG8_SCHED; PG8_LDA(At, 1, 0); PG8_STAGE(PG8_SA(0, 1), a2 + hstep, voffA);
            PG8_WAIT_V(8); PG8_WAIT_L(0); PG8_BAR; PG8_MMA(0, 0, At, B0); PG8_MMA(0, 1, At, B1); PG8_BAR; PG8_SCHED;
            PG8_LDA(At, 1, 1); PG8_STAGE(PG8_SB(1, 0), b3, voffB); PG8_STAGE(PG8_SB(1, 1), b3 + hstepB, voffB); PG8_STAGE(PG8_SA(1, 0), a3, voffA);
            PG8_WAIT_V(8); PG8_WAIT_L(0); PG8_BAR; PG8_MMA(1, 0, At, B0); PG8_MMA(1, 1, At, B1); PG8_BAR; PG8_SCHED;
            } else {
            PG8_LDB(B0, 0, 0); PG8_SCHED; PG8_LDA(At, 0, 0); PG8_STAGE(PG8_SA(1, 1), a1 + hstep, voffA);
            PG8_WAIT_L(8); PG8_BAR; PG8_WAIT_L(0); PG8_MMA(0, 0, At, B0); PG8_BAR; PG8_SCHED;
            PG8_LDB(B1, 0, 1); PG8_STAGE(PG8_SB(0, 0), b2, voffB);
            PG8_BAR; PG8_WAIT_L(0); PG8_MMA(0, 1, At, B1); PG8_BAR;
            PG8_LDA(At, 0, 1); PG8_STAGE(PG8_SA(0, 0), a2, voffA);
            PG8_BAR; PG8_WAIT_L(0); PG8_MMA(1, 0, At, B0); PG8_BAR; PG8_SCHED;
            PG8_STAGE(PG8_SB(0, 1), b2 + hstepB, voffB);
            PG8_WAIT_V(6); PG8_BAR; PG8_MMA(1, 1, At, B1); PG8_BAR;
            PG8_LDB(B0, 1, 0); PG8_SCHED; PG8_LDA(At, 1, 0); PG8_STAGE(PG8_SA(0, 1), a2 + hstep, voffA);
            PG8_WAIT_L(8); PG8_BAR; PG8_WAIT_L(0); PG8_MMA(0, 0, At, B0); PG8_BAR; PG8_SCHED;
            PG8_LDB(B1, 1, 1); PG8_STAGE(PG8_SB(1, 0), b3, voffB);
            PG8_BAR; PG8_WAIT_L(0); PG8_MMA(0, 1, At, B1); PG8_BAR;
            PG8_LDA(At, 1, 1); PG8_STAGE(PG8_SA(1, 0), a3, voffA);
            PG8_BAR; PG8_WAIT_L(0); PG8_MMA(1, 0, At, B0); PG8_BAR; PG8_SCHED;
            PG8_STAGE(PG8_SB(1, 1), b3 + hstepB, voffB);
            PG8_WAIT_V(6); PG8_BAR; PG8_MMA(1, 1, At, B1); PG8_BAR;
            }
        }
        if constexpr (ALIGN_EPI) { if (wr == 0) PG8_BAR; }
        if constexpr (!Epi::AFTER_DRAIN) { E(acc, cur, wr, wc, fr, fq); S.done(cur); }
        if (!has_next) break;
#pragma unroll
        for (int a = 0; a < 2; ++a)
#pragma unroll
            for (int b = 0; b < 2; ++b)
#pragma unroll
                for (int m = 0; m < 4; ++m)
#pragma unroll
                    for (int n = 0; n < 2; ++n) acc[a][b][m][n] = (f32x4){0.f, 0.f, 0.f, 0.f};
        cur = nxt; cA = nA; cB = nB; ++ui;
        if constexpr (ALIGN_EPI) { if (wr == 1) PG8_BAR; }
    }
    PG8_WAIT_V(0);
    if constexpr (!ALIGN_EPI) { if (wr == 0) PG8_BAR; }
    PG8_BAR;
    if constexpr (Epi::AFTER_DRAIN) { E.fused(acc, cur, wr, wc, fr, fq, lds, wid, lane); S.done(cur); }
#undef PG8_SA
#undef PG8_SB
#undef PG8_STAGE
#undef PG8_LDA
#undef PG8_LDB
#undef PG8_MMA
#undef PG8_WAIT_V
#undef PG8_WAIT_L
#undef PG8_BAR
#undef PG8_SCHED
}
}
constexpr int S = 16384, DM = 1024, DEPTH = 4, NIN = 2816, DFF = 2816, NUP = 5632;
constexpr float EPS = 1e-6f;
constexpr int NWAVES = 8, NTHR = 512;
constexpr size_t MiB = 1u << 20;
constexpr size_t WS_WIN = 1 * MiB, WS_WOUT = 23 * MiB, WS_WUP = 31 * MiB, WS_WDN = 75 * MiB;
constexpr size_t WS_PART = 97 * MiB;
constexpr size_t WS_BAR = 98 * MiB;
constexpr size_t WS_XB = 98 * MiB + 16384 + 4096;
constexpr size_t WS_P = 131 * MiB;
constexpr size_t WS_Y = 219 * MiB;
constexpr size_t WS_A = 131 * MiB;
constexpr size_t WS_END = 251 * MiB;
constexpr int LDS_BYTES = 147456;
#define LAS __attribute__((address_space(3)))
typedef unsigned short bf16;
typedef unsigned v4u __attribute__((ext_vector_type(4)));
typedef unsigned v2u __attribute__((ext_vector_type(2)));
typedef float f32x4 __attribute__((ext_vector_type(4)));
typedef float f32x16 __attribute__((ext_vector_type(16)));
typedef short bf16x8 __attribute__((ext_vector_type(8)));
#define LDS_WAIT() asm volatile("s_waitcnt lgkmcnt(0)" ::: "memory")
__device__ __forceinline__ unsigned pk2(float lo, float hi) { return pg8::cvt_pk_bf16(lo, hi); }
__device__ __forceinline__ float bflo(unsigned u) { return __uint_as_float(u << 16); }
__device__ __forceinline__ float bfhi(unsigned u) { return __uint_as_float(u & 0xffff0000u); }
__device__ __forceinline__ float bf1(bf16 v) { return __uint_as_float((unsigned)v << 16); }
#define WS_DPP(v, ctrl) __builtin_bit_cast(float, __builtin_amdgcn_update_dpp(0, __builtin_bit_cast(int, (float)(v)), (ctrl), 0xf, 0xf, true))
__device__ __forceinline__ float wave_sum(float v) {
    v += WS_DPP(v, 0xB1); v += WS_DPP(v, 0x4E); v += WS_DPP(v, 0x141); v += WS_DPP(v, 0x140);
    const int iv = __builtin_bit_cast(int, v);
    const float a = __builtin_bit_cast(float, __builtin_amdgcn_readlane(iv, 0)), b = __builtin_bit_cast(float, __builtin_amdgcn_readlane(iv, 16));
    const float c = __builtin_bit_cast(float, __builtin_amdgcn_readlane(iv, 32)), d = __builtin_bit_cast(float, __builtin_amdgcn_readlane(iv, 48));
    return (a + b) + (c + d);
}

__device__ __forceinline__ void cvt_item(const float* W, int K, int N, bf16* WT, const float* gain, int mode, LAS float* scr, int item, int lane) {
    const int nblk = N / 32, kb = item / nblk, nb = item % nblk, k0 = 64 * kb, n0 = 32 * nb;
    float wv[32];
#pragma unroll
    for (int i = 0; i < 32; ++i) { const int kk = 2 * i + (lane >> 5); wv[i] = __builtin_nontemporal_load(((const __attribute__((address_space(1))) float*)W) + (size_t)(k0 + kk) * N + n0 + (lane & 31)); }
#pragma unroll
    for (int i = 0; i < 32; ++i) { const int kk = 2 * i + (lane >> 5); const float g = gain ? ((const __attribute__((address_space(1))) float*)gain)[k0 + kk] : 1.0f; scr[kk * 33 + (lane & 31)] = wv[i] * g; }
    LDS_WAIT(); asm volatile("" ::: "memory");
    const float cs = (mode == 1 && n0 >= 1280 && n0 < 1792) ? 0.125f * 1.4426950408889634f : 1.0f;
    int rb = n0;
    if (mode == 2) { rb = (n0 < DFF) ? 256 * (n0 / 128) + (n0 % 128) : 256 * ((n0 - DFF) / 128) + 128 + ((n0 - DFF) % 128); }
    const int c = lane & 7;
#pragma unroll
    for (int j = 0; j < 4; ++j) { const int n = (lane >> 3) + 8 * j; const LAS float* s = scr + (8 * c) * 33 + n;
        v4u o; o.x = pk2(s[0 * 33] * cs, s[1 * 33] * cs); o.y = pk2(s[2 * 33] * cs, s[3 * 33] * cs); o.z = pk2(s[4 * 33] * cs, s[5 * 33] * cs); o.w = pk2(s[6 * 33] * cs, s[7 * 33] * cs);
        { void* p_ = (void*)(WT + (size_t)(rb + n) * K + k0 + 8 * c); asm volatile("global_store_dwordx4 %0, %1, off sc1\n\ts_nop 1" :: "v"(p_), "v"(o) : "memory"); } }
    LDS_WAIT(); asm volatile("" ::: "memory");
}

typedef __attribute__((address_space(1))) unsigned gu32;
#define XB_TMO      128
#define XB_XCNT(j)  (256  + 64 * (j))
#define XB_XSUB(j)  (1280 + 64 * (j))
#define XB_XGEN(j)  (2304 + 64 * (j))
#define XB_TOP      3328
#define XB_TOPGEN   3392
#define XCD_BAR_WORDS 3456
#define XB_SPIN_CAP (1u << 18)

__device__ __forceinline__ unsigned xb_ld(unsigned* p)              { return __hip_atomic_load(p, __ATOMIC_RELAXED, __HIP_MEMORY_SCOPE_AGENT); }
__device__ __forceinline__ unsigned xb_add(unsigned* p, unsigned v) { return __hip_atomic_fetch_add(p, v, __ATOMIC_RELAXED, __HIP_MEMORY_SCOPE_AGENT); }
__device__ __forceinline__ unsigned xb_xcc_id() { return (unsigned)__builtin_amdgcn_s_getreg((3 << 11) | 20) & 0xFu; }
#define XB_SPIN(cond, bar) do { unsigned _sp = 0; while (cond) { __builtin_amdgcn_s_sleep(1); \
    if ((++_sp & 255u) == 0u) { if (xb_ld(&(bar)[XB_TMO])) break; if (_sp > XB_SPIN_CAP) { atomicAdd(&(bar)[XB_TMO], 1u); break; } } } } while (0)

struct XcdBarrier {
    unsigned* bar; unsigned x;
    volatile LAS unsigned* st;
};

__device__ __forceinline__ XcdBarrier xcd_barrier_post(unsigned* bar, volatile LAS unsigned* st) {
    XcdBarrier b; b.bar = bar; b.x = xb_xcc_id(); b.st = st;
    if (threadIdx.x == 0) (void)xb_add(&bar[XB_XCNT(b.x)], 1u);
    return b;
}
__device__ __forceinline__ void xcd_barrier_complete(unsigned* bar, unsigned x, unsigned& nloc, unsigned& nx) {
    const unsigned G = gridDim.x * gridDim.y * gridDim.z;
    unsigned sum, cnt, mine, sp = 0u;
    for (;;) {
        sum = 0u; cnt = 0u; mine = 0u;
#pragma unroll
        for (unsigned j = 0; j < 16; ++j) { const unsigned c = xb_ld(&bar[XB_XCNT(j)]); sum += c; cnt += (c > 0u) ? 1u : 0u; mine = (j == x) ? c : mine; }
        if (sum == G) break;
        __builtin_amdgcn_s_sleep(1);
        if ((++sp & 255u) == 0u) { if (xb_ld(&bar[XB_TMO])) break; if (sp > XB_SPIN_CAP) { atomicAdd(&bar[XB_TMO], 1u); break; } }
    }
    nloc = mine > 0u ? mine : 1u; nx = cnt > 0u ? cnt : 1u;
}

__device__ __forceinline__ void xcd_barrier(const XcdBarrier& b) {
    asm volatile("s_waitcnt vmcnt(0)" ::: "memory");
    __syncthreads();
    if (threadIdx.x == 0) {
        unsigned* bar = b.bar;
        __builtin_amdgcn_s_waitcnt(0);
        unsigned nloc = b.st[0], nx = b.st[1];
        if (nloc == 0u) { xcd_barrier_complete(bar, b.x, nloc, nx); b.st[0] = nloc; b.st[1] = nx; }
        const unsigned old = xb_add(&bar[XB_XSUB(b.x)], 1u);
        const unsigned gen = old / nloc;
        if (old + 1u == (gen + 1u) * nloc) {
            __builtin_amdgcn_fence(__ATOMIC_RELEASE, "agent");
            asm volatile("s_waitcnt vmcnt(0)" ::: "memory");
            const unsigned og = xb_add(&bar[XB_TOP], 1u);
            const unsigned tg = og / nx;
            if (og + 1u == (tg + 1u) * nx) xb_add(&bar[XB_TOPGEN], 1u);
            else XB_SPIN(xb_ld(&bar[XB_TOPGEN]) == tg, bar);
            __builtin_amdgcn_fence(__ATOMIC_ACQUIRE, "agent");
            xb_add(&bar[XB_XGEN(b.x)], 1u);
            asm volatile("s_waitcnt vmcnt(0)" ::: "memory");
        } else {
            XB_SPIN(xb_ld(&bar[XB_XGEN(b.x)]) == gen, bar);
            __builtin_amdgcn_fence(__ATOMIC_ACQUIRE, "agent");
            asm volatile("s_waitcnt vmcnt(0)" ::: "memory");
        }
    }
    __syncthreads();
}

struct CvtSrc { const float *w_in, *w_out, *w_up, *w_down, *norm_mix, *out_norm, *norm_ffn; bf16 *Win_t, *Wout_t, *Wup_t, *Wdn_t; };
__device__ __forceinline__ void cvt_layer_item(const CvtSrc& c, int l, int r, LAS float* scr, int lane) {
    const float* W; bf16* WT; const float* gain; int K, N, mode;
    if (r < 1408) { W = c.w_in + (size_t)l * DM * NIN; K = DM; N = NIN; WT = c.Win_t + (size_t)l * NIN * DM; gain = c.norm_mix + l * DM; mode = 1; }
    else if (r < 1920) { r -= 1408; W = c.w_out + (size_t)l * DM * DM; K = DM; N = DM; WT = c.Wout_t + (size_t)l * DM * DM; gain = c.out_norm + l * DM; mode = 0; }
    else if (r < 4736) { r -= 1920; W = c.w_up + (size_t)l * DM * NUP; K = DM; N = NUP; WT = c.Wup_t + (size_t)l * NUP * DM; gain = c.norm_ffn + l * DM; mode = 2; }
    else { r -= 4736; W = c.w_down + (size_t)l * DFF * DM; K = DFF; N = DM; WT = c.Wdn_t + (size_t)l * DM * DFF; gain = nullptr; mode = 0; }
    cvt_item(W, K, N, WT, gain, mode, scr, r, lane);
}
__device__ __forceinline__ const float* ldptr(const volatile LAS unsigned* PT, int k) {
    const unsigned lo = __builtin_amdgcn_readfirstlane(PT[2 * k]), hi = __builtin_amdgcn_readfirstlane(PT[2 * k + 1]);
    return (const float*)(const __attribute__((address_space(1))) float*)(((unsigned long long)hi << 32) | lo);
}
struct Args { const float* in[14]; float* out; unsigned char* ws; };

__device__ __forceinline__ void norm_store_rows(const LAS float* tile, bf16* Y, int t0, int coff, int wave, int lane) {
#pragma unroll 2
    for (int i = 0; i < 8; ++i) { const int r = wave * 8 + i; const f32x4 v = *(const LAS f32x4*)(tile + r * 260 + lane * 4);
        const float ss = wave_sum((v[0] * v[0] + v[1] * v[1]) + (v[2] * v[2] + v[3] * v[3]));
        const float rs = __builtin_amdgcn_rsqf(ss * (1.0f / 256.0f) + EPS);
        v2u o; o.x = pk2(v[0] * rs, v[1] * rs); o.y = pk2(v[2] * rs, v[3] * rs);
        *(__attribute__((address_space(1))) v2u*)(Y + (size_t)(t0 + r) * DM + coff + lane * 4) = o; }
}

typedef short v4i16_t __attribute__((ext_vector_type(4)));
__device__ __forceinline__ bf16x8 vtfrag(const LAS bf16* p) {
    const v4i16_t lo = __builtin_amdgcn_ds_read_tr16_b64_v4i16((LAS v4i16_t*)p), hi = __builtin_amdgcn_ds_read_tr16_b64_v4i16((LAS v4i16_t*)(p + 4 * 96));
    return (bf16x8){lo[0], lo[1], lo[2], lo[3], hi[0], hi[1], hi[2], hi[3]};
}
__device__ __forceinline__ void mixer_unit(LAS unsigned char* lds, int unit, const bf16* P, bf16* Y, const float* conv_w, const float* sgu_norm, const float* sgu_w, const float* sgu_b, int tid, int wave, int lane) {
    const int t0 = unit * 64;
    asm volatile("" : "+v"(tid), "+v"(lane));
    LAS bf16* vnT = (LAS bf16*)lds;
    LAS float* tile = (LAS float*)(lds + 69632);
    LAS float* sm_ss = (LAS float*)(lds + 69632 + 66560);
    {
        const int hd = wave, r = lane & 31, h = lane >> 5;
        const int pr = (r & 0x13) | ((r & 4) << 1) | ((r & 8) >> 1);
        LAS bf16* Vr = (LAS bf16*)(lds + wave * 6144);
        const LAS bf16* vtb = Vr + (8 * h + ((lane & 15) >> 2)) * 96 + 16 * ((lane >> 4) & 1) + 4 * (lane & 3);
        f32x16 oacc[2][2];
        bf16x8 kfn[4]; v4u vvn[4];
        { const bf16* kp = P + (size_t)(t0 + 32 + pr) * NIN + 1792 + hd * 64 + 8 * h;
#pragma unroll
          for (int ks = 0; ks < 4; ++ks) kfn[ks] = *(const __attribute__((address_space(1))) bf16x8*)(kp + 16 * ks);
#pragma unroll
          for (int i = 0; i < 4; ++i) vvn[i] = *(const __attribute__((address_space(1))) v4u*)(P + (size_t)(t0 + 32 + (lane >> 3) + 8 * i) * NIN + 2304 + hd * 64 + 8 * (lane & 7)); }
        bf16x8 kf2[4]; v4u vv2[4];
        { const bf16* kp = P + (size_t)(t0 + pr) * NIN + 1792 + hd * 64 + 8 * h;
#pragma unroll
          for (int ks = 0; ks < 4; ++ks) kf2[ks] = *(const __attribute__((address_space(1))) bf16x8*)(kp + 16 * ks);
#pragma unroll
          for (int i = 0; i < 4; ++i) vv2[i] = *(const __attribute__((address_space(1))) v4u*)(P + (size_t)(t0 + (lane >> 3) + 8 * i) * NIN + 2304 + hd * 64 + 8 * (lane & 7)); }
        LAS bf16x8* Qs = (LAS bf16x8*)(lds + 49152 + wave * 8192);
#pragma unroll
        for (int ks = 0; ks < 4; ++ks) { Qs[ks * 64 + lane] = *(const __attribute__((address_space(1))) bf16x8*)(P + (size_t)(t0 + r) * NIN + 1280 + hd * 64 + 16 * ks + 8 * h); Qs[(4 + ks) * 64 + lane] = *(const __attribute__((address_space(1))) bf16x8*)(P + (size_t)(t0 + 32 + r) * NIN + 1280 + hd * 64 + 16 * ks + 8 * h); }
#pragma unroll
        for (int a = 0; a < 2; ++a)
#pragma unroll
            for (int b = 0; b < 2; ++b) oacc[a][b] = (f32x16){};
        float lsA = 1.0f, lsB = 1.0f; bool actA = true, actB = true;
#define SB_CHAIN(Z, O0, O1, SURV, DIAGV) do { \
            float om[16], be[16]; \
            _Pragma("unroll") for (int jj = 0; jj < 16; ++jj) { const float zz = Z[jj]; const float ex = __builtin_amdgcn_exp2f(-fabsf(zz)); const float rr = __builtin_amdgcn_rcpf(1.0f + ex); const float er = ex * rr; \
                be[jj] = zz >= 0.f ? rr : er; om[jj] = zz >= 0.f ? er : rr; } \
            if (DIAGV) { _Pragma("unroll") for (int jj = 0; jj < 16; ++jj) { const int keyl = 16 * (jj >> 3) + 8 * h + (jj & 7); const bool valid = keyl < r; om[jj] = valid ? om[jj] : 1.0f; be[jj] = valid ? be[jj] : 0.f; } } \
            float sl[8], sh[8]; sl[7] = 1.0f; sh[7] = 1.0f; \
            _Pragma("unroll") for (int i = 6; i >= 0; --i) { sl[i] = sl[i + 1] * om[i + 1]; sh[i] = sh[i + 1] * om[8 + i + 1]; } \
            const float pl = sl[0] * om[0], ph = sh[0] * om[8]; \
            const float plx = __shfl_xor(pl, 32), phx = __shfl_xor(ph, 32); \
            const float hh = ph * phx; \
            const float sc_hi = SURV * (h ? 1.0f : phx), sc_lo = SURV * (hh * (h ? 1.0f : plx)); \
            unsigned wp[8]; \
            _Pragma("unroll") for (int i = 0; i < 8; i += 2) { wp[i >> 1] = pk2(be[i] * sl[i] * sc_lo, be[i + 1] * sl[i + 1] * sc_lo); wp[4 + (i >> 1)] = pk2(be[8 + i] * sh[i] * sc_hi, be[9 + i] * sh[i + 1] * sc_hi); } \
            SURV *= (pl * plx) * hh; \
            const bf16x8 w0 = __builtin_bit_cast(bf16x8, (v4u){wp[0], wp[1], wp[2], wp[3]}), w1 = __builtin_bit_cast(bf16x8, (v4u){wp[4], wp[5], wp[6], wp[7]}); \
            O0 = __builtin_amdgcn_mfma_f32_32x32x16_bf16(vtfrag(vtb), w0, O0, 0, 0, 0); \
            O0 = __builtin_amdgcn_mfma_f32_32x32x16_bf16(vtfrag(vtb + 16 * 96), w1, O0, 0, 0, 0); \
            O1 = __builtin_amdgcn_mfma_f32_32x32x16_bf16(vtfrag(vtb + 32), w0, O1, 0, 0, 0); \
            O1 = __builtin_amdgcn_mfma_f32_32x32x16_bf16(vtfrag(vtb + 16 * 96 + 32), w1, O1, 0, 0, 0); } while (0)
        for (int k0 = t0 + 32;; k0 -= 32) {
            const bool doA = actA && (k0 <= t0);
            f32x16 zB = {}, zA = {};
            if (actB) {
#pragma unroll
                for (int ks = 0; ks < 4; ++ks) zB = __builtin_amdgcn_mfma_f32_32x32x16_bf16(kfn[ks], Qs[(4 + ks) * 64 + lane], zB, 0, 0, 0); }
            if (doA) {
#pragma unroll
                for (int ks = 0; ks < 4; ++ks) zA = __builtin_amdgcn_mfma_f32_32x32x16_bf16(kfn[ks], Qs[ks * 64 + lane], zA, 0, 0, 0); }
#pragma unroll
            for (int i = 0; i < 4; ++i) { const int key = (lane >> 3) + 8 * i, c = lane & 7; *(LAS v4u*)(Vr + key * 96 + 8 * c) = vvn[i]; }
#pragma unroll
            for (int ks = 0; ks < 4; ++ks) kfn[ks] = kf2[ks];
#pragma unroll
            for (int i = 0; i < 4; ++i) vvn[i] = vv2[i];
            if (k0 >= 64) { const bf16* kp = P + (size_t)(k0 - 64 + pr) * NIN + 1792 + hd * 64 + 8 * h;
#pragma unroll
                for (int ks = 0; ks < 4; ++ks) kf2[ks] = *(const __attribute__((address_space(1))) bf16x8*)(kp + 16 * ks);
#pragma unroll
                for (int i = 0; i < 4; ++i) vv2[i] = *(const __attribute__((address_space(1))) v4u*)(P + (size_t)(k0 - 64 + (lane >> 3) + 8 * i) * NIN + 2304 + hd * 64 + 8 * (lane & 7)); }
            if (actB) { const bool dg = (k0 == t0 + 32); SB_CHAIN(zB, oacc[1][0], oacc[1][1], lsB, dg);
                if (__builtin_amdgcn_ballot_w64(lsB > 1e-37f) == 0ull) actB = false; }
            if (doA) { const bool dg = (k0 == t0); SB_CHAIN(zA, oacc[0][0], oacc[0][1], lsA, dg);
                if (__builtin_amdgcn_ballot_w64(lsA > 1e-37f) == 0ull) actA = false; }
            if (k0 < 32 || !(actA || actB)) break;
        }
#undef SB_CHAIN
#pragma unroll
        for (int qh = 0; qh < 2; ++qh) { float ss = 0.f;
#pragma unroll
            for (int j = 0; j < 16; ++j) ss += oacc[qh][0][j] * oacc[qh][0][j] + oacc[qh][1][j] * oacc[qh][1][j];
            ss += __shfl_xor(ss, 32);
            if (h == 0) sm_ss[(32 * qh + r) * 8 + hd] = ss; }
        LDS_WAIT(); __syncthreads();
#pragma unroll
        for (int qh = 0; qh < 2; ++qh) {
            const f32x4 sa = *(const LAS f32x4*)(sm_ss + (32 * qh + r) * 8), sb = *(const LAS f32x4*)(sm_ss + (32 * qh + r) * 8 + 4);
            const float tot = ((sa[0] + sa[1]) + (sa[2] + sa[3])) + ((sb[0] + sb[1]) + (sb[2] + sb[3]));
            const float rs = __builtin_amdgcn_rsqf(tot * (1.0f / 512.0f) + EPS);
            bf16* yp = Y + (size_t)(t0 + 32 * qh + r) * DM + 512 + hd * 64 + 8 * h;
#pragma unroll
            for (int db = 0; db < 2; ++db)
#pragma unroll
                for (int kk = 0; kk < 2; ++kk) { const f32x16& o = oacc[qh][db]; const int ga = 8 * kk, gb2 = 8 * kk + 4;
                    const unsigned ax = pk2(o[ga + 0] * rs, o[ga + 1] * rs), ay = pk2(o[ga + 2] * rs, o[ga + 3] * rs), bx_ = pk2(o[gb2 + 0] * rs, o[gb2 + 1] * rs), by_ = pk2(o[gb2 + 2] * rs, o[gb2 + 3] * rs);
                    auto sx = __builtin_amdgcn_permlane32_swap(ax, bx_, false, false), sy = __builtin_amdgcn_permlane32_swap(ay, by_, false, false);
                    v4u w; w.x = sx[0]; w.y = sy[0]; w.z = sx[1]; w.w = sy[1];
                    *(__attribute__((address_space(1))) v4u*)(yp + 32 * db + 16 * kk) = w; }
        }
    }
    const int c8 = (tid & 31) * 8, rg = tid >> 5, tb = t0 + 4 * rg;
    v4u gb[4], gc[6], hc[6];
#pragma unroll
    for (int i = 0; i < 6; ++i) { const int t = tb - 2 + i; const bool ok = t >= 0; const bf16* rp = P + (size_t)(ok ? t : 0) * NIN;
        gc[i] = ok ? *(const __attribute__((address_space(1))) v4u*)(rp + 256 + c8) : (v4u){0u, 0u, 0u, 0u}; hc[i] = ok ? *(const __attribute__((address_space(1))) v4u*)(rp + 512 + c8) : (v4u){0u, 0u, 0u, 0u};
        if (i >= 2) gb[i - 2] = *(const __attribute__((address_space(1))) v4u*)(rp + c8); }
    const int tc = t0 & ~127, dt = t0 - tc, ns = dt + 64;
    v2u uu[16];
#pragma unroll
    for (int i = 0; i < 16; ++i) { const int s = wave + 8 * i; uu[i] = (s < ns) ? *(const __attribute__((address_space(1))) v2u*)(P + (size_t)(tc + s) * NIN + 1024 + lane * 4) : (v2u){0u, 0u}; }
    const int h = wave >> 1, rh = wave & 1, r32 = lane & 31, hi = lane >> 5;
    const int tcl = dt + 32 * rh + r32;
    const int nk = (dt + 32 * rh + 32) >> 4;
    f32x4 wa[8], wb[8];
    { const float* wrow = sgu_w + ((size_t)h * 128 + tcl) * 128;
#pragma unroll
      for (int ks = 0; ks < 8; ++ks) { const int s0 = ks * 16 + 8 * hi; if (ks < nk) { wa[ks] = *(const __attribute__((address_space(1))) f32x4*)(wrow + s0); wb[ks] = *(const __attribute__((address_space(1))) f32x4*)(wrow + s0 + 4); } else { wa[ks] = (f32x4){0.f, 0.f, 0.f, 0.f}; wb[ks] = wa[ks]; } } }
    {
        float w0[8], w1[8], w2[8];
        { const f32x4 a0 = *(const __attribute__((address_space(1))) f32x4*)(conv_w + c8), a1 = *(const __attribute__((address_space(1))) f32x4*)(conv_w + c8 + 4), b0 = *(const __attribute__((address_space(1))) f32x4*)(conv_w + 256 + c8), b1 = *(const __attribute__((address_space(1))) f32x4*)(conv_w + 256 + c8 + 4), d0 = *(const __attribute__((address_space(1))) f32x4*)(conv_w + 512 + c8), d1 = *(const __attribute__((address_space(1))) f32x4*)(conv_w + 512 + c8 + 4);
#pragma unroll
          for (int e = 0; e < 4; ++e) { w0[e] = a0[e]; w0[4 + e] = a1[e]; w1[e] = b0[e]; w1[4 + e] = b1[e]; w2[e] = d0[e]; w2[4 + e] = d1[e]; } }
        float pr_[6][8];
#pragma unroll
        for (int i = 0; i < 6; ++i) { const unsigned ga[4] = {gc[i].x, gc[i].y, gc[i].z, gc[i].w}, ha[4] = {hc[i].x, hc[i].y, hc[i].z, hc[i].w};
#pragma unroll
            for (int e = 0; e < 4; ++e) { pr_[i][2 * e] = bflo(ga[e]) * bflo(ha[e]); pr_[i][2 * e + 1] = bfhi(ga[e]) * bfhi(ha[e]); } }
#pragma unroll
        for (int i = 0; i < 4; ++i) { const unsigned ba[4] = {gb[i].x, gb[i].y, gb[i].z, gb[i].w}; float o[8];
#pragma unroll
            for (int e = 0; e < 4; ++e) { o[2 * e] = bflo(ba[e]) * (w0[2 * e] * pr_[i][2 * e] + w1[2 * e] * pr_[i + 1][2 * e] + w2[2 * e] * pr_[i + 2][2 * e]);
                o[2 * e + 1] = bfhi(ba[e]) * (w0[2 * e + 1] * pr_[i][2 * e + 1] + w1[2 * e + 1] * pr_[i + 1][2 * e + 1] + w2[2 * e + 1] * pr_[i + 2][2 * e + 1]); }
            LAS f32x4* tp = (LAS f32x4*)(tile + (4 * rg + i) * 260 + c8); tp[0] = (f32x4){o[0], o[1], o[2], o[3]}; tp[1] = (f32x4){o[4], o[5], o[6], o[7]}; }
    }
    LDS_WAIT(); __syncthreads();
    norm_store_rows(tile, Y, t0, 0, wave, lane);
    { const f32x4 g = *(const __attribute__((address_space(1))) f32x4*)(sgu_norm + lane * 4);
#pragma unroll
      for (int i = 0; i < 16; ++i) { const int s = wave + 8 * i;
        if (s < ns) { const v2u u = uu[i];
        const float v0 = bflo(u.x), v1 = bfhi(u.x), v2 = bflo(u.y), v3 = bfhi(u.y);
        const float ss = wave_sum((v0 * v0 + v1 * v1) + (v2 * v2 + v3 * v3)); const float rs = __builtin_amdgcn_rsqf(ss * (1.0f / 256.0f) + EPS);
        const unsigned a = pk2(v0 * rs * g[0], v1 * rs * g[1]), b = pk2(v2 * rs * g[2], v3 * rs * g[3]);
        const int sx = s ^ (((lane >> 1) & 7) << 3);
        vnT[(lane * 4 + 0) * 136 + sx] = (bf16)(a & 0xffffu); vnT[(lane * 4 + 1) * 136 + sx] = (bf16)(a >> 16); vnT[(lane * 4 + 2) * 136 + sx] = (bf16)(b & 0xffffu); vnT[(lane * 4 + 3) * 136 + sx] = (bf16)(b >> 16); } } }
    float ug0[16], ug1[16], bbv[16];
#pragma unroll
    for (int j = 0; j < 16; ++j) { const int rl = 32 * rh + (j & 3) + 8 * (j >> 2) + 4 * hi; const bf16* up = P + (size_t)(t0 + rl) * NIN + 768 + h * 64;
        ug0[j] = bf1(((const __attribute__((address_space(1))) bf16*)up)[r32]); ug1[j] = bf1(((const __attribute__((address_space(1))) bf16*)up)[32 + r32]); bbv[j] = ((const __attribute__((address_space(1))) float*)sgu_b)[h * 128 + dt + rl]; }
    LDS_WAIT(); __syncthreads();
    {
        f32x16 o0 = {}, o1 = {};
#pragma unroll
        for (int ks = 0; ks < 8; ++ks) if (ks < nk) { const int s0 = ks * 16 + 8 * hi;
            float wv[8] = {wa[ks][0], wa[ks][1], wa[ks][2], wa[ks][3], wb[ks][0], wb[ks][1], wb[ks][2], wb[ks][3]};
#pragma unroll
            for (int i = 0; i < 8; ++i) wv[i] = (s0 + i <= tcl) ? wv[i] : 0.f;
            v4u ap; ap.x = pk2(wv[0], wv[1]); ap.y = pk2(wv[2], wv[3]); ap.z = pk2(wv[4], wv[5]); ap.w = pk2(wv[6], wv[7]);
            const bf16x8 af = __builtin_bit_cast(bf16x8, ap);
            const int sw = s0 ^ (((r32 >> 3) & 3) << 3);
            const bf16x8 b0 = *(const LAS bf16x8*)(vnT + (h * 64 + r32) * 136 + sw), b1 = *(const LAS bf16x8*)(vnT + (h * 64 + 32 + r32) * 136 + (sw ^ 32));
            o0 = __builtin_amdgcn_mfma_f32_32x32x16_bf16(af, b0, o0, 0, 0, 0);
            o1 = __builtin_amdgcn_mfma_f32_32x32x16_bf16(af, b1, o1, 0, 0, 0); }
#pragma unroll
        for (int j = 0; j < 16; ++j) { const int rl = 32 * rh + (j & 3) + 8 * (j >> 2) + 4 * hi;
            tile[rl * 260 + h * 64 + r32] = ug0[j] * (o0[j] + bbv[j]);
            tile[rl * 260 + h * 64 + 32 + r32] = ug1[j] * (o1[j] + bbv[j]); }
    }
    LDS_WAIT(); __syncthreads();
    norm_store_rows(tile, Y, t0, 256, wave, lane);
    LDS_WAIT(); __syncthreads();
}

__global__ void __launch_bounds__(NTHR, 2) hybrid_fwd(Args args) {
    extern __shared__ __attribute__((aligned(16))) unsigned char lds_raw[];
    LAS unsigned char* lds = (LAS unsigned char*)lds_raw;
    cg::grid_group grid = cg::this_grid();
    volatile LAS unsigned* MISC = (volatile LAS unsigned*)(lds + LDS_BYTES - 64);
    volatile LAS unsigned* PT = (volatile LAS unsigned*)(lds + LDS_BYTES - 256);
    if (threadIdx.x < 16) MISC[threadIdx.x] = 0u;
    if (threadIdx.x == 0) {
#define PUTP(k) { const unsigned long long v_ = (unsigned long long)args.in[k]; PT[2 * (k)] = (unsigned)v_; PT[2 * (k) + 1] = (unsigned)(v_ >> 32); }
        PUTP(0) PUTP(1) PUTP(2) PUTP(3) PUTP(4) PUTP(5) PUTP(6) PUTP(7) PUTP(8) PUTP(9) PUTP(10) PUTP(11) PUTP(12) PUTP(13)
#undef PUTP
    }
    __syncthreads();
    XcdBarrier xbar = xcd_barrier_post((unsigned*)(args.ws + WS_BAR), MISC);
    const int tid = threadIdx.x, lane = tid & 63, wave = __builtin_amdgcn_readfirstlane(tid >> 6);
    const int G = gridDim.x, bx = blockIdx.x;
    const int gw = bx * NWAVES + wave, NGW = G * NWAVES;
    unsigned char* ws = args.ws;
#define INP(k) ldptr(PT, (k))
#define MAKE_CS() const CvtSrc cs{INP(2), INP(8), INP(10), INP(12), INP(1), INP(7), INP(9), Win_t, Wout_t, Wup_t, Wdn_t}
    float* xo = args.out;
#define PHASE_PTRS() unsigned char* w_ = ws; float* xcur = xo; asm volatile("" : "+s"(w_), "+s"(xcur)); \
    w_ = (unsigned char*)(__attribute__((address_space(1))) unsigned char*)w_; xcur = (float*)(__attribute__((address_space(1))) float*)xcur;     \
    bf16* Win_t = (bf16*)(w_ + WS_WIN); bf16* Wout_t = (bf16*)(w_ + WS_WOUT); bf16* Wup_t = (bf16*)(w_ + WS_WUP); bf16* Wdn_t = (bf16*)(w_ + WS_WDN); \
    float* part = (float*)(w_ + WS_PART); bf16* XB = (bf16*)(w_ + WS_XB); bf16* P = (bf16*)(w_ + WS_P); bf16* Y = (bf16*)(w_ + WS_Y); bf16* A = (bf16*)(w_ + WS_A); \
    (void)Win_t; (void)Wout_t; (void)Wup_t; (void)Wdn_t; (void)part; (void)XB; (void)P; (void)Y; (void)A; (void)xcur

    for (int step = -1; step < 5 * DEPTH; ++step) {
        const int l = step < 0 ? 0 : step / 5, ph = step < 0 ? -1 : step % 5;
        int cvt_layer = -1, cvt_first = 0, cvt_n = 0, cvt_nu = 0;
        if (ph < 0) {
            PHASE_PTRS(); const float* x_in = INP(0);
            int gw_ = gw, lane_ = lane; asm volatile("" : "+s"(gw_), "+v"(lane_));
            for (int m = gw_; m < S; m += NGW) { const __attribute__((address_space(1))) f32x4* xr = (const __attribute__((address_space(1))) f32x4*)(x_in + (size_t)m * DM) + lane_; f32x4 v[4]; float ss = 0.f;
#pragma unroll
                for (int j = 0; j < 4; ++j) { v[j] = __builtin_nontemporal_load(xr + 64 * j); ss += (v[j][0] * v[j][0] + v[j][1] * v[j][1]) + (v[j][2] * v[j][2] + v[j][3] * v[j][3]); }
                ss = wave_sum(ss);
                __attribute__((address_space(1))) v2u* o8 = (__attribute__((address_space(1))) v2u*)(XB + (size_t)m * DM) + lane_;
#pragma unroll
                for (int j = 0; j < 4; ++j) { v2u o; o.x = pk2(v[j][0], v[j][1]); o.y = pk2(v[j][2], v[j][3]); o8[64 * j] = o; }
                if (lane_ < 16) ((__attribute__((address_space(1))) float*)part)[(size_t)m * 16 + lane_] = lane_ == 0 ? ss : 0.f; }
            cvt_layer = 0; cvt_first = 0; cvt_n = 6144; cvt_nu = 0;
        } else if (ph == 0) {
            PHASE_PTRS(); pg8::Gemm g{XB, Win_t + (size_t)l * NIN * DM, S, NIN, DM, 256}; pg8::StaticOrder So; So.init(S, NIN, G, bx);
            pg8::EpiScaleBf16 E{P, NIN, part, (LAS float*)(lds + 131072 + 8192)};
            pg8::gemm_phase<pg8::EpiScaleBf16, pg8::StaticOrder, true, true>(lds, g, So, E);
            if (l + 1 < DEPTH) { cvt_layer = l + 1; cvt_first = 0; cvt_n = 1920; cvt_nu = (S / 256) * (NIN / 256); }
        } else if (ph == 1) {
            PHASE_PTRS();
            for (int u = bx; u < S / 64; u += G)
                mixer_unit(lds, u, P, Y, INP(3) + l * 3 * 256, INP(4) + l * 256, INP(5) + (size_t)l * 4 * 128 * 128, INP(6) + l * 4 * 128, tid, wave, lane);
        } else if (ph == 2) {
            PHASE_PTRS(); pg8::Gemm g{Y, Wout_t + (size_t)l * DM * DM, S, DM, DM, 256}; pg8::StaticOrder So; So.init(S, DM, G, bx);
            pg8::EpiResid E{XB, part};
            pg8::gemm_phase<pg8::EpiResid, pg8::StaticOrder, true, true>(lds, g, So, E);
        } else if (ph == 3) {
            PHASE_PTRS(); pg8::Gemm g{XB - 2 * DM, Wup_t + (size_t)l * NUP * DM, 65 * 256, NUP, DM, 254}; pg8::StaticOrder So; So.init(65 * 256, NUP, G, bx);
            pg8::EpiGate E{A, part, INP(11) + (size_t)l * 3 * NUP, (LAS float*)(lds + 131072)};
            pg8::gemm_phase<pg8::EpiGate, pg8::StaticOrder, true, true>(lds, g, So, E);
            if (l + 1 < DEPTH) { cvt_layer = l + 1; cvt_first = 1920; cvt_n = 4224; cvt_nu = 65 * (NUP / 256); }
        } else {
            PHASE_PTRS(); pg8::Gemm g{A, Wdn_t + (size_t)l * DM * DFF, S, DM, DFF, 256}; pg8::StaticOrder So; So.init(S, DM, G, bx);
            pg8::EpiResid E{XB, part};
            pg8::gemm_phase<pg8::EpiResid, pg8::StaticOrder, true, true>(lds, g, So, E);
        }
        if (cvt_layer >= 0) {
            const int first_idle = cvt_nu > 0 ? cvt_nu - ((cvt_nu + G - 1) / G - 1) * G : 0; const bool some_idle = first_idle < G;
            if (!some_idle || bx >= first_idle) { const int nw = (some_idle ? G - first_idle : G) * NWAVES, iw = (some_idle ? bx - first_idle : bx) * NWAVES + wave;
                PHASE_PTRS(); LAS float* scr = (LAS float*)(lds + wave * 16384); int lane_ = lane; asm volatile("" : "+v"(lane_));
                MAKE_CS(); for (int it = iw; it < cvt_n; it += nw) cvt_layer_item(cs, cvt_layer, cvt_first + it, scr, lane_); } }
        if (ws == nullptr) grid.sync();
        xcd_barrier(xbar);
    }
    { const float* nfin = INP(13); const bf16* XBf = (const bf16*)(ws + WS_XB);
      for (int m = gw; m < S; m += NGW) { const __attribute__((address_space(1))) v2u* xr = (const __attribute__((address_space(1))) v2u*)(XBf + (size_t)m * DM) + lane; f32x4 v[4]; float ss = 0.f;
#pragma unroll
        for (int j = 0; j < 4; ++j) { const v2u u = xr[64 * j]; v[j] = (f32x4){bflo(u.x), bfhi(u.x), bflo(u.y), bfhi(u.y)}; ss += (v[j][0] * v[j][0] + v[j][1] * v[j][1]) + (v[j][2] * v[j][2] + v[j][3] * v[j][3]); }
        const float rs = __builtin_amdgcn_rsqf(wave_sum(ss) * (1.0f / 1024.0f) + EPS);
        __attribute__((address_space(1))) f32x4* orow = (__attribute__((address_space(1))) f32x4*)(xo + (size_t)m * DM) + lane;
#pragma unroll
        for (int j = 0; j < 4; ++j) { const f32x4 g = *((const __attribute__((address_space(1))) f32x4*)nfin + lane + 64 * j); __builtin_nontemporal_store(v[j] * rs * g, orow + 64 * j); } } }
}

extern "C" void kernel_launch(void* const* d_in, const int* in_sizes, int n_in, void* d_out, int out_size, void* d_ws, size_t ws_size, hipStream_t stream) {
    static int grid = 0;
    if (grid == 0) {
        if (n_in != 14 || out_size != S * DM || ws_size < WS_END) { fprintf(stderr, "kernel_launch: unexpected shapes / workspace (%d inputs, out %d, ws %zu)\n", n_in, out_size, ws_size); grid = -1; return; }
        int dev = 0, cus = 0;
        hipGetDevice(&dev); hipDeviceGetAttribute(&cus, hipDeviceAttributeMultiprocessorCount, dev);
        hipFuncSetAttribute((const void*)hybrid_fwd, hipFuncAttributeMaxDynamicSharedMemorySize, LDS_BYTES);
        (void)hipGetLastError();
        grid = cus * 1;
    }
    if (grid < 0) return;
    hipMemsetAsync((unsigned char*)d_ws + WS_BAR, 0, 16384 + 4096, stream);
    Args a{};
    for (int i = 0; i < 14; ++i) a.in[i] = (const float*)d_in[i];
    a.out = (float*)d_out; a.ws = (unsigned char*)d_ws;
    void* kargs[] = {&a};
    hipError_t e = hipLaunchCooperativeKernel((const void*)hybrid_fwd, dim3(grid), dim3(NTHR), kargs, LDS_BYTES, stream);
    if (e != hipSuccess) fprintf(stderr, "cooperative launch failed: %s (grid %d)\n", hipGetErrorString(e), grid);
}
```

```cpp
#include <hip/hip_runtime.h>
#include <hip/hip_cooperative_groups.h>
#include <cstdio>
#include <cstdint>
namespace cg = cooperative_groups;
namespace pg8 {
#define PG8_LAS __attribute__((address_space(3)))
typedef unsigned short bf16_t;
typedef short bf16x8 __attribute__((ext_vector_type(8)));
typedef float f32x4 __attribute__((ext_vector_type(4)));
typedef unsigned u32x4 __attribute__((ext_vector_type(4)));
typedef unsigned u32x2 __attribute__((ext_vector_type(2)));
constexpr int BM = 256, BK = 64, HALF = 128, HTB = HALF * BK * 2  , STAGE_BYTES = 8 * HTB, NXCD = 8, WGM = 8;

__host__ __device__ __forceinline__ int lds_byte(int r, int c) { const int st = (r >> 4) * 2 + (c >> 5), rr = r & 15, cc = c & 31, ob = rr * 64 + cc * 2; return st * 1024 + (ob ^ (((ob >> 9) & 1) << 5)); }
__host__ __device__ __forceinline__ void stage_rc(int b, int& R, int& C) { const int st = b / 1024, sb = b % 1024, swz = sb ^ (((sb >> 9) & 1) << 5); R = (st >> 1) * 16 + swz / 64; C = (st & 1) * 32 + (swz % 64) / 2; }
__host__ __device__ __forceinline__ int perm32(int rho) { const int n = rho >> 4, i = rho & 15; return 8 * (i >> 2) + 4 * n + (i & 3); }

struct Unit { int pm, pn; };
struct Gemm { const bf16_t* A; const bf16_t* Bt; int M, N, K; int arows; };

struct StaticOrder {
    int nM, nN, nwg, G, c;
    __host__ __device__ void init(int M, int N, int G_, int c_) { nM = M / BM; nN = N / BM; nwg = nM * nN; G = G_; c = c_; }
    __host__ __device__ bool next(int i, Unit& u) const {
        const long L = (long)i * G + c; if (L >= nwg) return false;
        int wgid = (int)L; { const int q = nwg / NXCD, r = nwg % NXCD, xcd = wgid % NXCD, off = wgid / NXCD; wgid = (xcd < r ? xcd * (q + 1) : r * (q + 1) + (xcd - r) * q) + off; }
        const int nig = WGM * nN, gid = wgid / nig, fm = gid * WGM, gsz = (nM - fm) < WGM ? (nM - fm) : WGM;
        u.pm = fm + ((wgid % nig) % gsz); u.pn = (wgid % nig) / gsz; return true;
    }
    __device__ __forceinline__ void a_ready(const Unit&) const {}
    __device__ __forceinline__ void done(const Unit&) const {}
};

__device__ __forceinline__ unsigned cvt_pk_bf16(float lo, float hi) { unsigned r; asm volatile("v_cvt_pk_bf16_f32 %0, %1, %2" : "=v"(r) : "v"(lo), "v"(hi)); return r; }
struct EpiScaleBf16 {
    static constexpr bool PERM = true, AFTER_DRAIN = false, PERMA = false, WIDE = true;
    bf16_t* O; int ldc; const float* part; PG8_LAS float* rsl;
    __device__ __forceinline__ void operator()(const f32x4 (&acc)[2][2][4][2], const Unit& u, int wr, int wc, int fr, int fq) const {
        { const int t = (wr * 4 + wc) * 64 + fq * 16 + fr;
          if (t < 256) { const __attribute__((address_space(1))) f32x4* pp = (const __attribute__((address_space(1))) f32x4*)(part + (size_t)(u.pm * BM + t) * 16); const f32x4 a = pp[0], b = pp[1], c = pp[2], d = pp[3];
              const f32x4 s4 = (a + b) + (c + d); const float ss = (s4[0] + s4[1]) + (s4[2] + s4[3]); rsl[t] = __builtin_amdgcn_rsqf(ss * (1.0f / 1024.0f) + 1e-6f); } }
        asm volatile("s_waitcnt lgkmcnt(0)" ::: "memory"); __builtin_amdgcn_s_barrier(); asm volatile("" ::: "memory");
        const int row0 = u.pm * BM + wr * 64 + fr; const int col0 = u.pn * BM + wc * 64 + 8 * fq;
#pragma unroll
        for (int ai = 0; ai < 2; ++ai)
#pragma unroll
            for (int m = 0; m < 4; ++m) { const int row = row0 + ai * HALF + m * 16;
                const float rs = rsl[ai * HALF + wr * 64 + m * 16 + fr];
                bf16_t* rowp = O + (size_t)row * ldc + col0;
#pragma unroll
                for (int bj = 0; bj < 2; ++bj) { const f32x4 v0 = acc[ai][bj][m][0] * rs, v1 = acc[ai][bj][m][1] * rs;
                    u32x4 w; w.x = cvt_pk_bf16(v0[0], v0[1]); w.y = cvt_pk_bf16(v0[2], v0[3]); w.z = cvt_pk_bf16(v1[0], v1[1]); w.w = cvt_pk_bf16(v1[2], v1[3]);
                    *(__attribute__((address_space(1))) u32x4*)(rowp + bj * 32) = w; } }
    }
};
struct EpiResid {
    static constexpr bool PERM = true, AFTER_DRAIN = false, PERMA = false, WIDE = true;
    bf16_t* xb; float* part;
    __device__ __forceinline__ void operator()(const f32x4 (&acc)[2][2][4][2], const Unit& u, int wr, int wc, int fr, int fq) const {
        const int row0 = u.pm * BM + wr * 64 + fr; const int col0 = u.pn * BM + wc * 64 + 8 * fq;
        u32x4 pre[3][2];
#define PG8_RLOAD(g_) do { const size_t o_ = (size_t)(row0 + ((g_) >> 2) * HALF + ((g_) & 3) * 16) * 1024 + col0; \
            pre[(g_) % 3][0] = *(const __attribute__((address_space(1))) u32x4*)(xb + o_); pre[(g_) % 3][1] = *(const __attribute__((address_space(1))) u32x4*)(xb + o_ + 32); } while (0)
        PG8_RLOAD(0); PG8_RLOAD(1);
#pragma unroll
        for (int g = 0; g < 8; ++g) { const int ai = g >> 2, m = g & 3;
            if (g + 2 < 8) PG8_RLOAD(g + 2);
            asm volatile("" ::: "memory");
            const int row = row0 + ai * HALF + m * 16; const size_t off = (size_t)row * 1024 + col0; float ss = 0.f;
#pragma unroll
            for (int bj = 0; bj < 2; ++bj) { const u32x4 b = pre[g % 3][bj];
                const f32x4 b0 = {__uint_as_float(b.x << 16), __uint_as_float(b.x & 0xffff0000u), __uint_as_float(b.y << 16), __uint_as_float(b.y & 0xffff0000u)};
                const f32x4 b1 = {__uint_as_float(b.z << 16), __uint_as_float(b.z & 0xffff0000u), __uint_as_float(b.w << 16), __uint_as_float(b.w & 0xffff0000u)};
                const f32x4 v0 = acc[ai][bj][m][0] + b0, v1 = acc[ai][bj][m][1] + b1;
                ss += (v0[0] * v0[0] + v0[1] * v0[1]) + (v0[2] * v0[2] + v0[3] * v0[3]) + (v1[0] * v1[0] + v1[1] * v1[1]) + (v1[2] * v1[2] + v1[3] * v1[3]);
                u32x4 w; w.x = cvt_pk_bf16(v0[0], v0[1]); w.y = cvt_pk_bf16(v0[2], v0[3]); w.z = cvt_pk_bf16(v1[0], v1[1]); w.w = cvt_pk_bf16(v1[2], v1[3]);
                *(__attribute__((address_space(1))) u32x4*)(xb + off + bj * 32) = w; }
            ss += __shfl_xor(ss, 16); ss += __shfl_xor(ss, 32);
            if (fq == 0) ((__attribute__((address_space(1))) float*)part)[(size_t)row * 16 + u.pn * 4 + wc] = ss;
            asm volatile("" ::: "memory"); }
#undef PG8_RLOAD
    }
};
#define PG8_DPP(oldv, srcv, ctrl) __builtin_bit_cast(float, __builtin_amdgcn_update_dpp(__builtin_bit_cast(int, (float)(oldv)), __builtin_bit_cast(int, (float)(srcv)), (ctrl), 0xf, 0xf, false))
struct EpiGate {
    static constexpr bool PERM = true, AFTER_DRAIN = false, PERMA = true, WIDE = false;
    bf16_t* Aout; const float* part; const float* fconv; PG8_LAS float* xch;
    __device__ __forceinline__ void operator()(f32x4 (&acc)[2][2][4][2], const Unit& u, int wr, int wc, int fr, int fq) const {
        PG8_LAS float* rsl = xch + 2048;
        { const int t = (wr * 4 + wc) * 64 + fq * 16 + fr;
          if (t < 256) { const int row = u.pm * 254 - 2 + t; const bool ok = row >= 0 && row < 16384; const int rc = ok ? row : 0;
              const __attribute__((address_space(1))) f32x4* pp = (const __attribute__((address_space(1))) f32x4*)(part + (size_t)rc * 16); const f32x4 a = pp[0], b = pp[1], c = pp[2], d = pp[3];
              const f32x4 s4 = (a + b) + (c + d); const float ss = (s4[0] + s4[1]) + (s4[2] + s4[3]);
              rsl[t] = ok ? __builtin_amdgcn_rsqf(ss * (1.0f / 1024.0f) + 1e-6f) : 0.f; } }
        asm volatile("s_waitcnt lgkmcnt(0)" ::: "memory"); __builtin_amdgcn_s_barrier(); asm volatile("" ::: "memory");
        const int ccol = wc * 32 + 8 * fq;
#pragma unroll
        for (int ai = 0; ai < 2; ++ai) { const f32x4 rs4 = *(const PG8_LAS f32x4*)(rsl + ai * HALF + wr * 64 + 4 * fr);
#pragma unroll
            for (int m = 0; m < 4; ++m)
#pragma unroll
                for (int bj = 0; bj < 2; ++bj) { acc[ai][bj][m][0] *= rs4[m]; acc[ai][bj][m][1] *= rs4[m]; } }
        if (fr == 15) {
#pragma unroll
            for (int ai = 0; ai < 2; ++ai)
#pragma unroll
                for (int bj = 0; bj < 2; ++bj)
#pragma unroll
                    for (int n = 0; n < 2; ++n) { *(PG8_LAS f32x4*)(xch + ((2 * ai + wr) * 2 + 0) * 256 + bj * HALF + ccol + 4 * n) = acc[ai][bj][2][n]; *(PG8_LAS f32x4*)(xch + ((2 * ai + wr) * 2 + 1) * 256 + bj * HALF + ccol + 4 * n) = acc[ai][bj][3][n]; }
        }
        asm volatile("s_waitcnt lgkmcnt(0)" ::: "memory"); __builtin_amdgcn_s_barrier(); asm volatile("" ::: "memory");
        const int ch0 = u.pn * HALF + ccol;
#pragma unroll
        for (int ai = 0; ai < 2; ++ai) {
            const int grp = 2 * ai + wr;
            u32x2 keep[4];
#pragma unroll
            for (int n = 0; n < 2; ++n) {
                asm volatile("" ::: "memory");
                const float* fw = fconv + ch0 + 4 * n;
                const f32x4 wg0 = *(const __attribute__((address_space(1))) f32x4*)(fw), wg1 = *(const __attribute__((address_space(1))) f32x4*)(fw + 5632), wg2 = *(const __attribute__((address_space(1))) f32x4*)(fw + 2 * 5632);
                const f32x4 wu0 = *(const __attribute__((address_space(1))) f32x4*)(fw + 2816), wu1 = *(const __attribute__((address_space(1))) f32x4*)(fw + 5632 + 2816), wu2 = *(const __attribute__((address_space(1))) f32x4*)(fw + 2 * 5632 + 2816);
                f32x4 g62 = {0.f, 0.f, 0.f, 0.f}, g63 = g62, u62 = g62, u63 = g62;
                if (grp > 0) { const PG8_LAS float* xb_ = xch + ((grp - 1) * 2) * 256 + ccol + 4 * n;
                    g62 = *(const PG8_LAS f32x4*)(xb_); g63 = *(const PG8_LAS f32x4*)(xb_ + 256); u62 = *(const PG8_LAS f32x4*)(xb_ + HALF); u63 = *(const PG8_LAS f32x4*)(xb_ + 256 + HALF); }
                float o[4][4];
#pragma unroll
                for (int j = 0; j < 4; ++j) {
                    const float g0 = acc[ai][0][0][n][j], g1 = acc[ai][0][1][n][j], g2 = acc[ai][0][2][n][j], g3 = acc[ai][0][3][n][j];
                    const float u0 = acc[ai][1][0][n][j], u1 = acc[ai][1][1][n][j], u2 = acc[ai][1][2][n][j], u3 = acc[ai][1][3][n][j];
                    const float gm1 = PG8_DPP(g63[j], g3, 0x111), gm2 = PG8_DPP(g62[j], g2, 0x111);
                    const float um1 = PG8_DPP(u63[j], u3, 0x111), um2 = PG8_DPP(u62[j], u2, 0x111);
                    const float G0 = wg0[j] * gm2 + wg1[j] * gm1 + wg2[j] * g0, G1 = wg0[j] * gm1 + wg1[j] * g0 + wg2[j] * g1, G2 = wg0[j] * g0 + wg1[j] * g1 + wg2[j] * g2, G3 = wg0[j] * g1 + wg1[j] * g2 + wg2[j] * g3;
                    const float U0 = wu0[j] * um2 + wu1[j] * um1 + wu2[j] * u0, U1 = wu0[j] * um1 + wu1[j] * u0 + wu2[j] * u1, U2 = wu0[j] * u0 + wu1[j] * u1 + wu2[j] * u2, U3 = wu0[j] * u1 + wu1[j] * u2 + wu2[j] * u3;
                    o[0][j] = G0 * __builtin_amdgcn_rcpf(1.0f + __builtin_amdgcn_exp2f(G0 * -1.4426950408889634f)) * U0; o[1][j] = G1 * __builtin_amdgcn_rcpf(1.0f + __builtin_amdgcn_exp2f(G1 * -1.4426950408889634f)) * U1;
                    o[2][j] = G2 * __builtin_amdgcn_rcpf(1.0f + __builtin_amdgcn_exp2f(G2 * -1.4426950408889634f)) * U2; o[3][j] = G3 * __builtin_amdgcn_rcpf(1.0f + __builtin_amdgcn_exp2f(G3 * -1.4426950408889634f)) * U3; }
#pragma unroll
                for (int m = 0; m < 4; ++m) { const int r = ai * HALF + wr * 64 + 4 * fr + m, row = u.pm * 254 - 2 + r;
                    u32x2 w; w.x = cvt_pk_bf16(o[m][0], o[m][1]); w.y = cvt_pk_bf16(o[m][2], o[m][3]);
                    if (n == 0) keep[m] = w;
                    else if (r >= 2 && row < 16384) { u32x4 w4; w4.x = keep[m].x; w4.y = keep[m].y; w4.z = w.x; w4.w = w.y; *(__attribute__((address_space(1))) u32x4*)(Aout + (size_t)row * 2816 + ch0) = w4; } }
            }
        }
    }
};
template <class Epi, class Sched, bool ALIGN_EPI = false, bool SP2 = false>
__device__ __forceinline__ void gemm_phase(PG8_LAS unsigned char* lds, const Gemm g, const Sched& S, const Epi& E) {
    int tid = threadIdx.x; asm volatile("" : "+v"(tid));
    const int wid = __builtin_amdgcn_readfirstlane(tid >> 6), lane = tid & 63, wr = wid >> 2, wc = wid & 3, fr = lane & 15, fq = lane >> 4;
    const int K = g.K, nt = K / BK;
    unsigned voffA[2], voffB[2];
#pragma unroll
    for (int i = 0; i < 2; ++i) { int R, C; stage_rc(tid * 16 + i * 8192, R, C); const int Rb = Epi::WIDE ? (64 * (R >> 5) + perm32(R & 31)) : Epi::PERM ? ((R & ~31) + perm32(R & 31)) : R;
        const int Ra = Epi::PERMA ? ((R & ~63) + 4 * (R & 15) + ((R >> 4) & 3)) : R;
        voffA[i] = (unsigned)(Ra * K + C) * 2u; voffB[i] = (unsigned)(Rb * K + C) * 2u; }
    const size_t kstep = (size_t)(BK * 2);
    const size_t hstep = (size_t)HALF * K * 2;
    const size_t hstepB = Epi::WIDE ? (size_t)32 * K * 2 : hstep;
    const size_t tstep = 2 * hstep;
    const size_t tstepA = (size_t)g.arows * K * 2;
    const unsigned ldsw = (unsigned)wid * 1024u;
    const int aoff = lds_byte(wr * 64 + fr, fq * 8), boff = lds_byte(wc * 32 + fr, fq * 8);
#define PG8_SA(b, h) (((b) * 2 + (h)) * HTB)
#define PG8_SB(b, h) ((4 + (b) * 2 + (h)) * HTB)
#define PG8_STAGE(bufoff, gbase, voff) do { _Pragma("unroll") for (int _i = 0; _i < 2; ++_i) \
        __builtin_amdgcn_global_load_lds((const unsigned*)((const char*)(gbase) + (voff)[_i]), (PG8_LAS unsigned*)(lds + (bufoff) + ldsw + _i * 8192), 16, 0, 0); } while (0)
#define PG8_LDA(dst, b, h) do { _Pragma("unroll") for (int m = 0; m < 4; ++m) _Pragma("unroll") for (int k = 0; k < 2; ++k) dst[m][k] = *(const PG8_LAS bf16x8*)(lds + PG8_SA(b, h) + aoff + m * 2048 + k * 1024); } while (0)
#define PG8_LDB(dst, b, h) do { _Pragma("unroll") for (int n = 0; n < 2; ++n) _Pragma("unroll") for (int k = 0; k < 2; ++k) dst[n][k] = *(const PG8_LAS bf16x8*)(lds + PG8_SB(b, h) + boff + n * 2048 + k * 1024); } while (0)
#define PG8_MMA(ai, bj, At, Bt) do { __builtin_amdgcn_s_setprio(1); _Pragma("unroll") for (int m = 0; m < 4; ++m) _Pragma("unroll") for (int n = 0; n < 2; ++n) _Pragma("unroll") for (int k = 0; k < 2; ++k) \
        acc[ai][bj][m][n] = __builtin_amdgcn_mfma_f32_16x16x32_bf16(Bt[n][k], At[m][k], acc[ai][bj][m][n], 0, 0, 0); __builtin_amdgcn_s_setprio(0); } while (0)
#define PG8_WAIT_V(n) asm volatile("s_waitcnt vmcnt(" #n ")" ::: "memory")
#define PG8_WAIT_L(n) asm volatile("s_waitcnt lgkmcnt(" #n ")" ::: "memory")
#define PG8_BAR __builtin_amdgcn_s_barrier()
#define PG8_SCHED __builtin_amdgcn_sched_barrier(0)
    Unit cur, nxt; int ui = 0;
    if (!S.next(0, cur)) return;
    f32x4 acc[2][2][4][2];
#pragma unroll
    for (int a = 0; a < 2; ++a)
#pragma unroll
        for (int b = 0; b < 2; ++b)
#pragma unroll
            for (int m = 0; m < 4; ++m)
#pragma unroll
                for (int n = 0; n < 2; ++n) acc[a][b][m][n] = (f32x4){0.f, 0.f, 0.f, 0.f};
    bf16x8 At[4][2], B0[2][2], B1[2][2];
    const char* cA = (const char*)g.A + (size_t)cur.pm * tstepA; const char* cB = (const char*)g.Bt + (size_t)cur.pn * tstep;
    S.a_ready(cur);
    if constexpr (SP2) {
        PG8_STAGE(PG8_SB(0, 0), cB, voffB); PG8_STAGE(PG8_SB(0, 1), cB + hstepB, voffB); PG8_STAGE(PG8_SA(0, 0), cA, voffA); PG8_STAGE(PG8_SA(0, 1), cA + hstep, voffA);
        if (wr == 1) PG8_BAR;
        PG8_WAIT_V(2); PG8_BAR;
        PG8_STAGE(PG8_SB(1, 0), cB + kstep, voffB); PG8_STAGE(PG8_SA(1, 0), cA + kstep, voffA); PG8_STAGE(PG8_SB(1, 1), cB + hstepB + kstep, voffB);
        PG8_WAIT_V(6); PG8_BAR;
    } else {
        PG8_STAGE(PG8_SB(0, 0), cB, voffB); PG8_STAGE(PG8_SA(0, 0), cA, voffA); PG8_STAGE(PG8_SB(0, 1), cB + hstepB, voffB); PG8_STAGE(PG8_SA(0, 1), cA + hstep, voffA);
        if (wr == 1) PG8_BAR;
        PG8_WAIT_V(4); PG8_BAR;
        PG8_STAGE(PG8_SB(1, 0), cB + kstep, voffB); PG8_STAGE(PG8_SA(1, 0), cA + kstep, voffA); PG8_STAGE(PG8_SB(1, 1), cB + hstepB + kstep, voffB);
        PG8_WAIT_V(6); PG8_BAR;
    }
    for (;;) {
        const bool has_next = S.next(ui + 1, nxt);
        const char* nA = has_next ? (const char*)g.A + (size_t)nxt.pm * tstepA : cA; const char* nB = has_next ? (const char*)g.Bt + (size_t)nxt.pn * tstep : cB;
        for (int t = 0; t < nt; t += 2) {
            const bool last = (t == nt - 2);
            const char* a1 = cA + (size_t)(t + 1) * kstep;
            const char* a2 = last ? nA : cA + (size_t)(t + 2) * kstep; const char* b2 = last ? nB : cB + (size_t)(t + 2) * kstep;
            const char* a3 = a2 + kstep; const char* b3 = b2 + kstep;
            if (last && has_next) S.a_ready(nxt);
            if constexpr (SP2) {
            PG8_LDB(B0, 0, 0); PG8_LDB(B1, 0, 1); PG8_SCHED; PG8_LDA(At, 0, 0); PG8_STAGE(PG8_SA(1, 1), a1 + hstep, voffA);
            PG8_WAIT_V(8); PG8_WAIT_L(0); PG8_BAR; PG8_MMA(0, 0, At, B0); PG8_MMA(0, 1, At, B1); PG8_BAR; PG8_SCHED;
            PG8_LDA(At, 0, 1); PG8_STAGE(PG8_SB(0, 0), b2, voffB); PG8_STAGE(PG8_SB(0, 1), b2 + hstepB, voffB); PG8_STAGE(PG8_SA(0, 0), a2, voffA);
            PG8_WAIT_V(8); PG8_WAIT_L(0); PG8_BAR; PG8_MMA(1, 0, At, B0); PG8_MMA(1, 1, At, B1); PG8_BAR; PG8_SCHED;
            PG8_LDB(B0, 1, 0); PG8_LDB(B1, 1, 1); PG8_SCHED; PG8_LDA(At, 1, 0); PG8_STAGE(PG8_SA(0, 1), a2 + hstep, voffA);
            PG8_WAIT_V(8); PG8_WAIT_L(0); PG8_BAR; PG8_MMA(0, 0, At, B0); PG8_MMA(0, 1, At, B1); PG8_BAR; PG8_SCHED;
            PG8_LDA(At, 1, 1); PG8_STAGE(PG8_SB(1, 0), b3, voffB); PG8_STAGE(PG8_SB(1, 1), b3 + hstepB, voffB); PG8_STAGE(PG8_SA(1, 0), a3, voffA);
            PG8_WAIT_V(8); PG8_WAIT_L(0); PG8_BAR; PG8_MMA(1, 0, At, B0); PG8_MMA(1, 1, At, B1); PG8_BAR; PG8_SCHED;
            } else {
            PG8_LDB(B0, 0, 0); PG8_SCHED; PG8_LDA(At, 0, 0); PG8_STAGE(PG8_SA(1, 1), a1 + hstep, voffA);
            PG8_WAIT_L(8); PG8_BAR; PG8_WAIT_L(0); PG8_MMA(0, 0, At, B0); PG8_BAR; PG8_SCHED;
            PG8_LDB(B1, 0, 1); PG8_STAGE(PG8_SB(0, 0), b2, voffB);
            PG8_BAR; PG8_WAIT_L(0); PG8_MMA(0, 1, At, B1); PG8_BAR;
            PG8_LDA(At, 0, 1); PG8_STAGE(PG8_SA(0, 0), a2, voffA);
            PG8_BAR; PG8_WAIT_L(0); PG8_MMA(1, 0, At, B0); PG8_BAR; PG8_SCHED;
            PG8_STAGE(PG8_SB(0, 1), b2 + hstepB, voffB);
            PG8_WAIT_V(6); PG8_BAR; PG8_MMA(1, 1, At, B1); PG8_BAR;
            PG8_LDB(B0, 1, 0); PG8_SCHED; PG8_LDA(At, 1, 0); PG8_STAGE(PG8_SA(0, 1), a2 + hstep, voffA);
            PG8_WAIT_L(8); PG8_BAR; PG8_WAIT_L(0); PG8_MMA(0, 0, At, B0); PG8_BAR; PG8_SCHED;
            PG8_LDB(B1, 1, 1); PG8_STAGE(PG8_SB(1, 0), b3, voffB);
            PG8_BAR; PG8_WAIT_L(0); PG8_MMA(0, 1, At, B1); PG8_BAR;
            PG8_LDA(At, 1, 1); PG8_STAGE(PG8_SA(1, 0), a3, voffA);
            PG8_BAR; PG8_WAIT_L(0); PG8_MMA(1, 0, At, B0); PG8_BAR; PG8_SCHED;
            PG8_STAGE(PG8_SB(1, 1), b3 + hstepB, voffB);
            PG8_WAIT_V(6); PG8_BAR; PG8_MMA(1, 1, At, B1); PG8_BAR;
            }
        }
        if constexpr (ALIGN_EPI) { if (wr == 0) PG8_BAR; }
        if constexpr (!Epi::AFTER_DRAIN) { E(acc, cur, wr, wc, fr, fq); S.done(cur); }
        if (!has_next) break;
#pragma unroll
        for (int a = 0; a < 2; ++a)
#pragma unroll
            for (int b = 0; b < 2; ++b)
#pragma unroll
                for (int m = 0; m < 4; ++m)
#pragma unroll
                    for (int n = 0; n < 2; ++n) acc[a][b][m][n] = (f32x4){0.f, 0.f, 0.f, 0.f};
        cur = nxt; cA = nA; cB = nB; ++ui;
        if constexpr (ALIGN_EPI) { if (wr == 1) PG8_BAR; }
    }
    PG8_WAIT_V(0);
    if constexpr (!ALIGN_EPI) { if (wr == 0) PG8_BAR; }
    PG8_BAR;
    if constexpr (Epi::AFTER_DRAIN) { E.fused(acc, cur, wr, wc, fr, fq, lds, wid, lane); S.done(cur); }
#undef PG8_SA
#undef PG8_SB
#undef PG8_STAGE
#undef PG8_LDA
#undef PG8_LDB
#undef PG8_MMA
#undef PG8_WAIT_V
#undef PG8_WAIT_L
#undef PG8_BAR
#undef PG8_SCHED
}
}
constexpr int S = 16384, DM = 1024, DEPTH = 4, NIN = 2816, DFF = 2816, NUP = 5632;
constexpr float EPS = 1e-6f;
constexpr int NWAVES = 8, NTHR = 512;
constexpr size_t MiB = 1u << 20;
constexpr size_t WS_WIN = 1 * MiB, WS_WOUT = 23 * MiB, WS_WUP = 31 * MiB, WS_WDN = 75 * MiB;
constexpr size_t WS_PART = 97 * MiB;
constexpr size_t WS_BAR = 98 * MiB;
constexpr size_t WS_XB = 98 * MiB + 16384 + 4096;
constexpr size_t WS_P = 131 * MiB;
constexpr size_t WS_Y = 219 * MiB;
constexpr size_t WS_A = 131 * MiB;
constexpr size_t WS_END = 251 * MiB;
constexpr int LDS_BYTES = 147456;
#define LAS __attribute__((address_space(3)))
typedef unsigned short bf16;
typedef unsigned v4u __attribute__((ext_vector_type(4)));
typedef unsigned v2u __attribute__((ext_vector_type(2)));
typedef float f32x4 __attribute__((ext_vector_type(4)));
typedef float f32x16 __attribute__((ext_vector_type(16)));
typedef short bf16x8 __attribute__((ext_vector_type(8)));
#define LDS_WAIT() asm volatile("s_waitcnt lgkmcnt(0)" ::: "memory")
__device__ __forceinline__ unsigned pk2(float lo, float hi) { return pg8::cvt_pk_bf16(lo, hi); }
__device__ __forceinline__ float bflo(unsigned u) { return __uint_as_float(u << 16); }
__device__ __forceinline__ float bfhi(unsigned u) { return __uint_as_float(u & 0xffff0000u); }
__device__ __forceinline__ float bf1(bf16 v) { return __uint_as_float((unsigned)v << 16); }
#define WS_DPP(v, ctrl) __builtin_bit_cast(float, __builtin_amdgcn_update_dpp(0, __builtin_bit_cast(int, (float)(v)), (ctrl), 0xf, 0xf, true))
__device__ __forceinline__ float wave_sum(float v) {
    v += WS_DPP(v, 0xB1); v += WS_DPP(v, 0x4E); v += WS_DPP(v, 0x141); v += WS_DPP(v, 0x140);
    const int iv = __builtin_bit_cast(int, v);
    const float a = __builtin_bit_cast(float, __builtin_amdgcn_readlane(iv, 0)), b = __builtin_bit_cast(float, __builtin_amdgcn_readlane(iv, 16));
    const float c = __builtin_bit_cast(float, __builtin_amdgcn_readlane(iv, 32)), d = __builtin_bit_cast(float, __builtin_amdgcn_readlane(iv, 48));
    return (a + b) + (c + d);
}

__device__ __forceinline__ void cvt_item(const float* W, int K, int N, bf16* WT, const float* gain, int mode, LAS float* scr, int item, int lane) {
    const int nblk = N / 32, kb = item / nblk, nb = item % nblk, k0 = 64 * kb, n0 = 32 * nb;
    float wv[32];
#pragma unroll
    for (int i = 0; i < 32; ++i) { const int kk = 2 * i + (lane >> 5); wv[i] = __builtin_nontemporal_load(((const __attribute__((address_space(1))) float*)W) + (size_t)(k0 + kk) * N + n0 + (lane & 31)); }
#pragma unroll
    for (int i = 0; i < 32; ++i) { const int kk = 2 * i + (lane >> 5); const float g = gain ? ((const __attribute__((address_space(1))) float*)gain)[k0 + kk] : 1.0f; scr[kk * 33 + (lane & 31)] = wv[i] * g; }
    LDS_WAIT(); asm volatile("" ::: "memory");
    const float cs = (mode == 1 && n0 >= 1280 && n0 < 1792) ? 0.125f * 1.4426950408889634f : 1.0f;
    int rb = n0;
    if (mode == 2) { rb = (n0 < DFF) ? 256 * (n0 / 128) + (n0 % 128) : 256 * ((n0 - DFF) / 128) + 128 + ((n0 - DFF) % 128); }
    const int c = lane & 7;
#pragma unroll
    for (int j = 0; j < 4; ++j) { const int n = (lane >> 3) + 8 * j; const LAS float* s = scr + (8 * c) * 33 + n;
        v4u o; o.x = pk2(s[0 * 33] * cs, s[1 * 33] * cs); o.y = pk2(s[2 * 33] * cs, s[3 * 33] * cs); o.z = pk2(s[4 * 33] * cs, s[5 * 33] * cs); o.w = pk2(s[6 * 33] * cs, s[7 * 33] * cs);
        *(__attribute__((address_space(1))) v4u*)(WT + (size_t)(rb + n) * K + k0 + 8 * c) = o; }
    LDS_WAIT(); asm volatile("" ::: "memory");
}

typedef __attribute__((address_space(1))) unsigned gu32;
#define XB_TMO      128
#define XB_XCNT(j)  (256  + 64 * (j))
#define XB_XSUB(j)  (1280 + 64 * (j))
#define XB_XGEN(j)  (2304 + 64 * (j))
#define XB_TOP      3328
#define XB_TOPGEN   3392
#define XCD_BAR_WORDS 3456
#define XB_SPIN_CAP (1u << 18)

__device__ __forceinline__ unsigned xb_ld(unsigned* p)              { return __hip_atomic_load(p, __ATOMIC_RELAXED, __HIP_MEMORY_SCOPE_AGENT); }
__device__ __forceinline__ unsigned xb_add(unsigned* p, unsigned v) { return __hip_atomic_fetch_add(p, v, __ATOMIC_RELAXED, __HIP_MEMORY_SCOPE_AGENT); }
__device__ __forceinline__ unsigned xb_xcc_id() { return (unsigned)__builtin_amdgcn_s_getreg((3 << 11) | 20) & 0xFu; }
#define XB_SPIN(cond, bar) do { unsigned _sp = 0; while (cond) { __builtin_amdgcn_s_sleep(1); \
    if ((++_sp & 255u) == 0u) { if (xb_ld(&(bar)[XB_TMO])) break; if (_sp > XB_SPIN_CAP) { atomicAdd(&(bar)[XB_TMO], 1u); break; } } } } while (0)

struct XcdBarrier {
    unsigned* bar; unsigned x;
    volatile LAS unsigned* st;
};

__device__ __forceinline__ XcdBarrier xcd_barrier_post(unsigned* bar, volatile LAS unsigned* st) {
    XcdBarrier b; b.bar = bar; b.x = xb_xcc_id(); b.st = st;
    if (threadIdx.x == 0) (void)xb_add(&bar[XB_XCNT(b.x)], 1u);
    return b;
}
__device__ __forceinline__ void xcd_barrier_complete(unsigned* bar, unsigned x, unsigned& nloc, unsigned& nx) {
    const unsigned G = gridDim.x * gridDim.y * gridDim.z;
    unsigned sum, cnt, mine, sp = 0u;
    for (;;) {
        sum = 0u; cnt = 0u; mine = 0u;
#pragma unroll
        for (unsigned j = 0; j < 16; ++j) { const unsigned c = xb_ld(&bar[XB_XCNT(j)]); sum += c; cnt += (c > 0u) ? 1u : 0u; mine = (j == x) ? c : mine; }
        if (sum == G) break;
        __builtin_amdgcn_s_sleep(1);
        if ((++sp & 255u) == 0u) { if (xb_ld(&bar[XB_TMO])) break; if (sp > XB_SPIN_CAP) { atomicAdd(&bar[XB_TMO], 1u); break; } }
    }
    nloc = mine > 0u ? mine : 1u; nx = cnt > 0u ? cnt : 1u;
}

__device__ __forceinline__ void xcd_barrier(const XcdBarrier& b) {
    asm volatile("s_waitcnt vmcnt(0)" ::: "memory");
    __syncthreads();
    if (threadIdx.x == 0) {
        unsigned* bar = b.bar;
        __builtin_amdgcn_s_waitcnt(0);
        unsigned nloc = b.st[0], nx = b.st[1];
        if (nloc == 0u) { xcd_barrier_complete(bar, b.x, nloc, nx); b.st[0] = nloc; b.st[1] = nx; }
        const unsigned old = xb_add(&bar[XB_XSUB(b.x)], 1u);
        const unsigned gen = old / nloc;
        if (old + 1u == (gen + 1u) * nloc) {
            __builtin_amdgcn_fence(__ATOMIC_RELEASE, "agent");
            asm volatile("s_waitcnt vmcnt(0)" ::: "memory");
            const unsigned og = xb_add(&bar[XB_TOP], 1u);
            const unsigned tg = og / nx;
            if (og + 1u == (tg + 1u) * nx) xb_add(&bar[XB_TOPGEN], 1u);
            else XB_SPIN(xb_ld(&bar[XB_TOPGEN]) == tg, bar);
            __builtin_amdgcn_fence(__ATOMIC_ACQUIRE, "agent");
            xb_add(&bar[XB_XGEN(b.x)], 1u);
            asm volatile("s_waitcnt vmcnt(0)" ::: "memory");
        } else {
            XB_SPIN(xb_ld(&bar[XB_XGEN(b.x)]) == gen, bar);
            __builtin_amdgcn_fence(__ATOMIC_ACQUIRE, "agent");
            asm volatile("s_waitcnt vmcnt(0)" ::: "memory");
        }
    }
    __syncthreads();
}

struct CvtSrc { const float *w_in, *w_out, *w_up, *w_down, *norm_mix, *out_norm, *norm_ffn; bf16 *Win_t, *Wout_t, *Wup_t, *Wdn_t; };
__device__ __forceinline__ void cvt_layer_item(const CvtSrc& c, int l, int r, LAS float* scr, int lane) {
    const float* W; bf16* WT; const float* gain; int K, N, mode;
    if (r < 1408) { W = c.w_in + (size_t)l * DM * NIN; K = DM; N = NIN; WT = c.Win_t + (size_t)l * NIN * DM; gain = c.norm_mix + l * DM; mode = 1; }
    else if (r < 1920) { r -= 1408; W = c.w_out + (size_t)l * DM * DM; K = DM; N = DM; WT = c.Wout_t + (size_t)l * DM * DM; gain = c.out_norm + l * DM; mode = 0; }
    else if (r < 4736) { r -= 1920; W = c.w_up + (size_t)l * DM * NUP; K = DM; N = NUP; WT = c.Wup_t + (size_t)l * NUP * DM; gain = c.norm_ffn + l * DM; mode = 2; }
    else { r -= 4736; W = c.w_down + (size_t)l * DFF * DM; K = DFF; N = DM; WT = c.Wdn_t + (size_t)l * DM * DFF; gain = nullptr; mode = 0; }
    cvt_item(W, K, N, WT, gain, mode, scr, r, lane);
}
__device__ __forceinline__ const float* ldptr(const volatile LAS unsigned* PT, int k) {
    const unsigned lo = __builtin_amdgcn_readfirstlane(PT[2 * k]), hi = __builtin_amdgcn_readfirstlane(PT[2 * k + 1]);
    return (const float*)(const __attribute__((address_space(1))) float*)(((unsigned long long)hi << 32) | lo);
}
struct Args { const float* in[14]; float* out; unsigned char* ws; };

__device__ __forceinline__ void norm_store_rows(const LAS float* tile, bf16* Y, int t0, int coff, int wave, int lane) {
#pragma unroll 2
    for (int i = 0; i < 8; ++i) { const int r = wave * 8 + i; const f32x4 v = *(const LAS f32x4*)(tile + r * 260 + lane * 4);
        const float ss = wave_sum((v[0] * v[0] + v[1] * v[1]) + (v[2] * v[2] + v[3] * v[3]));
        const float rs = __builtin_amdgcn_rsqf(ss * (1.0f / 256.0f) + EPS);
        v2u o; o.x = pk2(v[0] * rs, v[1] * rs); o.y = pk2(v[2] * rs, v[3] * rs);
        *(__attribute__((address_space(1))) v2u*)(Y + (size_t)(t0 + r) * DM + coff + lane * 4) = o; }
}

typedef short v4i16_t __attribute__((ext_vector_type(4)));
__device__ __forceinline__ bf16x8 vtfrag(const LAS bf16* p) {
    const v4i16_t lo = __builtin_amdgcn_ds_read_tr16_b64_v4i16((LAS v4i16_t*)p), hi = __builtin_amdgcn_ds_read_tr16_b64_v4i16((LAS v4i16_t*)(p + 4 * 96));
    return (bf16x8){lo[0], lo[1], lo[2], lo[3], hi[0], hi[1], hi[2], hi[3]};
}
__device__ __forceinline__ void mixer_unit(LAS unsigned char* lds, int unit, const bf16* P, bf16* Y, const float* conv_w, const float* sgu_norm, const float* sgu_w, const float* sgu_b, int tid, int wave, int lane) {
    const int t0 = unit * 64;
    asm volatile("" : "+v"(tid), "+v"(lane));
    LAS bf16* vnT = (LAS bf16*)lds;
    LAS float* tile = (LAS float*)(lds + 69632);
    LAS float* sm_ss = (LAS float*)(lds + 69632 + 66560);
    {
        const int hd = wave, r = lane & 31, h = lane >> 5;
        const int pr = (r & 0x13) | ((r & 4) << 1) | ((r & 8) >> 1);
        LAS bf16* Vr = (LAS bf16*)(lds + wave * 6144);
        const LAS bf16* vtb = Vr + (8 * h + ((lane & 15) >> 2)) * 96 + 16 * ((lane >> 4) & 1) + 4 * (lane & 3);
        f32x16 oacc[2][2];
        bf16x8 kfn[4]; v4u vvn[4];
        { const bf16* kp = P + (size_t)(t0 + 32 + pr) * NIN + 1792 + hd * 64 + 8 * h;
#pragma unroll
          for (int ks = 0; ks < 4; ++ks) kfn[ks] = *(const __attribute__((address_space(1))) bf16x8*)(kp + 16 * ks);
#pragma unroll
          for (int i = 0; i < 4; ++i) vvn[i] = *(const __attribute__((address_space(1))) v4u*)(P + (size_t)(t0 + 32 + (lane >> 3) + 8 * i) * NIN + 2304 + hd * 64 + 8 * (lane & 7)); }
        bf16x8 kf2[4]; v4u vv2[4];
        { const bf16* kp = P + (size_t)(t0 + pr) * NIN + 1792 + hd * 64 + 8 * h;
#pragma unroll
          for (int ks = 0; ks < 4; ++ks) kf2[ks] = *(const __attribute__((address_space(1))) bf16x8*)(kp + 16 * ks);
#pragma unroll
          for (int i = 0; i < 4; ++i) vv2[i] = *(const __attribute__((address_space(1))) v4u*)(P + (size_t)(t0 + (lane >> 3) + 8 * i) * NIN + 2304 + hd * 64 + 8 * (lane & 7)); }
        LAS bf16x8* Qs = (LAS bf16x8*)(lds + 49152 + wave * 8192);
#pragma unroll
        for (int ks = 0; ks < 4; ++ks) { Qs[ks * 64 + lane] = *(const __attribute__((address_space(1))) bf16x8*)(P + (size_t)(t0 + r) * NIN + 1280 + hd * 64 + 16 * ks + 8 * h); Qs[(4 + ks) * 64 + lane] = *(const __attribute__((address_space(1))) bf16x8*)(P + (size_t)(t0 + 32 + r) * NIN + 1280 + hd * 64 + 16 * ks + 8 * h); }
#pragma unroll
        for (int a = 0; a < 2; ++a)
#pragma unroll
            for (int b = 0; b < 2; ++b) oacc[a][b] = (f32x16){};
        float lsA = 1.0f, lsB = 1.0f; bool actA = true, actB = true;
#define SB_CHAIN(Z, O0, O1, SURV, DIAGV) do { \
            float om[16], be[16]; \
            _Pragma("unroll") for (int jj = 0; jj < 16; ++jj) { const float zz = Z[jj]; const float ex = __builtin_amdgcn_exp2f(-fabsf(zz)); const float rr = __builtin_amdgcn_rcpf(1.0f + ex); const float er = ex * rr; \
                be[jj] = zz >= 0.f ? rr : er; om[jj] = zz >= 0.f ? er : rr; } \
            if (DIAGV) { _Pragma("unroll") for (int jj = 0; jj < 16; ++jj) { const int keyl = 16 * (jj >> 3) + 8 * h + (jj & 7); const bool valid = keyl < r; om[jj] = valid ? om[jj] : 1.0f; be[jj] = valid ? be[jj] : 0.f; } } \
            float sl[8], sh[8]; sl[7] = 1.0f; sh[7] = 1.0f; \
            _Pragma("unroll") for (int i = 6; i >= 0; --i) { sl[i] = sl[i + 1] * om[i + 1]; sh[i] = sh[i + 1] * om[8 + i + 1]; } \
            const float pl = sl[0] * om[0], ph = sh[0] * om[8]; \
            const float plx = __shfl_xor(pl, 32), phx = __shfl_xor(ph, 32); \
            const float hh = ph * phx; \
            const float sc_hi = SURV * (h ? 1.0f : phx), sc_lo = SURV * (hh * (h ? 1.0f : plx)); \
            unsigned wp[8]; \
            _Pragma("unroll") for (int i = 0; i < 8; i += 2) { wp[i >> 1] = pk2(be[i] * sl[i] * sc_lo, be[i + 1] * sl[i + 1] * sc_lo); wp[4 + (i >> 1)] = pk2(be[8 + i] * sh[i] * sc_hi, be[9 + i] * sh[i + 1] * sc_hi); } \
            SURV *= (pl * plx) * hh; \
            const bf16x8 w0 = __builtin_bit_cast(bf16x8, (v4u){wp[0], wp[1], wp[2], wp[3]}), w1 = __builtin_bit_cast(bf16x8, (v4u){wp[4], wp[5], wp[6], wp[7]}); \
            O0 = __builtin_amdgcn_mfma_f32_32x32x16_bf16(vtfrag(vtb), w0, O0, 0, 0, 0); \
            O0 = __builtin_amdgcn_mfma_f32_32x32x16_bf16(vtfrag(vtb + 16 * 96), w1, O0, 0, 0, 0); \
            O1 = __builtin_amdgcn_mfma_f32_32x32x16_bf16(vtfrag(vtb + 32), w0, O1, 0, 0, 0); \
            O1 = __builtin_amdgcn_mfma_f32_32x32x16_bf16(vtfrag(vtb + 16 * 96 + 32), w1, O1, 0, 0, 0); } while (0)
        for (int k0 = t0 + 32;; k0 -= 32) {
            const bool doA = actA && (k0 <= t0);
            f32x16 zB = {}, zA = {};
            if (actB) {
#pragma unroll
                for (int ks = 0; ks < 4; ++ks) zB = __builtin_amdgcn_mfma_f32_32x32x16_bf16(kfn[ks], Qs[(4 + ks) * 64 + lane], zB, 0, 0, 0); }
            if (doA) {
#pragma unroll
                for (int ks = 0; ks < 4; ++ks) zA = __builtin_amdgcn_mfma_f32_32x32x16_bf16(kfn[ks], Qs[ks * 64 + lane], zA, 0, 0, 0); }
#pragma unroll
            for (int i = 0; i < 4; ++i) { const int key = (lane >> 3) + 8 * i, c = lane & 7; *(LAS v4u*)(Vr + key * 96 + 8 * c) = vvn[i]; }
#pragma unroll
            for (int ks = 0; ks < 4; ++ks) kfn[ks] = kf2[ks];
#pragma unroll
            for (int i = 0; i < 4; ++i) vvn[i] = vv2[i];
            if (k0 >= 64) { const bf16* kp = P + (size_t)(k0 - 64 + pr) * NIN + 1792 + hd * 64 + 8 * h;
#pragma unroll
                for (int ks = 0; ks < 4; ++ks) kf2[ks] = *(const __attribute__((address_space(1))) bf16x8*)(kp + 16 * ks);
#pragma unroll
                for (int i = 0; i < 4; ++i) vv2[i] = *(const __attribute__((address_space(1))) v4u*)(P + (size_t)(k0 - 64 + (lane >> 3) + 8 * i) * NIN + 2304 + hd * 64 + 8 * (lane & 7)); }
            if (actB) { const bool dg = (k0 == t0 + 32); SB_CHAIN(zB, oacc[1][0], oacc[1][1], lsB, dg);
                if (__builtin_amdgcn_ballot_w64(lsB > 1e-37f) == 0ull) actB = false; }
            if (doA) { const bool dg = (k0 == t0); SB_CHAIN(zA, oacc[0][0], oacc[0][1], lsA, dg);
                if (__builtin_amdgcn_ballot_w64(lsA > 1e-37f) == 0ull) actA = false; }
            if (k0 < 32 || !(actA || actB)) break;
        }
#undef SB_CHAIN
#pragma unroll
        for (int qh = 0; qh < 2; ++qh) { float ss = 0.f;
#pragma unroll
            for (int j = 0; j < 16; ++j) ss += oacc[qh][0][j] * oacc[qh][0][j] + oacc[qh][1][j] * oacc[qh][1][j];
            ss += __shfl_xor(ss, 32);
            if (h == 0) sm_ss[(32 * qh + r) * 8 + hd] = ss; }
        LDS_WAIT(); __syncthreads();
#pragma unroll
        for (int qh = 0; qh < 2; ++qh) {
            const f32x4 sa = *(const LAS f32x4*)(sm_ss + (32 * qh + r) * 8), sb = *(const LAS f32x4*)(sm_ss + (32 * qh + r) * 8 + 4);
            const float tot = ((sa[0] + sa[1]) + (sa[2] + sa[3])) + ((sb[0] + sb[1]) + (sb[2] + sb[3]));
            const float rs = __builtin_amdgcn_rsqf(tot * (1.0f / 512.0f) + EPS);
            bf16* yp = Y + (size_t)(t0 + 32 * qh + r) * DM + 512 + hd * 64 + 8 * h;
#pragma unroll
            for (int db = 0; db < 2; ++db)
#pragma unroll
                for (int kk = 0; kk < 2; ++kk) { const f32x16& o = oacc[qh][db]; const int ga = 8 * kk, gb2 = 8 * kk + 4;
                    const unsigned ax = pk2(o[ga + 0] * rs, o[ga + 1] * rs), ay = pk2(o[ga + 2] * rs, o[ga + 3] * rs), bx_ = pk2(o[gb2 + 0] * rs, o[gb2 + 1] * rs), by_ = pk2(o[gb2 + 2] * rs, o[gb2 + 3] * rs);
                    auto sx = __builtin_amdgcn_permlane32_swap(ax, bx_, false, false), sy = __builtin_amdgcn_permlane32_swap(ay, by_, false, false);
                    v4u w; w.x = sx[0]; w.y = sy[0]; w.z = sx[1]; w.w = sy[1];
                    *(__attribute__((address_space(1))) v4u*)(yp + 32 * db + 16 * kk) = w; }
        }
    }
    const int c8 = (tid & 31) * 8, rg = tid >> 5, tb = t0 + 4 * rg;
    v4u gb[4], gc[6], hc[6];
#pragma unroll
    for (int i = 0; i < 6; ++i) { const int t = tb - 2 + i; const bool ok = t >= 0; const bf16* rp = P + (size_t)(ok ? t : 0) * NIN;
        gc[i] = ok ? *(const __attribute__((address_space(1))) v4u*)(rp + 256 + c8) : (v4u){0u, 0u, 0u, 0u}; hc[i] = ok ? *(const __attribute__((address_space(1))) v4u*)(rp + 512 + c8) : (v4u){0u, 0u, 0u, 0u};
        if (i >= 2) gb[i - 2] = *(const __attribute__((address_space(1))) v4u*)(rp + c8); }
    const int tc = t0 & ~127, dt = t0 - tc, ns = dt + 64;
    v2u uu[16];
#pragma unroll
    for (int i = 0; i < 16; ++i) { const int s = wave + 8 * i; uu[i] = (s < ns) ? *(const __attribute__((address_space(1))) v2u*)(P + (size_t)(tc + s) * NIN + 1024 + lane * 4) : (v2u){0u, 0u}; }
    const int h = wave >> 1, rh = wave & 1, r32 = lane & 31, hi = lane >> 5;
    const int tcl = dt + 32 * rh + r32;
    const int nk = (dt + 32 * rh + 32) >> 4;
    f32x4 wa[8], wb[8];
    { const float* wrow = sgu_w + ((size_t)h * 128 + tcl) * 128;
#pragma unroll
      for (int ks = 0; ks < 8; ++ks) { const int s0 = ks * 16 + 8 * hi; if (ks < nk) { wa[ks] = *(const __attribute__((address_space(1))) f32x4*)(wrow + s0); wb[ks] = *(const __attribute__((address_space(1))) f32x4*)(wrow + s0 + 4); } else { wa[ks] = (f32x4){0.f, 0.f, 0.f, 0.f}; wb[ks] = wa[ks]; } } }
    {
        float w0[8], w1[8], w2[8];
        { const f32x4 a0 = *(const __attribute__((address_space(1))) f32x4*)(conv_w + c8), a1 = *(const __attribute__((address_space(1))) f32x4*)(conv_w + c8 + 4), b0 = *(const __attribute__((address_space(1))) f32x4*)(conv_w + 256 + c8), b1 = *(const __attribute__((address_space(1))) f32x4*)(conv_w + 256 + c8 + 4), d0 = *(const __attribute__((address_space(1))) f32x4*)(conv_w + 512 + c8), d1 = *(const __attribute__((address_space(1))) f32x4*)(conv_w + 512 + c8 + 4);
#pragma unroll
          for (int e = 0; e < 4; ++e) { w0[e] = a0[e]; w0[4 + e] = a1[e]; w1[e] = b0[e]; w1[4 + e] = b1[e]; w2[e] = d0[e]; w2[4 + e] = d1[e]; } }
        float pr_[6][8];
#pragma unroll
        for (int i = 0; i < 6; ++i) { const unsigned ga[4] = {gc[i].x, gc[i].y, gc[i].z, gc[i].w}, ha[4] = {hc[i].x, hc[i].y, hc[i].z, hc[i].w};
#pragma unroll
            for (int e = 0; e < 4; ++e) { pr_[i][2 * e] = bflo(ga[e]) * bflo(ha[e]); pr_[i][2 * e + 1] = bfhi(ga[e]) * bfhi(ha[e]); } }
#pragma unroll
        for (int i = 0; i < 4; ++i) { const unsigned ba[4] = {gb[i].x, gb[i].y, gb[i].z, gb[i].w}; float o[8];
#pragma unroll
            for (int e = 0; e < 4; ++e) { o[2 * e] = bflo(ba[e]) * (w0[2 * e] * pr_[i][2 * e] + w1[2 * e] * pr_[i + 1][2 * e] + w2[2 * e] * pr_[i + 2][2 * e]);
                o[2 * e + 1] = bfhi(ba[e]) * (w0[2 * e + 1] * pr_[i][2 * e + 1] + w1[2 * e + 1] * pr_[i + 1][2 * e + 1] + w2[2 * e + 1] * pr_[i + 2][2 * e + 1]); }
            LAS f32x4* tp = (LAS f32x4*)(tile + (4 * rg + i) * 260 + c8); tp[0] = (f32x4){o[0], o[1], o[2], o[3]}; tp[1] = (f32x4){o[4], o[5], o[6], o[7]}; }
    }
    LDS_WAIT(); __syncthreads();
    norm_store_rows(tile, Y, t0, 0, wave, lane);
    { const f32x4 g = *(const __attribute__((address_space(1))) f32x4*)(sgu_norm + lane * 4);
#pragma unroll
      for (int i = 0; i < 16; ++i) { const int s = wave + 8 * i;
        if (s < ns) { const v2u u = uu[i];
        const float v0 = bflo(u.x), v1 = bfhi(u.x), v2 = bflo(u.y), v3 = bfhi(u.y);
        const float ss = wave_sum((v0 * v0 + v1 * v1) + (v2 * v2 + v3 * v3)); const float rs = __builtin_amdgcn_rsqf(ss * (1.0f / 256.0f) + EPS);
        const unsigned a = pk2(v0 * rs * g[0], v1 * rs * g[1]), b = pk2(v2 * rs * g[2], v3 * rs * g[3]);
        const int sx = s ^ (((lane >> 1) & 7) << 3);
        vnT[(lane * 4 + 0) * 136 + sx] = (bf16)(a & 0xffffu); vnT[(lane * 4 + 1) * 136 + sx] = (bf16)(a >> 16); vnT[(lane * 4 + 2) * 136 + sx] = (bf16)(b & 0xffffu); vnT[(lane * 4 + 3) * 136 + sx] = (bf16)(b >> 16); } } }
    float ug0[16], ug1[16], bbv[16];
#pragma unroll
    for (int j = 0; j < 16; ++j) { const int rl = 32 * rh + (j & 3) + 8 * (j >> 2) + 4 * hi; const bf16* up = P + (size_t)(t0 + rl) * NIN + 768 + h * 64;
        ug0[j] = bf1(((const __attribute__((address_space(1))) bf16*)up)[r32]); ug1[j] = bf1(((const __attribute__((address_space(1))) bf16*)up)[32 + r32]); bbv[j] = ((const __attribute__((address_space(1))) float*)sgu_b)[h * 128 + dt + rl]; }
    LDS_WAIT(); __syncthreads();
    {
        f32x16 o0 = {}, o1 = {};
#pragma unroll
        for (int ks = 0; ks < 8; ++ks) if (ks < nk) { const int s0 = ks * 16 + 8 * hi;
            float wv[8] = {wa[ks][0], wa[ks][1], wa[ks][2], wa[ks][3], wb[ks][0], wb[ks][1], wb[ks][2], wb[ks][3]};
#pragma unroll
            for (int i = 0; i < 8; ++i) wv[i] = (s0 + i <= tcl) ? wv[i] : 0.f;
            v4u ap; ap.x = pk2(wv[0], wv[1]); ap.y = pk2(wv[2], wv[3]); ap.z = pk2(wv[4], wv[5]); ap.w = pk2(wv[6], wv[7]);
            const bf16x8 af = __builtin_bit_cast(bf16x8, ap);
            const int sw = s0 ^ (((r32 >> 3) & 3) << 3);
            const bf16x8 b0 = *(const LAS bf16x8*)(vnT + (h * 64 + r32) * 136 + sw), b1 = *(const LAS bf16x8*)(vnT + (h * 64 + 32 + r32) * 136 + (sw ^ 32));
            o0 = __builtin_amdgcn_mfma_f32_32x32x16_bf16(af, b0, o0, 0, 0, 0);
            o1 = __builtin_amdgcn_mfma_f32_32x32x16_bf16(af, b1, o1, 0, 0, 0); }
#pragma unroll
        for (int j = 0; j < 16; ++j) { const int rl = 32 * rh + (j & 3) + 8 * (j >> 2) + 4 * hi;
            tile[rl * 260 + h * 64 + r32] = ug0[j] * (o0[j] + bbv[j]);
            tile[rl * 260 + h * 64 + 32 + r32] = ug1[j] * (o1[j] + bbv[j]); }
    }
    LDS_WAIT(); __syncthreads();
    norm_store_rows(tile, Y, t0, 256, wave, lane);
    LDS_WAIT(); __syncthreads();
}

__global__ void __launch_bounds__(NTHR, 2) hybrid_fwd(Args args) {
    extern __shared__ __attribute__((aligned(16))) unsigned char lds_raw[];
    LAS unsigned char* lds = (LAS unsigned char*)lds_raw;
    cg::grid_group grid = cg::this_grid();
    volatile LAS unsigned* MISC = (volatile LAS unsigned*)(lds + LDS_BYTES - 64);
    volatile LAS unsigned* PT = (volatile LAS unsigned*)(lds + LDS_BYTES - 256);
    if (threadIdx.x < 16) MISC[threadIdx.x] = 0u;
    if (threadIdx.x == 0) {
#define PUTP(k) { const unsigned long long v_ = (unsigned long long)args.in[k]; PT[2 * (k)] = (unsigned)v_; PT[2 * (k) + 1] = (unsigned)(v_ >> 32); }
        PUTP(0) PUTP(1) PUTP(2) PUTP(3) PUTP(4) PUTP(5) PUTP(6) PUTP(7) PUTP(8) PUTP(9) PUTP(10) PUTP(11) PUTP(12) PUTP(13)
#undef PUTP
    }
    __syncthreads();
    XcdBarrier xbar = xcd_barrier_post((unsigned*)(args.ws + WS_BAR), MISC);
    const int tid = threadIdx.x, lane = tid & 63, wave = __builtin_amdgcn_readfirstlane(tid >> 6);
    const int G = gridDim.x, bx = blockIdx.x;
    const int gw = bx * NWAVES + wave, NGW = G * NWAVES;
    unsigned char* ws = args.ws;
#define INP(k) ldptr(PT, (k))
#define MAKE_CS() const CvtSrc cs{INP(2), INP(8), INP(10), INP(12), INP(1), INP(7), INP(9), Win_t, Wout_t, Wup_t, Wdn_t}
    float* xo = args.out;
#define PHASE_PTRS() unsigned char* w_ = ws; float* xcur = xo; asm volatile("" : "+s"(w_), "+s"(xcur)); \
    w_ = (unsigned char*)(__attribute__((address_space(1))) unsigned char*)w_; xcur = (float*)(__attribute__((address_space(1))) float*)xcur;     \
    bf16* Win_t = (bf16*)(w_ + WS_WIN); bf16* Wout_t = (bf16*)(w_ + WS_WOUT); bf16* Wup_t = (bf16*)(w_ + WS_WUP); bf16* Wdn_t = (bf16*)(w_ + WS_WDN); \
    float* part = (float*)(w_ + WS_PART); bf16* XB = (bf16*)(w_ + WS_XB); bf16* P = (bf16*)(w_ + WS_P); bf16* Y = (bf16*)(w_ + WS_Y); bf16* A = (bf16*)(w_ + WS_A); \
    (void)Win_t; (void)Wout_t; (void)Wup_t; (void)Wdn_t; (void)part; (void)XB; (void)P; (void)Y; (void)A; (void)xcur

    for (int step = -1; step < 5 * DEPTH; ++step) {
        const int l = step < 0 ? 0 : step / 5, ph = step < 0 ? -1 : step % 5;
        int cvt_layer = -1, cvt_first = 0, cvt_n = 0, cvt_nu = 0;
        if (ph < 0) {
            PHASE_PTRS(); const float* x_in = INP(0);
            int gw_ = gw, lane_ = lane; asm volatile("" : "+s"(gw_), "+v"(lane_));
            for (int m = gw_; m < S; m += NGW) { const __attribute__((address_space(1))) f32x4* xr = (const __attribute__((address_space(1))) f32x4*)(x_in + (size_t)m * DM) + lane_; f32x4 v[4]; float ss = 0.f;
#pragma unroll
                for (int j = 0; j < 4; ++j) { v[j] = __builtin_nontemporal_load(xr + 64 * j); ss += (v[j][0] * v[j][0] + v[j][1] * v[j][1]) + (v[j][2] * v[j][2] + v[j][3] * v[j][3]); }
                ss = wave_sum(ss);
                __attribute__((address_space(1))) v2u* o8 = (__attribute__((address_space(1))) v2u*)(XB + (size_t)m * DM) + lane_;
#pragma unroll
                for (int j = 0; j < 4; ++j) { v2u o; o.x = pk2(v[j][0], v[j][1]); o.y = pk2(v[j][2], v[j][3]); o8[64 * j] = o; }
                if (lane_ < 16) ((__attribute__((address_space(1))) float*)part)[(size_t)m * 16 + lane_] = lane_ == 0 ? ss : 0.f; }
            cvt_layer = 0; cvt_first = 0; cvt_n = 6144; cvt_nu = 0;
        } else if (ph == 0) {
            PHASE_PTRS(); pg8::Gemm g{XB, Win_t + (size_t)l * NIN * DM, S, NIN, DM, 256}; pg8::StaticOrder So; So.init(S, NIN, G, bx);
            pg8::EpiScaleBf16 E{P, NIN, part, (LAS float*)(lds + 131072 + 8192)};
            pg8::gemm_phase<pg8::EpiScaleBf16, pg8::StaticOrder, true, true>(lds, g, So, E);
            if (l + 1 < DEPTH) { cvt_layer = l + 1; cvt_first = 0; cvt_n = 1920; cvt_nu = (S / 256) * (NIN / 256); }
        } else if (ph == 1) {
            PHASE_PTRS();
            for (int u = bx; u < S / 64; u += G)
                mixer_unit(lds, u, P, Y, INP(3) + l * 3 * 256, INP(4) + l * 256, INP(5) + (size_t)l * 4 * 128 * 128, INP(6) + l * 4 * 128, tid, wave, lane);
        } else if (ph == 2) {
            PHASE_PTRS(); pg8::Gemm g{Y, Wout_t + (size_t)l * DM * DM, S, DM, DM, 256}; pg8::StaticOrder So; So.init(S, DM, G, bx);
            pg8::EpiResid E{XB, part};
            pg8::gemm_phase<pg8::EpiResid, pg8::StaticOrder, true, true>(lds, g, So, E);
        } else if (ph == 3) {
            PHASE_PTRS(); pg8::Gemm g{XB - 2 * DM, Wup_t + (size_t)l * NUP * DM, 65 * 256, NUP, DM, 254}; pg8::StaticOrder So; So.init(65 * 256, NUP, G, bx);
            pg8::EpiGate E{A, part, INP(11) + (size_t)l * 3 * NUP, (LAS float*)(lds + 131072)};
            pg8::gemm_phase<pg8::EpiGate, pg8::StaticOrder, true, true>(lds, g, So, E);
            if (l + 1 < DEPTH) { cvt_layer = l + 1; cvt_first = 1920; cvt_n = 4224; cvt_nu = 65 * (NUP / 256); }
        } else {
            PHASE_PTRS(); pg8::Gemm g{A, Wdn_t + (size_t)l * DM * DFF, S, DM, DFF, 256}; pg8::StaticOrder So; So.init(S, DM, G, bx);
            pg8::EpiResid E{XB, part};
            pg8::gemm_phase<pg8::EpiResid, pg8::StaticOrder, true, true>(lds, g, So, E);
        }
        if (cvt_layer >= 0) {
            const int first_idle = cvt_nu > 0 ? cvt_nu - ((cvt_nu + G - 1) / G - 1) * G : 0; const bool some_idle = first_idle < G;
            if (!some_idle || bx >= first_idle) { const int nw = (some_idle ? G - first_idle : G) * NWAVES, iw = (some_idle ? bx - first_idle : bx) * NWAVES + wave;
                PHASE_PTRS(); LAS float* scr = (LAS float*)(lds + wave * 16384); int lane_ = lane; asm volatile("" : "+v"(lane_));
                MAKE_CS(); for (int it = iw; it < cvt_n; it += nw) cvt_layer_item(cs, cvt_layer, cvt_first + it, scr, lane_); } }
        if (ws == nullptr) grid.sync();
        xcd_barrier(xbar);
    }
    { const float* nfin = INP(13); const bf16* XBf = (const bf16*)(ws + WS_XB);
      for (int m = gw; m < S; m += NGW) { const __attribute__((address_space(1))) v2u* xr = (const __attribute__((address_space(1))) v2u*)(XBf + (size_t)m * DM) + lane; f32x4 v[4]; float ss = 0.f;
#pragma unroll
        for (int j = 0; j < 4; ++j) { const v2u u = xr[64 * j]; v[j] = (f32x4){bflo(u.x), bfhi(u.x), bflo(u.y), bfhi(u.y)}; ss += (v[j][0] * v[j][0] + v[j][1] * v[j][1]) + (v[j][2] * v[j][2] + v[j][3] * v[j][3]); }
        const float rs = __builtin_amdgcn_rsqf(wave_sum(ss) * (1.0f / 1024.0f) + EPS);
        __attribute__((address_space(1))) f32x4* orow = (__attribute__((address_space(1))) f32x4*)(xo + (size_t)m * DM) + lane;
#pragma unroll
        for (int j = 0; j < 4; ++j) { const f32x4 g = *((const __attribute__((address_space(1))) f32x4*)nfin + lane + 64 * j); __builtin_nontemporal_store(v[j] * rs * g, orow + 64 * j); } } }
}

extern "C" void kernel_launch(void* const* d_in, const int* in_sizes, int n_in, void* d_out, int out_size, void* d_ws, size_t ws_size, hipStream_t stream) {
    static int grid = 0;
    if (grid == 0) {
        if (n_in != 14 || out_size != S * DM || ws_size < WS_END) { fprintf(stderr, "kernel_launch: unexpected shapes / workspace (%d inputs, out %d, ws %zu)\n", n_in, out_size, ws_size); grid = -1; return; }
        int dev = 0, cus = 0;
        hipGetDevice(&dev); hipDeviceGetAttribute(&cus, hipDeviceAttributeMultiprocessorCount, dev);
        hipFuncSetAttribute((const void*)hybrid_fwd, hipFuncAttributeMaxDynamicSharedMemorySize, LDS_BYTES);
        (void)hipGetLastError();
        grid = cus * 1;
    }
    if (grid < 0) return;
    hipMemsetAsync((unsigned char*)d_ws + WS_BAR, 0, 16384 + 4096, stream);
    Args a{};
    for (int i = 0; i < 14; ++i) a.in[i] = (const float*)d_in[i];
    a.out = (float*)d_out; a.ws = (unsigned char*)d_ws;
    void* kargs[] = {&a};
    hipError_t e = hipLaunchCooperativeKernel((const void*)hybrid_fwd, dim3(grid), dim3(NTHR), kargs, LDS_BYTES, stream);
    if (e != hipSuccess) fprintf(stderr, "cooperative launch failed: %s (grid %d)\n", hipGetErrorString(e), grid);
}
```
